# Optimizing an MI355X kernel written in HIP

```python
import math
import jax, jax.numpy as jnp
from jax import lax
import numpy as np

D_MODEL = 1024
BATCH = 16
SEQ = 4096
DEPTH = 2
DEC_BATCH = 1
DEC_SEQ = 16384
PAST_LEN = 128

GRID_W = 64
HEAD_DIM = 64
EPS = 1e-6
Q_BLOCK = 128

NA_HEADS = 8
NA_WIN_R = 8
NA_WIN_C = 16
NA_COL_BLK = 16
NA_KEY_COLS = NA_COL_BLK + NA_WIN_C
NA_W = NA_HEADS * HEAD_DIM

DIFF_HEADS = 4
DIFF_QK_DIM = 64
DIFF_V_DIM = 2 * DIFF_QK_DIM
DIFF_QK_W = DIFF_HEADS * 2 * DIFF_QK_DIM
DIFF_V_W = DIFF_HEADS * DIFF_V_DIM

IN0_W = 3 * NA_W + 2 * DIFF_QK_W + DIFF_V_W
MIX0_W = NA_W + DIFF_V_W

MLA_HEADS = 16
MLA_Q_RANK = 384
MLA_KV_RANK = 256
MLA_NOPE = 64
MLA_ROPE = 32
MLA_V = 64
ROPE_THETA = 10000.0
MLA_DOWN_W = MLA_Q_RANK + MLA_KV_RANK + MLA_ROPE

D_FF = -(-8 * D_MODEL // (3 * 256)) * 256

kernel_name = "hybrid_na_diff_mla_encoder"


def rmsnorm(x, g):
    xf = x.astype(jnp.float32)
    y = xf * lax.rsqrt(jnp.mean(xf * xf, axis=-1, keepdims=True) + EPS)
    return (y * g.astype(jnp.float32)).astype(x.dtype)


def alibi_slopes(n):
    return (2.0 ** (-8.0 * np.arange(1, n + 1) / n)).astype(np.float32)


def apply_rope(x, pos):
    r = x.shape[-1]
    half = r // 2
    inv = jnp.asarray(ROPE_THETA ** (-np.arange(half, dtype=np.float32) * 2.0 / r), dtype=jnp.float32)
    ang = pos.astype(jnp.float32)[:, None] * inv[None, :]
    cos = jnp.cos(ang)[None, :, None, :]
    sin = jnp.sin(ang)[None, :, None, :]
    xf = x.astype(jnp.float32)
    x1, x2 = xf[..., :half], xf[..., half:]
    return jnp.concatenate([x1 * cos - x2 * sin, x2 * cos + x1 * sin], axis=-1).astype(x.dtype)


def neighbourhood_attention(q, k, v, rpb):
    B, S, H, d = q.shape
    rows = S // GRID_W
    kr = min(NA_WIN_R, rows)
    n_cb = GRID_W // NA_COL_BLK
    qg = q.reshape(B, rows, n_cb, NA_COL_BLK, H, d)
    kg = k.reshape(B, rows, GRID_W, H, d)
    vg = v.reshape(B, rows, GRID_W, H, d)
    cb_start = np.arange(n_cb) * NA_COL_BLK
    kc0 = np.clip(cb_start - NA_WIN_C // 2, 0, GRID_W - NA_KEY_COLS)
    key_cols = kc0[:, None] + np.arange(NA_KEY_COLS)
    q_cols = cb_start[:, None] + np.arange(NA_COL_BLK)
    win_c0 = np.clip(q_cols - NA_WIN_C // 2, 0, GRID_W - NA_WIN_C)
    kc = key_cols[:, None, :]
    col_ok = (kc >= win_c0[..., None]) & (kc < win_c0[..., None] + NA_WIN_C)
    col_idx = np.clip(kc - q_cols[..., None] + NA_WIN_C - 1, 0, 2 * NA_WIN_C - 2)
    rpb_c = rpb[:, :, col_idx]
    mask = jnp.asarray(col_ok)[:, :, None, :]
    scale = d ** -0.5

    def one_row(r):
        rs = jnp.clip(r - kr // 2, 0, rows - kr)
        k_blk = lax.dynamic_slice_in_dim(kg, rs, kr, axis=1)[:, :, key_cols]
        v_blk = lax.dynamic_slice_in_dim(vg, rs, kr, axis=1)[:, :, key_cols]
        q_row = lax.dynamic_index_in_dim(qg, r, axis=1, keepdims=False)
        s = jnp.einsum('bnqhd,brnkhd->bhnqrk', q_row, k_blk,
                       preferred_element_type=jnp.float32) * scale
        row_idx = rs + jnp.arange(kr) - r + NA_WIN_R - 1
        bias = jnp.take(rpb_c, row_idx, axis=1).transpose(0, 2, 3, 1, 4)
        s = jnp.where(mask, s + bias.astype(jnp.float32), -jnp.inf)
        p = jax.nn.softmax(s, axis=(-2, -1)).astype(v.dtype)
        o = jnp.einsum('bhnqrk,brnkhd->bnqhd', p, v_blk)
        return o.reshape(B, GRID_W, H, d)

    out = lax.map(one_row, jnp.arange(rows))
    return out.transpose(1, 0, 2, 3, 4).reshape(B, S, H, d)


def diff_attention(q, k, v, lam, sub_g, lam_init):
    B, S, H2, dq = q.shape
    H = H2 // 2
    dv = v.shape[-1]
    nblk = S // Q_BLOCK
    slopes = jnp.asarray(np.repeat(alibi_slopes(H), 2))
    kh = k.transpose(0, 2, 1, 3)
    vh = v.transpose(0, 2, 1, 3)
    qb = q.reshape(B, nblk, Q_BLOCK, H2, dq).transpose(1, 0, 3, 2, 4)
    kpos = jnp.arange(S)
    scale = dq ** -0.5

    def one_block(args):
        qblk, i = args
        qpos = i * Q_BLOCK + jnp.arange(Q_BLOCK)
        dist = jnp.abs(qpos[:, None] - kpos[None, :]).astype(jnp.float32)
        s = (jnp.einsum('bhqd,bhkd->bhqk', qblk, kh, preferred_element_type=jnp.float32) * scale
             - slopes[:, None, None] * dist)
        p = jax.nn.softmax(s, axis=-1).reshape(B, H, 2, Q_BLOCK, S)
        a = (p[:, :, 0] - lam * p[:, :, 1]).astype(v.dtype)
        return jnp.einsum('bhqk,bhkd->bqhd', a, vh)

    o = lax.map(one_block, (qb, jnp.arange(nblk)))
    o = o.transpose(1, 0, 2, 3, 4).reshape(B, S, H, dv)
    return rmsnorm(o, sub_g) * (1.0 - lam_init)


def mla_attention(h, w_down, g_q, g_kv, w_uq, w_ukv):
    B, S, _ = h.shape
    H = MLA_HEADS
    c = h @ w_down
    cq = c[..., :MLA_Q_RANK]
    ckv = c[..., MLA_Q_RANK:MLA_Q_RANK + MLA_KV_RANK]
    k_rope_in = c[..., MLA_Q_RANK + MLA_KV_RANK:]
    q = (rmsnorm(cq, g_q) @ w_uq).reshape(B, S, H, MLA_NOPE + MLA_ROPE)
    kv = (rmsnorm(ckv, g_kv) @ w_ukv).reshape(B, S, H, MLA_NOPE + MLA_V)
    pos = jnp.arange(S)
    q_nope = q[..., :MLA_NOPE]
    q_rope = apply_rope(q[..., MLA_NOPE:], pos)
    k_rope = apply_rope(k_rope_in[:, :, None, :], pos)[:, :, 0]
    kn = kv[..., :MLA_NOPE].transpose(0, 2, 1, 3)
    vh = kv[..., MLA_NOPE:].transpose(0, 2, 1, 3)
    nblk = S // Q_BLOCK
    qn_b = q_nope.reshape(B, nblk, Q_BLOCK, H, MLA_NOPE).transpose(1, 0, 3, 2, 4)
    qr_b = q_rope.reshape(B, nblk, Q_BLOCK, H, MLA_ROPE).transpose(1, 0, 3, 2, 4)
    scale = (MLA_NOPE + MLA_ROPE) ** -0.5

    def one_block(args):
        qn, qr = args
        s = (jnp.einsum('bhqd,bhkd->bhqk', qn, kn, preferred_element_type=jnp.float32)
             + jnp.einsum('bhqr,bkr->bhqk', qr, k_rope, preferred_element_type=jnp.float32)) * scale
        p = jax.nn.softmax(s, axis=-1).astype(h.dtype)
        return jnp.einsum('bhqk,bhkd->bqhd', p, vh)

    o = lax.map(one_block, (qn_b, qr_b))
    return o.transpose(1, 0, 2, 3, 4).reshape(B, S, H * MLA_V)


def swiglu(h, w_in, w_out):
    gu = h @ w_in
    g, u = gu[..., :D_FF], gu[..., D_FF:]
    return (jax.nn.silu(g) * u) @ w_out


def mixer_na_diff(h, w_in, rpb, lam_q1, lam_k1, lam_q2, lam_k2, g_sub, w_out, layer_idx):
    B, S, _ = h.shape
    proj = h @ w_in
    o0 = 3 * NA_W
    na_q = proj[..., 0:NA_W].reshape(B, S, NA_HEADS, HEAD_DIM)
    na_k = proj[..., NA_W:2 * NA_W].reshape(B, S, NA_HEADS, HEAD_DIM)
    na_v = proj[..., 2 * NA_W:o0].reshape(B, S, NA_HEADS, HEAD_DIM)
    d_q = proj[..., o0:o0 + DIFF_QK_W].reshape(B, S, 2 * DIFF_HEADS, DIFF_QK_DIM)
    d_k = proj[..., o0 + DIFF_QK_W:o0 + 2 * DIFF_QK_W].reshape(B, S, 2 * DIFF_HEADS, DIFF_QK_DIM)
    d_v = proj[..., o0 + 2 * DIFF_QK_W:].reshape(B, S, DIFF_HEADS, DIFF_V_DIM)
    a = neighbourhood_attention(na_q, na_k, na_v, rpb)
    lam_init = 0.8 - 0.6 * math.exp(-0.3 * layer_idx)
    f32 = jnp.float32
    lam = (jnp.exp(jnp.sum(lam_q1.astype(f32) * lam_k1.astype(f32)))
           - jnp.exp(jnp.sum(lam_q2.astype(f32) * lam_k2.astype(f32))) + lam_init)
    b = diff_attention(d_q, d_k, d_v, lam, g_sub, lam_init)
    o = jnp.concatenate([a.reshape(B, S, NA_W), b.reshape(B, S, DIFF_V_W)], axis=-1)
    return o @ w_out


def trunk(x, p0, p1):
    layers = [p0, p1]
    for l in range(DEPTH):
        p = layers[l]
        h = rmsnorm(x, p['g_pre_mix'])
        if l % 2 == 0:
            m = mixer_na_diff(h, p['w_in'], p['rpb'], p['lam_q1'], p['lam_k1'], p['lam_q2'],
                              p['lam_k2'], p['g_sub'], p['w_out'], l)
        else:
            m = mla_attention(h, p['w_down'], p['g_q'], p['g_kv'], p['w_uq'], p['w_ukv']) @ p['w_out']
        x = x + rmsnorm(m, p['g_post_mix'])
        f = swiglu(rmsnorm(x, p['g_pre_ffn']), p['w_ffn_in'], p['w_ffn_out'])
        x = x + rmsnorm(f, p['g_post_ffn'])
    return x


def setup_inputs(seed: int = 0) -> dict:
    key = jax.random.key(seed)
    ks = iter(jax.random.split(key, 40))
    f32 = jnp.float32

    def w(shape):
        return jax.random.normal(next(ks), shape, f32) * (shape[0] ** -0.5)

    def gain(n):
        return 1.0 + 0.05 * jax.random.normal(next(ks), (n,), f32)

    d = {}
    d['x_prompt'] = jax.random.normal(next(ks), (BATCH, SEQ, D_MODEL), f32)
    d['x_sample'] = jax.random.normal(next(ks), (DEC_BATCH, DEC_SEQ, D_MODEL), f32)
    d['l0_g_pre_mix'] = gain(D_MODEL)
    d['l0_w_in'] = w((D_MODEL, IN0_W))
    d['l0_rpb'] = 0.1 * jax.random.normal(next(ks), (NA_HEADS, 2 * NA_WIN_R - 1, 2 * NA_WIN_C - 1), f32)
    d['l0_lam_q1'] = 0.1 * jax.random.normal(next(ks), (DIFF_QK_DIM,), f32)
    d['l0_lam_k1'] = 0.1 * jax.random.normal(next(ks), (DIFF_QK_DIM,), f32)
    d['l0_lam_q2'] = 0.1 * jax.random.normal(next(ks), (DIFF_QK_DIM,), f32)
    d['l0_lam_k2'] = 0.1 * jax.random.normal(next(ks), (DIFF_QK_DIM,), f32)
    d['l0_g_sub'] = gain(DIFF_V_DIM)
    d['l0_w_out'] = w((MIX0_W, D_MODEL))
    d['l0_g_post_mix'] = gain(D_MODEL)
    d['l0_g_pre_ffn'] = gain(D_MODEL)
    d['l0_w_ffn_in'] = w((D_MODEL, 2 * D_FF))
    d['l0_w_ffn_out'] = w((D_FF, D_MODEL))
    d['l0_g_post_ffn'] = gain(D_MODEL)
    d['l1_g_pre_mix'] = gain(D_MODEL)
    d['l1_w_down'] = w((D_MODEL, MLA_DOWN_W))
    d['l1_g_q'] = gain(MLA_Q_RANK)
    d['l1_g_kv'] = gain(MLA_KV_RANK)
    d['l1_w_uq'] = w((MLA_Q_RANK, MLA_HEADS * (MLA_NOPE + MLA_ROPE)))
    d['l1_w_ukv'] = w((MLA_KV_RANK, MLA_HEADS * (MLA_NOPE + MLA_V)))
    d['l1_w_out'] = w((MLA_HEADS * MLA_V, D_MODEL))
    d['l1_g_post_mix'] = gain(D_MODEL)
    d['l1_g_pre_ffn'] = gain(D_MODEL)
    d['l1_w_ffn_in'] = w((D_MODEL, 2 * D_FF))
    d['l1_w_ffn_out'] = w((D_FF, D_MODEL))
    d['l1_g_post_ffn'] = gain(D_MODEL)
    return d


def reference(x_prompt, x_sample,
              l0_g_pre_mix, l0_w_in, l0_rpb, l0_lam_q1, l0_lam_k1, l0_lam_q2, l0_lam_k2, l0_g_sub,
              l0_w_out, l0_g_post_mix, l0_g_pre_ffn, l0_w_ffn_in, l0_w_ffn_out, l0_g_post_ffn,
              l1_g_pre_mix, l1_w_down, l1_g_q, l1_g_kv, l1_w_uq, l1_w_ukv, l1_w_out, l1_g_post_mix,
              l1_g_pre_ffn, l1_w_ffn_in, l1_w_ffn_out, l1_g_post_ffn):
    p0 = dict(g_pre_mix=l0_g_pre_mix, w_in=l0_w_in, rpb=l0_rpb, lam_q1=l0_lam_q1, lam_k1=l0_lam_k1,
              lam_q2=l0_lam_q2, lam_k2=l0_lam_k2, g_sub=l0_g_sub, w_out=l0_w_out,
              g_post_mix=l0_g_post_mix, g_pre_ffn=l0_g_pre_ffn, w_ffn_in=l0_w_ffn_in,
              w_ffn_out=l0_w_ffn_out, g_post_ffn=l0_g_post_ffn)
    p1 = dict(g_pre_mix=l1_g_pre_mix, w_down=l1_w_down, g_q=l1_g_q, g_kv=l1_g_kv, w_uq=l1_w_uq,
              w_ukv=l1_w_ukv, w_out=l1_w_out, g_post_mix=l1_g_post_mix, g_pre_ffn=l1_g_pre_ffn,
              w_ffn_in=l1_w_ffn_in, w_ffn_out=l1_w_ffn_out, g_post_ffn=l1_g_post_ffn)
    y_prompt = trunk(x_prompt, p0, p1)
    y_sample = trunk(x_sample, p0, p1)
    return (y_prompt, y_sample)
```

```cpp
#include <hip/hip_runtime.h>
#include <hip/hip_cooperative_groups.h>
#include <stdint.h>
#include <cstdio>
namespace cg = cooperative_groups;

#ifndef MULTI_LAUNCH
#define MULTI_LAUNCH 1
#endif

typedef unsigned short u16;
typedef __attribute__((ext_vector_type(8))) short bf16x8;
typedef __attribute__((ext_vector_type(16))) float f32x16;
typedef __attribute__((ext_vector_type(4))) unsigned u32x4;

#define MFMA32(a, b, c) __builtin_amdgcn_mfma_f32_32x32x16_bf16((a), (b), (c), 0, 0, 0)
#define DI __device__ __forceinline__

constexpr int T_TOK = 81920;
constexpr int T_PROMPT = 65536;
constexpr int DM = 1024;
constexpr int DFF = 2816;
constexpr float EPS = 1e-6f;
constexpr float LOG2E = 1.4426950408889634f;
constexpr float QSCALE64 = 0.125f * LOG2E;
constexpr float QSCALE96 = 0.10206207261596577f * LOG2E;
constexpr int NPHASE = 17;

constexpr size_t MiB = (size_t)1 << 20;
constexpr size_t W0IN = 0;
constexpr size_t W0OUT = W0IN + (size_t)3072 * 1024;
constexpr size_t W0F1 = W0OUT + (size_t)1024 * 1024;
constexpr size_t W0F2 = W0F1 + (size_t)5632 * 1024;
constexpr size_t W1DN = W0F2 + (size_t)1024 * 2816;
constexpr size_t W1UQ = W1DN + (size_t)768 * 1024;
constexpr size_t W1UKV = W1UQ + (size_t)1536 * 384;
constexpr size_t W1OUT = W1UKV + (size_t)2048 * 256;
constexpr size_t W1F1 = W1OUT + (size_t)1024 * 1024;
constexpr size_t W1F2 = W1F1 + (size_t)5632 * 1024;
constexpr size_t W_END = W1F2 + (size_t)1024 * 2816;
static_assert(W_END * 2 <= 48 * MiB, "weights region");
constexpr size_t OFF_ROPE = 48 * MiB;
constexpr size_t OFF_RQ = OFF_ROPE + 2 * MiB;
constexpr size_t OFF_RKV = OFF_RQ + MiB / 2;
constexpr size_t OFF_KROPE = OFF_RKV + MiB / 2;
constexpr size_t OFF_SCAL = OFF_KROPE + 5 * MiB;
constexpr size_t OFF_R1 = 58 * MiB;
constexpr size_t OFF_R3 = OFF_R1 + 160 * MiB;
constexpr size_t OFF_R2 = OFF_R3 + 160 * MiB;
constexpr size_t WS_NEED = OFF_R2 + 560 * MiB;
constexpr size_t SEG512 = (size_t)T_TOK * 512;

struct Params {
  const float* in[28];
  float* out;
  char* ws;
};

DI u16 f2bf(float x) { unsigned u = __float_as_uint(x); u += 0x7fffu + ((u >> 16) & 1u); return (u16)(u >> 16); }
DI unsigned pack2(float a, float b) { return (unsigned)f2bf(a) | ((unsigned)f2bf(b) << 16); }
DI float bflo(unsigned v) { return __uint_as_float(v << 16); }
DI float bfhi(unsigned v) { return __uint_as_float(v & 0xffff0000u); }
DI float wave_sum(float v) {
#pragma unroll
  for (int o = 32; o; o >>= 1) v += __shfl_xor(v, o);
  return v;
}
DI int tok_pos(int t) { return t < T_PROMPT ? (t & 4095) : (t - T_PROMPT); }
DI float fexp2(float x) { return __builtin_amdgcn_exp2f(x); }

__device__ const float ROPE_INV[16] = {1.0f, 0.5623413324356079f, 0.3162277638912201f, 0.17782793939113617f, 0.10000000149011612f, 0.05623413249850273f, 0.03162277489900589f, 0.017782794311642647f, 0.009999999776482582f, 0.005623413249850273f, 0.003162277629598975f, 0.0017782794311642647f, 0.0010000000474974513f, 0.000562341301701963f, 0.0003162277571391314f, 0.00017782794020604342f};

DI void wconv(const float* __restrict__ W, const float* __restrict__ g, u16* __restrict__ dst, int K, int N, int rowsOut, int perm, int gtid, int gthreads) {
  const int kc = K >> 3;
  const long total = (long)rowsOut * kc;
  for (long c = gtid; c < total; c += gthreads) {
    const int n = (int)(c % rowsOut);
    const int k0 = (int)(c / rowsOut) * 8;
    int sc;
    if (perm == 1) { const int blk = n >> 6, w = n & 63; const int j = blk * 32 + (w & 31); sc = (w < 32) ? j : DFF + j; }
    else sc = n;
    uint4 o = make_uint4(0, 0, 0, 0);
    if (sc < N) {
      float v[8];
#pragma unroll
      for (int i = 0; i < 8; ++i) { float x = W[(size_t)(k0 + i) * N + sc]; if (g) x *= g[k0 + i]; v[i] = x; }
      o.x = pack2(v[0], v[1]); o.y = pack2(v[2], v[3]); o.z = pack2(v[4], v[5]); o.w = pack2(v[6], v[7]);
    }
    *(uint4*)(dst + (size_t)n * K + k0) = o;
  }
}

DI void phase_prep(const Params& p) {
  const int gtid = blockIdx.x * 256 + threadIdx.x, gthreads = gridDim.x * 256;
  u16* wb = (u16*)p.ws;
  wconv(p.in[3], p.in[2], wb + W0IN, 1024, 3072, 3072, 0, gtid, gthreads);
  wconv(p.in[10], nullptr, wb + W0OUT, 1024, 1024, 1024, 0, gtid, gthreads);
  wconv(p.in[13], p.in[12], wb + W0F1, 1024, 5632, 5632, 1, gtid, gthreads);
  wconv(p.in[14], nullptr, wb + W0F2, 2816, 1024, 1024, 0, gtid, gthreads);
  wconv(p.in[17], p.in[16], wb + W1DN, 1024, 672, 768, 0, gtid, gthreads);
  wconv(p.in[20], p.in[18], wb + W1UQ, 384, 1536, 1536, 0, gtid, gthreads);
  wconv(p.in[21], p.in[19], wb + W1UKV, 256, 2048, 2048, 0, gtid, gthreads);
  wconv(p.in[22], nullptr, wb + W1OUT, 1024, 1024, 1024, 0, gtid, gthreads);
  wconv(p.in[25], p.in[24], wb + W1F1, 1024, 5632, 5632, 1, gtid, gthreads);
  wconv(p.in[26], nullptr, wb + W1F2, 2816, 1024, 1024, 0, gtid, gthreads);
  float2* rope = (float2*)(p.ws + OFF_ROPE);
  for (int idx = gtid; idx < 16384 * 16; idx += gthreads) {
    const int pos = idx >> 4, i = idx & 15;
    const float ang = (float)pos * ROPE_INV[i];
    double rev = (double)ang * 0.15915494309189535;
    rev -= rint(rev);
    const float rf = (float)rev;
    rope[idx] = make_float2(__builtin_amdgcn_cosf(rf), __builtin_amdgcn_sinf(rf));
  }
  if (gtid == 0) {
    float s1 = 0.f, s2 = 0.f;
    for (int i = 0; i < 64; ++i) { s1 += p.in[5][i] * p.in[6][i]; s2 += p.in[7][i] * p.in[8][i]; }
    float* sc = (float*)(p.ws + OFF_SCAL);
    sc[0] = __expf(s1) - __expf(s2) + 0.2f;
  }
  const int lane = threadIdx.x & 63;
  const int gw = blockIdx.x * 4 + (threadIdx.x >> 6), nw = gridDim.x * 4;
  u16* hb = (u16*)(p.ws + OFF_R1);
  for (int row = gw; row < T_TOK; row += nw) {
    const float* xr = row < T_PROMPT ? p.in[0] + (size_t)row * DM : p.in[1] + (size_t)(row - T_PROMPT) * DM;
    float4 v[4];
    float ss = 0.f;
#pragma unroll
    for (int j = 0; j < 4; ++j) { v[j] = ((const float4*)xr)[lane + 64 * j]; ss += v[j].x * v[j].x + v[j].y * v[j].y + v[j].z * v[j].z + v[j].w * v[j].w; }
    ss = wave_sum(ss);
    const float r = rsqrtf(ss * (1.f / DM) + EPS);
#pragma unroll
    for (int j = 0; j < 4; ++j) {
      uint2 o; o.x = pack2(v[j].x * r, v[j].y * r); o.y = pack2(v[j].z * r, v[j].w * r);
      ((uint2*)(hb + (size_t)row * DM))[lane + 64 * j] = o;
    }
  }
}

template <bool FIRST, bool LAST>
DI void phase_res(const Params& p, const u16* __restrict__ mbuf, const float* __restrict__ g) {
  const int lane = threadIdx.x & 63;
  const int gw = blockIdx.x * 4 + (threadIdx.x >> 6), nw = gridDim.x * 4;
  u16* hb = (u16*)(p.ws + OFF_R1);
  float4 gv[4];
#pragma unroll
  for (int j = 0; j < 4; ++j) gv[j] = ((const float4*)g)[lane + 64 * j];
  for (int row = gw; row < T_TOK; row += nw) {
    const float* xr;
    if (FIRST) xr = row < T_PROMPT ? p.in[0] + (size_t)row * DM : p.in[1] + (size_t)(row - T_PROMPT) * DM;
    else xr = p.out + (size_t)row * DM;
    float4 xv[4], mv[4];
    float ss = 0.f;
#pragma unroll
    for (int j = 0; j < 4; ++j) {
      const uint2 u = ((const uint2*)(mbuf + (size_t)row * DM))[lane + 64 * j];
      mv[j] = make_float4(bflo(u.x), bfhi(u.x), bflo(u.y), bfhi(u.y));
      ss += mv[j].x * mv[j].x + mv[j].y * mv[j].y + mv[j].z * mv[j].z + mv[j].w * mv[j].w;
      xv[j] = ((const float4*)xr)[lane + 64 * j];
    }
    ss = wave_sum(ss);
    const float rm = rsqrtf(ss * (1.f / DM) + EPS);
    float s2 = 0.f;
#pragma unroll
    for (int j = 0; j < 4; ++j) {
      xv[j].x += mv[j].x * rm * gv[j].x; xv[j].y += mv[j].y * rm * gv[j].y;
      xv[j].z += mv[j].z * rm * gv[j].z; xv[j].w += mv[j].w * rm * gv[j].w;
      s2 += xv[j].x * xv[j].x + xv[j].y * xv[j].y + xv[j].z * xv[j].z + xv[j].w * xv[j].w;
      ((float4*)(p.out + (size_t)row * DM))[lane + 64 * j] = xv[j];
    }
    if (!LAST) {
      s2 = wave_sum(s2);
      const float r2 = rsqrtf(s2 * (1.f / DM) + EPS);
#pragma unroll
      for (int j = 0; j < 4; ++j) {
        uint2 o; o.x = pack2(xv[j].x * r2, xv[j].y * r2); o.y = pack2(xv[j].z * r2, xv[j].w * r2);
        ((uint2*)(hb + (size_t)row * DM))[lane + 64 * j] = o;
      }
    }
  }
}

DI void phase_mla_stats(const Params& p) {
  const int lane = threadIdx.x & 63;
  const int gw = blockIdx.x * 4 + (threadIdx.x >> 6), nw = gridDim.x * 4;
  const u16* c = (const u16*)(p.ws + OFF_R3);
  float* rq = (float*)(p.ws + OFF_RQ);
  float* rkv = (float*)(p.ws + OFF_RKV);
  u16* krope = (u16*)(p.ws + OFF_KROPE);
  const float2* rope = (const float2*)(p.ws + OFF_ROPE);
  for (int row = gw; row < T_TOK; row += nw) {
    const u16* cr = c + (size_t)row * 768;
    const uint4 u0 = ((const uint4*)cr)[lane];
    float s0 = 0.f;
    { float a;
      a = bflo(u0.x); s0 += a * a; a = bfhi(u0.x); s0 += a * a; a = bflo(u0.y); s0 += a * a; a = bfhi(u0.y); s0 += a * a;
      a = bflo(u0.z); s0 += a * a; a = bfhi(u0.z); s0 += a * a; a = bflo(u0.w); s0 += a * a; a = bfhi(u0.w); s0 += a * a; }
    float s1 = 0.f;
    if (lane < 16) {
      const uint4 u1 = ((const uint4*)cr)[64 + lane];
      float a;
      a = bflo(u1.x); s1 += a * a; a = bfhi(u1.x); s1 += a * a; a = bflo(u1.y); s1 += a * a; a = bfhi(u1.y); s1 += a * a;
      a = bflo(u1.z); s1 += a * a; a = bfhi(u1.z); s1 += a * a; a = bflo(u1.w); s1 += a * a; a = bfhi(u1.w); s1 += a * a;
    }
    const float sq = wave_sum(lane < 48 ? s0 : 0.f);
    const float skv = wave_sum((lane >= 48 ? s0 : 0.f) + s1);
    if (lane == 0) {
      rq[row] = rsqrtf(sq * (1.f / 384.f) + EPS);
      rkv[row] = rsqrtf(skv * (1.f / 256.f) + EPS);
    }
    if (lane < 16) {
      const float x1 = __uint_as_float((unsigned)cr[640 + lane] << 16);
      const float x2 = __uint_as_float((unsigned)cr[656 + lane] << 16);
      const float2 cs = rope[tok_pos(row) * 16 + lane];
      krope[(size_t)row * 32 + lane] = f2bf(x1 * cs.x - x2 * cs.y);
      krope[(size_t)row * 32 + 16 + lane] = f2bf(x2 * cs.x + x1 * cs.y);
    }
  }
}

DI void store_tok(u16* out, int ldo, int m, int nbase, const f32x16& v, float sc) {
  u16* q = out + (size_t)m * ldo + nbase;
#pragma unroll
  for (int g = 0; g < 4; ++g) {
    uint2 u; u.x = pack2(v[4 * g] * sc, v[4 * g + 1] * sc); u.y = pack2(v[4 * g + 2] * sc, v[4 * g + 3] * sc);
    *(uint2*)(q + 8 * g) = u;
  }
}
DI void store_tr(u16* outT, size_t ldt, int n, int mbase, const f32x16& v, const float* __restrict__ rs) {
  u16* q = outT + (size_t)n * ldt + mbase;
#pragma unroll
  for (int g = 0; g < 4; ++g) {
    float4 s = make_float4(1.f, 1.f, 1.f, 1.f);
    if (rs) s = *(const float4*)(rs + mbase + 8 * g);
    uint2 u; u.x = pack2(v[4 * g] * s.x, v[4 * g + 1] * s.y); u.y = pack2(v[4 * g + 2] * s.z, v[4 * g + 3] * s.w);
    *(uint2*)(q + 8 * g) = u;
  }
}

struct EpiTok {
  u16* out; int ldo;
  static constexpr int SWAPMODE = 1;
  DI bool swap(int) const { return true; }
  template <int WMB, int WNB>
  DI void store(int m0w, int n0w, f32x16 (&acc)[WMB][WNB], int r, int h, bool) const {
#pragma unroll
    for (int mb = 0; mb < WMB; ++mb)
#pragma unroll
      for (int nb = 0; nb < WNB; ++nb) store_tok(out, ldo, m0w + mb * 32 + r, n0w + nb * 32 + 4 * h, acc[mb][nb], 1.f);
  }
};

struct EpiProj0 {
  u16* base;
  static constexpr int SWAPMODE = 2;
  DI bool swap(int n0w) const { const int reg = n0w >> 9; return !(reg == 2 || reg == 5); }
  template <int WMB, int WNB>
  DI void store(int m0w, int n0w, f32x16 (&acc)[WMB][WNB], int r, int h, bool sw) const {
    const int reg = n0w >> 9, nl = n0w & 511;
    u16* buf = base + (size_t)reg * SEG512;
    if (sw) {
      const float sc = (reg == 0 || reg == 3) ? QSCALE64 : 1.f;
#pragma unroll
      for (int mb = 0; mb < WMB; ++mb)
#pragma unroll
        for (int nb = 0; nb < WNB; ++nb) store_tok(buf, 512, m0w + mb * 32 + r, nl + nb * 32 + 4 * h, acc[mb][nb], sc);
    } else {
#pragma unroll
      for (int mb = 0; mb < WMB; ++mb)
#pragma unroll
        for (int nb = 0; nb < WNB; ++nb) store_tr(buf, T_TOK, nl + nb * 32 + r, m0w + mb * 32 + 4 * h, acc[mb][nb], nullptr);
    }
  }
};

struct EpiSwiGLU {
  u16* act;
  static constexpr int SWAPMODE = 1;
  DI bool swap(int) const { return true; }
  template <int WMB, int WNB>
  DI void store(int m0w, int n0w, f32x16 (&acc)[WMB][WNB], int r, int h, bool) const {
    static_assert(WNB == 2, "swiglu epilogue needs a 64-wide wave tile");
#pragma unroll
    for (int mb = 0; mb < WMB; ++mb) {
      u16* q = act + (size_t)(m0w + mb * 32 + r) * DFF + (n0w >> 1) + 4 * h;
#pragma unroll
      for (int g = 0; g < 4; ++g) {
        float y[4];
#pragma unroll
        for (int e = 0; e < 4; ++e) {
          const float gt = acc[mb][0][4 * g + e], up = acc[mb][1][4 * g + e];
          y[e] = gt / (1.f + __expf(-gt)) * up;
        }
        uint2 u; u.x = pack2(y[0], y[1]); u.y = pack2(y[2], y[3]);
        *(uint2*)(q + 8 * g) = u;
      }
    }
  }
};

struct EpiUQ {
  u16* q; const float* rq; const float2* rope;
  static constexpr int SWAPMODE = 1;
  DI bool swap(int) const { return true; }
  template <int WMB, int WNB>
  DI void store(int m0w, int n0w, f32x16 (&acc)[WMB][WNB], int r, int h, bool) const {
#pragma unroll
    for (int mb = 0; mb < WMB; ++mb) {
      const int m = m0w + mb * 32 + r;
      const float sc = rq[m] * QSCALE96;
      const int pos = tok_pos(m);
#pragma unroll
      for (int nb = 0; nb < WNB; ++nb) {
        const int n0b = n0w + nb * 32;
        f32x16 v = acc[mb][nb];
#pragma unroll
        for (int i = 0; i < 16; ++i) v[i] *= sc;
        if (((n0b >> 5) % 3) == 2) {
#pragma unroll
          for (int i = 0; i < 8; ++i) {
            const int f = (i & 3) + 8 * (i >> 2) + 4 * h;
            const float2 cs = rope[pos * 16 + f];
            const float x1 = v[i], x2 = v[i + 8];
            v[i] = x1 * cs.x - x2 * cs.y;
            v[i + 8] = x2 * cs.x + x1 * cs.y;
          }
        }
        store_tok(q, 1536, m, n0b + 4 * h, v, 1.f);
      }
    }
  }
};

struct EpiUKV {
  u16* knope; u16* vt; const float* rkv;
  static constexpr int SWAPMODE = 2;
  DI bool swap(int n0w) const { return (n0w & 64) == 0; }
  template <int WMB, int WNB>
  DI void store(int m0w, int n0w, f32x16 (&acc)[WMB][WNB], int r, int h, bool sw) const {
    static_assert(WNB == 2, "ukv epilogue needs a 64-wide wave tile");
    const int head = n0w >> 7;
    if (sw) {
#pragma unroll
      for (int mb = 0; mb < WMB; ++mb) {
        const int m = m0w + mb * 32 + r;
        const float sc = rkv[m];
#pragma unroll
        for (int nb = 0; nb < WNB; ++nb) store_tok(knope, 1024, m, head * 64 + nb * 32 + 4 * h, acc[mb][nb], sc);
      }
    } else {
#pragma unroll
      for (int mb = 0; mb < WMB; ++mb)
#pragma unroll
        for (int nb = 0; nb < WNB; ++nb) store_tr(vt, T_TOK, head * 64 + nb * 32 + r, m0w + mb * 32 + 4 * h, acc[mb][nb], rkv);
    }
  }
};

template <bool SWAP, int WMB, int WNB>
DI void gemm_compute(const char* la, const char* lb, f32x16 (&acc)[WMB][WNB], int wm, int wn, int r, int h) {
#pragma unroll
  for (int ks = 0; ks < 4; ++ks) {
    bf16x8 af[WMB], bfr[WNB];
#pragma unroll
    for (int mb = 0; mb < WMB; ++mb) af[mb] = *(const bf16x8*)(la + (wm * 32 * WMB + mb * 32 + r) * 144 + (ks * 2 + h) * 16);
#pragma unroll
    for (int nb = 0; nb < WNB; ++nb) bfr[nb] = *(const bf16x8*)(lb + (wn * 32 * WNB + nb * 32 + r) * 144 + (ks * 2 + h) * 16);
#pragma unroll
    for (int mb = 0; mb < WMB; ++mb)
#pragma unroll
      for (int nb = 0; nb < WNB; ++nb) {
        if (SWAP) acc[mb][nb] = MFMA32(bfr[nb], af[mb], acc[mb][nb]);
        else acc[mb][nb] = MFMA32(af[mb], bfr[nb], acc[mb][nb]);
      }
  }
}

template <int WMB, int WNB, class Epi>
DI void gemm_phase(const u16* __restrict__ A, int lda, const u16* __restrict__ Bt, int ldb, int M, int N, int K, const Epi epi, char* lds, int bid, int nblk) {
  constexpr int TM = 64 * WMB, TN = 64 * WNB;
  constexpr int ACH = TM / 32, BCH = TN / 32;
  char* la = lds;
  char* lb = lds + TM * 144;
  const int tid = threadIdx.x, lane = tid & 63, w = tid >> 6, wm = w >> 1, wn = w & 1, r = lane & 31, h = lane >> 5;
  const int NT = N / TN, MT = M / TM, tiles = MT * NT, nk = K >> 6;
  const int lrow = tid >> 3, lch = tid & 7;
  for (int tile = bid; tile < tiles; tile += nblk) {
    const int mt = tile / NT, nt = tile - mt * NT;
    const int m0 = mt * TM, n0 = nt * TN;
    const u16* ag = A + (size_t)(m0 + lrow) * lda + lch * 8;
    const u16* bg = Bt + (size_t)(n0 + lrow) * ldb + lch * 8;
    u32x4 pa[ACH], pb[BCH];
#pragma unroll
    for (int j = 0; j < ACH; ++j) pa[j] = *(const u32x4*)(ag + (size_t)j * 32 * lda);
#pragma unroll
    for (int j = 0; j < BCH; ++j) pb[j] = *(const u32x4*)(bg + (size_t)j * 32 * ldb);
    f32x16 acc[WMB][WNB];
#pragma unroll
    for (int mb = 0; mb < WMB; ++mb)
#pragma unroll
      for (int nb = 0; nb < WNB; ++nb)
#pragma unroll
        for (int i = 0; i < 16; ++i) acc[mb][nb][i] = 0.f;
    const bool sw = epi.swap(n0 + wn * 32 * WNB);
    for (int kt = 0; kt < nk; ++kt) {
      __syncthreads();
#pragma unroll
      for (int j = 0; j < ACH; ++j) *(u32x4*)(la + (lrow + 32 * j) * 144 + lch * 16) = pa[j];
#pragma unroll
      for (int j = 0; j < BCH; ++j) *(u32x4*)(lb + (lrow + 32 * j) * 144 + lch * 16) = pb[j];
      __syncthreads();
      if (kt + 1 < nk) {
#pragma unroll
        for (int j = 0; j < ACH; ++j) pa[j] = *(const u32x4*)(ag + (size_t)j * 32 * lda + (kt + 1) * 64);
#pragma unroll
        for (int j = 0; j < BCH; ++j) pb[j] = *(const u32x4*)(bg + (size_t)j * 32 * ldb + (kt + 1) * 64);
      }
      if (Epi::SWAPMODE == 1) gemm_compute<true, WMB, WNB>(la, lb, acc, wm, wn, r, h);
      else if (Epi::SWAPMODE == 0) gemm_compute<false, WMB, WNB>(la, lb, acc, wm, wn, r, h);
      else { if (sw) gemm_compute<true, WMB, WNB>(la, lb, acc, wm, wn, r, h); else gemm_compute<false, WMB, WNB>(la, lb, acc, wm, wn, r, h); }
    }
    epi.template store<WMB, WNB>(m0 + wm * 32 * WMB, n0 + wn * 32 * WNB, acc, r, h, sw);
  }
}

constexpr int MODE_NA = 0, MODE_DIFF = 1, MODE_MLA = 2;

template <int MODE, int DQK, int DV>
DI void attn_tile(const char* kl, const char* vl, const bf16x8 (&qf)[DQK / 16], f32x16 (&o)[DV / 32], float& m, float& l, int r, int h,
                  int qa, int ka, float fa, const float* tab) {
  constexpr int KS = DQK * 2 + 16;
  f32x16 s[2];
#pragma unroll
  for (int kb = 0; kb < 2; ++kb) {
#pragma unroll
    for (int i = 0; i < 16; ++i) s[kb][i] = 0.f;
#pragma unroll
    for (int ks = 0; ks < DQK / 16; ++ks) {
      const bf16x8 a = *(const bf16x8*)(kl + (32 * kb + r) * KS + (2 * ks + h) * 16);
      s[kb] = MFMA32(a, qf[ks], s[kb]);
    }
  }
  if (MODE == MODE_DIFF) {
#pragma unroll
    for (int kb = 0; kb < 2; ++kb)
#pragma unroll
      for (int i = 0; i < 16; ++i) {
        const int kp = ka + 32 * kb + (i & 3) + 8 * (i >> 2) + 4 * h;
        s[kb][i] -= fa * fabsf((float)(qa - kp));
      }
  } else if (MODE == MODE_NA) {
    const int wc0 = min(max(qa - 8, 0), 48);
#pragma unroll
    for (int kb = 0; kb < 2; ++kb)
#pragma unroll
      for (int i = 0; i < 16; ++i) {
        const int kc = 32 * kb + (i & 3) + 8 * (i >> 2) + 4 * h;
        const bool ok = (unsigned)(kc - wc0) < 16u;
        const int ci = min(max(kc - qa + 15, 0), 30);
        const float b = tab[ka * 31 + ci];
        s[kb][i] = ok ? s[kb][i] + b : -INFINITY;
      }
  }
  float mx = s[0][0];
#pragma unroll
  for (int kb = 0; kb < 2; ++kb)
#pragma unroll
    for (int i = 0; i < 16; ++i) mx = fmaxf(mx, s[kb][i]);
  mx = fmaxf(mx, __shfl_xor(mx, 32));
  const float mnew = fmaxf(m, mx);
  const float alpha = fexp2(m - mnew);
  m = mnew;
  float ps = 0.f;
#pragma unroll
  for (int kb = 0; kb < 2; ++kb)
#pragma unroll
    for (int i = 0; i < 16; ++i) { const float e = fexp2(s[kb][i] - mnew); s[kb][i] = e; ps += e; }
  l = l * alpha + ps;
#pragma unroll
  for (int d = 0; d < DV / 32; ++d)
#pragma unroll
    for (int i = 0; i < 16; ++i) o[d][i] *= alpha;
  bf16x8 pf[2][2];
#pragma unroll
  for (int kb = 0; kb < 2; ++kb)
#pragma unroll
    for (int st = 0; st < 2; ++st) {
      uint4 u;
      u.x = pack2(s[kb][8 * st + 0], s[kb][8 * st + 1]); u.y = pack2(s[kb][8 * st + 2], s[kb][8 * st + 3]);
      u.z = pack2(s[kb][8 * st + 4], s[kb][8 * st + 5]); u.w = pack2(s[kb][8 * st + 6], s[kb][8 * st + 7]);
      pf[kb][st] = __builtin_bit_cast(bf16x8, u);
    }
#pragma unroll
  for (int d = 0; d < DV / 32; ++d)
#pragma unroll
    for (int kb = 0; kb < 2; ++kb)
#pragma unroll
      for (int st = 0; st < 2; ++st) {
        const char* vp = vl + (32 * d + r) * 136 + (32 * kb + 16 * st + 4 * h) * 2;
        const uint2 lo = *(const uint2*)vp;
        const uint2 hi = *(const uint2*)(vp + 16);
        const uint4 u = make_uint4(lo.x, lo.y, hi.x, hi.y);
        o[d] = MFMA32(__builtin_bit_cast(bf16x8, u), pf[kb][st], o[d]);
      }
}

typedef __attribute__((ext_vector_type(2))) unsigned u32x2;
DI void lds_st16_as2x8(char* dst, const u32x4 v) {
  u32x2 a; a.x = v.x; a.y = v.y; u32x2 b; b.x = v.z; b.y = v.w;
  *(u32x2*)dst = a;
  *(u32x2*)(dst + 8) = b;
}

DI void attn_mla_item(const Params& p, int item, char* lds) {
  constexpr int DQK = 96, DV = 64, KS = DQK * 2 + 16;
  const int tid = threadIdx.x, lane = tid & 63, w = tid >> 6, r = lane & 31, h = lane >> 5;
  int head, qb, ts0, S;
  if (item < 2048) { head = item >> 7; qb = item & 127; ts0 = T_PROMPT; S = 16384; }
  else { const int it = item - 2048; qb = it & 31; head = (it >> 5) & 15; ts0 = (it >> 9) * 4096; S = 4096; }
  const u16* q = (const u16*)(p.ws + OFF_R2);
  const u16* knope = q + (size_t)T_TOK * 1536;
  const u16* vt = knope + (size_t)T_TOK * 1024;
  const u16* krope = (const u16*)(p.ws + OFF_KROPE);
  u16* o1 = (u16*)(p.ws + OFF_R1);
  char* kl = lds;
  char* vl = lds + 64 * KS;
  const int tq = ts0 + qb * 128 + w * 32 + r;
  bf16x8 qf[DQK / 16];
#pragma unroll
  for (int ks = 0; ks < DQK / 16; ++ks) qf[ks] = *(const bf16x8*)(q + (size_t)tq * 1536 + head * 96 + 16 * ks + 8 * h);
  f32x16 o[DV / 32];
#pragma unroll
  for (int d = 0; d < DV / 32; ++d)
#pragma unroll
    for (int i = 0; i < 16; ++i) o[d][i] = 0.f;
  float m = -INFINITY, l = 0.f;
  u32x4 pk[3], pv[2];
  int krow[3], kch[3];
#pragma unroll
  for (int j = 0; j < 3; ++j) { const int c = tid + 256 * j; krow[j] = c / 12; kch[j] = c - krow[j] * 12; }
  const int vrow = tid >> 3, vch = tid & 7;
  const int nkt = S >> 6;
  auto prefetch = [&](int kt) {
    const int tk0 = ts0 + kt * 64;
#pragma unroll
    for (int j = 0; j < 3; ++j) {
      const u16* src = kch[j] < 8 ? knope + (size_t)(tk0 + krow[j]) * 1024 + head * 64 + kch[j] * 8
                                  : krope + (size_t)(tk0 + krow[j]) * 32 + (kch[j] - 8) * 8;
      pk[j] = *(const u32x4*)src;
    }
#pragma unroll
    for (int j = 0; j < 2; ++j) pv[j] = *(const u32x4*)(vt + (size_t)(head * 64 + vrow + 32 * j) * T_TOK + tk0 + vch * 8);
  };
  prefetch(0);
  for (int kt = 0; kt < nkt; ++kt) {
    __syncthreads();
#pragma unroll
    for (int j = 0; j < 3; ++j) *(u32x4*)(kl + krow[j] * KS + kch[j] * 16) = pk[j];
#pragma unroll
    for (int j = 0; j < 2; ++j) lds_st16_as2x8(vl + (vrow + 32 * j) * 136 + vch * 16, pv[j]);
    __syncthreads();
    if (kt + 1 < nkt) prefetch(kt + 1);
    attn_tile<MODE_MLA, DQK, DV>(kl, vl, qf, o, m, l, r, h, 0, 0, 0.f, nullptr);
  }
  l += __shfl_xor(l, 32);
  const float inv = 1.f / l;
#pragma unroll
  for (int d = 0; d < DV / 32; ++d) store_tok(o1, 1024, tq, head * 64 + 32 * d + 4 * h, o[d], inv);
}

DI void attn_diff_item(const Params& p, int item, char* lds) {
  constexpr int DQK = 64, DV = 128, KS = DQK * 2 + 16;
  const int tid = threadIdx.x, lane = tid & 63, w = tid >> 6, r = lane & 31, h = lane >> 5;
  const int map = w >> 1, qh = w & 1;
  int hh, qb, ts0, S;
  if (item < 1024) { hh = item >> 8; qb = item & 255; ts0 = T_PROMPT; S = 16384; }
  else { const int it = item - 1024; qb = it & 63; hh = (it >> 6) & 3; ts0 = (it >> 8) * 4096; S = 4096; }
  const u16* base = (const u16*)(p.ws + OFF_R2);
  const u16* dq = base + 3 * SEG512;
  const u16* dk = base + 4 * SEG512;
  const u16* vtd = base + 5 * SEG512;
  u16* o0 = (u16*)(p.ws + OFF_R1);
  char* kl0 = lds;
  char* vl = lds + 2 * 64 * KS;
  const int qpos = qb * 64 + qh * 32 + r;
  const int tq = ts0 + qpos;
  bf16x8 qf[DQK / 16];
#pragma unroll
  for (int ks = 0; ks < DQK / 16; ++ks) qf[ks] = *(const bf16x8*)(dq + (size_t)tq * 512 + (2 * hh + map) * 64 + 16 * ks + 8 * h);
  f32x16 o[DV / 32];
#pragma unroll
  for (int d = 0; d < DV / 32; ++d)
#pragma unroll
    for (int i = 0; i < 16; ++i) o[d][i] = 0.f;
  float m = -INFINITY, l = 0.f;
  const float slope2 = exp2f(-2.f * (float)(hh + 1)) * LOG2E;
  u32x4 pk[4], pv[4];
  const int lrow = tid >> 3, lch = tid & 7;
  const int nkt = S >> 6;
  auto prefetch = [&](int kt) {
    const int tk0 = ts0 + kt * 64;
#pragma unroll
    for (int j = 0; j < 4; ++j) {
      const int row = lrow + 32 * (j & 1), which = j >> 1;
      pk[j] = *(const u32x4*)(dk + (size_t)(tk0 + row) * 512 + (2 * hh + which) * 64 + lch * 8);
    }
#pragma unroll
    for (int j = 0; j < 4; ++j) pv[j] = *(const u32x4*)(vtd + (size_t)(hh * 128 + lrow + 32 * j) * T_TOK + tk0 + lch * 8);
  };
  prefetch(0);
  for (int kt = 0; kt < nkt; ++kt) {
    __syncthreads();
#pragma unroll
    for (int j = 0; j < 4; ++j) *(u32x4*)(kl0 + (j >> 1) * 64 * KS + (lrow + 32 * (j & 1)) * KS + lch * 16) = pk[j];
#pragma unroll
    for (int j = 0; j < 4; ++j) lds_st16_as2x8(vl + (lrow + 32 * j) * 136 + lch * 16, pv[j]);
    __syncthreads();
    if (kt + 1 < nkt) prefetch(kt + 1);
    attn_tile<MODE_DIFF, DQK, DV>(kl0 + map * 64 * KS, vl, qf, o, m, l, r, h, qpos, kt * 64, slope2, nullptr);
  }
  l += __shfl_xor(l, 32);
  const float inv = 1.f / l;
  __syncthreads();
  float* ex = (float*)lds + qh * 4096;
  if (map == 1) {
#pragma unroll
    for (int d = 0; d < DV / 32; ++d)
#pragma unroll
      for (int i = 0; i < 16; ++i) ex[(d * 16 + i) * 64 + lane] = o[d][i] * inv;
  }
  __syncthreads();
  if (map == 0) {
    const float lam = ((const float*)(p.ws + OFF_SCAL))[0];
    float ss = 0.f;
#pragma unroll
    for (int d = 0; d < DV / 32; ++d)
#pragma unroll
      for (int i = 0; i < 16; ++i) { const float v = o[d][i] * inv - lam * ex[(d * 16 + i) * 64 + lane]; o[d][i] = v; ss += v * v; }
    ss += __shfl_xor(ss, 32);
    const float rn = rsqrtf(ss * (1.f / 128.f) + EPS) * 0.8f;
    const float* gs = p.in[9];
#pragma unroll
    for (int d = 0; d < DV / 32; ++d) {
#pragma unroll
      for (int g = 0; g < 4; ++g) {
        const float4 gv = *(const float4*)(gs + 32 * d + 8 * g + 4 * h);
        o[d][4 * g] *= gv.x; o[d][4 * g + 1] *= gv.y; o[d][4 * g + 2] *= gv.z; o[d][4 * g + 3] *= gv.w;
      }
      store_tok(o0, 1024, tq, 512 + hh * 128 + 32 * d + 4 * h, o[d], rn);
    }
  }
}

DI void attn_na_item(const Params& p, int item, char* lds) {
  constexpr int DQK = 64, DV = 64, KS = DQK * 2 + 16;
  const int tid = threadIdx.x, lane = tid & 63, w = tid >> 6, r = lane & 31, h = lane >> 5;
  const int pair = item % 640, head = item / 640;
  const int t0 = pair * 128;
  int ts0, rows;
  if (t0 < T_PROMPT) { ts0 = t0 & ~4095; rows = 64; } else { ts0 = T_PROMPT; rows = 256; }
  const int r0 = (t0 - ts0) >> 6;
  const int rw = r0 + (w >> 1);
  const int rs_lo = min(max(r0 - 4, 0), rows - 8);
  const int rs_hi = min(max(r0 + 1 - 4, 0), rows - 8);
  const int rs_w = min(max(rw - 4, 0), rows - 8);
  const int ntile = rs_hi + 8 - rs_lo;
  const u16* base = (const u16*)(p.ws + OFF_R2);
  const u16* qn = base;
  const u16* kn = base + SEG512;
  const u16* vtn = base + 2 * SEG512;
  u16* o0 = (u16*)(p.ws + OFF_R1);
  char* kl = lds;
  char* vl = lds + 64 * KS;
  float* tab = (float*)(lds + 64 * KS + 64 * 136);
  const int qc = (w & 1) * 32 + r;
  const int tq = t0 + w * 32 + r;
  bf16x8 qf[DQK / 16];
#pragma unroll
  for (int ks = 0; ks < DQK / 16; ++ks) qf[ks] = *(const bf16x8*)(qn + (size_t)tq * 512 + head * 64 + 16 * ks + 8 * h);
  f32x16 o[DV / 32];
#pragma unroll
  for (int d = 0; d < DV / 32; ++d)
#pragma unroll
    for (int i = 0; i < 16; ++i) o[d][i] = 0.f;
  float m = -INFINITY, l = 0.f;
  __syncthreads();
  for (int i = tid; i < 465; i += 256) tab[i] = p.in[4][head * 465 + i] * LOG2E;
  u32x4 pk[2], pv[2];
  const int lrow = tid >> 3, lch = tid & 7;
  auto prefetch = [&](int j) {
    const int tk0 = ts0 + (rs_lo + j) * 64;
#pragma unroll
    for (int jj = 0; jj < 2; ++jj) pk[jj] = *(const u32x4*)(kn + (size_t)(tk0 + lrow + 32 * jj) * 512 + head * 64 + lch * 8);
#pragma unroll
    for (int jj = 0; jj < 2; ++jj) pv[jj] = *(const u32x4*)(vtn + (size_t)(head * 64 + lrow + 32 * jj) * T_TOK + tk0 + lch * 8);
  };
  prefetch(0);
  for (int j = 0; j < ntile; ++j) {
    __syncthreads();
#pragma unroll
    for (int jj = 0; jj < 2; ++jj) *(u32x4*)(kl + (lrow + 32 * jj) * KS + lch * 16) = pk[jj];
#pragma unroll
    for (int jj = 0; jj < 2; ++jj) lds_st16_as2x8(vl + (lrow + 32 * jj) * 136 + lch * 16, pv[jj]);
    __syncthreads();
    if (j + 1 < ntile) prefetch(j + 1);
    const int kr = rs_lo + j;
    if (kr >= rs_w && kr < rs_w + 8)
      attn_tile<MODE_NA, DQK, DV>(kl, vl, qf, o, m, l, r, h, qc, kr - rw + 7, 0.f, tab);
  }
  l += __shfl_xor(l, 32);
  const float inv = 1.f / l;
#pragma unroll
  for (int d = 0; d < DV / 32; ++d) store_tok(o0, 1024, tq, head * 64 + 32 * d + 4 * h, o[d], inv);
}

template <int PH>
DI void run_phase(const Params& p, char* lds) {
  const int bid = blockIdx.x, nblk = gridDim.x;
  u16* wb = (u16*)p.ws;
  u16* R1 = (u16*)(p.ws + OFF_R1);
  u16* R2 = (u16*)(p.ws + OFF_R2);
  u16* R3 = (u16*)(p.ws + OFF_R3);
  if constexpr (PH == 0) phase_prep(p);
  else if constexpr (PH == 1) gemm_phase<2, 2>(R1, 1024, wb + W0IN, 1024, T_TOK, 3072, 1024, EpiProj0{R2}, lds, bid, nblk);
  else if constexpr (PH == 2) {
    for (int it = bid; it < 10240; it += nblk) {
      if (it < 5120) attn_diff_item(p, it, lds);
      else attn_na_item(p, it - 5120, lds);
    }
  }
  else if constexpr (PH == 3) gemm_phase<2, 2>(R1, 1024, wb + W0OUT, 1024, T_TOK, 1024, 1024, EpiTok{R3, 1024}, lds, bid, nblk);
  else if constexpr (PH == 4) phase_res<true, false>(p, R3, p.in[11]);
  else if constexpr (PH == 5) gemm_phase<2, 2>(R1, 1024, wb + W0F1, 1024, T_TOK, 5632, 1024, EpiSwiGLU{R2}, lds, bid, nblk);
  else if constexpr (PH == 6) gemm_phase<2, 2>(R2, 2816, wb + W0F2, 2816, T_TOK, 1024, 2816, EpiTok{R3, 1024}, lds, bid, nblk);
  else if constexpr (PH == 7) phase_res<false, false>(p, R3, p.in[15]);
  else if constexpr (PH == 8) gemm_phase<2, 2>(R1, 1024, wb + W1DN, 1024, T_TOK, 768, 1024, EpiTok{R3, 768}, lds, bid, nblk);
  else if constexpr (PH == 9) phase_mla_stats(p);
  else if constexpr (PH == 10) {
    gemm_phase<2, 2>(R3, 768, wb + W1UQ, 384, T_TOK, 1536, 384,
                     EpiUQ{R2, (const float*)(p.ws + OFF_RQ), (const float2*)(p.ws + OFF_ROPE)}, lds, bid, nblk);
    gemm_phase<2, 2>(R3 + 384, 768, wb + W1UKV, 256, T_TOK, 2048, 256,
                     EpiUKV{R2 + (size_t)T_TOK * 1536, R2 + (size_t)T_TOK * 2560, (const float*)(p.ws + OFF_RKV)}, lds, bid, nblk);
  }
  else if constexpr (PH == 11) { for (int it = bid; it < 10240; it += nblk) attn_mla_item(p, it, lds); }
  else if constexpr (PH == 12) gemm_phase<2, 2>(R1, 1024, wb + W1OUT, 1024, T_TOK, 1024, 1024, EpiTok{R3, 1024}, lds, bid, nblk);
  else if constexpr (PH == 13) phase_res<false, false>(p, R3, p.in[23]);
  else if constexpr (PH == 14) gemm_phase<2, 2>(R1, 1024, wb + W1F1, 1024, T_TOK, 5632, 1024, EpiSwiGLU{R2}, lds, bid, nblk);
  else if constexpr (PH == 15) gemm_phase<2, 2>(R2, 2816, wb + W1F2, 2816, T_TOK, 1024, 2816, EpiTok{R3, 1024}, lds, bid, nblk);
  else if constexpr (PH == 16) phase_res<false, true>(p, R3, p.in[27]);
}

#if MULTI_LAUNCH
template <int PH>
__global__ void __launch_bounds__(256, 2) k_phase(Params p) {
  __shared__ __attribute__((aligned(16))) char lds[36864];
  run_phase<PH>(p, lds);
}
template <int PH>
static void launch_all(const Params& p, int grid, hipStream_t stream) {
  hipLaunchKernelGGL(k_phase<PH>, dim3(grid), dim3(256), 0, stream, p);
  if constexpr (PH + 1 < NPHASE) launch_all<PH + 1>(p, grid, stream);
}
#define OCC_KERNEL k_phase<2>
#else
template <int PH>
DI void run_from(const Params& p, char* lds) {
  run_phase<PH>(p, lds);
  if constexpr (PH + 1 < NPHASE) { cg::this_grid().sync(); run_from<PH + 1>(p, lds); }
}
__global__ void __launch_bounds__(256, 2) mega(Params p) {
  __shared__ __attribute__((aligned(16))) char lds[36864];
  run_from<0>(p, lds);
}
#define OCC_KERNEL mega
#endif

extern "C" void kernel_launch(void* const* d_in, const int* in_sizes, int n_in, void* d_out, int out_size, void* d_ws, size_t ws_size,
                              hipStream_t stream) {
  static int grid = 0;
  if (grid == 0) {
    if (n_in != 28 || ws_size < WS_NEED) { fprintf(stderr, "kernel_launch: unexpected n_in %d / ws_size %zu (need %zu)\n", n_in, ws_size, (size_t)WS_NEED); grid = -1; return; }
    int dev = 0, cus = 0, per_cu = 0;
    (void)hipGetDevice(&dev);
    (void)hipDeviceGetAttribute(&cus, hipDeviceAttributeMultiprocessorCount, dev);
    (void)hipOccupancyMaxActiveBlocksPerMultiprocessor(&per_cu, (const void*)OCC_KERNEL, 256, 0);
    if (per_cu < 1) per_cu = 1;
    if (per_cu > 2) per_cu = 2;
    grid = cus * per_cu;
  }
  if (grid < 0) return;
  Params p{};
  for (int i = 0; i < 28; ++i) p.in[i] = (const float*)d_in[i];
  p.out = (float*)d_out;
  p.ws = (char*)d_ws;
#if MULTI_LAUNCH
  launch_all<0>(p, grid, stream);
#else
  void* args[] = {&p};
  hipError_t e = hipLaunchCooperativeKernel((const void*)mega, dim3(grid), dim3(256), args, 0, stream);
  if (e != hipSuccess) fprintf(stderr, "cooperative launch failed: %s (grid %d)\n", hipGetErrorString(e), grid);
#endif
}
```

```cpp
#include <hip/hip_runtime.h>
#include <hip/hip_cooperative_groups.h>
#include <stdint.h>
#include <cstdio>
namespace cg = cooperative_groups;

#ifndef MULTI_LAUNCH
#define MULTI_LAUNCH 0
#endif

typedef unsigned short u16;
typedef __attribute__((ext_vector_type(8))) short bf16x8;
typedef __attribute__((ext_vector_type(16))) float f32x16;
typedef __attribute__((ext_vector_type(4))) unsigned u32x4;

#define MFMA32(a, b, c) __builtin_amdgcn_mfma_f32_32x32x16_bf16((a), (b), (c), 0, 0, 0)
#define DI __device__ __forceinline__

constexpr int T_TOK = 81920;
constexpr int T_PROMPT = 65536;
constexpr int DM = 1024;
constexpr int DFF = 2816;
constexpr float EPS = 1e-6f;
constexpr float LOG2E = 1.4426950408889634f;
constexpr float QSCALE64 = 0.125f * LOG2E;
constexpr float QSCALE96 = 0.10206207261596577f * LOG2E;
constexpr int NPHASE = 17;

constexpr size_t MiB = (size_t)1 << 20;
constexpr size_t W0IN = 0;
constexpr size_t W0OUT = W0IN + (size_t)3072 * 1024;
constexpr size_t W0F1 = W0OUT + (size_t)1024 * 1024;
constexpr size_t W0F2 = W0F1 + (size_t)5632 * 1024;
constexpr size_t W1DN = W0F2 + (size_t)1024 * 2816;
constexpr size_t W1UQ = W1DN + (size_t)768 * 1024;
constexpr size_t W1UKV = W1UQ + (size_t)1536 * 384;
constexpr size_t W1OUT = W1UKV + (size_t)2048 * 256;
constexpr size_t W1F1 = W1OUT + (size_t)1024 * 1024;
constexpr size_t W1F2 = W1F1 + (size_t)5632 * 1024;
constexpr size_t W_END = W1F2 + (size_t)1024 * 2816;
static_assert(W_END * 2 <= 48 * MiB, "weights region");
constexpr size_t OFF_ROPE = 48 * MiB;
constexpr size_t OFF_RQ = OFF_ROPE + 2 * MiB;
constexpr size_t OFF_RKV = OFF_RQ + MiB / 2;
constexpr size_t OFF_KROPE = OFF_RKV + MiB / 2;
constexpr size_t OFF_SCAL = OFF_KROPE + 5 * MiB;
constexpr size_t OFF_R1 = 58 * MiB;
constexpr size_t OFF_R3 = OFF_R1 + 160 * MiB;
constexpr size_t OFF_R2 = OFF_R3 + 160 * MiB;
constexpr size_t WS_NEED = OFF_R2 + 560 * MiB;
constexpr size_t SEG512 = (size_t)T_TOK * 512;

struct Params {
  const float* in[28];
  float* out;
  char* ws;
};

DI u16 f2bf(float x) { unsigned u = __float_as_uint(x); u += 0x7fffu + ((u >> 16) & 1u); return (u16)(u >> 16); }
DI unsigned pack2(float a, float b) { return (unsigned)f2bf(a) | ((unsigned)f2bf(b) << 16); }
DI float bflo(unsigned v) { return __uint_as_float(v << 16); }
DI float bfhi(unsigned v) { return __uint_as_float(v & 0xffff0000u); }
DI float wave_sum(float v) {
#pragma unroll
  for (int o = 32; o; o >>= 1) v += __shfl_xor(v, o);
  return v;
}
DI int tok_pos(int t) { return t < T_PROMPT ? (t & 4095) : (t - T_PROMPT); }
DI float fexp2(float x) { return __builtin_amdgcn_exp2f(x); }

__device__ const float ROPE_INV[16] = {1.0f, 0.5623413324356079f, 0.3162277638912201f, 0.17782793939113617f, 0.10000000149011612f, 0.05623413249850273f, 0.03162277489900589f, 0.017782794311642647f, 0.009999999776482582f, 0.005623413249850273f, 0.003162277629598975f, 0.0017782794311642647f, 0.0010000000474974513f, 0.000562341301701963f, 0.0003162277571391314f, 0.00017782794020604342f};

DI void wconv(const float* __restrict__ W, const float* __restrict__ g, u16* __restrict__ dst, int K, int N, int rowsOut, int perm, int gtid, int gthreads) {
  const int kc = K >> 3;
  const long total = (long)rowsOut * kc;
  for (long c = gtid; c < total; c += gthreads) {
    const int n = (int)(c % rowsOut);
    const int k0 = (int)(c / rowsOut) * 8;
    int sc;
    if (perm == 1) { const int blk = n >> 6, w = n & 63; const int j = blk * 32 + (w & 31); sc = (w < 32) ? j : DFF + j; }
    else sc = n;
    uint4 o = make_uint4(0, 0, 0, 0);
    if (sc < N) {
      float v[8];
#pragma unroll
      for (int i = 0; i < 8; ++i) { float x = W[(size_t)(k0 + i) * N + sc]; if (g) x *= g[k0 + i]; v[i] = x; }
      o.x = pack2(v[0], v[1]); o.y = pack2(v[2], v[3]); o.z = pack2(v[4], v[5]); o.w = pack2(v[6], v[7]);
    }
    *(uint4*)(dst + (size_t)n * K + k0) = o;
  }
}

DI void phase_prep(const Params& p) {
  const int gtid = blockIdx.x * 256 + threadIdx.x, gthreads = gridDim.x * 256;
  u16* wb = (u16*)p.ws;
  wconv(p.in[3], p.in[2], wb + W0IN, 1024, 3072, 3072, 0, gtid, gthreads);
  wconv(p.in[10], nullptr, wb + W0OUT, 1024, 1024, 1024, 0, gtid, gthreads);
  wconv(p.in[13], p.in[12], wb + W0F1, 1024, 5632, 5632, 1, gtid, gthreads);
  wconv(p.in[14], nullptr, wb + W0F2, 2816, 1024, 1024, 0, gtid, gthreads);
  wconv(p.in[17], p.in[16], wb + W1DN, 1024, 672, 768, 0, gtid, gthreads);
  wconv(p.in[20], p.in[18], wb + W1UQ, 384, 1536, 1536, 0, gtid, gthreads);
  wconv(p.in[21], p.in[19], wb + W1UKV, 256, 2048, 2048, 0, gtid, gthreads);
  wconv(p.in[22], nullptr, wb + W1OUT, 1024, 1024, 1024, 0, gtid, gthreads);
  wconv(p.in[25], p.in[24], wb + W1F1, 1024, 5632, 5632, 1, gtid, gthreads);
  wconv(p.in[26], nullptr, wb + W1F2, 2816, 1024, 1024, 0, gtid, gthreads);
  float2* rope = (float2*)(p.ws + OFF_ROPE);
  for (int idx = gtid; idx < 16384 * 16; idx += gthreads) {
    const int pos = idx >> 4, i = idx & 15;
    const float ang = (float)pos * ROPE_INV[i];
    double rev = (double)ang * 0.15915494309189535;
    rev -= rint(rev);
    const float rf = (float)rev;
    rope[idx] = make_float2(__builtin_amdgcn_cosf(rf), __builtin_amdgcn_sinf(rf));
  }
  if (gtid == 0) {
    float s1 = 0.f, s2 = 0.f;
    for (int i = 0; i < 64; ++i) { s1 += p.in[5][i] * p.in[6][i]; s2 += p.in[7][i] * p.in[8][i]; }
    float* sc = (float*)(p.ws + OFF_SCAL);
    sc[0] = __expf(s1) - __expf(s2) + 0.2f;
  }
  const int lane = threadIdx.x & 63;
  const int gw = blockIdx.x * 4 + (threadIdx.x >> 6), nw = gridDim.x * 4;
  u16* hb = (u16*)(p.ws + OFF_R1);
  for (int row = gw; row < T_TOK; row += nw) {
    const float* xr = row < T_PROMPT ? p.in[0] + (size_t)row * DM : p.in[1] + (size_t)(row - T_PROMPT) * DM;
    float4 v[4];
    float ss = 0.f;
#pragma unroll
    for (int j = 0; j < 4; ++j) { v[j] = ((const float4*)xr)[lane + 64 * j]; ss += v[j].x * v[j].x + v[j].y * v[j].y + v[j].z * v[j].z + v[j].w * v[j].w; }
    ss = wave_sum(ss);
    const float r = rsqrtf(ss * (1.f / DM) + EPS);
#pragma unroll
    for (int j = 0; j < 4; ++j) {
      uint2 o; o.x = pack2(v[j].x * r, v[j].y * r); o.y = pack2(v[j].z * r, v[j].w * r);
      ((uint2*)(hb + (size_t)row * DM))[lane + 64 * j] = o;
    }
  }
}

template <bool FIRST, bool LAST>
DI void phase_res(const Params& p, const u16* __restrict__ mbuf, const float* __restrict__ g) {
  const int lane = threadIdx.x & 63;
  const int gw = blockIdx.x * 4 + (threadIdx.x >> 6), nw = gridDim.x * 4;
  u16* hb = (u16*)(p.ws + OFF_R1);
  float4 gv[4];
#pragma unroll
  for (int j = 0; j < 4; ++j) gv[j] = ((const float4*)g)[lane + 64 * j];
  for (int row = gw; row < T_TOK; row += nw) {
    const float* xr;
    if (FIRST) xr = row < T_PROMPT ? p.in[0] + (size_t)row * DM : p.in[1] + (size_t)(row - T_PROMPT) * DM;
    else xr = p.out + (size_t)row * DM;
    float4 xv[4], mv[4];
    float ss = 0.f;
#pragma unroll
    for (int j = 0; j < 4; ++j) {
      const uint2 u = ((const uint2*)(mbuf + (size_t)row * DM))[lane + 64 * j];
      mv[j] = make_float4(bflo(u.x), bfhi(u.x), bflo(u.y), bfhi(u.y));
      ss += mv[j].x * mv[j].x + mv[j].y * mv[j].y + mv[j].z * mv[j].z + mv[j].w * mv[j].w;
      xv[j] = ((const float4*)xr)[lane + 64 * j];
    }
    ss = wave_sum(ss);
    const float rm = rsqrtf(ss * (1.f / DM) + EPS);
    float s2 = 0.f;
#pragma unroll
    for (int j = 0; j < 4; ++j) {
      xv[j].x += mv[j].x * rm * gv[j].x; xv[j].y += mv[j].y * rm * gv[j].y;
      xv[j].z += mv[j].z * rm * gv[j].z; xv[j].w += mv[j].w * rm * gv[j].w;
      s2 += xv[j].x * xv[j].x + xv[j].y * xv[j].y + xv[j].z * xv[j].z + xv[j].w * xv[j].w;
      ((float4*)(p.out + (size_t)row * DM))[lane + 64 * j] = xv[j];
    }
    if (!LAST) {
      s2 = wave_sum(s2);
      const float r2 = rsqrtf(s2 * (1.f / DM) + EPS);
#pragma unroll
      for (int j = 0; j < 4; ++j) {
        uint2 o; o.x = pack2(xv[j].x * r2, xv[j].y * r2); o.y = pack2(xv[j].z * r2, xv[j].w * r2);
        ((uint2*)(hb + (size_t)row * DM))[lane + 64 * j] = o;
      }
    }
  }
}

DI void phase_mla_stats(const Params& p) {
  const int lane = threadIdx.x & 63;
  const int gw = blockIdx.x * 4 + (threadIdx.x >> 6), nw = gridDim.x * 4;
  const u16* c = (const u16*)(p.ws + OFF_R3);
  float* rq = (float*)(p.ws + OFF_RQ);
  float* rkv = (float*)(p.ws + OFF_RKV);
  u16* krope = (u16*)(p.ws + OFF_KROPE);
  const float2* rope = (const float2*)(p.ws + OFF_ROPE);
  for (int row = gw; row < T_TOK; row += nw) {
    const u16* cr = c + (size_t)row * 768;
    const uint4 u0 = ((const uint4*)cr)[lane];
    float s0 = 0.f;
    { float a;
      a = bflo(u0.x); s0 += a * a; a = bfhi(u0.x); s0 += a * a; a = bflo(u0.y); s0 += a * a; a = bfhi(u0.y); s0 += a * a;
      a = bflo(u0.z); s0 += a * a; a = bfhi(u0.z); s0 += a * a; a = bflo(u0.w); s0 += a * a; a = bfhi(u0.w); s0 += a * a; }
    float s1 = 0.f;
    if (lane < 16) {
      const uint4 u1 = ((const uint4*)cr)[64 + lane];
      float a;
      a = bflo(u1.x); s1 += a * a; a = bfhi(u1.x); s1 += a * a; a = bflo(u1.y); s1 += a * a; a = bfhi(u1.y); s1 += a * a;
      a = bflo(u1.z); s1 += a * a; a = bfhi(u1.z); s1 += a * a; a = bflo(u1.w); s1 += a * a; a = bfhi(u1.w); s1 += a * a;
    }
    const float sq = wave_sum(lane < 48 ? s0 : 0.f);
    const float skv = wave_sum((lane >= 48 ? s0 : 0.f) + s1);
    if (lane == 0) {
      rq[row] = rsqrtf(sq * (1.f / 384.f) + EPS);
      rkv[row] = rsqrtf(skv * (1.f / 256.f) + EPS);
    }
    if (lane < 16) {
      const float x1 = __uint_as_float((unsigned)cr[640 + lane] << 16);
      const float x2 = __uint_as_float((unsigned)cr[656 + lane] << 16);
      const float2 cs = rope[tok_pos(row) * 16 + lane];
      krope[(size_t)row * 32 + lane] = f2bf(x1 * cs.x - x2 * cs.y);
      krope[(size_t)row * 32 + 16 + lane] = f2bf(x2 * cs.x + x1 * cs.y);
    }
  }
}

DI void store_tok(u16* out, int ldo, int m, int nbase, const f32x16& v, float sc) {
  u16* q = out + (size_t)m * ldo + nbase;
#pragma unroll
  for (int g = 0; g < 4; ++g) {
    uint2 u; u.x = pack2(v[4 * g] * sc, v[4 * g + 1] * sc); u.y = pack2(v[4 * g + 2] * sc, v[4 * g + 3] * sc);
    *(uint2*)(q + 8 * g) = u;
  }
}
DI void store_tr(u16* outT, size_t ldt, int n, int mbase, const f32x16& v, const float* __restrict__ rs) {
  u16* q = outT + (size_t)n * ldt + mbase;
#pragma unroll
  for (int g = 0; g < 4; ++g) {
    float4 s = make_float4(1.f, 1.f, 1.f, 1.f);
    if (rs) s = *(const float4*)(rs + mbase + 8 * g);
    uint2 u; u.x = pack2(v[4 * g] * s.x, v[4 * g + 1] * s.y); u.y = pack2(v[4 * g + 2] * s.z, v[4 * g + 3] * s.w);
    *(uint2*)(q + 8 * g) = u;
  }
}

struct EpiTok {
  u16* out; int ldo;
  static constexpr int SWAPMODE = 1;
  DI bool swap(int) const { return true; }
  template <int WMB, int WNB>
  DI void store(int m0w, int n0w, f32x16 (&acc)[WMB][WNB], int r, int h, bool) const {
#pragma unroll
    for (int mb = 0; mb < WMB; ++mb)
#pragma unroll
      for (int nb = 0; nb < WNB; ++nb) store_tok(out, ldo, m0w + mb * 32 + r, n0w + nb * 32 + 4 * h, acc[mb][nb], 1.f);
  }
};

struct EpiProj0 {
  u16* base;
  static constexpr int SWAPMODE = 2;
  DI bool swap(int n0w) const { const int reg = n0w >> 9; return !(reg == 2 || reg == 5); }
  template <int WMB, int WNB>
  DI void store(int m0w, int n0w, f32x16 (&acc)[WMB][WNB], int r, int h, bool sw) const {
    const int reg = n0w >> 9, nl = n0w & 511;
    u16* buf = base + (size_t)reg * SEG512;
    if (sw) {
      const float sc = (reg == 0 || reg == 3) ? QSCALE64 : 1.f;
#pragma unroll
      for (int mb = 0; mb < WMB; ++mb)
#pragma unroll
        for (int nb = 0; nb < WNB; ++nb) store_tok(buf, 512, m0w + mb * 32 + r, nl + nb * 32 + 4 * h, acc[mb][nb], sc);
    } else {
#pragma unroll
      for (int mb = 0; mb < WMB; ++mb)
#pragma unroll
        for (int nb = 0; nb < WNB; ++nb) store_tr(buf, T_TOK, nl + nb * 32 + r, m0w + mb * 32 + 4 * h, acc[mb][nb], nullptr);
    }
  }
};

struct EpiSwiGLU {
  u16* act;
  static constexpr int SWAPMODE = 1;
  DI bool swap(int) const { return true; }
  template <int WMB, int WNB>
  DI void store(int m0w, int n0w, f32x16 (&acc)[WMB][WNB], int r, int h, bool) const {
    static_assert(WNB == 2, "swiglu epilogue needs a 64-wide wave tile");
#pragma unroll
    for (int mb = 0; mb < WMB; ++mb) {
      u16* q = act + (size_t)(m0w + mb * 32 + r) * DFF + (n0w >> 1) + 4 * h;
#pragma unroll
      for (int g = 0; g < 4; ++g) {
        float y[4];
#pragma unroll
        for (int e = 0; e < 4; ++e) {
          const float gt = acc[mb][0][4 * g + e], up = acc[mb][1][4 * g + e];
          y[e] = gt / (1.f + __expf(-gt)) * up;
        }
        uint2 u; u.x = pack2(y[0], y[1]); u.y = pack2(y[2], y[3]);
        *(uint2*)(q + 8 * g) = u;
      }
    }
  }
};

struct EpiUQ {
  u16* q; const float* rq; const float2* rope;
  static constexpr int SWAPMODE = 1;
  DI bool swap(int) const { return true; }
  template <int WMB, int WNB>
  DI void store(int m0w, int n0w, f32x16 (&acc)[WMB][WNB], int r, int h, bool) const {
#pragma unroll
    for (int mb = 0; mb < WMB; ++mb) {
      const int m = m0w + mb * 32 + r;
      const float sc = rq[m] * QSCALE96;
      const int pos = tok_pos(m);
#pragma unroll
      for (int nb = 0; nb < WNB; ++nb) {
        const int n0b = n0w + nb * 32;
        f32x16 v = acc[mb][nb];
#pragma unroll
        for (int i = 0; i < 16; ++i) v[i] *= sc;
        if (((n0b >> 5) % 3) == 2) {
#pragma unroll
          for (int i = 0; i < 8; ++i) {
            const int f = (i & 3) + 8 * (i >> 2) + 4 * h;
            const float2 cs = rope[pos * 16 + f];
            const float x1 = v[i], x2 = v[i + 8];
            v[i] = x1 * cs.x - x2 * cs.y;
            v[i + 8] = x2 * cs.x + x1 * cs.y;
          }
        }
        store_tok(q, 1536, m, n0b + 4 * h, v, 1.f);
      }
    }
  }
};

struct EpiUKV {
  u16* knope; u16* vt; const float* rkv;
  static constexpr int SWAPMODE = 2;
  DI bool swap(int n0w) const { return (n0w & 64) == 0; }
  template <int WMB, int WNB>
  DI void store(int m0w, int n0w, f32x16 (&acc)[WMB][WNB], int r, int h, bool sw) const {
    static_assert(WNB == 2, "ukv epilogue needs a 64-wide wave tile");
    const int head = n0w >> 7;
    if (sw) {
#pragma unroll
      for (int mb = 0; mb < WMB; ++mb) {
        const int m = m0w + mb * 32 + r;
        const float sc = rkv[m];
#pragma unroll
        for (int nb = 0; nb < WNB; ++nb) store_tok(knope, 1024, m, head * 64 + nb * 32 + 4 * h, acc[mb][nb], sc);
      }
    } else {
#pragma unroll
      for (int mb = 0; mb < WMB; ++mb)
#pragma unroll
        for (int nb = 0; nb < WNB; ++nb) store_tr(vt, T_TOK, head * 64 + nb * 32 + r, m0w + mb * 32 + 4 * h, acc[mb][nb], rkv);
    }
  }
};

template <bool SWAP, int WMB, int WNB>
DI void gemm_compute(const char* la, const char* lb, f32x16 (&acc)[WMB][WNB], int wm, int wn, int r, int h) {
#pragma unroll
  for (int ks = 0; ks < 4; ++ks) {
    bf16x8 af[WMB], bfr[WNB];
#pragma unroll
    for (int mb = 0; mb < WMB; ++mb) af[mb] = *(const bf16x8*)(la + (wm * 32 * WMB + mb * 32 + r) * 144 + (ks * 2 + h) * 16);
#pragma unroll
    for (int nb = 0; nb < WNB; ++nb) bfr[nb] = *(const bf16x8*)(lb + (wn * 32 * WNB + nb * 32 + r) * 144 + (ks * 2 + h) * 16);
#pragma unroll
    for (int mb = 0; mb < WMB; ++mb)
#pragma unroll
      for (int nb = 0; nb < WNB; ++nb) {
        if (SWAP) acc[mb][nb] = MFMA32(bfr[nb], af[mb], acc[mb][nb]);
        else acc[mb][nb] = MFMA32(af[mb], bfr[nb], acc[mb][nb]);
      }
  }
}

template <int WMB, int WNB, class Epi>
DI void gemm_phase(const u16* __restrict__ A, int lda, const u16* __restrict__ Bt, int ldb, int M, int N, int K, const Epi epi, char* lds, int bid, int nblk) {
  constexpr int TM = 64 * WMB, TN = 64 * WNB;
  constexpr int ACH = TM / 32, BCH = TN / 32;
  char* la = lds;
  char* lb = lds + TM * 144;
  const int tid = threadIdx.x, lane = tid & 63, w = tid >> 6, wm = w >> 1, wn = w & 1, r = lane & 31, h = lane >> 5;
  const int NT = N / TN, MT = M / TM, tiles = MT * NT, nk = K >> 6;
  const int lrow = tid >> 3, lch = tid & 7;
  for (int tile = bid; tile < tiles; tile += nblk) {
    const int mt = tile / NT, nt = tile - mt * NT;
    const int m0 = mt * TM, n0 = nt * TN;
    const u16* ag = A + (size_t)(m0 + lrow) * lda + lch * 8;
    const u16* bg = Bt + (size_t)(n0 + lrow) * ldb + lch * 8;
    u32x4 pa[ACH], pb[BCH];
#pragma unroll
    for (int j = 0; j < ACH; ++j) pa[j] = *(const u32x4*)(ag + (size_t)j * 32 * lda);
#pragma unroll
    for (int j = 0; j < BCH; ++j) pb[j] = *(const u32x4*)(bg + (size_t)j * 32 * ldb);
    f32x16 acc[WMB][WNB];
#pragma unroll
    for (int mb = 0; mb < WMB; ++mb)
#pragma unroll
      for (int nb = 0; nb < WNB; ++nb)
#pragma unroll
        for (int i = 0; i < 16; ++i) acc[mb][nb][i] = 0.f;
    const bool sw = epi.swap(n0 + wn * 32 * WNB);
    for (int kt = 0; kt < nk; ++kt) {
      __syncthreads();
#pragma unroll
      for (int j = 0; j < ACH; ++j) *(u32x4*)(la + (lrow + 32 * j) * 144 + lch * 16) = pa[j];
#pragma unroll
      for (int j = 0; j < BCH; ++j) *(u32x4*)(lb + (lrow + 32 * j) * 144 + lch * 16) = pb[j];
      __syncthreads();
      if (kt + 1 < nk) {
#pragma unroll
        for (int j = 0; j < ACH; ++j) pa[j] = *(const u32x4*)(ag + (size_t)j * 32 * lda + (kt + 1) * 64);
#pragma unroll
        for (int j = 0; j < BCH; ++j) pb[j] = *(const u32x4*)(bg + (size_t)j * 32 * ldb + (kt + 1) * 64);
      }
      if (Epi::SWAPMODE == 1) gemm_compute<true, WMB, WNB>(la, lb, acc, wm, wn, r, h);
      else if (Epi::SWAPMODE == 0) gemm_compute<false, WMB, WNB>(la, lb, acc, wm, wn, r, h);
      else { if (sw) gemm_compute<true, WMB, WNB>(la, lb, acc, wm, wn, r, h); else gemm_compute<false, WMB, WNB>(la, lb, acc, wm, wn, r, h); }
    }
    epi.template store<WMB, WNB>(m0 + wm * 32 * WMB, n0 + wn * 32 * WNB, acc, r, h, sw);
  }
}

constexpr int MODE_NA = 0, MODE_DIFF = 1, MODE_MLA = 2;

template <int MODE, int DQK, int DV>
DI void attn_tile(const char* kl, const char* vl, const bf16x8 (&qf)[DQK / 16], f32x16 (&o)[DV / 32], float& m, float& l, int r, int h,
                  int qa, int ka, float fa, const float* tab) {
  constexpr int KS = DQK * 2 + 16;
  f32x16 s[2];
#pragma unroll
  for (int kb = 0; kb < 2; ++kb) {
#pragma unroll
    for (int i = 0; i < 16; ++i) s[kb][i] = 0.f;
#pragma unroll
    for (int ks = 0; ks < DQK / 16; ++ks) {
      const bf16x8 a = *(const bf16x8*)(kl + (32 * kb + r) * KS + (2 * ks + h) * 16);
      s[kb] = MFMA32(a, qf[ks], s[kb]);
    }
  }
  if (MODE == MODE_DIFF) {
#pragma unroll
    for (int kb = 0; kb < 2; ++kb)
#pragma unroll
      for (int i = 0; i < 16; ++i) {
        const int kp = ka + 32 * kb + (i & 3) + 8 * (i >> 2) + 4 * h;
        s[kb][i] -= fa * fabsf((float)(qa - kp));
      }
  } else if (MODE == MODE_NA) {
    const int wc0 = min(max(qa - 8, 0), 48);
#pragma unroll
    for (int kb = 0; kb < 2; ++kb)
#pragma unroll
      for (int i = 0; i < 16; ++i) {
        const int kc = 32 * kb + (i & 3) + 8 * (i >> 2) + 4 * h;
        const bool ok = (unsigned)(kc - wc0) < 16u;
        const int ci = min(max(kc - qa + 15, 0), 30);
        const float b = tab[ka * 31 + ci];
        s[kb][i] = ok ? s[kb][i] + b : -INFINITY;
      }
  }
  float mx = s[0][0];
#pragma unroll
  for (int kb = 0; kb < 2; ++kb)
#pragma unroll
    for (int i = 0; i < 16; ++i) mx = fmaxf(mx, s[kb][i]);
  mx = fmaxf(mx, __shfl_xor(mx, 32));
  const float mnew = fmaxf(m, mx);
  const float alpha = fexp2(m - mnew);
  m = mnew;
  float ps = 0.f;
#pragma unroll
  for (int kb = 0; kb < 2; ++kb)
#pragma unroll
    for (int i = 0; i < 16; ++i) { const float e = fexp2(s[kb][i] - mnew); s[kb][i] = e; ps += e; }
  l = l * alpha + ps;
#pragma unroll
  for (int d = 0; d < DV / 32; ++d)
#pragma unroll
    for (int i = 0; i < 16; ++i) o[d][i] *= alpha;
  bf16x8 pf[2][2];
#pragma unroll
  for (int kb = 0; kb < 2; ++kb)
#pragma unroll
    for (int st = 0; st < 2; ++st) {
      uint4 u;
      u.x = pack2(s[kb][8 * st + 0], s[kb][8 * st + 1]); u.y = pack2(s[kb][8 * st + 2], s[kb][8 * st + 3]);
      u.z = pack2(s[kb][8 * st + 4], s[kb][8 * st + 5]); u.w = pack2(s[kb][8 * st + 6], s[kb][8 * st + 7]);
      pf[kb][st] = __builtin_bit_cast(bf16x8, u);
    }
#pragma unroll
  for (int d = 0; d < DV / 32; ++d)
#pragma unroll
    for (int kb = 0; kb < 2; ++kb)
#pragma unroll
      for (int st = 0; st < 2; ++st) {
        const char* vp = vl + (32 * d + r) * 136 + (32 * kb + 16 * st + 4 * h) * 2;
        const uint2 lo = *(const uint2*)vp;
        const uint2 hi = *(const uint2*)(vp + 16);
        const uint4 u = make_uint4(lo.x, lo.y, hi.x, hi.y);
        o[d] = MFMA32(__builtin_bit_cast(bf16x8, u), pf[kb][st], o[d]);
      }
}

typedef __attribute__((ext_vector_type(2))) unsigned u32x2;
DI void lds_st16_as2x8(char* dst, const u32x4 v) {
  u32x2 a; a.x = v.x; a.y = v.y; u32x2 b; b.x = v.z; b.y = v.w;
  *(u32x2*)dst = a;
  *(u32x2*)(dst + 8) = b;
}

DI void attn_mla_item(const Params& p, int item, char* lds) {
  constexpr int DQK = 96, DV = 64, KS = DQK * 2 + 16;
  const int tid = threadIdx.x, lane = tid & 63, w = tid >> 6, r = lane & 31, h = lane >> 5;
  int head, qb, ts0, S;
  if (item < 2048) { head = item >> 7; qb = item & 127; ts0 = T_PROMPT; S = 16384; }
  else { const int it = item - 2048; qb = it & 31; head = (it >> 5) & 15; ts0 = (it >> 9) * 4096; S = 4096; }
  const u16* q = (const u16*)(p.ws + OFF_R2);
  const u16* knope = q + (size_t)T_TOK * 1536;
  const u16* vt = knope + (size_t)T_TOK * 1024;
  const u16* krope = (const u16*)(p.ws + OFF_KROPE);
  u16* o1 = (u16*)(p.ws + OFF_R1);
  char* kl = lds;
  char* vl = lds + 64 * KS;
  const int tq = ts0 + qb * 128 + w * 32 + r;
  bf16x8 qf[DQK / 16];
#pragma unroll
  for (int ks = 0; ks < DQK / 16; ++ks) qf[ks] = *(const bf16x8*)(q + (size_t)tq * 1536 + head * 96 + 16 * ks + 8 * h);
  f32x16 o[DV / 32];
#pragma unroll
  for (int d = 0; d < DV / 32; ++d)
#pragma unroll
    for (int i = 0; i < 16; ++i) o[d][i] = 0.f;
  float m = -INFINITY, l = 0.f;
  u32x4 pk[3], pv[2];
  int krow[3], kch[3];
#pragma unroll
  for (int j = 0; j < 3; ++j) { const int c = tid + 256 * j; krow[j] = c / 12; kch[j] = c - krow[j] * 12; }
  const int vrow = tid >> 3, vch = tid & 7;
  const int nkt = S >> 6;
  auto prefetch = [&](int kt) {
    const int tk0 = ts0 + kt * 64;
#pragma unroll
    for (int j = 0; j < 3; ++j) {
      const u16* src = kch[j] < 8 ? knope + (size_t)(tk0 + krow[j]) * 1024 + head * 64 + kch[j] * 8
                                  : krope + (size_t)(tk0 + krow[j]) * 32 + (kch[j] - 8) * 8;
      pk[j] = *(const u32x4*)src;
    }
#pragma unroll
    for (int j = 0; j < 2; ++j) pv[j] = *(const u32x4*)(vt + (size_t)(head * 64 + vrow + 32 * j) * T_TOK + tk0 + vch * 8);
  };
  prefetch(0);
  for (int kt = 0; kt < nkt; ++kt) {
    __syncthreads();
#pragma unroll
    for (int j = 0; j < 3; ++j) *(u32x4*)(kl + krow[j] * KS + kch[j] * 16) = pk[j];
#pragma unroll
    for (int j = 0; j < 2; ++j) lds_st16_as2x8(vl + (vrow + 32 * j) * 136 + vch * 16, pv[j]);
    __syncthreads();
    if (kt + 1 < nkt) prefetch(kt + 1);
    attn_tile<MODE_MLA, DQK, DV>(kl, vl, qf, o, m, l, r, h, 0, 0, 0.f, nullptr);
  }
  l += __shfl_xor(l, 32);
  const float inv = 1.f / l;
#pragma unroll
  for (int d = 0; d < DV / 32; ++d) store_tok(o1, 1024, tq, head * 64 + 32 * d + 4 * h, o[d], inv);
}

DI void attn_diff_item(const Params& p, int item, char* lds) {
  constexpr int DQK = 64, DV = 128, KS = DQK * 2 + 16;
  const int tid = threadIdx.x, lane = tid & 63, w = tid >> 6, r = lane & 31, h = lane >> 5;
  const int map = w >> 1, qh = w & 1;
  int hh, qb, ts0, S;
  if (item < 1024) { hh = item >> 8; qb = item & 255; ts0 = T_PROMPT; S = 16384; }
  else { const int it = item - 1024; qb = it & 63; hh = (it >> 6) & 3; ts0 = (it >> 8) * 4096; S = 4096; }
  const u16* base = (const u16*)(p.ws + OFF_R2);
  const u16* dq = base + 3 * SEG512;
  const u16* dk = base + 4 * SEG512;
  const u16* vtd = base + 5 * SEG512;
  u16* o0 = (u16*)(p.ws + OFF_R1);
  char* kl0 = lds;
  char* vl = lds + 2 * 64 * KS;
  const int qpos = qb * 64 + qh * 32 + r;
  const int tq = ts0 + qpos;
  bf16x8 qf[DQK / 16];
#pragma unroll
  for (int ks = 0; ks < DQK / 16; ++ks) qf[ks] = *(const bf16x8*)(dq + (size_t)tq * 512 + (2 * hh + map) * 64 + 16 * ks + 8 * h);
  f32x16 o[DV / 32];
#pragma unroll
  for (int d = 0; d < DV / 32; ++d)
#pragma unroll
    for (int i = 0; i < 16; ++i) o[d][i] = 0.f;
  float m = -INFINITY, l = 0.f;
  const float slope2 = exp2f(-2.f * (float)(hh + 1)) * LOG2E;
  u32x4 pk[4], pv[4];
  const int lrow = tid >> 3, lch = tid & 7;
  const int nkt = S >> 6;
  auto prefetch = [&](int kt) {
    const int tk0 = ts0 + kt * 64;
#pragma unroll
    for (int j = 0; j < 4; ++j) {
      const int row = lrow + 32 * (j & 1), which = j >> 1;
      pk[j] = *(const u32x4*)(dk + (size_t)(tk0 + row) * 512 + (2 * hh + which) * 64 + lch * 8);
    }
#pragma unroll
    for (int j = 0; j < 4; ++j) pv[j] = *(const u32x4*)(vtd + (size_t)(hh * 128 + lrow + 32 * j) * T_TOK + tk0 + lch * 8);
  };
  prefetch(0);
  for (int kt = 0; kt < nkt; ++kt) {
    __syncthreads();
#pragma unroll
    for (int j = 0; j < 4; ++j) *(u32x4*)(kl0 + (j >> 1) * 64 * KS + (lrow + 32 * (j & 1)) * KS + lch * 16) = pk[j];
#pragma unroll
    for (int j = 0; j < 4; ++j) lds_st16_as2x8(vl + (lrow + 32 * j) * 136 + lch * 16, pv[j]);
    __syncthreads();
    if (kt + 1 < nkt) prefetch(kt + 1);
    attn_tile<MODE_DIFF, DQK, DV>(kl0 + map * 64 * KS, vl, qf, o, m, l, r, h, qpos, kt * 64, slope2, nullptr);
  }
  l += __shfl_xor(l, 32);
  const float inv = 1.f / l;
  __syncthreads();
  float* ex = (float*)lds + qh * 4096;
  if (map == 1) {
#pragma unroll
    for (int d = 0; d < DV / 32; ++d)
#pragma unroll
      for (int i = 0; i < 16; ++i) ex[(d * 16 + i) * 64 + lane] = o[d][i] * inv;
  }
  __syncthreads();
  if (map == 0) {
    const float lam = ((const float*)(p.ws + OFF_SCAL))[0];
    float ss = 0.f;
#pragma unroll
    for (int d = 0; d < DV / 32; ++d)
#pragma unroll
      for (int i = 0; i < 16; ++i) { const float v = o[d][i] * inv - lam * ex[(d * 16 + i) * 64 + lane]; o[d][i] = v; ss += v * v; }
    ss += __shfl_xor(ss, 32);
    const float rn = rsqrtf(ss * (1.f / 128.f) + EPS) * 0.8f;
    const float* gs = p.in[9];
#pragma unroll
    for (int d = 0; d < DV / 32; ++d) {
#pragma unroll
      for (int g = 0; g < 4; ++g) {
        const float4 gv = *(const float4*)(gs + 32 * d + 8 * g + 4 * h);
        o[d][4 * g] *= gv.x; o[d][4 * g + 1] *= gv.y; o[d][4 * g + 2] *= gv.z; o[d][4 * g + 3] *= gv.w;
      }
      store_tok(o0, 1024, tq, 512 + hh * 128 + 32 * d + 4 * h, o[d], rn);
    }
  }
}

DI void attn_na_item(const Params& p, int item, char* lds) {
  constexpr int DQK = 64, DV = 64, KS = DQK * 2 + 16;
  const int tid = threadIdx.x, lane = tid & 63, w = tid >> 6, r = lane & 31, h = lane >> 5;
  const int pair = item % 640, head = item / 640;
  const int t0 = pair * 128;
  int ts0, rows;
  if (t0 < T_PROMPT) { ts0 = t0 & ~4095; rows = 64; } else { ts0 = T_PROMPT; rows = 256; }
  const int r0 = (t0 - ts0) >> 6;
  const int rw = r0 + (w >> 1);
  const int rs_lo = min(max(r0 - 4, 0), rows - 8);
  const int rs_hi = min(max(r0 + 1 - 4, 0), rows - 8);
  const int rs_w = min(max(rw - 4, 0), rows - 8);
  const int ntile = rs_hi + 8 - rs_lo;
  const u16* base = (const u16*)(p.ws + OFF_R2);
  const u16* qn = base;
  const u16* kn = base + SEG512;
  const u16* vtn = base + 2 * SEG512;
  u16* o0 = (u16*)(p.ws + OFF_R1);
  char* kl = lds;
  char* vl = lds + 64 * KS;
  float* tab = (float*)(lds + 64 * KS + 64 * 136);
  const int qc = (w & 1) * 32 + r;
  const int tq = t0 + w * 32 + r;
  bf16x8 qf[DQK / 16];
#pragma unroll
  for (int ks = 0; ks < DQK / 16; ++ks) qf[ks] = *(const bf16x8*)(qn + (size_t)tq * 512 + head * 64 + 16 * ks + 8 * h);
  f32x16 o[DV / 32];
#pragma unroll
  for (int d = 0; d < DV / 32; ++d)
#pragma unroll
    for (int i = 0; i < 16; ++i) o[d][i] = 0.f;
  float m = -INFINITY, l = 0.f;
  __syncthreads();
  for (int i = tid; i < 465; i += 256) tab[i] = p.in[4][head * 465 + i] * LOG2E;
  u32x4 pk[2], pv[2];
  const int lrow = tid >> 3, lch = tid & 7;
  auto prefetch = [&](int j) {
    const int tk0 = ts0 + (rs_lo + j) * 64;
#pragma unroll
    for (int jj = 0; jj < 2; ++jj) pk[jj] = *(const u32x4*)(kn + (size_t)(tk0 + lrow + 32 * jj) * 512 + head * 64 + lch * 8);
#pragma unroll
    for (int jj = 0; jj < 2; ++jj) pv[jj] = *(const u32x4*)(vtn + (size_t)(head * 64 + lrow + 32 * jj) * T_TOK + tk0 + lch * 8);
  };
  prefetch(0);
  for (int j = 0; j < ntile; ++j) {
    __syncthreads();
#pragma unroll
    for (int jj = 0; jj < 2; ++jj) *(u32x4*)(kl + (lrow + 32 * jj) * KS + lch * 16) = pk[jj];
#pragma unroll
    for (int jj = 0; jj < 2; ++jj) lds_st16_as2x8(vl + (lrow + 32 * jj) * 136 + lch * 16, pv[jj]);
    __syncthreads();
    if (j + 1 < ntile) prefetch(j + 1);
    const int kr = rs_lo + j;
    if (kr >= rs_w && kr < rs_w + 8)
      attn_tile<MODE_NA, DQK, DV>(kl, vl, qf, o, m, l, r, h, qc, kr - rw + 7, 0.f, tab);
  }
  l += __shfl_xor(l, 32);
  const float inv = 1.f / l;
#pragma unroll
  for (int d = 0; d < DV / 32; ++d) store_tok(o0, 1024, tq, head * 64 + 32 * d + 4 * h, o[d], inv);
}

template <int PH>
DI void run_phase(const Params& p, char* lds) {
  const int bid = blockIdx.x, nblk = gridDim.x;
  u16* wb = (u16*)p.ws;
  u16* R1 = (u16*)(p.ws + OFF_R1);
  u16* R2 = (u16*)(p.ws + OFF_R2);
  u16* R3 = (u16*)(p.ws + OFF_R3);
  if constexpr (PH == 0) phase_prep(p);
  else if constexpr (PH == 1) gemm_phase<2, 2>(R1, 1024, wb + W0IN, 1024, T_TOK, 3072, 1024, EpiProj0{R2}, lds, bid, nblk);
  else if constexpr (PH == 2) {
    for (int it = bid; it < 10240; it += nblk) {
      if (it < 5120) attn_diff_item(p, it, lds);
      else attn_na_item(p, it - 5120, lds);
    }
  }
  else if constexpr (PH == 3) gemm_phase<2, 2>(R1, 1024, wb + W0OUT, 1024, T_TOK, 1024, 1024, EpiTok{R3, 1024}, lds, bid, nblk);
  else if constexpr (PH == 4) phase_res<true, false>(p, R3, p.in[11]);
  else if constexpr (PH == 5) gemm_phase<2, 2>(R1, 1024, wb + W0F1, 1024, T_TOK, 5632, 1024, EpiSwiGLU{R2}, lds, bid, nblk);
  else if constexpr (PH == 6) gemm_phase<2, 2>(R2, 2816, wb + W0F2, 2816, T_TOK, 1024, 2816, EpiTok{R3, 1024}, lds, bid, nblk);
  else if constexpr (PH == 7) phase_res<false, false>(p, R3, p.in[15]);
  else if constexpr (PH == 8) gemm_phase<2, 2>(R1, 1024, wb + W1DN, 1024, T_TOK, 768, 1024, EpiTok{R3, 768}, lds, bid, nblk);
  else if constexpr (PH == 9) phase_mla_stats(p);
  else if constexpr (PH == 10) {
    gemm_phase<2, 2>(R3, 768, wb + W1UQ, 384, T_TOK, 1536, 384,
                     EpiUQ{R2, (const float*)(p.ws + OFF_RQ), (const float2*)(p.ws + OFF_ROPE)}, lds, bid, nblk);
    gemm_phase<2, 2>(R3 + 384, 768, wb + W1UKV, 256, T_TOK, 2048, 256,
                     EpiUKV{R2 + (size_t)T_TOK * 1536, R2 + (size_t)T_TOK * 2560, (const float*)(p.ws + OFF_RKV)}, lds, bid, nblk);
  }
  else if constexpr (PH == 11) { for (int it = bid; it < 10240; it += nblk) attn_mla_item(p, it, lds); }
  else if constexpr (PH == 12) gemm_phase<2, 2>(R1, 1024, wb + W1OUT, 1024, T_TOK, 1024, 1024, EpiTok{R3, 1024}, lds, bid, nblk);
  else if constexpr (PH == 13) phase_res<false, false>(p, R3, p.in[23]);
  else if constexpr (PH == 14) gemm_phase<2, 2>(R1, 1024, wb + W1F1, 1024, T_TOK, 5632, 1024, EpiSwiGLU{R2}, lds, bid, nblk);
  else if constexpr (PH == 15) gemm_phase<2, 2>(R2, 2816, wb + W1F2, 2816, T_TOK, 1024, 2816, EpiTok{R3, 1024}, lds, bid, nblk);
  else if constexpr (PH == 16) phase_res<false, true>(p, R3, p.in[27]);
}

#if MULTI_LAUNCH
template <int PH>
__global__ void __launch_bounds__(256, 2) k_phase(Params p) {
  __shared__ __attribute__((aligned(16))) char lds[36864];
  run_phase<PH>(p, lds);
}
template <int PH>
static void launch_all(const Params& p, int grid, hipStream_t stream) {
  hipLaunchKernelGGL(k_phase<PH>, dim3(grid), dim3(256), 0, stream, p);
  if constexpr (PH + 1 < NPHASE) launch_all<PH + 1>(p, grid, stream);
}
#define OCC_KERNEL k_phase<2>
#else
template <int PH>
DI void run_from(const Params& p, char* lds) {
  run_phase<PH>(p, lds);
  if constexpr (PH + 1 < NPHASE) { cg::this_grid().sync(); run_from<PH + 1>(p, lds); }
}
__global__ void __launch_bounds__(256, 2) mega(Params p) {
  __shared__ __attribute__((aligned(16))) char lds[36864];
  run_from<0>(p, lds);
}
#define OCC_KERNEL mega
#endif

extern "C" void kernel_launch(void* const* d_in, const int* in_sizes, int n_in, void* d_out, int out_size, void* d_ws, size_t ws_size,
                              hipStream_t stream) {
  static int grid = 0;
  if (grid == 0) {
    if (n_in != 28 || ws_size < WS_NEED) { fprintf(stderr, "kernel_launch: unexpected n_in %d / ws_size %zu (need %zu)\n", n_in, ws_size, (size_t)WS_NEED); grid = -1; return; }
    int dev = 0, cus = 0, per_cu = 0;
    (void)hipGetDevice(&dev);
    (void)hipDeviceGetAttribute(&cus, hipDeviceAttributeMultiprocessorCount, dev);
    (void)hipOccupancyMaxActiveBlocksPerMultiprocessor(&per_cu, (const void*)OCC_KERNEL, 256, 0);
    if (per_cu < 1) per_cu = 1;
    if (per_cu > 2) per_cu = 2;
    grid = cus * per_cu;
  }
  if (grid < 0) return;
  Params p{};
  for (int i = 0; i < 28; ++i) p.in[i] = (const float*)d_in[i];
  p.out = (float*)d_out;
  p.ws = (char*)d_ws;
#if MULTI_LAUNCH
  launch_all<0>(p, grid, stream);
#else
  void* args[] = {&p};
  hipError_t e = hipLaunchCooperativeKernel((const void*)mega, dim3(grid), dim3(256), args, 0, stream);
  if (e != hipSuccess) fprintf(stderr, "cooperative launch failed: %s (grid %d)\n", hipGetErrorString(e), grid);
#endif
}
```

```cpp
#include <hip/hip_runtime.h>
#include <hip/hip_cooperative_groups.h>
#include <stdint.h>
#include <cstdio>
namespace cg = cooperative_groups;

#ifndef MULTI_LAUNCH
#define MULTI_LAUNCH 0
#endif

typedef unsigned short u16;
typedef __attribute__((ext_vector_type(8))) short bf16x8;
typedef __attribute__((ext_vector_type(16))) float f32x16;
typedef __attribute__((ext_vector_type(4))) unsigned u32x4;

#define MFMA32(a, b, c) __builtin_amdgcn_mfma_f32_32x32x16_bf16((a), (b), (c), 0, 0, 0)
#define DI __device__ __forceinline__

constexpr int T_TOK = 81920;
constexpr int T_PROMPT = 65536;
constexpr int DM = 1024;
constexpr int DFF = 2816;
constexpr float EPS = 1e-6f;
constexpr float LOG2E = 1.4426950408889634f;
constexpr float QSCALE64 = 0.125f * LOG2E;
constexpr float QSCALE96 = 0.10206207261596577f * LOG2E;
constexpr int NPHASE = 17;

constexpr size_t MiB = (size_t)1 << 20;
constexpr size_t W0IN = 0;
constexpr size_t W0OUT = W0IN + (size_t)3072 * 1024;
constexpr size_t W0F1 = W0OUT + (size_t)1024 * 1024;
constexpr size_t W0F2 = W0F1 + (size_t)5632 * 1024;
constexpr size_t W1DN = W0F2 + (size_t)1024 * 2816;
constexpr size_t W1UQ = W1DN + (size_t)768 * 1024;
constexpr size_t W1UKV = W1UQ + (size_t)1536 * 384;
constexpr size_t W1OUT = W1UKV + (size_t)2048 * 256;
constexpr size_t W1F1 = W1OUT + (size_t)1024 * 1024;
constexpr size_t W1F2 = W1F1 + (size_t)5632 * 1024;
constexpr size_t W_END = W1F2 + (size_t)1024 * 2816;
static_assert(W_END * 2 <= 48 * MiB, "weights region");
constexpr size_t OFF_ROPE = 48 * MiB;
constexpr size_t OFF_RQ = OFF_ROPE + 2 * MiB;
constexpr size_t OFF_RKV = OFF_RQ + MiB / 2;
constexpr size_t OFF_KROPE = OFF_RKV + MiB / 2;
constexpr size_t OFF_SCAL = OFF_KROPE + 5 * MiB;
constexpr size_t OFF_R1 = 58 * MiB;
constexpr size_t OFF_R3 = OFF_R1 + 160 * MiB;
constexpr size_t OFF_R2 = OFF_R3 + 160 * MiB;
constexpr size_t WS_NEED = OFF_R2 + 560 * MiB;
constexpr size_t SEG512 = (size_t)T_TOK * 512;

struct Params {
  const float* in[28];
  float* out;
  char* ws;
};

DI u16 f2bf(float x) { unsigned u = __float_as_uint(x); u += 0x7fffu + ((u >> 16) & 1u); return (u16)(u >> 16); }
DI unsigned pack2(float a, float b) { return (unsigned)f2bf(a) | ((unsigned)f2bf(b) << 16); }
DI float bflo(unsigned v) { return __uint_as_float(v << 16); }
DI float bfhi(unsigned v) { return __uint_as_float(v & 0xffff0000u); }
DI float wave_sum(float v) {
#pragma unroll
  for (int o = 32; o; o >>= 1) v += __shfl_xor(v, o);
  return v;
}
DI int tok_pos(int t) { return t < T_PROMPT ? (t & 4095) : (t - T_PROMPT); }
DI float fexp2(float x) { return __builtin_amdgcn_exp2f(x); }
DI int otid() { int t = threadIdx.x; asm volatile("" : "+v"(t)); return t; }
DI int obid() { int b = blockIdx.x; asm volatile("" : "+s"(b)); return b; }

__device__ const float ROPE_INV[16] = {1.0f, 0.5623413324356079f, 0.3162277638912201f, 0.17782793939113617f, 0.10000000149011612f, 0.05623413249850273f, 0.03162277489900589f, 0.017782794311642647f, 0.009999999776482582f, 0.005623413249850273f, 0.003162277629598975f, 0.0017782794311642647f, 0.0010000000474974513f, 0.000562341301701963f, 0.0003162277571391314f, 0.00017782794020604342f};

DI void wconv(const float* __restrict__ W, const float* __restrict__ g, u16* __restrict__ dst, int K, int N, int rowsOut, int perm, int gtid, int gthreads) {
  const int kc = K >> 3;
  const long total = (long)rowsOut * kc;
  for (long c = gtid; c < total; c += gthreads) {
    const int n = (int)(c % rowsOut);
    const int k0 = (int)(c / rowsOut) * 8;
    int sc;
    if (perm == 1) { const int blk = n >> 6, w = n & 63; const int j = blk * 32 + (w & 31); sc = (w < 32) ? j : DFF + j; }
    else if (perm == 2) { const int hd = (n & 1023) >> 6, d = n & 63; sc = hd * 128 + (n >= 1024 ? 64 : 0) + d; }
    else sc = n;
    uint4 o = make_uint4(0, 0, 0, 0);
    if (sc < N) {
      float v[8];
#pragma unroll
      for (int i = 0; i < 8; ++i) { float x = W[(size_t)(k0 + i) * N + sc]; if (g) x *= g[k0 + i]; v[i] = x; }
      o.x = pack2(v[0], v[1]); o.y = pack2(v[2], v[3]); o.z = pack2(v[4], v[5]); o.w = pack2(v[6], v[7]);
    }
    *(uint4*)(dst + (size_t)n * K + k0) = o;
  }
}

DI void phase_prep(const Params& p) {
  const int gtid = obid() * 512 + otid(), gthreads = gridDim.x * 512;
  u16* wb = (u16*)p.ws;
  wconv(p.in[3], p.in[2], wb + W0IN, 1024, 3072, 3072, 0, gtid, gthreads);
  wconv(p.in[10], nullptr, wb + W0OUT, 1024, 1024, 1024, 0, gtid, gthreads);
  wconv(p.in[13], p.in[12], wb + W0F1, 1024, 5632, 5632, 1, gtid, gthreads);
  wconv(p.in[14], nullptr, wb + W0F2, 2816, 1024, 1024, 0, gtid, gthreads);
  wconv(p.in[17], p.in[16], wb + W1DN, 1024, 672, 768, 0, gtid, gthreads);
  wconv(p.in[20], p.in[18], wb + W1UQ, 384, 1536, 1536, 0, gtid, gthreads);
  wconv(p.in[21], p.in[19], wb + W1UKV, 256, 2048, 2048, 2, gtid, gthreads);
  wconv(p.in[22], nullptr, wb + W1OUT, 1024, 1024, 1024, 0, gtid, gthreads);
  wconv(p.in[25], p.in[24], wb + W1F1, 1024, 5632, 5632, 1, gtid, gthreads);
  wconv(p.in[26], nullptr, wb + W1F2, 2816, 1024, 1024, 0, gtid, gthreads);
  float2* rope = (float2*)(p.ws + OFF_ROPE);
  for (int idx = gtid; idx < 16384 * 16; idx += gthreads) {
    const int pos = idx >> 4, i = idx & 15;
    const float ang = (float)pos * ROPE_INV[i];
    double rev = (double)ang * 0.15915494309189535;
    rev -= rint(rev);
    const float rf = (float)rev;
    rope[idx] = make_float2(__builtin_amdgcn_cosf(rf), __builtin_amdgcn_sinf(rf));
  }
  if (gtid == 0) {
    float s1 = 0.f, s2 = 0.f;
    for (int i = 0; i < 64; ++i) { s1 += p.in[5][i] * p.in[6][i]; s2 += p.in[7][i] * p.in[8][i]; }
    float* sc = (float*)(p.ws + OFF_SCAL);
    sc[0] = __expf(s1) - __expf(s2) + 0.2f;
  }
  const int tid_ = otid();
  const int lane = tid_ & 63;
  const int gw = obid() * 8 + (tid_ >> 6), nw = gridDim.x * 8;
  u16* hb = (u16*)(p.ws + OFF_R1);
  for (int row = gw; row < T_TOK; row += nw) {
    const float* xr = row < T_PROMPT ? p.in[0] + (size_t)row * DM : p.in[1] + (size_t)(row - T_PROMPT) * DM;
    float4 v[4];
    float ss = 0.f;
#pragma unroll
    for (int j = 0; j < 4; ++j) { v[j] = ((const float4*)xr)[lane + 64 * j]; ss += v[j].x * v[j].x + v[j].y * v[j].y + v[j].z * v[j].z + v[j].w * v[j].w; }
    ss = wave_sum(ss);
    const float r = rsqrtf(ss * (1.f / DM) + EPS);
#pragma unroll
    for (int j = 0; j < 4; ++j) {
      uint2 o; o.x = pack2(v[j].x * r, v[j].y * r); o.y = pack2(v[j].z * r, v[j].w * r);
      ((uint2*)(hb + (size_t)row * DM))[lane + 64 * j] = o;
    }
  }
}

template <bool FIRST, bool LAST>
DI void phase_res(const Params& p, const u16* __restrict__ mbuf, const float* __restrict__ g) {
  const int tid_ = otid();
  const int lane = tid_ & 63;
  const int gw = obid() * 8 + (tid_ >> 6), nw = gridDim.x * 8;
  u16* hb = (u16*)(p.ws + OFF_R1);
  float4 gv[4];
#pragma unroll
  for (int j = 0; j < 4; ++j) gv[j] = ((const float4*)g)[lane + 64 * j];
  for (int row = gw; row < T_TOK; row += nw) {
    const float* xr;
    if (FIRST) xr = row < T_PROMPT ? p.in[0] + (size_t)row * DM : p.in[1] + (size_t)(row - T_PROMPT) * DM;
    else xr = p.out + (size_t)row * DM;
    float4 xv[4], mv[4];
    float ss = 0.f;
#pragma unroll
    for (int j = 0; j < 4; ++j) {
      const uint2 u = ((const uint2*)(mbuf + (size_t)row * DM))[lane + 64 * j];
      mv[j] = make_float4(bflo(u.x), bfhi(u.x), bflo(u.y), bfhi(u.y));
      ss += mv[j].x * mv[j].x + mv[j].y * mv[j].y + mv[j].z * mv[j].z + mv[j].w * mv[j].w;
      xv[j] = ((const float4*)xr)[lane + 64 * j];
    }
    ss = wave_sum(ss);
    const float rm = rsqrtf(ss * (1.f / DM) + EPS);
    float s2 = 0.f;
#pragma unroll
    for (int j = 0; j < 4; ++j) {
      xv[j].x += mv[j].x * rm * gv[j].x; xv[j].y += mv[j].y * rm * gv[j].y;
      xv[j].z += mv[j].z * rm * gv[j].z; xv[j].w += mv[j].w * rm * gv[j].w;
      s2 += xv[j].x * xv[j].x + xv[j].y * xv[j].y + xv[j].z * xv[j].z + xv[j].w * xv[j].w;
      ((float4*)(p.out + (size_t)row * DM))[lane + 64 * j] = xv[j];
    }
    if (!LAST) {
      s2 = wave_sum(s2);
      const float r2 = rsqrtf(s2 * (1.f / DM) + EPS);
#pragma unroll
      for (int j = 0; j < 4; ++j) {
        uint2 o; o.x = pack2(xv[j].x * r2, xv[j].y * r2); o.y = pack2(xv[j].z * r2, xv[j].w * r2);
        ((uint2*)(hb + (size_t)row * DM))[lane + 64 * j] = o;
      }
    }
  }
}

DI void phase_mla_stats(const Params& p) {
  const int tid_ = otid();
  const int lane = tid_ & 63;
  const int gw = obid() * 8 + (tid_ >> 6), nw = gridDim.x * 8;
  const u16* c = (const u16*)(p.ws + OFF_R3);
  float* rq = (float*)(p.ws + OFF_RQ);
  float* rkv = (float*)(p.ws + OFF_RKV);
  u16* krope = (u16*)(p.ws + OFF_KROPE);
  const float2* rope = (const float2*)(p.ws + OFF_ROPE);
  for (int row = gw; row < T_TOK; row += nw) {
    const u16* cr = c + (size_t)row * 768;
    const uint4 u0 = ((const uint4*)cr)[lane];
    float s0 = 0.f;
    { float a;
      a = bflo(u0.x); s0 += a * a; a = bfhi(u0.x); s0 += a * a; a = bflo(u0.y); s0 += a * a; a = bfhi(u0.y); s0 += a * a;
      a = bflo(u0.z); s0 += a * a; a = bfhi(u0.z); s0 += a * a; a = bflo(u0.w); s0 += a * a; a = bfhi(u0.w); s0 += a * a; }
    float s1 = 0.f;
    if (lane < 16) {
      const uint4 u1 = ((const uint4*)cr)[64 + lane];
      float a;
      a = bflo(u1.x); s1 += a * a; a = bfhi(u1.x); s1 += a * a; a = bflo(u1.y); s1 += a * a; a = bfhi(u1.y); s1 += a * a;
      a = bflo(u1.z); s1 += a * a; a = bfhi(u1.z); s1 += a * a; a = bflo(u1.w); s1 += a * a; a = bfhi(u1.w); s1 += a * a;
    }
    const float sq = wave_sum(lane < 48 ? s0 : 0.f);
    const float skv = wave_sum((lane >= 48 ? s0 : 0.f) + s1);
    if (lane == 0) {
      rq[row] = rsqrtf(sq * (1.f / 384.f) + EPS);
      rkv[row] = rsqrtf(skv * (1.f / 256.f) + EPS);
    }
    if (lane < 16) {
      const float x1 = __uint_as_float((unsigned)cr[640 + lane] << 16);
      const float x2 = __uint_as_float((unsigned)cr[656 + lane] << 16);
      const float2 cs = rope[tok_pos(row) * 16 + lane];
      krope[(size_t)row * 32 + lane] = f2bf(x1 * cs.x - x2 * cs.y);
      krope[(size_t)row * 32 + 16 + lane] = f2bf(x2 * cs.x + x1 * cs.y);
    }
  }
}

DI void store_tok(u16* out, int ldo, int m, int nbase, const f32x16& v, float sc) {
  u16* q = out + (size_t)m * ldo + nbase;
#pragma unroll
  for (int g = 0; g < 4; ++g) {
    uint2 u; u.x = pack2(v[4 * g] * sc, v[4 * g + 1] * sc); u.y = pack2(v[4 * g + 2] * sc, v[4 * g + 3] * sc);
    *(uint2*)(q + 8 * g) = u;
  }
}
DI void store_tr(u16* outT, size_t ldt, int n, int mbase, const f32x16& v, const float* __restrict__ rs) {
  u16* q = outT + (size_t)n * ldt + mbase;
#pragma unroll
  for (int g = 0; g < 4; ++g) {
    float4 s = make_float4(1.f, 1.f, 1.f, 1.f);
    if (rs) s = *(const float4*)(rs + mbase + 8 * g);
    uint2 u; u.x = pack2(v[4 * g] * s.x, v[4 * g + 1] * s.y); u.y = pack2(v[4 * g + 2] * s.z, v[4 * g + 3] * s.w);
    *(uint2*)(q + 8 * g) = u;
  }
}

struct EpiTok {
  u16* out; int ldo;
  static constexpr int SWAPMODE = 1;
  DI bool swap(int) const { return true; }
  template <int WMB, int WNB>
  DI void store(int m0w, int n0w, f32x16 (&acc)[WMB][WNB], int r, int h, bool) const {
#pragma unroll
    for (int mb = 0; mb < WMB; ++mb)
#pragma unroll
      for (int nb = 0; nb < WNB; ++nb) store_tok(out, ldo, m0w + mb * 32 + r, n0w + nb * 32 + 4 * h, acc[mb][nb], 1.f);
  }
};

struct EpiProj0 {
  u16* base;
  static constexpr int SWAPMODE = 2;
  DI bool swap(int n0w) const { const int reg = n0w >> 9; return !(reg == 2 || reg == 5); }
  template <int WMB, int WNB>
  DI void store(int m0w, int n0w, f32x16 (&acc)[WMB][WNB], int r, int h, bool sw) const {
    const int reg = n0w >> 9, nl = n0w & 511;
    u16* buf = base + (size_t)reg * SEG512;
    if (sw) {
      const float sc = (reg == 0 || reg == 3) ? QSCALE64 : 1.f;
#pragma unroll
      for (int mb = 0; mb < WMB; ++mb)
#pragma unroll
        for (int nb = 0; nb < WNB; ++nb) store_tok(buf, 512, m0w + mb * 32 + r, nl + nb * 32 + 4 * h, acc[mb][nb], sc);
    } else {
#pragma unroll
      for (int mb = 0; mb < WMB; ++mb)
#pragma unroll
        for (int nb = 0; nb < WNB; ++nb) store_tr(buf, T_TOK, nl + nb * 32 + r, m0w + mb * 32 + 4 * h, acc[mb][nb], nullptr);
    }
  }
};

struct EpiSwiGLU {
  u16* act;
  static constexpr int SWAPMODE = 1;
  DI bool swap(int) const { return true; }
  template <int WMB, int WNB>
  DI void store(int m0w, int n0w, f32x16 (&acc)[WMB][WNB], int r, int h, bool) const {
    static_assert(WNB == 2, "swiglu epilogue needs a 64-wide wave tile");
#pragma unroll
    for (int mb = 0; mb < WMB; ++mb) {
      u16* q = act + (size_t)(m0w + mb * 32 + r) * DFF + (n0w >> 1) + 4 * h;
#pragma unroll
      for (int g = 0; g < 4; ++g) {
        float y[4];
#pragma unroll
        for (int e = 0; e < 4; ++e) {
          const float gt = acc[mb][0][4 * g + e], up = acc[mb][1][4 * g + e];
          y[e] = gt / (1.f + __expf(-gt)) * up;
        }
        uint2 u; u.x = pack2(y[0], y[1]); u.y = pack2(y[2], y[3]);
        *(uint2*)(q + 8 * g) = u;
      }
    }
  }
};

struct EpiUQ {
  u16* q; const float* rq; const float2* rope;
  static constexpr int SWAPMODE = 1;
  DI bool swap(int) const { return true; }
  template <int WMB, int WNB>
  DI void store(int m0w, int n0w, f32x16 (&acc)[WMB][WNB], int r, int h, bool) const {
#pragma unroll
    for (int mb = 0; mb < WMB; ++mb) {
      const int m = m0w + mb * 32 + r;
      const float sc = rq[m] * QSCALE96;
      const int pos = tok_pos(m);
#pragma unroll
      for (int nb = 0; nb < WNB; ++nb) {
        const int n0b = n0w + nb * 32;
        f32x16 v = acc[mb][nb];
#pragma unroll
        for (int i = 0; i < 16; ++i) v[i] *= sc;
        if (((n0b >> 5) % 3) == 2) {
#pragma unroll
          for (int i = 0; i < 8; ++i) {
            const int f = (i & 3) + 8 * (i >> 2) + 4 * h;
            const float2 cs = rope[pos * 16 + f];
            const float x1 = v[i], x2 = v[i + 8];
            v[i] = x1 * cs.x - x2 * cs.y;
            v[i + 8] = x2 * cs.x + x1 * cs.y;
          }
        }
        store_tok(q, 1536, m, n0b + 4 * h, v, 1.f);
      }
    }
  }
};

struct EpiUKV {
  u16* knope; u16* vt; const float* rkv;
  static constexpr int SWAPMODE = 2;
  DI bool swap(int n0) const { return n0 < 1024; }
  template <int WMB, int WNB>
  DI void store(int m0w, int n0w, f32x16 (&acc)[WMB][WNB], int r, int h, bool sw) const {
    if (sw) {
#pragma unroll
      for (int mb = 0; mb < WMB; ++mb) {
        const int m = m0w + mb * 32 + r;
        const float sc = rkv[m];
#pragma unroll
        for (int nb = 0; nb < WNB; ++nb) store_tok(knope, 1024, m, n0w + nb * 32 + 4 * h, acc[mb][nb], sc);
      }
    } else {
#pragma unroll
      for (int mb = 0; mb < WMB; ++mb)
#pragma unroll
        for (int nb = 0; nb < WNB; ++nb) store_tr(vt, T_TOK, n0w - 1024 + nb * 32 + r, m0w + mb * 32 + 4 * h, acc[mb][nb], rkv);
    }
  }
};

template <bool SWAP, int WMB, int WNB>
DI void gemm_compute(const char* la, const char* lb, f32x16 (&acc)[WMB][WNB], int wm, int wn, int r, int h) {
#pragma unroll
  for (int ks = 0; ks < 4; ++ks) {
    bf16x8 af[WMB], bfr[WNB];
#pragma unroll
    for (int mb = 0; mb < WMB; ++mb) af[mb] = *(const bf16x8*)(la + (wm * 32 * WMB + mb * 32 + r) * 144 + (ks * 2 + h) * 16);
#pragma unroll
    for (int nb = 0; nb < WNB; ++nb) bfr[nb] = *(const bf16x8*)(lb + (wn * 32 * WNB + nb * 32 + r) * 144 + (ks * 2 + h) * 16);
#pragma unroll
    for (int mb = 0; mb < WMB; ++mb)
#pragma unroll
      for (int nb = 0; nb < WNB; ++nb) {
        if (SWAP) acc[mb][nb] = MFMA32(bfr[nb], af[mb], acc[mb][nb]);
        else acc[mb][nb] = MFMA32(af[mb], bfr[nb], acc[mb][nb]);
      }
  }
}

template <bool SWAP, class Epi>
DI void gemm_tile(const u16* __restrict__ ag, int lda, const u16* __restrict__ bg, int ldb, int nk, int m0, int n0, const Epi& epi, char* lds) {
  constexpr int WMB = 4, WNB = 2;
  constexpr int TM = 256, TN = 256;
  constexpr int STAGE = (TM + TN) * 144;
  const int tid = otid(), lane = tid & 63, w = tid >> 6, wm = w >> 2, wn = w & 3, r = lane & 31, h = lane >> 5;
  const int lrow = tid >> 3, lch = tid & 7;
  u32x4 pa[4], pb[4];
  f32x16 acc[WMB][WNB];
#pragma unroll
  for (int mb = 0; mb < WMB; ++mb)
#pragma unroll
    for (int nb = 0; nb < WNB; ++nb)
#pragma unroll
      for (int i = 0; i < 16; ++i) acc[mb][nb][i] = 0.f;
#pragma unroll
  for (int j = 0; j < 4; ++j) pa[j] = *(const u32x4*)(ag + (size_t)j * 64 * lda);
#pragma unroll
  for (int j = 0; j < 4; ++j) pb[j] = *(const u32x4*)(bg + (size_t)j * 64 * ldb);
  {
    char* la = lds; char* lb = lds + TM * 144;
#pragma unroll
    for (int j = 0; j < 4; ++j) *(u32x4*)(la + (lrow + 64 * j) * 144 + lch * 16) = pa[j];
#pragma unroll
    for (int j = 0; j < 4; ++j) *(u32x4*)(lb + (lrow + 64 * j) * 144 + lch * 16) = pb[j];
  }
  if (nk > 1) {
#pragma unroll
    for (int j = 0; j < 4; ++j) pa[j] = *(const u32x4*)(ag + (size_t)j * 64 * lda + 64);
#pragma unroll
    for (int j = 0; j < 4; ++j) pb[j] = *(const u32x4*)(bg + (size_t)j * 64 * ldb + 64);
  }
  __syncthreads();
  for (int kt = 0; kt < nk; ++kt) {
    const char* la = lds + (kt & 1) * STAGE;
    const char* lb = la + TM * 144;
    gemm_compute<SWAP, WMB, WNB>(la, lb, acc, wm, wn, r, h);
    if (kt + 1 < nk) {
      char* wa = lds + ((kt + 1) & 1) * STAGE;
      char* wb = wa + TM * 144;
#pragma unroll
      for (int j = 0; j < 4; ++j) *(u32x4*)(wa + (lrow + 64 * j) * 144 + lch * 16) = pa[j];
#pragma unroll
      for (int j = 0; j < 4; ++j) *(u32x4*)(wb + (lrow + 64 * j) * 144 + lch * 16) = pb[j];
    }
    if (kt + 2 < nk) {
#pragma unroll
      for (int j = 0; j < 4; ++j) pa[j] = *(const u32x4*)(ag + (size_t)j * 64 * lda + (kt + 2) * 64);
#pragma unroll
      for (int j = 0; j < 4; ++j) pb[j] = *(const u32x4*)(bg + (size_t)j * 64 * ldb + (kt + 2) * 64);
    }
    __syncthreads();
  }
  epi.template store<WMB, WNB>(m0 + wm * 32 * WMB, n0 + wn * 32 * WNB, acc, r, h, SWAP);
}

template <class Epi>
DI void gemm_phase(const u16* __restrict__ A, int lda, const u16* __restrict__ Bt, int ldb, int M, int N, int K, const Epi epi, char* lds, int bid, int nblk) {
  constexpr int TM = 256, TN = 256;
  const int tid = otid();
  const int NT = N / TN, MT = M / TM, tiles = MT * NT, nk = K >> 6;
  const int lrow = tid >> 3, lch = tid & 7;
  for (int tile = bid; tile < tiles; tile += nblk) {
    const int mt = tile / NT, nt = tile - mt * NT;
    const int m0 = mt * TM, n0 = nt * TN;
    const u16* ag = A + (size_t)(m0 + lrow) * lda + lch * 8;
    const u16* bg = Bt + (size_t)(n0 + lrow) * ldb + lch * 8;
    if (Epi::SWAPMODE == 1) gemm_tile<true>(ag, lda, bg, ldb, nk, m0, n0, epi, lds);
    else if (Epi::SWAPMODE == 0) gemm_tile<false>(ag, lda, bg, ldb, nk, m0, n0, epi, lds);
    else { if (epi.swap(n0)) gemm_tile<true>(ag, lda, bg, ldb, nk, m0, n0, epi, lds); else gemm_tile<false>(ag, lda, bg, ldb, nk, m0, n0, epi, lds); }
  }
}

typedef __attribute__((ext_vector_type(2))) float f32x2;
typedef __attribute__((ext_vector_type(2))) __bf16 bf16x2_t;
typedef __attribute__((ext_vector_type(2))) unsigned u32x2;
DI unsigned cvt_pk(float a, float b) {
  f32x2 v; v.x = a; v.y = b;
  return __builtin_bit_cast(unsigned, __builtin_convertvector(v, bf16x2_t));
}
DI void lds_st16_as2x8(char* dst, const u32x4 v) {
  u32x2 a; a.x = v.x; a.y = v.y; u32x2 b; b.x = v.z; b.y = v.w;
  *(u32x2*)dst = a;
  *(u32x2*)(dst + 8) = b;
}
constexpr int ATT_STAGE = 35840;
constexpr float DEFER_THR = 8.f;

template <int DQK>
DI void qk_scores_qlds(const char* kl, const char* qsl, f32x16 (&s)[2], int r, int h) {
  constexpr int KS = DQK * 2 + 16;
#pragma unroll
  for (int kb = 0; kb < 2; ++kb) {
#pragma unroll
    for (int ks = 0; ks < DQK / 16; ++ks) {
      const bf16x8 a = *(const bf16x8*)(kl + (32 * kb + r) * KS + (2 * ks + h) * 16);
      const bf16x8 qv = *(const bf16x8*)(qsl + ks * 1024);
      s[kb] = MFMA32(a, qv, s[kb]);
    }
    __builtin_amdgcn_sched_barrier(0);
  }
}
template <int DQK>
DI void qk_scores(const char* kl, const bf16x8 (&qf)[DQK / 16], const f32x16& initv, f32x16 (&s)[2], int r, int h) {
  constexpr int KS = DQK * 2 + 16;
#pragma unroll
  for (int kb = 0; kb < 2; ++kb) {
    s[kb] = initv;
#pragma unroll
    for (int ks = 0; ks < DQK / 16; ++ks) {
      const bf16x8 a = *(const bf16x8*)(kl + (32 * kb + r) * KS + (2 * ks + h) * 16);
      s[kb] = MFMA32(a, qf[ks], s[kb]);
    }
  }
}

template <int DV>
DI float softmax_pv(f32x16 (&s)[2], f32x16 (&o)[DV / 32], float& l, bool first, const char* vl, int r, int h) {
  float dret = 0.f;
  float mx = fmaxf(fmaxf(s[0][0], s[0][1]), s[0][2]);
#pragma unroll
  for (int i = 3; i < 15; i += 2) mx = fmaxf(fmaxf(mx, s[0][i]), s[0][i + 1]);
  mx = fmaxf(fmaxf(mx, s[0][15]), s[1][0]);
#pragma unroll
  for (int i = 1; i < 15; i += 2) mx = fmaxf(fmaxf(mx, s[1][i]), s[1][i + 1]);
  mx = fmaxf(mx, s[1][15]);
  const bool need = first || (mx > DEFER_THR);
  if (__any(need)) {
    mx = fmaxf(mx, __shfl_xor(mx, 32));
    float delta;
    if (first) delta = mx;
    else {
      delta = fmaxf(mx, 0.f);
      const float alpha = fexp2(-delta);
      l *= alpha;
#pragma unroll
      for (int d = 0; d < DV / 32; ++d)
#pragma unroll
        for (int i = 0; i < 16; ++i) o[d][i] *= alpha;
    }
#pragma unroll
    for (int kb = 0; kb < 2; ++kb)
#pragma unroll
      for (int i = 0; i < 16; ++i) s[kb][i] -= delta;
    dret = delta;
  }
  float ps = 0.f;
#pragma unroll
  for (int kb = 0; kb < 2; ++kb)
#pragma unroll
    for (int i = 0; i < 16; ++i) { const float e = fexp2(s[kb][i]); s[kb][i] = e; ps += e; }
  l += ps;
  bf16x8 pf[2][2];
#pragma unroll
  for (int kb = 0; kb < 2; ++kb)
#pragma unroll
    for (int st = 0; st < 2; ++st) {
      u32x4 u;
      u.x = cvt_pk(s[kb][8 * st + 0], s[kb][8 * st + 1]); u.y = cvt_pk(s[kb][8 * st + 2], s[kb][8 * st + 3]);
      u.z = cvt_pk(s[kb][8 * st + 4], s[kb][8 * st + 5]); u.w = cvt_pk(s[kb][8 * st + 6], s[kb][8 * st + 7]);
      pf[kb][st] = __builtin_bit_cast(bf16x8, u);
    }
#pragma unroll
  for (int d = 0; d < DV / 32; ++d)
#pragma unroll
    for (int kb = 0; kb < 2; ++kb)
#pragma unroll
      for (int st = 0; st < 2; ++st) {
        const char* vp = vl + (32 * d + r) * 136 + (32 * kb + 16 * st + 4 * h) * 2;
        const u32x2 lo = *(const u32x2*)vp;
        const u32x2 hi = *(const u32x2*)(vp + 16);
        u32x4 u; u.x = lo.x; u.y = lo.y; u.z = hi.x; u.w = hi.y;
        o[d] = MFMA32(__builtin_bit_cast(bf16x8, u), pf[kb][st], o[d]);
        if (kb == 1 && st == 1) __builtin_amdgcn_sched_barrier(0);
      }
  return dret;
}

DI void attn_mla_item(const Params& p, int item, char* lds) {
  constexpr int DQK = 96, DV = 64, KS = DQK * 2 + 16;
  const int tid = otid(), lane = tid & 63, w = tid >> 6, r = lane & 31, h = lane >> 5;
  int head, qb, ts0, S;
  if (item < 1024) { head = item >> 6; qb = item & 63; ts0 = T_PROMPT; S = 16384; }
  else { const int it = item - 1024; qb = it & 15; head = (it >> 4) & 15; ts0 = (it >> 8) * 4096; S = 4096; }
  const u16* q = (const u16*)(p.ws + OFF_R2);
  const u16* knope = q + (size_t)T_TOK * 1536;
  const u16* vt = knope + (size_t)T_TOK * 1024;
  const u16* krope = (const u16*)(p.ws + OFF_KROPE);
  u16* o1 = (u16*)(p.ws + OFF_R1);
  const int tq = ts0 + qb * 256 + w * 32 + r;
  bf16x8 qf[DQK / 16];
#pragma unroll
  for (int ks = 0; ks < DQK / 16; ++ks) qf[ks] = *(const bf16x8*)(q + (size_t)tq * 1536 + head * 96 + 16 * ks + 8 * h);
  f32x16 o[DV / 32];
#pragma unroll
  for (int d = 0; d < DV / 32; ++d)
#pragma unroll
    for (int i = 0; i < 16; ++i) o[d][i] = 0.f;
  f32x16 initv;
#pragma unroll
  for (int i = 0; i < 16; ++i) initv[i] = 0.f;
  float l = 0.f;
  u32x4 pk0, pk1, pv0;
  const int c1 = 512 + tid;
  const int krow0 = tid / 12, kch0 = tid - krow0 * 12;
  const int krow1 = c1 / 12, kch1 = c1 - krow1 * 12;
  const int vrow = tid >> 3, vch = tid & 7;
  const int nkt = S >> 6;
  auto prefetch = [&](int kt) {
    const int tk0 = ts0 + kt * 64;
    {
      const u16* src = kch0 < 8 ? knope + (size_t)(tk0 + krow0) * 1024 + head * 64 + kch0 * 8 : krope + (size_t)(tk0 + krow0) * 32 + (kch0 - 8) * 8;
      pk0 = *(const u32x4*)src;
    }
    if (tid < 256) {
      const u16* src = kch1 < 8 ? knope + (size_t)(tk0 + krow1) * 1024 + head * 64 + kch1 * 8 : krope + (size_t)(tk0 + krow1) * 32 + (kch1 - 8) * 8;
      pk1 = *(const u32x4*)src;
    }
    pv0 = *(const u32x4*)(vt + (size_t)(head * 64 + vrow) * T_TOK + tk0 + vch * 8);
  };
  auto stage = [&](int b) {
    char* kl = lds + b * ATT_STAGE;
    char* vl = kl + 64 * KS;
    *(u32x4*)(kl + krow0 * KS + kch0 * 16) = pk0;
    if (tid < 256) *(u32x4*)(kl + krow1 * KS + kch1 * 16) = pk1;
    lds_st16_as2x8(vl + vrow * 136 + vch * 16, pv0);
  };
  prefetch(0);
  __syncthreads();
  stage(0);
  if (nkt > 1) prefetch(1);
  __syncthreads();
  for (int kt = 0; kt < nkt; ++kt) {
    const char* kl = lds + (kt & 1) * ATT_STAGE;
    const char* vl = kl + 64 * KS;
    f32x16 s[2];
    qk_scores<DQK>(kl, qf, initv, s, r, h);
    {
      const float dl = softmax_pv<DV>(s, o, l, kt == 0, vl, r, h);
      if (__any(dl != 0.f)) {
#pragma unroll
        for (int i = 0; i < 16; ++i) initv[i] -= dl;
      }
    }
    if (kt + 1 < nkt) stage((kt + 1) & 1);
    if (kt + 2 < nkt) prefetch(kt + 2);
    __syncthreads();
  }
  l += __shfl_xor(l, 32);
  const float inv = 1.f / l;
#pragma unroll
  for (int d = 0; d < DV / 32; ++d) store_tok(o1, 1024, tq, head * 64 + 32 * d + 4 * h, o[d], inv);
}

DI void attn_diff_item(const Params& p, int item, char* lds) {
  constexpr int DQK = 64, DV = 128, KS = DQK * 2 + 16;
  const int tid = otid(), lane = tid & 63, w = tid >> 6, r = lane & 31, h = lane >> 5;
  const int map = w >> 2, qw = w & 3;
  int hh, qb, ts0, S;
  if (item < 512) { hh = item >> 7; qb = item & 127; ts0 = T_PROMPT; S = 16384; }
  else { const int it = item - 512; qb = it & 31; hh = (it >> 5) & 3; ts0 = (it >> 7) * 4096; S = 4096; }
  const u16* base = (const u16*)(p.ws + OFF_R2);
  const u16* dq = base + 3 * SEG512;
  const u16* dk = base + 4 * SEG512;
  const u16* vtd = base + 5 * SEG512;
  u16* o0 = (u16*)(p.ws + OFF_R1);
  const int qpos = qb * 128 + qw * 32 + r;
  const int tq = ts0 + qpos;
  char* qsl = lds + 2 * ATT_STAGE + 4096 + w * 4096 + lane * 16;
  __syncthreads();
#pragma unroll
  for (int ks = 0; ks < DQK / 16; ++ks) *(bf16x8*)(qsl + ks * 1024) = *(const bf16x8*)(dq + (size_t)tq * 512 + (2 * hh + map) * 64 + 16 * ks + 8 * h);
  f32x16 o[DV / 32];
#pragma unroll
  for (int d = 0; d < DV / 32; ++d)
#pragma unroll
    for (int i = 0; i < 16; ++i) o[d][i] = 0.f;
  float l = 0.f;
  float ref = 0.f;
  const float slope2 = exp2f(-2.f * (float)(hh + 1)) * LOG2E;
  const float cq = slope2 * (float)qpos;
  unsigned kloc[2];
#pragma unroll
  for (int kb = 0; kb < 2; ++kb) {
    const float x = slope2 * (float)(32 * kb + r);
    const unsigned hi = cvt_pk(x, 0.f) & 0xffffu;
    const float xr = x - __uint_as_float(hi << 16);
    const unsigned lo = cvt_pk(xr, 0.f) & 0xffffu;
    kloc[kb] = h == 0 ? (hi | (lo << 16)) : 0u;
  }
  const int d0 = 2 * qb;
  const int kd = d0 + (qw >> 1);
  const int nkt = S >> 6;
  u32x4 pk[2], pv[2];
  const int lrow = tid >> 3, lch = tid & 7;
  auto tile_of = [&](int idx) { return idx < 2 ? d0 + idx : (idx - 2 < d0 ? d0 - 1 - (idx - 2) : idx); };
  const unsigned koff = (unsigned)(((ts0 + lrow) * 512 + 2 * hh * 64 + lch * 8) * 2);
  const unsigned voff = (unsigned)((((hh * 128 + lrow) * T_TOK) + ts0 + lch * 8) * 2);
  const char* dkb = (const char*)dk;
  const char* vtb = (const char*)vtd;
  auto prefetch = [&](int kt) {
    const unsigned ko = koff + (unsigned)kt * (64u * 512u * 2u);
    const unsigned vo = voff + (unsigned)kt * 128u;
    pk[0] = *(const u32x4*)(dkb + ko);
    pk[1] = *(const u32x4*)(dkb + ko + 128u);
    pv[0] = *(const u32x4*)(vtb + vo);
    pv[1] = *(const u32x4*)(vtb + vo + (unsigned)(64 * T_TOK * 2));
  };
  auto stage = [&](int b) {
    char* kl0 = lds + b * ATT_STAGE;
    char* vl = kl0 + 2 * 64 * KS;
#pragma unroll
    for (int j = 0; j < 2; ++j) *(u32x4*)(kl0 + j * 64 * KS + lrow * KS + lch * 16) = pk[j];
#pragma unroll
    for (int j = 0; j < 2; ++j) lds_st16_as2x8(vl + (lrow + 64 * j) * 136 + lch * 16, pv[j]);
  };
  prefetch(tile_of(0));
  __syncthreads();
  stage(0);
  if (nkt > 1) prefetch(tile_of(1));
  __syncthreads();
  for (int idx = 0; idx < nkt; ++idx) {
    const int kt = tile_of(idx);
    const char* kl = lds + (idx & 1) * ATT_STAGE + map * 64 * KS;
    const char* vl = lds + (idx & 1) * ATT_STAGE + 2 * 64 * KS;
    const int side = kt < kd ? -1 : (kt > kd ? 1 : 0);
    const float I = (float)side * cq - ref;
    const unsigned i_hi = cvt_pk(I, 0.f) & 0xffffu;
    const float ir1 = I - __uint_as_float(i_hi << 16);
    const unsigned i_mid = cvt_pk(ir1, 0.f) & 0xffffu;
    const float ir2 = ir1 - __uint_as_float(i_mid << 16);
    const unsigned i_lo = cvt_pk(ir2, 0.f) & 0xffffu;
    const float T = slope2 * (float)(kt * 64);
    const unsigned t_hi = cvt_pk(T, 0.f) & 0xffffu;
    const float r1 = T - __uint_as_float(t_hi << 16);
    const unsigned t_mid = cvt_pk(r1, 0.f) & 0xffffu;
    const float r2 = r1 - __uint_as_float(t_mid << 16);
    const unsigned t_lo = cvt_pk(r2, 0.f) & 0xffffu;
    const unsigned one = side < 0 ? 0x3F80u : (side > 0 ? 0xBF80u : 0u);
    u32x4 qa;
    qa.x = h == 0 ? (one | (one << 16)) : 0u; qa.y = qa.x; qa.z = h == 0 ? (one | (i_hi << 16)) : 0u; qa.w = h == 0 ? (i_mid | (i_lo << 16)) : 0u;
    const bf16x8 qaug = __builtin_bit_cast(bf16x8, qa);
    f32x16 s[2];
#pragma unroll
    for (int kb = 0; kb < 2; ++kb) {
      u32x4 ka; ka.x = kloc[kb]; ka.y = h == 0 ? (t_hi | (t_mid << 16)) : 0u; ka.z = h == 0 ? (t_lo | 0x3F800000u) : 0u; ka.w = h == 0 ? 0x3F803F80u : 0u;
      f32x16 z;
#pragma unroll
      for (int i = 0; i < 16; ++i) z[i] = 0.f;
      s[kb] = MFMA32(__builtin_bit_cast(bf16x8, ka), qaug, z);
    }
    qk_scores_qlds<DQK>(kl, qsl, s, r, h);
    if (side == 0) {
#pragma unroll
      for (int kb = 0; kb < 2; ++kb)
#pragma unroll
        for (int i = 0; i < 16; ++i) {
          const int kp = kt * 64 + 32 * kb + (i & 3) + 8 * (i >> 2) + 4 * h;
          s[kb][i] -= slope2 * fabsf((float)(qpos - kp));
        }
    }
    ref += softmax_pv<DV>(s, o, l, idx == 0, vl, r, h);
    if (idx + 1 < nkt) stage((idx + 1) & 1);
    if (idx + 2 < nkt) prefetch(tile_of(idx + 2));
    __syncthreads();
  }
  l += __shfl_xor(l, 32);
  const float inv = 1.f / l;
  float* ex = (float*)lds + qw * 4096;
  if (map == 1) {
#pragma unroll
    for (int d = 0; d < DV / 32; ++d)
#pragma unroll
      for (int i = 0; i < 16; ++i) ex[(d * 16 + i) * 64 + lane] = o[d][i] * inv;
  }
  __syncthreads();
  if (map == 0) {
    const float lam = ((const float*)(p.ws + OFF_SCAL))[0];
    float ss = 0.f;
#pragma unroll
    for (int d = 0; d < DV / 32; ++d)
#pragma unroll
      for (int i = 0; i < 16; ++i) { const float v = o[d][i] * inv - lam * ex[(d * 16 + i) * 64 + lane]; o[d][i] = v; ss += v * v; }
    ss += __shfl_xor(ss, 32);
    const float rn = rsqrtf(ss * (1.f / 128.f) + EPS) * 0.8f;
    const float* gs = p.in[9];
#pragma unroll
    for (int d = 0; d < DV / 32; ++d) {
#pragma unroll
      for (int g = 0; g < 4; ++g) {
        const float4 gv = *(const float4*)(gs + 32 * d + 8 * g + 4 * h);
        o[d][4 * g] *= gv.x; o[d][4 * g + 1] *= gv.y; o[d][4 * g + 2] *= gv.z; o[d][4 * g + 3] *= gv.w;
      }
      store_tok(o0, 1024, tq, 512 + hh * 128 + 32 * d + 4 * h, o[d], rn);
    }
  }
}

DI void attn_na_item(const Params& p, int item, char* lds) {
  constexpr int DQK = 64, DV = 64, KS = DQK * 2 + 16;
  const int tid = otid(), lane = tid & 63, w = tid >> 6, r = lane & 31, h = lane >> 5;
  const int quad = item % 320, head = item / 320;
  const int t0 = quad * 256;
  int ts0, rows;
  if (t0 < T_PROMPT) { ts0 = t0 & ~4095; rows = 64; } else { ts0 = T_PROMPT; rows = 256; }
  const int r0 = (t0 - ts0) >> 6;
  const int rw = r0 + (w >> 1);
  const int rs_lo = min(max(r0 - 4, 0), rows - 8);
  const int rs_hi = min(max(r0 + 3 - 4, 0), rows - 8);
  const int rs_w = min(max(rw - 4, 0), rows - 8);
  const int ntile = rs_hi + 8 - rs_lo;
  const u16* base = (const u16*)(p.ws + OFF_R2);
  const u16* qn = base;
  const u16* kn = base + SEG512;
  const u16* vtn = base + 2 * SEG512;
  u16* o0 = (u16*)(p.ws + OFF_R1);
  float* tab = (float*)(lds + 2 * ATT_STAGE) + 64;
  const int qc = (w & 1) * 32 + r;
  const int tq = t0 + w * 32 + r;
  bf16x8 qf[DQK / 16];
#pragma unroll
  for (int ks = 0; ks < DQK / 16; ++ks) qf[ks] = *(const bf16x8*)(qn + (size_t)tq * 512 + head * 64 + 16 * ks + 8 * h);
  f32x16 o[DV / 32];
#pragma unroll
  for (int d = 0; d < DV / 32; ++d)
#pragma unroll
    for (int i = 0; i < 16; ++i) o[d][i] = 0.f;
  f32x16 initv;
#pragma unroll
  for (int i = 0; i < 16; ++i) initv[i] = 0.f;
  float l = 0.f;
  bool first = true;
  u32x4 pk0, pv0;
  const int lrow = tid >> 3, lch = tid & 7;
  auto prefetch = [&](int j) {
    const int tk0 = ts0 + (rs_lo + j) * 64;
    pk0 = *(const u32x4*)(kn + (size_t)(tk0 + lrow) * 512 + head * 64 + lch * 8);
    pv0 = *(const u32x4*)(vtn + (size_t)(head * 64 + lrow) * T_TOK + tk0 + lch * 8);
  };
  auto stage = [&](int b) {
    char* kl = lds + b * ATT_STAGE;
    char* vl = kl + 64 * KS;
    *(u32x4*)(kl + lrow * KS + lch * 16) = pk0;
    lds_st16_as2x8(vl + lrow * 136 + lch * 16, pv0);
  };
  prefetch(0);
  __syncthreads();
  if (tid < 465) tab[tid] = p.in[4][head * 465 + tid] * LOG2E;
  stage(0);
  prefetch(1);
  __syncthreads();
  const int wc0 = min(max(qc - 8, 0), 48);
  const float* tabq = tab + (15 - qc + 4 * h);
  for (int j = 0; j < ntile; ++j) {
    const char* kl = lds + (j & 1) * ATT_STAGE;
    const char* vl = kl + 64 * KS;
    const int kr = rs_lo + j;
    if (kr >= rs_w && kr < rs_w + 8) {
      f32x16 s[2];
      qk_scores<DQK>(kl, qf, initv, s, r, h);
      const int ridx = kr - rw + 7;
#pragma unroll
      for (int kb = 0; kb < 2; ++kb)
#pragma unroll
        for (int i = 0; i < 16; ++i) {
          const int kc = 32 * kb + (i & 3) + 8 * (i >> 2) + 4 * h;
          const bool ok = (unsigned)(kc - wc0) < 16u;
          const float b = tabq[ridx * 31 + 32 * kb + (i & 3) + 8 * (i >> 2)];
          s[kb][i] = ok ? s[kb][i] + b : -INFINITY;
        }
      {
        const float dl = softmax_pv<DV>(s, o, l, first, vl, r, h);
        if (__any(dl != 0.f)) {
#pragma unroll
          for (int i = 0; i < 16; ++i) initv[i] -= dl;
        }
      }
      first = false;
    }
    if (j + 1 < ntile) stage((j + 1) & 1);
    if (j + 2 < ntile) prefetch(j + 2);
    __syncthreads();
  }
  l += __shfl_xor(l, 32);
  const float inv = 1.f / l;
#pragma unroll
  for (int d = 0; d < DV / 32; ++d) store_tok(o0, 1024, tq, head * 64 + 32 * d + 4 * h, o[d], inv);
}

constexpr int LDS_BYTES = 2 * (256 + 256) * 144;
template <int PH>
DI void run_phase(const Params& p, char* lds) {
  const int bid = obid(), nblk = gridDim.x;
  u16* wb = (u16*)p.ws;
  u16* R1 = (u16*)(p.ws + OFF_R1);
  u16* R2 = (u16*)(p.ws + OFF_R2);
  u16* R3 = (u16*)(p.ws + OFF_R3);
  if constexpr (PH == 0) phase_prep(p);
  else if constexpr (PH == 1) gemm_phase(R1, 1024, wb + W0IN, 1024, T_TOK, 3072, 1024, EpiProj0{R2}, lds, bid, nblk);
  else if constexpr (PH == 2) {
    for (int it = bid; it < 5120; it += nblk) {
      if (it < 2560) attn_diff_item(p, it, lds);
      else attn_na_item(p, it - 2560, lds);
    }
  }
  else if constexpr (PH == 3) gemm_phase(R1, 1024, wb + W0OUT, 1024, T_TOK, 1024, 1024, EpiTok{R3, 1024}, lds, bid, nblk);
  else if constexpr (PH == 4) phase_res<true, false>(p, R3, p.in[11]);
  else if constexpr (PH == 5) gemm_phase(R1, 1024, wb + W0F1, 1024, T_TOK, 5632, 1024, EpiSwiGLU{R2}, lds, bid, nblk);
  else if constexpr (PH == 6) gemm_phase(R2, 2816, wb + W0F2, 2816, T_TOK, 1024, 2816, EpiTok{R3, 1024}, lds, bid, nblk);
  else if constexpr (PH == 7) phase_res<false, false>(p, R3, p.in[15]);
  else if constexpr (PH == 8) gemm_phase(R1, 1024, wb + W1DN, 1024, T_TOK, 768, 1024, EpiTok{R3, 768}, lds, bid, nblk);
  else if constexpr (PH == 9) phase_mla_stats(p);
  else if constexpr (PH == 10) {
    gemm_phase(R3, 768, wb + W1UQ, 384, T_TOK, 1536, 384,
                     EpiUQ{R2, (const float*)(p.ws + OFF_RQ), (const float2*)(p.ws + OFF_ROPE)}, lds, bid, nblk);
    gemm_phase(R3 + 384, 768, wb + W1UKV, 256, T_TOK, 2048, 256,
                     EpiUKV{R2 + (size_t)T_TOK * 1536, R2 + (size_t)T_TOK * 2560, (const float*)(p.ws + OFF_RKV)}, lds, bid, nblk);
  }
  else if constexpr (PH == 11) { for (int it = bid; it < 5120; it += nblk) attn_mla_item(p, it, lds); }
  else if constexpr (PH == 12) gemm_phase(R1, 1024, wb + W1OUT, 1024, T_TOK, 1024, 1024, EpiTok{R3, 1024}, lds, bid, nblk);
  else if constexpr (PH == 13) phase_res<false, false>(p, R3, p.in[23]);
  else if constexpr (PH == 14) gemm_phase(R1, 1024, wb + W1F1, 1024, T_TOK, 5632, 1024, EpiSwiGLU{R2}, lds, bid, nblk);
  else if constexpr (PH == 15) gemm_phase(R2, 2816, wb + W1F2, 2816, T_TOK, 1024, 2816, EpiTok{R3, 1024}, lds, bid, nblk);
  else if constexpr (PH == 16) phase_res<false, true>(p, R3, p.in[27]);
}

#if MULTI_LAUNCH
template <int PH>
__global__ void __launch_bounds__(512, 2) k_phase(Params p) {
  extern __shared__ __attribute__((aligned(16))) char lds[];
  run_phase<PH>(p, lds);
}
template <int PH>
static void launch_all(const Params& p, int grid, hipStream_t stream) {
  (void)hipFuncSetAttribute((const void*)k_phase<PH>, hipFuncAttributeMaxDynamicSharedMemorySize, LDS_BYTES);
  hipLaunchKernelGGL(k_phase<PH>, dim3(grid), dim3(512), LDS_BYTES, stream, p);
  if constexpr (PH + 1 < NPHASE) launch_all<PH + 1>(p, grid, stream);
}
#define OCC_KERNEL k_phase<2>
#else
template <int PH>
DI void run_from(const Params& p, char* lds) {
  run_phase<PH>(p, lds);
  if constexpr (PH + 1 < NPHASE) { cg::this_grid().sync(); run_from<PH + 1>(p, lds); }
}
__global__ void __launch_bounds__(512, 2) mega(Params p) {
  extern __shared__ __attribute__((aligned(16))) char lds[];
  run_from<0>(p, lds);
}
#define OCC_KERNEL mega
#endif

extern "C" void kernel_launch(void* const* d_in, const int* in_sizes, int n_in, void* d_out, int out_size, void* d_ws, size_t ws_size,
                              hipStream_t stream) {
  static int grid = 0;
  if (grid == 0) {
    if (n_in != 28 || ws_size < WS_NEED) { fprintf(stderr, "kernel_launch: unexpected n_in %d / ws_size %zu (need %zu)\n", n_in, ws_size, (size_t)WS_NEED); grid = -1; return; }
    int dev = 0, cus = 0, per_cu = 0;
    (void)hipGetDevice(&dev);
    (void)hipDeviceGetAttribute(&cus, hipDeviceAttributeMultiprocessorCount, dev);
    (void)hipFuncSetAttribute((const void*)OCC_KERNEL, hipFuncAttributeMaxDynamicSharedMemorySize, LDS_BYTES);
    (void)hipOccupancyMaxActiveBlocksPerMultiprocessor(&per_cu, (const void*)OCC_KERNEL, 512, LDS_BYTES);
    if (per_cu < 1) per_cu = 1;
    if (per_cu > 1) per_cu = 1;
    grid = cus * per_cu;
  }
  if (grid < 0) return;
  Params p{};
  for (int i = 0; i < 28; ++i) p.in[i] = (const float*)d_in[i];
  p.out = (float*)d_out;
  p.ws = (char*)d_ws;
#if MULTI_LAUNCH
  launch_all<0>(p, grid, stream);
#else
  void* args[] = {&p};
  hipError_t e = hipLaunchCooperativeKernel((const void*)mega, dim3(grid), dim3(512), args, LDS_BYTES, stream);
  if (e != hipSuccess) fprintf(stderr, "cooperative launch failed: %s (grid %d)\n", hipGetErrorString(e), grid);
#endif
}
```

```cpp
#include <hip/hip_runtime.h>
#include <hip/hip_cooperative_groups.h>
#include <stdint.h>
#include <cstdio>
namespace cg = cooperative_groups;

#ifndef MULTI_LAUNCH
#define MULTI_LAUNCH 0
#endif

typedef unsigned short u16;
typedef __attribute__((ext_vector_type(8))) short bf16x8;
typedef __attribute__((ext_vector_type(16))) float f32x16;
typedef __attribute__((ext_vector_type(4))) unsigned u32x4;

#define MFMA32(a, b, c) __builtin_amdgcn_mfma_f32_32x32x16_bf16((a), (b), (c), 0, 0, 0)
#define DI __device__ __forceinline__

constexpr int T_TOK = 81920;
constexpr int T_PROMPT = 65536;
constexpr int DM = 1024;
constexpr int DFF = 2816;
constexpr float EPS = 1e-6f;
constexpr float LOG2E = 1.4426950408889634f;
constexpr float QSCALE64 = 0.125f * LOG2E;
constexpr float QSCALE96 = 0.10206207261596577f * LOG2E;
constexpr int NPHASE = 17;

constexpr size_t MiB = (size_t)1 << 20;
constexpr size_t W0IN = 0;
constexpr size_t W0OUT = W0IN + (size_t)3072 * 1024;
constexpr size_t W0F1 = W0OUT + (size_t)1024 * 1024;
constexpr size_t W0F2 = W0F1 + (size_t)5632 * 1024;
constexpr size_t W1DN = W0F2 + (size_t)1024 * 2816;
constexpr size_t W1UQ = W1DN + (size_t)768 * 1024;
constexpr size_t W1UKV = W1UQ + (size_t)1536 * 384;
constexpr size_t W1OUT = W1UKV + (size_t)2048 * 256;
constexpr size_t W1F1 = W1OUT + (size_t)1024 * 1024;
constexpr size_t W1F2 = W1F1 + (size_t)5632 * 1024;
constexpr size_t W_END = W1F2 + (size_t)1024 * 2816;
static_assert(W_END * 2 <= 48 * MiB, "weights region");
constexpr size_t OFF_ROPE = 48 * MiB;
constexpr size_t OFF_RQ = OFF_ROPE + 2 * MiB;
constexpr size_t OFF_RKV = OFF_RQ + MiB / 2;
constexpr size_t OFF_KROPE = OFF_RKV + MiB / 2;
constexpr size_t OFF_SCAL = OFF_KROPE + 5 * MiB;
constexpr int SC_G0 = 1024, SC_G1 = 2048, SC_G2 = 3072, SC_G3 = 4096, SC_GSUB = 5120, SC_RPB = 6144;
constexpr size_t OFF_R1 = 58 * MiB;
constexpr size_t OFF_R3 = OFF_R1 + 160 * MiB;
constexpr size_t OFF_R2 = OFF_R3 + 160 * MiB;
constexpr size_t WS_NEED = OFF_R2 + 560 * MiB;
constexpr size_t SEG512 = (size_t)T_TOK * 512;

struct Params {
  const float* in[28];
  float* out;
  char* ws;
};

DI u16 f2bf(float x) { unsigned u = __float_as_uint(x); u += 0x7fffu + ((u >> 16) & 1u); return (u16)(u >> 16); }
DI unsigned pack2(float a, float b) { return (unsigned)f2bf(a) | ((unsigned)f2bf(b) << 16); }
DI float bflo(unsigned v) { return __uint_as_float(v << 16); }
DI float bfhi(unsigned v) { return __uint_as_float(v & 0xffff0000u); }
DI float wave_sum(float v) {
#pragma unroll
  for (int o = 32; o; o >>= 1) v += __shfl_xor(v, o);
  return v;
}
DI int tok_pos(int t) { return t < T_PROMPT ? (t & 4095) : (t - T_PROMPT); }
DI float fexp2(float x) { return __builtin_amdgcn_exp2f(x); }
DI int otid() { int t = threadIdx.x; asm volatile("" : "+v"(t)); return t; }
DI int obid() { int b = blockIdx.x; asm volatile("" : "+s"(b)); return b; }

__device__ const float ROPE_INV[16] = {1.0f, 0.5623413324356079f, 0.3162277638912201f, 0.17782793939113617f, 0.10000000149011612f, 0.05623413249850273f, 0.03162277489900589f, 0.017782794311642647f, 0.009999999776482582f, 0.005623413249850273f, 0.003162277629598975f, 0.0017782794311642647f, 0.0010000000474974513f, 0.000562341301701963f, 0.0003162277571391314f, 0.00017782794020604342f};

DI void wconv(const float* __restrict__ W, const float* __restrict__ g, u16* __restrict__ dst, int K, int N, int rowsOut, int perm, int gtid, int gthreads) {
  const int kc = K >> 3;
  const long total = (long)rowsOut * kc;
  for (long c = gtid; c < total; c += gthreads) {
    const int n = (int)(c % rowsOut);
    const int k0 = (int)(c / rowsOut) * 8;
    int sc;
    if (perm == 1) { const int blk = n >> 6, w = n & 63; const int j = blk * 32 + (w & 31); sc = (w < 32) ? j : DFF + j; }
    else if (perm == 2) { const int hd = (n & 1023) >> 6, d = n & 63; sc = hd * 128 + (n >= 1024 ? 64 : 0) + d; }
    else sc = n;
    uint4 o = make_uint4(0, 0, 0, 0);
    if (sc < N) {
      float v[8];
#pragma unroll
      for (int i = 0; i < 8; ++i) { float x = W[(size_t)(k0 + i) * N + sc]; if (g) x *= g[k0 + i]; v[i] = x; }
      o.x = pack2(v[0], v[1]); o.y = pack2(v[2], v[3]); o.z = pack2(v[4], v[5]); o.w = pack2(v[6], v[7]);
    }
    *(uint4*)(dst + (size_t)n * K + k0) = o;
  }
}

DI void phase_prep(const Params& p) {
  const int gtid = obid() * 512 + otid(), gthreads = gridDim.x * 512;
  u16* wb = (u16*)p.ws;
  wconv(p.in[3], p.in[2], wb + W0IN, 1024, 3072, 3072, 0, gtid, gthreads);
  wconv(p.in[10], nullptr, wb + W0OUT, 1024, 1024, 1024, 0, gtid, gthreads);
  wconv(p.in[13], p.in[12], wb + W0F1, 1024, 5632, 5632, 1, gtid, gthreads);
  wconv(p.in[14], nullptr, wb + W0F2, 2816, 1024, 1024, 0, gtid, gthreads);
  wconv(p.in[17], p.in[16], wb + W1DN, 1024, 672, 768, 0, gtid, gthreads);
  wconv(p.in[20], p.in[18], wb + W1UQ, 384, 1536, 1536, 0, gtid, gthreads);
  wconv(p.in[21], p.in[19], wb + W1UKV, 256, 2048, 2048, 2, gtid, gthreads);
  wconv(p.in[22], nullptr, wb + W1OUT, 1024, 1024, 1024, 0, gtid, gthreads);
  wconv(p.in[25], p.in[24], wb + W1F1, 1024, 5632, 5632, 1, gtid, gthreads);
  wconv(p.in[26], nullptr, wb + W1F2, 2816, 1024, 1024, 0, gtid, gthreads);
  float2* rope = (float2*)(p.ws + OFF_ROPE);
  for (int idx = gtid; idx < 16384 * 16; idx += gthreads) {
    const int pos = idx >> 4, i = idx & 15;
    const float ang = (float)pos * ROPE_INV[i];
    double rev = (double)ang * 0.15915494309189535;
    rev -= rint(rev);
    const float rf = (float)rev;
    rope[idx] = make_float2(__builtin_amdgcn_cosf(rf), __builtin_amdgcn_sinf(rf));
  }
  if (gtid == 0) {
    float s1 = 0.f, s2 = 0.f;
    for (int i = 0; i < 64; ++i) { s1 += p.in[5][i] * p.in[6][i]; s2 += p.in[7][i] * p.in[8][i]; }
    float* sc = (float*)(p.ws + OFF_SCAL);
    sc[0] = __expf(s1) - __expf(s2) + 0.2f;
  }
  {
    float* sc = (float*)(p.ws + OFF_SCAL);
    for (int i = gtid; i < 1024; i += gthreads) { sc[SC_G0 + i] = p.in[11][i]; sc[SC_G1 + i] = p.in[15][i]; sc[SC_G2 + i] = p.in[23][i]; sc[SC_G3 + i] = p.in[27][i]; }
    for (int i = gtid; i < 128; i += gthreads) sc[SC_GSUB + i] = p.in[9][i];
    for (int i = gtid; i < 8 * 465; i += gthreads) sc[SC_RPB + i] = p.in[4][i] * LOG2E;
  }
  const int tid_ = otid();
  const int lane = tid_ & 63;
  const int gw = obid() * 8 + (tid_ >> 6), nw = gridDim.x * 8;
  u16* hb = (u16*)(p.ws + OFF_R1);
  for (int row = gw; row < T_TOK; row += nw) {
    const float* xr = row < T_PROMPT ? p.in[0] + (size_t)row * DM : p.in[1] + (size_t)(row - T_PROMPT) * DM;
    float4 v[4];
    float ss = 0.f;
#pragma unroll
    for (int j = 0; j < 4; ++j) { v[j] = ((const float4*)xr)[lane + 64 * j]; ss += v[j].x * v[j].x + v[j].y * v[j].y + v[j].z * v[j].z + v[j].w * v[j].w; }
    ss = wave_sum(ss);
    const float r = rsqrtf(ss * (1.f / DM) + EPS);
#pragma unroll
    for (int j = 0; j < 4; ++j) {
      uint2 o; o.x = pack2(v[j].x * r, v[j].y * r); o.y = pack2(v[j].z * r, v[j].w * r);
      ((uint2*)(hb + (size_t)row * DM))[lane + 64 * j] = o;
    }
  }
}

template <bool FIRST, bool LAST>
DI void phase_res(const Params& p, const u16* __restrict__ mbuf, const float* __restrict__ g) {
  const int tid_ = otid();
  const int lane = tid_ & 63;
  const int gw = obid() * 8 + (tid_ >> 6), nw = gridDim.x * 8;
  u16* hb = (u16*)(p.ws + OFF_R1);
  float4 gv[4];
#pragma unroll
  for (int j = 0; j < 4; ++j) gv[j] = ((const float4*)g)[lane + 64 * j];
  for (int row = gw; row < T_TOK; row += nw) {
    const float* xr;
    if (FIRST) xr = row < T_PROMPT ? p.in[0] + (size_t)row * DM : p.in[1] + (size_t)(row - T_PROMPT) * DM;
    else xr = p.out + (size_t)row * DM;
    float4 xv[4], mv[4];
    float ss = 0.f;
#pragma unroll
    for (int j = 0; j < 4; ++j) {
      const uint2 u = ((const uint2*)(mbuf + (size_t)row * DM))[lane + 64 * j];
      mv[j] = make_float4(bflo(u.x), bfhi(u.x), bflo(u.y), bfhi(u.y));
      ss += mv[j].x * mv[j].x + mv[j].y * mv[j].y + mv[j].z * mv[j].z + mv[j].w * mv[j].w;
      xv[j] = ((const float4*)xr)[lane + 64 * j];
    }
    ss = wave_sum(ss);
    const float rm = rsqrtf(ss * (1.f / DM) + EPS);
    float s2 = 0.f;
#pragma unroll
    for (int j = 0; j < 4; ++j) {
      xv[j].x += mv[j].x * rm * gv[j].x; xv[j].y += mv[j].y * rm * gv[j].y;
      xv[j].z += mv[j].z * rm * gv[j].z; xv[j].w += mv[j].w * rm * gv[j].w;
      s2 += xv[j].x * xv[j].x + xv[j].y * xv[j].y + xv[j].z * xv[j].z + xv[j].w * xv[j].w;
      ((float4*)(p.out + (size_t)row * DM))[lane + 64 * j] = xv[j];
    }
    if (!LAST) {
      s2 = wave_sum(s2);
      const float r2 = rsqrtf(s2 * (1.f / DM) + EPS);
#pragma unroll
      for (int j = 0; j < 4; ++j) {
        uint2 o; o.x = pack2(xv[j].x * r2, xv[j].y * r2); o.y = pack2(xv[j].z * r2, xv[j].w * r2);
        ((uint2*)(hb + (size_t)row * DM))[lane + 64 * j] = o;
      }
    }
  }
}

DI void phase_mla_stats(const Params& p) {
  const int tid_ = otid();
  const int lane = tid_ & 63;
  const int gw = obid() * 8 + (tid_ >> 6), nw = gridDim.x * 8;
  const u16* c = (const u16*)(p.ws + OFF_R3);
  float* rq = (float*)(p.ws + OFF_RQ);
  float* rkv = (float*)(p.ws + OFF_RKV);
  u16* krope = (u16*)(p.ws + OFF_KROPE);
  const float2* rope = (const float2*)(p.ws + OFF_ROPE);
  for (int row = gw; row < T_TOK; row += nw) {
    const u16* cr = c + (size_t)row * 768;
    const uint4 u0 = ((const uint4*)cr)[lane];
    float s0 = 0.f;
    { float a;
      a = bflo(u0.x); s0 += a * a; a = bfhi(u0.x); s0 += a * a; a = bflo(u0.y); s0 += a * a; a = bfhi(u0.y); s0 += a * a;
      a = bflo(u0.z); s0 += a * a; a = bfhi(u0.z); s0 += a * a; a = bflo(u0.w); s0 += a * a; a = bfhi(u0.w); s0 += a * a; }
    float s1 = 0.f;
    if (lane < 16) {
      const uint4 u1 = ((const uint4*)cr)[64 + lane];
      float a;
      a = bflo(u1.x); s1 += a * a; a = bfhi(u1.x); s1 += a * a; a = bflo(u1.y); s1 += a * a; a = bfhi(u1.y); s1 += a * a;
      a = bflo(u1.z); s1 += a * a; a = bfhi(u1.z); s1 += a * a; a = bflo(u1.w); s1 += a * a; a = bfhi(u1.w); s1 += a * a;
    }
    const float sq = wave_sum(lane < 48 ? s0 : 0.f);
    const float skv = wave_sum((lane >= 48 ? s0 : 0.f) + s1);
    if (lane == 0) {
      rq[row] = rsqrtf(sq * (1.f / 384.f) + EPS);
      rkv[row] = rsqrtf(skv * (1.f / 256.f) + EPS);
    }
    if (lane < 16) {
      const float x1 = __uint_as_float((unsigned)cr[640 + lane] << 16);
      const float x2 = __uint_as_float((unsigned)cr[656 + lane] << 16);
      const float2 cs = rope[tok_pos(row) * 16 + lane];
      krope[(size_t)row * 32 + lane] = f2bf(x1 * cs.x - x2 * cs.y);
      krope[(size_t)row * 32 + 16 + lane] = f2bf(x2 * cs.x + x1 * cs.y);
    }
  }
}

DI void store_tok(u16* out, int ldo, int m, int nbase, const f32x16& v, float sc) {
  u16* q = out + (size_t)m * ldo + nbase;
#pragma unroll
  for (int g = 0; g < 4; ++g) {
    uint2 u; u.x = pack2(v[4 * g] * sc, v[4 * g + 1] * sc); u.y = pack2(v[4 * g + 2] * sc, v[4 * g + 3] * sc);
    *(uint2*)(q + 8 * g) = u;
  }
}
DI void store_tr(u16* outT, size_t ldt, int n, int mbase, const f32x16& v, const float* __restrict__ rs) {
  u16* q = outT + (size_t)n * ldt + mbase;
#pragma unroll
  for (int g = 0; g < 4; ++g) {
    float4 s = make_float4(1.f, 1.f, 1.f, 1.f);
    if (rs) s = *(const float4*)(rs + mbase + 8 * g);
    uint2 u; u.x = pack2(v[4 * g] * s.x, v[4 * g + 1] * s.y); u.y = pack2(v[4 * g + 2] * s.z, v[4 * g + 3] * s.w);
    *(uint2*)(q + 8 * g) = u;
  }
}

struct EpiTok {
  u16* out; int ldo;
  static constexpr int SWAPMODE = 1;
  DI bool swap(int) const { return true; }
  template <int WMB, int WNB>
  DI void store(int m0w, int n0w, f32x16 (&acc)[WMB][WNB], int r, int h, bool) const {
#pragma unroll
    for (int mb = 0; mb < WMB; ++mb)
#pragma unroll
      for (int nb = 0; nb < WNB; ++nb) store_tok(out, ldo, m0w + mb * 32 + r, n0w + nb * 32 + 4 * h, acc[mb][nb], 1.f);
  }
};

struct EpiProj0 {
  u16* base;
  static constexpr int SWAPMODE = 2;
  DI bool swap(int n0w) const { const int reg = n0w >> 9; return !(reg == 2 || reg == 5); }
  template <int WMB, int WNB>
  DI void store(int m0w, int n0w, f32x16 (&acc)[WMB][WNB], int r, int h, bool sw) const {
    const int reg = n0w >> 9, nl = n0w & 511;
    u16* buf = base + (size_t)reg * SEG512;
    if (sw) {
      const float sc = (reg == 0 || reg == 3) ? QSCALE64 : 1.f;
#pragma unroll
      for (int mb = 0; mb < WMB; ++mb)
#pragma unroll
        for (int nb = 0; nb < WNB; ++nb) store_tok(buf, 512, m0w + mb * 32 + r, nl + nb * 32 + 4 * h, acc[mb][nb], sc);
    } else {
#pragma unroll
      for (int mb = 0; mb < WMB; ++mb)
#pragma unroll
        for (int nb = 0; nb < WNB; ++nb) store_tr(buf, T_TOK, nl + nb * 32 + r, m0w + mb * 32 + 4 * h, acc[mb][nb], nullptr);
    }
  }
};

struct EpiSwiGLU {
  u16* act;
  static constexpr int SWAPMODE = 1;
  DI bool swap(int) const { return true; }
  template <int WMB, int WNB>
  DI void store(int m0w, int n0w, f32x16 (&acc)[WMB][WNB], int r, int h, bool) const {
    static_assert(WNB == 2, "swiglu epilogue needs a 64-wide wave tile");
#pragma unroll
    for (int mb = 0; mb < WMB; ++mb) {
      u16* q = act + (size_t)(m0w + mb * 32 + r) * DFF + (n0w >> 1) + 4 * h;
#pragma unroll
      for (int g = 0; g < 4; ++g) {
        float y[4];
#pragma unroll
        for (int e = 0; e < 4; ++e) {
          const float gt = acc[mb][0][4 * g + e], up = acc[mb][1][4 * g + e];
          y[e] = gt / (1.f + __expf(-gt)) * up;
        }
        uint2 u; u.x = pack2(y[0], y[1]); u.y = pack2(y[2], y[3]);
        *(uint2*)(q + 8 * g) = u;
      }
    }
  }
};

struct EpiUQ {
  u16* q; const float* rq; const float2* rope;
  static constexpr int SWAPMODE = 1;
  DI bool swap(int) const { return true; }
  template <int WMB, int WNB>
  DI void store(int m0w, int n0w, f32x16 (&acc)[WMB][WNB], int r, int h, bool) const {
#pragma unroll
    for (int mb = 0; mb < WMB; ++mb) {
      const int m = m0w + mb * 32 + r;
      const float sc = rq[m] * QSCALE96;
      const int pos = tok_pos(m);
#pragma unroll
      for (int nb = 0; nb < WNB; ++nb) {
        const int n0b = n0w + nb * 32;
        f32x16 v = acc[mb][nb];
#pragma unroll
        for (int i = 0; i < 16; ++i) v[i] *= sc;
        if (((n0b >> 5) % 3) == 2) {
#pragma unroll
          for (int i = 0; i < 8; ++i) {
            const int f = (i & 3) + 8 * (i >> 2) + 4 * h;
            const float2 cs = rope[pos * 16 + f];
            const float x1 = v[i], x2 = v[i + 8];
            v[i] = x1 * cs.x - x2 * cs.y;
            v[i + 8] = x2 * cs.x + x1 * cs.y;
          }
        }
        store_tok(q, 1536, m, n0b + 4 * h, v, 1.f);
      }
    }
  }
};

struct EpiUKV {
  u16* knope; u16* vt; const float* rkv;
  static constexpr int SWAPMODE = 2;
  DI bool swap(int n0) const { return n0 < 1024; }
  template <int WMB, int WNB>
  DI void store(int m0w, int n0w, f32x16 (&acc)[WMB][WNB], int r, int h, bool sw) const {
    if (sw) {
#pragma unroll
      for (int mb = 0; mb < WMB; ++mb) {
        const int m = m0w + mb * 32 + r;
        const float sc = rkv[m];
#pragma unroll
        for (int nb = 0; nb < WNB; ++nb) store_tok(knope, 1024, m, n0w + nb * 32 + 4 * h, acc[mb][nb], sc);
      }
    } else {
#pragma unroll
      for (int mb = 0; mb < WMB; ++mb)
#pragma unroll
        for (int nb = 0; nb < WNB; ++nb) store_tr(vt, T_TOK, n0w - 1024 + nb * 32 + r, m0w + mb * 32 + 4 * h, acc[mb][nb], rkv);
    }
  }
};

template <bool SWAP, int WMB, int WNB>
DI void gemm_compute(const char* la, const char* lb, f32x16 (&acc)[WMB][WNB], int wm, int wn, int r, int h) {
#pragma unroll
  for (int ks = 0; ks < 4; ++ks) {
    bf16x8 af[WMB], bfr[WNB];
#pragma unroll
    for (int mb = 0; mb < WMB; ++mb) af[mb] = *(const bf16x8*)(la + (wm * 32 * WMB + mb * 32 + r) * 144 + (ks * 2 + h) * 16);
#pragma unroll
    for (int nb = 0; nb < WNB; ++nb) bfr[nb] = *(const bf16x8*)(lb + (wn * 32 * WNB + nb * 32 + r) * 144 + (ks * 2 + h) * 16);
#pragma unroll
    for (int mb = 0; mb < WMB; ++mb)
#pragma unroll
      for (int nb = 0; nb < WNB; ++nb) {
        if (SWAP) acc[mb][nb] = MFMA32(bfr[nb], af[mb], acc[mb][nb]);
        else acc[mb][nb] = MFMA32(af[mb], bfr[nb], acc[mb][nb]);
      }
  }
}

template <bool SWAP, class Epi>
DI void gemm_tile(const u16* __restrict__ ag, int lda, const u16* __restrict__ bg, int ldb, int nk, int m0, int n0, const Epi& epi, char* lds) {
  constexpr int WMB = 4, WNB = 2;
  constexpr int TM = 256, TN = 256;
  constexpr int STAGE = (TM + TN) * 144;
  const int tid = otid(), lane = tid & 63, w = tid >> 6, wm = w >> 2, wn = w & 3, r = lane & 31, h = lane >> 5;
  const int lrow = tid >> 3, lch = tid & 7;
  u32x4 pa[4], pb[4];
  f32x16 acc[WMB][WNB];
#pragma unroll
  for (int mb = 0; mb < WMB; ++mb)
#pragma unroll
    for (int nb = 0; nb < WNB; ++nb)
#pragma unroll
      for (int i = 0; i < 16; ++i) acc[mb][nb][i] = 0.f;
#pragma unroll
  for (int j = 0; j < 4; ++j) pa[j] = *(const u32x4*)(ag + (size_t)j * 64 * lda);
#pragma unroll
  for (int j = 0; j < 4; ++j) pb[j] = *(const u32x4*)(bg + (size_t)j * 64 * ldb);
  {
    char* la = lds; char* lb = lds + TM * 144;
#pragma unroll
    for (int j = 0; j < 4; ++j) *(u32x4*)(la + (lrow + 64 * j) * 144 + lch * 16) = pa[j];
#pragma unroll
    for (int j = 0; j < 4; ++j) *(u32x4*)(lb + (lrow + 64 * j) * 144 + lch * 16) = pb[j];
  }
  if (nk > 1) {
#pragma unroll
    for (int j = 0; j < 4; ++j) pa[j] = *(const u32x4*)(ag + (size_t)j * 64 * lda + 64);
#pragma unroll
    for (int j = 0; j < 4; ++j) pb[j] = *(const u32x4*)(bg + (size_t)j * 64 * ldb + 64);
  }
  __syncthreads();
  for (int kt = 0; kt < nk; ++kt) {
    const char* la = lds + (kt & 1) * STAGE;
    const char* lb = la + TM * 144;
    gemm_compute<SWAP, WMB, WNB>(la, lb, acc, wm, wn, r, h);
    if (kt + 1 < nk) {
      char* wa = lds + ((kt + 1) & 1) * STAGE;
      char* wb = wa + TM * 144;
#pragma unroll
      for (int j = 0; j < 4; ++j) *(u32x4*)(wa + (lrow + 64 * j) * 144 + lch * 16) = pa[j];
#pragma unroll
      for (int j = 0; j < 4; ++j) *(u32x4*)(wb + (lrow + 64 * j) * 144 + lch * 16) = pb[j];
    }
    if (kt + 2 < nk) {
#pragma unroll
      for (int j = 0; j < 4; ++j) pa[j] = *(const u32x4*)(ag + (size_t)j * 64 * lda + (kt + 2) * 64);
#pragma unroll
      for (int j = 0; j < 4; ++j) pb[j] = *(const u32x4*)(bg + (size_t)j * 64 * ldb + (kt + 2) * 64);
    }
    __syncthreads();
  }
  epi.template store<WMB, WNB>(m0 + wm * 32 * WMB, n0 + wn * 32 * WNB, acc, r, h, SWAP);
}

template <class Epi>
DI void gemm_phase(const u16* __restrict__ A, int lda, const u16* __restrict__ Bt, int ldb, int M, int N, int K, const Epi epi, char* lds, int bid, int nblk) {
  constexpr int TM = 256, TN = 256;
  const int tid = otid();
  const int NT = N / TN, MT = M / TM, tiles = MT * NT, nk = K >> 6;
  const int lrow = tid >> 3, lch = tid & 7;
  for (int t0 = bid; t0 < ((tiles + nblk - 1) / nblk) * nblk; t0 += nblk) {
    int tile = t0;
    if (nblk == 256) tile = (t0 & ~255) + (bid & 7) * 32 + (bid >> 3);
    if (tile >= tiles) continue;
    const int mt = tile / NT, nt = tile - mt * NT;
    const int m0 = mt * TM, n0 = nt * TN;
    const u16* ag = A + (size_t)(m0 + lrow) * lda + lch * 8;
    const u16* bg = Bt + (size_t)(n0 + lrow) * ldb + lch * 8;
    if (Epi::SWAPMODE == 1) gemm_tile<true>(ag, lda, bg, ldb, nk, m0, n0, epi, lds);
    else if (Epi::SWAPMODE == 0) gemm_tile<false>(ag, lda, bg, ldb, nk, m0, n0, epi, lds);
    else { if (epi.swap(n0)) gemm_tile<true>(ag, lda, bg, ldb, nk, m0, n0, epi, lds); else gemm_tile<false>(ag, lda, bg, ldb, nk, m0, n0, epi, lds); }
  }
}

typedef __attribute__((ext_vector_type(2))) float f32x2;
typedef __attribute__((ext_vector_type(2))) __bf16 bf16x2_t;
typedef __attribute__((ext_vector_type(2))) unsigned u32x2;
DI unsigned cvt_pk(float a, float b) {
  f32x2 v; v.x = a; v.y = b;
  return __builtin_bit_cast(unsigned, __builtin_convertvector(v, bf16x2_t));
}
DI void lds_st16_as2x8(char* dst, const u32x4 v) {
  u32x2 a; a.x = v.x; a.y = v.y; u32x2 b; b.x = v.z; b.y = v.w;
  *(u32x2*)dst = a;
  *(u32x2*)(dst + 8) = b;
}
constexpr int ATT_STAGE = 35840;
constexpr float DEFER_THR = 8.f;

template <int DQK>
DI void qk_scores_qlds(const char* kl, const char* qsl, f32x16 (&s)[2], int r, int h) {
  constexpr int KS = DQK * 2 + 16;
#pragma unroll
  for (int kb = 0; kb < 2; ++kb) {
#pragma unroll
    for (int ks = 0; ks < DQK / 16; ++ks) {
      const bf16x8 a = *(const bf16x8*)(kl + (32 * kb + r) * KS + (2 * ks + h) * 16);
      const bf16x8 qv = *(const bf16x8*)(qsl + ks * 1024);
      s[kb] = MFMA32(a, qv, s[kb]);
    }
  }
}
template <int DQK>
DI void qk_scores(const char* kl, const bf16x8 (&qf)[DQK / 16], const f32x16& initv, f32x16 (&s)[2], int r, int h) {
  constexpr int KS = DQK * 2 + 16;
#pragma unroll
  for (int kb = 0; kb < 2; ++kb) {
    s[kb] = initv;
#pragma unroll
    for (int ks = 0; ks < DQK / 16; ++ks) {
      const bf16x8 a = *(const bf16x8*)(kl + (32 * kb + r) * KS + (2 * ks + h) * 16);
      s[kb] = MFMA32(a, qf[ks], s[kb]);
    }
  }
}

template <int DV>
DI float softmax_pv(f32x16 (&s)[2], f32x16 (&o)[DV / 32], float& l, bool first, const char* vl, int r, int h) {
  float dret = 0.f;
  float mx = fmaxf(fmaxf(s[0][0], s[0][1]), s[0][2]);
#pragma unroll
  for (int i = 3; i < 15; i += 2) mx = fmaxf(fmaxf(mx, s[0][i]), s[0][i + 1]);
  mx = fmaxf(fmaxf(mx, s[0][15]), s[1][0]);
#pragma unroll
  for (int i = 1; i < 15; i += 2) mx = fmaxf(fmaxf(mx, s[1][i]), s[1][i + 1]);
  mx = fmaxf(mx, s[1][15]);
  const bool need = first || (mx > DEFER_THR);
  if (__any(need)) {
    mx = fmaxf(mx, __shfl_xor(mx, 32));
    float delta;
    if (first) delta = mx;
    else {
      delta = fmaxf(mx, 0.f);
      const float alpha = fexp2(-delta);
      l *= alpha;
#pragma unroll
      for (int d = 0; d < DV / 32; ++d)
#pragma unroll
        for (int i = 0; i < 16; ++i) o[d][i] *= alpha;
    }
#pragma unroll
    for (int kb = 0; kb < 2; ++kb)
#pragma unroll
      for (int i = 0; i < 16; ++i) s[kb][i] -= delta;
    dret = delta;
  }
  float ps = 0.f;
#pragma unroll
  for (int kb = 0; kb < 2; ++kb)
#pragma unroll
    for (int i = 0; i < 16; ++i) { const float e = fexp2(s[kb][i]); s[kb][i] = e; ps += e; }
  l += ps;
  bf16x8 pf[2][2];
#pragma unroll
  for (int kb = 0; kb < 2; ++kb)
#pragma unroll
    for (int st = 0; st < 2; ++st) {
      u32x4 u;
      u.x = cvt_pk(s[kb][8 * st + 0], s[kb][8 * st + 1]); u.y = cvt_pk(s[kb][8 * st + 2], s[kb][8 * st + 3]);
      u.z = cvt_pk(s[kb][8 * st + 4], s[kb][8 * st + 5]); u.w = cvt_pk(s[kb][8 * st + 6], s[kb][8 * st + 7]);
      pf[kb][st] = __builtin_bit_cast(bf16x8, u);
    }
#pragma unroll
  for (int d = 0; d < DV / 32; ++d)
#pragma unroll
    for (int kb = 0; kb < 2; ++kb)
#pragma unroll
      for (int st = 0; st < 2; ++st) {
        const char* vp = vl + (32 * d + r) * 136 + (32 * kb + 16 * st + 4 * h) * 2;
        const u32x2 lo = *(const u32x2*)vp;
        const u32x2 hi = *(const u32x2*)(vp + 16);
        u32x4 u; u.x = lo.x; u.y = lo.y; u.z = hi.x; u.w = hi.y;
        o[d] = MFMA32(__builtin_bit_cast(bf16x8, u), pf[kb][st], o[d]);
      }
  return dret;
}

template <int DV>
DI float softmax_pre(f32x16 (&s)[2], f32x16 (&o)[DV / 32], float& l, bool first) {
  float dret = 0.f;
  float mx = fmaxf(fmaxf(s[0][0], s[0][1]), s[0][2]);
#pragma unroll
  for (int i = 3; i < 15; i += 2) mx = fmaxf(fmaxf(mx, s[0][i]), s[0][i + 1]);
  mx = fmaxf(fmaxf(mx, s[0][15]), s[1][0]);
#pragma unroll
  for (int i = 1; i < 15; i += 2) mx = fmaxf(fmaxf(mx, s[1][i]), s[1][i + 1]);
  mx = fmaxf(mx, s[1][15]);
  const bool need = first || (mx > DEFER_THR);
  if (__any(need)) {
    mx = fmaxf(mx, __shfl_xor(mx, 32));
    float delta;
    if (first) delta = mx;
    else {
      delta = fmaxf(mx, 0.f);
      const float alpha = fexp2(-delta);
      l *= alpha;
#pragma unroll
      for (int d = 0; d < DV / 32; ++d)
#pragma unroll
        for (int i = 0; i < 16; ++i) o[d][i] *= alpha;
    }
#pragma unroll
    for (int kb = 0; kb < 2; ++kb)
#pragma unroll
      for (int i = 0; i < 16; ++i) s[kb][i] -= delta;
    dret = delta;
  }
  return dret;
}
DI void softmax_exp_half(f32x16& s, float& l, bf16x8 (&pf)[2]) {
  float ps = 0.f;
#pragma unroll
  for (int i = 0; i < 16; ++i) { const float e = fexp2(s[i]); s[i] = e; ps += e; }
  l += ps;
#pragma unroll
  for (int st = 0; st < 2; ++st) {
    u32x4 u;
    u.x = cvt_pk(s[8 * st + 0], s[8 * st + 1]); u.y = cvt_pk(s[8 * st + 2], s[8 * st + 3]);
    u.z = cvt_pk(s[8 * st + 4], s[8 * st + 5]); u.w = cvt_pk(s[8 * st + 6], s[8 * st + 7]);
    pf[st] = __builtin_bit_cast(bf16x8, u);
  }
}
template <int DV>
DI void pv_half(const bf16x8 (&pf)[2], f32x16 (&o)[DV / 32], const char* vl, int kb, int r, int h) {
#pragma unroll
  for (int d = 0; d < DV / 32; ++d)
#pragma unroll
    for (int st = 0; st < 2; ++st) {
      const char* vp = vl + (32 * d + r) * 136 + (32 * kb + 16 * st + 4 * h) * 2;
      const u32x2 lo = *(const u32x2*)vp;
      const u32x2 hi = *(const u32x2*)(vp + 16);
      u32x4 u; u.x = lo.x; u.y = lo.y; u.z = hi.x; u.w = hi.y;
      o[d] = MFMA32(__builtin_bit_cast(bf16x8, u), pf[st], o[d]);
    }
}

template <int ABL>
DI void attn_mla_item(const Params& p, int item, char* lds) {
  constexpr int DQK = 96, DV = 64, KS = DQK * 2 + 16;
  const int tid = otid(), lane = tid & 63, w = tid >> 6, r = lane & 31, h = lane >> 5;
  int head, qb, ts0, S;
  if (item < 1024) { head = item >> 6; qb = item & 63; ts0 = T_PROMPT; S = 16384; }
  else { const int it = item - 1024; qb = it & 15; head = (it >> 4) & 15; ts0 = (it >> 8) * 4096; S = 4096; }
  const u16* q = (const u16*)(p.ws + OFF_R2);
  const u16* knope = q + (size_t)T_TOK * 1536;
  const u16* vt = knope + (size_t)T_TOK * 1024;
  const u16* krope = (const u16*)(p.ws + OFF_KROPE);
  u16* o1 = (u16*)(p.ws + OFF_R1);
  const int tq = ts0 + qb * 256 + w * 32 + r;
  bf16x8 qf[DQK / 16];
#pragma unroll
  for (int ks = 0; ks < DQK / 16; ++ks) qf[ks] = *(const bf16x8*)(q + (size_t)tq * 1536 + head * 96 + 16 * ks + 8 * h);
  f32x16 o[DV / 32];
#pragma unroll
  for (int d = 0; d < DV / 32; ++d)
#pragma unroll
    for (int i = 0; i < 16; ++i) o[d][i] = 0.f;
  f32x16 initv;
#pragma unroll
  for (int i = 0; i < 16; ++i) initv[i] = 0.f;
  float l = 0.f;
  u32x4 pk0, pk1, pv0;
  const int c1 = 512 + tid;
  const int krow0 = tid / 12, kch0 = tid - krow0 * 12;
  const int krow1 = c1 / 12, kch1 = c1 - krow1 * 12;
  const int vrow = tid >> 3, vch = tid & 7;
  const int nkt = S >> 6;
  auto prefetch = [&](int kt) {
    const int tk0 = ts0 + kt * 64;
    {
      const u16* src = kch0 < 8 ? knope + (size_t)(tk0 + krow0) * 1024 + head * 64 + kch0 * 8 : krope + (size_t)(tk0 + krow0) * 32 + (kch0 - 8) * 8;
      pk0 = *(const u32x4*)src;
    }
    if (tid < 256) {
      const u16* src = kch1 < 8 ? knope + (size_t)(tk0 + krow1) * 1024 + head * 64 + kch1 * 8 : krope + (size_t)(tk0 + krow1) * 32 + (kch1 - 8) * 8;
      pk1 = *(const u32x4*)src;
    }
    pv0 = *(const u32x4*)(vt + (size_t)(head * 64 + vrow) * T_TOK + tk0 + vch * 8);
  };
  auto stage_at = [&](int boff) {
    char* kl = lds + boff;
    char* vl = kl + 64 * KS;
    *(u32x4*)(kl + krow0 * KS + kch0 * 16) = pk0;
    if (tid < 256) *(u32x4*)(kl + krow1 * KS + kch1 * 16) = pk1;
    lds_st16_as2x8(vl + vrow * 136 + vch * 16, pv0);
  };
  prefetch(0);
  __syncthreads();
  stage_at(0);
  prefetch(1);
  stage_at(ATT_STAGE);
  if (nkt > 2) prefetch(2);
  __syncthreads();
  int cur = 0, nxt = ATT_STAGE, nn = 2 * ATT_STAGE;
  f32x16 s[2];
  qk_scores<DQK>(lds, qf, initv, s, r, h);
#pragma unroll 1
  for (int kt = 0; kt < nkt; ++kt) {
    if (ABL == 2) { __syncthreads(); if (kt + 2 < nkt) stage_at(nn); if (kt + 3 < nkt) prefetch(kt + 3); { const int t = cur; cur = nxt; nxt = nn; nn = t; } continue; }
    const float dl = softmax_pre<DV>(s, o, l, kt == 0);
    if (__any(dl != 0.f)) {
#pragma unroll
      for (int i = 0; i < 16; ++i) initv[i] -= dl;
    }
    f32x16 sn[2];
    qk_scores<DQK>(lds + nxt, qf, initv, sn, r, h);
#pragma unroll
    for (int kb = 0; kb < 2; ++kb) {
      bf16x8 pf[2];
      softmax_exp_half(s[kb], l, pf);
      pv_half<DV>(pf, o, lds + cur + 64 * KS, kb, r, h);
    }
    if (ABL != 1) { if (kt + 2 < nkt) stage_at(nn);
    if (kt + 3 < nkt) prefetch(kt + 3); }
    __syncthreads();
    s[0] = sn[0]; s[1] = sn[1];
    const int t = cur; cur = nxt; nxt = nn; nn = t;
  }
  l += __shfl_xor(l, 32);
  const float inv = 1.f / l;
#pragma unroll
  for (int d = 0; d < DV / 32; ++d) store_tok(o1, 1024, tq, head * 64 + 32 * d + 4 * h, o[d], inv);
}

DI void attn_diff_item(const Params& p, int item, char* lds) {
  constexpr int DQK = 64, DV = 128, KS = DQK * 2 + 16;
  const int tid = otid(), lane = tid & 63, w = tid >> 6, r = lane & 31, h = lane >> 5;
  const int map = w >> 2, qw = w & 3;
  int hh, qb, ts0, S;
  if (item < 512) { hh = item >> 7; qb = item & 127; ts0 = T_PROMPT; S = 16384; }
  else { const int it = item - 512; qb = it & 31; hh = (it >> 5) & 3; ts0 = (it >> 7) * 4096; S = 4096; }
  const u16* base = (const u16*)(p.ws + OFF_R2);
  const u16* dq = base + 3 * SEG512;
  const u16* dk = base + 4 * SEG512;
  const u16* vtd = base + 5 * SEG512;
  u16* o0 = (u16*)(p.ws + OFF_R1);
  const int qpos = qb * 128 + qw * 32 + r;
  const int tq = ts0 + qpos;
  char* qsl = lds + 3 * ATT_STAGE + 4096 + w * 4096 + lane * 16;
  __syncthreads();
#pragma unroll
  for (int ks = 0; ks < DQK / 16; ++ks) *(bf16x8*)(qsl + ks * 1024) = *(const bf16x8*)(dq + (size_t)tq * 512 + (2 * hh + map) * 64 + 16 * ks + 8 * h);
  f32x16 o[DV / 32];
#pragma unroll
  for (int d = 0; d < DV / 32; ++d)
#pragma unroll
    for (int i = 0; i < 16; ++i) o[d][i] = 0.f;
  float l = 0.f;
  float ref = 0.f;
  const float slope2 = exp2f(-2.f * (float)(hh + 1)) * LOG2E;
  const float cq = slope2 * (float)qpos;
  const int d0 = 2 * qb;
  const int kd = d0 + (qw >> 1);
  const int nkt = S >> 6;
  u32x4 pk[2], pv[2];
  const int lrow = tid >> 3, lch = tid & 7;
  auto tile_of = [&](int idx) { return idx < 2 ? d0 + idx : (idx - 2 < d0 ? d0 - 1 - (idx - 2) : idx); };
  const unsigned koff = (unsigned)(((ts0 + lrow) * 512 + 2 * hh * 64 + lch * 8) * 2);
  const unsigned voff = (unsigned)((((hh * 128 + lrow) * T_TOK) + ts0 + lch * 8) * 2);
  const char* dkb = (const char*)dk;
  const char* vtb = (const char*)vtd;
  auto prefetch = [&](int kt) {
    const unsigned ko = koff + (unsigned)kt * (64u * 512u * 2u);
    const unsigned vo = voff + (unsigned)kt * 128u;
    pk[0] = *(const u32x4*)(dkb + ko);
    pk[1] = *(const u32x4*)(dkb + ko + 128u);
    pv[0] = *(const u32x4*)(vtb + vo);
    pv[1] = *(const u32x4*)(vtb + vo + (unsigned)(64 * T_TOK * 2));
  };
  auto stage_at = [&](int boff) {
    char* kl0 = lds + boff;
    char* vl = kl0 + 2 * 64 * KS;
#pragma unroll
    for (int j = 0; j < 2; ++j) *(u32x4*)(kl0 + j * 64 * KS + lrow * KS + lch * 16) = pk[j];
#pragma unroll
    for (int j = 0; j < 2; ++j) lds_st16_as2x8(vl + (lrow + 64 * j) * 136 + lch * 16, pv[j]);
  };
  auto scores = [&](int kt, int boff, f32x16 (&sc)[2]) {
    const int side = kt < kd ? -1 : (kt > kd ? 1 : 0);
    const float I = (float)side * cq - ref;
    const unsigned i_hi = cvt_pk(I, 0.f) & 0xffffu;
    const float ir1 = I - __uint_as_float(i_hi << 16);
    const unsigned i_mid = cvt_pk(ir1, 0.f) & 0xffffu;
    const float ir2 = ir1 - __uint_as_float(i_mid << 16);
    const unsigned i_lo = cvt_pk(ir2, 0.f) & 0xffffu;
    const float T = slope2 * (float)(kt * 64);
    const unsigned t_hi = cvt_pk(T, 0.f) & 0xffffu;
    const float r1 = T - __uint_as_float(t_hi << 16);
    const unsigned t_mid = cvt_pk(r1, 0.f) & 0xffffu;
    const float r2 = r1 - __uint_as_float(t_mid << 16);
    const unsigned t_lo = cvt_pk(r2, 0.f) & 0xffffu;
    const unsigned one = side < 0 ? 0x3F80u : (side > 0 ? 0xBF80u : 0u);
    u32x4 qa;
    qa.x = h == 0 ? (one | (one << 16)) : 0u; qa.y = qa.x; qa.z = h == 0 ? (one | (i_hi << 16)) : 0u; qa.w = h == 0 ? (i_mid | (i_lo << 16)) : 0u;
    const bf16x8 qaug = __builtin_bit_cast(bf16x8, qa);
#pragma unroll
    for (int kb = 0; kb < 2; ++kb) {
      const float xl = slope2 * (float)(32 * kb + r);
      const unsigned l_hi = cvt_pk(xl, 0.f) & 0xffffu;
      const unsigned l_lo = cvt_pk(xl - __uint_as_float(l_hi << 16), 0.f) & 0xffffu;
      u32x4 ka; ka.x = h == 0 ? (l_hi | (l_lo << 16)) : 0u; ka.y = h == 0 ? (t_hi | (t_mid << 16)) : 0u; ka.z = h == 0 ? (t_lo | 0x3F800000u) : 0u; ka.w = h == 0 ? 0x3F803F80u : 0u;
      f32x16 z;
#pragma unroll
      for (int i = 0; i < 16; ++i) z[i] = 0.f;
      sc[kb] = MFMA32(__builtin_bit_cast(bf16x8, ka), qaug, z);
    }
    qk_scores_qlds<DQK>(lds + boff + map * 64 * KS, qsl, sc, r, h);
  };
  prefetch(tile_of(0));
  __syncthreads();
  stage_at(0);
  prefetch(tile_of(1));
  stage_at(ATT_STAGE);
  if (nkt > 2) prefetch(tile_of(2));
  __syncthreads();
  int cur = 0, nxt = ATT_STAGE, nn = 2 * ATT_STAGE;
  f32x16 s[2];
  scores(tile_of(0), 0, s);
#pragma unroll 1
  for (int idx = 0; idx < nkt; ++idx) {
    const int kt = tile_of(idx);
    if (kt == kd) {
#pragma unroll
      for (int kb = 0; kb < 2; ++kb)
#pragma unroll
        for (int i = 0; i < 16; ++i) {
          const int kp = kt * 64 + 32 * kb + (i & 3) + 8 * (i >> 2) + 4 * h;
          s[kb][i] -= slope2 * fabsf((float)(qpos - kp));
        }
    }
    ref += softmax_pre<DV>(s, o, l, idx == 0);
    f32x16 sn[2];
    scores(tile_of(min(idx + 1, nkt - 1)), nxt, sn);
#pragma unroll
    for (int kb = 0; kb < 2; ++kb) {
      bf16x8 pf[2];
      softmax_exp_half(s[kb], l, pf);
      pv_half<DV>(pf, o, lds + cur + 2 * 64 * KS, kb, r, h);
    }
    if (idx + 2 < nkt) stage_at(nn);
    if (idx + 3 < nkt) prefetch(tile_of(idx + 3));
    __syncthreads();
    s[0] = sn[0]; s[1] = sn[1];
    const int t = cur; cur = nxt; nxt = nn; nn = t;
  }
  l += __shfl_xor(l, 32);
  const float inv = 1.f / l;
  int tid2 = otid();
  const int lane2 = tid2 & 63, qw2 = (tid2 >> 6) & 3, h2 = lane2 >> 5;
  int item2 = item; asm volatile("" : "+s"(item2));
  int hh2, tq2;
  if (item2 < 512) { hh2 = item2 >> 7; tq2 = T_PROMPT + (item2 & 127) * 128 + qw2 * 32 + (lane2 & 31); }
  else { const int it = item2 - 512; hh2 = (it >> 5) & 3; tq2 = (it >> 7) * 4096 + (it & 31) * 128 + qw2 * 32 + (lane2 & 31); }
  float* ex = (float*)lds + qw2 * 4096;
  if (map == 1) {
#pragma unroll
    for (int d = 0; d < DV / 32; ++d)
#pragma unroll
      for (int i = 0; i < 16; ++i) ex[(d * 16 + i) * 64 + lane2] = o[d][i] * inv;
  }
  __syncthreads();
  if (map == 0) {
    const float lam = ((const float*)(p.ws + OFF_SCAL))[0];
    float ss = 0.f;
#pragma unroll
    for (int d = 0; d < DV / 32; ++d)
#pragma unroll
      for (int i = 0; i < 16; ++i) { const float v = o[d][i] * inv - lam * ex[(d * 16 + i) * 64 + lane2]; o[d][i] = v; ss += v * v; }
    ss += __shfl_xor(ss, 32);
    const float rn = rsqrtf(ss * (1.f / 128.f) + EPS) * 0.8f;
    const float* gs = (const float*)(p.ws + OFF_SCAL) + SC_GSUB;
#pragma unroll
    for (int d = 0; d < DV / 32; ++d) {
#pragma unroll
      for (int g = 0; g < 4; ++g) {
        const float4 gv = *(const float4*)(gs + 32 * d + 8 * g + 4 * h2);
        o[d][4 * g] *= gv.x; o[d][4 * g + 1] *= gv.y; o[d][4 * g + 2] *= gv.z; o[d][4 * g + 3] *= gv.w;
      }
      store_tok(o0, 1024, tq2, 512 + hh2 * 128 + 32 * d + 4 * h2, o[d], rn);
    }
  }
}

DI void attn_na_item(const Params& p, int item, char* lds) {
  constexpr int DQK = 64, DV = 64, KS = DQK * 2 + 16;
  const int tid = otid(), lane = tid & 63, w = tid >> 6, r = lane & 31, h = lane >> 5;
  const int quad = item % 320, head = item / 320;
  const int t0 = quad * 256;
  int ts0, rows;
  if (t0 < T_PROMPT) { ts0 = t0 & ~4095; rows = 64; } else { ts0 = T_PROMPT; rows = 256; }
  const int r0 = (t0 - ts0) >> 6;
  const int rw = r0 + (w >> 1);
  const int rs_lo = min(max(r0 - 4, 0), rows - 8);
  const int rs_hi = min(max(r0 + 3 - 4, 0), rows - 8);
  const int rs_w = min(max(rw - 4, 0), rows - 8);
  const int ntile = rs_hi + 8 - rs_lo;
  const u16* base = (const u16*)(p.ws + OFF_R2);
  const u16* qn = base;
  const u16* kn = base + SEG512;
  const u16* vtn = base + 2 * SEG512;
  u16* o0 = (u16*)(p.ws + OFF_R1);
  float* tab = (float*)(lds + 2 * ATT_STAGE) + 64;
  const int qc = (w & 1) * 32 + r;
  const int tq = t0 + w * 32 + r;
  bf16x8 qf[DQK / 16];
#pragma unroll
  for (int ks = 0; ks < DQK / 16; ++ks) qf[ks] = *(const bf16x8*)(qn + (size_t)tq * 512 + head * 64 + 16 * ks + 8 * h);
  f32x16 o[DV / 32];
#pragma unroll
  for (int d = 0; d < DV / 32; ++d)
#pragma unroll
    for (int i = 0; i < 16; ++i) o[d][i] = 0.f;
  f32x16 initv;
#pragma unroll
  for (int i = 0; i < 16; ++i) initv[i] = 0.f;
  float l = 0.f;
  bool first = true;
  u32x4 pk0, pv0;
  const int lrow = tid >> 3, lch = tid & 7;
  auto prefetch = [&](int j) {
    const int tk0 = ts0 + (rs_lo + j) * 64;
    pk0 = *(const u32x4*)(kn + (size_t)(tk0 + lrow) * 512 + head * 64 + lch * 8);
    pv0 = *(const u32x4*)(vtn + (size_t)(head * 64 + lrow) * T_TOK + tk0 + lch * 8);
  };
  auto stage = [&](int b) {
    char* kl = lds + b * ATT_STAGE;
    char* vl = kl + 64 * KS;
    *(u32x4*)(kl + lrow * KS + lch * 16) = pk0;
    lds_st16_as2x8(vl + lrow * 136 + lch * 16, pv0);
  };
  prefetch(0);
  __syncthreads();
  if (tid < 465) tab[tid] = ((const float*)(p.ws + OFF_SCAL))[SC_RPB + head * 465 + tid];
  stage(0);
  prefetch(1);
  __syncthreads();
  const int wc0 = min(max(qc - 8, 0), 48);
  const float* tabq = tab + (15 - qc + 4 * h);
  for (int j = 0; j < ntile; ++j) {
    const char* kl = lds + (j & 1) * ATT_STAGE;
    const char* vl = kl + 64 * KS;
    const int kr = rs_lo + j;
    if (kr >= rs_w && kr < rs_w + 8) {
      f32x16 s[2];
      qk_scores<DQK>(kl, qf, initv, s, r, h);
      const int ridx = kr - rw + 7;
#pragma unroll
      for (int kb = 0; kb < 2; ++kb)
#pragma unroll
        for (int i = 0; i < 16; ++i) {
          const int kc = 32 * kb + (i & 3) + 8 * (i >> 2) + 4 * h;
          const bool ok = (unsigned)(kc - wc0) < 16u;
          const float b = tabq[ridx * 31 + 32 * kb + (i & 3) + 8 * (i >> 2)];
          s[kb][i] = ok ? s[kb][i] + b : -INFINITY;
        }
      {
        const float dl = softmax_pv<DV>(s, o, l, first, vl, r, h);
        if (__any(dl != 0.f)) {
#pragma unroll
          for (int i = 0; i < 16; ++i) initv[i] -= dl;
        }
      }
      first = false;
    }
    if (j + 1 < ntile) stage((j + 1) & 1);
    if (j + 2 < ntile) prefetch(j + 2);
    __syncthreads();
  }
  l += __shfl_xor(l, 32);
  const float inv = 1.f / l;
#pragma unroll
  for (int d = 0; d < DV / 32; ++d) store_tok(o0, 1024, tq, head * 64 + 32 * d + 4 * h, o[d], inv);
}

constexpr int LDS_BYTES = 2 * (256 + 256) * 144;
template <int PH>
DI void run_phase(const Params& p, char* lds) {
  const int bid = obid(), nblk = gridDim.x;
  u16* wb = (u16*)p.ws;
  u16* R1 = (u16*)(p.ws + OFF_R1);
  u16* R2 = (u16*)(p.ws + OFF_R2);
  u16* R3 = (u16*)(p.ws + OFF_R3);
  if constexpr (PH == 0) phase_prep(p);
  else if constexpr (PH == 1) gemm_phase(R1, 1024, wb + W0IN, 1024, T_TOK, 3072, 1024, EpiProj0{R2}, lds, bid, nblk);
  else if constexpr (PH == 2) {
    for (int it = bid; it < 5120; it += nblk) {
      if (it < 2560) {
        int itm = it;
        if (nblk == 256) {
          const int rnd = it >> 8, x = bid & 7, j = bid >> 3;
          itm = rnd < 2 ? (2 * rnd + (x >> 2)) * 128 + (x & 3) * 32 + j : 512 + ((2 * (rnd - 2) + (x >> 2)) * 4 + (x & 3)) * 32 + j;
        }
        attn_diff_item(p, itm, lds);
      }
      else attn_na_item(p, it - 2560, lds);
    }
  }
  else if constexpr (PH == 3) gemm_phase(R1, 1024, wb + W0OUT, 1024, T_TOK, 1024, 1024, EpiTok{R3, 1024}, lds, bid, nblk);
  else if constexpr (PH == 4) phase_res<true, false>(p, R3, (const float*)(p.ws + OFF_SCAL) + SC_G0);
  else if constexpr (PH == 5) gemm_phase(R1, 1024, wb + W0F1, 1024, T_TOK, 5632, 1024, EpiSwiGLU{R2}, lds, bid, nblk);
  else if constexpr (PH == 6) gemm_phase(R2, 2816, wb + W0F2, 2816, T_TOK, 1024, 2816, EpiTok{R3, 1024}, lds, bid, nblk);
  else if constexpr (PH == 7) phase_res<false, false>(p, R3, (const float*)(p.ws + OFF_SCAL) + SC_G1);
  else if constexpr (PH == 8) gemm_phase(R1, 1024, wb + W1DN, 1024, T_TOK, 768, 1024, EpiTok{R3, 768}, lds, bid, nblk);
  else if constexpr (PH == 9) phase_mla_stats(p);
  else if constexpr (PH == 10) {
    gemm_phase(R3, 768, wb + W1UQ, 384, T_TOK, 1536, 384,
                     EpiUQ{R2, (const float*)(p.ws + OFF_RQ), (const float2*)(p.ws + OFF_ROPE)}, lds, bid, nblk);
    gemm_phase(R3 + 384, 768, wb + W1UKV, 256, T_TOK, 2048, 256,
                     EpiUKV{R2 + (size_t)T_TOK * 1536, R2 + (size_t)T_TOK * 2560, (const float*)(p.ws + OFF_RKV)}, lds, bid, nblk);
  }
  else if constexpr (PH == 11) { for (int it = bid; it < 5120; it += nblk) {
      int itm = it;
      if (nblk == 256) {
        const int rnd = it >> 8, x = bid & 7, j = bid >> 3;
        itm = rnd < 4 ? (4 * rnd + (x >> 1)) * 64 + (x & 1) * 32 + j : 1024 + (rnd - 4) * 256 + (2 * x + (j >> 4)) * 16 + (j & 15);
      }
      attn_mla_item<0>(p, itm, lds);
    } }
  else if constexpr (PH == 12) gemm_phase(R1, 1024, wb + W1OUT, 1024, T_TOK, 1024, 1024, EpiTok{R3, 1024}, lds, bid, nblk);
  else if constexpr (PH == 13) phase_res<false, false>(p, R3, (const float*)(p.ws + OFF_SCAL) + SC_G2);
  else if constexpr (PH == 14) gemm_phase(R1, 1024, wb + W1F1, 1024, T_TOK, 5632, 1024, EpiSwiGLU{R2}, lds, bid, nblk);
  else if constexpr (PH == 15) gemm_phase(R2, 2816, wb + W1F2, 2816, T_TOK, 1024, 2816, EpiTok{R3, 1024}, lds, bid, nblk);
  else if constexpr (PH == 16) phase_res<false, true>(p, R3, (const float*)(p.ws + OFF_SCAL) + SC_G3);
}

#if MULTI_LAUNCH
template <int PH>
__global__ void __launch_bounds__(512, 2) k_phase(Params p) {
  extern __shared__ __attribute__((aligned(16))) char lds[];
  run_phase<PH>(p, lds);
}
template <int PH>
static void launch_all(const Params& p, int grid, hipStream_t stream) {
  (void)hipFuncSetAttribute((const void*)k_phase<PH>, hipFuncAttributeMaxDynamicSharedMemorySize, LDS_BYTES);
  hipLaunchKernelGGL(k_phase<PH>, dim3(grid), dim3(512), LDS_BYTES, stream, p);
  if constexpr (PH + 1 < NPHASE) launch_all<PH + 1>(p, grid, stream);
}
#define OCC_KERNEL k_phase<2>
#else
#ifndef PROBE_DUP
#define PROBE_DUP -1
#endif
#ifndef PROBE_DUP2
#define PROBE_DUP2 -1
#endif
template <int PH>
DI void run_from(const Params& p, char* lds) {
  if constexpr (PH == PROBE_DUP || PH == PROBE_DUP2) { run_phase<PH>(p, lds); cg::this_grid().sync(); }
#ifdef PROBE_ABL
  if constexpr (PH == 11) { for (int it = obid(); it < 5120; it += gridDim.x) attn_mla_item<PROBE_ABL>(p, it, lds); cg::this_grid().sync(); }
#endif
  run_phase<PH>(p, lds);
  if constexpr (PH + 1 < NPHASE) { cg::this_grid().sync(); run_from<PH + 1>(p, lds); }
}
__global__ void __launch_bounds__(512, 2) mega(Params p) {
  extern __shared__ __attribute__((aligned(16))) char lds[];
  run_from<0>(p, lds);
}
#define OCC_KERNEL mega
#endif

extern "C" void kernel_launch(void* const* d_in, const int* in_sizes, int n_in, void* d_out, int out_size, void* d_ws, size_t ws_size,
                              hipStream_t stream) {
  static int grid = 0;
  if (grid == 0) {
    if (n_in != 28 || ws_size < WS_NEED) { fprintf(stderr, "kernel_launch: unexpected n_in %d / ws_size %zu (need %zu)\n", n_in, ws_size, (size_t)WS_NEED); grid = -1; return; }
    int dev = 0, cus = 0, per_cu = 0;
    (void)hipGetDevice(&dev);
    (void)hipDeviceGetAttribute(&cus, hipDeviceAttributeMultiprocessorCount, dev);
    (void)hipFuncSetAttribute((const void*)OCC_KERNEL, hipFuncAttributeMaxDynamicSharedMemorySize, LDS_BYTES);
    (void)hipOccupancyMaxActiveBlocksPerMultiprocessor(&per_cu, (const void*)OCC_KERNEL, 512, LDS_BYTES);
    if (per_cu < 1) per_cu = 1;
    if (per_cu > 1) per_cu = 1;
    grid = cus * per_cu;
  }
  if (grid < 0) return;
  Params p{};
  for (int i = 0; i < 28; ++i) p.in[i] = (const float*)d_in[i];
  p.out = (float*)d_out;
  p.ws = (char*)d_ws;
#if MULTI_LAUNCH
  launch_all<0>(p, grid, stream);
#else
  void* args[] = {&p};
  hipError_t e = hipLaunchCooperativeKernel((const void*)mega, dim3(grid), dim3(512), args, LDS_BYTES, stream);
  if (e != hipSuccess) fprintf(stderr, "cooperative launch failed: %s (grid %d)\n", hipGetErrorString(e), grid);
#endif
}
```

```cpp
#include <hip/hip_runtime.h>
#include <hip/hip_cooperative_groups.h>
#include <stdint.h>
#include <cstdio>
namespace cg = cooperative_groups;

#ifndef MULTI_LAUNCH
#define MULTI_LAUNCH 0
#endif

typedef unsigned short u16;
typedef __attribute__((ext_vector_type(8))) short bf16x8;
typedef __attribute__((ext_vector_type(16))) float f32x16;
typedef __attribute__((ext_vector_type(4))) unsigned u32x4;

#define MFMA32(a, b, c) __builtin_amdgcn_mfma_f32_32x32x16_bf16((a), (b), (c), 0, 0, 0)
#define DI __device__ __forceinline__

constexpr int T_TOK = 81920;
constexpr int T_PROMPT = 65536;
constexpr int DM = 1024;
constexpr int DFF = 2816;
constexpr float EPS = 1e-6f;
constexpr float LOG2E = 1.4426950408889634f;
constexpr float QSCALE64 = 0.125f * LOG2E;
constexpr float QSCALE96 = 0.10206207261596577f * LOG2E;
constexpr int NPHASE = 17;

constexpr size_t MiB = (size_t)1 << 20;
constexpr size_t W0IN = 0;
constexpr size_t W0OUT = W0IN + (size_t)3072 * 1024;
constexpr size_t W0F1 = W0OUT + (size_t)1024 * 1024;
constexpr size_t W0F2 = W0F1 + (size_t)5632 * 1024;
constexpr size_t W1DN = W0F2 + (size_t)1024 * 2816;
constexpr size_t W1UQ = W1DN + (size_t)768 * 1024;
constexpr size_t W1UKV = W1UQ + (size_t)1536 * 384;
constexpr size_t W1OUT = W1UKV + (size_t)2048 * 256;
constexpr size_t W1F1 = W1OUT + (size_t)1024 * 1024;
constexpr size_t W1F2 = W1F1 + (size_t)5632 * 1024;
constexpr size_t W_END = W1F2 + (size_t)1024 * 2816;
static_assert(W_END * 2 <= 48 * MiB, "weights region");
constexpr size_t OFF_ROPE = 48 * MiB;
constexpr size_t OFF_RQ = OFF_ROPE + 2 * MiB;
constexpr size_t OFF_RKV = OFF_RQ + MiB / 2;
constexpr size_t OFF_KROPE = OFF_RKV + MiB / 2;
constexpr size_t OFF_SCAL = OFF_KROPE + 5 * MiB;
constexpr int SC_QKMAX = 16, SC_CTR = 32;
constexpr int SC_G0 = 1024, SC_G1 = 2048, SC_G2 = 3072, SC_G3 = 4096, SC_GSUB = 5120, SC_RPB = 6144;
constexpr size_t OFF_R1 = 58 * MiB;
constexpr size_t OFF_R3 = OFF_R1 + 160 * MiB;
constexpr size_t OFF_R2 = OFF_R3 + 160 * MiB;
constexpr size_t WS_NEED = OFF_R2 + 560 * MiB;
constexpr size_t SEG512 = (size_t)T_TOK * 512;

struct Params {
  const float* in[28];
  float* out;
  char* ws;
};

DI u16 f2bf(float x) { unsigned u = __float_as_uint(x); u += 0x7fffu + ((u >> 16) & 1u); return (u16)(u >> 16); }
DI unsigned pack2(float a, float b) { return (unsigned)f2bf(a) | ((unsigned)f2bf(b) << 16); }
DI float bflo(unsigned v) { return __uint_as_float(v << 16); }
DI float bfhi(unsigned v) { return __uint_as_float(v & 0xffff0000u); }
DI float wave_sum(float v) {
#pragma unroll
  for (int o = 32; o; o >>= 1) v += __shfl_xor(v, o);
  return v;
}
DI int tok_pos(int t) { return t < T_PROMPT ? (t & 4095) : (t - T_PROMPT); }
DI float fexp2(float x) { return __builtin_amdgcn_exp2f(x); }
DI int otid() { int t = threadIdx.x; asm volatile("" : "+v"(t)); return t; }
DI int obid() { int b = blockIdx.x; asm volatile("" : "+s"(b)); return b; }

__device__ const float ROPE_INV[16] = {1.0f, 0.5623413324356079f, 0.3162277638912201f, 0.17782793939113617f, 0.10000000149011612f, 0.05623413249850273f, 0.03162277489900589f, 0.017782794311642647f, 0.009999999776482582f, 0.005623413249850273f, 0.003162277629598975f, 0.0017782794311642647f, 0.0010000000474974513f, 0.000562341301701963f, 0.0003162277571391314f, 0.00017782794020604342f};

DI void wconv(const float* __restrict__ W, const float* __restrict__ g, u16* __restrict__ dst, int K, int N, int rowsOut, int perm, int gtid, int gthreads) {
  const int kc = K >> 3;
  const long total = (long)rowsOut * kc;
  for (long c = gtid; c < total; c += gthreads) {
    const int n = (int)(c % rowsOut);
    const int k0 = (int)(c / rowsOut) * 8;
    int sc;
    if (perm == 1) { const int blk = n >> 6, w = n & 63; const int j = blk * 32 + (w & 31); sc = (w < 32) ? j : DFF + j; }
    else if (perm == 2) { const int hd = (n & 1023) >> 6, d = n & 63; sc = hd * 128 + (n >= 1024 ? 64 : 0) + d; }
    else sc = n;
    uint4 o = make_uint4(0, 0, 0, 0);
    if (sc < N) {
      float v[8];
#pragma unroll
      for (int i = 0; i < 8; ++i) { float x = W[(size_t)(k0 + i) * N + sc]; if (g) x *= g[k0 + i]; v[i] = x; }
      o.x = pack2(v[0], v[1]); o.y = pack2(v[2], v[3]); o.z = pack2(v[4], v[5]); o.w = pack2(v[6], v[7]);
    }
    *(uint4*)(dst + (size_t)n * K + k0) = o;
  }
}

DI void phase_prep(const Params& p) {
  const int gtid = obid() * 512 + otid(), gthreads = gridDim.x * 512;
  u16* wb = (u16*)p.ws;
  wconv(p.in[3], p.in[2], wb + W0IN, 1024, 3072, 3072, 0, gtid, gthreads);
  wconv(p.in[10], nullptr, wb + W0OUT, 1024, 1024, 1024, 0, gtid, gthreads);
  wconv(p.in[13], p.in[12], wb + W0F1, 1024, 5632, 5632, 1, gtid, gthreads);
  wconv(p.in[14], nullptr, wb + W0F2, 2816, 1024, 1024, 0, gtid, gthreads);
  wconv(p.in[17], p.in[16], wb + W1DN, 1024, 672, 768, 0, gtid, gthreads);
  wconv(p.in[20], p.in[18], wb + W1UQ, 384, 1536, 1536, 0, gtid, gthreads);
  wconv(p.in[21], p.in[19], wb + W1UKV, 256, 2048, 2048, 2, gtid, gthreads);
  wconv(p.in[22], nullptr, wb + W1OUT, 1024, 1024, 1024, 0, gtid, gthreads);
  wconv(p.in[25], p.in[24], wb + W1F1, 1024, 5632, 5632, 1, gtid, gthreads);
  wconv(p.in[26], nullptr, wb + W1F2, 2816, 1024, 1024, 0, gtid, gthreads);
  float2* rope = (float2*)(p.ws + OFF_ROPE);
  for (int idx = gtid; idx < 16384 * 16; idx += gthreads) {
    const int pos = idx >> 4, i = idx & 15;
    const float ang = (float)pos * ROPE_INV[i];
    double rev = (double)ang * 0.15915494309189535;
    rev -= rint(rev);
    const float rf = (float)rev;
    rope[idx] = make_float2(__builtin_amdgcn_cosf(rf), __builtin_amdgcn_sinf(rf));
  }
  if (gtid == 0) {
    float s1 = 0.f, s2 = 0.f;
    for (int i = 0; i < 64; ++i) { s1 += p.in[5][i] * p.in[6][i]; s2 += p.in[7][i] * p.in[8][i]; }
    float* sc = (float*)(p.ws + OFF_SCAL);
    sc[0] = __expf(s1) - __expf(s2) + 0.2f;
    for (int i = 0; i < 17; ++i) ((unsigned*)sc)[SC_QKMAX + i] = 0u;
  }
  {
    float* sc = (float*)(p.ws + OFF_SCAL);
    for (int i = gtid; i < 1024; i += gthreads) { sc[SC_G0 + i] = p.in[11][i]; sc[SC_G1 + i] = p.in[15][i]; sc[SC_G2 + i] = p.in[23][i]; sc[SC_G3 + i] = p.in[27][i]; }
    for (int i = gtid; i < 128; i += gthreads) sc[SC_GSUB + i] = p.in[9][i];
    for (int i = gtid; i < 8 * 465; i += gthreads) sc[SC_RPB + i] = p.in[4][i] * LOG2E;
  }
  const int tid_ = otid();
  const int lane = tid_ & 63;
  const int gw = obid() * 8 + (tid_ >> 6), nw = gridDim.x * 8;
  u16* hb = (u16*)(p.ws + OFF_R1);
  for (int row = gw; row < T_TOK; row += nw) {
    const float* xr = row < T_PROMPT ? p.in[0] + (size_t)row * DM : p.in[1] + (size_t)(row - T_PROMPT) * DM;
    float4 v[4];
    float ss = 0.f;
#pragma unroll
    for (int j = 0; j < 4; ++j) { v[j] = ((const float4*)xr)[lane + 64 * j]; ss += v[j].x * v[j].x + v[j].y * v[j].y + v[j].z * v[j].z + v[j].w * v[j].w; }
    ss = wave_sum(ss);
    const float r = rsqrtf(ss * (1.f / DM) + EPS);
#pragma unroll
    for (int j = 0; j < 4; ++j) {
      uint2 o; o.x = pack2(v[j].x * r, v[j].y * r); o.y = pack2(v[j].z * r, v[j].w * r);
      ((uint2*)(hb + (size_t)row * DM))[lane + 64 * j] = o;
    }
  }
}

template <bool FIRST, bool LAST>
DI void phase_res(const Params& p, const u16* __restrict__ mbuf, const float* __restrict__ g) {
  const int tid_ = otid();
  const int lane = tid_ & 63;
  const int gw = obid() * 8 + (tid_ >> 6), nw = gridDim.x * 8;
  u16* hb = (u16*)(p.ws + OFF_R1);
  float4 gv[4];
#pragma unroll
  for (int j = 0; j < 4; ++j) gv[j] = ((const float4*)g)[lane + 64 * j];
  for (int row = gw; row < T_TOK; row += nw) {
    const float* xr;
    if (FIRST) xr = row < T_PROMPT ? p.in[0] + (size_t)row * DM : p.in[1] + (size_t)(row - T_PROMPT) * DM;
    else xr = p.out + (size_t)row * DM;
    float4 xv[4], mv[4];
    float ss = 0.f;
#pragma unroll
    for (int j = 0; j < 4; ++j) {
      const uint2 u = ((const uint2*)(mbuf + (size_t)row * DM))[lane + 64 * j];
      mv[j] = make_float4(bflo(u.x), bfhi(u.x), bflo(u.y), bfhi(u.y));
      ss += mv[j].x * mv[j].x + mv[j].y * mv[j].y + mv[j].z * mv[j].z + mv[j].w * mv[j].w;
      xv[j] = ((const float4*)xr)[lane + 64 * j];
    }
    ss = wave_sum(ss);
    const float rm = rsqrtf(ss * (1.f / DM) + EPS);
    float s2 = 0.f;
#pragma unroll
    for (int j = 0; j < 4; ++j) {
      xv[j].x += mv[j].x * rm * gv[j].x; xv[j].y += mv[j].y * rm * gv[j].y;
      xv[j].z += mv[j].z * rm * gv[j].z; xv[j].w += mv[j].w * rm * gv[j].w;
      s2 += xv[j].x * xv[j].x + xv[j].y * xv[j].y + xv[j].z * xv[j].z + xv[j].w * xv[j].w;
      ((float4*)(p.out + (size_t)row * DM))[lane + 64 * j] = xv[j];
    }
    if (!LAST) {
      s2 = wave_sum(s2);
      const float r2 = rsqrtf(s2 * (1.f / DM) + EPS);
#pragma unroll
      for (int j = 0; j < 4; ++j) {
        uint2 o; o.x = pack2(xv[j].x * r2, xv[j].y * r2); o.y = pack2(xv[j].z * r2, xv[j].w * r2);
        ((uint2*)(hb + (size_t)row * DM))[lane + 64 * j] = o;
      }
    }
  }
}

DI void phase_mla_stats(const Params& p) {
  const int tid_ = otid();
  const int lane = tid_ & 63;
  const int gw = obid() * 8 + (tid_ >> 6), nw = gridDim.x * 8;
  const u16* c = (const u16*)(p.ws + OFF_R3);
  float* rq = (float*)(p.ws + OFF_RQ);
  float* rkv = (float*)(p.ws + OFF_RKV);
  u16* krope = (u16*)(p.ws + OFF_KROPE);
  const float2* rope = (const float2*)(p.ws + OFF_ROPE);
  for (int row = gw; row < T_TOK; row += nw) {
    const u16* cr = c + (size_t)row * 768;
    const uint4 u0 = ((const uint4*)cr)[lane];
    float s0 = 0.f;
    { float a;
      a = bflo(u0.x); s0 += a * a; a = bfhi(u0.x); s0 += a * a; a = bflo(u0.y); s0 += a * a; a = bfhi(u0.y); s0 += a * a;
      a = bflo(u0.z); s0 += a * a; a = bfhi(u0.z); s0 += a * a; a = bflo(u0.w); s0 += a * a; a = bfhi(u0.w); s0 += a * a; }
    float s1 = 0.f;
    if (lane < 16) {
      const uint4 u1 = ((const uint4*)cr)[64 + lane];
      float a;
      a = bflo(u1.x); s1 += a * a; a = bfhi(u1.x); s1 += a * a; a = bflo(u1.y); s1 += a * a; a = bfhi(u1.y); s1 += a * a;
      a = bflo(u1.z); s1 += a * a; a = bfhi(u1.z); s1 += a * a; a = bflo(u1.w); s1 += a * a; a = bfhi(u1.w); s1 += a * a;
    }
    const float sq = wave_sum(lane < 48 ? s0 : 0.f);
    const float skv = wave_sum((lane >= 48 ? s0 : 0.f) + s1);
    if (lane == 0) {
      rq[row] = rsqrtf(sq * (1.f / 384.f) + EPS);
      rkv[row] = rsqrtf(skv * (1.f / 256.f) + EPS);
    }
    if (lane < 16) {
      const float x1 = __uint_as_float((unsigned)cr[640 + lane] << 16);
      const float x2 = __uint_as_float((unsigned)cr[656 + lane] << 16);
      const float2 cs = rope[tok_pos(row) * 16 + lane];
      krope[(size_t)row * 32 + lane] = f2bf(x1 * cs.x - x2 * cs.y);
      krope[(size_t)row * 32 + 16 + lane] = f2bf(x2 * cs.x + x1 * cs.y);
    }
  }
}

DI void store_tok(u16* out, int ldo, int m, int nbase, const f32x16& v, float sc) {
  u16* q = out + (size_t)m * ldo + nbase;
#pragma unroll
  for (int g = 0; g < 4; ++g) {
    uint2 u; u.x = pack2(v[4 * g] * sc, v[4 * g + 1] * sc); u.y = pack2(v[4 * g + 2] * sc, v[4 * g + 3] * sc);
    *(uint2*)(q + 8 * g) = u;
  }
}
DI void store_tr(u16* outT, size_t ldt, int n, int mbase, const f32x16& v, const float* __restrict__ rs) {
  u16* q = outT + (size_t)n * ldt + mbase;
#pragma unroll
  for (int g = 0; g < 4; ++g) {
    float4 s = make_float4(1.f, 1.f, 1.f, 1.f);
    if (rs) s = *(const float4*)(rs + mbase + 8 * g);
    uint2 u; u.x = pack2(v[4 * g] * s.x, v[4 * g + 1] * s.y); u.y = pack2(v[4 * g + 2] * s.z, v[4 * g + 3] * s.w);
    *(uint2*)(q + 8 * g) = u;
  }
}

struct EpiTok {
  u16* out; int ldo;
  static constexpr int SWAPMODE = 1;
  DI bool swap(int) const { return true; }
  template <int WMB, int WNB>
  DI void store(int m0w, int n0w, f32x16 (&acc)[WMB][WNB], int r, int h, bool) const {
#pragma unroll
    for (int mb = 0; mb < WMB; ++mb)
#pragma unroll
      for (int nb = 0; nb < WNB; ++nb) store_tok(out, ldo, m0w + mb * 32 + r, n0w + nb * 32 + 4 * h, acc[mb][nb], 1.f);
  }
};

struct EpiProj0 {
  u16* base; unsigned* qkmax;
  static constexpr int SWAPMODE = 2;
  DI bool swap(int n0w) const { const int reg = n0w >> 9; return !(reg == 2 || reg == 5); }
  template <int WMB, int WNB>
  DI void store(int m0w, int n0w, f32x16 (&acc)[WMB][WNB], int r, int h, bool sw) const {
    const int reg = n0w >> 9, nl = n0w & 511;
    u16* buf = base + (size_t)reg * SEG512;
    if (sw) {
      const float sc = (reg == 0 || reg == 3) ? QSCALE64 : 1.f;
#pragma unroll
      for (int mb = 0; mb < WMB; ++mb)
#pragma unroll
        for (int nb = 0; nb < WNB; ++nb) store_tok(buf, 512, m0w + mb * 32 + r, nl + nb * 32 + 4 * h, acc[mb][nb], sc);
      if (reg == 3 || reg == 4) {
        static_assert(WNB == 2, "one head per wave tile");
        float mxn = 0.f;
#pragma unroll
        for (int mb = 0; mb < WMB; ++mb) {
          float ss = 0.f;
#pragma unroll
          for (int nb = 0; nb < WNB; ++nb)
#pragma unroll
            for (int i = 0; i < 16; ++i) { const float v = acc[mb][nb][i] * sc; ss += v * v; }
          ss += __shfl_xor(ss, 32);
          mxn = fmaxf(mxn, ss);
        }
#pragma unroll
        for (int o = 16; o; o >>= 1) mxn = fmaxf(mxn, __shfl_xor(mxn, o));
        if (r == 0 && h == 0) atomicMax(qkmax + (reg - 3) * 8 + (nl >> 6), __float_as_uint(sqrtf(mxn)));
      }
    } else {
#pragma unroll
      for (int mb = 0; mb < WMB; ++mb)
#pragma unroll
        for (int nb = 0; nb < WNB; ++nb) store_tr(buf, T_TOK, nl + nb * 32 + r, m0w + mb * 32 + 4 * h, acc[mb][nb], nullptr);
    }
  }
};

struct EpiSwiGLU {
  u16* act;
  static constexpr int SWAPMODE = 1;
  DI bool swap(int) const { return true; }
  template <int WMB, int WNB>
  DI void store(int m0w, int n0w, f32x16 (&acc)[WMB][WNB], int r, int h, bool) const {
    static_assert(WNB == 2, "swiglu epilogue needs a 64-wide wave tile");
#pragma unroll
    for (int mb = 0; mb < WMB; ++mb) {
      u16* q = act + (size_t)(m0w + mb * 32 + r) * DFF + (n0w >> 1) + 4 * h;
#pragma unroll
      for (int g = 0; g < 4; ++g) {
        float y[4];
#pragma unroll
        for (int e = 0; e < 4; ++e) {
          const float gt = acc[mb][0][4 * g + e], up = acc[mb][1][4 * g + e];
          y[e] = gt / (1.f + __expf(-gt)) * up;
        }
        uint2 u; u.x = pack2(y[0], y[1]); u.y = pack2(y[2], y[3]);
        *(uint2*)(q + 8 * g) = u;
      }
    }
  }
};

struct EpiUQ {
  u16* q; const float* rq; const float2* rope;
  static constexpr int SWAPMODE = 1;
  DI bool swap(int) const { return true; }
  template <int WMB, int WNB>
  DI void store(int m0w, int n0w, f32x16 (&acc)[WMB][WNB], int r, int h, bool) const {
#pragma unroll
    for (int mb = 0; mb < WMB; ++mb) {
      const int m = m0w + mb * 32 + r;
      const float sc = rq[m] * QSCALE96;
      const int pos = tok_pos(m);
#pragma unroll
      for (int nb = 0; nb < WNB; ++nb) {
        const int n0b = n0w + nb * 32;
        f32x16 v = acc[mb][nb];
#pragma unroll
        for (int i = 0; i < 16; ++i) v[i] *= sc;
        if (((n0b >> 5) % 3) == 2) {
#pragma unroll
          for (int i = 0; i < 8; ++i) {
            const int f = (i & 3) + 8 * (i >> 2) + 4 * h;
            const float2 cs = rope[pos * 16 + f];
            const float x1 = v[i], x2 = v[i + 8];
            v[i] = x1 * cs.x - x2 * cs.y;
            v[i + 8] = x2 * cs.x + x1 * cs.y;
          }
        }
        store_tok(q, 1536, m, n0b + 4 * h, v, 1.f);
      }
    }
  }
};

struct EpiUKV {
  u16* knope; u16* vt; const float* rkv;
  static constexpr int SWAPMODE = 2;
  DI bool swap(int n0) const { return n0 < 1024; }
  template <int WMB, int WNB>
  DI void store(int m0w, int n0w, f32x16 (&acc)[WMB][WNB], int r, int h, bool sw) const {
    if (sw) {
#pragma unroll
      for (int mb = 0; mb < WMB; ++mb) {
        const int m = m0w + mb * 32 + r;
        const float sc = rkv[m];
#pragma unroll
        for (int nb = 0; nb < WNB; ++nb) store_tok(knope, 1024, m, n0w + nb * 32 + 4 * h, acc[mb][nb], sc);
      }
    } else {
#pragma unroll
      for (int mb = 0; mb < WMB; ++mb)
#pragma unroll
        for (int nb = 0; nb < WNB; ++nb) store_tr(vt, T_TOK, n0w - 1024 + nb * 32 + r, m0w + mb * 32 + 4 * h, acc[mb][nb], rkv);
    }
  }
};

template <bool SWAP, int WMB, int WNB>
DI void gemm_compute(const char* la, const char* lb, f32x16 (&acc)[WMB][WNB], int wm, int wn, int r, int h) {
#pragma unroll
  for (int ks = 0; ks < 4; ++ks) {
    bf16x8 af[WMB], bfr[WNB];
#pragma unroll
    for (int mb = 0; mb < WMB; ++mb) af[mb] = *(const bf16x8*)(la + (wm * 32 * WMB + mb * 32 + r) * 144 + (ks * 2 + h) * 16);
#pragma unroll
    for (int nb = 0; nb < WNB; ++nb) bfr[nb] = *(const bf16x8*)(lb + (wn * 32 * WNB + nb * 32 + r) * 144 + (ks * 2 + h) * 16);
#pragma unroll
    for (int mb = 0; mb < WMB; ++mb)
#pragma unroll
      for (int nb = 0; nb < WNB; ++nb) {
        if (SWAP) acc[mb][nb] = MFMA32(bfr[nb], af[mb], acc[mb][nb]);
        else acc[mb][nb] = MFMA32(af[mb], bfr[nb], acc[mb][nb]);
      }
  }
}

template <bool SWAP, class Epi>
DI void gemm_tile(const u16* __restrict__ ag, int lda, const u16* __restrict__ bg, int ldb, int nk, int m0, int n0, const Epi& epi, char* lds) {
  constexpr int WMB = 4, WNB = 2;
  constexpr int TM = 256, TN = 256;
  constexpr int STAGE = (TM + TN) * 144;
  const int tid = otid(), lane = tid & 63, w = tid >> 6, wm = w >> 2, wn = w & 3, r = lane & 31, h = lane >> 5;
  const int lrow = tid >> 3, lch = tid & 7;
  u32x4 pa[4], pb[4];
  f32x16 acc[WMB][WNB];
#pragma unroll
  for (int mb = 0; mb < WMB; ++mb)
#pragma unroll
    for (int nb = 0; nb < WNB; ++nb)
#pragma unroll
      for (int i = 0; i < 16; ++i) acc[mb][nb][i] = 0.f;
#pragma unroll
  for (int j = 0; j < 4; ++j) pa[j] = *(const u32x4*)(ag + (size_t)j * 64 * lda);
#pragma unroll
  for (int j = 0; j < 4; ++j) pb[j] = *(const u32x4*)(bg + (size_t)j * 64 * ldb);
  {
    char* la = lds; char* lb = lds + TM * 144;
#pragma unroll
    for (int j = 0; j < 4; ++j) *(u32x4*)(la + (lrow + 64 * j) * 144 + lch * 16) = pa[j];
#pragma unroll
    for (int j = 0; j < 4; ++j) *(u32x4*)(lb + (lrow + 64 * j) * 144 + lch * 16) = pb[j];
  }
  if (nk > 1) {
#pragma unroll
    for (int j = 0; j < 4; ++j) pa[j] = *(const u32x4*)(ag + (size_t)j * 64 * lda + 64);
#pragma unroll
    for (int j = 0; j < 4; ++j) pb[j] = *(const u32x4*)(bg + (size_t)j * 64 * ldb + 64);
  }
  __syncthreads();
  for (int kt = 0; kt < nk; ++kt) {
    const char* la = lds + (kt & 1) * STAGE;
    const char* lb = la + TM * 144;
    if (kt + 1 < nk) {
      char* wa = lds + ((kt + 1) & 1) * STAGE;
      char* wb = wa + TM * 144;
#pragma unroll
      for (int j = 0; j < 4; ++j) *(u32x4*)(wa + (lrow + 64 * j) * 144 + lch * 16) = pa[j];
#pragma unroll
      for (int j = 0; j < 4; ++j) *(u32x4*)(wb + (lrow + 64 * j) * 144 + lch * 16) = pb[j];
    }
    if (kt + 2 < nk) {
#pragma unroll
      for (int j = 0; j < 4; ++j) pa[j] = *(const u32x4*)(ag + (size_t)j * 64 * lda + (kt + 2) * 64);
#pragma unroll
      for (int j = 0; j < 4; ++j) pb[j] = *(const u32x4*)(bg + (size_t)j * 64 * ldb + (kt + 2) * 64);
    }
    gemm_compute<SWAP, WMB, WNB>(la, lb, acc, wm, wn, r, h);
    __syncthreads();
  }
  epi.template store<WMB, WNB>(m0 + wm * 32 * WMB, n0 + wn * 32 * WNB, acc, r, h, SWAP);
}

template <class Epi>
DI void gemm_phase(const u16* __restrict__ A, int lda, const u16* __restrict__ Bt, int ldb, int M, int N, int K, const Epi epi, char* lds, int bid, int nblk) {
  constexpr int TM = 256, TN = 256;
  const int tid = otid();
  const int NT = N / TN, MT = M / TM, tiles = MT * NT, nk = K >> 6;
  const int lrow = tid >> 3, lch = tid & 7;
  for (int t0 = bid; t0 < ((tiles + nblk - 1) / nblk) * nblk; t0 += nblk) {
    int tile = t0;
    if (nblk == 256) tile = (t0 & ~255) + (bid & 7) * 32 + (bid >> 3);
    if (tile >= tiles) continue;
    const int grp = tile / (8 * NT), within = tile - grp * (8 * NT);
    const int nt = within >> 3, mt = grp * 8 + (within & 7);
    const int m0 = mt * TM, n0 = nt * TN;
    const u16* ag = A + (size_t)(m0 + lrow) * lda + lch * 8;
    const u16* bg = Bt + (size_t)(n0 + lrow) * ldb + lch * 8;
    if (Epi::SWAPMODE == 1) gemm_tile<true>(ag, lda, bg, ldb, nk, m0, n0, epi, lds);
    else if (Epi::SWAPMODE == 0) gemm_tile<false>(ag, lda, bg, ldb, nk, m0, n0, epi, lds);
    else { if (epi.swap(n0)) gemm_tile<true>(ag, lda, bg, ldb, nk, m0, n0, epi, lds); else gemm_tile<false>(ag, lda, bg, ldb, nk, m0, n0, epi, lds); }
  }
}

typedef __attribute__((ext_vector_type(2))) float f32x2;
typedef __attribute__((ext_vector_type(2))) __bf16 bf16x2_t;
typedef __attribute__((ext_vector_type(2))) unsigned u32x2;
DI unsigned cvt_pk(float a, float b) {
  f32x2 v; v.x = a; v.y = b;
  return __builtin_bit_cast(unsigned, __builtin_convertvector(v, bf16x2_t));
}
DI void lds_st16_as2x8(char* dst, const u32x4 v) {
  u32x2 a; a.x = v.x; a.y = v.y; u32x2 b; b.x = v.z; b.y = v.w;
  *(u32x2*)dst = a;
  *(u32x2*)(dst + 8) = b;
}
constexpr int ATT_STAGE = 35840;
constexpr float DEFER_THR = 8.f;

template <int DQK>
DI void qk_scores_qlds(const char* kl, const char* qsl, f32x16 (&s)[2], int r, int h) {
  constexpr int KS = DQK * 2 + 16;
#pragma unroll
  for (int kb = 0; kb < 2; ++kb) {
#pragma unroll
    for (int ks = 0; ks < DQK / 16; ++ks) {
      const bf16x8 a = *(const bf16x8*)(kl + (32 * kb + r) * KS + (2 * ks + h) * 16);
      const bf16x8 qv = *(const bf16x8*)(qsl + ks * 1024);
      s[kb] = MFMA32(a, qv, s[kb]);
    }
  }
}
template <int DQK>
DI void qk_scores(const char* kl, const bf16x8 (&qf)[DQK / 16], const f32x16& initv, f32x16 (&s)[2], int r, int h) {
  constexpr int KS = DQK * 2 + 16;
#pragma unroll
  for (int kb = 0; kb < 2; ++kb) {
    s[kb] = initv;
#pragma unroll
    for (int ks = 0; ks < DQK / 16; ++ks) {
      const bf16x8 a = *(const bf16x8*)(kl + (32 * kb + r) * KS + (2 * ks + h) * 16);
      s[kb] = MFMA32(a, qf[ks], s[kb]);
    }
  }
}

template <int DV>
DI float softmax_pv(f32x16 (&s)[2], f32x16 (&o)[DV / 32], float& l, bool first, const char* vl, int r, int h) {
  float dret = 0.f;
  float mx = fmaxf(fmaxf(s[0][0], s[0][1]), s[0][2]);
#pragma unroll
  for (int i = 3; i < 15; i += 2) mx = fmaxf(fmaxf(mx, s[0][i]), s[0][i + 1]);
  mx = fmaxf(fmaxf(mx, s[0][15]), s[1][0]);
#pragma unroll
  for (int i = 1; i < 15; i += 2) mx = fmaxf(fmaxf(mx, s[1][i]), s[1][i + 1]);
  mx = fmaxf(mx, s[1][15]);
  const bool need = first || (mx > DEFER_THR);
  if (__any(need)) {
    mx = fmaxf(mx, __shfl_xor(mx, 32));
    float delta;
    if (first) delta = mx;
    else {
      delta = fmaxf(mx, 0.f);
      const float alpha = fexp2(-delta);
      l *= alpha;
#pragma unroll
      for (int d = 0; d < DV / 32; ++d)
#pragma unroll
        for (int i = 0; i < 16; ++i) o[d][i] *= alpha;
    }
#pragma unroll
    for (int kb = 0; kb < 2; ++kb)
#pragma unroll
      for (int i = 0; i < 16; ++i) s[kb][i] -= delta;
    dret = delta;
  }
  float ps = 0.f;
#pragma unroll
  for (int kb = 0; kb < 2; ++kb)
#pragma unroll
    for (int i = 0; i < 16; ++i) { const float e = fexp2(s[kb][i]); s[kb][i] = e; ps += e; }
  l += ps;
  bf16x8 pf[2][2];
#pragma unroll
  for (int kb = 0; kb < 2; ++kb)
#pragma unroll
    for (int st = 0; st < 2; ++st) {
      u32x4 u;
      u.x = cvt_pk(s[kb][8 * st + 0], s[kb][8 * st + 1]); u.y = cvt_pk(s[kb][8 * st + 2], s[kb][8 * st + 3]);
      u.z = cvt_pk(s[kb][8 * st + 4], s[kb][8 * st + 5]); u.w = cvt_pk(s[kb][8 * st + 6], s[kb][8 * st + 7]);
      pf[kb][st] = __builtin_bit_cast(bf16x8, u);
    }
#pragma unroll
  for (int d = 0; d < DV / 32; ++d)
#pragma unroll
    for (int kb = 0; kb < 2; ++kb)
#pragma unroll
      for (int st = 0; st < 2; ++st) {
        const char* vp = vl + (32 * d + r) * 136 + (32 * kb + 16 * st + 4 * h) * 2;
        const u32x2 lo = *(const u32x2*)vp;
        const u32x2 hi = *(const u32x2*)(vp + 16);
        u32x4 u; u.x = lo.x; u.y = lo.y; u.z = hi.x; u.w = hi.y;
        o[d] = MFMA32(__builtin_bit_cast(bf16x8, u), pf[kb][st], o[d]);
      }
  return dret;
}

template <int DV>
DI float softmax_pre(f32x16 (&s)[2], f32x16 (&o)[DV / 32], float& l, bool first) {
  float dret = 0.f;
  float mx = fmaxf(fmaxf(s[0][0], s[0][1]), s[0][2]);
#pragma unroll
  for (int i = 3; i < 15; i += 2) mx = fmaxf(fmaxf(mx, s[0][i]), s[0][i + 1]);
  mx = fmaxf(fmaxf(mx, s[0][15]), s[1][0]);
#pragma unroll
  for (int i = 1; i < 15; i += 2) mx = fmaxf(fmaxf(mx, s[1][i]), s[1][i + 1]);
  mx = fmaxf(mx, s[1][15]);
  const bool need = first || (mx > DEFER_THR);
  if (__any(need)) {
    mx = fmaxf(mx, __shfl_xor(mx, 32));
    float delta;
    if (first) delta = mx;
    else {
      delta = fmaxf(mx, 0.f);
      const float alpha = fexp2(-delta);
      l *= alpha;
#pragma unroll
      for (int d = 0; d < DV / 32; ++d)
#pragma unroll
        for (int i = 0; i < 16; ++i) o[d][i] *= alpha;
    }
#pragma unroll
    for (int kb = 0; kb < 2; ++kb)
#pragma unroll
      for (int i = 0; i < 16; ++i) s[kb][i] -= delta;
    dret = delta;
  }
  return dret;
}
DI void softmax_exp_half(f32x16& s, float& l, bf16x8 (&pf)[2]) {
  float ps = 0.f;
#pragma unroll
  for (int i = 0; i < 16; ++i) { const float e = fexp2(s[i]); s[i] = e; ps += e; }
  l += ps;
#pragma unroll
  for (int st = 0; st < 2; ++st) {
    u32x4 u;
    u.x = cvt_pk(s[8 * st + 0], s[8 * st + 1]); u.y = cvt_pk(s[8 * st + 2], s[8 * st + 3]);
    u.z = cvt_pk(s[8 * st + 4], s[8 * st + 5]); u.w = cvt_pk(s[8 * st + 6], s[8 * st + 7]);
    pf[st] = __builtin_bit_cast(bf16x8, u);
  }
}
template <int DV>
DI void pv_half(const bf16x8 (&pf)[2], f32x16 (&o)[DV / 32], const char* vl, int kb, int r, int h) {
#pragma unroll
  for (int d = 0; d < DV / 32; ++d)
#pragma unroll
    for (int st = 0; st < 2; ++st) {
      const char* vp = vl + (32 * d + r) * 136 + (32 * kb + 16 * st + 4 * h) * 2;
      const u32x2 lo = *(const u32x2*)vp;
      const u32x2 hi = *(const u32x2*)(vp + 16);
      u32x4 u; u.x = lo.x; u.y = lo.y; u.z = hi.x; u.w = hi.y;
      o[d] = MFMA32(__builtin_bit_cast(bf16x8, u), pf[st], o[d]);
    }
}

template <int ABL>
DI void attn_mla_item(const Params& p, int item, char* lds) {
  constexpr int DQK = 96, DV = 64, KS = DQK * 2 + 16;
  const int tid = otid(), lane = tid & 63, w = tid >> 6, r = lane & 31, h = lane >> 5;
  int head, qb, ts0, S;
  if (item < 1024) { head = item >> 6; qb = item & 63; ts0 = T_PROMPT; S = 16384; }
  else { const int it = item - 1024; qb = it & 15; head = (it >> 4) & 15; ts0 = (it >> 8) * 4096; S = 4096; }
  const u16* q = (const u16*)(p.ws + OFF_R2);
  const u16* knope = q + (size_t)T_TOK * 1536;
  const u16* vt = knope + (size_t)T_TOK * 1024;
  const u16* krope = (const u16*)(p.ws + OFF_KROPE);
  u16* o1 = (u16*)(p.ws + OFF_R1);
  const int tq = ts0 + qb * 256 + w * 32 + r;
  bf16x8 qf[DQK / 16];
#pragma unroll
  for (int ks = 0; ks < DQK / 16; ++ks) qf[ks] = *(const bf16x8*)(q + (size_t)tq * 1536 + head * 96 + 16 * ks + 8 * h);
  f32x16 o[DV / 32];
#pragma unroll
  for (int d = 0; d < DV / 32; ++d)
#pragma unroll
    for (int i = 0; i < 16; ++i) o[d][i] = 0.f;
  f32x16 initv;
#pragma unroll
  for (int i = 0; i < 16; ++i) initv[i] = 0.f;
  float l = 0.f;
  u32x4 pk0, pk1, pv0;
  const int c1 = 512 + tid;
  const int krow0 = tid / 12, kch0 = tid - krow0 * 12;
  const int krow1 = c1 / 12, kch1 = c1 - krow1 * 12;
  const int vrow = tid >> 3, vch = tid & 7;
  const int nkt = S >> 6;
  auto prefetch = [&](int kt) {
    const int tk0 = ts0 + kt * 64;
    {
      const u16* src = kch0 < 8 ? knope + (size_t)(tk0 + krow0) * 1024 + head * 64 + kch0 * 8 : krope + (size_t)(tk0 + krow0) * 32 + (kch0 - 8) * 8;
      pk0 = *(const u32x4*)src;
    }
    if (tid < 256) {
      const u16* src = kch1 < 8 ? knope + (size_t)(tk0 + krow1) * 1024 + head * 64 + kch1 * 8 : krope + (size_t)(tk0 + krow1) * 32 + (kch1 - 8) * 8;
      pk1 = *(const u32x4*)src;
    }
    pv0 = *(const u32x4*)(vt + (size_t)(head * 64 + vrow) * T_TOK + tk0 + vch * 8);
  };
  auto stage_at = [&](int boff) {
    char* kl = lds + boff;
    char* vl = kl + 64 * KS;
    *(u32x4*)(kl + krow0 * KS + kch0 * 16) = pk0;
    if (tid < 256) *(u32x4*)(kl + krow1 * KS + kch1 * 16) = pk1;
    lds_st16_as2x8(vl + vrow * 136 + vch * 16, pv0);
  };
  prefetch(0);
  __syncthreads();
  stage_at(0);
  prefetch(1);
  stage_at(ATT_STAGE);
  if (nkt > 2) prefetch(2);
  __syncthreads();
  int cur = 0, nxt = ATT_STAGE, nn = 2 * ATT_STAGE;
  f32x16 s[2];
  qk_scores<DQK>(lds, qf, initv, s, r, h);
#pragma unroll 1
  for (int kt = 0; kt < nkt; ++kt) {
    if (ABL == 2) { __syncthreads(); if (kt + 2 < nkt) stage_at(nn); if (kt + 3 < nkt) prefetch(kt + 3); { const int t = cur; cur = nxt; nxt = nn; nn = t; } continue; }
    const float dl = softmax_pre<DV>(s, o, l, kt == 0);
    if (__any(dl != 0.f)) {
#pragma unroll
      for (int i = 0; i < 16; ++i) initv[i] -= dl;
    }
    f32x16 sn[2];
    qk_scores<DQK>(lds + nxt, qf, initv, sn, r, h);
#pragma unroll
    for (int kb = 0; kb < 2; ++kb) {
      bf16x8 pf[2];
      softmax_exp_half(s[kb], l, pf);
      pv_half<DV>(pf, o, lds + cur + 64 * KS, kb, r, h);
    }
    if (ABL != 1) { if (kt + 2 < nkt) stage_at(nn);
    if (kt + 3 < nkt) prefetch(kt + 3); }
    __syncthreads();
    s[0] = sn[0]; s[1] = sn[1];
    const int t = cur; cur = nxt; nxt = nn; nn = t;
  }
  l += __shfl_xor(l, 32);
  const float inv = 1.f / l;
#pragma unroll
  for (int d = 0; d < DV / 32; ++d) store_tok(o1, 1024, tq, head * 64 + 32 * d + 4 * h, o[d], inv);
}

DI void diff_decode(int item, int& hh, int& qb, int& ts0, int& S) {
  int j;
  if (item < 128) { hh = 3; j = item; S = 16384; }
  else if (item < 256) { hh = 2; j = item - 128; S = 16384; }
  else if (item < 768) { hh = 3; j = item - 256; S = 4096; }
  else if (item < 1280) { hh = 2; j = item - 768; S = 4096; }
  else if (item < 1408) { hh = 1; j = item - 1280; S = 16384; }
  else if (item < 1920) { hh = 1; j = item - 1408; S = 4096; }
  else if (item < 2048) { hh = 0; j = item - 1920; S = 16384; }
  else { hh = 0; j = item - 2048; S = 4096; }
  if (S == 16384) { qb = j; ts0 = T_PROMPT; } else { qb = j & 31; ts0 = (j >> 5) * 4096; }
}
DI void attn_diff_item(const Params& p, int item, char* lds) {
  constexpr int DQK = 64, DV = 128, KS = DQK * 2 + 16;
  const int tid = otid(), lane = tid & 63, w = tid >> 6, r = lane & 31, h = lane >> 5;
  const int map = w >> 2, qw = w & 3;
  int hh, qb, ts0, S;
  diff_decode(item, hh, qb, ts0, S);
  const u16* base = (const u16*)(p.ws + OFF_R2);
  const u16* dq = base + 3 * SEG512;
  const u16* dk = base + 4 * SEG512;
  const u16* vtd = base + 5 * SEG512;
  u16* o0 = (u16*)(p.ws + OFF_R1);
  const int qpos = qb * 128 + qw * 32 + r;
  const int tq = ts0 + qpos;
  char* qsl = lds + 3 * ATT_STAGE + 4096 + w * 4096 + lane * 16;
  __syncthreads();
#pragma unroll
  for (int ks = 0; ks < DQK / 16; ++ks) *(bf16x8*)(qsl + ks * 1024) = *(const bf16x8*)(dq + (size_t)tq * 512 + (2 * hh + map) * 64 + 16 * ks + 8 * h);
  f32x16 o[DV / 32];
#pragma unroll
  for (int d = 0; d < DV / 32; ++d)
#pragma unroll
    for (int i = 0; i < 16; ++i) o[d][i] = 0.f;
  float l = 0.f;
  float ref = 0.f;
  const float slope2 = exp2f(-2.f * (float)(hh + 1)) * LOG2E;
  const float cq = slope2 * (float)qpos;
  const int d0 = 2 * qb;
  const int kd = d0 + (qw >> 1);
  int kt_lo, kt_hi;
  {
    const unsigned* qk = (const unsigned*)(p.ws + OFF_SCAL) + SC_QKMAX;
    const float b0 = __uint_as_float(qk[2 * hh]) * __uint_as_float(qk[8 + 2 * hh]);
    const float b1 = __uint_as_float(qk[2 * hh + 1]) * __uint_as_float(qk[8 + 2 * hh + 1]);
    const float B = fmaxf(b0, b1) * 1.02f + 0.5f;
    const float dskip = fminf((2.f * B + 34.f) / slope2 + 1.f, 1.0e6f);
    const int q_lo = qb * 128, q_hi = q_lo + 127, ds = (int)dskip;
    kt_lo = max(0, (q_lo - 63 - ds) >> 6);
    kt_hi = min((S >> 6) - 1, (q_hi + ds) >> 6);
    kt_lo = min(kt_lo, 2 * qb); kt_hi = max(kt_hi, 2 * qb + 1);
  }
  const int nleft = d0 - kt_lo;
  const int nkt = kt_hi - kt_lo + 1;
  u32x4 pk[2], pv[2];
  const int lrow = tid >> 3, lch = tid & 7;
  auto tile_of = [&](int idx) { return idx < 2 ? d0 + idx : (idx - 2 < nleft ? d0 - 1 - (idx - 2) : idx + kt_lo); };
  const unsigned koff = (unsigned)(((ts0 + lrow) * 512 + 2 * hh * 64 + lch * 8) * 2);
  const unsigned voff = (unsigned)((((hh * 128 + lrow) * T_TOK) + ts0 + lch * 8) * 2);
  const char* dkb = (const char*)dk;
  const char* vtb = (const char*)vtd;
  auto prefetch = [&](int kt) {
    const unsigned ko = koff + (unsigned)kt * (64u * 512u * 2u);
    const unsigned vo = voff + (unsigned)kt * 128u;
    pk[0] = *(const u32x4*)(dkb + ko);
    pk[1] = *(const u32x4*)(dkb + ko + 128u);
    pv[0] = *(const u32x4*)(vtb + vo);
    pv[1] = *(const u32x4*)(vtb + vo + (unsigned)(64 * T_TOK * 2));
  };
  auto stage_at = [&](int boff) {
    char* kl0 = lds + boff;
    char* vl = kl0 + 2 * 64 * KS;
#pragma unroll
    for (int j = 0; j < 2; ++j) *(u32x4*)(kl0 + j * 64 * KS + lrow * KS + lch * 16) = pk[j];
#pragma unroll
    for (int j = 0; j < 2; ++j) lds_st16_as2x8(vl + (lrow + 64 * j) * 136 + lch * 16, pv[j]);
  };
  auto scores = [&](int kt, int boff, f32x16 (&sc)[2]) {
    const int side = kt < kd ? -1 : (kt > kd ? 1 : 0);
    const float I = (float)side * cq - ref;
    const unsigned i_hi = cvt_pk(I, 0.f) & 0xffffu;
    const float ir1 = I - __uint_as_float(i_hi << 16);
    const unsigned i_mid = cvt_pk(ir1, 0.f) & 0xffffu;
    const float ir2 = ir1 - __uint_as_float(i_mid << 16);
    const unsigned i_lo = cvt_pk(ir2, 0.f) & 0xffffu;
    const float T = slope2 * (float)(kt * 64);
    const unsigned t_hi = cvt_pk(T, 0.f) & 0xffffu;
    const float r1 = T - __uint_as_float(t_hi << 16);
    const unsigned t_mid = cvt_pk(r1, 0.f) & 0xffffu;
    const float r2 = r1 - __uint_as_float(t_mid << 16);
    const unsigned t_lo = cvt_pk(r2, 0.f) & 0xffffu;
    const unsigned one = side < 0 ? 0x3F80u : (side > 0 ? 0xBF80u : 0u);
    u32x4 qa;
    qa.x = h == 0 ? (one | (one << 16)) : 0u; qa.y = qa.x; qa.z = h == 0 ? (one | (i_hi << 16)) : 0u; qa.w = h == 0 ? (i_mid | (i_lo << 16)) : 0u;
    const bf16x8 qaug = __builtin_bit_cast(bf16x8, qa);
#pragma unroll
    for (int kb = 0; kb < 2; ++kb) {
      const float xl = slope2 * (float)(32 * kb + r);
      const unsigned l_hi = cvt_pk(xl, 0.f) & 0xffffu;
      const unsigned l_lo = cvt_pk(xl - __uint_as_float(l_hi << 16), 0.f) & 0xffffu;
      u32x4 ka; ka.x = h == 0 ? (l_hi | (l_lo << 16)) : 0u; ka.y = h == 0 ? (t_hi | (t_mid << 16)) : 0u; ka.z = h == 0 ? (t_lo | 0x3F800000u) : 0u; ka.w = h == 0 ? 0x3F803F80u : 0u;
      f32x16 z;
#pragma unroll
      for (int i = 0; i < 16; ++i) z[i] = 0.f;
      sc[kb] = MFMA32(__builtin_bit_cast(bf16x8, ka), qaug, z);
    }
    qk_scores_qlds<DQK>(lds + boff + map * 64 * KS, qsl, sc, r, h);
  };
  prefetch(tile_of(0));
  __syncthreads();
  stage_at(0);
  prefetch(tile_of(1));
  stage_at(ATT_STAGE);
  if (nkt > 2) prefetch(tile_of(2));
  __syncthreads();
  int cur = 0, nxt = ATT_STAGE, nn = 2 * ATT_STAGE;
  f32x16 s[2];
  scores(tile_of(0), 0, s);
#pragma unroll 1
  for (int idx = 0; idx < nkt; ++idx) {
    const int kt = tile_of(idx);
    if (kt == kd) {
#pragma unroll
      for (int kb = 0; kb < 2; ++kb)
#pragma unroll
        for (int i = 0; i < 16; ++i) {
          const int kp = kt * 64 + 32 * kb + (i & 3) + 8 * (i >> 2) + 4 * h;
          s[kb][i] -= slope2 * fabsf((float)(qpos - kp));
        }
    }
    ref += softmax_pre<DV>(s, o, l, idx == 0);
    f32x16 sn[2];
    scores(tile_of(min(idx + 1, nkt - 1)), nxt, sn);
#pragma unroll
    for (int kb = 0; kb < 2; ++kb) {
      bf16x8 pf[2];
      softmax_exp_half(s[kb], l, pf);
      pv_half<DV>(pf, o, lds + cur + 2 * 64 * KS, kb, r, h);
    }
    if (idx + 2 < nkt) stage_at(nn);
    if (idx + 3 < nkt) prefetch(tile_of(idx + 3));
    __syncthreads();
    s[0] = sn[0]; s[1] = sn[1];
    const int t = cur; cur = nxt; nxt = nn; nn = t;
  }
  l += __shfl_xor(l, 32);
  const float inv = 1.f / l;
  int tid2 = otid();
  const int lane2 = tid2 & 63, qw2 = (tid2 >> 6) & 3, h2 = lane2 >> 5;
  int item2 = item; asm volatile("" : "+s"(item2));
  int hh2, tq2;
  { int qb2, ts02, S2; diff_decode(item2, hh2, qb2, ts02, S2); tq2 = ts02 + qb2 * 128 + qw2 * 32 + (lane2 & 31); }
  float* ex = (float*)lds + qw2 * 4096;
  if (map == 1) {
#pragma unroll
    for (int d = 0; d < DV / 32; ++d)
#pragma unroll
      for (int i = 0; i < 16; ++i) ex[(d * 16 + i) * 64 + lane2] = o[d][i] * inv;
  }
  __syncthreads();
  if (map == 0) {
    const float lam = ((const float*)(p.ws + OFF_SCAL))[0];
    float ss = 0.f;
#pragma unroll
    for (int d = 0; d < DV / 32; ++d)
#pragma unroll
      for (int i = 0; i < 16; ++i) { const float v = o[d][i] * inv - lam * ex[(d * 16 + i) * 64 + lane2]; o[d][i] = v; ss += v * v; }
    ss += __shfl_xor(ss, 32);
    const float rn = rsqrtf(ss * (1.f / 128.f) + EPS) * 0.8f;
    const float* gs = (const float*)(p.ws + OFF_SCAL) + SC_GSUB;
#pragma unroll
    for (int d = 0; d < DV / 32; ++d) {
#pragma unroll
      for (int g = 0; g < 4; ++g) {
        const float4 gv = *(const float4*)(gs + 32 * d + 8 * g + 4 * h2);
        o[d][4 * g] *= gv.x; o[d][4 * g + 1] *= gv.y; o[d][4 * g + 2] *= gv.z; o[d][4 * g + 3] *= gv.w;
      }
      store_tok(o0, 1024, tq2, 512 + hh2 * 128 + 32 * d + 4 * h2, o[d], rn);
    }
  }
}

DI void attn_na_item(const Params& p, int item, char* lds) {
  constexpr int DQK = 64, DV = 64, KS = DQK * 2 + 16;
  const int tid = otid(), lane = tid & 63, w = tid >> 6, r = lane & 31, h = lane >> 5;
  const int quad = item % 320, head = item / 320;
  const int t0 = quad * 256;
  int ts0, rows;
  if (t0 < T_PROMPT) { ts0 = t0 & ~4095; rows = 64; } else { ts0 = T_PROMPT; rows = 256; }
  const int r0 = (t0 - ts0) >> 6;
  const int rw = r0 + (w >> 1);
  const int rs_lo = min(max(r0 - 4, 0), rows - 8);
  const int rs_hi = min(max(r0 + 3 - 4, 0), rows - 8);
  const int rs_w = min(max(rw - 4, 0), rows - 8);
  const int ntile = rs_hi + 8 - rs_lo;
  const u16* base = (const u16*)(p.ws + OFF_R2);
  const u16* qn = base;
  const u16* kn = base + SEG512;
  const u16* vtn = base + 2 * SEG512;
  u16* o0 = (u16*)(p.ws + OFF_R1);
  float* tab = (float*)(lds + 2 * ATT_STAGE) + 64;
  const int qc = (w & 1) * 32 + r;
  const int tq = t0 + w * 32 + r;
  bf16x8 qf[DQK / 16];
#pragma unroll
  for (int ks = 0; ks < DQK / 16; ++ks) qf[ks] = *(const bf16x8*)(qn + (size_t)tq * 512 + head * 64 + 16 * ks + 8 * h);
  f32x16 o[DV / 32];
#pragma unroll
  for (int d = 0; d < DV / 32; ++d)
#pragma unroll
    for (int i = 0; i < 16; ++i) o[d][i] = 0.f;
  f32x16 initv;
#pragma unroll
  for (int i = 0; i < 16; ++i) initv[i] = 0.f;
  float l = 0.f;
  bool first = true;
  u32x4 pk0, pv0;
  const int lrow = tid >> 3, lch = tid & 7;
  auto prefetch = [&](int j) {
    const int tk0 = ts0 + (rs_lo + j) * 64;
    pk0 = *(const u32x4*)(kn + (size_t)(tk0 + lrow) * 512 + head * 64 + lch * 8);
    pv0 = *(const u32x4*)(vtn + (size_t)(head * 64 + lrow) * T_TOK + tk0 + lch * 8);
  };
  auto stage = [&](int b) {
    char* kl = lds + b * ATT_STAGE;
    char* vl = kl + 64 * KS;
    *(u32x4*)(kl + lrow * KS + lch * 16) = pk0;
    lds_st16_as2x8(vl + lrow * 136 + lch * 16, pv0);
  };
  prefetch(0);
  __syncthreads();
  if (tid < 465) tab[tid] = ((const float*)(p.ws + OFF_SCAL))[SC_RPB + head * 465 + tid];
  stage(0);
  prefetch(1);
  __syncthreads();
  const int wc0 = min(max(qc - 8, 0), 48);
  const float* tabq = tab + (15 - qc + 4 * h);
  for (int j = 0; j < ntile; ++j) {
    const char* kl = lds + (j & 1) * ATT_STAGE;
    const char* vl = kl + 64 * KS;
    const int kr = rs_lo + j;
    if (kr >= rs_w && kr < rs_w + 8) {
      f32x16 s[2];
      qk_scores<DQK>(kl, qf, initv, s, r, h);
      const int ridx = kr - rw + 7;
#pragma unroll
      for (int kb = 0; kb < 2; ++kb)
#pragma unroll
        for (int i = 0; i < 16; ++i) {
          const int kc = 32 * kb + (i & 3) + 8 * (i >> 2) + 4 * h;
          const bool ok = (unsigned)(kc - wc0) < 16u;
          const float b = tabq[ridx * 31 + 32 * kb + (i & 3) + 8 * (i >> 2)];
          s[kb][i] = ok ? s[kb][i] + b : -INFINITY;
        }
      {
        const float dl = softmax_pv<DV>(s, o, l, first, vl, r, h);
        if (__any(dl != 0.f)) {
#pragma unroll
          for (int i = 0; i < 16; ++i) initv[i] -= dl;
        }
      }
      first = false;
    }
    if (j + 1 < ntile) stage((j + 1) & 1);
    if (j + 2 < ntile) prefetch(j + 2);
    __syncthreads();
  }
  l += __shfl_xor(l, 32);
  const float inv = 1.f / l;
#pragma unroll
  for (int d = 0; d < DV / 32; ++d) store_tok(o0, 1024, tq, head * 64 + 32 * d + 4 * h, o[d], inv);
}

constexpr int LDS_BYTES = 2 * (256 + 256) * 144;
template <int PH>
DI void run_phase(const Params& p, char* lds) {
  const int bid = obid(), nblk = gridDim.x;
  u16* wb = (u16*)p.ws;
  u16* R1 = (u16*)(p.ws + OFF_R1);
  u16* R2 = (u16*)(p.ws + OFF_R2);
  u16* R3 = (u16*)(p.ws + OFF_R3);
  if constexpr (PH == 0) phase_prep(p);
  else if constexpr (PH == 1) gemm_phase(R1, 1024, wb + W0IN, 1024, T_TOK, 3072, 1024, EpiProj0{R2, (unsigned*)(p.ws + OFF_SCAL) + SC_QKMAX}, lds, bid, nblk);
  else if constexpr (PH == 2) {
    unsigned* ctr = (unsigned*)(p.ws + OFF_SCAL) + SC_CTR;
    int* nxt_slot = (int*)(lds + LDS_BYTES - 16);
    const int tid0 = otid();
    int it = bid;
    while (it < 5120) {
      int nx = 0;
      if (tid0 == 0) nx = (int)atomicAdd(ctr, 1u) + nblk;
      if (it < 2560) attn_diff_item(p, it, lds);
      else attn_na_item(p, it - 2560, lds);
      __syncthreads();
      if (tid0 == 0) *nxt_slot = nx;
      __syncthreads();
      it = *nxt_slot;
    }
  }
  else if constexpr (PH == 3) gemm_phase(R1, 1024, wb + W0OUT, 1024, T_TOK, 1024, 1024, EpiTok{R3, 1024}, lds, bid, nblk);
  else if constexpr (PH == 4) phase_res<true, false>(p, R3, (const float*)(p.ws + OFF_SCAL) + SC_G0);
  else if constexpr (PH == 5) gemm_phase(R1, 1024, wb + W0F1, 1024, T_TOK, 5632, 1024, EpiSwiGLU{R2}, lds, bid, nblk);
  else if constexpr (PH == 6) gemm_phase(R2, 2816, wb + W0F2, 2816, T_TOK, 1024, 2816, EpiTok{R3, 1024}, lds, bid, nblk);
  else if constexpr (PH == 7) phase_res<false, false>(p, R3, (const float*)(p.ws + OFF_SCAL) + SC_G1);
  else if constexpr (PH == 8) gemm_phase(R1, 1024, wb + W1DN, 1024, T_TOK, 768, 1024, EpiTok{R3, 768}, lds, bid, nblk);
  else if constexpr (PH == 9) phase_mla_stats(p);
  else if constexpr (PH == 10) {
    gemm_phase(R3, 768, wb + W1UQ, 384, T_TOK, 1536, 384,
                     EpiUQ{R2, (const float*)(p.ws + OFF_RQ), (const float2*)(p.ws + OFF_ROPE)}, lds, bid, nblk);
    gemm_phase(R3 + 384, 768, wb + W1UKV, 256, T_TOK, 2048, 256,
                     EpiUKV{R2 + (size_t)T_TOK * 1536, R2 + (size_t)T_TOK * 2560, (const float*)(p.ws + OFF_RKV)}, lds, bid, nblk);
  }
  else if constexpr (PH == 11) { for (int it = bid; it < 5120; it += nblk) {
      int itm = it;
      if (nblk == 256) {
        const int rnd = it >> 8, x = bid & 7, j = bid >> 3;
        itm = rnd < 4 ? (4 * rnd + (x >> 1)) * 64 + (x & 1) * 32 + j : 1024 + (rnd - 4) * 256 + (2 * x + (j >> 4)) * 16 + (j & 15);
      }
      attn_mla_item<0>(p, itm, lds);
    } }
  else if constexpr (PH == 12) gemm_phase(R1, 1024, wb + W1OUT, 1024, T_TOK, 1024, 1024, EpiTok{R3, 1024}, lds, bid, nblk);
  else if constexpr (PH == 13) phase_res<false, false>(p, R3, (const float*)(p.ws + OFF_SCAL) + SC_G2);
  else if constexpr (PH == 14) gemm_phase(R1, 1024, wb + W1F1, 1024, T_TOK, 5632, 1024, EpiSwiGLU{R2}, lds, bid, nblk);
  else if constexpr (PH == 15) gemm_phase(R2, 2816, wb + W1F2, 2816, T_TOK, 1024, 2816, EpiTok{R3, 1024}, lds, bid, nblk);
  else if constexpr (PH == 16) phase_res<false, true>(p, R3, (const float*)(p.ws + OFF_SCAL) + SC_G3);
}

#if MULTI_LAUNCH
template <int PH>
__global__ void __launch_bounds__(512, 2) k_phase(Params p) {
  extern __shared__ __attribute__((aligned(16))) char lds[];
  run_phase<PH>(p, lds);
}
template <int PH>
static void launch_all(const Params& p, int grid, hipStream_t stream) {
  (void)hipFuncSetAttribute((const void*)k_phase<PH>, hipFuncAttributeMaxDynamicSharedMemorySize, LDS_BYTES);
  hipLaunchKernelGGL(k_phase<PH>, dim3(grid), dim3(512), LDS_BYTES, stream, p);
  if constexpr (PH + 1 < NPHASE) launch_all<PH + 1>(p, grid, stream);
}
#define OCC_KERNEL k_phase<2>
#else
#ifndef PROBE_DUP
#define PROBE_DUP -1
#endif
#ifndef PROBE_DUP2
#define PROBE_DUP2 -1
#endif
template <int PH>
DI void run_from(const Params& p, char* lds) {
  if constexpr (PH == PROBE_DUP || PH == PROBE_DUP2) { run_phase<PH>(p, lds); cg::this_grid().sync(); }
#ifdef PROBE_ABL
  if constexpr (PH == 11) { for (int it = obid(); it < 5120; it += gridDim.x) attn_mla_item<PROBE_ABL>(p, it, lds); cg::this_grid().sync(); }
#endif
  run_phase<PH>(p, lds);
  if constexpr (PH + 1 < NPHASE) { cg::this_grid().sync(); run_from<PH + 1>(p, lds); }
}
__global__ void __launch_bounds__(512, 2) mega(Params p) {
  extern __shared__ __attribute__((aligned(16))) char lds[];
  run_from<0>(p, lds);
}
#define OCC_KERNEL mega
#endif

extern "C" void kernel_launch(void* const* d_in, const int* in_sizes, int n_in, void* d_out, int out_size, void* d_ws, size_t ws_size,
                              hipStream_t stream) {
  static int grid = 0;
  if (grid == 0) {
    if (n_in != 28 || ws_size < WS_NEED) { fprintf(stderr, "kernel_launch: unexpected n_in %d / ws_size %zu (need %zu)\n", n_in, ws_size, (size_t)WS_NEED); grid = -1; return; }
    int dev = 0, cus = 0, per_cu = 0;
    (void)hipGetDevice(&dev);
    (void)hipDeviceGetAttribute(&cus, hipDeviceAttributeMultiprocessorCount, dev);
    (void)hipFuncSetAttribute((const void*)OCC_KERNEL, hipFuncAttributeMaxDynamicSharedMemorySize, LDS_BYTES);
    (void)hipOccupancyMaxActiveBlocksPerMultiprocessor(&per_cu, (const void*)OCC_KERNEL, 512, LDS_BYTES);
    if (per_cu < 1) per_cu = 1;
    if (per_cu > 1) per_cu = 1;
    grid = cus * per_cu;
  }
  if (grid < 0) return;
  Params p{};
  for (int i = 0; i < 28; ++i) p.in[i] = (const float*)d_in[i];
  p.out = (float*)d_out;
  p.ws = (char*)d_ws;
#if MULTI_LAUNCH
  launch_all<0>(p, grid, stream);
#else
  void* args[] = {&p};
  hipError_t e = hipLaunchCooperativeKernel((const void*)mega, dim3(grid), dim3(512), args, LDS_BYTES, stream);
  if (e != hipSuccess) fprintf(stderr, "cooperative launch failed: %s (grid %d)\n", hipGetErrorString(e), grid);
#endif
}
```

```cpp
#include <hip/hip_runtime.h>
#include <hip/hip_cooperative_groups.h>
#include <stdint.h>
#include <cstdio>
namespace cg = cooperative_groups;

#ifndef MULTI_LAUNCH
#define MULTI_LAUNCH 0
#endif

typedef unsigned short u16;
typedef __attribute__((ext_vector_type(8))) short bf16x8;
typedef __attribute__((ext_vector_type(16))) float f32x16;
typedef __attribute__((ext_vector_type(4))) unsigned u32x4;

#define MFMA32(a, b, c) __builtin_amdgcn_mfma_f32_32x32x16_bf16((a), (b), (c), 0, 0, 0)
#define DI __device__ __forceinline__

constexpr int T_TOK = 81920;
constexpr int T_PROMPT = 65536;
constexpr int DM = 1024;
constexpr int DFF = 2816;
constexpr float EPS = 1e-6f;
constexpr float LOG2E = 1.4426950408889634f;
constexpr float QSCALE64 = 0.125f * LOG2E;
constexpr float QSCALE96 = 0.10206207261596577f * LOG2E;
constexpr int NPHASE = 17;

constexpr size_t MiB = (size_t)1 << 20;
constexpr size_t W0IN = 0;
constexpr size_t W0OUT = W0IN + (size_t)3072 * 1024;
constexpr size_t W0F1 = W0OUT + (size_t)1024 * 1024;
constexpr size_t W0F2 = W0F1 + (size_t)5632 * 1024;
constexpr size_t W1DN = W0F2 + (size_t)1024 * 2816;
constexpr size_t W1UQ = W1DN + (size_t)768 * 1024;
constexpr size_t W1UKV = W1UQ + (size_t)1536 * 384;
constexpr size_t W1OUT = W1UKV + (size_t)2048 * 256;
constexpr size_t W1F1 = W1OUT + (size_t)1024 * 1024;
constexpr size_t W1F2 = W1F1 + (size_t)5632 * 1024;
constexpr size_t W_END = W1F2 + (size_t)1024 * 2816;
static_assert(W_END * 2 <= 48 * MiB, "weights region");
constexpr size_t OFF_ROPE = 48 * MiB;
constexpr size_t OFF_RQ = OFF_ROPE + 2 * MiB;
constexpr size_t OFF_RKV = OFF_RQ + MiB / 2;
constexpr size_t OFF_KROPE = OFF_RKV + MiB / 2;
constexpr size_t OFF_SCAL = OFF_KROPE + 5 * MiB;
constexpr int SC_QKMAX = 16, SC_CTR = 32, SC_BAR = 33;
constexpr int SC_G0 = 1024, SC_G1 = 2048, SC_G2 = 3072, SC_G3 = 4096, SC_GSUB = 5120, SC_RPB = 6144;
constexpr size_t OFF_R1 = 58 * MiB;
constexpr size_t OFF_R3 = OFF_R1 + 160 * MiB;
constexpr size_t OFF_R2 = OFF_R3 + 160 * MiB;
constexpr size_t WS_NEED = OFF_R2 + 560 * MiB;
constexpr size_t SEG512 = (size_t)T_TOK * 512;

struct Params {
  const float* in[28];
  float* out;
  char* ws;
};

DI u16 f2bf(float x) { unsigned u = __float_as_uint(x); u += 0x7fffu + ((u >> 16) & 1u); return (u16)(u >> 16); }
DI unsigned pack2(float a, float b) { return (unsigned)f2bf(a) | ((unsigned)f2bf(b) << 16); }
DI float bflo(unsigned v) { return __uint_as_float(v << 16); }
DI float bfhi(unsigned v) { return __uint_as_float(v & 0xffff0000u); }
DI float wave_sum(float v) {
#pragma unroll
  for (int o = 32; o; o >>= 1) v += __shfl_xor(v, o);
  return v;
}
DI int tok_pos(int t) { return t < T_PROMPT ? (t & 4095) : (t - T_PROMPT); }
DI float fexp2(float x) { return __builtin_amdgcn_exp2f(x); }
typedef __attribute__((ext_vector_type(2))) float f32x2;
typedef __attribute__((ext_vector_type(2))) __bf16 bf16x2_t;
typedef __attribute__((ext_vector_type(2))) unsigned u32x2;
typedef __attribute__((ext_vector_type(4))) unsigned u32x4_;
DI unsigned cvt_pk(float a, float b) {
  f32x2 v; v.x = a; v.y = b;
  return __builtin_bit_cast(unsigned, __builtin_convertvector(v, bf16x2_t));
}
DI int otid() { int t = threadIdx.x; asm volatile("" : "+v"(t)); return t; }
DI int obid() { int b = blockIdx.x; asm volatile("" : "+s"(b)); return b; }

__device__ const float ROPE_INV[16] = {1.0f, 0.5623413324356079f, 0.3162277638912201f, 0.17782793939113617f, 0.10000000149011612f, 0.05623413249850273f, 0.03162277489900589f, 0.017782794311642647f, 0.009999999776482582f, 0.005623413249850273f, 0.003162277629598975f, 0.0017782794311642647f, 0.0010000000474974513f, 0.000562341301701963f, 0.0003162277571391314f, 0.00017782794020604342f};

DI void wconv(const float* __restrict__ W, const float* __restrict__ g, u16* __restrict__ dst, int K, int N, int rowsOut, int perm, int gtid, int gthreads) {
  const int kc = K >> 3;
  const long total = (long)rowsOut * kc;
  for (long c = gtid; c < total; c += gthreads) {
    const int n = (int)(c % rowsOut);
    const int k0 = (int)(c / rowsOut) * 8;
    int sc;
    if (perm == 1) { const int blk = n >> 6, w = n & 63; const int j = blk * 32 + (w & 31); sc = (w < 32) ? j : DFF + j; }
    else if (perm == 2) { const int hd = (n & 1023) >> 6, d = n & 63; sc = hd * 128 + (n >= 1024 ? 64 : 0) + d; }
    else sc = n;
    uint4 o = make_uint4(0, 0, 0, 0);
    if (sc < N) {
      float v[8];
#pragma unroll
      for (int i = 0; i < 8; ++i) { float x = W[(size_t)(k0 + i) * N + sc]; if (g) x *= g[k0 + i]; v[i] = x; }
      o.x = pack2(v[0], v[1]); o.y = pack2(v[2], v[3]); o.z = pack2(v[4], v[5]); o.w = pack2(v[6], v[7]);
    }
    *(uint4*)(dst + (size_t)n * K + k0) = o;
  }
}

DI void phase_prep(const Params& p) {
  const int gtid = obid() * 512 + otid(), gthreads = gridDim.x * 512;
  u16* wb = (u16*)p.ws;
  wconv(p.in[3], p.in[2], wb + W0IN, 1024, 3072, 3072, 0, gtid, gthreads);
  wconv(p.in[10], nullptr, wb + W0OUT, 1024, 1024, 1024, 0, gtid, gthreads);
  wconv(p.in[13], p.in[12], wb + W0F1, 1024, 5632, 5632, 1, gtid, gthreads);
  wconv(p.in[14], nullptr, wb + W0F2, 2816, 1024, 1024, 0, gtid, gthreads);
  wconv(p.in[17], p.in[16], wb + W1DN, 1024, 672, 768, 0, gtid, gthreads);
  wconv(p.in[20], p.in[18], wb + W1UQ, 384, 1536, 1536, 0, gtid, gthreads);
  wconv(p.in[21], p.in[19], wb + W1UKV, 256, 2048, 2048, 2, gtid, gthreads);
  wconv(p.in[22], nullptr, wb + W1OUT, 1024, 1024, 1024, 0, gtid, gthreads);
  wconv(p.in[25], p.in[24], wb + W1F1, 1024, 5632, 5632, 1, gtid, gthreads);
  wconv(p.in[26], nullptr, wb + W1F2, 2816, 1024, 1024, 0, gtid, gthreads);
  float2* rope = (float2*)(p.ws + OFF_ROPE);
  for (int idx = gtid; idx < 16384 * 16; idx += gthreads) {
    const int pos = idx >> 4, i = idx & 15;
    const float ang = (float)pos * ROPE_INV[i];
    double rev = (double)ang * 0.15915494309189535;
    rev -= rint(rev);
    const float rf = (float)rev;
    rope[idx] = make_float2(__builtin_amdgcn_cosf(rf), __builtin_amdgcn_sinf(rf));
  }
  if (gtid == 0) {
    float s1 = 0.f, s2 = 0.f;
    for (int i = 0; i < 64; ++i) { s1 += p.in[5][i] * p.in[6][i]; s2 += p.in[7][i] * p.in[8][i]; }
    float* sc = (float*)(p.ws + OFF_SCAL);
    sc[0] = __expf(s1) - __expf(s2) + 0.2f;
    for (int i = 0; i < 18; ++i) ((unsigned*)sc)[SC_QKMAX + i] = 0u;
  }
  {
    float* sc = (float*)(p.ws + OFF_SCAL);
    for (int i = gtid; i < 1024; i += gthreads) { sc[SC_G0 + i] = p.in[11][i]; sc[SC_G1 + i] = p.in[15][i]; sc[SC_G2 + i] = p.in[23][i]; sc[SC_G3 + i] = p.in[27][i]; }
    for (int i = gtid; i < 128; i += gthreads) sc[SC_GSUB + i] = p.in[9][i];
    for (int i = gtid; i < 8 * 465; i += gthreads) sc[SC_RPB + i] = p.in[4][i] * LOG2E;
  }
  const int tid_ = otid();
  const int lane = tid_ & 63;
  const int gw = obid() * 8 + (tid_ >> 6), nw = gridDim.x * 8;
  u16* hb = (u16*)(p.ws + OFF_R1);
  for (int row = gw; row < T_TOK; row += nw) {
    const float* xr = row < T_PROMPT ? p.in[0] + (size_t)row * DM : p.in[1] + (size_t)(row - T_PROMPT) * DM;
    float4 v[4];
    float ss = 0.f;
#pragma unroll
    for (int j = 0; j < 4; ++j) { v[j] = ((const float4*)xr)[lane + 64 * j]; ss += v[j].x * v[j].x + v[j].y * v[j].y + v[j].z * v[j].z + v[j].w * v[j].w; }
    ss = wave_sum(ss);
    const float r = rsqrtf(ss * (1.f / DM) + EPS);
#pragma unroll
    for (int j = 0; j < 4; ++j) {
      uint2 o; o.x = pack2(v[j].x * r, v[j].y * r); o.y = pack2(v[j].z * r, v[j].w * r);
      ((uint2*)(hb + (size_t)row * DM))[lane + 64 * j] = o;
    }
  }
}

template <bool FIRST, bool LAST>
DI void phase_res(const Params& p, const u16* __restrict__ mbuf, const float* __restrict__ g) {
  const int tid_ = otid();
  const int lane = tid_ & 63;
  const int gw = obid() * 8 + (tid_ >> 6), nw = gridDim.x * 8;
  u16* hb = (u16*)(p.ws + OFF_R1);
  float4 gv[4];
#pragma unroll
  for (int j = 0; j < 4; ++j) gv[j] = ((const float4*)g)[lane + 64 * j];
  for (int row = gw; row < T_TOK; row += nw) {
    const float* xr;
    if (FIRST) xr = row < T_PROMPT ? p.in[0] + (size_t)row * DM : p.in[1] + (size_t)(row - T_PROMPT) * DM;
    else xr = p.out + (size_t)row * DM;
    float4 xv[4], mv[4];
    float ss = 0.f;
#pragma unroll
    for (int j = 0; j < 4; ++j) {
      const uint2 u = ((const uint2*)(mbuf + (size_t)row * DM))[lane + 64 * j];
      mv[j] = make_float4(bflo(u.x), bfhi(u.x), bflo(u.y), bfhi(u.y));
      ss += mv[j].x * mv[j].x + mv[j].y * mv[j].y + mv[j].z * mv[j].z + mv[j].w * mv[j].w;
      xv[j] = ((const float4*)xr)[lane + 64 * j];
    }
    ss = wave_sum(ss);
    const float rm = rsqrtf(ss * (1.f / DM) + EPS);
    float s2 = 0.f;
#pragma unroll
    for (int j = 0; j < 4; ++j) {
      xv[j].x += mv[j].x * rm * gv[j].x; xv[j].y += mv[j].y * rm * gv[j].y;
      xv[j].z += mv[j].z * rm * gv[j].z; xv[j].w += mv[j].w * rm * gv[j].w;
      s2 += xv[j].x * xv[j].x + xv[j].y * xv[j].y + xv[j].z * xv[j].z + xv[j].w * xv[j].w;
      ((float4*)(p.out + (size_t)row * DM))[lane + 64 * j] = xv[j];
    }
    if (!LAST) {
      s2 = wave_sum(s2);
      const float r2 = rsqrtf(s2 * (1.f / DM) + EPS);
#pragma unroll
      for (int j = 0; j < 4; ++j) {
        uint2 o; o.x = pack2(xv[j].x * r2, xv[j].y * r2); o.y = pack2(xv[j].z * r2, xv[j].w * r2);
        ((uint2*)(hb + (size_t)row * DM))[lane + 64 * j] = o;
      }
    }
  }
}

DI void phase_mla_stats(const Params& p) {
  const int tid_ = otid();
  const int lane = tid_ & 63;
  const int gw = obid() * 8 + (tid_ >> 6), nw = gridDim.x * 8;
  const u16* c = (const u16*)(p.ws + OFF_R3);
  float* rq = (float*)(p.ws + OFF_RQ);
  float* rkv = (float*)(p.ws + OFF_RKV);
  u16* krope = (u16*)(p.ws + OFF_KROPE);
  const float2* rope = (const float2*)(p.ws + OFF_ROPE);
  for (int row = gw; row < T_TOK; row += nw) {
    const u16* cr = c + (size_t)row * 768;
    const uint4 u0 = ((const uint4*)cr)[lane];
    float s0 = 0.f;
    { float a;
      a = bflo(u0.x); s0 += a * a; a = bfhi(u0.x); s0 += a * a; a = bflo(u0.y); s0 += a * a; a = bfhi(u0.y); s0 += a * a;
      a = bflo(u0.z); s0 += a * a; a = bfhi(u0.z); s0 += a * a; a = bflo(u0.w); s0 += a * a; a = bfhi(u0.w); s0 += a * a; }
    float s1 = 0.f;
    if (lane < 16) {
      const uint4 u1 = ((const uint4*)cr)[64 + lane];
      float a;
      a = bflo(u1.x); s1 += a * a; a = bfhi(u1.x); s1 += a * a; a = bflo(u1.y); s1 += a * a; a = bfhi(u1.y); s1 += a * a;
      a = bflo(u1.z); s1 += a * a; a = bfhi(u1.z); s1 += a * a; a = bflo(u1.w); s1 += a * a; a = bfhi(u1.w); s1 += a * a;
    }
    const float sq = wave_sum(lane < 48 ? s0 : 0.f);
    const float skv = wave_sum((lane >= 48 ? s0 : 0.f) + s1);
    if (lane == 0) {
      rq[row] = rsqrtf(sq * (1.f / 384.f) + EPS);
      rkv[row] = rsqrtf(skv * (1.f / 256.f) + EPS);
    }
    if (lane < 16) {
      const float x1 = __uint_as_float((unsigned)cr[640 + lane] << 16);
      const float x2 = __uint_as_float((unsigned)cr[656 + lane] << 16);
      const float2 cs = rope[tok_pos(row) * 16 + lane];
      krope[(size_t)row * 32 + lane] = f2bf(x1 * cs.x - x2 * cs.y);
      krope[(size_t)row * 32 + 16 + lane] = f2bf(x2 * cs.x + x1 * cs.y);
    }
  }
}

DI void store_tok(u16* out, int ldo, int m, int nbase, const f32x16& v, float sc) {
  u16* q = out + (size_t)m * ldo + nbase;
#pragma unroll
  for (int g = 0; g < 4; ++g) {
    uint2 u; u.x = pack2(v[4 * g] * sc, v[4 * g + 1] * sc); u.y = pack2(v[4 * g + 2] * sc, v[4 * g + 3] * sc);
    *(uint2*)(q + 8 * g) = u;
  }
}
DI void store_tr(u16* outT, size_t ldt, int n, int mbase, const f32x16& v, const float* __restrict__ rs) {
  u16* q = outT + (size_t)n * ldt + mbase;
#pragma unroll
  for (int g = 0; g < 4; ++g) {
    float4 s = make_float4(1.f, 1.f, 1.f, 1.f);
    if (rs) s = *(const float4*)(rs + mbase + 8 * g);
    uint2 u; u.x = pack2(v[4 * g] * s.x, v[4 * g + 1] * s.y); u.y = pack2(v[4 * g + 2] * s.z, v[4 * g + 3] * s.w);
    *(uint2*)(q + 8 * g) = u;
  }
}

DI void store_tok_u(u16* ub, unsigned loff, const f32x16& v, float sc) {
  char* q = (char*)ub;
#pragma unroll
  for (int g = 0; g < 4; ++g) {
    u32x2 u; u.x = cvt_pk(v[4 * g] * sc, v[4 * g + 1] * sc); u.y = cvt_pk(v[4 * g + 2] * sc, v[4 * g + 3] * sc);
    *(u32x2*)(q + loff + 16 * g) = u;
  }
}
DI void store_tr_u(u16* ub, unsigned loff, const f32x16& v, const float* __restrict__ rs) {
  char* q = (char*)ub;
#pragma unroll
  for (int g = 0; g < 4; ++g) {
    float4 s = make_float4(1.f, 1.f, 1.f, 1.f);
    if (rs) s = *(const float4*)(rs + 8 * g);
    u32x2 u; u.x = cvt_pk(v[4 * g] * s.x, v[4 * g + 1] * s.y); u.y = cvt_pk(v[4 * g + 2] * s.z, v[4 * g + 3] * s.w);
    *(u32x2*)(q + loff + 16 * g) = u;
  }
}

struct EpiTok {
  u16* out; int ldo;
  static constexpr int SWAPMODE = 1;
  DI bool swap(int) const { return true; }
  template <int WMB, int WNB>
  DI void store(int m0w, int n0w, f32x16 (&acc)[WMB][WNB], int r, int h, bool) const {
#pragma unroll
    for (int mb = 0; mb < WMB; ++mb)
#pragma unroll
      for (int nb = 0; nb < WNB; ++nb) store_tok_u(out + (size_t)(m0w + mb * 32) * ldo + n0w + nb * 32, (unsigned)((r * ldo + 4 * h) * 2), acc[mb][nb], 1.f);
  }
};

struct EpiProj0 {
  u16* base; unsigned* qkmax;
  static constexpr int SWAPMODE = 2;
  DI bool swap(int n0) const { const int reg = n0 >> 9; return !(reg == 2 || reg == 5); }
  template <int WMB, int WNB>
  DI void store(int m0w, int n0w, f32x16 (&acc)[WMB][WNB], int r, int h, bool) const {
    const int reg = n0w >> 9, nl = n0w & 511;
    u16* buf = base + (size_t)reg * SEG512;
    const float sc = (reg == 0 || reg == 3) ? QSCALE64 : 1.f;
#pragma unroll
    for (int mb = 0; mb < WMB; ++mb)
#pragma unroll
      for (int nb = 0; nb < WNB; ++nb) store_tok_u(buf + (size_t)(m0w + mb * 32) * 512 + nl + nb * 32, (unsigned)((r * 512 + 4 * h) * 2), acc[mb][nb], sc);
    __builtin_amdgcn_sched_barrier(0);
    if (reg == 3 || reg == 4) {
      static_assert(WNB == 2, "one head per wave tile");
      float mxn = 0.f;
#pragma unroll
      for (int mb = 0; mb < WMB; ++mb) {
        float ss = 0.f;
#pragma unroll
        for (int nb = 0; nb < WNB; ++nb)
#pragma unroll
          for (int i = 0; i < 16; ++i) { const float v = acc[mb][nb][i]; ss += v * v; }
        { const u32x2 sw = __builtin_amdgcn_permlane32_swap(__float_as_uint(ss), __float_as_uint(ss), false, false); ss = __uint_as_float(sw.x) + __uint_as_float(sw.y); }
        mxn = fmaxf(mxn, ss);
      }
      mxn = fmaxf(mxn, __int_as_float(__builtin_amdgcn_ds_swizzle(__float_as_int(mxn), (16 << 10) | 0x1f)));
      mxn = fmaxf(mxn, __int_as_float(__builtin_amdgcn_ds_swizzle(__float_as_int(mxn), (8 << 10) | 0x1f)));
      mxn = fmaxf(mxn, __int_as_float(__builtin_amdgcn_ds_swizzle(__float_as_int(mxn), (4 << 10) | 0x1f)));
      mxn = fmaxf(mxn, __int_as_float(__builtin_amdgcn_ds_swizzle(__float_as_int(mxn), (2 << 10) | 0x1f)));
      mxn = fmaxf(mxn, __int_as_float(__builtin_amdgcn_ds_swizzle(__float_as_int(mxn), (1 << 10) | 0x1f)));
      if (r == 0 && h == 0) atomicMax(qkmax + (reg - 3) * 8 + (nl >> 6), __float_as_uint(sqrtf(mxn) * sc));
    }
  }
  template <int WMB, int WNB>
  DI void store_t(int n0w, int m0w, f32x16 (&acc)[WMB][WNB], int r, int h) const {
    const int reg = n0w >> 9, nl = n0w & 511;
    u16* buf = base + (size_t)reg * SEG512;
#pragma unroll
    for (int mb = 0; mb < WMB; ++mb)
#pragma unroll
      for (int nb = 0; nb < WNB; ++nb) store_tr_u(buf + (size_t)(nl + mb * 32) * T_TOK + m0w + nb * 32, (unsigned)((r * T_TOK + 4 * h) * 2), acc[mb][nb], nullptr);
  }
};

struct EpiSwiGLU {
  u16* act;
  static constexpr int SWAPMODE = 1;
  DI bool swap(int) const { return true; }
  template <int WMB, int WNB>
  DI void store(int m0w, int n0w, f32x16 (&acc)[WMB][WNB], int r, int h, bool) const {
    static_assert(WNB == 2, "swiglu epilogue needs a 64-wide wave tile");
#pragma unroll
    for (int mb = 0; mb < WMB; ++mb) {
      char* q = (char*)(act + (size_t)(m0w + mb * 32) * DFF + (n0w >> 1)) + (unsigned)((r * DFF + 4 * h) * 2);
#pragma unroll
      for (int g = 0; g < 4; ++g) {
        float y[4];
#pragma unroll
        for (int e = 0; e < 4; ++e) {
          const float gt = acc[mb][0][4 * g + e], up = acc[mb][1][4 * g + e];
          y[e] = gt / (1.f + __expf(-gt)) * up;
        }
        u32x2 u; u.x = cvt_pk(y[0], y[1]); u.y = cvt_pk(y[2], y[3]);
        *(u32x2*)(q + 16 * g) = u;
      }
      __builtin_amdgcn_sched_barrier(0);
    }
  }
};

struct EpiUQ {
  u16* q; const float* rq; const float2* rope;
  static constexpr int SWAPMODE = 1;
  DI bool swap(int) const { return true; }
  template <int WMB, int WNB>
  DI void store(int m0w, int n0w, f32x16 (&acc)[WMB][WNB], int r, int h, bool) const {
#pragma unroll
    for (int mb = 0; mb < WMB; ++mb) {
      const int m = m0w + mb * 32 + r;
      const float sc = rq[m] * QSCALE96;
      const int pos = tok_pos(m);
#pragma unroll
      for (int nb = 0; nb < WNB; ++nb) {
        const int n0b = n0w + nb * 32;
        f32x16 v = acc[mb][nb];
#pragma unroll
        for (int i = 0; i < 16; ++i) v[i] *= sc;
        if (((n0b >> 5) % 3) == 2) {
#pragma unroll
          for (int i = 0; i < 8; ++i) {
            const int f = (i & 3) + 8 * (i >> 2) + 4 * h;
            const float2 cs = rope[pos * 16 + f];
            const float x1 = v[i], x2 = v[i + 8];
            v[i] = x1 * cs.x - x2 * cs.y;
            v[i + 8] = x2 * cs.x + x1 * cs.y;
          }
        }
        store_tok_u(q + (size_t)(m0w + mb * 32) * 1536 + n0b, (unsigned)((r * 1536 + 4 * h) * 2), v, 1.f);
        __builtin_amdgcn_sched_barrier(0);
      }
    }
  }
};

struct EpiUKV {
  u16* knope; u16* vt; const float* rkv;
  static constexpr int SWAPMODE = 2;
  DI bool swap(int n0) const { return n0 < 1024; }
  template <int WMB, int WNB>
  DI void store(int m0w, int n0w, f32x16 (&acc)[WMB][WNB], int r, int h, bool) const {
#pragma unroll
    for (int mb = 0; mb < WMB; ++mb) {
      const int m = m0w + mb * 32 + r;
      const float sc = rkv[m];
#pragma unroll
      for (int nb = 0; nb < WNB; ++nb) store_tok_u(knope + (size_t)(m0w + mb * 32) * 1024 + n0w + nb * 32, (unsigned)((r * 1024 + 4 * h) * 2), acc[mb][nb], sc);
    }
  }
  template <int WMB, int WNB>
  DI void store_t(int n0w, int m0w, f32x16 (&acc)[WMB][WNB], int r, int h) const {
#pragma unroll
    for (int mb = 0; mb < WMB; ++mb)
#pragma unroll
      for (int nb = 0; nb < WNB; ++nb) store_tr_u(vt + (size_t)(n0w - 1024 + mb * 32) * T_TOK + m0w + nb * 32, (unsigned)((r * T_TOK + 4 * h) * 2), acc[mb][nb], rkv + m0w + nb * 32 + 4 * h);
  }
};

template <bool SWAP, int WMB, int WNB>
DI void gemm_compute(const char* la, const char* lb, f32x16 (&acc)[WMB][WNB], int wm, int wn, int r, int h) {
#pragma unroll
  for (int ks = 0; ks < 4; ++ks) {
    bf16x8 af[WMB], bfr[WNB];
#pragma unroll
    for (int mb = 0; mb < WMB; ++mb) af[mb] = *(const bf16x8*)(la + (wm * 32 * WMB + mb * 32 + r) * 144 + (ks * 2 + h) * 16);
#pragma unroll
    for (int nb = 0; nb < WNB; ++nb) bfr[nb] = *(const bf16x8*)(lb + (wn * 32 * WNB + nb * 32 + r) * 144 + (ks * 2 + h) * 16);
#pragma unroll
    for (int mb = 0; mb < WMB; ++mb)
#pragma unroll
      for (int nb = 0; nb < WNB; ++nb) {
        if (SWAP) acc[mb][nb] = MFMA32(bfr[nb], af[mb], acc[mb][nb]);
        else acc[mb][nb] = MFMA32(af[mb], bfr[nb], acc[mb][nb]);
      }
  }
}

template <class Epi>
DI void gemm_tile(const char* __restrict__ Ab, unsigned aoff, int lda, const char* __restrict__ Bb, unsigned boff, int ldb, int nk, int m0, int n0, const Epi& epi, char* lds, bool normal) {
  constexpr int WMB = 4, WNB = 2;
  constexpr int TM = 256, TN = 256;
  constexpr int STAGE = (TM + TN) * 144;
  const int tid = otid(), lane = tid & 63, w = __builtin_amdgcn_readfirstlane(tid >> 6), wm = w >> 2, wn = w & 3, r = lane & 31, h = lane >> 5;
  const int lrow = tid >> 3, lch = tid & 7;
  u32x4 pa[4], pb[4];
  f32x16 acc[WMB][WNB];
#pragma unroll
  for (int mb = 0; mb < WMB; ++mb)
#pragma unroll
    for (int nb = 0; nb < WNB; ++nb)
#pragma unroll
      for (int i = 0; i < 16; ++i) acc[mb][nb][i] = 0.f;
#pragma unroll
  for (int j = 0; j < 4; ++j) pa[j] = *(const u32x4*)(Ab + (size_t)j * 128 * lda + aoff);
#pragma unroll
  for (int j = 0; j < 4; ++j) pb[j] = *(const u32x4*)(Bb + (size_t)j * 128 * ldb + boff);
  {
    char* la = lds; char* lb = lds + TM * 144;
#pragma unroll
    for (int j = 0; j < 4; ++j) *(u32x4*)(la + (lrow + 64 * j) * 144 + lch * 16) = pa[j];
#pragma unroll
    for (int j = 0; j < 4; ++j) *(u32x4*)(lb + (lrow + 64 * j) * 144 + lch * 16) = pb[j];
  }
  if (nk > 1) {
#pragma unroll
    for (int j = 0; j < 4; ++j) pa[j] = *(const u32x4*)(Ab + ((size_t)j * 128 * lda + 128) + aoff);
#pragma unroll
    for (int j = 0; j < 4; ++j) pb[j] = *(const u32x4*)(Bb + ((size_t)j * 128 * ldb + 128) + boff);
  }
  __syncthreads();
  auto stage_next = [&](int kt) {
    if (kt + 1 < nk) {
      char* wa = lds + ((kt + 1) & 1) * STAGE;
      char* wb = wa + TM * 144;
#pragma unroll
      for (int j = 0; j < 4; ++j) *(u32x4*)(wa + (lrow + 64 * j) * 144 + lch * 16) = pa[j];
#pragma unroll
      for (int j = 0; j < 4; ++j) *(u32x4*)(wb + (lrow + 64 * j) * 144 + lch * 16) = pb[j];
    }
    if (kt + 2 < nk) {
#pragma unroll
      for (int j = 0; j < 4; ++j) pa[j] = *(const u32x4*)(Ab + ((size_t)j * 128 * lda + (size_t)(kt + 2) * 128) + aoff);
#pragma unroll
      for (int j = 0; j < 4; ++j) pb[j] = *(const u32x4*)(Bb + ((size_t)j * 128 * ldb + (size_t)(kt + 2) * 128) + boff);
    }
  };
  if (w < 4) {
    for (int kt = 0; kt < nk; ++kt) {
      const char* la = lds + (kt & 1) * STAGE;
      stage_next(kt);
      __builtin_amdgcn_sched_barrier(0);
      gemm_compute<true, WMB, WNB>(la, la + TM * 144, acc, wm, wn, r, h);
      __syncthreads();
    }
  } else {
    for (int kt = 0; kt < nk; ++kt) {
      const char* la = lds + (kt & 1) * STAGE;
      gemm_compute<true, WMB, WNB>(la, la + TM * 144, acc, wm, wn, r, h);
      __builtin_amdgcn_sched_barrier(0);
      stage_next(kt);
      __syncthreads();
    }
  }
  asm volatile("" : "+s"(m0), "+s"(n0));
  int r2 = r, h2 = h, wm2 = wm, wn2 = wn;
  asm volatile("" : "+v"(r2), "+v"(h2));
  asm volatile("" : "+s"(wm2), "+s"(wn2));
  if constexpr (Epi::SWAPMODE == 2) {
    if (normal) epi.template store<WMB, WNB>(m0 + wm2 * 32 * WMB, n0 + wn2 * 32 * WNB, acc, r2, h2, true);
    else epi.template store_t<WMB, WNB>(n0 + wm2 * 32 * WMB, m0 + wn2 * 32 * WNB, acc, r2, h2);
  } else {
    epi.template store<WMB, WNB>(m0 + wm2 * 32 * WMB, n0 + wn2 * 32 * WNB, acc, r2, h2, true);
  }
}

template <class Epi>
DI void gemm_phase(const u16* __restrict__ A, int lda, const u16* __restrict__ Bt, int ldb, int M, int N, int K, const Epi epi, char* lds, int bid, int nblk) {
  constexpr int TM = 256, TN = 256;
  const int tid = otid();
  const int NT = N / TN, MT = M / TM, tiles = MT * NT, nk = K >> 6;
  const int lrow = tid >> 3, lch = tid & 7;
  for (int t0 = bid; t0 < ((tiles + nblk - 1) / nblk) * nblk; t0 += nblk) {
    int tile = t0;
    if (nblk == 256) tile = (t0 & ~255) + (bid & 7) * 32 + (bid >> 3);
    if (tile >= tiles) continue;
    const int grp = tile / (8 * NT), within = tile - grp * (8 * NT);
    const int nt = within >> 3, mt = grp * 8 + (within & 7);
    const int m0 = mt * TM, n0 = nt * TN;
    const char* Ab = (const char*)A + (size_t)m0 * lda * 2;
    const char* Bb = (const char*)Bt + (size_t)n0 * ldb * 2;
    const unsigned aoff = (unsigned)(lrow * lda * 2 + lch * 16), boff = (unsigned)(lrow * ldb * 2 + lch * 16);
    if constexpr (Epi::SWAPMODE == 2) {
      const bool normal = epi.swap(n0);
      gemm_tile(normal ? Ab : Bb, normal ? aoff : boff, normal ? lda : ldb, normal ? Bb : Ab, normal ? boff : aoff, normal ? ldb : lda, nk, m0, n0, epi, lds, normal);
    } else {
      gemm_tile(Ab, aoff, lda, Bb, boff, ldb, nk, m0, n0, epi, lds, true);
    }
  }
}

DI void lds_st16_as2x8(char* dst, const u32x4 v) {
  u32x2 a; a.x = v.x; a.y = v.y; u32x2 b; b.x = v.z; b.y = v.w;
  *(u32x2*)dst = a;
  *(u32x2*)(dst + 8) = b;
}
constexpr int ATT_STAGE = 35840;
constexpr float DEFER_THR = 8.f;

template <int DQK>
DI void qk_scores_qlds(const char* kl, const char* qsl, f32x16 (&s)[2], int r, int h) {
  constexpr int KS = DQK * 2 + 16;
#pragma unroll
  for (int kb = 0; kb < 2; ++kb) {
#pragma unroll
    for (int ks = 0; ks < DQK / 16; ++ks) {
      const bf16x8 a = *(const bf16x8*)(kl + (32 * kb + r) * KS + (2 * ks + h) * 16);
      const bf16x8 qv = *(const bf16x8*)(qsl + ks * 1024);
      s[kb] = MFMA32(a, qv, s[kb]);
    }
  }
}
template <int DQK>
DI void qk_scores(const char* kl, const bf16x8 (&qf)[DQK / 16], const f32x16& initv, f32x16 (&s)[2], int r, int h) {
  constexpr int KS = DQK * 2 + 16;
#pragma unroll
  for (int kb = 0; kb < 2; ++kb) {
    s[kb] = initv;
#pragma unroll
    for (int ks = 0; ks < DQK / 16; ++ks) {
      const bf16x8 a = *(const bf16x8*)(kl + (32 * kb + r) * KS + (2 * ks + h) * 16);
      s[kb] = MFMA32(a, qf[ks], s[kb]);
    }
  }
}

template <int DV>
DI float softmax_pv(f32x16 (&s)[2], f32x16 (&o)[DV / 32], float& l, bool first, const char* vl, int r, int h) {
  float dret = 0.f;
  float mx = fmaxf(fmaxf(s[0][0], s[0][1]), s[0][2]);
#pragma unroll
  for (int i = 3; i < 15; i += 2) mx = fmaxf(fmaxf(mx, s[0][i]), s[0][i + 1]);
  mx = fmaxf(fmaxf(mx, s[0][15]), s[1][0]);
#pragma unroll
  for (int i = 1; i < 15; i += 2) mx = fmaxf(fmaxf(mx, s[1][i]), s[1][i + 1]);
  mx = fmaxf(mx, s[1][15]);
  const bool need = first || (mx > DEFER_THR);
  if (__any(need)) {
    mx = fmaxf(mx, __shfl_xor(mx, 32));
    float delta;
    if (first) delta = mx;
    else {
      delta = fmaxf(mx, 0.f);
      const float alpha = fexp2(-delta);
      l *= alpha;
#pragma unroll
      for (int d = 0; d < DV / 32; ++d)
#pragma unroll
        for (int i = 0; i < 16; ++i) o[d][i] *= alpha;
    }
#pragma unroll
    for (int kb = 0; kb < 2; ++kb)
#pragma unroll
      for (int i = 0; i < 16; ++i) s[kb][i] -= delta;
    dret = delta;
  }
  float ps = 0.f;
#pragma unroll
  for (int kb = 0; kb < 2; ++kb)
#pragma unroll
    for (int i = 0; i < 16; ++i) { const float e = fexp2(s[kb][i]); s[kb][i] = e; ps += e; }
  l += ps;
  bf16x8 pf[2][2];
#pragma unroll
  for (int kb = 0; kb < 2; ++kb)
#pragma unroll
    for (int st = 0; st < 2; ++st) {
      u32x4 u;
      u.x = cvt_pk(s[kb][8 * st + 0], s[kb][8 * st + 1]); u.y = cvt_pk(s[kb][8 * st + 2], s[kb][8 * st + 3]);
      u.z = cvt_pk(s[kb][8 * st + 4], s[kb][8 * st + 5]); u.w = cvt_pk(s[kb][8 * st + 6], s[kb][8 * st + 7]);
      pf[kb][st] = __builtin_bit_cast(bf16x8, u);
    }
#pragma unroll
  for (int d = 0; d < DV / 32; ++d)
#pragma unroll
    for (int kb = 0; kb < 2; ++kb)
#pragma unroll
      for (int st = 0; st < 2; ++st) {
        const char* vp = vl + (32 * d + r) * 136 + (32 * kb + 16 * st + 4 * h) * 2;
        const u32x2 lo = *(const u32x2*)vp;
        const u32x2 hi = *(const u32x2*)(vp + 16);
        u32x4 u; u.x = lo.x; u.y = lo.y; u.z = hi.x; u.w = hi.y;
        o[d] = MFMA32(__builtin_bit_cast(bf16x8, u), pf[kb][st], o[d]);
      }
  return dret;
}

template <int DV>
DI float softmax_pre(f32x16 (&s)[2], f32x16 (&o)[DV / 32], float& l, bool first) {
  float dret = 0.f;
  float mx = fmaxf(fmaxf(s[0][0], s[0][1]), s[0][2]);
#pragma unroll
  for (int i = 3; i < 15; i += 2) mx = fmaxf(fmaxf(mx, s[0][i]), s[0][i + 1]);
  mx = fmaxf(fmaxf(mx, s[0][15]), s[1][0]);
#pragma unroll
  for (int i = 1; i < 15; i += 2) mx = fmaxf(fmaxf(mx, s[1][i]), s[1][i + 1]);
  mx = fmaxf(mx, s[1][15]);
  const bool need = first || (mx > DEFER_THR);
  if (__any(need)) {
    mx = fmaxf(mx, __shfl_xor(mx, 32));
    float delta;
    if (first) delta = mx;
    else {
      delta = fmaxf(mx, 0.f);
      const float alpha = fexp2(-delta);
      l *= alpha;
#pragma unroll
      for (int d = 0; d < DV / 32; ++d)
#pragma unroll
        for (int i = 0; i < 16; ++i) o[d][i] *= alpha;
    }
#pragma unroll
    for (int kb = 0; kb < 2; ++kb)
#pragma unroll
      for (int i = 0; i < 16; ++i) s[kb][i] -= delta;
    dret = delta;
  }
  return dret;
}
DI void softmax_exp_half(f32x16& s, float& l, bf16x8 (&pf)[2]) {
  float ps = 0.f;
#pragma unroll
  for (int i = 0; i < 16; ++i) { const float e = fexp2(s[i]); s[i] = e; ps += e; }
  l += ps;
#pragma unroll
  for (int st = 0; st < 2; ++st) {
    u32x4 u;
    u.x = cvt_pk(s[8 * st + 0], s[8 * st + 1]); u.y = cvt_pk(s[8 * st + 2], s[8 * st + 3]);
    u.z = cvt_pk(s[8 * st + 4], s[8 * st + 5]); u.w = cvt_pk(s[8 * st + 6], s[8 * st + 7]);
    pf[st] = __builtin_bit_cast(bf16x8, u);
  }
}
template <int DV>
DI void pv_half(const bf16x8 (&pf)[2], f32x16 (&o)[DV / 32], const char* vl, int kb, int r, int h) {
#pragma unroll
  for (int d = 0; d < DV / 32; ++d)
#pragma unroll
    for (int st = 0; st < 2; ++st) {
      const char* vp = vl + (32 * d + r) * 136 + (32 * kb + 16 * st + 4 * h) * 2;
      const u32x2 lo = *(const u32x2*)vp;
      const u32x2 hi = *(const u32x2*)(vp + 16);
      u32x4 u; u.x = lo.x; u.y = lo.y; u.z = hi.x; u.w = hi.y;
      o[d] = MFMA32(__builtin_bit_cast(bf16x8, u), pf[st], o[d]);
    }
}

template <int ABL>
DI void attn_mla_item(const Params& p, int item, char* lds) {
  constexpr int DQK = 96, DV = 64, KS = DQK * 2 + 16;
  const int tid = otid(), lane = tid & 63, w = tid >> 6, r = lane & 31, h = lane >> 5;
  int head, qb, ts0, S;
  if (item < 1024) { head = item >> 6; qb = item & 63; ts0 = T_PROMPT; S = 16384; }
  else { const int it = item - 1024; qb = it & 15; head = (it >> 4) & 15; ts0 = (it >> 8) * 4096; S = 4096; }
  const u16* q = (const u16*)(p.ws + OFF_R2);
  const u16* knope = q + (size_t)T_TOK * 1536;
  const u16* vt = knope + (size_t)T_TOK * 1024;
  const u16* krope = (const u16*)(p.ws + OFF_KROPE);
  u16* o1 = (u16*)(p.ws + OFF_R1);
  const int tq = ts0 + qb * 256 + w * 32 + r;
  bf16x8 qf[DQK / 16];
#pragma unroll
  for (int ks = 0; ks < DQK / 16; ++ks) qf[ks] = *(const bf16x8*)(q + (size_t)tq * 1536 + head * 96 + 16 * ks + 8 * h);
  f32x16 o[DV / 32];
#pragma unroll
  for (int d = 0; d < DV / 32; ++d)
#pragma unroll
    for (int i = 0; i < 16; ++i) o[d][i] = 0.f;
  f32x16 initv;
#pragma unroll
  for (int i = 0; i < 16; ++i) initv[i] = 0.f;
  float l = 0.f;
  u32x4 pk0, pk1, pv0;
  const int c1 = 512 + tid;
  const int krow0 = tid / 12, kch0 = tid - krow0 * 12;
  const int krow1 = c1 / 12, kch1 = c1 - krow1 * 12;
  const int vrow = tid >> 3, vch = tid & 7;
  const int nkt = S >> 6;
  auto prefetch = [&](int kt) {
    const int tk0 = ts0 + kt * 64;
    {
      const u16* src = kch0 < 8 ? knope + (size_t)(tk0 + krow0) * 1024 + head * 64 + kch0 * 8 : krope + (size_t)(tk0 + krow0) * 32 + (kch0 - 8) * 8;
      pk0 = *(const u32x4*)src;
    }
    if (tid < 256) {
      const u16* src = kch1 < 8 ? knope + (size_t)(tk0 + krow1) * 1024 + head * 64 + kch1 * 8 : krope + (size_t)(tk0 + krow1) * 32 + (kch1 - 8) * 8;
      pk1 = *(const u32x4*)src;
    }
    pv0 = *(const u32x4*)(vt + (size_t)(head * 64 + vrow) * T_TOK + tk0 + vch * 8);
  };
  auto stage_at = [&](int boff) {
    char* kl = lds + boff;
    char* vl = kl + 64 * KS;
    *(u32x4*)(kl + krow0 * KS + kch0 * 16) = pk0;
    if (tid < 256) *(u32x4*)(kl + krow1 * KS + kch1 * 16) = pk1;
    lds_st16_as2x8(vl + vrow * 136 + vch * 16, pv0);
  };
  prefetch(0);
  __syncthreads();
  stage_at(0);
  prefetch(1);
  stage_at(ATT_STAGE);
  if (nkt > 2) prefetch(2);
  __syncthreads();
  int cur = 0, nxt = ATT_STAGE, nn = 2 * ATT_STAGE;
  f32x16 s[2];
  qk_scores<DQK>(lds, qf, initv, s, r, h);
#pragma unroll 1
  for (int kt = 0; kt < nkt; ++kt) {
    if (ABL == 2) { __syncthreads(); if (kt + 2 < nkt) stage_at(nn); if (kt + 3 < nkt) prefetch(kt + 3); { const int t = cur; cur = nxt; nxt = nn; nn = t; } continue; }
    const float dl = softmax_pre<DV>(s, o, l, kt == 0);
    if (__any(dl != 0.f)) {
#pragma unroll
      for (int i = 0; i < 16; ++i) initv[i] -= dl;
    }
    f32x16 sn[2];
    qk_scores<DQK>(lds + nxt, qf, initv, sn, r, h);
#pragma unroll
    for (int kb = 0; kb < 2; ++kb) {
      bf16x8 pf[2];
      softmax_exp_half(s[kb], l, pf);
      pv_half<DV>(pf, o, lds + cur + 64 * KS, kb, r, h);
    }
    if (ABL != 1) { if (kt + 2 < nkt) stage_at(nn);
    if (kt + 3 < nkt) prefetch(kt + 3); }
    __syncthreads();
    s[0] = sn[0]; s[1] = sn[1];
    const int t = cur; cur = nxt; nxt = nn; nn = t;
  }
  l += __shfl_xor(l, 32);
  const float inv = 1.f / l;
#pragma unroll
  for (int d = 0; d < DV / 32; ++d) store_tok(o1, 1024, tq, head * 64 + 32 * d + 4 * h, o[d], inv);
}

DI void diff_decode(int item, int& hh, int& qb, int& ts0, int& S) {
  int j;
  if (item < 128) { hh = 3; j = item; S = 16384; }
  else if (item < 256) { hh = 2; j = item - 128; S = 16384; }
  else if (item < 768) { hh = 3; j = item - 256; S = 4096; }
  else if (item < 1280) { hh = 2; j = item - 768; S = 4096; }
  else if (item < 1408) { hh = 1; j = item - 1280; S = 16384; }
  else if (item < 1920) { hh = 1; j = item - 1408; S = 4096; }
  else if (item < 2048) { hh = 0; j = item - 1920; S = 16384; }
  else { hh = 0; j = item - 2048; S = 4096; }
  if (S == 16384) { qb = j; ts0 = T_PROMPT; } else { qb = j & 31; ts0 = (j >> 5) * 4096; }
}
DI void attn_diff_item(const Params& p, int item, char* lds) {
  constexpr int DQK = 64, DV = 128, KS = DQK * 2 + 16;
  const int tid = otid(), lane = tid & 63, w = tid >> 6, r = lane & 31, h = lane >> 5;
  const int map = w >> 2, qw = w & 3;
  int hh, qb, ts0, S;
  diff_decode(item, hh, qb, ts0, S);
  const u16* base = (const u16*)(p.ws + OFF_R2);
  const u16* dq = base + 3 * SEG512;
  const u16* dk = base + 4 * SEG512;
  const u16* vtd = base + 5 * SEG512;
  u16* o0 = (u16*)(p.ws + OFF_R1);
  const int qpos = qb * 128 + qw * 32 + r;
  const int tq = ts0 + qpos;
  char* qsl = lds + 3 * ATT_STAGE + 4096 + w * 4096 + lane * 16;
  __syncthreads();
#pragma unroll
  for (int ks = 0; ks < DQK / 16; ++ks) *(bf16x8*)(qsl + ks * 1024) = *(const bf16x8*)(dq + (size_t)tq * 512 + (2 * hh + map) * 64 + 16 * ks + 8 * h);
  f32x16 o[DV / 32];
#pragma unroll
  for (int d = 0; d < DV / 32; ++d)
#pragma unroll
    for (int i = 0; i < 16; ++i) o[d][i] = 0.f;
  float l = 0.f;
  float ref = 0.f;
  const float slope2 = exp2f(-2.f * (float)(hh + 1)) * LOG2E;
  const float cq = slope2 * (float)qpos;
  const int d0 = 2 * qb;
  const int kd = d0 + (qw >> 1);
  int kt_lo, kt_hi;
  {
    const unsigned* qk = (const unsigned*)(p.ws + OFF_SCAL) + SC_QKMAX;
    const float b0 = __uint_as_float(qk[2 * hh]) * __uint_as_float(qk[8 + 2 * hh]);
    const float b1 = __uint_as_float(qk[2 * hh + 1]) * __uint_as_float(qk[8 + 2 * hh + 1]);
    const float B = fmaxf(b0, b1) * 1.02f + 0.5f;
    const float dskip = fminf((2.f * B + 34.f) / slope2 + 1.f, 1.0e6f);
    const int q_lo = qb * 128, q_hi = q_lo + 127, ds = (int)dskip;
    kt_lo = max(0, (q_lo - 63 - ds) >> 6);
    kt_hi = min((S >> 6) - 1, (q_hi + ds) >> 6);
    kt_lo = min(kt_lo, 2 * qb); kt_hi = max(kt_hi, 2 * qb + 1);
  }
  const int nleft = d0 - kt_lo;
  const int nkt = kt_hi - kt_lo + 1;
  u32x4 pk[2], pv[2];
  const int lrow = tid >> 3, lch = tid & 7;
  auto tile_of = [&](int idx) { return idx < 2 ? d0 + idx : (idx - 2 < nleft ? d0 - 1 - (idx - 2) : idx + kt_lo); };
  const unsigned koff = (unsigned)(((ts0 + lrow) * 512 + 2 * hh * 64 + lch * 8) * 2);
  const unsigned voff = (unsigned)((((hh * 128 + lrow) * T_TOK) + ts0 + lch * 8) * 2);
  const char* dkb = (const char*)dk;
  const char* vtb = (const char*)vtd;
  auto prefetch = [&](int kt) {
    const unsigned ko = koff + (unsigned)kt * (64u * 512u * 2u);
    const unsigned vo = voff + (unsigned)kt * 128u;
    pk[0] = *(const u32x4*)(dkb + ko);
    pk[1] = *(const u32x4*)(dkb + ko + 128u);
    pv[0] = *(const u32x4*)(vtb + vo);
    pv[1] = *(const u32x4*)(vtb + vo + (unsigned)(64 * T_TOK * 2));
  };
  auto stage_at = [&](int boff) {
    char* kl0 = lds + boff;
    char* vl = kl0 + 2 * 64 * KS;
#pragma unroll
    for (int j = 0; j < 2; ++j) *(u32x4*)(kl0 + j * 64 * KS + lrow * KS + lch * 16) = pk[j];
#pragma unroll
    for (int j = 0; j < 2; ++j) lds_st16_as2x8(vl + (lrow + 64 * j) * 136 + lch * 16, pv[j]);
  };
  auto scores = [&](int kt, int boff, f32x16 (&sc)[2]) {
    const int side = kt < kd ? -1 : (kt > kd ? 1 : 0);
    const float I = (float)side * cq - ref;
    const unsigned i_hi = cvt_pk(I, 0.f) & 0xffffu;
    const float ir1 = I - __uint_as_float(i_hi << 16);
    const unsigned i_mid = cvt_pk(ir1, 0.f) & 0xffffu;
    const float ir2 = ir1 - __uint_as_float(i_mid << 16);
    const unsigned i_lo = cvt_pk(ir2, 0.f) & 0xffffu;
    const float T = slope2 * (float)(kt * 64);
    const unsigned t_hi = cvt_pk(T, 0.f) & 0xffffu;
    const float r1 = T - __uint_as_float(t_hi << 16);
    const unsigned t_mid = cvt_pk(r1, 0.f) & 0xffffu;
    const float r2 = r1 - __uint_as_float(t_mid << 16);
    const unsigned t_lo = cvt_pk(r2, 0.f) & 0xffffu;
    const unsigned one = side < 0 ? 0x3F80u : (side > 0 ? 0xBF80u : 0u);
    u32x4 qa;
    qa.x = h == 0 ? (one | (one << 16)) : 0u; qa.y = qa.x; qa.z = h == 0 ? (one | (i_hi << 16)) : 0u; qa.w = h == 0 ? (i_mid | (i_lo << 16)) : 0u;
    const bf16x8 qaug = __builtin_bit_cast(bf16x8, qa);
#pragma unroll
    for (int kb = 0; kb < 2; ++kb) {
      const float xl = slope2 * (float)(32 * kb + r);
      const unsigned l_hi = cvt_pk(xl, 0.f) & 0xffffu;
      const unsigned l_lo = cvt_pk(xl - __uint_as_float(l_hi << 16), 0.f) & 0xffffu;
      u32x4 ka; ka.x = h == 0 ? (l_hi | (l_lo << 16)) : 0u; ka.y = h == 0 ? (t_hi | (t_mid << 16)) : 0u; ka.z = h == 0 ? (t_lo | 0x3F800000u) : 0u; ka.w = h == 0 ? 0x3F803F80u : 0u;
      f32x16 z;
#pragma unroll
      for (int i = 0; i < 16; ++i) z[i] = 0.f;
      sc[kb] = MFMA32(__builtin_bit_cast(bf16x8, ka), qaug, z);
    }
    qk_scores_qlds<DQK>(lds + boff + map * 64 * KS, qsl, sc, r, h);
  };
  prefetch(tile_of(0));
  __syncthreads();
  stage_at(0);
  prefetch(tile_of(1));
  stage_at(ATT_STAGE);
  if (nkt > 2) prefetch(tile_of(2));
  __syncthreads();
  int cur = 0, nxt = ATT_STAGE, nn = 2 * ATT_STAGE;
  f32x16 s[2];
  scores(tile_of(0), 0, s);
#pragma unroll 1
  for (int idx = 0; idx < nkt; ++idx) {
    const int kt = tile_of(idx);
    if (kt == kd) {
#pragma unroll
      for (int kb = 0; kb < 2; ++kb)
#pragma unroll
        for (int i = 0; i < 16; ++i) {
          const int kp = kt * 64 + 32 * kb + (i & 3) + 8 * (i >> 2) + 4 * h;
          s[kb][i] -= slope2 * fabsf((float)(qpos - kp));
        }
    }
    ref += softmax_pre<DV>(s, o, l, idx == 0);
    f32x16 sn[2];
    scores(tile_of(min(idx + 1, nkt - 1)), nxt, sn);
#pragma unroll
    for (int kb = 0; kb < 2; ++kb) {
      bf16x8 pf[2];
      softmax_exp_half(s[kb], l, pf);
      pv_half<DV>(pf, o, lds + cur + 2 * 64 * KS, kb, r, h);
    }
    if (idx + 2 < nkt) stage_at(nn);
    if (idx + 3 < nkt) prefetch(tile_of(idx + 3));
    __syncthreads();
    s[0] = sn[0]; s[1] = sn[1];
    const int t = cur; cur = nxt; nxt = nn; nn = t;
  }
  l += __shfl_xor(l, 32);
  const float inv = 1.f / l;
  int tid2 = otid();
  const int lane2 = tid2 & 63, qw2 = (tid2 >> 6) & 3, h2 = lane2 >> 5;
  int item2 = item; asm volatile("" : "+s"(item2));
  int hh2, tq2;
  { int qb2, ts02, S2; diff_decode(item2, hh2, qb2, ts02, S2); tq2 = ts02 + qb2 * 128 + qw2 * 32 + (lane2 & 31); }
  float* ex = (float*)lds + qw2 * 4096;
  if (map == 1) {
#pragma unroll
    for (int d = 0; d < DV / 32; ++d)
#pragma unroll
      for (int i = 0; i < 16; ++i) ex[(d * 16 + i) * 64 + lane2] = o[d][i] * inv;
  }
  __syncthreads();
  if (map == 0) {
    const float lam = ((const float*)(p.ws + OFF_SCAL))[0];
    float ss = 0.f;
#pragma unroll
    for (int d = 0; d < DV / 32; ++d)
#pragma unroll
      for (int i = 0; i < 16; ++i) { const float v = o[d][i] * inv - lam * ex[(d * 16 + i) * 64 + lane2]; o[d][i] = v; ss += v * v; }
    ss += __shfl_xor(ss, 32);
    const float rn = rsqrtf(ss * (1.f / 128.f) + EPS) * 0.8f;
    const float* gs = (const float*)(p.ws + OFF_SCAL) + SC_GSUB;
#pragma unroll
    for (int d = 0; d < DV / 32; ++d) {
#pragma unroll
      for (int g = 0; g < 4; ++g) {
        const float4 gv = *(const float4*)(gs + 32 * d + 8 * g + 4 * h2);
        o[d][4 * g] *= gv.x; o[d][4 * g + 1] *= gv.y; o[d][4 * g + 2] *= gv.z; o[d][4 * g + 3] *= gv.w;
      }
      store_tok(o0, 1024, tq2, 512 + hh2 * 128 + 32 * d + 4 * h2, o[d], rn);
    }
  }
}

DI void attn_na_item(const Params& p, int item, char* lds) {
  constexpr int DQK = 64, DV = 64, KS = DQK * 2 + 16;
  const int tid = otid(), lane = tid & 63, w = tid >> 6, r = lane & 31, h = lane >> 5;
  const int quad = item % 320, head = item / 320;
  const int t0 = quad * 256;
  int ts0, rows;
  if (t0 < T_PROMPT) { ts0 = t0 & ~4095; rows = 64; } else { ts0 = T_PROMPT; rows = 256; }
  const int r0 = (t0 - ts0) >> 6;
  const int rw = r0 + (w >> 1);
  const int rs_lo = min(max(r0 - 4, 0), rows - 8);
  const int rs_hi = min(max(r0 + 3 - 4, 0), rows - 8);
  const int rs_w = min(max(rw - 4, 0), rows - 8);
  const int ntile = rs_hi + 8 - rs_lo;
  const u16* base = (const u16*)(p.ws + OFF_R2);
  const u16* qn = base;
  const u16* kn = base + SEG512;
  const u16* vtn = base + 2 * SEG512;
  u16* o0 = (u16*)(p.ws + OFF_R1);
  float* tab = (float*)(lds + 2 * ATT_STAGE) + 64;
  const int qc = (w & 1) * 32 + r;
  const int tq = t0 + w * 32 + r;
  bf16x8 qf[DQK / 16];
#pragma unroll
  for (int ks = 0; ks < DQK / 16; ++ks) qf[ks] = *(const bf16x8*)(qn + (size_t)tq * 512 + head * 64 + 16 * ks + 8 * h);
  f32x16 o[DV / 32];
#pragma unroll
  for (int d = 0; d < DV / 32; ++d)
#pragma unroll
    for (int i = 0; i < 16; ++i) o[d][i] = 0.f;
  f32x16 initv;
#pragma unroll
  for (int i = 0; i < 16; ++i) initv[i] = 0.f;
  float l = 0.f;
  bool first = true;
  u32x4 pk0, pv0;
  const int lrow = tid >> 3, lch = tid & 7;
  auto prefetch = [&](int j) {
    const int tk0 = ts0 + (rs_lo + j) * 64;
    pk0 = *(const u32x4*)(kn + (size_t)(tk0 + lrow) * 512 + head * 64 + lch * 8);
    pv0 = *(const u32x4*)(vtn + (size_t)(head * 64 + lrow) * T_TOK + tk0 + lch * 8);
  };
  auto stage = [&](int b) {
    char* kl = lds + b * ATT_STAGE;
    char* vl = kl + 64 * KS;
    *(u32x4*)(kl + lrow * KS + lch * 16) = pk0;
    lds_st16_as2x8(vl + lrow * 136 + lch * 16, pv0);
  };
  prefetch(0);
  __syncthreads();
  if (tid < 465) tab[tid] = ((const float*)(p.ws + OFF_SCAL))[SC_RPB + head * 465 + tid];
  stage(0);
  prefetch(1);
  __syncthreads();
  const int wc0 = min(max(qc - 8, 0), 48);
  const float* tabq = tab + (15 - qc + 4 * h);
  for (int j = 0; j < ntile; ++j) {
    const char* kl = lds + (j & 1) * ATT_STAGE;
    const char* vl = kl + 64 * KS;
    const int kr = rs_lo + j;
    if (kr >= rs_w && kr < rs_w + 8) {
      f32x16 s[2];
      qk_scores<DQK>(kl, qf, initv, s, r, h);
      const int ridx = kr - rw + 7;
#pragma unroll
      for (int kb = 0; kb < 2; ++kb)
#pragma unroll
        for (int i = 0; i < 16; ++i) {
          const int kc = 32 * kb + (i & 3) + 8 * (i >> 2) + 4 * h;
          const bool ok = (unsigned)(kc - wc0) < 16u;
          const float b = tabq[ridx * 31 + 32 * kb + (i & 3) + 8 * (i >> 2)];
          s[kb][i] = ok ? s[kb][i] + b : -INFINITY;
        }
      {
        const float dl = softmax_pv<DV>(s, o, l, first, vl, r, h);
        if (__any(dl != 0.f)) {
#pragma unroll
          for (int i = 0; i < 16; ++i) initv[i] -= dl;
        }
      }
      first = false;
    }
    if (j + 1 < ntile) stage((j + 1) & 1);
    if (j + 2 < ntile) prefetch(j + 2);
    __syncthreads();
  }
  l += __shfl_xor(l, 32);
  const float inv = 1.f / l;
#pragma unroll
  for (int d = 0; d < DV / 32; ++d) store_tok(o0, 1024, tq, head * 64 + 32 * d + 4 * h, o[d], inv);
}

constexpr int LDS_BYTES = 2 * (256 + 256) * 144;
template <int PH>
DI void run_phase(const Params& p, char* lds) {
  const int bid = obid(), nblk = gridDim.x;
  u16* wb = (u16*)p.ws;
  u16* R1 = (u16*)(p.ws + OFF_R1);
  u16* R2 = (u16*)(p.ws + OFF_R2);
  u16* R3 = (u16*)(p.ws + OFF_R3);
  if constexpr (PH == 0) phase_prep(p);
  else if constexpr (PH == 1) gemm_phase(R1, 1024, wb + W0IN, 1024, T_TOK, 3072, 1024, EpiProj0{R2, (unsigned*)(p.ws + OFF_SCAL) + SC_QKMAX}, lds, bid, nblk);
  else if constexpr (PH == 2) {
    unsigned* ctr = (unsigned*)(p.ws + OFF_SCAL) + SC_CTR;
    int* nxt_slot = (int*)(lds + LDS_BYTES - 16);
    const int tid0 = otid();
    int it = bid;
    while (it < 5120) {
      int nx = 0;
      if (tid0 == 0) nx = (int)atomicAdd(ctr, 1u) + nblk;
      if (it < 2560) attn_diff_item(p, it, lds);
      else attn_na_item(p, it - 2560, lds);
      __syncthreads();
      if (tid0 == 0) *nxt_slot = nx;
      __syncthreads();
      it = *nxt_slot;
    }
  }
  else if constexpr (PH == 3) gemm_phase(R1, 1024, wb + W0OUT, 1024, T_TOK, 1024, 1024, EpiTok{R3, 1024}, lds, bid, nblk);
  else if constexpr (PH == 4) phase_res<true, false>(p, R3, (const float*)(p.ws + OFF_SCAL) + SC_G0);
  else if constexpr (PH == 5) gemm_phase(R1, 1024, wb + W0F1, 1024, T_TOK, 5632, 1024, EpiSwiGLU{R2}, lds, bid, nblk);
  else if constexpr (PH == 6) gemm_phase(R2, 2816, wb + W0F2, 2816, T_TOK, 1024, 2816, EpiTok{R3, 1024}, lds, bid, nblk);
  else if constexpr (PH == 7) phase_res<false, false>(p, R3, (const float*)(p.ws + OFF_SCAL) + SC_G1);
  else if constexpr (PH == 8) gemm_phase(R1, 1024, wb + W1DN, 1024, T_TOK, 768, 1024, EpiTok{R3, 768}, lds, bid, nblk);
  else if constexpr (PH == 9) phase_mla_stats(p);
  else if constexpr (PH == 10) {
    gemm_phase(R3, 768, wb + W1UQ, 384, T_TOK, 1536, 384,
                     EpiUQ{R2, (const float*)(p.ws + OFF_RQ), (const float2*)(p.ws + OFF_ROPE)}, lds, bid, nblk);
    gemm_phase(R3 + 384, 768, wb + W1UKV, 256, T_TOK, 2048, 256,
                     EpiUKV{R2 + (size_t)T_TOK * 1536, R2 + (size_t)T_TOK * 2560, (const float*)(p.ws + OFF_RKV)}, lds, bid, nblk);
  }
  else if constexpr (PH == 11) { for (int it = bid; it < 5120; it += nblk) {
      int itm = it;
      if (nblk == 256) {
        const int rnd = it >> 8, x = bid & 7, j = bid >> 3;
        itm = rnd < 4 ? (4 * rnd + (x >> 1)) * 64 + (x & 1) * 32 + j : 1024 + (rnd - 4) * 256 + (2 * x + (j >> 4)) * 16 + (j & 15);
      }
      attn_mla_item<0>(p, itm, lds);
    } }
  else if constexpr (PH == 12) gemm_phase(R1, 1024, wb + W1OUT, 1024, T_TOK, 1024, 1024, EpiTok{R3, 1024}, lds, bid, nblk);
  else if constexpr (PH == 13) phase_res<false, false>(p, R3, (const float*)(p.ws + OFF_SCAL) + SC_G2);
  else if constexpr (PH == 14) gemm_phase(R1, 1024, wb + W1F1, 1024, T_TOK, 5632, 1024, EpiSwiGLU{R2}, lds, bid, nblk);
  else if constexpr (PH == 15) gemm_phase(R2, 2816, wb + W1F2, 2816, T_TOK, 1024, 2816, EpiTok{R3, 1024}, lds, bid, nblk);
  else if constexpr (PH == 16) phase_res<false, true>(p, R3, (const float*)(p.ws + OFF_SCAL) + SC_G3);
}

#if MULTI_LAUNCH
template <int PH>
__global__ void __launch_bounds__(512, 2) k_phase(Params p) {
  extern __shared__ __attribute__((aligned(16))) char lds[];
  run_phase<PH>(p, lds);
}
template <int PH>
static void launch_all(const Params& p, int grid, hipStream_t stream) {
  (void)hipFuncSetAttribute((const void*)k_phase<PH>, hipFuncAttributeMaxDynamicSharedMemorySize, LDS_BYTES);
  hipLaunchKernelGGL(k_phase<PH>, dim3(grid), dim3(512), LDS_BYTES, stream, p);
  if constexpr (PH + 1 < NPHASE) launch_all<PH + 1>(p, grid, stream);
}
#define OCC_KERNEL k_phase<2>
#else
#ifndef PROBE_DUP
#define PROBE_DUP -1
#endif
#ifndef PROBE_DUP2
#define PROBE_DUP2 -1
#endif
DI void grid_barrier(unsigned* ctr, unsigned target) {
  __syncthreads();
  if (otid() < 64) {
    __builtin_amdgcn_fence(__ATOMIC_RELEASE, "agent");
    if (otid() == 0) {
      __hip_atomic_fetch_add(ctr, 1u, __ATOMIC_RELAXED, __HIP_MEMORY_SCOPE_AGENT);
      while (__hip_atomic_load(ctr, __ATOMIC_RELAXED, __HIP_MEMORY_SCOPE_AGENT) < target) __builtin_amdgcn_s_sleep(1);
    }
    __builtin_amdgcn_fence(__ATOMIC_ACQUIRE, "agent");
  }
  __syncthreads();
}
template <int PH>
DI void run_from(const Params& p, char* lds) {
  if constexpr (PH == PROBE_DUP || PH == PROBE_DUP2) { run_phase<PH>(p, lds); cg::this_grid().sync(); }
#ifdef PROBE_ABL
  if constexpr (PH == 11) { for (int it = obid(); it < 5120; it += gridDim.x) attn_mla_item<PROBE_ABL>(p, it, lds); cg::this_grid().sync(); }
#endif
  run_phase<PH>(p, lds);
  if constexpr (PH + 1 < NPHASE) {
    if constexpr (PH == 0) cg::this_grid().sync();
    else grid_barrier((unsigned*)(p.ws + OFF_SCAL) + SC_BAR, (unsigned)PH * gridDim.x);
    run_from<PH + 1>(p, lds);
  }
}
__global__ void __launch_bounds__(512, 2) mega(Params p) {
  extern __shared__ __attribute__((aligned(16))) char lds[];
  run_from<0>(p, lds);
}
#define OCC_KERNEL mega
#endif

extern "C" void kernel_launch(void* const* d_in, const int* in_sizes, int n_in, void* d_out, int out_size, void* d_ws, size_t ws_size,
                              hipStream_t stream) {
  static int grid = 0;
  if (grid == 0) {
    if (n_in != 28 || ws_size < WS_NEED) { fprintf(stderr, "kernel_launch: unexpected n_in %d / ws_size %zu (need %zu)\n", n_in, ws_size, (size_t)WS_NEED); grid = -1; return; }
    int dev = 0, cus = 0, per_cu = 0;
    (void)hipGetDevice(&dev);
    (void)hipDeviceGetAttribute(&cus, hipDeviceAttributeMultiprocessorCount, dev);
    (void)hipFuncSetAttribute((const void*)OCC_KERNEL, hipFuncAttributeMaxDynamicSharedMemorySize, LDS_BYTES);
    (void)hipOccupancyMaxActiveBlocksPerMultiprocessor(&per_cu, (const void*)OCC_KERNEL, 512, LDS_BYTES);
    if (per_cu < 1) per_cu = 1;
    if (per_cu > 1) per_cu = 1;
    grid = cus * per_cu;
  }
  if (grid < 0) return;
  Params p{};
  for (int i = 0; i < 28; ++i) p.in[i] = (const float*)d_in[i];
  p.out = (float*)d_out;
  p.ws = (char*)d_ws;
#if MULTI_LAUNCH
  launch_all<0>(p, grid, stream);
#else
  void* args[] = {&p};
  hipError_t e = hipLaunchCooperativeKernel((const void*)mega, dim3(grid), dim3(512), args, LDS_BYTES, stream);
  if (e != hipSuccess) fprintf(stderr, "cooperative launch failed: %s (grid %d)\n", hipGetErrorString(e), grid);
#endif
}
```

```cpp
#include <hip/hip_runtime.h>
#include <hip/hip_cooperative_groups.h>
#include <stdint.h>
#include <cstdio>
namespace cg = cooperative_groups;

#ifndef MULTI_LAUNCH
#define MULTI_LAUNCH 0
#endif

typedef unsigned short u16;
typedef __attribute__((ext_vector_type(8))) short bf16x8;
typedef __attribute__((ext_vector_type(16))) float f32x16;
typedef __attribute__((ext_vector_type(4))) unsigned u32x4;

#define MFMA32(a, b, c) __builtin_amdgcn_mfma_f32_32x32x16_bf16((a), (b), (c), 0, 0, 0)
#define DI __device__ __forceinline__

constexpr int T_TOK = 81920;
constexpr int T_PROMPT = 65536;
constexpr int DM = 1024;
constexpr int DFF = 2816;
constexpr float EPS = 1e-6f;
constexpr float LOG2E = 1.4426950408889634f;
constexpr float QSCALE64 = 0.125f * LOG2E;
constexpr float QSCALE96 = 0.10206207261596577f * LOG2E;
constexpr int NPHASE = 17;

constexpr size_t MiB = (size_t)1 << 20;
constexpr size_t W0IN = 0;
constexpr size_t W0OUT = W0IN + (size_t)3072 * 1024;
constexpr size_t W0F1 = W0OUT + (size_t)1024 * 1024;
constexpr size_t W0F2 = W0F1 + (size_t)5632 * 1024;
constexpr size_t W1DN = W0F2 + (size_t)1024 * 2816;
constexpr size_t W1UQ = W1DN + (size_t)768 * 1024;
constexpr size_t W1UKV = W1UQ + (size_t)1536 * 384;
constexpr size_t W1OUT = W1UKV + (size_t)2048 * 256;
constexpr size_t W1F1 = W1OUT + (size_t)1024 * 1024;
constexpr size_t W1F2 = W1F1 + (size_t)5632 * 1024;
constexpr size_t W_END = W1F2 + (size_t)1024 * 2816;
static_assert(W_END * 2 <= 48 * MiB, "weights region");
constexpr size_t OFF_ROPE = 48 * MiB;
constexpr size_t OFF_RQ = OFF_ROPE + 2 * MiB;
constexpr size_t OFF_RKV = OFF_RQ + MiB / 2;
constexpr size_t OFF_KROPE = OFF_RKV + MiB / 2;
constexpr size_t OFF_SCAL = OFF_KROPE + 5 * MiB;
constexpr int SC_QKMAX = 16, SC_CTR = 32, SC_BAR = 33;
constexpr int SC_G0 = 1024, SC_G1 = 2048, SC_G2 = 3072, SC_G3 = 4096, SC_GSUB = 5120, SC_RPB = 6144;
constexpr size_t OFF_R1 = 58 * MiB;
constexpr size_t OFF_R3 = OFF_R1 + 160 * MiB;
constexpr size_t OFF_R2 = OFF_R3 + 160 * MiB;
constexpr size_t WS_NEED = OFF_R2 + 560 * MiB;
constexpr size_t SEG512 = (size_t)T_TOK * 512;

struct Params {
  const float* in[28];
  float* out;
  char* ws;
};
struct Ctx {
  const float* in[28];
  float* out;
  char* ws;
  int wv;
};

DI u16 f2bf(float x) { unsigned u = __float_as_uint(x); u += 0x7fffu + ((u >> 16) & 1u); return (u16)(u >> 16); }
DI unsigned pack2(float a, float b) { return (unsigned)f2bf(a) | ((unsigned)f2bf(b) << 16); }
DI float bflo(unsigned v) { return __uint_as_float(v << 16); }
DI float bfhi(unsigned v) { return __uint_as_float(v & 0xffff0000u); }
DI float wave_sum(float v) {
#pragma unroll
  for (int o = 32; o; o >>= 1) v += __shfl_xor(v, o);
  return v;
}
DI int tok_pos(int t) { return t < T_PROMPT ? (t & 4095) : (t - T_PROMPT); }
DI float fexp2(float x) { return __builtin_amdgcn_exp2f(x); }
typedef __attribute__((ext_vector_type(2))) float f32x2;
typedef __attribute__((ext_vector_type(2))) __bf16 bf16x2_t;
typedef __attribute__((ext_vector_type(2))) unsigned u32x2;
typedef __attribute__((ext_vector_type(4))) unsigned u32x4_;
DI unsigned cvt_pk(float a, float b) {
  f32x2 v; v.x = a; v.y = b;
  return __builtin_bit_cast(unsigned, __builtin_convertvector(v, bf16x2_t));
}
DI int otid(const Ctx& p) {
  int wv = p.wv; asm volatile("" : "+s"(wv));
  int t = wv * 64 + (int)__builtin_amdgcn_mbcnt_hi(~0u, __builtin_amdgcn_mbcnt_lo(~0u, 0u));
  asm volatile("" : "+v"(t));
  return t;
}
DI int obid() { int b = blockIdx.x; asm volatile("" : "+s"(b)); return b; }

__device__ const float ROPE_INV[16] = {1.0f, 0.5623413324356079f, 0.3162277638912201f, 0.17782793939113617f, 0.10000000149011612f, 0.05623413249850273f, 0.03162277489900589f, 0.017782794311642647f, 0.009999999776482582f, 0.005623413249850273f, 0.003162277629598975f, 0.0017782794311642647f, 0.0010000000474974513f, 0.000562341301701963f, 0.0003162277571391314f, 0.00017782794020604342f};

DI void wconv(const float* __restrict__ W, const float* __restrict__ g, u16* __restrict__ dst, int K, int N, int rowsOut, int perm, int gtid, int gthreads) {
  const int kc = K >> 3;
  const long total = (long)rowsOut * kc;
  for (long c = gtid; c < total; c += gthreads) {
    const int n = (int)(c % rowsOut);
    const int k0 = (int)(c / rowsOut) * 8;
    int sc;
    if (perm == 1) { const int blk = n >> 6, w = n & 63; const int j = blk * 32 + (w & 31); sc = (w < 32) ? j : DFF + j; }
    else if (perm == 2) { const int hd = (n & 1023) >> 6, d = n & 63; sc = hd * 128 + (n >= 1024 ? 64 : 0) + d; }
    else sc = n;
    uint4 o = make_uint4(0, 0, 0, 0);
    if (sc < N) {
      float v[8];
#pragma unroll
      for (int i = 0; i < 8; ++i) { float x = W[(size_t)(k0 + i) * N + sc]; if (g) x *= g[k0 + i]; v[i] = x; }
      o.x = pack2(v[0], v[1]); o.y = pack2(v[2], v[3]); o.z = pack2(v[4], v[5]); o.w = pack2(v[6], v[7]);
    }
    *(uint4*)(dst + (size_t)n * K + k0) = o;
  }
}

DI void phase_prep(const Ctx& p) {
  const int gtid = obid() * 512 + otid(p), gthreads = gridDim.x * 512;
  u16* wb = (u16*)p.ws;
  wconv(p.in[3], p.in[2], wb + W0IN, 1024, 3072, 3072, 0, gtid, gthreads);
  wconv(p.in[10], nullptr, wb + W0OUT, 1024, 1024, 1024, 0, gtid, gthreads);
  wconv(p.in[13], p.in[12], wb + W0F1, 1024, 5632, 5632, 1, gtid, gthreads);
  wconv(p.in[14], nullptr, wb + W0F2, 2816, 1024, 1024, 0, gtid, gthreads);
  wconv(p.in[17], p.in[16], wb + W1DN, 1024, 672, 768, 0, gtid, gthreads);
  wconv(p.in[20], p.in[18], wb + W1UQ, 384, 1536, 1536, 0, gtid, gthreads);
  wconv(p.in[21], p.in[19], wb + W1UKV, 256, 2048, 2048, 2, gtid, gthreads);
  wconv(p.in[22], nullptr, wb + W1OUT, 1024, 1024, 1024, 0, gtid, gthreads);
  wconv(p.in[25], p.in[24], wb + W1F1, 1024, 5632, 5632, 1, gtid, gthreads);
  wconv(p.in[26], nullptr, wb + W1F2, 2816, 1024, 1024, 0, gtid, gthreads);
  float2* rope = (float2*)(p.ws + OFF_ROPE);
  for (int idx = gtid; idx < 16384 * 16; idx += gthreads) {
    const int pos = idx >> 4, i = idx & 15;
    const float ang = (float)pos * ROPE_INV[i];
    double rev = (double)ang * 0.15915494309189535;
    rev -= rint(rev);
    const float rf = (float)rev;
    rope[idx] = make_float2(__builtin_amdgcn_cosf(rf), __builtin_amdgcn_sinf(rf));
  }
  if (gtid == 0) {
    float s1 = 0.f, s2 = 0.f;
    for (int i = 0; i < 64; ++i) { s1 += p.in[5][i] * p.in[6][i]; s2 += p.in[7][i] * p.in[8][i]; }
    float* sc = (float*)(p.ws + OFF_SCAL);
    sc[0] = __expf(s1) - __expf(s2) + 0.2f;
    for (int i = 0; i < 18; ++i) ((unsigned*)sc)[SC_QKMAX + i] = 0u;
  }
  {
    float* sc = (float*)(p.ws + OFF_SCAL);
    for (int i = gtid; i < 1024; i += gthreads) { sc[SC_G0 + i] = p.in[11][i]; sc[SC_G1 + i] = p.in[15][i]; sc[SC_G2 + i] = p.in[23][i]; sc[SC_G3 + i] = p.in[27][i]; }
    for (int i = gtid; i < 128; i += gthreads) sc[SC_GSUB + i] = p.in[9][i];
    for (int i = gtid; i < 8 * 465; i += gthreads) sc[SC_RPB + i] = p.in[4][i] * LOG2E;
  }
  const int tid_ = otid(p);
  const int lane = tid_ & 63;
  const int gw = obid() * 8 + (tid_ >> 6), nw = gridDim.x * 8;
  u16* hb = (u16*)(p.ws + OFF_R1);
  for (int row = gw; row < T_TOK; row += nw) {
    const float* xr = row < T_PROMPT ? p.in[0] + (size_t)row * DM : p.in[1] + (size_t)(row - T_PROMPT) * DM;
    float4 v[4];
    float ss = 0.f;
#pragma unroll
    for (int j = 0; j < 4; ++j) { v[j] = ((const float4*)xr)[lane + 64 * j]; ss += v[j].x * v[j].x + v[j].y * v[j].y + v[j].z * v[j].z + v[j].w * v[j].w; }
    ss = wave_sum(ss);
    const float r = rsqrtf(ss * (1.f / DM) + EPS);
#pragma unroll
    for (int j = 0; j < 4; ++j) {
      uint2 o; o.x = pack2(v[j].x * r, v[j].y * r); o.y = pack2(v[j].z * r, v[j].w * r);
      ((uint2*)(hb + (size_t)row * DM))[lane + 64 * j] = o;
    }
  }
}

template <bool FIRST, bool LAST>
DI void phase_res(const Ctx& p, const u16* __restrict__ mbuf, const float* __restrict__ g) {
  const int tid_ = otid(p);
  const int lane = tid_ & 63;
  const int gw = obid() * 8 + (tid_ >> 6), nw = gridDim.x * 8;
  u16* hb = (u16*)(p.ws + OFF_R1);
  float4 gv[4];
#pragma unroll
  for (int j = 0; j < 4; ++j) gv[j] = ((const float4*)g)[lane + 64 * j];
  for (int row = gw; row < T_TOK; row += nw) {
    const float* xr;
    if (FIRST) xr = row < T_PROMPT ? p.in[0] + (size_t)row * DM : p.in[1] + (size_t)(row - T_PROMPT) * DM;
    else xr = p.out + (size_t)row * DM;
    float4 xv[4], mv[4];
    float ss = 0.f;
#pragma unroll
    for (int j = 0; j < 4; ++j) {
      const uint2 u = ((const uint2*)(mbuf + (size_t)row * DM))[lane + 64 * j];
      mv[j] = make_float4(bflo(u.x), bfhi(u.x), bflo(u.y), bfhi(u.y));
      ss += mv[j].x * mv[j].x + mv[j].y * mv[j].y + mv[j].z * mv[j].z + mv[j].w * mv[j].w;
      xv[j] = ((const float4*)xr)[lane + 64 * j];
    }
    ss = wave_sum(ss);
    const float rm = rsqrtf(ss * (1.f / DM) + EPS);
    float s2 = 0.f;
#pragma unroll
    for (int j = 0; j < 4; ++j) {
      xv[j].x += mv[j].x * rm * gv[j].x; xv[j].y += mv[j].y * rm * gv[j].y;
      xv[j].z += mv[j].z * rm * gv[j].z; xv[j].w += mv[j].w * rm * gv[j].w;
      s2 += xv[j].x * xv[j].x + xv[j].y * xv[j].y + xv[j].z * xv[j].z + xv[j].w * xv[j].w;
      ((float4*)(p.out + (size_t)row * DM))[lane + 64 * j] = xv[j];
    }
    if (!LAST) {
      s2 = wave_sum(s2);
      const float r2 = rsqrtf(s2 * (1.f / DM) + EPS);
#pragma unroll
      for (int j = 0; j < 4; ++j) {
        uint2 o; o.x = pack2(xv[j].x * r2, xv[j].y * r2); o.y = pack2(xv[j].z * r2, xv[j].w * r2);
        ((uint2*)(hb + (size_t)row * DM))[lane + 64 * j] = o;
      }
    }
  }
}

DI void phase_mla_stats(const Ctx& p) {
  const int tid_ = otid(p);
  const int lane = tid_ & 63;
  const int gw = obid() * 8 + (tid_ >> 6), nw = gridDim.x * 8;
  const u16* c = (const u16*)(p.ws + OFF_R3);
  float* rq = (float*)(p.ws + OFF_RQ);
  float* rkv = (float*)(p.ws + OFF_RKV);
  u16* krope = (u16*)(p.ws + OFF_KROPE);
  const float2* rope = (const float2*)(p.ws + OFF_ROPE);
  for (int row = gw; row < T_TOK; row += nw) {
    const u16* cr = c + (size_t)row * 768;
    const uint4 u0 = ((const uint4*)cr)[lane];
    float s0 = 0.f;
    { float a;
      a = bflo(u0.x); s0 += a * a; a = bfhi(u0.x); s0 += a * a; a = bflo(u0.y); s0 += a * a; a = bfhi(u0.y); s0 += a * a;
      a = bflo(u0.z); s0 += a * a; a = bfhi(u0.z); s0 += a * a; a = bflo(u0.w); s0 += a * a; a = bfhi(u0.w); s0 += a * a; }
    float s1 = 0.f;
    if (lane < 16) {
      const uint4 u1 = ((const uint4*)cr)[64 + lane];
      float a;
      a = bflo(u1.x); s1 += a * a; a = bfhi(u1.x); s1 += a * a; a = bflo(u1.y); s1 += a * a; a = bfhi(u1.y); s1 += a * a;
      a = bflo(u1.z); s1 += a * a; a = bfhi(u1.z); s1 += a * a; a = bflo(u1.w); s1 += a * a; a = bfhi(u1.w); s1 += a * a;
    }
    const float sq = wave_sum(lane < 48 ? s0 : 0.f);
    const float skv = wave_sum((lane >= 48 ? s0 : 0.f) + s1);
    if (lane == 0) {
      rq[row] = rsqrtf(sq * (1.f / 384.f) + EPS);
      rkv[row] = rsqrtf(skv * (1.f / 256.f) + EPS);
    }
    if (lane < 16) {
      const float x1 = __uint_as_float((unsigned)cr[640 + lane] << 16);
      const float x2 = __uint_as_float((unsigned)cr[656 + lane] << 16);
      const float2 cs = rope[tok_pos(row) * 16 + lane];
      krope[(size_t)row * 32 + lane] = f2bf(x1 * cs.x - x2 * cs.y);
      krope[(size_t)row * 32 + 16 + lane] = f2bf(x2 * cs.x + x1 * cs.y);
    }
  }
}

DI void store_tok(u16* out, int ldo, int m, int nbase, const f32x16& v, float sc) {
  u16* q = out + (size_t)m * ldo + nbase;
#pragma unroll
  for (int g = 0; g < 4; ++g) {
    uint2 u; u.x = pack2(v[4 * g] * sc, v[4 * g + 1] * sc); u.y = pack2(v[4 * g + 2] * sc, v[4 * g + 3] * sc);
    *(uint2*)(q + 8 * g) = u;
  }
}
DI void store_tr(u16* outT, size_t ldt, int n, int mbase, const f32x16& v, const float* __restrict__ rs) {
  u16* q = outT + (size_t)n * ldt + mbase;
#pragma unroll
  for (int g = 0; g < 4; ++g) {
    float4 s = make_float4(1.f, 1.f, 1.f, 1.f);
    if (rs) s = *(const float4*)(rs + mbase + 8 * g);
    uint2 u; u.x = pack2(v[4 * g] * s.x, v[4 * g + 1] * s.y); u.y = pack2(v[4 * g + 2] * s.z, v[4 * g + 3] * s.w);
    *(uint2*)(q + 8 * g) = u;
  }
}

DI void store_tok_u(u16* ub, unsigned loff, const f32x16& v, float sc) {
  char* q = (char*)ub;
#pragma unroll
  for (int g = 0; g < 4; ++g) {
    u32x2 u; u.x = cvt_pk(v[4 * g] * sc, v[4 * g + 1] * sc); u.y = cvt_pk(v[4 * g + 2] * sc, v[4 * g + 3] * sc);
    *(u32x2*)(q + loff + 16 * g) = u;
  }
}
DI void store_tr_u(u16* ub, unsigned loff, const f32x16& v, const float* __restrict__ rs) {
  char* q = (char*)ub;
#pragma unroll
  for (int g = 0; g < 4; ++g) {
    float4 s = make_float4(1.f, 1.f, 1.f, 1.f);
    if (rs) s = *(const float4*)(rs + 8 * g);
    u32x2 u; u.x = cvt_pk(v[4 * g] * s.x, v[4 * g + 1] * s.y); u.y = cvt_pk(v[4 * g + 2] * s.z, v[4 * g + 3] * s.w);
    *(u32x2*)(q + loff + 16 * g) = u;
  }
}

struct EpiTok {
  u16* out; int ldo;
  static constexpr int SWAPMODE = 1;
  DI bool swap(int) const { return true; }
  template <int WMB, int WNB>
  DI void store(int m0w, int n0w, f32x16 (&acc)[WMB][WNB], int r, int h, bool) const {
#pragma unroll
    for (int mb = 0; mb < WMB; ++mb)
#pragma unroll
      for (int nb = 0; nb < WNB; ++nb) store_tok_u(out + (size_t)(m0w + mb * 32) * ldo + n0w + nb * 32, (unsigned)((r * ldo + 4 * h) * 2), acc[mb][nb], 1.f);
  }
};

struct EpiProj0 {
  u16* base; unsigned* qkmax;
  static constexpr int SWAPMODE = 2;
  DI bool swap(int n0) const { const int reg = n0 >> 9; return !(reg == 2 || reg == 5); }
  template <int WMB, int WNB>
  DI void store(int m0w, int n0w, f32x16 (&acc)[WMB][WNB], int r, int h, bool) const {
    const int reg = n0w >> 9, nl = n0w & 511;
    u16* buf = base + (size_t)reg * SEG512;
    const float sc = (reg == 0 || reg == 3) ? QSCALE64 : 1.f;
#pragma unroll
    for (int mb = 0; mb < WMB; ++mb)
#pragma unroll
      for (int nb = 0; nb < WNB; ++nb) store_tok_u(buf + (size_t)(m0w + mb * 32) * 512 + nl + nb * 32, (unsigned)((r * 512 + 4 * h) * 2), acc[mb][nb], sc);
    __builtin_amdgcn_sched_barrier(0);
    if (reg == 3 || reg == 4) {
      static_assert(WNB == 2, "one head per wave tile");
      float mxn = 0.f;
#pragma unroll
      for (int mb = 0; mb < WMB; ++mb) {
        float ss = 0.f;
#pragma unroll
        for (int nb = 0; nb < WNB; ++nb)
#pragma unroll
          for (int i = 0; i < 16; ++i) { const float v = acc[mb][nb][i]; ss += v * v; }
        { const u32x2 sw = __builtin_amdgcn_permlane32_swap(__float_as_uint(ss), __float_as_uint(ss), false, false); ss = __uint_as_float(sw.x) + __uint_as_float(sw.y); }
        mxn = fmaxf(mxn, ss);
      }
      mxn = fmaxf(mxn, __int_as_float(__builtin_amdgcn_ds_swizzle(__float_as_int(mxn), (16 << 10) | 0x1f)));
      mxn = fmaxf(mxn, __int_as_float(__builtin_amdgcn_ds_swizzle(__float_as_int(mxn), (8 << 10) | 0x1f)));
      mxn = fmaxf(mxn, __int_as_float(__builtin_amdgcn_ds_swizzle(__float_as_int(mxn), (4 << 10) | 0x1f)));
      mxn = fmaxf(mxn, __int_as_float(__builtin_amdgcn_ds_swizzle(__float_as_int(mxn), (2 << 10) | 0x1f)));
      mxn = fmaxf(mxn, __int_as_float(__builtin_amdgcn_ds_swizzle(__float_as_int(mxn), (1 << 10) | 0x1f)));
      if (r == 0 && h == 0) atomicMax(qkmax + (reg - 3) * 8 + (nl >> 6), __float_as_uint(sqrtf(mxn) * sc));
    }
  }
  template <int WMB, int WNB>
  DI void store_t(int n0w, int m0w, f32x16 (&acc)[WMB][WNB], int r, int h) const {
    const int reg = n0w >> 9, nl = n0w & 511;
    u16* buf = base + (size_t)reg * SEG512;
#pragma unroll
    for (int mb = 0; mb < WMB; ++mb)
#pragma unroll
      for (int nb = 0; nb < WNB; ++nb) store_tr_u(buf + (size_t)(nl + mb * 32) * T_TOK + m0w + nb * 32, (unsigned)((r * T_TOK + 4 * h) * 2), acc[mb][nb], nullptr);
  }
};

struct EpiSwiGLU {
  u16* act;
  static constexpr int SWAPMODE = 1;
  DI bool swap(int) const { return true; }
  template <int WMB, int WNB>
  DI void store(int m0w, int n0w, f32x16 (&acc)[WMB][WNB], int r, int h, bool) const {
    static_assert(WNB == 2, "swiglu epilogue needs a 64-wide wave tile");
#pragma unroll
    for (int mb = 0; mb < WMB; ++mb) {
      char* q = (char*)(act + (size_t)(m0w + mb * 32) * DFF + (n0w >> 1)) + (unsigned)((r * DFF + 4 * h) * 2);
#pragma unroll
      for (int g = 0; g < 4; ++g) {
        float y[4];
#pragma unroll
        for (int e = 0; e < 4; ++e) {
          const float gt = acc[mb][0][4 * g + e], up = acc[mb][1][4 * g + e];
          y[e] = gt * __builtin_amdgcn_rcpf(1.f + fexp2(-LOG2E * gt)) * up;
        }
        u32x2 u; u.x = cvt_pk(y[0], y[1]); u.y = cvt_pk(y[2], y[3]);
        *(u32x2*)(q + 16 * g) = u;
      }
      __builtin_amdgcn_sched_barrier(0);
    }
  }
};

struct EpiUQ {
  u16* q; const float* rq; const float2* rope;
  static constexpr int SWAPMODE = 1;
  DI bool swap(int) const { return true; }
  template <int WMB, int WNB>
  DI void store(int m0w, int n0w, f32x16 (&acc)[WMB][WNB], int r, int h, bool) const {
#pragma unroll
    for (int mb = 0; mb < WMB; ++mb) {
      const int m = m0w + mb * 32 + r;
      const float sc = rq[m] * QSCALE96;
      const int pos = tok_pos(m);
#pragma unroll
      for (int nb = 0; nb < WNB; ++nb) {
        const int n0b = n0w + nb * 32;
        f32x16 v = acc[mb][nb];
#pragma unroll
        for (int i = 0; i < 16; ++i) v[i] *= sc;
        if (((n0b >> 5) % 3) == 2) {
#pragma unroll
          for (int i = 0; i < 8; ++i) {
            const int f = (i & 3) + 8 * (i >> 2) + 4 * h;
            const float2 cs = rope[pos * 16 + f];
            const float x1 = v[i], x2 = v[i + 8];
            v[i] = x1 * cs.x - x2 * cs.y;
            v[i + 8] = x2 * cs.x + x1 * cs.y;
          }
        }
        store_tok_u(q + (size_t)(m0w + mb * 32) * 1536 + n0b, (unsigned)((r * 1536 + 4 * h) * 2), v, 1.f);
        __builtin_amdgcn_sched_barrier(0);
      }
    }
  }
};

struct EpiUKV {
  u16* knope; u16* vt; const float* rkv;
  static constexpr int SWAPMODE = 2;
  DI bool swap(int n0) const { return n0 < 1024; }
  template <int WMB, int WNB>
  DI void store(int m0w, int n0w, f32x16 (&acc)[WMB][WNB], int r, int h, bool) const {
#pragma unroll
    for (int mb = 0; mb < WMB; ++mb) {
      const int m = m0w + mb * 32 + r;
      const float sc = rkv[m];
#pragma unroll
      for (int nb = 0; nb < WNB; ++nb) store_tok_u(knope + (size_t)(m0w + mb * 32) * 1024 + n0w + nb * 32, (unsigned)((r * 1024 + 4 * h) * 2), acc[mb][nb], sc);
    }
  }
  template <int WMB, int WNB>
  DI void store_t(int n0w, int m0w, f32x16 (&acc)[WMB][WNB], int r, int h) const {
#pragma unroll
    for (int mb = 0; mb < WMB; ++mb)
#pragma unroll
      for (int nb = 0; nb < WNB; ++nb) store_tr_u(vt + (size_t)(n0w - 1024 + mb * 32) * T_TOK + m0w + nb * 32, (unsigned)((r * T_TOK + 4 * h) * 2), acc[mb][nb], rkv + m0w + nb * 32 + 4 * h);
  }
};

template <bool SWAP, int WMB, int WNB>
DI void gemm_compute(const char* la, const char* lb, f32x16 (&acc)[WMB][WNB], int wm, int wn, int r, int h) {
#pragma unroll
  for (int ks = 0; ks < 4; ++ks) {
    bf16x8 af[WMB], bfr[WNB];
#pragma unroll
    for (int mb = 0; mb < WMB; ++mb) af[mb] = *(const bf16x8*)(la + (wm * 32 * WMB + mb * 32 + r) * 144 + (ks * 2 + h) * 16);
#pragma unroll
    for (int nb = 0; nb < WNB; ++nb) bfr[nb] = *(const bf16x8*)(lb + (wn * 32 * WNB + nb * 32 + r) * 144 + (ks * 2 + h) * 16);
#pragma unroll
    for (int mb = 0; mb < WMB; ++mb)
#pragma unroll
      for (int nb = 0; nb < WNB; ++nb) {
        if (SWAP) acc[mb][nb] = MFMA32(bfr[nb], af[mb], acc[mb][nb]);
        else acc[mb][nb] = MFMA32(af[mb], bfr[nb], acc[mb][nb]);
      }
  }
}

template <class Epi>
DI void gemm_tile(const char* __restrict__ Ab, unsigned aoff, int lda, const char* __restrict__ Bb, unsigned boff, int ldb, int nk, int m0, int n0, const Epi& epi, char* lds, bool normal, const Ctx& p) {
  constexpr int WMB = 4, WNB = 2;
  constexpr int TM = 256, TN = 256;
  constexpr int STAGE = (TM + TN) * 144;
  const int tid = otid(p), lane = tid & 63, w = __builtin_amdgcn_readfirstlane(tid >> 6), wm = w >> 2, wn = w & 3, r = lane & 31, h = lane >> 5;
  const int lrow = tid >> 3, lch = tid & 7;
  u32x4 pa[4], pb[4];
  f32x16 acc[WMB][WNB];
#pragma unroll
  for (int mb = 0; mb < WMB; ++mb)
#pragma unroll
    for (int nb = 0; nb < WNB; ++nb)
#pragma unroll
      for (int i = 0; i < 16; ++i) acc[mb][nb][i] = 0.f;
#pragma unroll
  for (int j = 0; j < 4; ++j) pa[j] = *(const u32x4*)(Ab + (size_t)j * 128 * lda + aoff);
#pragma unroll
  for (int j = 0; j < 4; ++j) pb[j] = *(const u32x4*)(Bb + (size_t)j * 128 * ldb + boff);
  {
    char* la = lds; char* lb = lds + TM * 144;
#pragma unroll
    for (int j = 0; j < 4; ++j) *(u32x4*)(la + (lrow + 64 * j) * 144 + lch * 16) = pa[j];
#pragma unroll
    for (int j = 0; j < 4; ++j) *(u32x4*)(lb + (lrow + 64 * j) * 144 + lch * 16) = pb[j];
  }
  if (nk > 1) {
#pragma unroll
    for (int j = 0; j < 4; ++j) pa[j] = *(const u32x4*)(Ab + ((size_t)j * 128 * lda + 128) + aoff);
#pragma unroll
    for (int j = 0; j < 4; ++j) pb[j] = *(const u32x4*)(Bb + ((size_t)j * 128 * ldb + 128) + boff);
  }
  __syncthreads();
  auto stage_next = [&](int kt) {
    if (kt + 1 < nk) {
      char* wa = lds + ((kt + 1) & 1) * STAGE;
      char* wb = wa + TM * 144;
#pragma unroll
      for (int j = 0; j < 4; ++j) *(u32x4*)(wa + (lrow + 64 * j) * 144 + lch * 16) = pa[j];
#pragma unroll
      for (int j = 0; j < 4; ++j) *(u32x4*)(wb + (lrow + 64 * j) * 144 + lch * 16) = pb[j];
    }
    if (kt + 2 < nk) {
      const char* Ak = Ab + (size_t)(kt + 2) * 128; asm volatile("" : "+s"(Ak));
      const char* Bk = Bb + (size_t)(kt + 2) * 128; asm volatile("" : "+s"(Bk));
#pragma unroll
      for (int j = 0; j < 4; ++j) pa[j] = *(const u32x4*)(Ak + (size_t)j * 128 * lda + aoff);
#pragma unroll
      for (int j = 0; j < 4; ++j) pb[j] = *(const u32x4*)(Bk + (size_t)j * 128 * ldb + boff);
    }
  };
  if (w < 4) {
    for (int kt = 0; kt < nk; ++kt) {
      const char* la = lds + (kt & 1) * STAGE;
      stage_next(kt);
      __builtin_amdgcn_sched_barrier(0);
      gemm_compute<true, WMB, WNB>(la, la + TM * 144, acc, wm, wn, r, h);
      __syncthreads();
    }
  } else {
    for (int kt = 0; kt < nk; ++kt) {
      const char* la = lds + (kt & 1) * STAGE;
      gemm_compute<true, WMB, WNB>(la, la + TM * 144, acc, wm, wn, r, h);
      __builtin_amdgcn_sched_barrier(0);
      stage_next(kt);
      __syncthreads();
    }
  }
  asm volatile("" : "+s"(m0), "+s"(n0));
  int r2 = r, h2 = h, wm2 = wm, wn2 = wn;
  asm volatile("" : "+v"(r2), "+v"(h2));
  asm volatile("" : "+s"(wm2), "+s"(wn2));
  if constexpr (Epi::SWAPMODE == 2) {
    if (normal) epi.template store<WMB, WNB>(m0 + wm2 * 32 * WMB, n0 + wn2 * 32 * WNB, acc, r2, h2, true);
    else epi.template store_t<WMB, WNB>(n0 + wm2 * 32 * WMB, m0 + wn2 * 32 * WNB, acc, r2, h2);
  } else {
    epi.template store<WMB, WNB>(m0 + wm2 * 32 * WMB, n0 + wn2 * 32 * WNB, acc, r2, h2, true);
  }
}

template <class Epi>
DI void gemm_phase(const u16* __restrict__ A, int lda, const u16* __restrict__ Bt, int ldb, int M, int N, int K, const Epi epi, char* lds, int bid, int nblk, const Ctx& p) {
  constexpr int TM = 256, TN = 256;
  const int tid = otid(p);
  const int NT = N / TN, MT = M / TM, tiles = MT * NT, nk = K >> 6;
  const int lrow = tid >> 3, lch = tid & 7;
  for (int t0 = bid; t0 < ((tiles + nblk - 1) / nblk) * nblk; t0 += nblk) {
    int tile = t0;
    if (nblk == 256) tile = (t0 & ~255) + (bid & 7) * 32 + (bid >> 3);
    if (tile >= tiles) continue;
    const int grp = tile / (8 * NT), within = tile - grp * (8 * NT);
    const int nt = within >> 3, mt = grp * 8 + (within & 7);
    const int m0 = mt * TM, n0 = nt * TN;
    const char* Ab = (const char*)A + (size_t)m0 * lda * 2;
    const char* Bb = (const char*)Bt + (size_t)n0 * ldb * 2;
    const unsigned aoff = (unsigned)(lrow * lda * 2 + lch * 16), boff = (unsigned)(lrow * ldb * 2 + lch * 16);
    if constexpr (Epi::SWAPMODE == 2) {
      const bool normal = epi.swap(n0);
      gemm_tile(normal ? Ab : Bb, normal ? aoff : boff, normal ? lda : ldb, normal ? Bb : Ab, normal ? boff : aoff, normal ? ldb : lda, nk, m0, n0, epi, lds, normal, p);
    } else {
      gemm_tile(Ab, aoff, lda, Bb, boff, ldb, nk, m0, n0, epi, lds, true, p);
    }
  }
}

DI void lds_st16_as2x8(char* dst, const u32x4 v) {
  u32x2 a; a.x = v.x; a.y = v.y; u32x2 b; b.x = v.z; b.y = v.w;
  *(u32x2*)dst = a;
  *(u32x2*)(dst + 8) = b;
}
constexpr int ATT_STAGE = 35840;
constexpr float DEFER_THR = 8.f;

template <int DQK>
DI void qk_scores_qlds(const char* kl, const char* qsl, f32x16 (&s)[2], int r, int h) {
  constexpr int KS = DQK * 2 + 16;
#pragma unroll
  for (int kb = 0; kb < 2; ++kb) {
#pragma unroll
    for (int ks = 0; ks < DQK / 16; ++ks) {
      const bf16x8 a = *(const bf16x8*)(kl + (32 * kb + r) * KS + (2 * ks + h) * 16);
      const bf16x8 qv = *(const bf16x8*)(qsl + ks * 1024);
      s[kb] = MFMA32(a, qv, s[kb]);
    }
  }
}
template <int DQK>
DI void qk_scores(const char* kl, const bf16x8 (&qf)[DQK / 16], const f32x16& initv, f32x16 (&s)[2], int r, int h) {
  constexpr int KS = DQK * 2 + 16;
#pragma unroll
  for (int kb = 0; kb < 2; ++kb) {
    s[kb] = initv;
#pragma unroll
    for (int ks = 0; ks < DQK / 16; ++ks) {
      const bf16x8 a = *(const bf16x8*)(kl + (32 * kb + r) * KS + (2 * ks + h) * 16);
      s[kb] = MFMA32(a, qf[ks], s[kb]);
    }
  }
}

template <int DV>
DI float softmax_pv(f32x16 (&s)[2], f32x16 (&o)[DV / 32], float& l, bool first, const char* vl, int r, int h) {
  float dret = 0.f;
  float mx = fmaxf(fmaxf(s[0][0], s[0][1]), s[0][2]);
#pragma unroll
  for (int i = 3; i < 15; i += 2) mx = fmaxf(fmaxf(mx, s[0][i]), s[0][i + 1]);
  mx = fmaxf(fmaxf(mx, s[0][15]), s[1][0]);
#pragma unroll
  for (int i = 1; i < 15; i += 2) mx = fmaxf(fmaxf(mx, s[1][i]), s[1][i + 1]);
  mx = fmaxf(mx, s[1][15]);
  const bool need = first || (mx > DEFER_THR);
  if (__any(need)) {
    mx = fmaxf(mx, __shfl_xor(mx, 32));
    float delta;
    if (first) delta = mx;
    else {
      delta = fmaxf(mx, 0.f);
      const float alpha = fexp2(-delta);
      l *= alpha;
#pragma unroll
      for (int d = 0; d < DV / 32; ++d)
#pragma unroll
        for (int i = 0; i < 16; ++i) o[d][i] *= alpha;
    }
#pragma unroll
    for (int kb = 0; kb < 2; ++kb)
#pragma unroll
      for (int i = 0; i < 16; ++i) s[kb][i] -= delta;
    dret = delta;
  }
  float ps = 0.f;
#pragma unroll
  for (int kb = 0; kb < 2; ++kb)
#pragma unroll
    for (int i = 0; i < 16; ++i) { const float e = fexp2(s[kb][i]); s[kb][i] = e; ps += e; }
  l += ps;
  bf16x8 pf[2][2];
#pragma unroll
  for (int kb = 0; kb < 2; ++kb)
#pragma unroll
    for (int st = 0; st < 2; ++st) {
      u32x4 u;
      u.x = cvt_pk(s[kb][8 * st + 0], s[kb][8 * st + 1]); u.y = cvt_pk(s[kb][8 * st + 2], s[kb][8 * st + 3]);
      u.z = cvt_pk(s[kb][8 * st + 4], s[kb][8 * st + 5]); u.w = cvt_pk(s[kb][8 * st + 6], s[kb][8 * st + 7]);
      pf[kb][st] = __builtin_bit_cast(bf16x8, u);
    }
#pragma unroll
  for (int d = 0; d < DV / 32; ++d)
#pragma unroll
    for (int kb = 0; kb < 2; ++kb)
#pragma unroll
      for (int st = 0; st < 2; ++st) {
        const char* vp = vl + (32 * d + r) * 136 + (32 * kb + 16 * st + 4 * h) * 2;
        const u32x2 lo = *(const u32x2*)vp;
        const u32x2 hi = *(const u32x2*)(vp + 16);
        u32x4 u; u.x = lo.x; u.y = lo.y; u.z = hi.x; u.w = hi.y;
        o[d] = MFMA32(__builtin_bit_cast(bf16x8, u), pf[kb][st], o[d]);
      }
  return dret;
}

template <int DV>
DI float softmax_pre(f32x16 (&s)[2], f32x16 (&o)[DV / 32], float& l, bool first) {
  float dret = 0.f;
  float mx = fmaxf(fmaxf(s[0][0], s[0][1]), s[0][2]);
#pragma unroll
  for (int i = 3; i < 15; i += 2) mx = fmaxf(fmaxf(mx, s[0][i]), s[0][i + 1]);
  mx = fmaxf(fmaxf(mx, s[0][15]), s[1][0]);
#pragma unroll
  for (int i = 1; i < 15; i += 2) mx = fmaxf(fmaxf(mx, s[1][i]), s[1][i + 1]);
  mx = fmaxf(mx, s[1][15]);
  const bool need = first || (mx > DEFER_THR);
  if (__any(need)) {
    mx = fmaxf(mx, __shfl_xor(mx, 32));
    float delta;
    if (first) delta = mx;
    else {
      delta = fmaxf(mx, 0.f);
      const float alpha = fexp2(-delta);
      l *= alpha;
#pragma unroll
      for (int d = 0; d < DV / 32; ++d)
#pragma unroll
        for (int i = 0; i < 16; ++i) o[d][i] *= alpha;
    }
#pragma unroll
    for (int kb = 0; kb < 2; ++kb)
#pragma unroll
      for (int i = 0; i < 16; ++i) s[kb][i] -= delta;
    dret = delta;
  }
  return dret;
}
DI void softmax_exp_half(f32x16& s, float& l, bf16x8 (&pf)[2]) {
  float ps = 0.f;
#pragma unroll
  for (int i = 0; i < 16; ++i) { const float e = fexp2(s[i]); s[i] = e; ps += e; }
  l += ps;
#pragma unroll
  for (int st = 0; st < 2; ++st) {
    u32x4 u;
    u.x = cvt_pk(s[8 * st + 0], s[8 * st + 1]); u.y = cvt_pk(s[8 * st + 2], s[8 * st + 3]);
    u.z = cvt_pk(s[8 * st + 4], s[8 * st + 5]); u.w = cvt_pk(s[8 * st + 6], s[8 * st + 7]);
    pf[st] = __builtin_bit_cast(bf16x8, u);
  }
}
template <int DV>
DI void pv_half(const bf16x8 (&pf)[2], f32x16 (&o)[DV / 32], const char* vl, int kb, int r, int h) {
#pragma unroll
  for (int d = 0; d < DV / 32; ++d)
#pragma unroll
    for (int st = 0; st < 2; ++st) {
      const char* vp = vl + (32 * d + r) * 136 + (32 * kb + 16 * st + 4 * h) * 2;
      const u32x2 lo = *(const u32x2*)vp;
      const u32x2 hi = *(const u32x2*)(vp + 16);
      u32x4 u; u.x = lo.x; u.y = lo.y; u.z = hi.x; u.w = hi.y;
      o[d] = MFMA32(__builtin_bit_cast(bf16x8, u), pf[st], o[d]);
    }
}

template <int ABL>
DI void attn_mla_item(const Ctx& p, int item, char* lds) {
  constexpr int DQK = 96, DV = 64, KS = DQK * 2 + 16;
  const int tid = otid(p), lane = tid & 63, w = tid >> 6, r = lane & 31, h = lane >> 5;
  int head, qb, ts0, S;
  if (item < 1024) { head = item >> 6; qb = item & 63; ts0 = T_PROMPT; S = 16384; }
  else { const int it = item - 1024; qb = it & 15; head = (it >> 4) & 15; ts0 = (it >> 8) * 4096; S = 4096; }
  const u16* q = (const u16*)(p.ws + OFF_R2);
  const u16* knope = q + (size_t)T_TOK * 1536;
  const u16* vt = knope + (size_t)T_TOK * 1024;
  const u16* krope = (const u16*)(p.ws + OFF_KROPE);
  u16* o1 = (u16*)(p.ws + OFF_R1);
  const int tq = ts0 + qb * 256 + w * 32 + r;
  bf16x8 qf[DQK / 16];
#pragma unroll
  for (int ks = 0; ks < DQK / 16; ++ks) qf[ks] = *(const bf16x8*)(q + (size_t)tq * 1536 + head * 96 + 16 * ks + 8 * h);
  f32x16 o[DV / 32];
#pragma unroll
  for (int d = 0; d < DV / 32; ++d)
#pragma unroll
    for (int i = 0; i < 16; ++i) o[d][i] = 0.f;
  f32x16 initv;
#pragma unroll
  for (int i = 0; i < 16; ++i) initv[i] = 0.f;
  float l = 0.f;
  u32x4 pk0, pk1, pv0;
  const int c1 = 512 + tid;
  const int krow0 = tid / 12, kch0 = tid - krow0 * 12;
  const int krow1 = c1 / 12, kch1 = c1 - krow1 * 12;
  const int vrow = tid >> 3, vch = tid & 7;
  const int nkt = S >> 6;
  auto prefetch = [&](int kt) {
    const int tk0 = ts0 + kt * 64;
    {
      const u16* src = kch0 < 8 ? knope + (size_t)(tk0 + krow0) * 1024 + head * 64 + kch0 * 8 : krope + (size_t)(tk0 + krow0) * 32 + (kch0 - 8) * 8;
      pk0 = *(const u32x4*)src;
    }
    if (tid < 256) {
      const u16* src = kch1 < 8 ? knope + (size_t)(tk0 + krow1) * 1024 + head * 64 + kch1 * 8 : krope + (size_t)(tk0 + krow1) * 32 + (kch1 - 8) * 8;
      pk1 = *(const u32x4*)src;
    }
    pv0 = *(const u32x4*)(vt + (size_t)(head * 64 + vrow) * T_TOK + tk0 + vch * 8);
  };
  auto stage_at = [&](int boff) {
    char* kl = lds + boff;
    char* vl = kl + 64 * KS;
    *(u32x4*)(kl + krow0 * KS + kch0 * 16) = pk0;
    if (tid < 256) *(u32x4*)(kl + krow1 * KS + kch1 * 16) = pk1;
    lds_st16_as2x8(vl + vrow * 136 + vch * 16, pv0);
  };
  prefetch(0);
  __syncthreads();
  stage_at(0);
  prefetch(1);
  stage_at(ATT_STAGE);
  if (nkt > 2) prefetch(2);
  __syncthreads();
  int cur = 0, nxt = ATT_STAGE, nn = 2 * ATT_STAGE;
  f32x16 s[2];
  qk_scores<DQK>(lds, qf, initv, s, r, h);
#pragma unroll 1
  for (int kt = 0; kt < nkt; ++kt) {
    if (ABL == 2) { __syncthreads(); if (kt + 2 < nkt) stage_at(nn); if (kt + 3 < nkt) prefetch(kt + 3); { const int t = cur; cur = nxt; nxt = nn; nn = t; } continue; }
    const float dl = softmax_pre<DV>(s, o, l, kt == 0);
    if (__any(dl != 0.f)) {
#pragma unroll
      for (int i = 0; i < 16; ++i) initv[i] -= dl;
    }
    f32x16 sn[2];
    qk_scores<DQK>(lds + nxt, qf, initv, sn, r, h);
#pragma unroll
    for (int kb = 0; kb < 2; ++kb) {
      bf16x8 pf[2];
      softmax_exp_half(s[kb], l, pf);
      pv_half<DV>(pf, o, lds + cur + 64 * KS, kb, r, h);
    }
    if (ABL != 1) { if (kt + 2 < nkt) stage_at(nn);
    if (kt + 3 < nkt) prefetch(kt + 3); }
    __syncthreads();
    s[0] = sn[0]; s[1] = sn[1];
    const int t = cur; cur = nxt; nxt = nn; nn = t;
  }
  l += __shfl_xor(l, 32);
  const float inv = 1.f / l;
#pragma unroll
  for (int d = 0; d < DV / 32; ++d) store_tok(o1, 1024, tq, head * 64 + 32 * d + 4 * h, o[d], inv);
}

DI void attn_mla_item2(const Ctx& p, int item, char* lds) {
  constexpr int DQK = 96, DV = 64, KS = DQK * 2 + 16;
  const int tid = otid(p), lane = tid & 63, w = tid >> 6, r = lane & 31, h = lane >> 5;
  int head, qb, ts0, S;
  if (item < 512) { head = item >> 5; qb = item & 31; ts0 = T_PROMPT; S = 16384; }
  else { const int it = item - 512; qb = it & 7; head = (it >> 3) & 15; ts0 = (it >> 7) * 4096; S = 4096; }
  const u16* q = (const u16*)(p.ws + OFF_R2);
  const u16* knope = q + (size_t)T_TOK * 1536;
  const u16* vt = knope + (size_t)T_TOK * 1024;
  const u16* krope = (const u16*)(p.ws + OFF_KROPE);
  u16* o1 = (u16*)(p.ws + OFF_R1);
  const int tq0 = ts0 + qb * 512 + w * 64 + r;
  char* qsl = lds + 49152 + w * 12288 + lane * 16;
  __syncthreads();
#pragma unroll
  for (int j = 0; j < 2; ++j)
#pragma unroll
    for (int ks = 0; ks < DQK / 16; ++ks)
      *(bf16x8*)(qsl + (j * 6 + ks) * 1024) = *(const bf16x8*)(q + (size_t)(tq0 + 32 * j) * 1536 + head * 96 + 16 * ks + 8 * h);
  f32x16 o[2][DV / 32];
  f32x16 initv[2];
#pragma unroll
  for (int j = 0; j < 2; ++j) {
#pragma unroll
    for (int d = 0; d < DV / 32; ++d)
#pragma unroll
      for (int i = 0; i < 16; ++i) o[j][d][i] = 0.f;
#pragma unroll
    for (int i = 0; i < 16; ++i) initv[j][i] = 0.f;
  }
  float l[2] = {0.f, 0.f};
  u32x4 pk0, pk1, pv0;
  const int c1 = 512 + (tid & 255);
  const int krow0 = tid / 12, kch0 = tid - krow0 * 12;
  const int krow1 = c1 / 12, kch1 = c1 - krow1 * 12;
  const int vrow = tid >> 3, vch = tid & 7;
  const int nkt = S >> 6;
  auto prefetch = [&](int kt) {
    const int tk0 = ts0 + kt * 64;
    {
      const u16* src = kch0 < 8 ? knope + (size_t)(tk0 + krow0) * 1024 + head * 64 + kch0 * 8 : krope + (size_t)(tk0 + krow0) * 32 + (kch0 - 8) * 8;
      pk0 = *(const u32x4*)src;
    }
    {
      const u16* src = kch1 < 8 ? knope + (size_t)(tk0 + krow1) * 1024 + head * 64 + kch1 * 8 : krope + (size_t)(tk0 + krow1) * 32 + (kch1 - 8) * 8;
      pk1 = *(const u32x4*)src;
    }
    pv0 = *(const u32x4*)(vt + (size_t)(head * 64 + vrow) * T_TOK + tk0 + vch * 8);
  };
  auto stage_at = [&](int boff) {
    char* kl = lds + boff;
    char* vl = kl + 64 * KS;
    *(u32x4*)(kl + krow0 * KS + kch0 * 16) = pk0;
    *(u32x4*)(kl + krow1 * KS + kch1 * 16) = pk1;
    lds_st16_as2x8(vl + vrow * 136 + vch * 16, pv0);
  };
  prefetch(0);
  stage_at(0);
  prefetch(1);
  __syncthreads();
#pragma unroll 1
  for (int kt = 0; kt < nkt; ++kt) {
    const char* kl = lds + (kt & 1) * 24576;
    const char* vl = kl + 64 * KS;
    if (kt + 1 < nkt) stage_at(((kt + 1) & 1) * 24576);
    if (kt + 2 < nkt) prefetch(kt + 2);
    f32x16 s[2][2];
#pragma unroll
    for (int kb = 0; kb < 2; ++kb) {
      s[0][kb] = initv[0]; s[1][kb] = initv[1];
#pragma unroll
      for (int ks = 0; ks < DQK / 16; ++ks) {
        const bf16x8 a = *(const bf16x8*)(kl + (32 * kb + r) * KS + (2 * ks + h) * 16);
        const bf16x8 q0 = *(const bf16x8*)(qsl + ks * 1024);
        const bf16x8 q1 = *(const bf16x8*)(qsl + (6 + ks) * 1024);
        s[0][kb] = MFMA32(a, q0, s[0][kb]);
        s[1][kb] = MFMA32(a, q1, s[1][kb]);
      }
    }
#pragma unroll
    for (int j = 0; j < 2; ++j) {
      const float dl = softmax_pre<DV>(s[j], o[j], l[j], kt == 0);
      if (__any(dl != 0.f)) {
#pragma unroll
        for (int i = 0; i < 16; ++i) initv[j][i] -= dl;
      }
    }
#pragma unroll
    for (int kb = 0; kb < 2; ++kb) {
      bf16x8 pf0[2], pf1[2];
      softmax_exp_half(s[0][kb], l[0], pf0);
      softmax_exp_half(s[1][kb], l[1], pf1);
#pragma unroll
      for (int d = 0; d < DV / 32; ++d)
#pragma unroll
        for (int st = 0; st < 2; ++st) {
          const char* vp = vl + (32 * d + r) * 136 + (32 * kb + 16 * st + 4 * h) * 2;
          const u32x2 lo = *(const u32x2*)vp;
          const u32x2 hi = *(const u32x2*)(vp + 16);
          u32x4 u; u.x = lo.x; u.y = lo.y; u.z = hi.x; u.w = hi.y;
          const bf16x8 vf = __builtin_bit_cast(bf16x8, u);
          o[0][d] = MFMA32(vf, pf0[st], o[0][d]);
          o[1][d] = MFMA32(vf, pf1[st], o[1][d]);
        }
    }
    __syncthreads();
  }
  int tid2 = otid(p);
  const int lane2 = tid2 & 63, h2 = lane2 >> 5, w2 = tid2 >> 6;
  int item2 = item; asm volatile("" : "+s"(item2));
  int head2, tq2;
  if (item2 < 512) { head2 = item2 >> 5; tq2 = T_PROMPT + (item2 & 31) * 512 + w2 * 64 + (lane2 & 31); }
  else { const int it = item2 - 512; head2 = (it >> 3) & 15; tq2 = (it >> 7) * 4096 + (it & 7) * 512 + w2 * 64 + (lane2 & 31); }
#pragma unroll
  for (int j = 0; j < 2; ++j) {
    float lj = l[j];
    lj += __shfl_xor(lj, 32);
    const float inv = __builtin_amdgcn_rcpf(lj);
#pragma unroll
    for (int d = 0; d < DV / 32; ++d) store_tok(o1, 1024, tq2 + 32 * j, head2 * 64 + 32 * d + 4 * h2, o[j][d], inv);
  }
}

DI void diff_decode(int item, int& hh, int& qb, int& ts0, int& S) {
  int j;
  if (item < 128) { hh = 3; j = item; S = 16384; }
  else if (item < 256) { hh = 2; j = item - 128; S = 16384; }
  else if (item < 768) { hh = 3; j = item - 256; S = 4096; }
  else if (item < 1280) { hh = 2; j = item - 768; S = 4096; }
  else if (item < 1408) { hh = 1; j = item - 1280; S = 16384; }
  else if (item < 1920) { hh = 1; j = item - 1408; S = 4096; }
  else if (item < 2048) { hh = 0; j = item - 1920; S = 16384; }
  else { hh = 0; j = item - 2048; S = 4096; }
  if (S == 16384) { qb = j; ts0 = T_PROMPT; } else { qb = j & 31; ts0 = (j >> 5) * 4096; }
}
DI void attn_diff_item(const Ctx& p, int item, char* lds) {
  constexpr int DQK = 64, DV = 128, KS = DQK * 2 + 16;
  const int tid = otid(p), lane = tid & 63, w = tid >> 6, r = lane & 31, h = lane >> 5;
  const int map = w >> 2, qw = w & 3;
  int hh, qb, ts0, S;
  diff_decode(item, hh, qb, ts0, S);
  const u16* base = (const u16*)(p.ws + OFF_R2);
  const u16* dq = base + 3 * SEG512;
  const u16* dk = base + 4 * SEG512;
  const u16* vtd = base + 5 * SEG512;
  u16* o0 = (u16*)(p.ws + OFF_R1);
  const int qpos = qb * 128 + qw * 32 + r;
  const int tq = ts0 + qpos;
  char* qsl = lds + 3 * ATT_STAGE + 4096 + w * 4096 + lane * 16;
  __syncthreads();
#pragma unroll
  for (int ks = 0; ks < DQK / 16; ++ks) *(bf16x8*)(qsl + ks * 1024) = *(const bf16x8*)(dq + (size_t)tq * 512 + (2 * hh + map) * 64 + 16 * ks + 8 * h);
  f32x16 o[DV / 32];
#pragma unroll
  for (int d = 0; d < DV / 32; ++d)
#pragma unroll
    for (int i = 0; i < 16; ++i) o[d][i] = 0.f;
  float l = 0.f;
  float ref = 0.f;
  const float slope2 = exp2f(-2.f * (float)(hh + 1)) * LOG2E;
  const float cq = slope2 * (float)qpos;
  const int d0 = 2 * qb;
  const int kd = d0 + (qw >> 1);
  int kt_lo, kt_hi;
  {
    const unsigned* qk = (const unsigned*)(p.ws + OFF_SCAL) + SC_QKMAX;
    const float b0 = __uint_as_float(qk[2 * hh]) * __uint_as_float(qk[8 + 2 * hh]);
    const float b1 = __uint_as_float(qk[2 * hh + 1]) * __uint_as_float(qk[8 + 2 * hh + 1]);
    const float B = fmaxf(b0, b1) * 1.02f + 0.5f;
    const float dskip = fminf((2.f * B + 34.f) / slope2 + 1.f, 1.0e6f);
    const int q_lo = qb * 128, q_hi = q_lo + 127, ds = (int)dskip;
    kt_lo = max(0, (q_lo - 63 - ds) >> 6);
    kt_hi = min((S >> 6) - 1, (q_hi + ds) >> 6);
    kt_lo = min(kt_lo, 2 * qb); kt_hi = max(kt_hi, 2 * qb + 1);
  }
  const int nleft = d0 - kt_lo;
  const int nkt = kt_hi - kt_lo + 1;
  u32x4 pk[2], pv[2];
  const int lrow = tid >> 3, lch = tid & 7;
  auto tile_of = [&](int idx) { return idx < 2 ? d0 + idx : (idx - 2 < nleft ? d0 - 1 - (idx - 2) : idx + kt_lo); };
  const unsigned koff = (unsigned)(((ts0 + lrow) * 512 + 2 * hh * 64 + lch * 8) * 2);
  const unsigned voff = (unsigned)((((hh * 128 + lrow) * T_TOK) + ts0 + lch * 8) * 2);
  const char* dkb = (const char*)dk;
  const char* vtb = (const char*)vtd;
  auto prefetch = [&](int kt) {
    const unsigned ko = koff + (unsigned)kt * (64u * 512u * 2u);
    const unsigned vo = voff + (unsigned)kt * 128u;
    pk[0] = *(const u32x4*)(dkb + ko);
    pk[1] = *(const u32x4*)(dkb + ko + 128u);
    pv[0] = *(const u32x4*)(vtb + vo);
    pv[1] = *(const u32x4*)(vtb + vo + (unsigned)(64 * T_TOK * 2));
  };
  auto stage_at = [&](int boff) {
    char* kl0 = lds + boff;
    char* vl = kl0 + 2 * 64 * KS;
#pragma unroll
    for (int j = 0; j < 2; ++j) *(u32x4*)(kl0 + j * 64 * KS + lrow * KS + lch * 16) = pk[j];
#pragma unroll
    for (int j = 0; j < 2; ++j) lds_st16_as2x8(vl + (lrow + 64 * j) * 136 + lch * 16, pv[j]);
  };
  auto scores = [&](int kt, int boff, f32x16 (&sc)[2]) {
    const int side = kt < kd ? -1 : (kt > kd ? 1 : 0);
    const float I = (float)side * cq - ref;
    const unsigned i_hi = cvt_pk(I, 0.f) & 0xffffu;
    const float ir1 = I - __uint_as_float(i_hi << 16);
    const unsigned i_mid = cvt_pk(ir1, 0.f) & 0xffffu;
    const float ir2 = ir1 - __uint_as_float(i_mid << 16);
    const unsigned i_lo = cvt_pk(ir2, 0.f) & 0xffffu;
    const float T = slope2 * (float)(kt * 64);
    const unsigned t_hi = cvt_pk(T, 0.f) & 0xffffu;
    const float r1 = T - __uint_as_float(t_hi << 16);
    const unsigned t_mid = cvt_pk(r1, 0.f) & 0xffffu;
    const float r2 = r1 - __uint_as_float(t_mid << 16);
    const unsigned t_lo = cvt_pk(r2, 0.f) & 0xffffu;
    const unsigned one = side < 0 ? 0x3F80u : (side > 0 ? 0xBF80u : 0u);
    u32x4 qa;
    qa.x = h == 0 ? (one | (one << 16)) : 0u; qa.y = qa.x; qa.z = h == 0 ? (one | (i_hi << 16)) : 0u; qa.w = h == 0 ? (i_mid | (i_lo << 16)) : 0u;
    const bf16x8 qaug = __builtin_bit_cast(bf16x8, qa);
#pragma unroll
    for (int kb = 0; kb < 2; ++kb) {
      const float xl = slope2 * (float)(32 * kb + r);
      const unsigned l_hi = cvt_pk(xl, 0.f) & 0xffffu;
      const unsigned l_lo = cvt_pk(xl - __uint_as_float(l_hi << 16), 0.f) & 0xffffu;
      u32x4 ka; ka.x = h == 0 ? (l_hi | (l_lo << 16)) : 0u; ka.y = h == 0 ? (t_hi | (t_mid << 16)) : 0u; ka.z = h == 0 ? (t_lo | 0x3F800000u) : 0u; ka.w = h == 0 ? 0x3F803F80u : 0u;
      f32x16 z;
#pragma unroll
      for (int i = 0; i < 16; ++i) z[i] = 0.f;
      sc[kb] = MFMA32(__builtin_bit_cast(bf16x8, ka), qaug, z);
    }
    qk_scores_qlds<DQK>(lds + boff + map * 64 * KS, qsl, sc, r, h);
  };
  prefetch(tile_of(0));
  __syncthreads();
  stage_at(0);
  prefetch(tile_of(1));
  stage_at(ATT_STAGE);
  if (nkt > 2) prefetch(tile_of(2));
  __syncthreads();
  int cur = 0, nxt = ATT_STAGE, nn = 2 * ATT_STAGE;
  f32x16 s[2];
  scores(tile_of(0), 0, s);
#pragma unroll 1
  for (int idx = 0; idx < nkt; ++idx) {
    const int kt = tile_of(idx);
    if (kt == kd) {
#pragma unroll
      for (int kb = 0; kb < 2; ++kb)
#pragma unroll
        for (int i = 0; i < 16; ++i) {
          const int kp = kt * 64 + 32 * kb + (i & 3) + 8 * (i >> 2) + 4 * h;
          s[kb][i] -= slope2 * fabsf((float)(qpos - kp));
        }
    }
    ref += softmax_pre<DV>(s, o, l, idx == 0);
    f32x16 sn[2];
    scores(tile_of(min(idx + 1, nkt - 1)), nxt, sn);
#pragma unroll
    for (int kb = 0; kb < 2; ++kb) {
      bf16x8 pf[2];
      softmax_exp_half(s[kb], l, pf);
      pv_half<DV>(pf, o, lds + cur + 2 * 64 * KS, kb, r, h);
    }
    if (idx + 2 < nkt) stage_at(nn);
    if (idx + 3 < nkt) prefetch(tile_of(idx + 3));
    __syncthreads();
    s[0] = sn[0]; s[1] = sn[1];
    const int t = cur; cur = nxt; nxt = nn; nn = t;
  }
  l += __shfl_xor(l, 32);
  const float inv = 1.f / l;
  int tid2 = otid(p);
  const int lane2 = tid2 & 63, qw2 = (tid2 >> 6) & 3, h2 = lane2 >> 5;
  int item2 = item; asm volatile("" : "+s"(item2));
  int hh2, tq2;
  { int qb2, ts02, S2; diff_decode(item2, hh2, qb2, ts02, S2); tq2 = ts02 + qb2 * 128 + qw2 * 32 + (lane2 & 31); }
  float* ex = (float*)lds + qw2 * 4096;
  if (map == 1) {
#pragma unroll
    for (int d = 0; d < DV / 32; ++d)
#pragma unroll
      for (int i = 0; i < 16; ++i) ex[(d * 16 + i) * 64 + lane2] = o[d][i] * inv;
  }
  __syncthreads();
  if (map == 0) {
    const float lam = ((const float*)(p.ws + OFF_SCAL))[0];
    float ss = 0.f;
#pragma unroll
    for (int d = 0; d < DV / 32; ++d)
#pragma unroll
      for (int i = 0; i < 16; ++i) { const float v = o[d][i] * inv - lam * ex[(d * 16 + i) * 64 + lane2]; o[d][i] = v; ss += v * v; }
    ss += __shfl_xor(ss, 32);
    const float rn = rsqrtf(ss * (1.f / 128.f) + EPS) * 0.8f;
    const float* gs = (const float*)(p.ws + OFF_SCAL) + SC_GSUB;
#pragma unroll
    for (int d = 0; d < DV / 32; ++d) {
#pragma unroll
      for (int g = 0; g < 4; ++g) {
        const float4 gv = *(const float4*)(gs + 32 * d + 8 * g + 4 * h2);
        o[d][4 * g] *= gv.x; o[d][4 * g + 1] *= gv.y; o[d][4 * g + 2] *= gv.z; o[d][4 * g + 3] *= gv.w;
      }
      store_tok(o0, 1024, tq2, 512 + hh2 * 128 + 32 * d + 4 * h2, o[d], rn);
    }
  }
}

DI void attn_na_item(const Ctx& p, int item, char* lds) {
  constexpr int DQK = 64, DV = 64, KS = DQK * 2 + 16;
  const int tid = otid(p), lane = tid & 63, w = tid >> 6, r = lane & 31, h = lane >> 5;
  const int quad = item % 320, head = item / 320;
  const int t0 = quad * 256;
  int ts0, rows;
  if (t0 < T_PROMPT) { ts0 = t0 & ~4095; rows = 64; } else { ts0 = T_PROMPT; rows = 256; }
  const int r0 = (t0 - ts0) >> 6;
  const int rw = r0 + (w >> 1);
  const int rs_lo = min(max(r0 - 4, 0), rows - 8);
  const int rs_hi = min(max(r0 + 3 - 4, 0), rows - 8);
  const int rs_w = min(max(rw - 4, 0), rows - 8);
  const int ntile = rs_hi + 8 - rs_lo;
  const u16* base = (const u16*)(p.ws + OFF_R2);
  const u16* qn = base;
  const u16* kn = base + SEG512;
  const u16* vtn = base + 2 * SEG512;
  u16* o0 = (u16*)(p.ws + OFF_R1);
  float* tab = (float*)(lds + 2 * ATT_STAGE) + 64;
  const int qc = (w & 1) * 32 + r;
  const int tq = t0 + w * 32 + r;
  bf16x8 qf[DQK / 16];
#pragma unroll
  for (int ks = 0; ks < DQK / 16; ++ks) qf[ks] = *(const bf16x8*)(qn + (size_t)tq * 512 + head * 64 + 16 * ks + 8 * h);
  f32x16 o[DV / 32];
#pragma unroll
  for (int d = 0; d < DV / 32; ++d)
#pragma unroll
    for (int i = 0; i < 16; ++i) o[d][i] = 0.f;
  f32x16 initv;
#pragma unroll
  for (int i = 0; i < 16; ++i) initv[i] = 0.f;
  float l = 0.f;
  bool first = true;
  u32x4 pk0, pv0;
  const int lrow = tid >> 3, lch = tid & 7;
  auto prefetch = [&](int j) {
    const int tk0 = ts0 + (rs_lo + j) * 64;
    pk0 = *(const u32x4*)(kn + (size_t)(tk0 + lrow) * 512 + head * 64 + lch * 8);
    pv0 = *(const u32x4*)(vtn + (size_t)(head * 64 + lrow) * T_TOK + tk0 + lch * 8);
  };
  auto stage = [&](int b) {
    char* kl = lds + b * ATT_STAGE;
    char* vl = kl + 64 * KS;
    *(u32x4*)(kl + lrow * KS + lch * 16) = pk0;
    lds_st16_as2x8(vl + lrow * 136 + lch * 16, pv0);
  };
  prefetch(0);
  __syncthreads();
  if (tid < 465) tab[tid] = ((const float*)(p.ws + OFF_SCAL))[SC_RPB + head * 465 + tid];
  stage(0);
  prefetch(1);
  __syncthreads();
  const int wc0 = min(max(qc - 8, 0), 48);
  const float* tabq = tab + (15 - qc + 4 * h);
  for (int j = 0; j < ntile; ++j) {
    const char* kl = lds + (j & 1) * ATT_STAGE;
    const char* vl = kl + 64 * KS;
    const int kr = rs_lo + j;
    if (kr >= rs_w && kr < rs_w + 8) {
      f32x16 s[2];
      qk_scores<DQK>(kl, qf, initv, s, r, h);
      const int ridx = kr - rw + 7;
#pragma unroll
      for (int kb = 0; kb < 2; ++kb)
#pragma unroll
        for (int i = 0; i < 16; ++i) {
          const int kc = 32 * kb + (i & 3) + 8 * (i >> 2) + 4 * h;
          const bool ok = (unsigned)(kc - wc0) < 16u;
          const float b = tabq[ridx * 31 + 32 * kb + (i & 3) + 8 * (i >> 2)];
          s[kb][i] = ok ? s[kb][i] + b : -INFINITY;
        }
      {
        const float dl = softmax_pv<DV>(s, o, l, first, vl, r, h);
        if (__any(dl != 0.f)) {
#pragma unroll
          for (int i = 0; i < 16; ++i) initv[i] -= dl;
        }
      }
      first = false;
    }
    if (j + 1 < ntile) stage((j + 1) & 1);
    if (j + 2 < ntile) prefetch(j + 2);
    __syncthreads();
  }
  l += __shfl_xor(l, 32);
  const float inv = 1.f / l;
#pragma unroll
  for (int d = 0; d < DV / 32; ++d) store_tok(o0, 1024, tq, head * 64 + 32 * d + 4 * h, o[d], inv);
}

constexpr int LDS_BYTES = 2 * (256 + 256) * 144;
template <int PH>
DI void run_phase(const Ctx& p, char* lds) {
  const int bid = obid(), nblk = gridDim.x;
  u16* wb = (u16*)p.ws;
  u16* R1 = (u16*)(p.ws + OFF_R1);
  u16* R2 = (u16*)(p.ws + OFF_R2);
  u16* R3 = (u16*)(p.ws + OFF_R3);
  if constexpr (PH == 0) phase_prep(p);
  else if constexpr (PH == 1) gemm_phase(R1, 1024, wb + W0IN, 1024, T_TOK, 3072, 1024, EpiProj0{R2, (unsigned*)(p.ws + OFF_SCAL) + SC_QKMAX}, lds, bid, nblk, p);
  else if constexpr (PH == 2) {
    unsigned* ctr = (unsigned*)(p.ws + OFF_SCAL) + SC_CTR;
    int* nxt_slot = (int*)(lds + LDS_BYTES - 16);
    const int tid0 = otid(p);
    int it = bid;
    while (it < 5120) {
      int nx = 0;
      if (tid0 == 0) nx = (int)atomicAdd(ctr, 1u) + nblk;
      if (it < 2560) attn_diff_item(p, it, lds);
      else attn_na_item(p, it - 2560, lds);
      __syncthreads();
      if (tid0 == 0) *nxt_slot = nx;
      __syncthreads();
      it = *nxt_slot;
    }
  }
  else if constexpr (PH == 3) gemm_phase(R1, 1024, wb + W0OUT, 1024, T_TOK, 1024, 1024, EpiTok{R3, 1024}, lds, bid, nblk, p);
  else if constexpr (PH == 4) phase_res<true, false>(p, R3, (const float*)(p.ws + OFF_SCAL) + SC_G0);
  else if constexpr (PH == 5) gemm_phase(R1, 1024, wb + W0F1, 1024, T_TOK, 5632, 1024, EpiSwiGLU{R2}, lds, bid, nblk, p);
  else if constexpr (PH == 6) gemm_phase(R2, 2816, wb + W0F2, 2816, T_TOK, 1024, 2816, EpiTok{R3, 1024}, lds, bid, nblk, p);
  else if constexpr (PH == 7) phase_res<false, false>(p, R3, (const float*)(p.ws + OFF_SCAL) + SC_G1);
  else if constexpr (PH == 8) gemm_phase(R1, 1024, wb + W1DN, 1024, T_TOK, 768, 1024, EpiTok{R3, 768}, lds, bid, nblk, p);
  else if constexpr (PH == 9) phase_mla_stats(p);
  else if constexpr (PH == 10) {
    gemm_phase(R3, 768, wb + W1UQ, 384, T_TOK, 1536, 384,
                     EpiUQ{R2, (const float*)(p.ws + OFF_RQ), (const float2*)(p.ws + OFF_ROPE)}, lds, bid, nblk, p);
    gemm_phase(R3 + 384, 768, wb + W1UKV, 256, T_TOK, 2048, 256,
                     EpiUKV{R2 + (size_t)T_TOK * 1536, R2 + (size_t)T_TOK * 2560, (const float*)(p.ws + OFF_RKV)}, lds, bid, nblk, p);
  }
  else if constexpr (PH == 11) { for (int it = bid; it < 2560; it += nblk) {
      int itm = it;
      if (nblk == 256) {
        const int rnd = it >> 8, x = bid & 7, j = bid >> 3;
        itm = rnd < 2 ? (8 * rnd + x) * 32 + j : 512 + (2 * (rnd - 2) + (x >> 2)) * 128 + (4 * (x & 3) + (j >> 3)) * 8 + (j & 7);
      }
      attn_mla_item2(p, itm, lds);
    } }
  else if constexpr (PH == 12) gemm_phase(R1, 1024, wb + W1OUT, 1024, T_TOK, 1024, 1024, EpiTok{R3, 1024}, lds, bid, nblk, p);
  else if constexpr (PH == 13) phase_res<false, false>(p, R3, (const float*)(p.ws + OFF_SCAL) + SC_G2);
  else if constexpr (PH == 14) gemm_phase(R1, 1024, wb + W1F1, 1024, T_TOK, 5632, 1024, EpiSwiGLU{R2}, lds, bid, nblk, p);
  else if constexpr (PH == 15) gemm_phase(R2, 2816, wb + W1F2, 2816, T_TOK, 1024, 2816, EpiTok{R3, 1024}, lds, bid, nblk, p);
  else if constexpr (PH == 16) phase_res<false, true>(p, R3, (const float*)(p.ws + OFF_SCAL) + SC_G3);
}

#if MULTI_LAUNCH
template <int PH>
__global__ void __launch_bounds__(512, 2) k_phase(Params pa) {
  extern __shared__ __attribute__((aligned(16))) char lds[];
  Ctx p;
#pragma unroll
  for (int i = 0; i < 28; ++i) p.in[i] = pa.in[i];
  p.out = pa.out; p.ws = pa.ws;
  p.wv = __builtin_amdgcn_readfirstlane((int)(threadIdx.x >> 6));
  run_phase<PH>(p, lds);
}
template <int PH>
static void launch_all(const Ctx& p, int grid, hipStream_t stream) {
  (void)hipFuncSetAttribute((const void*)k_phase<PH>, hipFuncAttributeMaxDynamicSharedMemorySize, LDS_BYTES);
  hipLaunchKernelGGL(k_phase<PH>, dim3(grid), dim3(512), LDS_BYTES, stream, p);
  if constexpr (PH + 1 < NPHASE) launch_all<PH + 1>(p, grid, stream);
}
#define OCC_KERNEL k_phase<2>
#else
#ifndef PROBE_DUP
#define PROBE_DUP -1
#endif
#ifndef PROBE_DUP2
#define PROBE_DUP2 -1
#endif
DI void grid_barrier(unsigned* ctr, unsigned target, const Ctx& p) {
  __syncthreads();
  if (otid(p) < 64) {
    __builtin_amdgcn_fence(__ATOMIC_RELEASE, "agent");
    if (otid(p) == 0) {
      __hip_atomic_fetch_add(ctr, 1u, __ATOMIC_RELAXED, __HIP_MEMORY_SCOPE_AGENT);
      while (__hip_atomic_load(ctr, __ATOMIC_RELAXED, __HIP_MEMORY_SCOPE_AGENT) < target) __builtin_amdgcn_s_sleep(1);
    }
    __builtin_amdgcn_fence(__ATOMIC_ACQUIRE, "agent");
  }
  __syncthreads();
}
template <int PH>
DI void run_from(const Ctx& p, char* lds) {
  if constexpr (PH == PROBE_DUP || PH == PROBE_DUP2) { run_phase<PH>(p, lds); cg::this_grid().sync(); }
#ifdef PROBE_ABL
  if constexpr (PH == 11) { for (int it = obid(); it < 5120; it += gridDim.x) attn_mla_item<PROBE_ABL>(p, it, lds); cg::this_grid().sync(); }
#endif
  run_phase<PH>(p, lds);
  if constexpr (PH + 1 < NPHASE) {
    if constexpr (PH == 0) cg::this_grid().sync();
    else grid_barrier((unsigned*)(p.ws + OFF_SCAL) + SC_BAR, (unsigned)PH * gridDim.x, p);
    run_from<PH + 1>(p, lds);
  }
}
__global__ void __launch_bounds__(512, 2) mega(Params pa) {
  extern __shared__ __attribute__((aligned(16))) char lds[];
  Ctx p;
#pragma unroll
  for (int i = 0; i < 28; ++i) p.in[i] = pa.in[i];
  p.out = pa.out; p.ws = pa.ws;
  p.wv = __builtin_amdgcn_readfirstlane((int)(threadIdx.x >> 6));
  run_from<0>(p, lds);
}
#define OCC_KERNEL mega
#endif

extern "C" void kernel_launch(void* const* d_in, const int* in_sizes, int n_in, void* d_out, int out_size, void* d_ws, size_t ws_size,
                              hipStream_t stream) {
  static int grid = 0;
  if (grid == 0) {
    if (n_in != 28 || ws_size < WS_NEED) { fprintf(stderr, "kernel_launch: unexpected n_in %d / ws_size %zu (need %zu)\n", n_in, ws_size, (size_t)WS_NEED); grid = -1; return; }
    int dev = 0, cus = 0, per_cu = 0;
    (void)hipGetDevice(&dev);
    (void)hipDeviceGetAttribute(&cus, hipDeviceAttributeMultiprocessorCount, dev);
    (void)hipFuncSetAttribute((const void*)OCC_KERNEL, hipFuncAttributeMaxDynamicSharedMemorySize, LDS_BYTES);
    (void)hipOccupancyMaxActiveBlocksPerMultiprocessor(&per_cu, (const void*)OCC_KERNEL, 512, LDS_BYTES);
    if (per_cu < 1) per_cu = 1;
    if (per_cu > 1) per_cu = 1;
    grid = cus * per_cu;
  }
  if (grid < 0) return;
  Params p{};
  for (int i = 0; i < 28; ++i) p.in[i] = (const float*)d_in[i];
  p.out = (float*)d_out;
  p.ws = (char*)d_ws;
#if MULTI_LAUNCH
  launch_all<0>(p, grid, stream);
#else
  void* args[] = {&p};
  hipError_t e = hipLaunchCooperativeKernel((const void*)mega, dim3(grid), dim3(512), args, LDS_BYTES, stream);
  if (e != hipSuccess) fprintf(stderr, "cooperative launch failed: %s (grid %d)\n", hipGetErrorString(e), grid);
#endif
}
```

```cpp
#include <hip/hip_runtime.h>
#include <hip/hip_cooperative_groups.h>
#include <stdint.h>
#include <cstdio>
namespace cg = cooperative_groups;

#ifndef MULTI_LAUNCH
#define MULTI_LAUNCH 0
#endif

typedef unsigned short u16;
typedef __attribute__((ext_vector_type(8))) short bf16x8;
typedef __attribute__((ext_vector_type(16))) float f32x16;
typedef __attribute__((ext_vector_type(4))) unsigned u32x4;

#define MFMA32(a, b, c) __builtin_amdgcn_mfma_f32_32x32x16_bf16((a), (b), (c), 0, 0, 0)
#define DI __device__ __forceinline__

constexpr int T_TOK = 81920;
constexpr int T_PROMPT = 65536;
constexpr int DM = 1024;
constexpr int DFF = 2816;
constexpr float EPS = 1e-6f;
constexpr float LOG2E = 1.4426950408889634f;
constexpr float QSCALE64 = 0.125f * LOG2E;
constexpr float QSCALE96 = 0.10206207261596577f * LOG2E;
constexpr int NPHASE = 17;

constexpr size_t MiB = (size_t)1 << 20;
constexpr size_t W0IN = 0;
constexpr size_t W0OUT = W0IN + (size_t)3072 * 1024;
constexpr size_t W0F1 = W0OUT + (size_t)1024 * 1024;
constexpr size_t W0F2 = W0F1 + (size_t)5632 * 1024;
constexpr size_t W1DN = W0F2 + (size_t)1024 * 2816;
constexpr size_t W1UQ = W1DN + (size_t)768 * 1024;
constexpr size_t W1UKV = W1UQ + (size_t)1536 * 384;
constexpr size_t W1OUT = W1UKV + (size_t)2048 * 256;
constexpr size_t W1F1 = W1OUT + (size_t)1024 * 1024;
constexpr size_t W1F2 = W1F1 + (size_t)5632 * 1024;
constexpr size_t W_END = W1F2 + (size_t)1024 * 2816;
static_assert(W_END * 2 <= 48 * MiB, "weights region");
constexpr size_t OFF_ROPE = 48 * MiB;
constexpr size_t OFF_RQ = OFF_ROPE + 2 * MiB;
constexpr size_t OFF_RKV = OFF_RQ + MiB / 2;
constexpr size_t OFF_KROPE = OFF_RKV + MiB / 2;
constexpr size_t OFF_SCAL = OFF_KROPE + 5 * MiB;
constexpr int SC_QKMAX = 16, SC_CTR = 32, SC_BAR = 33, SC_KMAX1 = 40, SC_KRMAX = 56;
constexpr int SC_G0 = 1024, SC_G1 = 2048, SC_G2 = 3072, SC_G3 = 4096, SC_GSUB = 5120, SC_RPB = 6144;
constexpr size_t OFF_R1 = 58 * MiB;
constexpr size_t OFF_R3 = OFF_R1 + 160 * MiB;
constexpr size_t OFF_R2 = OFF_R3 + 160 * MiB;
constexpr size_t WS_NEED = OFF_R2 + 560 * MiB;
constexpr size_t SEG512 = (size_t)T_TOK * 512;

struct Params {
  const float* in[28];
  float* out;
  char* ws;
};
struct Ctx {
  const float* in[28];
  float* out;
  char* ws;
  int wv;
};

DI u16 f2bf(float x) { unsigned u = __float_as_uint(x); u += 0x7fffu + ((u >> 16) & 1u); return (u16)(u >> 16); }
DI unsigned pack2(float a, float b) { return (unsigned)f2bf(a) | ((unsigned)f2bf(b) << 16); }
DI float bflo(unsigned v) { return __uint_as_float(v << 16); }
DI float bfhi(unsigned v) { return __uint_as_float(v & 0xffff0000u); }
DI float wave_sum(float v) {
#pragma unroll
  for (int o = 32; o; o >>= 1) v += __shfl_xor(v, o);
  return v;
}
DI int tok_pos(int t) { return t < T_PROMPT ? (t & 4095) : (t - T_PROMPT); }
DI float fexp2(float x) { return __builtin_amdgcn_exp2f(x); }
typedef __attribute__((ext_vector_type(2))) float f32x2;
typedef __attribute__((ext_vector_type(2))) __bf16 bf16x2_t;
typedef __attribute__((ext_vector_type(2))) unsigned u32x2;
typedef __attribute__((ext_vector_type(4))) unsigned u32x4_;
DI unsigned cvt_pk(float a, float b) {
  f32x2 v; v.x = a; v.y = b;
  return __builtin_bit_cast(unsigned, __builtin_convertvector(v, bf16x2_t));
}
DI int otid(const Ctx& p) {
  int wv = p.wv; asm volatile("" : "+s"(wv));
  int t = wv * 64 + (int)__builtin_amdgcn_mbcnt_hi(~0u, __builtin_amdgcn_mbcnt_lo(~0u, 0u));
  asm volatile("" : "+v"(t));
  return t;
}
DI int obid() { int b = blockIdx.x; asm volatile("" : "+s"(b)); return b; }

__device__ const float ROPE_INV[16] = {1.0f, 0.5623413324356079f, 0.3162277638912201f, 0.17782793939113617f, 0.10000000149011612f, 0.05623413249850273f, 0.03162277489900589f, 0.017782794311642647f, 0.009999999776482582f, 0.005623413249850273f, 0.003162277629598975f, 0.0017782794311642647f, 0.0010000000474974513f, 0.000562341301701963f, 0.0003162277571391314f, 0.00017782794020604342f};

DI void wconv(const float* __restrict__ W, const float* __restrict__ g, u16* __restrict__ dst, int K, int N, int rowsOut, int perm, int gtid, int gthreads) {
  const int kc = K >> 3;
  const long total = (long)rowsOut * kc;
  for (long c = gtid; c < total; c += gthreads) {
    const int n = (int)(c % rowsOut);
    const int k0 = (int)(c / rowsOut) * 8;
    int sc;
    if (perm == 1) { const int blk = n >> 6, w = n & 63; const int j = blk * 32 + (w & 31); sc = (w < 32) ? j : DFF + j; }
    else if (perm == 2) { const int hd = (n & 1023) >> 6, d = n & 63; sc = hd * 128 + (n >= 1024 ? 64 : 0) + d; }
    else sc = n;
    uint4 o = make_uint4(0, 0, 0, 0);
    if (sc < N) {
      float v[8];
#pragma unroll
      for (int i = 0; i < 8; ++i) { float x = W[(size_t)(k0 + i) * N + sc]; if (g) x *= g[k0 + i]; v[i] = x; }
      o.x = pack2(v[0], v[1]); o.y = pack2(v[2], v[3]); o.z = pack2(v[4], v[5]); o.w = pack2(v[6], v[7]);
    }
    *(uint4*)(dst + (size_t)n * K + k0) = o;
  }
}

DI void phase_prep(const Ctx& p) {
  const int gtid = obid() * 512 + otid(p), gthreads = gridDim.x * 512;
  u16* wb = (u16*)p.ws;
  wconv(p.in[3], p.in[2], wb + W0IN, 1024, 3072, 3072, 0, gtid, gthreads);
  wconv(p.in[10], nullptr, wb + W0OUT, 1024, 1024, 1024, 0, gtid, gthreads);
  wconv(p.in[13], p.in[12], wb + W0F1, 1024, 5632, 5632, 1, gtid, gthreads);
  wconv(p.in[14], nullptr, wb + W0F2, 2816, 1024, 1024, 0, gtid, gthreads);
  wconv(p.in[17], p.in[16], wb + W1DN, 1024, 672, 768, 0, gtid, gthreads);
  wconv(p.in[20], p.in[18], wb + W1UQ, 384, 1536, 1536, 0, gtid, gthreads);
  wconv(p.in[21], p.in[19], wb + W1UKV, 256, 2048, 2048, 2, gtid, gthreads);
  wconv(p.in[22], nullptr, wb + W1OUT, 1024, 1024, 1024, 0, gtid, gthreads);
  wconv(p.in[25], p.in[24], wb + W1F1, 1024, 5632, 5632, 1, gtid, gthreads);
  wconv(p.in[26], nullptr, wb + W1F2, 2816, 1024, 1024, 0, gtid, gthreads);
  float2* rope = (float2*)(p.ws + OFF_ROPE);
  for (int idx = gtid; idx < 16384 * 16; idx += gthreads) {
    const int pos = idx >> 4, i = idx & 15;
    const float ang = (float)pos * ROPE_INV[i];
    double rev = (double)ang * 0.15915494309189535;
    rev -= rint(rev);
    const float rf = (float)rev;
    rope[idx] = make_float2(__builtin_amdgcn_cosf(rf), __builtin_amdgcn_sinf(rf));
  }
  if (gtid == 0) {
    float s1 = 0.f, s2 = 0.f;
    for (int i = 0; i < 64; ++i) { s1 += p.in[5][i] * p.in[6][i]; s2 += p.in[7][i] * p.in[8][i]; }
    float* sc = (float*)(p.ws + OFF_SCAL);
    sc[0] = __expf(s1) - __expf(s2) + 0.2f;
    for (int i = 0; i < 48; ++i) ((unsigned*)sc)[SC_QKMAX + i] = 0u;
  }
  {
    float* sc = (float*)(p.ws + OFF_SCAL);
    for (int i = gtid; i < 1024; i += gthreads) { sc[SC_G0 + i] = p.in[11][i]; sc[SC_G1 + i] = p.in[15][i]; sc[SC_G2 + i] = p.in[23][i]; sc[SC_G3 + i] = p.in[27][i]; }
    for (int i = gtid; i < 128; i += gthreads) sc[SC_GSUB + i] = p.in[9][i];
    for (int i = gtid; i < 8 * 465; i += gthreads) sc[SC_RPB + i] = p.in[4][i] * LOG2E;
  }
  const int tid_ = otid(p);
  const int lane = tid_ & 63;
  const int gw = obid() * 8 + (tid_ >> 6), nw = gridDim.x * 8;
  u16* hb = (u16*)(p.ws + OFF_R1);
  for (int row = gw; row < T_TOK; row += nw) {
    const float* xr = row < T_PROMPT ? p.in[0] + (size_t)row * DM : p.in[1] + (size_t)(row - T_PROMPT) * DM;
    float4 v[4];
    float ss = 0.f;
#pragma unroll
    for (int j = 0; j < 4; ++j) { v[j] = ((const float4*)xr)[lane + 64 * j]; ss += v[j].x * v[j].x + v[j].y * v[j].y + v[j].z * v[j].z + v[j].w * v[j].w; }
    ss = wave_sum(ss);
    const float r = rsqrtf(ss * (1.f / DM) + EPS);
#pragma unroll
    for (int j = 0; j < 4; ++j) {
      uint2 o; o.x = pack2(v[j].x * r, v[j].y * r); o.y = pack2(v[j].z * r, v[j].w * r);
      ((uint2*)(hb + (size_t)row * DM))[lane + 64 * j] = o;
    }
  }
}

template <bool FIRST, bool LAST>
DI void phase_res(const Ctx& p, const u16* __restrict__ mbuf, const float* __restrict__ g) {
  const int tid_ = otid(p);
  const int lane = tid_ & 63;
  const int gw = obid() * 8 + (tid_ >> 6), nw = gridDim.x * 8;
  u16* hb = (u16*)(p.ws + OFF_R1);
  float4 gv[4];
#pragma unroll
  for (int j = 0; j < 4; ++j) gv[j] = ((const float4*)g)[lane + 64 * j];
  for (int row0 = gw; row0 < T_TOK; row0 += 2 * nw) {
    float4 xv[2][4], mv[2][4];
    float ss[2] = {0.f, 0.f};
    bool act[2];
#pragma unroll
    for (int t = 0; t < 2; ++t) {
      const int row = row0 + t * nw;
      act[t] = row < T_TOK;
      const int rr = act[t] ? row : row0;
      const float* xr;
      if (FIRST) xr = rr < T_PROMPT ? p.in[0] + (size_t)rr * DM : p.in[1] + (size_t)(rr - T_PROMPT) * DM;
      else xr = p.out + (size_t)rr * DM;
#pragma unroll
      for (int j = 0; j < 4; ++j) {
        const uint2 u = ((const uint2*)(mbuf + (size_t)rr * DM))[lane + 64 * j];
        mv[t][j] = make_float4(bflo(u.x), bfhi(u.x), bflo(u.y), bfhi(u.y));
        xv[t][j] = ((const float4*)xr)[lane + 64 * j];
      }
    }
#pragma unroll
    for (int t = 0; t < 2; ++t) {
#pragma unroll
      for (int j = 0; j < 4; ++j) ss[t] += mv[t][j].x * mv[t][j].x + mv[t][j].y * mv[t][j].y + mv[t][j].z * mv[t][j].z + mv[t][j].w * mv[t][j].w;
      ss[t] = wave_sum(ss[t]);
    }
#pragma unroll
    for (int t = 0; t < 2; ++t) {
      if (!act[t]) continue;
      const int row = row0 + t * nw;
      const float rm = rsqrtf(ss[t] * (1.f / DM) + EPS);
      float s2 = 0.f;
#pragma unroll
      for (int j = 0; j < 4; ++j) {
        xv[t][j].x += mv[t][j].x * rm * gv[j].x; xv[t][j].y += mv[t][j].y * rm * gv[j].y;
        xv[t][j].z += mv[t][j].z * rm * gv[j].z; xv[t][j].w += mv[t][j].w * rm * gv[j].w;
        s2 += xv[t][j].x * xv[t][j].x + xv[t][j].y * xv[t][j].y + xv[t][j].z * xv[t][j].z + xv[t][j].w * xv[t][j].w;
        ((float4*)(p.out + (size_t)row * DM))[lane + 64 * j] = xv[t][j];
      }
      if (!LAST) {
        s2 = wave_sum(s2);
        const float r2 = rsqrtf(s2 * (1.f / DM) + EPS);
#pragma unroll
        for (int j = 0; j < 4; ++j) {
          uint2 o; o.x = pack2(xv[t][j].x * r2, xv[t][j].y * r2); o.y = pack2(xv[t][j].z * r2, xv[t][j].w * r2);
          ((uint2*)(hb + (size_t)row * DM))[lane + 64 * j] = o;
        }
      }
    }
  }
}

DI void phase_mla_stats(const Ctx& p) {
  const int tid_ = otid(p);
  const int lane = tid_ & 63;
  const int gw = obid() * 8 + (tid_ >> 6), nw = gridDim.x * 8;
  const u16* c = (const u16*)(p.ws + OFF_R3);
  float* rq = (float*)(p.ws + OFF_RQ);
  float* rkv = (float*)(p.ws + OFF_RKV);
  u16* krope = (u16*)(p.ws + OFF_KROPE);
  const float2* rope = (const float2*)(p.ws + OFF_ROPE);
  float krmax2 = 0.f;
  for (int row = gw; row < T_TOK; row += nw) {
    const u16* cr = c + (size_t)row * 768;
    const uint4 u0 = ((const uint4*)cr)[lane];
    float s0 = 0.f;
    { float a;
      a = bflo(u0.x); s0 += a * a; a = bfhi(u0.x); s0 += a * a; a = bflo(u0.y); s0 += a * a; a = bfhi(u0.y); s0 += a * a;
      a = bflo(u0.z); s0 += a * a; a = bfhi(u0.z); s0 += a * a; a = bflo(u0.w); s0 += a * a; a = bfhi(u0.w); s0 += a * a; }
    float s1 = 0.f;
    if (lane < 16) {
      const uint4 u1 = ((const uint4*)cr)[64 + lane];
      float a;
      a = bflo(u1.x); s1 += a * a; a = bfhi(u1.x); s1 += a * a; a = bflo(u1.y); s1 += a * a; a = bfhi(u1.y); s1 += a * a;
      a = bflo(u1.z); s1 += a * a; a = bfhi(u1.z); s1 += a * a; a = bflo(u1.w); s1 += a * a; a = bfhi(u1.w); s1 += a * a;
    }
    const float sq = wave_sum(lane < 48 ? s0 : 0.f);
    const float skv = wave_sum((lane >= 48 ? s0 : 0.f) + s1);
    if (lane == 0) {
      rq[row] = rsqrtf(sq * (1.f / 384.f) + EPS);
      rkv[row] = rsqrtf(skv * (1.f / 256.f) + EPS);
    }
    float kr2 = 0.f;
    if (lane < 16) {
      const float x1 = __uint_as_float((unsigned)cr[640 + lane] << 16);
      const float x2 = __uint_as_float((unsigned)cr[656 + lane] << 16);
      const float2 cs = rope[tok_pos(row) * 16 + lane];
      const float o1 = x1 * cs.x - x2 * cs.y, o2 = x2 * cs.x + x1 * cs.y;
      krope[(size_t)row * 32 + lane] = f2bf(o1);
      krope[(size_t)row * 32 + 16 + lane] = f2bf(o2);
      kr2 = o1 * o1 + o2 * o2;
    }
    krmax2 = fmaxf(krmax2, wave_sum(kr2));
  }
  if (lane == 0) atomicMax((unsigned*)(p.ws + OFF_SCAL) + SC_KRMAX, __float_as_uint(sqrtf(krmax2)));
}

DI void store_tok(u16* out, int ldo, int m, int nbase, const f32x16& v, float sc) {
  u16* q = out + (size_t)m * ldo + nbase;
#pragma unroll
  for (int g = 0; g < 4; ++g) {
    uint2 u; u.x = pack2(v[4 * g] * sc, v[4 * g + 1] * sc); u.y = pack2(v[4 * g + 2] * sc, v[4 * g + 3] * sc);
    *(uint2*)(q + 8 * g) = u;
  }
}
DI void store_tr(u16* outT, size_t ldt, int n, int mbase, const f32x16& v, const float* __restrict__ rs) {
  u16* q = outT + (size_t)n * ldt + mbase;
#pragma unroll
  for (int g = 0; g < 4; ++g) {
    float4 s = make_float4(1.f, 1.f, 1.f, 1.f);
    if (rs) s = *(const float4*)(rs + mbase + 8 * g);
    uint2 u; u.x = pack2(v[4 * g] * s.x, v[4 * g + 1] * s.y); u.y = pack2(v[4 * g + 2] * s.z, v[4 * g + 3] * s.w);
    *(uint2*)(q + 8 * g) = u;
  }
}

DI void store_tok_u(u16* ub, unsigned loff, const f32x16& v, float sc) {
  char* q = (char*)ub;
#pragma unroll
  for (int g = 0; g < 4; ++g) {
    u32x2 u; u.x = cvt_pk(v[4 * g] * sc, v[4 * g + 1] * sc); u.y = cvt_pk(v[4 * g + 2] * sc, v[4 * g + 3] * sc);
    *(u32x2*)(q + loff + 16 * g) = u;
  }
}
DI void store_tr_u(u16* ub, unsigned loff, const f32x16& v, const float* __restrict__ rs) {
  char* q = (char*)ub;
#pragma unroll
  for (int g = 0; g < 4; ++g) {
    float4 s = make_float4(1.f, 1.f, 1.f, 1.f);
    if (rs) s = *(const float4*)(rs + 8 * g);
    u32x2 u; u.x = cvt_pk(v[4 * g] * s.x, v[4 * g + 1] * s.y); u.y = cvt_pk(v[4 * g + 2] * s.z, v[4 * g + 3] * s.w);
    *(u32x2*)(q + loff + 16 * g) = u;
  }
}

struct EpiTok {
  u16* out; int ldo;
  static constexpr int SWAPMODE = 1;
  DI bool swap(int) const { return true; }
  template <int WMB, int WNB>
  DI void store(int m0w, int n0w, f32x16 (&acc)[WMB][WNB], int r, int h, bool) const {
#pragma unroll
    for (int mb = 0; mb < WMB; ++mb)
#pragma unroll
      for (int nb = 0; nb < WNB; ++nb) store_tok_u(out + (size_t)(m0w + mb * 32) * ldo + n0w + nb * 32, (unsigned)((r * ldo + 4 * h) * 2), acc[mb][nb], 1.f);
  }
};

struct EpiProj0 {
  u16* base; unsigned* qkmax;
  static constexpr int SWAPMODE = 2;
  DI bool swap(int n0) const { const int reg = n0 >> 9; return !(reg == 2 || reg == 5); }
  template <int WMB, int WNB>
  DI void store(int m0w, int n0w, f32x16 (&acc)[WMB][WNB], int r, int h, bool) const {
    const int reg = n0w >> 9, nl = n0w & 511;
    u16* buf = base + (size_t)reg * SEG512;
    const float sc = (reg == 0 || reg == 3) ? QSCALE64 : 1.f;
#pragma unroll
    for (int mb = 0; mb < WMB; ++mb)
#pragma unroll
      for (int nb = 0; nb < WNB; ++nb) store_tok_u(buf + (size_t)(m0w + mb * 32) * 512 + nl + nb * 32, (unsigned)((r * 512 + 4 * h) * 2), acc[mb][nb], sc);
    __builtin_amdgcn_sched_barrier(0);
    if (reg == 3 || reg == 4) {
      static_assert(WNB == 2, "one head per wave tile");
      float mxn = 0.f;
#pragma unroll
      for (int mb = 0; mb < WMB; ++mb) {
        float ss = 0.f;
#pragma unroll
        for (int nb = 0; nb < WNB; ++nb)
#pragma unroll
          for (int i = 0; i < 16; ++i) { const float v = acc[mb][nb][i]; ss += v * v; }
        { const u32x2 sw = __builtin_amdgcn_permlane32_swap(__float_as_uint(ss), __float_as_uint(ss), false, false); ss = __uint_as_float(sw.x) + __uint_as_float(sw.y); }
        mxn = fmaxf(mxn, ss);
      }
      mxn = fmaxf(mxn, __int_as_float(__builtin_amdgcn_ds_swizzle(__float_as_int(mxn), (16 << 10) | 0x1f)));
      mxn = fmaxf(mxn, __int_as_float(__builtin_amdgcn_ds_swizzle(__float_as_int(mxn), (8 << 10) | 0x1f)));
      mxn = fmaxf(mxn, __int_as_float(__builtin_amdgcn_ds_swizzle(__float_as_int(mxn), (4 << 10) | 0x1f)));
      mxn = fmaxf(mxn, __int_as_float(__builtin_amdgcn_ds_swizzle(__float_as_int(mxn), (2 << 10) | 0x1f)));
      mxn = fmaxf(mxn, __int_as_float(__builtin_amdgcn_ds_swizzle(__float_as_int(mxn), (1 << 10) | 0x1f)));
      if (r == 0 && h == 0) atomicMax(qkmax + (reg - 3) * 8 + (nl >> 6), __float_as_uint(sqrtf(mxn) * sc));
    }
  }
  template <int WMB, int WNB>
  DI void store_t(int n0w, int m0w, f32x16 (&acc)[WMB][WNB], int r, int h) const {
    const int reg = n0w >> 9, nl = n0w & 511;
    u16* buf = base + (size_t)reg * SEG512;
#pragma unroll
    for (int mb = 0; mb < WMB; ++mb)
#pragma unroll
      for (int nb = 0; nb < WNB; ++nb) store_tr_u(buf + (size_t)(nl + mb * 32) * T_TOK + m0w + nb * 32, (unsigned)((r * T_TOK + 4 * h) * 2), acc[mb][nb], nullptr);
  }
};

struct EpiSwiGLU {
  u16* act;
  static constexpr int SWAPMODE = 1;
  DI bool swap(int) const { return true; }
  template <int WMB, int WNB>
  DI void store(int m0w, int n0w, f32x16 (&acc)[WMB][WNB], int r, int h, bool) const {
    static_assert(WNB == 2, "swiglu epilogue needs a 64-wide wave tile");
#pragma unroll
    for (int mb = 0; mb < WMB; ++mb) {
      char* q = (char*)(act + (size_t)(m0w + mb * 32) * DFF + (n0w >> 1)) + (unsigned)((r * DFF + 4 * h) * 2);
#pragma unroll
      for (int g = 0; g < 4; ++g) {
        float y[4];
#pragma unroll
        for (int e = 0; e < 4; ++e) {
          const float gt = acc[mb][0][4 * g + e], up = acc[mb][1][4 * g + e];
          y[e] = gt * __builtin_amdgcn_rcpf(1.f + fexp2(-LOG2E * gt)) * up;
        }
        u32x2 u; u.x = cvt_pk(y[0], y[1]); u.y = cvt_pk(y[2], y[3]);
        *(u32x2*)(q + 16 * g) = u;
      }
      __builtin_amdgcn_sched_barrier(0);
    }
  }
};

struct EpiUQ {
  u16* q; const float* rq; const float2* rope;
  static constexpr int SWAPMODE = 1;
  DI bool swap(int) const { return true; }
  template <int WMB, int WNB>
  DI void store(int m0w, int n0w, f32x16 (&acc)[WMB][WNB], int r, int h, bool) const {
#pragma unroll
    for (int mb = 0; mb < WMB; ++mb) {
      const int m = m0w + mb * 32 + r;
      const float sc = rq[m] * QSCALE96;
      const int pos = tok_pos(m);
#pragma unroll
      for (int nb = 0; nb < WNB; ++nb) {
        const int n0b = n0w + nb * 32;
        f32x16 v = acc[mb][nb];
#pragma unroll
        for (int i = 0; i < 16; ++i) v[i] *= sc;
        if (((n0b >> 5) % 3) == 2) {
#pragma unroll
          for (int i = 0; i < 8; ++i) {
            const int f = (i & 3) + 8 * (i >> 2) + 4 * h;
            const float2 cs = rope[pos * 16 + f];
            const float x1 = v[i], x2 = v[i + 8];
            v[i] = x1 * cs.x - x2 * cs.y;
            v[i + 8] = x2 * cs.x + x1 * cs.y;
          }
        }
        store_tok_u(q + (size_t)(m0w + mb * 32) * 1536 + n0b, (unsigned)((r * 1536 + 4 * h) * 2), v, 1.f);
        __builtin_amdgcn_sched_barrier(0);
      }
    }
  }
};

struct EpiUKV {
  u16* knope; u16* vt; const float* rkv; unsigned* kmax;
  static constexpr int SWAPMODE = 2;
  DI bool swap(int n0) const { return n0 < 1024; }
  template <int WMB, int WNB>
  DI void store(int m0w, int n0w, f32x16 (&acc)[WMB][WNB], int r, int h, bool) const {
#pragma unroll
    for (int mb = 0; mb < WMB; ++mb) {
      const int m = m0w + mb * 32 + r;
      const float sc = rkv[m];
#pragma unroll
      for (int nb = 0; nb < WNB; ++nb) store_tok_u(knope + (size_t)(m0w + mb * 32) * 1024 + n0w + nb * 32, (unsigned)((r * 1024 + 4 * h) * 2), acc[mb][nb], sc);
    }
    __builtin_amdgcn_sched_barrier(0);
    static_assert(WNB == 2, "one head per wave tile");
    float mxn = 0.f;
#pragma unroll
    for (int mb = 0; mb < WMB; ++mb) {
      float ss = 0.f;
#pragma unroll
      for (int nb = 0; nb < WNB; ++nb)
#pragma unroll
        for (int i = 0; i < 16; ++i) { const float v = acc[mb][nb][i]; ss += v * v; }
      { const u32x2 sw = __builtin_amdgcn_permlane32_swap(__float_as_uint(ss), __float_as_uint(ss), false, false); ss = __uint_as_float(sw.x) + __uint_as_float(sw.y); }
      const float sc = rkv[m0w + mb * 32 + r];
      mxn = fmaxf(mxn, ss * sc * sc);
    }
    mxn = fmaxf(mxn, __int_as_float(__builtin_amdgcn_ds_swizzle(__float_as_int(mxn), (16 << 10) | 0x1f)));
    mxn = fmaxf(mxn, __int_as_float(__builtin_amdgcn_ds_swizzle(__float_as_int(mxn), (8 << 10) | 0x1f)));
    mxn = fmaxf(mxn, __int_as_float(__builtin_amdgcn_ds_swizzle(__float_as_int(mxn), (4 << 10) | 0x1f)));
    mxn = fmaxf(mxn, __int_as_float(__builtin_amdgcn_ds_swizzle(__float_as_int(mxn), (2 << 10) | 0x1f)));
    mxn = fmaxf(mxn, __int_as_float(__builtin_amdgcn_ds_swizzle(__float_as_int(mxn), (1 << 10) | 0x1f)));
    if (r == 0 && h == 0) atomicMax(kmax + (n0w >> 6), __float_as_uint(sqrtf(mxn)));
  }
  template <int WMB, int WNB>
  DI void store_t(int n0w, int m0w, f32x16 (&acc)[WMB][WNB], int r, int h) const {
#pragma unroll
    for (int mb = 0; mb < WMB; ++mb)
#pragma unroll
      for (int nb = 0; nb < WNB; ++nb) store_tr_u(vt + (size_t)(n0w - 1024 + mb * 32) * T_TOK + m0w + nb * 32, (unsigned)((r * T_TOK + 4 * h) * 2), acc[mb][nb], rkv + m0w + nb * 32 + 4 * h);
  }
};

template <bool SWAP, int WMB, int WNB>
DI void gemm_compute(const char* la, const char* lb, f32x16 (&acc)[WMB][WNB], int wm, int wn, int r, int h) {
#pragma unroll
  for (int ks = 0; ks < 4; ++ks) {
    bf16x8 af[WMB], bfr[WNB];
#pragma unroll
    for (int mb = 0; mb < WMB; ++mb) af[mb] = *(const bf16x8*)(la + (wm * 32 * WMB + mb * 32 + r) * 144 + (ks * 2 + h) * 16);
#pragma unroll
    for (int nb = 0; nb < WNB; ++nb) bfr[nb] = *(const bf16x8*)(lb + (wn * 32 * WNB + nb * 32 + r) * 144 + (ks * 2 + h) * 16);
#pragma unroll
    for (int mb = 0; mb < WMB; ++mb)
#pragma unroll
      for (int nb = 0; nb < WNB; ++nb) {
        if (SWAP) acc[mb][nb] = MFMA32(bfr[nb], af[mb], acc[mb][nb]);
        else acc[mb][nb] = MFMA32(af[mb], bfr[nb], acc[mb][nb]);
      }
  }
}

struct TileDesc { bool valid; bool normal; int m0, n0, ldp, ldq; unsigned po, qo; const char* P; const char* Q; };

template <class Epi>
DI void gemm_phase(const u16* __restrict__ A, int lda, const u16* __restrict__ Bt, int ldb, int M, int N, int K, const Epi epi, char* lds, int bid, int nblk, const Ctx& p) {
  constexpr int WMB = 4, WNB = 2;
  constexpr int TM = 256, TN = 256;
  constexpr int STAGE = (TM + TN) * 144;
  const int tid = otid(p), lane = tid & 63, w = __builtin_amdgcn_readfirstlane(tid >> 6), wm = w >> 2, wn = w & 3, r = lane & 31, h = lane >> 5;
  const int lrow = tid >> 3, lch = tid & 7;
  const int NT = N / TN, MT = M / TM, tiles = MT * NT, nk = K >> 6;
  const int rounds = (tiles + nblk - 1) / nblk;
  auto desc = [&](int rnd) {
    TileDesc d;
    int tile = rnd * nblk + bid;
    if (nblk == 256) tile = rnd * 256 + (bid & 7) * 32 + (bid >> 3);
    d.valid = rnd < rounds && tile < tiles;
    const int grp = tile / (8 * NT), within = tile - grp * (8 * NT);
    const int nt = within >> 3, mt = grp * 8 + (within & 7);
    d.m0 = mt * TM; d.n0 = nt * TN;
    d.normal = true;
    if constexpr (Epi::SWAPMODE == 2) d.normal = epi.swap(d.n0);
    const char* Ab = (const char*)A + (size_t)d.m0 * lda * 2;
    const char* Bb = (const char*)Bt + (size_t)d.n0 * ldb * 2;
    const unsigned aoff = (unsigned)(lrow * lda * 2 + lch * 16), boff = (unsigned)(lrow * ldb * 2 + lch * 16);
    d.P = d.normal ? Ab : Bb; d.Q = d.normal ? Bb : Ab;
    d.po = d.normal ? aoff : boff; d.qo = d.normal ? boff : aoff;
    d.ldp = d.normal ? lda : ldb; d.ldq = d.normal ? ldb : lda;
    return d;
  };
  u32x4 pa[4], pb[4];
  auto issue = [&](const TileDesc& d, int kt) {
    const char* Pk = d.P + (size_t)kt * 128; asm volatile("" : "+s"(Pk));
    const char* Qk = d.Q + (size_t)kt * 128; asm volatile("" : "+s"(Qk));
#pragma unroll
    for (int j = 0; j < 4; ++j) pa[j] = *(const u32x4*)(Pk + (size_t)j * 128 * d.ldp + d.po);
#pragma unroll
    for (int j = 0; j < 4; ++j) pb[j] = *(const u32x4*)(Qk + (size_t)j * 128 * d.ldq + d.qo);
  };
  auto write_stage = [&](int b) {
    char* wa = lds + b * STAGE;
    char* wb = wa + TM * 144;
#pragma unroll
    for (int j = 0; j < 4; ++j) *(u32x4*)(wa + (lrow + 64 * j) * 144 + lch * 16) = pa[j];
#pragma unroll
    for (int j = 0; j < 4; ++j) *(u32x4*)(wb + (lrow + 64 * j) * 144 + lch * 16) = pb[j];
  };
  TileDesc cur = desc(0);
  if (!cur.valid) return;
  issue(cur, 0);
  for (int rnd = 0;; ++rnd) {
    f32x16 acc[WMB][WNB];
#pragma unroll
    for (int mb = 0; mb < WMB; ++mb)
#pragma unroll
      for (int nb = 0; nb < WNB; ++nb)
#pragma unroll
        for (int i = 0; i < 16; ++i) acc[mb][nb][i] = 0.f;
    write_stage(0);
    if (nk > 1) issue(cur, 1);
    __syncthreads();
    if (w < 4) {
      for (int kt = 0; kt < nk; ++kt) {
        const char* la = lds + (kt & 1) * STAGE;
        if (kt + 1 < nk) write_stage((kt + 1) & 1);
        if (kt + 2 < nk) issue(cur, kt + 2);
        __builtin_amdgcn_sched_barrier(0);
        gemm_compute<true, WMB, WNB>(la, la + TM * 144, acc, wm, wn, r, h);
        __syncthreads();
      }
    } else {
      for (int kt = 0; kt < nk; ++kt) {
        const char* la = lds + (kt & 1) * STAGE;
        gemm_compute<true, WMB, WNB>(la, la + TM * 144, acc, wm, wn, r, h);
        __builtin_amdgcn_sched_barrier(0);
        if (kt + 1 < nk) write_stage((kt + 1) & 1);
        if (kt + 2 < nk) issue(cur, kt + 2);
        __syncthreads();
      }
    }
    const TileDesc nxt = desc(rnd + 1);
    if (nxt.valid) issue(nxt, 0);
    __builtin_amdgcn_sched_barrier(0);
    int m0 = cur.m0, n0 = cur.n0;
    asm volatile("" : "+s"(m0), "+s"(n0));
    int r2 = r, h2 = h, wm2 = wm, wn2 = wn;
    asm volatile("" : "+v"(r2), "+v"(h2));
    asm volatile("" : "+s"(wm2), "+s"(wn2));
    if constexpr (Epi::SWAPMODE == 2) {
      if (cur.normal) epi.template store<WMB, WNB>(m0 + wm2 * 32 * WMB, n0 + wn2 * 32 * WNB, acc, r2, h2, true);
      else epi.template store_t<WMB, WNB>(n0 + wm2 * 32 * WMB, m0 + wn2 * 32 * WNB, acc, r2, h2);
    } else {
      epi.template store<WMB, WNB>(m0 + wm2 * 32 * WMB, n0 + wn2 * 32 * WNB, acc, r2, h2, true);
    }
    if (!nxt.valid) break;
    cur = nxt;
  }
}

DI void lds_st16_as2x8(char* dst, const u32x4 v) {
  u32x2 a; a.x = v.x; a.y = v.y; u32x2 b; b.x = v.z; b.y = v.w;
  *(u32x2*)dst = a;
  *(u32x2*)(dst + 8) = b;
}
constexpr int ATT_STAGE = 35840;
constexpr float DEFER_THR = 8.f;

template <int DQK>
DI void qk_scores_qlds(const char* kl, const char* qsl, f32x16 (&s)[2], int r, int h) {
  constexpr int KS = DQK * 2 + 16;
#pragma unroll
  for (int kb = 0; kb < 2; ++kb) {
#pragma unroll
    for (int ks = 0; ks < DQK / 16; ++ks) {
      const bf16x8 a = *(const bf16x8*)(kl + (32 * kb + r) * KS + (2 * ks + h) * 16);
      const bf16x8 qv = *(const bf16x8*)(qsl + ks * 1024);
      s[kb] = MFMA32(a, qv, s[kb]);
    }
  }
}
template <int DQK>
DI void qk_scores(const char* kl, const bf16x8 (&qf)[DQK / 16], const f32x16& initv, f32x16 (&s)[2], int r, int h) {
  constexpr int KS = DQK * 2 + 16;
#pragma unroll
  for (int kb = 0; kb < 2; ++kb) {
    s[kb] = initv;
#pragma unroll
    for (int ks = 0; ks < DQK / 16; ++ks) {
      const bf16x8 a = *(const bf16x8*)(kl + (32 * kb + r) * KS + (2 * ks + h) * 16);
      s[kb] = MFMA32(a, qf[ks], s[kb]);
    }
  }
}

template <int DV>
DI float softmax_pv(f32x16 (&s)[2], f32x16 (&o)[DV / 32], float& l, bool first, const char* vl, int r, int h) {
  float dret = 0.f;
  float mx = fmaxf(fmaxf(s[0][0], s[0][1]), s[0][2]);
#pragma unroll
  for (int i = 3; i < 15; i += 2) mx = fmaxf(fmaxf(mx, s[0][i]), s[0][i + 1]);
  mx = fmaxf(fmaxf(mx, s[0][15]), s[1][0]);
#pragma unroll
  for (int i = 1; i < 15; i += 2) mx = fmaxf(fmaxf(mx, s[1][i]), s[1][i + 1]);
  mx = fmaxf(mx, s[1][15]);
  const bool need = first || (mx > DEFER_THR);
  if (__any(need)) {
    mx = fmaxf(mx, __shfl_xor(mx, 32));
    float delta;
    if (first) delta = mx;
    else {
      delta = fmaxf(mx, 0.f);
      const float alpha = fexp2(-delta);
      l *= alpha;
#pragma unroll
      for (int d = 0; d < DV / 32; ++d)
#pragma unroll
        for (int i = 0; i < 16; ++i) o[d][i] *= alpha;
    }
#pragma unroll
    for (int kb = 0; kb < 2; ++kb)
#pragma unroll
      for (int i = 0; i < 16; ++i) s[kb][i] -= delta;
    dret = delta;
  }
  float ps = 0.f;
#pragma unroll
  for (int kb = 0; kb < 2; ++kb)
#pragma unroll
    for (int i = 0; i < 16; ++i) { const float e = fexp2(s[kb][i]); s[kb][i] = e; ps += e; }
  l += ps;
  bf16x8 pf[2][2];
#pragma unroll
  for (int kb = 0; kb < 2; ++kb)
#pragma unroll
    for (int st = 0; st < 2; ++st) {
      u32x4 u;
      u.x = cvt_pk(s[kb][8 * st + 0], s[kb][8 * st + 1]); u.y = cvt_pk(s[kb][8 * st + 2], s[kb][8 * st + 3]);
      u.z = cvt_pk(s[kb][8 * st + 4], s[kb][8 * st + 5]); u.w = cvt_pk(s[kb][8 * st + 6], s[kb][8 * st + 7]);
      pf[kb][st] = __builtin_bit_cast(bf16x8, u);
    }
#pragma unroll
  for (int d = 0; d < DV / 32; ++d)
#pragma unroll
    for (int kb = 0; kb < 2; ++kb)
#pragma unroll
      for (int st = 0; st < 2; ++st) {
        const char* vp = vl + (32 * d + r) * 136 + (32 * kb + 16 * st + 4 * h) * 2;
        const u32x2 lo = *(const u32x2*)vp;
        const u32x2 hi = *(const u32x2*)(vp + 16);
        u32x4 u; u.x = lo.x; u.y = lo.y; u.z = hi.x; u.w = hi.y;
        o[d] = MFMA32(__builtin_bit_cast(bf16x8, u), pf[kb][st], o[d]);
      }
  return dret;
}

template <int DV>
DI float softmax_pre(f32x16 (&s)[2], f32x16 (&o)[DV / 32], float& l, bool first) {
  float dret = 0.f;
  float mx = fmaxf(fmaxf(s[0][0], s[0][1]), s[0][2]);
#pragma unroll
  for (int i = 3; i < 15; i += 2) mx = fmaxf(fmaxf(mx, s[0][i]), s[0][i + 1]);
  mx = fmaxf(fmaxf(mx, s[0][15]), s[1][0]);
#pragma unroll
  for (int i = 1; i < 15; i += 2) mx = fmaxf(fmaxf(mx, s[1][i]), s[1][i + 1]);
  mx = fmaxf(mx, s[1][15]);
  const bool need = first || (mx > DEFER_THR);
  if (__any(need)) {
    mx = fmaxf(mx, __shfl_xor(mx, 32));
    float delta;
    if (first) delta = mx;
    else {
      delta = fmaxf(mx, 0.f);
      const float alpha = fexp2(-delta);
      l *= alpha;
#pragma unroll
      for (int d = 0; d < DV / 32; ++d)
#pragma unroll
        for (int i = 0; i < 16; ++i) o[d][i] *= alpha;
    }
#pragma unroll
    for (int kb = 0; kb < 2; ++kb)
#pragma unroll
      for (int i = 0; i < 16; ++i) s[kb][i] -= delta;
    dret = delta;
  }
  return dret;
}
DI void softmax_exp_half(f32x16& s, float& l, bf16x8 (&pf)[2]) {
  float ps = 0.f;
#pragma unroll
  for (int i = 0; i < 16; ++i) { const float e = fexp2(s[i]); s[i] = e; ps += e; }
  l += ps;
#pragma unroll
  for (int st = 0; st < 2; ++st) {
    u32x4 u;
    u.x = cvt_pk(s[8 * st + 0], s[8 * st + 1]); u.y = cvt_pk(s[8 * st + 2], s[8 * st + 3]);
    u.z = cvt_pk(s[8 * st + 4], s[8 * st + 5]); u.w = cvt_pk(s[8 * st + 6], s[8 * st + 7]);
    pf[st] = __builtin_bit_cast(bf16x8, u);
  }
}
template <int DV>
DI void pv_half(const bf16x8 (&pf)[2], f32x16 (&o)[DV / 32], const char* vl, int kb, int r, int h) {
#pragma unroll
  for (int d = 0; d < DV / 32; ++d)
#pragma unroll
    for (int st = 0; st < 2; ++st) {
      const char* vp = vl + (32 * d + r) * 136 + (32 * kb + 16 * st + 4 * h) * 2;
      const u32x2 lo = *(const u32x2*)vp;
      const u32x2 hi = *(const u32x2*)(vp + 16);
      u32x4 u; u.x = lo.x; u.y = lo.y; u.z = hi.x; u.w = hi.y;
      o[d] = MFMA32(__builtin_bit_cast(bf16x8, u), pf[st], o[d]);
    }
}

template <int ABL>
DI void attn_mla_item(const Ctx& p, int item, char* lds) {
  constexpr int DQK = 96, DV = 64, KS = DQK * 2 + 16;
  const int tid = otid(p), lane = tid & 63, w = tid >> 6, r = lane & 31, h = lane >> 5;
  int head, qb, ts0, S;
  if (item < 1024) { head = item >> 6; qb = item & 63; ts0 = T_PROMPT; S = 16384; }
  else { const int it = item - 1024; qb = it & 15; head = (it >> 4) & 15; ts0 = (it >> 8) * 4096; S = 4096; }
  const u16* q = (const u16*)(p.ws + OFF_R2);
  const u16* knope = q + (size_t)T_TOK * 1536;
  const u16* vt = knope + (size_t)T_TOK * 1024;
  const u16* krope = (const u16*)(p.ws + OFF_KROPE);
  u16* o1 = (u16*)(p.ws + OFF_R1);
  const int tq = ts0 + qb * 256 + w * 32 + r;
  bf16x8 qf[DQK / 16];
#pragma unroll
  for (int ks = 0; ks < DQK / 16; ++ks) qf[ks] = *(const bf16x8*)(q + (size_t)tq * 1536 + head * 96 + 16 * ks + 8 * h);
  f32x16 o[DV / 32];
#pragma unroll
  for (int d = 0; d < DV / 32; ++d)
#pragma unroll
    for (int i = 0; i < 16; ++i) o[d][i] = 0.f;
  f32x16 initv;
#pragma unroll
  for (int i = 0; i < 16; ++i) initv[i] = 0.f;
  float l = 0.f;
  u32x4 pk0, pk1, pv0;
  const int c1 = 512 + tid;
  const int krow0 = tid / 12, kch0 = tid - krow0 * 12;
  const int krow1 = c1 / 12, kch1 = c1 - krow1 * 12;
  const int vrow = tid >> 3, vch = tid & 7;
  const int nkt = S >> 6;
  auto prefetch = [&](int kt) {
    const int tk0 = ts0 + kt * 64;
    {
      const u16* src = kch0 < 8 ? knope + (size_t)(tk0 + krow0) * 1024 + head * 64 + kch0 * 8 : krope + (size_t)(tk0 + krow0) * 32 + (kch0 - 8) * 8;
      pk0 = *(const u32x4*)src;
    }
    if (tid < 256) {
      const u16* src = kch1 < 8 ? knope + (size_t)(tk0 + krow1) * 1024 + head * 64 + kch1 * 8 : krope + (size_t)(tk0 + krow1) * 32 + (kch1 - 8) * 8;
      pk1 = *(const u32x4*)src;
    }
    pv0 = *(const u32x4*)(vt + (size_t)(head * 64 + vrow) * T_TOK + tk0 + vch * 8);
  };
  auto stage_at = [&](int boff) {
    char* kl = lds + boff;
    char* vl = kl + 64 * KS;
    *(u32x4*)(kl + krow0 * KS + kch0 * 16) = pk0;
    if (tid < 256) *(u32x4*)(kl + krow1 * KS + kch1 * 16) = pk1;
    lds_st16_as2x8(vl + vrow * 136 + vch * 16, pv0);
  };
  prefetch(0);
  __syncthreads();
  stage_at(0);
  prefetch(1);
  stage_at(ATT_STAGE);
  if (nkt > 2) prefetch(2);
  __syncthreads();
  int cur = 0, nxt = ATT_STAGE, nn = 2 * ATT_STAGE;
  f32x16 s[2];
  qk_scores<DQK>(lds, qf, initv, s, r, h);
#pragma unroll 1
  for (int kt = 0; kt < nkt; ++kt) {
    if (ABL == 2) { __syncthreads(); if (kt + 2 < nkt) stage_at(nn); if (kt + 3 < nkt) prefetch(kt + 3); { const int t = cur; cur = nxt; nxt = nn; nn = t; } continue; }
    const float dl = softmax_pre<DV>(s, o, l, kt == 0);
    if (__any(dl != 0.f)) {
#pragma unroll
      for (int i = 0; i < 16; ++i) initv[i] -= dl;
    }
    f32x16 sn[2];
    qk_scores<DQK>(lds + nxt, qf, initv, sn, r, h);
#pragma unroll
    for (int kb = 0; kb < 2; ++kb) {
      bf16x8 pf[2];
      softmax_exp_half(s[kb], l, pf);
      pv_half<DV>(pf, o, lds + cur + 64 * KS, kb, r, h);
    }
    if (ABL != 1) { if (kt + 2 < nkt) stage_at(nn);
    if (kt + 3 < nkt) prefetch(kt + 3); }
    __syncthreads();
    s[0] = sn[0]; s[1] = sn[1];
    const int t = cur; cur = nxt; nxt = nn; nn = t;
  }
  l += __shfl_xor(l, 32);
  const float inv = 1.f / l;
#pragma unroll
  for (int d = 0; d < DV / 32; ++d) store_tok(o1, 1024, tq, head * 64 + 32 * d + 4 * h, o[d], inv);
}

DI void attn_mla_item2(const Ctx& p, int item, char* lds) {
  constexpr int DQK = 96, DV = 64, KS = DQK * 2 + 16;
  const int tid = otid(p), lane = tid & 63, w = tid >> 6, r = lane & 31, h = lane >> 5;
  int head, qb, ts0, S;
  if (item < 512) { head = item >> 5; qb = item & 31; ts0 = T_PROMPT; S = 16384; }
  else { const int it = item - 512; qb = it & 7; head = (it >> 3) & 15; ts0 = (it >> 7) * 4096; S = 4096; }
  const u16* q = (const u16*)(p.ws + OFF_R2);
  const u16* knope = q + (size_t)T_TOK * 1536;
  const u16* vt = knope + (size_t)T_TOK * 1024;
  const u16* krope = (const u16*)(p.ws + OFF_KROPE);
  u16* o1 = (u16*)(p.ws + OFF_R1);
  const int tq0 = ts0 + qb * 512 + w * 64 + r;
  char* qsl = lds + 49152 + w * 12288 + lane * 16;
  __syncthreads();
  float qn2[2] = {0.f, 0.f};
#pragma unroll
  for (int j = 0; j < 2; ++j)
#pragma unroll
    for (int ks = 0; ks < DQK / 16; ++ks) {
      const u32x4 qv = *(const u32x4*)(q + (size_t)(tq0 + 32 * j) * 1536 + head * 96 + 16 * ks + 8 * h);
      *(u32x4*)(qsl + (j * 6 + ks) * 1024) = qv;
      float a;
      a = bflo(qv.x); qn2[j] += a * a; a = bfhi(qv.x); qn2[j] += a * a; a = bflo(qv.y); qn2[j] += a * a; a = bfhi(qv.y); qn2[j] += a * a;
      a = bflo(qv.z); qn2[j] += a * a; a = bfhi(qv.z); qn2[j] += a * a; a = bflo(qv.w); qn2[j] += a * a; a = bfhi(qv.w); qn2[j] += a * a;
    }
  float ref[2];
  {
    const float kn = __uint_as_float(((const unsigned*)(p.ws + OFF_SCAL))[SC_KMAX1 + head]);
    const float kr = __uint_as_float(((const unsigned*)(p.ws + OFF_SCAL))[SC_KRMAX]);
    const float kmaxn = sqrtf(kn * kn + kr * kr);
#pragma unroll
    for (int j = 0; j < 2; ++j) {
      qn2[j] += __shfl_xor(qn2[j], 32);
      ref[j] = sqrtf(qn2[j]) * kmaxn * 1.02f + 0.5f;
    }
  }
  const bool fixedref = !__any(ref[0] > 60.f || ref[1] > 60.f);
  f32x16 o[2][DV / 32];
  f32x16 initv[2];
#pragma unroll
  for (int j = 0; j < 2; ++j) {
#pragma unroll
    for (int d = 0; d < DV / 32; ++d)
#pragma unroll
      for (int i = 0; i < 16; ++i) o[j][d][i] = 0.f;
#pragma unroll
    for (int i = 0; i < 16; ++i) initv[j][i] = fixedref ? -ref[j] : 0.f;
  }
  float l[2] = {0.f, 0.f};
  u32x4 pk0, pk1, pv0;
  const int c1 = 512 + (tid & 255);
  const int krow0 = tid / 12, kch0 = tid - krow0 * 12;
  const int krow1 = c1 / 12, kch1 = c1 - krow1 * 12;
  const int vrow = tid >> 3, vch = tid & 7;
  const int nkt = S >> 6;
  auto prefetch = [&](int kt) {
    const int tk0 = ts0 + kt * 64;
    {
      const u16* src = kch0 < 8 ? knope + (size_t)(tk0 + krow0) * 1024 + head * 64 + kch0 * 8 : krope + (size_t)(tk0 + krow0) * 32 + (kch0 - 8) * 8;
      pk0 = *(const u32x4*)src;
    }
    {
      const u16* src = kch1 < 8 ? knope + (size_t)(tk0 + krow1) * 1024 + head * 64 + kch1 * 8 : krope + (size_t)(tk0 + krow1) * 32 + (kch1 - 8) * 8;
      pk1 = *(const u32x4*)src;
    }
    pv0 = *(const u32x4*)(vt + (size_t)(head * 64 + vrow) * T_TOK + tk0 + vch * 8);
  };
  auto stage_at = [&](int boff) {
    char* kl = lds + boff;
    char* vl = kl + 64 * KS;
    *(u32x4*)(kl + krow0 * KS + kch0 * 16) = pk0;
    *(u32x4*)(kl + krow1 * KS + kch1 * 16) = pk1;
    lds_st16_as2x8(vl + vrow * 136 + vch * 16, pv0);
  };
  prefetch(0);
  stage_at(0);
  prefetch(1);
  __syncthreads();
#pragma unroll 1
  for (int kt = 0; kt < nkt; ++kt) {
    const char* kl = lds + (kt & 1) * 24576;
    const char* vl = kl + 64 * KS;
    if (kt + 1 < nkt) stage_at(((kt + 1) & 1) * 24576);
    if (kt + 2 < nkt) prefetch(kt + 2);
    f32x16 s[2][2];
#pragma unroll
    for (int kb = 0; kb < 2; ++kb) {
      s[0][kb] = initv[0]; s[1][kb] = initv[1];
#pragma unroll
      for (int ks = 0; ks < DQK / 16; ++ks) {
        const bf16x8 a = *(const bf16x8*)(kl + (32 * kb + r) * KS + (2 * ks + h) * 16);
        const bf16x8 q0 = *(const bf16x8*)(qsl + ks * 1024);
        const bf16x8 q1 = *(const bf16x8*)(qsl + (6 + ks) * 1024);
        s[0][kb] = MFMA32(a, q0, s[0][kb]);
        s[1][kb] = MFMA32(a, q1, s[1][kb]);
      }
    }
    if (!fixedref) {
#pragma unroll
      for (int j = 0; j < 2; ++j) {
        const float dl = softmax_pre<DV>(s[j], o[j], l[j], kt == 0);
        if (__any(dl != 0.f)) {
#pragma unroll
          for (int i = 0; i < 16; ++i) initv[j][i] -= dl;
        }
      }
    }
#pragma unroll
    for (int kb = 0; kb < 2; ++kb) {
      bf16x8 pf0[2], pf1[2];
      softmax_exp_half(s[0][kb], l[0], pf0);
      softmax_exp_half(s[1][kb], l[1], pf1);
#pragma unroll
      for (int d = 0; d < DV / 32; ++d)
#pragma unroll
        for (int st = 0; st < 2; ++st) {
          const char* vp = vl + (32 * d + r) * 136 + (32 * kb + 16 * st + 4 * h) * 2;
          const u32x2 lo = *(const u32x2*)vp;
          const u32x2 hi = *(const u32x2*)(vp + 16);
          u32x4 u; u.x = lo.x; u.y = lo.y; u.z = hi.x; u.w = hi.y;
          const bf16x8 vf = __builtin_bit_cast(bf16x8, u);
          o[0][d] = MFMA32(vf, pf0[st], o[0][d]);
          o[1][d] = MFMA32(vf, pf1[st], o[1][d]);
        }
    }
    __syncthreads();
  }
  int tid2 = otid(p);
  const int lane2 = tid2 & 63, h2 = lane2 >> 5, w2 = tid2 >> 6;
  int item2 = item; asm volatile("" : "+s"(item2));
  int head2, tq2;
  if (item2 < 512) { head2 = item2 >> 5; tq2 = T_PROMPT + (item2 & 31) * 512 + w2 * 64 + (lane2 & 31); }
  else { const int it = item2 - 512; head2 = (it >> 3) & 15; tq2 = (it >> 7) * 4096 + (it & 7) * 512 + w2 * 64 + (lane2 & 31); }
#pragma unroll
  for (int j = 0; j < 2; ++j) {
    float lj = l[j];
    lj += __shfl_xor(lj, 32);
    const float inv = __builtin_amdgcn_rcpf(lj);
#pragma unroll
    for (int d = 0; d < DV / 32; ++d) store_tok(o1, 1024, tq2 + 32 * j, head2 * 64 + 32 * d + 4 * h2, o[j][d], inv);
  }
}

DI void diff_decode(int item, int& hh, int& qb, int& ts0, int& S) {
  int j;
  if (item < 128) { hh = 3; j = item; S = 16384; }
  else if (item < 256) { hh = 2; j = item - 128; S = 16384; }
  else if (item < 768) { hh = 3; j = item - 256; S = 4096; }
  else if (item < 1280) { hh = 2; j = item - 768; S = 4096; }
  else if (item < 1408) { hh = 1; j = item - 1280; S = 16384; }
  else if (item < 1920) { hh = 1; j = item - 1408; S = 4096; }
  else if (item < 2048) { hh = 0; j = item - 1920; S = 16384; }
  else { hh = 0; j = item - 2048; S = 4096; }
  if (S == 16384) { qb = j; ts0 = T_PROMPT; } else { qb = j & 31; ts0 = (j >> 5) * 4096; }
}
DI void attn_diff_item(const Ctx& p, int item, char* lds) {
  constexpr int DQK = 64, DV = 128, KS = DQK * 2 + 16;
  const int tid = otid(p), lane = tid & 63, w = tid >> 6, r = lane & 31, h = lane >> 5;
  const int map = w >> 2, qw = w & 3;
  int hh, qb, ts0, S;
  diff_decode(item, hh, qb, ts0, S);
  const u16* base = (const u16*)(p.ws + OFF_R2);
  const u16* dq = base + 3 * SEG512;
  const u16* dk = base + 4 * SEG512;
  const u16* vtd = base + 5 * SEG512;
  u16* o0 = (u16*)(p.ws + OFF_R1);
  const int qpos = qb * 128 + qw * 32 + r;
  const int tq = ts0 + qpos;
  char* qsl = lds + 3 * ATT_STAGE + 4096 + w * 4096 + lane * 16;
  __syncthreads();
  float qn2 = 0.f;
#pragma unroll
  for (int ks = 0; ks < DQK / 16; ++ks) {
    const u32x4 qv = *(const u32x4*)(dq + (size_t)tq * 512 + (2 * hh + map) * 64 + 16 * ks + 8 * h);
    *(u32x4*)(qsl + ks * 1024) = qv;
    float a;
    a = bflo(qv.x); qn2 += a * a; a = bfhi(qv.x); qn2 += a * a; a = bflo(qv.y); qn2 += a * a; a = bfhi(qv.y); qn2 += a * a;
    a = bflo(qv.z); qn2 += a * a; a = bfhi(qv.z); qn2 += a * a; a = bflo(qv.w); qn2 += a * a; a = bfhi(qv.w); qn2 += a * a;
  }
  qn2 += __shfl_xor(qn2, 32);
  f32x16 o[DV / 32];
#pragma unroll
  for (int d = 0; d < DV / 32; ++d)
#pragma unroll
    for (int i = 0; i < 16; ++i) o[d][i] = 0.f;
  float l = 0.f;
  const float refb = sqrtf(qn2) * __uint_as_float(((const unsigned*)(p.ws + OFF_SCAL))[SC_QKMAX + 8 + 2 * hh + map]) * 1.02f + 0.5f;
  const bool fixedref = !__any(refb > 60.f);
  float ref = fixedref ? refb : 0.f;
  const float slope2 = exp2f(-2.f * (float)(hh + 1)) * LOG2E;
  const float cq = slope2 * (float)qpos;
  const int d0 = 2 * qb;
  const int kd = d0 + (qw >> 1);
  int kt_lo, kt_hi;
  {
    const unsigned* qk = (const unsigned*)(p.ws + OFF_SCAL) + SC_QKMAX;
    const float b0 = __uint_as_float(qk[2 * hh]) * __uint_as_float(qk[8 + 2 * hh]);
    const float b1 = __uint_as_float(qk[2 * hh + 1]) * __uint_as_float(qk[8 + 2 * hh + 1]);
    const float B = fmaxf(b0, b1) * 1.02f + 0.5f;
    const float dskip = fminf((2.f * B + 34.f) / slope2 + 1.f, 1.0e6f);
    const int q_lo = qb * 128, q_hi = q_lo + 127, ds = (int)dskip;
    kt_lo = max(0, (q_lo - 63 - ds) >> 6);
    kt_hi = min((S >> 6) - 1, (q_hi + ds) >> 6);
    kt_lo = min(kt_lo, 2 * qb); kt_hi = max(kt_hi, 2 * qb + 1);
  }
  const int nleft = d0 - kt_lo;
  const int nkt = kt_hi - kt_lo + 1;
  u32x4 pk[2], pv[2];
  const int lrow = tid >> 3, lch = tid & 7;
  auto tile_of = [&](int idx) { return idx < 2 ? d0 + idx : (idx - 2 < nleft ? d0 - 1 - (idx - 2) : idx + kt_lo); };
  const unsigned koff = (unsigned)(((ts0 + lrow) * 512 + 2 * hh * 64 + lch * 8) * 2);
  const unsigned voff = (unsigned)((((hh * 128 + lrow) * T_TOK) + ts0 + lch * 8) * 2);
  const char* dkb = (const char*)dk;
  const char* vtb = (const char*)vtd;
  auto prefetch = [&](int kt) {
    const unsigned ko = koff + (unsigned)kt * (64u * 512u * 2u);
    const unsigned vo = voff + (unsigned)kt * 128u;
    pk[0] = *(const u32x4*)(dkb + ko);
    pk[1] = *(const u32x4*)(dkb + ko + 128u);
    pv[0] = *(const u32x4*)(vtb + vo);
    pv[1] = *(const u32x4*)(vtb + vo + (unsigned)(64 * T_TOK * 2));
  };
  auto stage_at = [&](int boff) {
    char* kl0 = lds + boff;
    char* vl = kl0 + 2 * 64 * KS;
#pragma unroll
    for (int j = 0; j < 2; ++j) *(u32x4*)(kl0 + j * 64 * KS + lrow * KS + lch * 16) = pk[j];
#pragma unroll
    for (int j = 0; j < 2; ++j) lds_st16_as2x8(vl + (lrow + 64 * j) * 136 + lch * 16, pv[j]);
  };
  auto scores = [&](int kt, int boff, f32x16 (&sc)[2]) {
    const int side = kt < kd ? -1 : (kt > kd ? 1 : 0);
    const float I = (float)side * cq - ref;
    const unsigned i_hi = cvt_pk(I, 0.f) & 0xffffu;
    const float ir1 = I - __uint_as_float(i_hi << 16);
    const unsigned i_mid = cvt_pk(ir1, 0.f) & 0xffffu;
    const float ir2 = ir1 - __uint_as_float(i_mid << 16);
    const unsigned i_lo = cvt_pk(ir2, 0.f) & 0xffffu;
    const float T = slope2 * (float)(kt * 64);
    const unsigned t_hi = cvt_pk(T, 0.f) & 0xffffu;
    const float r1 = T - __uint_as_float(t_hi << 16);
    const unsigned t_mid = cvt_pk(r1, 0.f) & 0xffffu;
    const float r2 = r1 - __uint_as_float(t_mid << 16);
    const unsigned t_lo = cvt_pk(r2, 0.f) & 0xffffu;
    const unsigned one = side < 0 ? 0x3F80u : (side > 0 ? 0xBF80u : 0u);
    u32x4 qa;
    qa.x = h == 0 ? (one | (one << 16)) : 0u; qa.y = qa.x; qa.z = h == 0 ? (one | (i_hi << 16)) : 0u; qa.w = h == 0 ? (i_mid | (i_lo << 16)) : 0u;
    const bf16x8 qaug = __builtin_bit_cast(bf16x8, qa);
#pragma unroll
    for (int kb = 0; kb < 2; ++kb) {
      const float xl = slope2 * (float)(32 * kb + r);
      const unsigned l_hi = cvt_pk(xl, 0.f) & 0xffffu;
      const unsigned l_lo = cvt_pk(xl - __uint_as_float(l_hi << 16), 0.f) & 0xffffu;
      u32x4 ka; ka.x = h == 0 ? (l_hi | (l_lo << 16)) : 0u; ka.y = h == 0 ? (t_hi | (t_mid << 16)) : 0u; ka.z = h == 0 ? (t_lo | 0x3F800000u) : 0u; ka.w = h == 0 ? 0x3F803F80u : 0u;
      f32x16 z;
#pragma unroll
      for (int i = 0; i < 16; ++i) z[i] = 0.f;
      sc[kb] = MFMA32(__builtin_bit_cast(bf16x8, ka), qaug, z);
    }
    qk_scores_qlds<DQK>(lds + boff + map * 64 * KS, qsl, sc, r, h);
  };
  prefetch(tile_of(0));
  __syncthreads();
  stage_at(0);
  prefetch(tile_of(1));
  stage_at(ATT_STAGE);
  if (nkt > 2) prefetch(tile_of(2));
  __syncthreads();
  int cur = 0, nxt = ATT_STAGE, nn = 2 * ATT_STAGE;
  f32x16 s[2];
  scores(tile_of(0), 0, s);
#pragma unroll 1
  for (int idx = 0; idx < nkt; ++idx) {
    const int kt = tile_of(idx);
    if (kt == kd) {
#pragma unroll
      for (int kb = 0; kb < 2; ++kb)
#pragma unroll
        for (int i = 0; i < 16; ++i) {
          const int kp = kt * 64 + 32 * kb + (i & 3) + 8 * (i >> 2) + 4 * h;
          s[kb][i] -= slope2 * fabsf((float)(qpos - kp));
        }
    }
    if (!fixedref) ref += softmax_pre<DV>(s, o, l, idx == 0);
    f32x16 sn[2];
    scores(tile_of(min(idx + 1, nkt - 1)), nxt, sn);
#pragma unroll
    for (int kb = 0; kb < 2; ++kb) {
      bf16x8 pf[2];
      softmax_exp_half(s[kb], l, pf);
      pv_half<DV>(pf, o, lds + cur + 2 * 64 * KS, kb, r, h);
    }
    if (idx + 2 < nkt) stage_at(nn);
    if (idx + 3 < nkt) prefetch(tile_of(idx + 3));
    __syncthreads();
    s[0] = sn[0]; s[1] = sn[1];
    const int t = cur; cur = nxt; nxt = nn; nn = t;
  }
  l += __shfl_xor(l, 32);
  const float inv = 1.f / l;
  int tid2 = otid(p);
  const int lane2 = tid2 & 63, qw2 = (tid2 >> 6) & 3, h2 = lane2 >> 5;
  int item2 = item; asm volatile("" : "+s"(item2));
  int hh2, tq2;
  { int qb2, ts02, S2; diff_decode(item2, hh2, qb2, ts02, S2); tq2 = ts02 + qb2 * 128 + qw2 * 32 + (lane2 & 31); }
  float* ex = (float*)lds + qw2 * 4096;
  if (map == 1) {
#pragma unroll
    for (int d = 0; d < DV / 32; ++d)
#pragma unroll
      for (int i = 0; i < 16; ++i) ex[(d * 16 + i) * 64 + lane2] = o[d][i] * inv;
  }
  __syncthreads();
  if (map == 0) {
    const float lam = ((const float*)(p.ws + OFF_SCAL))[0];
    float ss = 0.f;
#pragma unroll
    for (int d = 0; d < DV / 32; ++d)
#pragma unroll
      for (int i = 0; i < 16; ++i) { const float v = o[d][i] * inv - lam * ex[(d * 16 + i) * 64 + lane2]; o[d][i] = v; ss += v * v; }
    ss += __shfl_xor(ss, 32);
    const float rn = rsqrtf(ss * (1.f / 128.f) + EPS) * 0.8f;
    const float* gs = (const float*)(p.ws + OFF_SCAL) + SC_GSUB;
#pragma unroll
    for (int d = 0; d < DV / 32; ++d) {
#pragma unroll
      for (int g = 0; g < 4; ++g) {
        const float4 gv = *(const float4*)(gs + 32 * d + 8 * g + 4 * h2);
        o[d][4 * g] *= gv.x; o[d][4 * g + 1] *= gv.y; o[d][4 * g + 2] *= gv.z; o[d][4 * g + 3] *= gv.w;
      }
      store_tok(o0, 1024, tq2, 512 + hh2 * 128 + 32 * d + 4 * h2, o[d], rn);
    }
  }
}

DI void attn_na_item(const Ctx& p, int item, char* lds) {
  constexpr int DQK = 64, DV = 64, KS = DQK * 2 + 16;
  const int tid = otid(p), lane = tid & 63, w = tid >> 6, r = lane & 31, h = lane >> 5;
  const int quad = item % 320, head = item / 320;
  const int t0 = quad * 256;
  int ts0, rows;
  if (t0 < T_PROMPT) { ts0 = t0 & ~4095; rows = 64; } else { ts0 = T_PROMPT; rows = 256; }
  const int r0 = (t0 - ts0) >> 6;
  const int rw = r0 + (w >> 1);
  const int rs_lo = min(max(r0 - 4, 0), rows - 8);
  const int rs_hi = min(max(r0 + 3 - 4, 0), rows - 8);
  const int rs_w = min(max(rw - 4, 0), rows - 8);
  const int ntile = rs_hi + 8 - rs_lo;
  const u16* base = (const u16*)(p.ws + OFF_R2);
  const u16* qn = base;
  const u16* kn = base + SEG512;
  const u16* vtn = base + 2 * SEG512;
  u16* o0 = (u16*)(p.ws + OFF_R1);
  float* tab = (float*)(lds + 2 * ATT_STAGE) + 64;
  const int qc = (w & 1) * 32 + r;
  const int tq = t0 + w * 32 + r;
  bf16x8 qf[DQK / 16];
#pragma unroll
  for (int ks = 0; ks < DQK / 16; ++ks) qf[ks] = *(const bf16x8*)(qn + (size_t)tq * 512 + head * 64 + 16 * ks + 8 * h);
  f32x16 o[DV / 32];
#pragma unroll
  for (int d = 0; d < DV / 32; ++d)
#pragma unroll
    for (int i = 0; i < 16; ++i) o[d][i] = 0.f;
  f32x16 initv;
#pragma unroll
  for (int i = 0; i < 16; ++i) initv[i] = 0.f;
  float l = 0.f;
  bool first = true;
  u32x4 pk0, pv0;
  const int lrow = tid >> 3, lch = tid & 7;
  auto prefetch = [&](int j) {
    const int tk0 = ts0 + (rs_lo + j) * 64;
    pk0 = *(const u32x4*)(kn + (size_t)(tk0 + lrow) * 512 + head * 64 + lch * 8);
    pv0 = *(const u32x4*)(vtn + (size_t)(head * 64 + lrow) * T_TOK + tk0 + lch * 8);
  };
  auto stage = [&](int b) {
    char* kl = lds + b * ATT_STAGE;
    char* vl = kl + 64 * KS;
    *(u32x4*)(kl + lrow * KS + lch * 16) = pk0;
    lds_st16_as2x8(vl + lrow * 136 + lch * 16, pv0);
  };
  prefetch(0);
  __syncthreads();
  if (tid < 465) tab[tid] = ((const float*)(p.ws + OFF_SCAL))[SC_RPB + head * 465 + tid];
  stage(0);
  prefetch(1);
  __syncthreads();
  const int wc0 = min(max(qc - 8, 0), 48);
  const float* tabq = tab + (15 - qc + 4 * h);
  for (int j = 0; j < ntile; ++j) {
    const char* kl = lds + (j & 1) * ATT_STAGE;
    const char* vl = kl + 64 * KS;
    const int kr = rs_lo + j;
    if (kr >= rs_w && kr < rs_w + 8) {
      f32x16 s[2];
      qk_scores<DQK>(kl, qf, initv, s, r, h);
      const int ridx = kr - rw + 7;
#pragma unroll
      for (int kb = 0; kb < 2; ++kb)
#pragma unroll
        for (int i = 0; i < 16; ++i) {
          const int kc = 32 * kb + (i & 3) + 8 * (i >> 2) + 4 * h;
          const bool ok = (unsigned)(kc - wc0) < 16u;
          const float b = tabq[ridx * 31 + 32 * kb + (i & 3) + 8 * (i >> 2)];
          s[kb][i] = ok ? s[kb][i] + b : -INFINITY;
        }
      {
        const float dl = softmax_pv<DV>(s, o, l, first, vl, r, h);
        if (__any(dl != 0.f)) {
#pragma unroll
          for (int i = 0; i < 16; ++i) initv[i] -= dl;
        }
      }
      first = false;
    }
    if (j + 1 < ntile) stage((j + 1) & 1);
    if (j + 2 < ntile) prefetch(j + 2);
    __syncthreads();
  }
  l += __shfl_xor(l, 32);
  const float inv = 1.f / l;
#pragma unroll
  for (int d = 0; d < DV / 32; ++d) store_tok(o0, 1024, tq, head * 64 + 32 * d + 4 * h, o[d], inv);
}

constexpr int LDS_BYTES = 2 * (256 + 256) * 144;
template <int PH>
DI void run_phase(const Ctx& p, char* lds) {
  const int bid = obid(), nblk = gridDim.x;
  u16* wb = (u16*)p.ws;
  u16* R1 = (u16*)(p.ws + OFF_R1);
  u16* R2 = (u16*)(p.ws + OFF_R2);
  u16* R3 = (u16*)(p.ws + OFF_R3);
  if constexpr (PH == 0) phase_prep(p);
  else if constexpr (PH == 1) gemm_phase(R1, 1024, wb + W0IN, 1024, T_TOK, 3072, 1024, EpiProj0{R2, (unsigned*)(p.ws + OFF_SCAL) + SC_QKMAX}, lds, bid, nblk, p);
  else if constexpr (PH == 2) {
    unsigned* ctr = (unsigned*)(p.ws + OFF_SCAL) + SC_CTR;
    int* nxt_slot = (int*)(lds + LDS_BYTES - 16);
    const int tid0 = otid(p);
    int it = bid;
    while (it < 5120) {
      int nx = 0;
      if (tid0 == 0) nx = (int)atomicAdd(ctr, 1u) + nblk;
      if (it < 2560) attn_diff_item(p, it, lds);
      else attn_na_item(p, it - 2560, lds);
      __syncthreads();
      if (tid0 == 0) *nxt_slot = nx;
      __syncthreads();
      it = *nxt_slot;
    }
  }
  else if constexpr (PH == 3) gemm_phase(R1, 1024, wb + W0OUT, 1024, T_TOK, 1024, 1024, EpiTok{R3, 1024}, lds, bid, nblk, p);
  else if constexpr (PH == 4) phase_res<true, false>(p, R3, (const float*)(p.ws + OFF_SCAL) + SC_G0);
  else if constexpr (PH == 5) gemm_phase(R1, 1024, wb + W0F1, 1024, T_TOK, 5632, 1024, EpiSwiGLU{R2}, lds, bid, nblk, p);
  else if constexpr (PH == 6) gemm_phase(R2, 2816, wb + W0F2, 2816, T_TOK, 1024, 2816, EpiTok{R3, 1024}, lds, bid, nblk, p);
  else if constexpr (PH == 7) phase_res<false, false>(p, R3, (const float*)(p.ws + OFF_SCAL) + SC_G1);
  else if constexpr (PH == 8) gemm_phase(R1, 1024, wb + W1DN, 1024, T_TOK, 768, 1024, EpiTok{R3, 768}, lds, bid, nblk, p);
  else if constexpr (PH == 9) phase_mla_stats(p);
  else if constexpr (PH == 10) {
    gemm_phase(R3, 768, wb + W1UQ, 384, T_TOK, 1536, 384,
                     EpiUQ{R2, (const float*)(p.ws + OFF_RQ), (const float2*)(p.ws + OFF_ROPE)}, lds, bid, nblk, p);
    gemm_phase(R3 + 384, 768, wb + W1UKV, 256, T_TOK, 2048, 256,
                     EpiUKV{R2 + (size_t)T_TOK * 1536, R2 + (size_t)T_TOK * 2560, (const float*)(p.ws + OFF_RKV), (unsigned*)(p.ws + OFF_SCAL) + SC_KMAX1}, lds, bid, nblk, p);
  }
  else if constexpr (PH == 11) { for (int it = bid; it < 2560; it += nblk) {
      int itm = it;
      if (nblk == 256) {
        const int rnd = it >> 8, x = bid & 7, j = bid >> 3;
        itm = rnd < 2 ? (8 * rnd + x) * 32 + j : 512 + (2 * (rnd - 2) + (x >> 2)) * 128 + (4 * (x & 3) + (j >> 3)) * 8 + (j & 7);
      }
      attn_mla_item2(p, itm, lds);
    } }
  else if constexpr (PH == 12) gemm_phase(R1, 1024, wb + W1OUT, 1024, T_TOK, 1024, 1024, EpiTok{R3, 1024}, lds, bid, nblk, p);
  else if constexpr (PH == 13) phase_res<false, false>(p, R3, (const float*)(p.ws + OFF_SCAL) + SC_G2);
  else if constexpr (PH == 14) gemm_phase(R1, 1024, wb + W1F1, 1024, T_TOK, 5632, 1024, EpiSwiGLU{R2}, lds, bid, nblk, p);
  else if constexpr (PH == 15) gemm_phase(R2, 2816, wb + W1F2, 2816, T_TOK, 1024, 2816, EpiTok{R3, 1024}, lds, bid, nblk, p);
  else if constexpr (PH == 16) phase_res<false, true>(p, R3, (const float*)(p.ws + OFF_SCAL) + SC_G3);
}

#if MULTI_LAUNCH
template <int PH>
__global__ void __launch_bounds__(512, 2) k_phase(Params pa) {
  extern __shared__ __attribute__((aligned(16))) char lds[];
  Ctx p;
#pragma unroll
  for (int i = 0; i < 28; ++i) p.in[i] = pa.in[i];
  p.out = pa.out; p.ws = pa.ws;
  p.wv = __builtin_amdgcn_readfirstlane((int)(threadIdx.x >> 6));
  run_phase<PH>(p, lds);
}
template <int PH>
static void launch_all(const Ctx& p, int grid, hipStream_t stream) {
  (void)hipFuncSetAttribute((const void*)k_phase<PH>, hipFuncAttributeMaxDynamicSharedMemorySize, LDS_BYTES);
  hipLaunchKernelGGL(k_phase<PH>, dim3(grid), dim3(512), LDS_BYTES, stream, p);
  if constexpr (PH + 1 < NPHASE) launch_all<PH + 1>(p, grid, stream);
}
#define OCC_KERNEL k_phase<2>
#else
#ifndef PROBE_DUP
#define PROBE_DUP -1
#endif
#ifndef PROBE_DUP2
#define PROBE_DUP2 -1
#endif
DI void grid_barrier(unsigned* ctr, unsigned target, const Ctx& p) {
  __syncthreads();
  if (otid(p) < 64) {
    __builtin_amdgcn_fence(__ATOMIC_RELEASE, "agent");
    if (otid(p) == 0) {
      __hip_atomic_fetch_add(ctr, 1u, __ATOMIC_RELAXED, __HIP_MEMORY_SCOPE_AGENT);
      while (__hip_atomic_load(ctr, __ATOMIC_RELAXED, __HIP_MEMORY_SCOPE_AGENT) < target) __builtin_amdgcn_s_sleep(1);
    }
    __builtin_amdgcn_fence(__ATOMIC_ACQUIRE, "agent");
  }
  __syncthreads();
}
template <int PH>
DI void run_from(const Ctx& p, char* lds) {
  if constexpr (PH == PROBE_DUP || PH == PROBE_DUP2) { run_phase<PH>(p, lds); cg::this_grid().sync(); }
#ifdef PROBE_ABL
  if constexpr (PH == 11) { for (int it = obid(); it < 5120; it += gridDim.x) attn_mla_item<PROBE_ABL>(p, it, lds); cg::this_grid().sync(); }
#endif
  run_phase<PH>(p, lds);
  if constexpr (PH + 1 < NPHASE) {
    if constexpr (PH == 0) cg::this_grid().sync();
    else grid_barrier((unsigned*)(p.ws + OFF_SCAL) + SC_BAR, (unsigned)PH * gridDim.x, p);
    run_from<PH + 1>(p, lds);
  }
}
__global__ void __launch_bounds__(512, 2) mega(Params pa) {
  extern __shared__ __attribute__((aligned(16))) char lds[];
  Ctx p;
#pragma unroll
  for (int i = 0; i < 28; ++i) p.in[i] = pa.in[i];
  p.out = pa.out; p.ws = pa.ws;
  p.wv = __builtin_amdgcn_readfirstlane((int)(threadIdx.x >> 6));
  run_from<0>(p, lds);
}
#define OCC_KERNEL mega
#endif

extern "C" void kernel_launch(void* const* d_in, const int* in_sizes, int n_in, void* d_out, int out_size, void* d_ws, size_t ws_size,
                              hipStream_t stream) {
  static int grid = 0;
  if (grid == 0) {
    if (n_in != 28 || ws_size < WS_NEED) { fprintf(stderr, "kernel_launch: unexpected n_in %d / ws_size %zu (need %zu)\n", n_in, ws_size, (size_t)WS_NEED); grid = -1; return; }
    int dev = 0, cus = 0, per_cu = 0;
    (void)hipGetDevice(&dev);
    (void)hipDeviceGetAttribute(&cus, hipDeviceAttributeMultiprocessorCount, dev);
    (void)hipFuncSetAttribute((const void*)OCC_KERNEL, hipFuncAttributeMaxDynamicSharedMemorySize, LDS_BYTES);
    (void)hipOccupancyMaxActiveBlocksPerMultiprocessor(&per_cu, (const void*)OCC_KERNEL, 512, LDS_BYTES);
    if (per_cu < 1) per_cu = 1;
    if (per_cu > 1) per_cu = 1;
    grid = cus * per_cu;
  }
  if (grid < 0) return;
  Params p{};
  for (int i = 0; i < 28; ++i) p.in[i] = (const float*)d_in[i];
  p.out = (float*)d_out;
  p.ws = (char*)d_ws;
#if MULTI_LAUNCH
  launch_all<0>(p, grid, stream);
#else
  void* args[] = {&p};
  hipError_t e = hipLaunchCooperativeKernel((const void*)mega, dim3(grid), dim3(512), args, LDS_BYTES, stream);
  if (e != hipSuccess) fprintf(stderr, "cooperative launch failed: %s (grid %d)\n", hipGetErrorString(e), grid);
#endif
}
```

```cpp
#include <hip/hip_runtime.h>
#include <hip/hip_cooperative_groups.h>
#include <stdint.h>
#include <cstdio>
namespace cg = cooperative_groups;

#ifndef MULTI_LAUNCH
#define MULTI_LAUNCH 0
#endif

typedef unsigned short u16;
typedef __attribute__((ext_vector_type(8))) short bf16x8;
typedef __attribute__((ext_vector_type(16))) float f32x16;
typedef __attribute__((ext_vector_type(4))) unsigned u32x4;

#define MFMA32(a, b, c) __builtin_amdgcn_mfma_f32_32x32x16_bf16((a), (b), (c), 0, 0, 0)
#define DI __device__ __forceinline__

constexpr int T_TOK = 81920;
constexpr int T_PROMPT = 65536;
constexpr int DM = 1024;
constexpr int DFF = 2816;
constexpr float EPS = 1e-6f;
constexpr float LOG2E = 1.4426950408889634f;
constexpr float QSCALE64 = 0.125f * LOG2E;
constexpr float QSCALE96 = 0.10206207261596577f * LOG2E;
constexpr int NPHASE = 17;

constexpr size_t MiB = (size_t)1 << 20;
constexpr size_t W0IN = 0;
constexpr size_t W0OUT = W0IN + (size_t)3072 * 1024;
constexpr size_t W0F1 = W0OUT + (size_t)1024 * 1024;
constexpr size_t W0F2 = W0F1 + (size_t)5632 * 1024;
constexpr size_t W1DN = W0F2 + (size_t)1024 * 2816;
constexpr size_t W1UQ = W1DN + (size_t)768 * 1024;
constexpr size_t W1UKV = W1UQ + (size_t)1536 * 384;
constexpr size_t W1OUT = W1UKV + (size_t)2048 * 256;
constexpr size_t W1F1 = W1OUT + (size_t)1024 * 1024;
constexpr size_t W1F2 = W1F1 + (size_t)5632 * 1024;
constexpr size_t W_END = W1F2 + (size_t)1024 * 2816;
static_assert(W_END * 2 <= 48 * MiB, "weights region");
constexpr size_t OFF_ROPE = 48 * MiB;
constexpr size_t OFF_RQ = OFF_ROPE + 2 * MiB;
constexpr size_t OFF_RKV = OFF_RQ + MiB / 2;
constexpr size_t OFF_KROPE = OFF_RKV + MiB / 2;
constexpr size_t OFF_SCAL = OFF_KROPE + 5 * MiB;
constexpr int SC_QKMAX = 16, SC_CTR = 32, SC_BAR = 33, SC_KMAX1 = 40, SC_KRMAX = 56;
constexpr int SC_G0 = 1024, SC_G1 = 2048, SC_G2 = 3072, SC_G3 = 4096, SC_GSUB = 5120, SC_RPB = 6144;
constexpr size_t OFF_R1 = 58 * MiB;
constexpr size_t OFF_R3 = OFF_R1 + 160 * MiB;
constexpr size_t OFF_R2 = OFF_R3 + 160 * MiB;
constexpr size_t WS_NEED = OFF_R2 + 560 * MiB;
constexpr size_t SEG512 = (size_t)T_TOK * 512;

struct Params {
  const float* in[28];
  float* out;
  char* ws;
};
struct Ctx {
  const float* in[28];
  float* out;
  char* ws;
  int wv;
};

DI u16 f2bf(float x) { unsigned u = __float_as_uint(x); u += 0x7fffu + ((u >> 16) & 1u); return (u16)(u >> 16); }
DI unsigned pack2(float a, float b) { return (unsigned)f2bf(a) | ((unsigned)f2bf(b) << 16); }
DI float bflo(unsigned v) { return __uint_as_float(v << 16); }
DI float bfhi(unsigned v) { return __uint_as_float(v & 0xffff0000u); }
DI float wave_sum(float v) {
#pragma unroll
  for (int o = 32; o; o >>= 1) v += __shfl_xor(v, o);
  return v;
}
DI int tok_pos(int t) { return t < T_PROMPT ? (t & 4095) : (t - T_PROMPT); }
DI float fexp2(float x) { return __builtin_amdgcn_exp2f(x); }
typedef __attribute__((ext_vector_type(2))) float f32x2;
typedef __attribute__((ext_vector_type(2))) __bf16 bf16x2_t;
typedef __attribute__((ext_vector_type(2))) unsigned u32x2;
typedef __attribute__((ext_vector_type(4))) unsigned u32x4_;
DI unsigned cvt_pk(float a, float b) {
  f32x2 v; v.x = a; v.y = b;
  return __builtin_bit_cast(unsigned, __builtin_convertvector(v, bf16x2_t));
}
DI int otid(const Ctx& p) {
  int wv = p.wv; asm volatile("" : "+s"(wv));
  int t = wv * 64 + (int)__builtin_amdgcn_mbcnt_hi(~0u, __builtin_amdgcn_mbcnt_lo(~0u, 0u));
  asm volatile("" : "+v"(t));
  return t;
}
DI int obid() { int b = blockIdx.x; asm volatile("" : "+s"(b)); return b; }

__device__ const float ROPE_INV[16] = {1.0f, 0.5623413324356079f, 0.3162277638912201f, 0.17782793939113617f, 0.10000000149011612f, 0.05623413249850273f, 0.03162277489900589f, 0.017782794311642647f, 0.009999999776482582f, 0.005623413249850273f, 0.003162277629598975f, 0.0017782794311642647f, 0.0010000000474974513f, 0.000562341301701963f, 0.0003162277571391314f, 0.00017782794020604342f};

DI void wconv(const float* __restrict__ W, const float* __restrict__ g, u16* __restrict__ dst, int K, int N, int rowsOut, int perm, int gtid, int gthreads) {
  const int kc = K >> 3;
  const long total = (long)rowsOut * kc;
  for (long c = gtid; c < total; c += gthreads) {
    const int n = (int)(c % rowsOut);
    const int k0 = (int)(c / rowsOut) * 8;
    int sc;
    if (perm == 1) { const int blk = n >> 6, w = n & 63; const int j = blk * 32 + (w & 31); sc = (w < 32) ? j : DFF + j; }
    else if (perm == 2) { const int hd = (n & 1023) >> 6, d = n & 63; sc = hd * 128 + (n >= 1024 ? 64 : 0) + d; }
    else sc = n;
    uint4 o = make_uint4(0, 0, 0, 0);
    if (sc < N) {
      float v[8];
#pragma unroll
      for (int i = 0; i < 8; ++i) { float x = W[(size_t)(k0 + i) * N + sc]; if (g) x *= g[k0 + i]; v[i] = x; }
      o.x = pack2(v[0], v[1]); o.y = pack2(v[2], v[3]); o.z = pack2(v[4], v[5]); o.w = pack2(v[6], v[7]);
    }
    *(uint4*)(dst + (size_t)n * K + k0) = o;
  }
}

DI void phase_prep(const Ctx& p) {
  const int gtid = obid() * 512 + otid(p), gthreads = gridDim.x * 512;
  u16* wb = (u16*)p.ws;
  wconv(p.in[3], p.in[2], wb + W0IN, 1024, 3072, 3072, 0, gtid, gthreads);
  wconv(p.in[10], nullptr, wb + W0OUT, 1024, 1024, 1024, 0, gtid, gthreads);
  wconv(p.in[13], p.in[12], wb + W0F1, 1024, 5632, 5632, 1, gtid, gthreads);
  wconv(p.in[14], nullptr, wb + W0F2, 2816, 1024, 1024, 0, gtid, gthreads);
  wconv(p.in[17], p.in[16], wb + W1DN, 1024, 672, 768, 0, gtid, gthreads);
  wconv(p.in[20], p.in[18], wb + W1UQ, 384, 1536, 1536, 0, gtid, gthreads);
  wconv(p.in[21], p.in[19], wb + W1UKV, 256, 2048, 2048, 2, gtid, gthreads);
  wconv(p.in[22], nullptr, wb + W1OUT, 1024, 1024, 1024, 0, gtid, gthreads);
  wconv(p.in[25], p.in[24], wb + W1F1, 1024, 5632, 5632, 1, gtid, gthreads);
  wconv(p.in[26], nullptr, wb + W1F2, 2816, 1024, 1024, 0, gtid, gthreads);
  float2* rope = (float2*)(p.ws + OFF_ROPE);
  for (int idx = gtid; idx < 16384 * 16; idx += gthreads) {
    const int pos = idx >> 4, i = idx & 15;
    const float ang = (float)pos * ROPE_INV[i];
    double rev = (double)ang * 0.15915494309189535;
    rev -= rint(rev);
    const float rf = (float)rev;
    rope[idx] = make_float2(__builtin_amdgcn_cosf(rf), __builtin_amdgcn_sinf(rf));
  }
  if (gtid == 0) {
    float s1 = 0.f, s2 = 0.f;
    for (int i = 0; i < 64; ++i) { s1 += p.in[5][i] * p.in[6][i]; s2 += p.in[7][i] * p.in[8][i]; }
    float* sc = (float*)(p.ws + OFF_SCAL);
    sc[0] = __expf(s1) - __expf(s2) + 0.2f;
    for (int i = 0; i < 48; ++i) ((unsigned*)sc)[SC_QKMAX + i] = 0u;
  }
  {
    float* sc = (float*)(p.ws + OFF_SCAL);
    for (int i = gtid; i < 1024; i += gthreads) { sc[SC_G0 + i] = p.in[11][i]; sc[SC_G1 + i] = p.in[15][i]; sc[SC_G2 + i] = p.in[23][i]; sc[SC_G3 + i] = p.in[27][i]; }
    for (int i = gtid; i < 128; i += gthreads) sc[SC_GSUB + i] = p.in[9][i];
    for (int i = gtid; i < 8 * 465; i += gthreads) sc[SC_RPB + i] = p.in[4][i] * LOG2E;
  }
  const int tid_ = otid(p);
  const int lane = tid_ & 63;
  const int gw = obid() * 8 + (tid_ >> 6), nw = gridDim.x * 8;
  u16* hb = (u16*)(p.ws + OFF_R1);
  for (int row = gw; row < T_TOK; row += nw) {
    const float* xr = row < T_PROMPT ? p.in[0] + (size_t)row * DM : p.in[1] + (size_t)(row - T_PROMPT) * DM;
    float4 v[4];
    float ss = 0.f;
#pragma unroll
    for (int j = 0; j < 4; ++j) { v[j] = ((const float4*)xr)[lane + 64 * j]; ss += v[j].x * v[j].x + v[j].y * v[j].y + v[j].z * v[j].z + v[j].w * v[j].w; }
    ss = wave_sum(ss);
    const float r = rsqrtf(ss * (1.f / DM) + EPS);
#pragma unroll
    for (int j = 0; j < 4; ++j) {
      uint2 o; o.x = pack2(v[j].x * r, v[j].y * r); o.y = pack2(v[j].z * r, v[j].w * r);
      ((uint2*)(hb + (size_t)row * DM))[lane + 64 * j] = o;
    }
  }
}

template <bool FIRST, bool LAST>
DI void phase_res(const Ctx& p, const u16* __restrict__ mbuf, const float* __restrict__ g) {
  const int tid_ = otid(p);
  const int lane = tid_ & 63;
  const int gw = obid() * 8 + (tid_ >> 6), nw = gridDim.x * 8;
  u16* hb = (u16*)(p.ws + OFF_R1);
  float4 gv[4];
#pragma unroll
  for (int j = 0; j < 4; ++j) gv[j] = ((const float4*)g)[lane + 64 * j];
  for (int row0 = gw; row0 < T_TOK; row0 += 2 * nw) {
    float4 xv[2][4], mv[2][4];
    float ss[2] = {0.f, 0.f};
    bool act[2];
#pragma unroll
    for (int t = 0; t < 2; ++t) {
      const int row = row0 + t * nw;
      act[t] = row < T_TOK;
      const int rr = act[t] ? row : row0;
      const float* xr;
      if (FIRST) xr = rr < T_PROMPT ? p.in[0] + (size_t)rr * DM : p.in[1] + (size_t)(rr - T_PROMPT) * DM;
      else xr = p.out + (size_t)rr * DM;
#pragma unroll
      for (int j = 0; j < 4; ++j) {
        const uint2 u = ((const uint2*)(mbuf + (size_t)rr * DM))[lane + 64 * j];
        mv[t][j] = make_float4(bflo(u.x), bfhi(u.x), bflo(u.y), bfhi(u.y));
        xv[t][j] = ((const float4*)xr)[lane + 64 * j];
      }
    }
#pragma unroll
    for (int t = 0; t < 2; ++t) {
#pragma unroll
      for (int j = 0; j < 4; ++j) ss[t] += mv[t][j].x * mv[t][j].x + mv[t][j].y * mv[t][j].y + mv[t][j].z * mv[t][j].z + mv[t][j].w * mv[t][j].w;
      ss[t] = wave_sum(ss[t]);
    }
#pragma unroll
    for (int t = 0; t < 2; ++t) {
      if (!act[t]) continue;
      const int row = row0 + t * nw;
      const float rm = rsqrtf(ss[t] * (1.f / DM) + EPS);
      float s2 = 0.f;
#pragma unroll
      for (int j = 0; j < 4; ++j) {
        xv[t][j].x += mv[t][j].x * rm * gv[j].x; xv[t][j].y += mv[t][j].y * rm * gv[j].y;
        xv[t][j].z += mv[t][j].z * rm * gv[j].z; xv[t][j].w += mv[t][j].w * rm * gv[j].w;
        s2 += xv[t][j].x * xv[t][j].x + xv[t][j].y * xv[t][j].y + xv[t][j].z * xv[t][j].z + xv[t][j].w * xv[t][j].w;
        ((float4*)(p.out + (size_t)row * DM))[lane + 64 * j] = xv[t][j];
      }
      if (!LAST) {
        s2 = wave_sum(s2);
        const float r2 = rsqrtf(s2 * (1.f / DM) + EPS);
#pragma unroll
        for (int j = 0; j < 4; ++j) {
          uint2 o; o.x = pack2(xv[t][j].x * r2, xv[t][j].y * r2); o.y = pack2(xv[t][j].z * r2, xv[t][j].w * r2);
          ((uint2*)(hb + (size_t)row * DM))[lane + 64 * j] = o;
        }
      }
    }
  }
}

DI void phase_mla_stats(const Ctx& p) {
  const int tid_ = otid(p);
  const int lane = tid_ & 63;
  const int gw = obid() * 8 + (tid_ >> 6), nw = gridDim.x * 8;
  const u16* c = (const u16*)(p.ws + OFF_R3);
  float* rq = (float*)(p.ws + OFF_RQ);
  float* rkv = (float*)(p.ws + OFF_RKV);
  u16* krope = (u16*)(p.ws + OFF_KROPE);
  const float2* rope = (const float2*)(p.ws + OFF_ROPE);
  float krmax2 = 0.f;
  for (int row = gw; row < T_TOK; row += nw) {
    const u16* cr = c + (size_t)row * 768;
    const uint4 u0 = ((const uint4*)cr)[lane];
    float s0 = 0.f;
    { float a;
      a = bflo(u0.x); s0 += a * a; a = bfhi(u0.x); s0 += a * a; a = bflo(u0.y); s0 += a * a; a = bfhi(u0.y); s0 += a * a;
      a = bflo(u0.z); s0 += a * a; a = bfhi(u0.z); s0 += a * a; a = bflo(u0.w); s0 += a * a; a = bfhi(u0.w); s0 += a * a; }
    float s1 = 0.f;
    if (lane < 16) {
      const uint4 u1 = ((const uint4*)cr)[64 + lane];
      float a;
      a = bflo(u1.x); s1 += a * a; a = bfhi(u1.x); s1 += a * a; a = bflo(u1.y); s1 += a * a; a = bfhi(u1.y); s1 += a * a;
      a = bflo(u1.z); s1 += a * a; a = bfhi(u1.z); s1 += a * a; a = bflo(u1.w); s1 += a * a; a = bfhi(u1.w); s1 += a * a;
    }
    const float sq = wave_sum(lane < 48 ? s0 : 0.f);
    const float skv = wave_sum((lane >= 48 ? s0 : 0.f) + s1);
    if (lane == 0) {
      rq[row] = rsqrtf(sq * (1.f / 384.f) + EPS);
      rkv[row] = rsqrtf(skv * (1.f / 256.f) + EPS);
    }
    float kr2 = 0.f;
    if (lane < 16) {
      const float x1 = __uint_as_float((unsigned)cr[640 + lane] << 16);
      const float x2 = __uint_as_float((unsigned)cr[656 + lane] << 16);
      const float2 cs = rope[tok_pos(row) * 16 + lane];
      const float o1 = x1 * cs.x - x2 * cs.y, o2 = x2 * cs.x + x1 * cs.y;
      krope[(size_t)row * 32 + lane] = f2bf(o1);
      krope[(size_t)row * 32 + 16 + lane] = f2bf(o2);
      kr2 = o1 * o1 + o2 * o2;
    }
    krmax2 = fmaxf(krmax2, wave_sum(kr2));
  }
  if (lane == 0) atomicMax((unsigned*)(p.ws + OFF_SCAL) + SC_KRMAX, __float_as_uint(sqrtf(krmax2)));
}

DI void store_tok(u16* out, int ldo, int m, int nbase, const f32x16& v, float sc) {
  u16* q = out + (size_t)m * ldo + nbase;
#pragma unroll
  for (int g = 0; g < 4; ++g) {
    uint2 u; u.x = pack2(v[4 * g] * sc, v[4 * g + 1] * sc); u.y = pack2(v[4 * g + 2] * sc, v[4 * g + 3] * sc);
    *(uint2*)(q + 8 * g) = u;
  }
}
DI void store_tr(u16* outT, size_t ldt, int n, int mbase, const f32x16& v, const float* __restrict__ rs) {
  u16* q = outT + (size_t)n * ldt + mbase;
#pragma unroll
  for (int g = 0; g < 4; ++g) {
    float4 s = make_float4(1.f, 1.f, 1.f, 1.f);
    if (rs) s = *(const float4*)(rs + mbase + 8 * g);
    uint2 u; u.x = pack2(v[4 * g] * s.x, v[4 * g + 1] * s.y); u.y = pack2(v[4 * g + 2] * s.z, v[4 * g + 3] * s.w);
    *(uint2*)(q + 8 * g) = u;
  }
}

DI void store_tok_u(u16* ub, unsigned loff, const f32x16& v, float sc) {
  char* q = (char*)ub;
  const unsigned hoff = (loff & 8u) << 1;
  const unsigned lbase = loff & ~8u;
#pragma unroll
  for (int pi = 0; pi < 2; ++pi) {
    const int g0 = 2 * pi, g1 = 2 * pi + 1;
    const unsigned a0 = cvt_pk(v[4 * g0] * sc, v[4 * g0 + 1] * sc), a1 = cvt_pk(v[4 * g0 + 2] * sc, v[4 * g0 + 3] * sc);
    const unsigned b0 = cvt_pk(v[4 * g1] * sc, v[4 * g1 + 1] * sc), b1 = cvt_pk(v[4 * g1 + 2] * sc, v[4 * g1 + 3] * sc);
    const u32x2 s0 = __builtin_amdgcn_permlane32_swap(a0, b0, false, false);
    const u32x2 s1 = __builtin_amdgcn_permlane32_swap(a1, b1, false, false);
    u32x4 u; u.x = s0.x; u.y = s1.x; u.z = s0.y; u.w = s1.y;
    *(u32x4*)(q + lbase + hoff + 32 * pi) = u;
  }
}
DI void store_tr_u(u16* ub, unsigned loff, const f32x16& v, const float* __restrict__ rs) {
  char* q = (char*)ub;
  const unsigned hoff = (loff & 8u) << 1;
  const unsigned lbase = loff & ~8u;
#pragma unroll
  for (int pi = 0; pi < 2; ++pi) {
    const int g0 = 2 * pi, g1 = 2 * pi + 1;
    float4 sa = make_float4(1.f, 1.f, 1.f, 1.f), sb = sa;
    if (rs) { sa = *(const float4*)(rs + 8 * g0); sb = *(const float4*)(rs + 8 * g1); }
    const unsigned a0 = cvt_pk(v[4 * g0] * sa.x, v[4 * g0 + 1] * sa.y), a1 = cvt_pk(v[4 * g0 + 2] * sa.z, v[4 * g0 + 3] * sa.w);
    const unsigned b0 = cvt_pk(v[4 * g1] * sb.x, v[4 * g1 + 1] * sb.y), b1 = cvt_pk(v[4 * g1 + 2] * sb.z, v[4 * g1 + 3] * sb.w);
    const u32x2 s0 = __builtin_amdgcn_permlane32_swap(a0, b0, false, false);
    const u32x2 s1 = __builtin_amdgcn_permlane32_swap(a1, b1, false, false);
    u32x4 u; u.x = s0.x; u.y = s1.x; u.z = s0.y; u.w = s1.y;
    *(u32x4*)(q + lbase + hoff + 32 * pi) = u;
  }
}

struct EpiTok {
  u16* out; int ldo;
  static constexpr int SWAPMODE = 1;
  DI bool swap(int) const { return true; }
  template <int WMB, int WNB>
  DI void store(int m0w, int n0w, f32x16 (&acc)[WMB][WNB], int r, int h, bool) const {
#pragma unroll
    for (int mb = 0; mb < WMB; ++mb)
#pragma unroll
      for (int nb = 0; nb < WNB; ++nb) store_tok_u(out + (size_t)(m0w + mb * 32) * ldo + n0w + nb * 32, (unsigned)((r * ldo + 4 * h) * 2), acc[mb][nb], 1.f);
  }
};

struct EpiProj0 {
  u16* base; unsigned* qkmax;
  static constexpr int SWAPMODE = 2;
  DI bool swap(int n0) const { const int reg = n0 >> 9; return !(reg == 2 || reg == 5); }
  template <int WMB, int WNB>
  DI void store(int m0w, int n0w, f32x16 (&acc)[WMB][WNB], int r, int h, bool) const {
    const int reg = n0w >> 9, nl = n0w & 511;
    u16* buf = base + (size_t)reg * SEG512;
    const float sc = (reg == 0 || reg == 3) ? QSCALE64 : 1.f;
#pragma unroll
    for (int mb = 0; mb < WMB; ++mb)
#pragma unroll
      for (int nb = 0; nb < WNB; ++nb) store_tok_u(buf + (size_t)(m0w + mb * 32) * 512 + nl + nb * 32, (unsigned)((r * 512 + 4 * h) * 2), acc[mb][nb], sc);
    __builtin_amdgcn_sched_barrier(0);
    if (reg == 3 || reg == 4) {
      static_assert(WNB == 2, "one head per wave tile");
      float mxn = 0.f;
#pragma unroll
      for (int mb = 0; mb < WMB; ++mb) {
        float ss = 0.f;
#pragma unroll
        for (int nb = 0; nb < WNB; ++nb)
#pragma unroll
          for (int i = 0; i < 16; ++i) { const float v = acc[mb][nb][i]; ss += v * v; }
        { const u32x2 sw = __builtin_amdgcn_permlane32_swap(__float_as_uint(ss), __float_as_uint(ss), false, false); ss = __uint_as_float(sw.x) + __uint_as_float(sw.y); }
        mxn = fmaxf(mxn, ss);
      }
      mxn = fmaxf(mxn, __int_as_float(__builtin_amdgcn_ds_swizzle(__float_as_int(mxn), (16 << 10) | 0x1f)));
      mxn = fmaxf(mxn, __int_as_float(__builtin_amdgcn_ds_swizzle(__float_as_int(mxn), (8 << 10) | 0x1f)));
      mxn = fmaxf(mxn, __int_as_float(__builtin_amdgcn_ds_swizzle(__float_as_int(mxn), (4 << 10) | 0x1f)));
      mxn = fmaxf(mxn, __int_as_float(__builtin_amdgcn_ds_swizzle(__float_as_int(mxn), (2 << 10) | 0x1f)));
      mxn = fmaxf(mxn, __int_as_float(__builtin_amdgcn_ds_swizzle(__float_as_int(mxn), (1 << 10) | 0x1f)));
      if (r == 0 && h == 0) atomicMax(qkmax + (reg - 3) * 8 + (nl >> 6), __float_as_uint(sqrtf(mxn) * sc));
    }
  }
  template <int WMB, int WNB>
  DI void store_t(int n0w, int m0w, f32x16 (&acc)[WMB][WNB], int r, int h) const {
    const int reg = n0w >> 9, nl = n0w & 511;
    u16* buf = base + (size_t)reg * SEG512;
#pragma unroll
    for (int mb = 0; mb < WMB; ++mb)
#pragma unroll
      for (int nb = 0; nb < WNB; ++nb) store_tr_u(buf + (size_t)(nl + mb * 32) * T_TOK + m0w + nb * 32, (unsigned)((r * T_TOK + 4 * h) * 2), acc[mb][nb], nullptr);
  }
};

struct EpiSwiGLU {
  u16* act;
  static constexpr int SWAPMODE = 1;
  DI bool swap(int) const { return true; }
  template <int WMB, int WNB>
  DI void store(int m0w, int n0w, f32x16 (&acc)[WMB][WNB], int r, int h, bool) const {
    static_assert(WNB == 2, "swiglu epilogue needs a 64-wide wave tile");
#pragma unroll
    for (int mb = 0; mb < WMB; ++mb) {
      char* q = (char*)(act + (size_t)(m0w + mb * 32) * DFF + (n0w >> 1)) + (unsigned)((r * DFF) * 2) + 16 * h;
#pragma unroll
      for (int pi = 0; pi < 2; ++pi) {
        unsigned pk[2][2];
#pragma unroll
        for (int gg = 0; gg < 2; ++gg) {
          const int g = 2 * pi + gg;
          float y[4];
#pragma unroll
          for (int e = 0; e < 4; ++e) {
            const float gt = acc[mb][0][4 * g + e], up = acc[mb][1][4 * g + e];
            y[e] = gt * __builtin_amdgcn_rcpf(1.f + fexp2(-LOG2E * gt)) * up;
          }
          pk[gg][0] = cvt_pk(y[0], y[1]); pk[gg][1] = cvt_pk(y[2], y[3]);
        }
        const u32x2 s0 = __builtin_amdgcn_permlane32_swap(pk[0][0], pk[1][0], false, false);
        const u32x2 s1 = __builtin_amdgcn_permlane32_swap(pk[0][1], pk[1][1], false, false);
        u32x4 u; u.x = s0.x; u.y = s1.x; u.z = s0.y; u.w = s1.y;
        *(u32x4*)(q + 32 * pi) = u;
      }
      __builtin_amdgcn_sched_barrier(0);
    }
  }
};

struct EpiUQ {
  u16* q; const float* rq; const float2* rope;
  static constexpr int SWAPMODE = 1;
  DI bool swap(int) const { return true; }
  template <int WMB, int WNB>
  DI void store(int m0w, int n0w, f32x16 (&acc)[WMB][WNB], int r, int h, bool) const {
#pragma unroll
    for (int mb = 0; mb < WMB; ++mb) {
      const int m = m0w + mb * 32 + r;
      const float sc = rq[m] * QSCALE96;
      const int pos = tok_pos(m);
#pragma unroll
      for (int nb = 0; nb < WNB; ++nb) {
        const int n0b = n0w + nb * 32;
        f32x16 v = acc[mb][nb];
#pragma unroll
        for (int i = 0; i < 16; ++i) v[i] *= sc;
        if (((n0b >> 5) % 3) == 2) {
#pragma unroll
          for (int i = 0; i < 8; ++i) {
            const int f = (i & 3) + 8 * (i >> 2) + 4 * h;
            const float2 cs = rope[pos * 16 + f];
            const float x1 = v[i], x2 = v[i + 8];
            v[i] = x1 * cs.x - x2 * cs.y;
            v[i + 8] = x2 * cs.x + x1 * cs.y;
          }
        }
        store_tok_u(q + (size_t)(m0w + mb * 32) * 1536 + n0b, (unsigned)((r * 1536 + 4 * h) * 2), v, 1.f);
        __builtin_amdgcn_sched_barrier(0);
      }
    }
  }
};

struct EpiUKV {
  u16* knope; u16* vt; const float* rkv; unsigned* kmax;
  static constexpr int SWAPMODE = 2;
  DI bool swap(int n0) const { return n0 < 1024; }
  template <int WMB, int WNB>
  DI void store(int m0w, int n0w, f32x16 (&acc)[WMB][WNB], int r, int h, bool) const {
#pragma unroll
    for (int mb = 0; mb < WMB; ++mb) {
      const int m = m0w + mb * 32 + r;
      const float sc = rkv[m];
#pragma unroll
      for (int nb = 0; nb < WNB; ++nb) store_tok_u(knope + (size_t)(m0w + mb * 32) * 1024 + n0w + nb * 32, (unsigned)((r * 1024 + 4 * h) * 2), acc[mb][nb], sc);
    }
    __builtin_amdgcn_sched_barrier(0);
    static_assert(WNB == 2, "one head per wave tile");
    float mxn = 0.f;
#pragma unroll
    for (int mb = 0; mb < WMB; ++mb) {
      float ss = 0.f;
#pragma unroll
      for (int nb = 0; nb < WNB; ++nb)
#pragma unroll
        for (int i = 0; i < 16; ++i) { const float v = acc[mb][nb][i]; ss += v * v; }
      { const u32x2 sw = __builtin_amdgcn_permlane32_swap(__float_as_uint(ss), __float_as_uint(ss), false, false); ss = __uint_as_float(sw.x) + __uint_as_float(sw.y); }
      const float sc = rkv[m0w + mb * 32 + r];
      mxn = fmaxf(mxn, ss * sc * sc);
    }
    mxn = fmaxf(mxn, __int_as_float(__builtin_amdgcn_ds_swizzle(__float_as_int(mxn), (16 << 10) | 0x1f)));
    mxn = fmaxf(mxn, __int_as_float(__builtin_amdgcn_ds_swizzle(__float_as_int(mxn), (8 << 10) | 0x1f)));
    mxn = fmaxf(mxn, __int_as_float(__builtin_amdgcn_ds_swizzle(__float_as_int(mxn), (4 << 10) | 0x1f)));
    mxn = fmaxf(mxn, __int_as_float(__builtin_amdgcn_ds_swizzle(__float_as_int(mxn), (2 << 10) | 0x1f)));
    mxn = fmaxf(mxn, __int_as_float(__builtin_amdgcn_ds_swizzle(__float_as_int(mxn), (1 << 10) | 0x1f)));
    if (r == 0 && h == 0) atomicMax(kmax + (n0w >> 6), __float_as_uint(sqrtf(mxn)));
  }
  template <int WMB, int WNB>
  DI void store_t(int n0w, int m0w, f32x16 (&acc)[WMB][WNB], int r, int h) const {
#pragma unroll
    for (int mb = 0; mb < WMB; ++mb)
#pragma unroll
      for (int nb = 0; nb < WNB; ++nb) store_tr_u(vt + (size_t)(n0w - 1024 + mb * 32) * T_TOK + m0w + nb * 32, (unsigned)((r * T_TOK + 4 * h) * 2), acc[mb][nb], rkv + m0w + nb * 32 + 4 * h);
  }
};

template <bool SWAP, int WMB, int WNB>
DI void gemm_compute(const char* la, const char* lb, f32x16 (&acc)[WMB][WNB], int wm, int wn, int r, int h) {
#pragma unroll
  for (int ks = 0; ks < 4; ++ks) {
    bf16x8 af[WMB], bfr[WNB];
#pragma unroll
    for (int mb = 0; mb < WMB; ++mb) af[mb] = *(const bf16x8*)(la + (wm * 32 * WMB + mb * 32 + r) * 144 + (ks * 2 + h) * 16);
#pragma unroll
    for (int nb = 0; nb < WNB; ++nb) bfr[nb] = *(const bf16x8*)(lb + (wn * 32 * WNB + nb * 32 + r) * 144 + (ks * 2 + h) * 16);
#pragma unroll
    for (int mb = 0; mb < WMB; ++mb)
#pragma unroll
      for (int nb = 0; nb < WNB; ++nb) {
        if (SWAP) acc[mb][nb] = MFMA32(bfr[nb], af[mb], acc[mb][nb]);
        else acc[mb][nb] = MFMA32(af[mb], bfr[nb], acc[mb][nb]);
      }
  }
}

struct TileDesc { bool valid; bool normal; int m0, n0, ldp, ldq; unsigned po, qo; const char* P; const char* Q; };

template <class Epi>
DI void gemm_phase(const u16* __restrict__ A, int lda, const u16* __restrict__ Bt, int ldb, int M, int N, int K, const Epi epi, char* lds, int bid, int nblk, const Ctx& p) {
  constexpr int WMB = 4, WNB = 2;
  constexpr int TM = 256, TN = 256;
  constexpr int STAGE = (TM + TN) * 144;
  const int tid = otid(p), lane = tid & 63, w = __builtin_amdgcn_readfirstlane(tid >> 6), wm = w >> 2, wn = w & 3, r = lane & 31, h = lane >> 5;
  const int lrow = tid >> 3, lch = tid & 7;
  const int NT = N / TN, MT = M / TM, tiles = MT * NT, nk = K >> 6;
  const int rounds = (tiles + nblk - 1) / nblk;
  auto desc = [&](int rnd) {
    TileDesc d;
    int tile = rnd * nblk + bid;
    if (nblk == 256) tile = rnd * 256 + (bid & 7) * 32 + (bid >> 3);
    d.valid = rnd < rounds && tile < tiles;
    const int grp = tile / (8 * NT), within = tile - grp * (8 * NT);
    const int nt = within >> 3, mt = grp * 8 + (within & 7);
    d.m0 = mt * TM; d.n0 = nt * TN;
    d.normal = true;
    if constexpr (Epi::SWAPMODE == 2) d.normal = epi.swap(d.n0);
    const char* Ab = (const char*)A + (size_t)d.m0 * lda * 2;
    const char* Bb = (const char*)Bt + (size_t)d.n0 * ldb * 2;
    const unsigned aoff = (unsigned)(lrow * lda * 2 + lch * 16), boff = (unsigned)(lrow * ldb * 2 + lch * 16);
    d.P = d.normal ? Ab : Bb; d.Q = d.normal ? Bb : Ab;
    d.po = d.normal ? aoff : boff; d.qo = d.normal ? boff : aoff;
    d.ldp = d.normal ? lda : ldb; d.ldq = d.normal ? ldb : lda;
    return d;
  };
  u32x4 pa[4], pb[4];
  auto issue = [&](const TileDesc& d, int kt) {
    const char* Pk = d.P + (size_t)kt * 128; asm volatile("" : "+s"(Pk));
    const char* Qk = d.Q + (size_t)kt * 128; asm volatile("" : "+s"(Qk));
#pragma unroll
    for (int j = 0; j < 4; ++j) pa[j] = *(const u32x4*)(Pk + (size_t)j * 128 * d.ldp + d.po);
#pragma unroll
    for (int j = 0; j < 4; ++j) pb[j] = *(const u32x4*)(Qk + (size_t)j * 128 * d.ldq + d.qo);
  };
  auto write_stage = [&](int b) {
    char* wa = lds + b * STAGE;
    char* wb = wa + TM * 144;
#pragma unroll
    for (int j = 0; j < 4; ++j) *(u32x4*)(wa + (lrow + 64 * j) * 144 + lch * 16) = pa[j];
#pragma unroll
    for (int j = 0; j < 4; ++j) *(u32x4*)(wb + (lrow + 64 * j) * 144 + lch * 16) = pb[j];
  };
  TileDesc cur = desc(0);
  if (!cur.valid) return;
  issue(cur, 0);
  for (int rnd = 0;; ++rnd) {
    f32x16 acc[WMB][WNB];
#pragma unroll
    for (int mb = 0; mb < WMB; ++mb)
#pragma unroll
      for (int nb = 0; nb < WNB; ++nb)
#pragma unroll
        for (int i = 0; i < 16; ++i) acc[mb][nb][i] = 0.f;
    write_stage(0);
    if (nk > 1) issue(cur, 1);
    __syncthreads();
    if (w < 4) {
      for (int kt = 0; kt < nk; ++kt) {
        const char* la = lds + (kt & 1) * STAGE;
        if (kt + 1 < nk) write_stage((kt + 1) & 1);
        if (kt + 2 < nk) issue(cur, kt + 2);
        __builtin_amdgcn_sched_barrier(0);
        gemm_compute<true, WMB, WNB>(la, la + TM * 144, acc, wm, wn, r, h);
        __syncthreads();
      }
    } else {
      for (int kt = 0; kt < nk; ++kt) {
        const char* la = lds + (kt & 1) * STAGE;
        gemm_compute<true, WMB, WNB>(la, la + TM * 144, acc, wm, wn, r, h);
        __builtin_amdgcn_sched_barrier(0);
        if (kt + 1 < nk) write_stage((kt + 1) & 1);
        if (kt + 2 < nk) issue(cur, kt + 2);
        __syncthreads();
      }
    }
    const TileDesc nxt = desc(rnd + 1);
    if (nxt.valid) issue(nxt, 0);
    __builtin_amdgcn_sched_barrier(0);
    int m0 = cur.m0, n0 = cur.n0;
    asm volatile("" : "+s"(m0), "+s"(n0));
    int r2 = r, h2 = h, wm2 = wm, wn2 = wn;
    asm volatile("" : "+v"(r2), "+v"(h2));
    asm volatile("" : "+s"(wm2), "+s"(wn2));
    if constexpr (Epi::SWAPMODE == 2) {
      if (cur.normal) epi.template store<WMB, WNB>(m0 + wm2 * 32 * WMB, n0 + wn2 * 32 * WNB, acc, r2, h2, true);
      else epi.template store_t<WMB, WNB>(n0 + wm2 * 32 * WMB, m0 + wn2 * 32 * WNB, acc, r2, h2);
    } else {
      epi.template store<WMB, WNB>(m0 + wm2 * 32 * WMB, n0 + wn2 * 32 * WNB, acc, r2, h2, true);
    }
    if (!nxt.valid) break;
    cur = nxt;
  }
}

DI void lds_st16_as2x8(char* dst, const u32x4 v) {
  u32x2 a; a.x = v.x; a.y = v.y; u32x2 b; b.x = v.z; b.y = v.w;
  *(u32x2*)dst = a;
  *(u32x2*)(dst + 8) = b;
}
constexpr int ATT_STAGE = 35840;
constexpr float DEFER_THR = 8.f;

template <int DQK>
DI void qk_scores_qlds(const char* kl, const char* qsl, f32x16 (&s)[2], int r, int h) {
  constexpr int KS = DQK * 2 + 16;
#pragma unroll
  for (int kb = 0; kb < 2; ++kb) {
#pragma unroll
    for (int ks = 0; ks < DQK / 16; ++ks) {
      const bf16x8 a = *(const bf16x8*)(kl + (32 * kb + r) * KS + (2 * ks + h) * 16);
      const bf16x8 qv = *(const bf16x8*)(qsl + ks * 1024);
      s[kb] = MFMA32(a, qv, s[kb]);
    }
  }
}
template <int DQK>
DI void qk_scores(const char* kl, const bf16x8 (&qf)[DQK / 16], const f32x16& initv, f32x16 (&s)[2], int r, int h) {
  constexpr int KS = DQK * 2 + 16;
#pragma unroll
  for (int kb = 0; kb < 2; ++kb) {
    s[kb] = initv;
#pragma unroll
    for (int ks = 0; ks < DQK / 16; ++ks) {
      const bf16x8 a = *(const bf16x8*)(kl + (32 * kb + r) * KS + (2 * ks + h) * 16);
      s[kb] = MFMA32(a, qf[ks], s[kb]);
    }
  }
}

template <int DV>
DI float softmax_pv(f32x16 (&s)[2], f32x16 (&o)[DV / 32], float& l, bool first, const char* vl, int r, int h) {
  float dret = 0.f;
  float mx = fmaxf(fmaxf(s[0][0], s[0][1]), s[0][2]);
#pragma unroll
  for (int i = 3; i < 15; i += 2) mx = fmaxf(fmaxf(mx, s[0][i]), s[0][i + 1]);
  mx = fmaxf(fmaxf(mx, s[0][15]), s[1][0]);
#pragma unroll
  for (int i = 1; i < 15; i += 2) mx = fmaxf(fmaxf(mx, s[1][i]), s[1][i + 1]);
  mx = fmaxf(mx, s[1][15]);
  const bool need = first || (mx > DEFER_THR);
  if (__any(need)) {
    mx = fmaxf(mx, __shfl_xor(mx, 32));
    float delta;
    if (first) delta = mx;
    else {
      delta = fmaxf(mx, 0.f);
      const float alpha = fexp2(-delta);
      l *= alpha;
#pragma unroll
      for (int d = 0; d < DV / 32; ++d)
#pragma unroll
        for (int i = 0; i < 16; ++i) o[d][i] *= alpha;
    }
#pragma unroll
    for (int kb = 0; kb < 2; ++kb)
#pragma unroll
      for (int i = 0; i < 16; ++i) s[kb][i] -= delta;
    dret = delta;
  }
  float ps = 0.f;
#pragma unroll
  for (int kb = 0; kb < 2; ++kb)
#pragma unroll
    for (int i = 0; i < 16; ++i) { const float e = fexp2(s[kb][i]); s[kb][i] = e; ps += e; }
  l += ps;
  bf16x8 pf[2][2];
#pragma unroll
  for (int kb = 0; kb < 2; ++kb)
#pragma unroll
    for (int st = 0; st < 2; ++st) {
      u32x4 u;
      u.x = cvt_pk(s[kb][8 * st + 0], s[kb][8 * st + 1]); u.y = cvt_pk(s[kb][8 * st + 2], s[kb][8 * st + 3]);
      u.z = cvt_pk(s[kb][8 * st + 4], s[kb][8 * st + 5]); u.w = cvt_pk(s[kb][8 * st + 6], s[kb][8 * st + 7]);
      pf[kb][st] = __builtin_bit_cast(bf16x8, u);
    }
#pragma unroll
  for (int d = 0; d < DV / 32; ++d)
#pragma unroll
    for (int kb = 0; kb < 2; ++kb)
#pragma unroll
      for (int st = 0; st < 2; ++st) {
        const char* vp = vl + (32 * d + r) * 136 + (32 * kb + 16 * st + 4 * h) * 2;
        const u32x2 lo = *(const u32x2*)vp;
        const u32x2 hi = *(const u32x2*)(vp + 16);
        u32x4 u; u.x = lo.x; u.y = lo.y; u.z = hi.x; u.w = hi.y;
        o[d] = MFMA32(__builtin_bit_cast(bf16x8, u), pf[kb][st], o[d]);
      }
  return dret;
}

template <int DV>
DI float softmax_pre(f32x16 (&s)[2], f32x16 (&o)[DV / 32], float& l, bool first) {
  float dret = 0.f;
  float mx = fmaxf(fmaxf(s[0][0], s[0][1]), s[0][2]);
#pragma unroll
  for (int i = 3; i < 15; i += 2) mx = fmaxf(fmaxf(mx, s[0][i]), s[0][i + 1]);
  mx = fmaxf(fmaxf(mx, s[0][15]), s[1][0]);
#pragma unroll
  for (int i = 1; i < 15; i += 2) mx = fmaxf(fmaxf(mx, s[1][i]), s[1][i + 1]);
  mx = fmaxf(mx, s[1][15]);
  const bool need = first || (mx > DEFER_THR);
  if (__any(need)) {
    mx = fmaxf(mx, __shfl_xor(mx, 32));
    float delta;
    if (first) delta = mx;
    else {
      delta = fmaxf(mx, 0.f);
      const float alpha = fexp2(-delta);
      l *= alpha;
#pragma unroll
      for (int d = 0; d < DV / 32; ++d)
#pragma unroll
        for (int i = 0; i < 16; ++i) o[d][i] *= alpha;
    }
#pragma unroll
    for (int kb = 0; kb < 2; ++kb)
#pragma unroll
      for (int i = 0; i < 16; ++i) s[kb][i] -= delta;
    dret = delta;
  }
  return dret;
}
DI void softmax_exp_half(f32x16& s, float& l, bf16x8 (&pf)[2]) {
  float ps = 0.f;
#pragma unroll
  for (int i = 0; i < 16; ++i) { const float e = fexp2(s[i]); s[i] = e; ps += e; }
  l += ps;
#pragma unroll
  for (int st = 0; st < 2; ++st) {
    u32x4 u;
    u.x = cvt_pk(s[8 * st + 0], s[8 * st + 1]); u.y = cvt_pk(s[8 * st + 2], s[8 * st + 3]);
    u.z = cvt_pk(s[8 * st + 4], s[8 * st + 5]); u.w = cvt_pk(s[8 * st + 6], s[8 * st + 7]);
    pf[st] = __builtin_bit_cast(bf16x8, u);
  }
}
template <int DV>
DI void pv_half(const bf16x8 (&pf)[2], f32x16 (&o)[DV / 32], const char* vl, int kb, int r, int h) {
#pragma unroll
  for (int d = 0; d < DV / 32; ++d)
#pragma unroll
    for (int st = 0; st < 2; ++st) {
      const char* vp = vl + (32 * d + r) * 136 + (32 * kb + 16 * st + 4 * h) * 2;
      const u32x2 lo = *(const u32x2*)vp;
      const u32x2 hi = *(const u32x2*)(vp + 16);
      u32x4 u; u.x = lo.x; u.y = lo.y; u.z = hi.x; u.w = hi.y;
      o[d] = MFMA32(__builtin_bit_cast(bf16x8, u), pf[st], o[d]);
    }
}

template <int ABL>
DI void attn_mla_item(const Ctx& p, int item, char* lds) {
  constexpr int DQK = 96, DV = 64, KS = DQK * 2 + 16;
  const int tid = otid(p), lane = tid & 63, w = tid >> 6, r = lane & 31, h = lane >> 5;
  int head, qb, ts0, S;
  if (item < 1024) { head = item >> 6; qb = item & 63; ts0 = T_PROMPT; S = 16384; }
  else { const int it = item - 1024; qb = it & 15; head = (it >> 4) & 15; ts0 = (it >> 8) * 4096; S = 4096; }
  const u16* q = (const u16*)(p.ws + OFF_R2);
  const u16* knope = q + (size_t)T_TOK * 1536;
  const u16* vt = knope + (size_t)T_TOK * 1024;
  const u16* krope = (const u16*)(p.ws + OFF_KROPE);
  u16* o1 = (u16*)(p.ws + OFF_R1);
  const int tq = ts0 + qb * 256 + w * 32 + r;
  bf16x8 qf[DQK / 16];
#pragma unroll
  for (int ks = 0; ks < DQK / 16; ++ks) qf[ks] = *(const bf16x8*)(q + (size_t)tq * 1536 + head * 96 + 16 * ks + 8 * h);
  f32x16 o[DV / 32];
#pragma unroll
  for (int d = 0; d < DV / 32; ++d)
#pragma unroll
    for (int i = 0; i < 16; ++i) o[d][i] = 0.f;
  f32x16 initv;
#pragma unroll
  for (int i = 0; i < 16; ++i) initv[i] = 0.f;
  float l = 0.f;
  u32x4 pk0, pk1, pv0;
  const int c1 = 512 + tid;
  const int krow0 = tid / 12, kch0 = tid - krow0 * 12;
  const int krow1 = c1 / 12, kch1 = c1 - krow1 * 12;
  const int vrow = tid >> 3, vch = tid & 7;
  const int nkt = S >> 6;
  auto prefetch = [&](int kt) {
    const int tk0 = ts0 + kt * 64;
    {
      const u16* src = kch0 < 8 ? knope + (size_t)(tk0 + krow0) * 1024 + head * 64 + kch0 * 8 : krope + (size_t)(tk0 + krow0) * 32 + (kch0 - 8) * 8;
      pk0 = *(const u32x4*)src;
    }
    if (tid < 256) {
      const u16* src = kch1 < 8 ? knope + (size_t)(tk0 + krow1) * 1024 + head * 64 + kch1 * 8 : krope + (size_t)(tk0 + krow1) * 32 + (kch1 - 8) * 8;
      pk1 = *(const u32x4*)src;
    }
    pv0 = *(const u32x4*)(vt + (size_t)(head * 64 + vrow) * T_TOK + tk0 + vch * 8);
  };
  auto stage_at = [&](int boff) {
    char* kl = lds + boff;
    char* vl = kl + 64 * KS;
    *(u32x4*)(kl + krow0 * KS + kch0 * 16) = pk0;
    if (tid < 256) *(u32x4*)(kl + krow1 * KS + kch1 * 16) = pk1;
    lds_st16_as2x8(vl + vrow * 136 + vch * 16, pv0);
  };
  prefetch(0);
  __syncthreads();
  stage_at(0);
  prefetch(1);
  stage_at(ATT_STAGE);
  if (nkt > 2) prefetch(2);
  __syncthreads();
  int cur = 0, nxt = ATT_STAGE, nn = 2 * ATT_STAGE;
  f32x16 s[2];
  qk_scores<DQK>(lds, qf, initv, s, r, h);
#pragma unroll 1
  for (int kt = 0; kt < nkt; ++kt) {
    if (ABL == 2) { __syncthreads(); if (kt + 2 < nkt) stage_at(nn); if (kt + 3 < nkt) prefetch(kt + 3); { const int t = cur; cur = nxt; nxt = nn; nn = t; } continue; }
    const float dl = softmax_pre<DV>(s, o, l, kt == 0);
    if (__any(dl != 0.f)) {
#pragma unroll
      for (int i = 0; i < 16; ++i) initv[i] -= dl;
    }
    f32x16 sn[2];
    qk_scores<DQK>(lds + nxt, qf, initv, sn, r, h);
#pragma unroll
    for (int kb = 0; kb < 2; ++kb) {
      bf16x8 pf[2];
      softmax_exp_half(s[kb], l, pf);
      pv_half<DV>(pf, o, lds + cur + 64 * KS, kb, r, h);
    }
    if (ABL != 1) { if (kt + 2 < nkt) stage_at(nn);
    if (kt + 3 < nkt) prefetch(kt + 3); }
    __syncthreads();
    s[0] = sn[0]; s[1] = sn[1];
    const int t = cur; cur = nxt; nxt = nn; nn = t;
  }
  l += __shfl_xor(l, 32);
  const float inv = 1.f / l;
#pragma unroll
  for (int d = 0; d < DV / 32; ++d) store_tok(o1, 1024, tq, head * 64 + 32 * d + 4 * h, o[d], inv);
}

DI void attn_mla_item2(const Ctx& p, int item, char* lds) {
  constexpr int DQK = 96, DV = 64, KS = DQK * 2 + 16;
  const int tid = otid(p), lane = tid & 63, w = tid >> 6, r = lane & 31, h = lane >> 5;
  int head, qb, ts0, S;
  if (item < 512) { head = item >> 5; qb = item & 31; ts0 = T_PROMPT; S = 16384; }
  else { const int it = item - 512; qb = it & 7; head = (it >> 3) & 15; ts0 = (it >> 7) * 4096; S = 4096; }
  const u16* q = (const u16*)(p.ws + OFF_R2);
  const u16* knope = q + (size_t)T_TOK * 1536;
  const u16* vt = knope + (size_t)T_TOK * 1024;
  const u16* krope = (const u16*)(p.ws + OFF_KROPE);
  u16* o1 = (u16*)(p.ws + OFF_R1);
  const int tq0 = ts0 + qb * 512 + w * 64 + r;
  char* qsl = lds + 49152 + w * 12288 + lane * 16;
  __syncthreads();
  float qn2[2] = {0.f, 0.f};
#pragma unroll
  for (int j = 0; j < 2; ++j)
#pragma unroll
    for (int ks = 0; ks < DQK / 16; ++ks) {
      const u32x4 qv = *(const u32x4*)(q + (size_t)(tq0 + 32 * j) * 1536 + head * 96 + 16 * ks + 8 * h);
      *(u32x4*)(qsl + (j * 6 + ks) * 1024) = qv;
      float a;
      a = bflo(qv.x); qn2[j] += a * a; a = bfhi(qv.x); qn2[j] += a * a; a = bflo(qv.y); qn2[j] += a * a; a = bfhi(qv.y); qn2[j] += a * a;
      a = bflo(qv.z); qn2[j] += a * a; a = bfhi(qv.z); qn2[j] += a * a; a = bflo(qv.w); qn2[j] += a * a; a = bfhi(qv.w); qn2[j] += a * a;
    }
  float ref[2];
  {
    const float kn = __uint_as_float(((const unsigned*)(p.ws + OFF_SCAL))[SC_KMAX1 + head]);
    const float kr = __uint_as_float(((const unsigned*)(p.ws + OFF_SCAL))[SC_KRMAX]);
    const float kmaxn = sqrtf(kn * kn + kr * kr);
#pragma unroll
    for (int j = 0; j < 2; ++j) {
      qn2[j] += __shfl_xor(qn2[j], 32);
      ref[j] = sqrtf(qn2[j]) * kmaxn * 1.02f + 0.5f;
    }
  }
  const bool fixedref = !__any(ref[0] > 60.f || ref[1] > 60.f);
  f32x16 o[2][DV / 32];
  f32x16 initv[2];
#pragma unroll
  for (int j = 0; j < 2; ++j) {
#pragma unroll
    for (int d = 0; d < DV / 32; ++d)
#pragma unroll
      for (int i = 0; i < 16; ++i) o[j][d][i] = 0.f;
#pragma unroll
    for (int i = 0; i < 16; ++i) initv[j][i] = fixedref ? -ref[j] : 0.f;
  }
  float l[2] = {0.f, 0.f};
  u32x4 pk0, pk1, pv0;
  const int c1 = 512 + (tid & 255);
  const int krow0 = tid / 12, kch0 = tid - krow0 * 12;
  const int krow1 = c1 / 12, kch1 = c1 - krow1 * 12;
  const int vrow = tid >> 3, vch = tid & 7;
  const int nkt = S >> 6;
  auto prefetch = [&](int kt) {
    const int tk0 = ts0 + kt * 64;
    {
      const u16* src = kch0 < 8 ? knope + (size_t)(tk0 + krow0) * 1024 + head * 64 + kch0 * 8 : krope + (size_t)(tk0 + krow0) * 32 + (kch0 - 8) * 8;
      pk0 = *(const u32x4*)src;
    }
    {
      const u16* src = kch1 < 8 ? knope + (size_t)(tk0 + krow1) * 1024 + head * 64 + kch1 * 8 : krope + (size_t)(tk0 + krow1) * 32 + (kch1 - 8) * 8;
      pk1 = *(const u32x4*)src;
    }
    pv0 = *(const u32x4*)(vt + (size_t)(head * 64 + vrow) * T_TOK + tk0 + vch * 8);
  };
  auto stage_at = [&](int boff) {
    char* kl = lds + boff;
    char* vl = kl + 64 * KS;
    *(u32x4*)(kl + krow0 * KS + kch0 * 16) = pk0;
    *(u32x4*)(kl + krow1 * KS + kch1 * 16) = pk1;
    lds_st16_as2x8(vl + vrow * 136 + vch * 16, pv0);
  };
  prefetch(0);
  stage_at(0);
  prefetch(1);
  __syncthreads();
#pragma unroll 1
  for (int kt = 0; kt < nkt; ++kt) {
    const char* kl = lds + (kt & 1) * 24576;
    const char* vl = kl + 64 * KS;
    if (kt + 1 < nkt) stage_at(((kt + 1) & 1) * 24576);
    if (kt + 2 < nkt) prefetch(kt + 2);
    f32x16 s[2][2];
#pragma unroll
    for (int kb = 0; kb < 2; ++kb) {
      s[0][kb] = initv[0]; s[1][kb] = initv[1];
#pragma unroll
      for (int ks = 0; ks < DQK / 16; ++ks) {
        const bf16x8 a = *(const bf16x8*)(kl + (32 * kb + r) * KS + (2 * ks + h) * 16);
        const bf16x8 q0 = *(const bf16x8*)(qsl + ks * 1024);
        const bf16x8 q1 = *(const bf16x8*)(qsl + (6 + ks) * 1024);
        s[0][kb] = MFMA32(a, q0, s[0][kb]);
        s[1][kb] = MFMA32(a, q1, s[1][kb]);
      }
    }
    if (!fixedref) {
#pragma unroll
      for (int j = 0; j < 2; ++j) {
        const float dl = softmax_pre<DV>(s[j], o[j], l[j], kt == 0);
        if (__any(dl != 0.f)) {
#pragma unroll
          for (int i = 0; i < 16; ++i) initv[j][i] -= dl;
        }
      }
    }
#pragma unroll
    for (int kb = 0; kb < 2; ++kb) {
      bf16x8 pf0[2], pf1[2];
      softmax_exp_half(s[0][kb], l[0], pf0);
      softmax_exp_half(s[1][kb], l[1], pf1);
#pragma unroll
      for (int d = 0; d < DV / 32; ++d)
#pragma unroll
        for (int st = 0; st < 2; ++st) {
          const char* vp = vl + (32 * d + r) * 136 + (32 * kb + 16 * st + 4 * h) * 2;
          const u32x2 lo = *(const u32x2*)vp;
          const u32x2 hi = *(const u32x2*)(vp + 16);
          u32x4 u; u.x = lo.x; u.y = lo.y; u.z = hi.x; u.w = hi.y;
          const bf16x8 vf = __builtin_bit_cast(bf16x8, u);
          o[0][d] = MFMA32(vf, pf0[st], o[0][d]);
          o[1][d] = MFMA32(vf, pf1[st], o[1][d]);
        }
    }
    __syncthreads();
  }
  int tid2 = otid(p);
  const int lane2 = tid2 & 63, h2 = lane2 >> 5, w2 = tid2 >> 6;
  int item2 = item; asm volatile("" : "+s"(item2));
  int head2, tq2;
  if (item2 < 512) { head2 = item2 >> 5; tq2 = T_PROMPT + (item2 & 31) * 512 + w2 * 64 + (lane2 & 31); }
  else { const int it = item2 - 512; head2 = (it >> 3) & 15; tq2 = (it >> 7) * 4096 + (it & 7) * 512 + w2 * 64 + (lane2 & 31); }
#pragma unroll
  for (int j = 0; j < 2; ++j) {
    float lj = l[j];
    lj += __shfl_xor(lj, 32);
    const float inv = __builtin_amdgcn_rcpf(lj);
#pragma unroll
    for (int d = 0; d < DV / 32; ++d) store_tok(o1, 1024, tq2 + 32 * j, head2 * 64 + 32 * d + 4 * h2, o[j][d], inv);
  }
}

DI void diff_decode(int item, int& hh, int& qb, int& ts0, int& S) {
  int j;
  if (item < 128) { hh = 3; j = item; S = 16384; }
  else if (item < 256) { hh = 2; j = item - 128; S = 16384; }
  else if (item < 768) { hh = 3; j = item - 256; S = 4096; }
  else if (item < 1280) { hh = 2; j = item - 768; S = 4096; }
  else if (item < 1408) { hh = 1; j = item - 1280; S = 16384; }
  else if (item < 1920) { hh = 1; j = item - 1408; S = 4096; }
  else if (item < 2048) { hh = 0; j = item - 1920; S = 16384; }
  else { hh = 0; j = item - 2048; S = 4096; }
  if (S == 16384) { qb = j; ts0 = T_PROMPT; } else { qb = j & 31; ts0 = (j >> 5) * 4096; }
}
DI void attn_diff_item(const Ctx& p, int item, char* lds) {
  constexpr int DQK = 64, DV = 128, KS = DQK * 2 + 16;
  const int tid = otid(p), lane = tid & 63, w = tid >> 6, r = lane & 31, h = lane >> 5;
  const int map = w >> 2, qw = w & 3;
  int hh, qb, ts0, S;
  diff_decode(item, hh, qb, ts0, S);
  const u16* base = (const u16*)(p.ws + OFF_R2);
  const u16* dq = base + 3 * SEG512;
  const u16* dk = base + 4 * SEG512;
  const u16* vtd = base + 5 * SEG512;
  u16* o0 = (u16*)(p.ws + OFF_R1);
  const int qpos = qb * 128 + qw * 32 + r;
  const int tq = ts0 + qpos;
  char* qsl = lds + 3 * ATT_STAGE + 4096 + w * 4096 + lane * 16;
  __syncthreads();
  float qn2 = 0.f;
#pragma unroll
  for (int ks = 0; ks < DQK / 16; ++ks) {
    const u32x4 qv = *(const u32x4*)(dq + (size_t)tq * 512 + (2 * hh + map) * 64 + 16 * ks + 8 * h);
    *(u32x4*)(qsl + ks * 1024) = qv;
    float a;
    a = bflo(qv.x); qn2 += a * a; a = bfhi(qv.x); qn2 += a * a; a = bflo(qv.y); qn2 += a * a; a = bfhi(qv.y); qn2 += a * a;
    a = bflo(qv.z); qn2 += a * a; a = bfhi(qv.z); qn2 += a * a; a = bflo(qv.w); qn2 += a * a; a = bfhi(qv.w); qn2 += a * a;
  }
  qn2 += __shfl_xor(qn2, 32);
  f32x16 o[DV / 32];
#pragma unroll
  for (int d = 0; d < DV / 32; ++d)
#pragma unroll
    for (int i = 0; i < 16; ++i) o[d][i] = 0.f;
  float l = 0.f;
  const float refb = sqrtf(qn2) * __uint_as_float(((const unsigned*)(p.ws + OFF_SCAL))[SC_QKMAX + 8 + 2 * hh + map]) * 1.02f + 0.5f;
  const bool fixedref = !__any(refb > 60.f);
  float ref = fixedref ? refb : 0.f;
  const float slope2 = exp2f(-2.f * (float)(hh + 1)) * LOG2E;
  const float cq = slope2 * (float)qpos;
  const int d0 = 2 * qb;
  const int kd = d0 + (qw >> 1);
  int kt_lo, kt_hi;
  {
    const unsigned* qk = (const unsigned*)(p.ws + OFF_SCAL) + SC_QKMAX;
    const float b0 = __uint_as_float(qk[2 * hh]) * __uint_as_float(qk[8 + 2 * hh]);
    const float b1 = __uint_as_float(qk[2 * hh + 1]) * __uint_as_float(qk[8 + 2 * hh + 1]);
    const float B = fmaxf(b0, b1) * 1.02f + 0.5f;
    const float dskip = fminf((2.f * B + 34.f) / slope2 + 1.f, 1.0e6f);
    const int q_lo = qb * 128, q_hi = q_lo + 127, ds = (int)dskip;
    kt_lo = max(0, (q_lo - 63 - ds) >> 6);
    kt_hi = min((S >> 6) - 1, (q_hi + ds) >> 6);
    kt_lo = min(kt_lo, 2 * qb); kt_hi = max(kt_hi, 2 * qb + 1);
  }
  const int nleft = d0 - kt_lo;
  const int nkt = kt_hi - kt_lo + 1;
  u32x4 pk[2], pv[2];
  const int lrow = tid >> 3, lch = tid & 7;
  auto tile_of = [&](int idx) { return idx < 2 ? d0 + idx : (idx - 2 < nleft ? d0 - 1 - (idx - 2) : idx + kt_lo); };
  const unsigned koff = (unsigned)(((ts0 + lrow) * 512 + 2 * hh * 64 + lch * 8) * 2);
  const unsigned voff = (unsigned)((((hh * 128 + lrow) * T_TOK) + ts0 + lch * 8) * 2);
  const char* dkb = (const char*)dk;
  const char* vtb = (const char*)vtd;
  auto prefetch = [&](int kt) {
    const unsigned ko = koff + (unsigned)kt * (64u * 512u * 2u);
    const unsigned vo = voff + (unsigned)kt * 128u;
    pk[0] = *(const u32x4*)(dkb + ko);
    pk[1] = *(const u32x4*)(dkb + ko + 128u);
    pv[0] = *(const u32x4*)(vtb + vo);
    pv[1] = *(const u32x4*)(vtb + vo + (unsigned)(64 * T_TOK * 2));
  };
  auto stage_at = [&](int boff) {
    char* kl0 = lds + boff;
    char* vl = kl0 + 2 * 64 * KS;
#pragma unroll
    for (int j = 0; j < 2; ++j) *(u32x4*)(kl0 + j * 64 * KS + lrow * KS + lch * 16) = pk[j];
#pragma unroll
    for (int j = 0; j < 2; ++j) lds_st16_as2x8(vl + (lrow + 64 * j) * 136 + lch * 16, pv[j]);
  };
  auto scores = [&](int kt, int boff, f32x16 (&sc)[2]) {
    const int side = kt < kd ? -1 : (kt > kd ? 1 : 0);
    const float I = (float)side * cq - ref;
    const unsigned i_hi = cvt_pk(I, 0.f) & 0xffffu;
    const float ir1 = I - __uint_as_float(i_hi << 16);
    const unsigned i_mid = cvt_pk(ir1, 0.f) & 0xffffu;
    const float ir2 = ir1 - __uint_as_float(i_mid << 16);
    const unsigned i_lo = cvt_pk(ir2, 0.f) & 0xffffu;
    const float T = slope2 * (float)(kt * 64);
    const unsigned t_hi = cvt_pk(T, 0.f) & 0xffffu;
    const float r1 = T - __uint_as_float(t_hi << 16);
    const unsigned t_mid = cvt_pk(r1, 0.f) & 0xffffu;
    const float r2 = r1 - __uint_as_float(t_mid << 16);
    const unsigned t_lo = cvt_pk(r2, 0.f) & 0xffffu;
    const unsigned one = side < 0 ? 0x3F80u : (side > 0 ? 0xBF80u : 0u);
    u32x4 qa;
    qa.x = h == 0 ? (one | (one << 16)) : 0u; qa.y = qa.x; qa.z = h == 0 ? (one | (i_hi << 16)) : 0u; qa.w = h == 0 ? (i_mid | (i_lo << 16)) : 0u;
    const bf16x8 qaug = __builtin_bit_cast(bf16x8, qa);
#pragma unroll
    for (int kb = 0; kb < 2; ++kb) {
      const float xl = slope2 * (float)(32 * kb + r);
      const unsigned l_hi = cvt_pk(xl, 0.f) & 0xffffu;
      const unsigned l_lo = cvt_pk(xl - __uint_as_float(l_hi << 16), 0.f) & 0xffffu;
      u32x4 ka; ka.x = h == 0 ? (l_hi | (l_lo << 16)) : 0u; ka.y = h == 0 ? (t_hi | (t_mid << 16)) : 0u; ka.z = h == 0 ? (t_lo | 0x3F800000u) : 0u; ka.w = h == 0 ? 0x3F803F80u : 0u;
      f32x16 z;
#pragma unroll
      for (int i = 0; i < 16; ++i) z[i] = 0.f;
      sc[kb] = MFMA32(__builtin_bit_cast(bf16x8, ka), qaug, z);
    }
    qk_scores_qlds<DQK>(lds + boff + map * 64 * KS, qsl, sc, r, h);
  };
  prefetch(tile_of(0));
  __syncthreads();
  stage_at(0);
  prefetch(tile_of(1));
  stage_at(ATT_STAGE);
  if (nkt > 2) prefetch(tile_of(2));
  __syncthreads();
  int cur = 0, nxt = ATT_STAGE, nn = 2 * ATT_STAGE;
  f32x16 s[2];
  scores(tile_of(0), 0, s);
#pragma unroll 1
  for (int idx = 0; idx < nkt; ++idx) {
    const int kt = tile_of(idx);
    if (kt == kd) {
#pragma unroll
      for (int kb = 0; kb < 2; ++kb)
#pragma unroll
        for (int i = 0; i < 16; ++i) {
          const int kp = kt * 64 + 32 * kb + (i & 3) + 8 * (i >> 2) + 4 * h;
          s[kb][i] -= slope2 * fabsf((float)(qpos - kp));
        }
    }
    if (!fixedref) ref += softmax_pre<DV>(s, o, l, idx == 0);
    f32x16 sn[2];
    scores(tile_of(min(idx + 1, nkt - 1)), nxt, sn);
#pragma unroll
    for (int kb = 0; kb < 2; ++kb) {
      bf16x8 pf[2];
      softmax_exp_half(s[kb], l, pf);
      pv_half<DV>(pf, o, lds + cur + 2 * 64 * KS, kb, r, h);
    }
    if (idx + 2 < nkt) stage_at(nn);
    if (idx + 3 < nkt) prefetch(tile_of(idx + 3));
    __syncthreads();
    s[0] = sn[0]; s[1] = sn[1];
    const int t = cur; cur = nxt; nxt = nn; nn = t;
  }
  l += __shfl_xor(l, 32);
  const float inv = 1.f / l;
  int tid2 = otid(p);
  const int lane2 = tid2 & 63, qw2 = (tid2 >> 6) & 3, h2 = lane2 >> 5;
  int item2 = item; asm volatile("" : "+s"(item2));
  int hh2, tq2;
  { int qb2, ts02, S2; diff_decode(item2, hh2, qb2, ts02, S2); tq2 = ts02 + qb2 * 128 + qw2 * 32 + (lane2 & 31); }
  float* ex = (float*)lds + qw2 * 4096;
  if (map == 1) {
#pragma unroll
    for (int d = 0; d < DV / 32; ++d)
#pragma unroll
      for (int i = 0; i < 16; ++i) ex[(d * 16 + i) * 64 + lane2] = o[d][i] * inv;
  }
  __syncthreads();
  if (map == 0) {
    const float lam = ((const float*)(p.ws + OFF_SCAL))[0];
    float ss = 0.f;
#pragma unroll
    for (int d = 0; d < DV / 32; ++d)
#pragma unroll
      for (int i = 0; i < 16; ++i) { const float v = o[d][i] * inv - lam * ex[(d * 16 + i) * 64 + lane2]; o[d][i] = v; ss += v * v; }
    ss += __shfl_xor(ss, 32);
    const float rn = rsqrtf(ss * (1.f / 128.f) + EPS) * 0.8f;
    const float* gs = (const float*)(p.ws + OFF_SCAL) + SC_GSUB;
#pragma unroll
    for (int d = 0; d < DV / 32; ++d) {
#pragma unroll
      for (int g = 0; g < 4; ++g) {
        const float4 gv = *(const float4*)(gs + 32 * d + 8 * g + 4 * h2);
        o[d][4 * g] *= gv.x; o[d][4 * g + 1] *= gv.y; o[d][4 * g + 2] *= gv.z; o[d][4 * g + 3] *= gv.w;
      }
      store_tok(o0, 1024, tq2, 512 + hh2 * 128 + 32 * d + 4 * h2, o[d], rn);
    }
  }
}

DI void attn_na_item(const Ctx& p, int item, char* lds) {
  constexpr int DQK = 64, DV = 64, KS = DQK * 2 + 16;
  const int tid = otid(p), lane = tid & 63, w = tid >> 6, r = lane & 31, h = lane >> 5;
  const int quad = item % 320, head = item / 320;
  const int t0 = quad * 256;
  int ts0, rows;
  if (t0 < T_PROMPT) { ts0 = t0 & ~4095; rows = 64; } else { ts0 = T_PROMPT; rows = 256; }
  const int r0 = (t0 - ts0) >> 6;
  const int rw = r0 + (w >> 1);
  const int rs_lo = min(max(r0 - 4, 0), rows - 8);
  const int rs_hi = min(max(r0 + 3 - 4, 0), rows - 8);
  const int rs_w = min(max(rw - 4, 0), rows - 8);
  const int ntile = rs_hi + 8 - rs_lo;
  const u16* base = (const u16*)(p.ws + OFF_R2);
  const u16* qn = base;
  const u16* kn = base + SEG512;
  const u16* vtn = base + 2 * SEG512;
  u16* o0 = (u16*)(p.ws + OFF_R1);
  float* tab = (float*)(lds + 2 * ATT_STAGE) + 64;
  const int qc = (w & 1) * 32 + r;
  const int tq = t0 + w * 32 + r;
  bf16x8 qf[DQK / 16];
#pragma unroll
  for (int ks = 0; ks < DQK / 16; ++ks) qf[ks] = *(const bf16x8*)(qn + (size_t)tq * 512 + head * 64 + 16 * ks + 8 * h);
  f32x16 o[DV / 32];
#pragma unroll
  for (int d = 0; d < DV / 32; ++d)
#pragma unroll
    for (int i = 0; i < 16; ++i) o[d][i] = 0.f;
  f32x16 initv;
#pragma unroll
  for (int i = 0; i < 16; ++i) initv[i] = 0.f;
  float l = 0.f;
  bool first = true;
  u32x4 pk0, pv0;
  const int lrow = tid >> 3, lch = tid & 7;
  auto prefetch = [&](int j) {
    const int tk0 = ts0 + (rs_lo + j) * 64;
    pk0 = *(const u32x4*)(kn + (size_t)(tk0 + lrow) * 512 + head * 64 + lch * 8);
    pv0 = *(const u32x4*)(vtn + (size_t)(head * 64 + lrow) * T_TOK + tk0 + lch * 8);
  };
  auto stage = [&](int b) {
    char* kl = lds + b * ATT_STAGE;
    char* vl = kl + 64 * KS;
    *(u32x4*)(kl + lrow * KS + lch * 16) = pk0;
    lds_st16_as2x8(vl + lrow * 136 + lch * 16, pv0);
  };
  prefetch(0);
  __syncthreads();
  if (tid < 465) tab[tid] = ((const float*)(p.ws + OFF_SCAL))[SC_RPB + head * 465 + tid];
  stage(0);
  prefetch(1);
  __syncthreads();
  const int wc0 = min(max(qc - 8, 0), 48);
  const float* tabq = tab + (15 - qc + 4 * h);
  for (int j = 0; j < ntile; ++j) {
    const char* kl = lds + (j & 1) * ATT_STAGE;
    const char* vl = kl + 64 * KS;
    const int kr = rs_lo + j;
    if (kr >= rs_w && kr < rs_w + 8) {
      f32x16 s[2];
      qk_scores<DQK>(kl, qf, initv, s, r, h);
      const int ridx = kr - rw + 7;
#pragma unroll
      for (int kb = 0; kb < 2; ++kb)
#pragma unroll
        for (int i = 0; i < 16; ++i) {
          const int kc = 32 * kb + (i & 3) + 8 * (i >> 2) + 4 * h;
          const bool ok = (unsigned)(kc - wc0) < 16u;
          float b = tabq[ridx * 31 + 32 * kb + (i & 3) + 8 * (i >> 2)];
          asm volatile("" : "+v"(b));
          s[kb][i] = ok ? s[kb][i] + b : -INFINITY;
        }
      {
        const float dl = softmax_pv<DV>(s, o, l, first, vl, r, h);
        if (__any(dl != 0.f)) {
#pragma unroll
          for (int i = 0; i < 16; ++i) initv[i] -= dl;
        }
      }
      first = false;
    }
    if (j + 1 < ntile) stage((j + 1) & 1);
    if (j + 2 < ntile) prefetch(j + 2);
    __syncthreads();
  }
  l += __shfl_xor(l, 32);
  const float inv = 1.f / l;
#pragma unroll
  for (int d = 0; d < DV / 32; ++d) store_tok(o0, 1024, tq, head * 64 + 32 * d + 4 * h, o[d], inv);
}

constexpr int LDS_BYTES = 2 * (256 + 256) * 144;
template <int PH>
DI void run_phase(const Ctx& p, char* lds) {
  const int bid = obid(), nblk = gridDim.x;
  u16* wb = (u16*)p.ws;
  u16* R1 = (u16*)(p.ws + OFF_R1);
  u16* R2 = (u16*)(p.ws + OFF_R2);
  u16* R3 = (u16*)(p.ws + OFF_R3);
  if constexpr (PH == 0) phase_prep(p);
  else if constexpr (PH == 1) gemm_phase(R1, 1024, wb + W0IN, 1024, T_TOK, 3072, 1024, EpiProj0{R2, (unsigned*)(p.ws + OFF_SCAL) + SC_QKMAX}, lds, bid, nblk, p);
  else if constexpr (PH == 2) {
    unsigned* ctr = (unsigned*)(p.ws + OFF_SCAL) + SC_CTR;
    int* nxt_slot = (int*)(lds + LDS_BYTES - 16);
    const int tid0 = otid(p);
    int it = bid;
    while (it < 5120) {
      int nx = 0;
      if (tid0 == 0) nx = (int)atomicAdd(ctr, 1u) + nblk;
      if (it < 2560) attn_diff_item(p, it, lds);
      else attn_na_item(p, it - 2560, lds);
      __syncthreads();
      if (tid0 == 0) *nxt_slot = nx;
      __syncthreads();
      it = *nxt_slot;
    }
  }
  else if constexpr (PH == 3) gemm_phase(R1, 1024, wb + W0OUT, 1024, T_TOK, 1024, 1024, EpiTok{R3, 1024}, lds, bid, nblk, p);
  else if constexpr (PH == 4) phase_res<true, false>(p, R3, (const float*)(p.ws + OFF_SCAL) + SC_G0);
  else if constexpr (PH == 5) gemm_phase(R1, 1024, wb + W0F1, 1024, T_TOK, 5632, 1024, EpiSwiGLU{R2}, lds, bid, nblk, p);
  else if constexpr (PH == 6) gemm_phase(R2, 2816, wb + W0F2, 2816, T_TOK, 1024, 2816, EpiTok{R3, 1024}, lds, bid, nblk, p);
  else if constexpr (PH == 7) phase_res<false, false>(p, R3, (const float*)(p.ws + OFF_SCAL) + SC_G1);
  else if constexpr (PH == 8) gemm_phase(R1, 1024, wb + W1DN, 1024, T_TOK, 768, 1024, EpiTok{R3, 768}, lds, bid, nblk, p);
  else if constexpr (PH == 9) phase_mla_stats(p);
  else if constexpr (PH == 10) {
    gemm_phase(R3, 768, wb + W1UQ, 384, T_TOK, 1536, 384,
                     EpiUQ{R2, (const float*)(p.ws + OFF_RQ), (const float2*)(p.ws + OFF_ROPE)}, lds, bid, nblk, p);
    gemm_phase(R3 + 384, 768, wb + W1UKV, 256, T_TOK, 2048, 256,
                     EpiUKV{R2 + (size_t)T_TOK * 1536, R2 + (size_t)T_TOK * 2560, (const float*)(p.ws + OFF_RKV), (unsigned*)(p.ws + OFF_SCAL) + SC_KMAX1}, lds, bid, nblk, p);
  }
  else if constexpr (PH == 11) { for (int it = bid; it < 2560; it += nblk) {
      int itm = it;
      if (nblk == 256) {
        const int rnd = it >> 8, x = bid & 7, j = bid >> 3;
        itm = rnd < 2 ? (8 * rnd + x) * 32 + j : 512 + (2 * (rnd - 2) + (x >> 2)) * 128 + (4 * (x & 3) + (j >> 3)) * 8 + (j & 7);
      }
      attn_mla_item2(p, itm, lds);
    } }
  else if constexpr (PH == 12) gemm_phase(R1, 1024, wb + W1OUT, 1024, T_TOK, 1024, 1024, EpiTok{R3, 1024}, lds, bid, nblk, p);
  else if constexpr (PH == 13) phase_res<false, false>(p, R3, (const float*)(p.ws + OFF_SCAL) + SC_G2);
  else if constexpr (PH == 14) gemm_phase(R1, 1024, wb + W1F1, 1024, T_TOK, 5632, 1024, EpiSwiGLU{R2}, lds, bid, nblk, p);
  else if constexpr (PH == 15) gemm_phase(R2, 2816, wb + W1F2, 2816, T_TOK, 1024, 2816, EpiTok{R3, 1024}, lds, bid, nblk, p);
  else if constexpr (PH == 16) phase_res<false, true>(p, R3, (const float*)(p.ws + OFF_SCAL) + SC_G3);
}

#if MULTI_LAUNCH
template <int PH>
__global__ void __launch_bounds__(512, 2) k_phase(Params pa) {
  extern __shared__ __attribute__((aligned(16))) char lds[];
  Ctx p;
#pragma unroll
  for (int i = 0; i < 28; ++i) p.in[i] = pa.in[i];
  p.out = pa.out; p.ws = pa.ws;
  p.wv = __builtin_amdgcn_readfirstlane((int)(threadIdx.x >> 6));
  run_phase<PH>(p, lds);
}
template <int PH>
static void launch_all(const Params& p, int grid, hipStream_t stream) {
  (void)hipFuncSetAttribute((const void*)k_phase<PH>, hipFuncAttributeMaxDynamicSharedMemorySize, LDS_BYTES);
  hipLaunchKernelGGL(k_phase<PH>, dim3(grid), dim3(512), LDS_BYTES, stream, p);
  if constexpr (PH + 1 < NPHASE) launch_all<PH + 1>(p, grid, stream);
}
#define OCC_KERNEL k_phase<2>
#else
#ifndef PROBE_DUP
#define PROBE_DUP -1
#endif
#ifndef PROBE_DUP2
#define PROBE_DUP2 -1
#endif
DI void grid_barrier(unsigned* ctr, unsigned target, const Ctx& p) {
  __syncthreads();
  if (otid(p) < 64) {
    __builtin_amdgcn_fence(__ATOMIC_RELEASE, "agent");
    if (otid(p) == 0) {
      __hip_atomic_fetch_add(ctr, 1u, __ATOMIC_RELAXED, __HIP_MEMORY_SCOPE_AGENT);
      while (__hip_atomic_load(ctr, __ATOMIC_RELAXED, __HIP_MEMORY_SCOPE_AGENT) < target) __builtin_amdgcn_s_sleep(1);
    }
    __builtin_amdgcn_fence(__ATOMIC_ACQUIRE, "agent");
  }
  __syncthreads();
}
template <int PH>
DI void run_from(const Ctx& p, char* lds) {
  if constexpr (PH == PROBE_DUP || PH == PROBE_DUP2) { run_phase<PH>(p, lds); cg::this_grid().sync(); }
#ifdef PROBE_ABL
  if constexpr (PH == 11) { for (int it = obid(); it < 5120; it += gridDim.x) attn_mla_item<PROBE_ABL>(p, it, lds); cg::this_grid().sync(); }
#endif
  run_phase<PH>(p, lds);
  if constexpr (PH + 1 < NPHASE) {
    if constexpr (PH == 0) cg::this_grid().sync();
    else grid_barrier((unsigned*)(p.ws + OFF_SCAL) + SC_BAR, (unsigned)PH * gridDim.x, p);
    run_from<PH + 1>(p, lds);
  }
}
__global__ void __launch_bounds__(512, 2) mega(Params pa) {
  extern __shared__ __attribute__((aligned(16))) char lds[];
  Ctx p;
#pragma unroll
  for (int i = 0; i < 28; ++i) p.in[i] = pa.in[i];
  p.out = pa.out; p.ws = pa.ws;
  p.wv = __builtin_amdgcn_readfirstlane((int)(threadIdx.x >> 6));
  run_from<0>(p, lds);
}
#define OCC_KERNEL mega
#endif

extern "C" void kernel_launch(void* const* d_in, const int* in_sizes, int n_in, void* d_out, int out_size, void* d_ws, size_t ws_size,
                              hipStream_t stream) {
  static int grid = 0;
  if (grid == 0) {
    if (n_in != 28 || ws_size < WS_NEED) { fprintf(stderr, "kernel_launch: unexpected n_in %d / ws_size %zu (need %zu)\n", n_in, ws_size, (size_t)WS_NEED); grid = -1; return; }
    int dev = 0, cus = 0, per_cu = 0;
    (void)hipGetDevice(&dev);
    (void)hipDeviceGetAttribute(&cus, hipDeviceAttributeMultiprocessorCount, dev);
    (void)hipFuncSetAttribute((const void*)OCC_KERNEL, hipFuncAttributeMaxDynamicSharedMemorySize, LDS_BYTES);
    (void)hipOccupancyMaxActiveBlocksPerMultiprocessor(&per_cu, (const void*)OCC_KERNEL, 512, LDS_BYTES);
    if (per_cu < 1) per_cu = 1;
    if (per_cu > 1) per_cu = 1;
    grid = cus * per_cu;
  }
  if (grid < 0) return;
  Params p{};
  for (int i = 0; i < 28; ++i) p.in[i] = (const float*)d_in[i];
  p.out = (float*)d_out;
  p.ws = (char*)d_ws;
#if MULTI_LAUNCH
  launch_all<0>(p, grid, stream);
#else
  void* args[] = {&p};
  hipError_t e = hipLaunchCooperativeKernel((const void*)mega, dim3(grid), dim3(512), args, LDS_BYTES, stream);
  if (e != hipSuccess) fprintf(stderr, "cooperative launch failed: %s (grid %d)\n", hipGetErrorString(e), grid);
#endif
}
```

```cpp
#include <hip/hip_runtime.h>
#include <hip/hip_cooperative_groups.h>
#include <stdint.h>
#include <cstdio>
namespace cg = cooperative_groups;

#ifndef MULTI_LAUNCH
#define MULTI_LAUNCH 0
#endif

typedef unsigned short u16;
typedef __attribute__((ext_vector_type(8))) short bf16x8;
typedef __attribute__((ext_vector_type(16))) float f32x16;
typedef __attribute__((ext_vector_type(4))) unsigned u32x4;

#define MFMA32(a, b, c) __builtin_amdgcn_mfma_f32_32x32x16_bf16((a), (b), (c), 0, 0, 0)
#define DI __device__ __forceinline__

constexpr int T_TOK = 81920;
constexpr int T_PROMPT = 65536;
constexpr int DM = 1024;
constexpr int DFF = 2816;
constexpr float EPS = 1e-6f;
constexpr float LOG2E = 1.4426950408889634f;
constexpr float QSCALE64 = 0.125f * LOG2E;
constexpr float QSCALE96 = 0.10206207261596577f * LOG2E;
constexpr int NPHASE = 17;

constexpr size_t MiB = (size_t)1 << 20;
constexpr size_t W0IN = 0;
constexpr size_t W0OUT = W0IN + (size_t)3072 * 1024;
constexpr size_t W0F1 = W0OUT + (size_t)1024 * 1024;
constexpr size_t W0F2 = W0F1 + (size_t)5632 * 1024;
constexpr size_t W1DN = W0F2 + (size_t)1024 * 2816;
constexpr size_t W1UQ = W1DN + (size_t)768 * 1024;
constexpr size_t W1UKV = W1UQ + (size_t)1536 * 384;
constexpr size_t W1OUT = W1UKV + (size_t)2048 * 256;
constexpr size_t W1F1 = W1OUT + (size_t)1024 * 1024;
constexpr size_t W1F2 = W1F1 + (size_t)5632 * 1024;
constexpr size_t W_END = W1F2 + (size_t)1024 * 2816;
static_assert(W_END * 2 <= 48 * MiB, "weights region");
constexpr size_t OFF_ROPE = 48 * MiB;
constexpr size_t OFF_RQ = OFF_ROPE + 2 * MiB;
constexpr size_t OFF_RKV = OFF_RQ + MiB / 2;
constexpr size_t OFF_KROPE = OFF_RKV + MiB / 2;
constexpr size_t OFF_SCAL = OFF_KROPE + 5 * MiB;
constexpr int SC_QKMAX = 16, SC_CTR = 32, SC_BAR = 33, SC_KMAX1 = 40, SC_KRMAX = 56;
constexpr int SC_G0 = 1024, SC_G1 = 2048, SC_G2 = 3072, SC_G3 = 4096, SC_GSUB = 5120, SC_RPB = 6144;
constexpr size_t OFF_R1 = 58 * MiB;
constexpr size_t OFF_R3 = OFF_R1 + 160 * MiB;
constexpr size_t OFF_R2 = OFF_R3 + 160 * MiB;
constexpr size_t WS_NEED = OFF_R2 + 560 * MiB;
constexpr size_t SEG512 = (size_t)T_TOK * 512;

struct Params {
  const float* in[28];
  float* out;
  char* ws;
};
struct Ctx {
  const float* in[28];
  float* out;
  char* ws;
  int wv;
};

DI u16 f2bf(float x) { unsigned u = __float_as_uint(x); u += 0x7fffu + ((u >> 16) & 1u); return (u16)(u >> 16); }
DI unsigned pack2(float a, float b) { return (unsigned)f2bf(a) | ((unsigned)f2bf(b) << 16); }
DI float bflo(unsigned v) { return __uint_as_float(v << 16); }
DI float bfhi(unsigned v) { return __uint_as_float(v & 0xffff0000u); }
DI float wave_sum(float v) {
#pragma unroll
  for (int o = 32; o; o >>= 1) v += __shfl_xor(v, o);
  return v;
}
DI int tok_pos(int t) { return t < T_PROMPT ? (t & 4095) : (t - T_PROMPT); }
DI float fexp2(float x) { return __builtin_amdgcn_exp2f(x); }
typedef __attribute__((ext_vector_type(2))) float f32x2;
typedef __attribute__((ext_vector_type(2))) __bf16 bf16x2_t;
typedef __attribute__((ext_vector_type(2))) unsigned u32x2;
typedef __attribute__((ext_vector_type(4))) unsigned u32x4_;
DI unsigned cvt_pk(float a, float b) {
  f32x2 v; v.x = a; v.y = b;
  return __builtin_bit_cast(unsigned, __builtin_convertvector(v, bf16x2_t));
}
DI int otid(const Ctx& p) {
  int wv = p.wv; asm volatile("" : "+s"(wv));
  int t = wv * 64 + (int)__builtin_amdgcn_mbcnt_hi(~0u, __builtin_amdgcn_mbcnt_lo(~0u, 0u));
  asm volatile("" : "+v"(t));
  return t;
}
DI int obid() { int b = blockIdx.x; asm volatile("" : "+s"(b)); return b; }

__device__ const float ROPE_INV[16] = {1.0f, 0.5623413324356079f, 0.3162277638912201f, 0.17782793939113617f, 0.10000000149011612f, 0.05623413249850273f, 0.03162277489900589f, 0.017782794311642647f, 0.009999999776482582f, 0.005623413249850273f, 0.003162277629598975f, 0.0017782794311642647f, 0.0010000000474974513f, 0.000562341301701963f, 0.0003162277571391314f, 0.00017782794020604342f};

DI void wconv(const float* __restrict__ W, const float* __restrict__ g, u16* __restrict__ dst, int K, int N, int rowsOut, int perm, int gtid, int gthreads) {
  const int kc = K >> 3;
  const long total = (long)rowsOut * kc;
  for (long c = gtid; c < total; c += gthreads) {
    const int n = (int)(c % rowsOut);
    const int k0 = (int)(c / rowsOut) * 8;
    int sc;
    if (perm == 1) { const int blk = n >> 8, w = n & 255; const int j = blk * 128 + (w & 127); sc = (w < 128) ? j : DFF + j; }
    else if (perm == 2) { const int hd = (n & 1023) >> 6, d = n & 63; sc = hd * 128 + (n >= 1024 ? 64 : 0) + d; }
    else sc = n;
    uint4 o = make_uint4(0, 0, 0, 0);
    if (sc < N) {
      float v[8];
#pragma unroll
      for (int i = 0; i < 8; ++i) { float x = W[(size_t)(k0 + i) * N + sc]; if (g) x *= g[k0 + i]; v[i] = x; }
      o.x = pack2(v[0], v[1]); o.y = pack2(v[2], v[3]); o.z = pack2(v[4], v[5]); o.w = pack2(v[6], v[7]);
    }
    *(uint4*)(dst + (size_t)n * K + k0) = o;
  }
}

DI void phase_prep(const Ctx& p) {
  const int gtid = obid() * 512 + otid(p), gthreads = gridDim.x * 512;
  u16* wb = (u16*)p.ws;
  wconv(p.in[3], p.in[2], wb + W0IN, 1024, 3072, 3072, 0, gtid, gthreads);
  wconv(p.in[10], nullptr, wb + W0OUT, 1024, 1024, 1024, 0, gtid, gthreads);
  wconv(p.in[13], p.in[12], wb + W0F1, 1024, 5632, 5632, 1, gtid, gthreads);
  wconv(p.in[14], nullptr, wb + W0F2, 2816, 1024, 1024, 0, gtid, gthreads);
  wconv(p.in[17], p.in[16], wb + W1DN, 1024, 672, 768, 0, gtid, gthreads);
  wconv(p.in[20], p.in[18], wb + W1UQ, 384, 1536, 1536, 0, gtid, gthreads);
  wconv(p.in[21], p.in[19], wb + W1UKV, 256, 2048, 2048, 2, gtid, gthreads);
  wconv(p.in[22], nullptr, wb + W1OUT, 1024, 1024, 1024, 0, gtid, gthreads);
  wconv(p.in[25], p.in[24], wb + W1F1, 1024, 5632, 5632, 1, gtid, gthreads);
  wconv(p.in[26], nullptr, wb + W1F2, 2816, 1024, 1024, 0, gtid, gthreads);
  float2* rope = (float2*)(p.ws + OFF_ROPE);
  for (int idx = gtid; idx < 16384 * 16; idx += gthreads) {
    const int pos = idx >> 4, i = idx & 15;
    const float ang = (float)pos * ROPE_INV[i];
    double rev = (double)ang * 0.15915494309189535;
    rev -= rint(rev);
    const float rf = (float)rev;
    rope[idx] = make_float2(__builtin_amdgcn_cosf(rf), __builtin_amdgcn_sinf(rf));
  }
  if (gtid == 0) {
    float s1 = 0.f, s2 = 0.f;
    for (int i = 0; i < 64; ++i) { s1 += p.in[5][i] * p.in[6][i]; s2 += p.in[7][i] * p.in[8][i]; }
    float* sc = (float*)(p.ws + OFF_SCAL);
    sc[0] = __expf(s1) - __expf(s2) + 0.2f;
    for (int i = 0; i < 48; ++i) ((unsigned*)sc)[SC_QKMAX + i] = 0u;
  }
  {
    float* sc = (float*)(p.ws + OFF_SCAL);
    for (int i = gtid; i < 1024; i += gthreads) { sc[SC_G0 + i] = p.in[11][i]; sc[SC_G1 + i] = p.in[15][i]; sc[SC_G2 + i] = p.in[23][i]; sc[SC_G3 + i] = p.in[27][i]; }
    for (int i = gtid; i < 128; i += gthreads) sc[SC_GSUB + i] = p.in[9][i];
    for (int i = gtid; i < 8 * 465; i += gthreads) sc[SC_RPB + i] = p.in[4][i] * LOG2E;
  }
  const int tid_ = otid(p);
  const int lane = tid_ & 63;
  const int gw = obid() * 8 + (tid_ >> 6), nw = gridDim.x * 8;
  u16* hb = (u16*)(p.ws + OFF_R1);
  for (int row = gw; row < T_TOK; row += nw) {
    const float* xr = row < T_PROMPT ? p.in[0] + (size_t)row * DM : p.in[1] + (size_t)(row - T_PROMPT) * DM;
    float4 v[4];
    float ss = 0.f;
#pragma unroll
    for (int j = 0; j < 4; ++j) { v[j] = ((const float4*)xr)[lane + 64 * j]; ss += v[j].x * v[j].x + v[j].y * v[j].y + v[j].z * v[j].z + v[j].w * v[j].w; }
    ss = wave_sum(ss);
    const float r = rsqrtf(ss * (1.f / DM) + EPS);
#pragma unroll
    for (int j = 0; j < 4; ++j) {
      uint2 o; o.x = pack2(v[j].x * r, v[j].y * r); o.y = pack2(v[j].z * r, v[j].w * r);
      ((uint2*)(hb + (size_t)row * DM))[lane + 64 * j] = o;
    }
  }
}

template <bool FIRST, bool LAST>
DI void phase_res(const Ctx& p, const u16* __restrict__ mbuf, const float* __restrict__ g) {
  const int tid_ = otid(p);
  const int lane = tid_ & 63;
  const int gw = obid() * 8 + (tid_ >> 6), nw = gridDim.x * 8;
  u16* hb = (u16*)(p.ws + OFF_R1);
  float4 gv[4];
#pragma unroll
  for (int j = 0; j < 4; ++j) gv[j] = ((const float4*)g)[lane + 64 * j];
  for (int row0 = gw; row0 < T_TOK; row0 += 2 * nw) {
    float4 xv[2][4], mv[2][4];
    float ss[2] = {0.f, 0.f};
    bool act[2];
#pragma unroll
    for (int t = 0; t < 2; ++t) {
      const int row = row0 + t * nw;
      act[t] = row < T_TOK;
      const int rr = act[t] ? row : row0;
      const float* xr;
      if (FIRST) xr = rr < T_PROMPT ? p.in[0] + (size_t)rr * DM : p.in[1] + (size_t)(rr - T_PROMPT) * DM;
      else xr = p.out + (size_t)rr * DM;
#pragma unroll
      for (int j = 0; j < 4; ++j) {
        const uint2 u = ((const uint2*)(mbuf + (size_t)rr * DM))[lane + 64 * j];
        mv[t][j] = make_float4(bflo(u.x), bfhi(u.x), bflo(u.y), bfhi(u.y));
        xv[t][j] = ((const float4*)xr)[lane + 64 * j];
      }
    }
#pragma unroll
    for (int t = 0; t < 2; ++t) {
#pragma unroll
      for (int j = 0; j < 4; ++j) ss[t] += mv[t][j].x * mv[t][j].x + mv[t][j].y * mv[t][j].y + mv[t][j].z * mv[t][j].z + mv[t][j].w * mv[t][j].w;
      ss[t] = wave_sum(ss[t]);
    }
#pragma unroll
    for (int t = 0; t < 2; ++t) {
      if (!act[t]) continue;
      const int row = row0 + t * nw;
      const float rm = rsqrtf(ss[t] * (1.f / DM) + EPS);
      float s2 = 0.f;
#pragma unroll
      for (int j = 0; j < 4; ++j) {
        xv[t][j].x += mv[t][j].x * rm * gv[j].x; xv[t][j].y += mv[t][j].y * rm * gv[j].y;
        xv[t][j].z += mv[t][j].z * rm * gv[j].z; xv[t][j].w += mv[t][j].w * rm * gv[j].w;
        s2 += xv[t][j].x * xv[t][j].x + xv[t][j].y * xv[t][j].y + xv[t][j].z * xv[t][j].z + xv[t][j].w * xv[t][j].w;
        ((float4*)(p.out + (size_t)row * DM))[lane + 64 * j] = xv[t][j];
      }
      if (!LAST) {
        s2 = wave_sum(s2);
        const float r2 = rsqrtf(s2 * (1.f / DM) + EPS);
#pragma unroll
        for (int j = 0; j < 4; ++j) {
          uint2 o; o.x = pack2(xv[t][j].x * r2, xv[t][j].y * r2); o.y = pack2(xv[t][j].z * r2, xv[t][j].w * r2);
          ((uint2*)(hb + (size_t)row * DM))[lane + 64 * j] = o;
        }
      }
    }
  }
}

DI void phase_mla_stats(const Ctx& p) {
  const int tid_ = otid(p);
  const int lane = tid_ & 63;
  const int gw = obid() * 8 + (tid_ >> 6), nw = gridDim.x * 8;
  const u16* c = (const u16*)(p.ws + OFF_R3);
  float* rq = (float*)(p.ws + OFF_RQ);
  float* rkv = (float*)(p.ws + OFF_RKV);
  u16* krope = (u16*)(p.ws + OFF_KROPE);
  const float2* rope = (const float2*)(p.ws + OFF_ROPE);
  float krmax2 = 0.f;
  for (int row = gw; row < T_TOK; row += nw) {
    const u16* cr = c + (size_t)row * 768;
    const uint4 u0 = ((const uint4*)cr)[lane];
    float s0 = 0.f;
    { float a;
      a = bflo(u0.x); s0 += a * a; a = bfhi(u0.x); s0 += a * a; a = bflo(u0.y); s0 += a * a; a = bfhi(u0.y); s0 += a * a;
      a = bflo(u0.z); s0 += a * a; a = bfhi(u0.z); s0 += a * a; a = bflo(u0.w); s0 += a * a; a = bfhi(u0.w); s0 += a * a; }
    float s1 = 0.f;
    if (lane < 16) {
      const uint4 u1 = ((const uint4*)cr)[64 + lane];
      float a;
      a = bflo(u1.x); s1 += a * a; a = bfhi(u1.x); s1 += a * a; a = bflo(u1.y); s1 += a * a; a = bfhi(u1.y); s1 += a * a;
      a = bflo(u1.z); s1 += a * a; a = bfhi(u1.z); s1 += a * a; a = bflo(u1.w); s1 += a * a; a = bfhi(u1.w); s1 += a * a;
    }
    const float sq = wave_sum(lane < 48 ? s0 : 0.f);
    const float skv = wave_sum((lane >= 48 ? s0 : 0.f) + s1);
    if (lane == 0) {
      rq[row] = rsqrtf(sq * (1.f / 384.f) + EPS);
      rkv[row] = rsqrtf(skv * (1.f / 256.f) + EPS);
    }
    float kr2 = 0.f;
    if (lane < 16) {
      const float x1 = __uint_as_float((unsigned)cr[640 + lane] << 16);
      const float x2 = __uint_as_float((unsigned)cr[656 + lane] << 16);
      const float2 cs = rope[tok_pos(row) * 16 + lane];
      const float o1 = x1 * cs.x - x2 * cs.y, o2 = x2 * cs.x + x1 * cs.y;
      krope[(size_t)row * 32 + lane] = f2bf(o1);
      krope[(size_t)row * 32 + 16 + lane] = f2bf(o2);
      kr2 = o1 * o1 + o2 * o2;
    }
    krmax2 = fmaxf(krmax2, wave_sum(kr2));
  }
  if (lane == 0) atomicMax((unsigned*)(p.ws + OFF_SCAL) + SC_KRMAX, __float_as_uint(sqrtf(krmax2)));
}

DI void store_tok(u16* out, int ldo, int m, int nbase, const f32x16& v, float sc) {
  u16* q = out + (size_t)m * ldo + nbase;
#pragma unroll
  for (int g = 0; g < 4; ++g) {
    uint2 u; u.x = pack2(v[4 * g] * sc, v[4 * g + 1] * sc); u.y = pack2(v[4 * g + 2] * sc, v[4 * g + 3] * sc);
    *(uint2*)(q + 8 * g) = u;
  }
}
DI void store_tr(u16* outT, size_t ldt, int n, int mbase, const f32x16& v, const float* __restrict__ rs) {
  u16* q = outT + (size_t)n * ldt + mbase;
#pragma unroll
  for (int g = 0; g < 4; ++g) {
    float4 s = make_float4(1.f, 1.f, 1.f, 1.f);
    if (rs) s = *(const float4*)(rs + mbase + 8 * g);
    uint2 u; u.x = pack2(v[4 * g] * s.x, v[4 * g + 1] * s.y); u.y = pack2(v[4 * g + 2] * s.z, v[4 * g + 3] * s.w);
    *(uint2*)(q + 8 * g) = u;
  }
}

DI void store_tok_u(u16* ub, unsigned loff, const f32x16& v, float sc) {
  char* q = (char*)ub;
  const unsigned hoff = (loff & 8u) << 1;
  const unsigned lbase = loff & ~8u;
#pragma unroll
  for (int pi = 0; pi < 2; ++pi) {
    const int g0 = 2 * pi, g1 = 2 * pi + 1;
    const unsigned a0 = cvt_pk(v[4 * g0] * sc, v[4 * g0 + 1] * sc), a1 = cvt_pk(v[4 * g0 + 2] * sc, v[4 * g0 + 3] * sc);
    const unsigned b0 = cvt_pk(v[4 * g1] * sc, v[4 * g1 + 1] * sc), b1 = cvt_pk(v[4 * g1 + 2] * sc, v[4 * g1 + 3] * sc);
    const u32x2 s0 = __builtin_amdgcn_permlane32_swap(a0, b0, false, false);
    const u32x2 s1 = __builtin_amdgcn_permlane32_swap(a1, b1, false, false);
    u32x4 u; u.x = s0.x; u.y = s1.x; u.z = s0.y; u.w = s1.y;
    *(u32x4*)(q + lbase + hoff + 32 * pi) = u;
  }
}
DI void store_tr_u(u16* ub, unsigned loff, const f32x16& v, const float* __restrict__ rs) {
  char* q = (char*)ub;
  const unsigned hoff = (loff & 8u) << 1;
  const unsigned lbase = loff & ~8u;
#pragma unroll
  for (int pi = 0; pi < 2; ++pi) {
    const int g0 = 2 * pi, g1 = 2 * pi + 1;
    float4 sa = make_float4(1.f, 1.f, 1.f, 1.f), sb = sa;
    if (rs) { sa = *(const float4*)(rs + 8 * g0); sb = *(const float4*)(rs + 8 * g1); }
    const unsigned a0 = cvt_pk(v[4 * g0] * sa.x, v[4 * g0 + 1] * sa.y), a1 = cvt_pk(v[4 * g0 + 2] * sa.z, v[4 * g0 + 3] * sa.w);
    const unsigned b0 = cvt_pk(v[4 * g1] * sb.x, v[4 * g1 + 1] * sb.y), b1 = cvt_pk(v[4 * g1 + 2] * sb.z, v[4 * g1 + 3] * sb.w);
    const u32x2 s0 = __builtin_amdgcn_permlane32_swap(a0, b0, false, false);
    const u32x2 s1 = __builtin_amdgcn_permlane32_swap(a1, b1, false, false);
    u32x4 u; u.x = s0.x; u.y = s1.x; u.z = s0.y; u.w = s1.y;
    *(u32x4*)(q + lbase + hoff + 32 * pi) = u;
  }
}

struct EpiTok {
  u16* out; int ldo;
  static constexpr int SWAPMODE = 1;
  DI bool swap(int) const { return true; }
  template <int WMB, int WNB>
  DI void store(int m0w, int n0w, f32x16 (&acc)[WMB][WNB], int r, int h, bool) const {
#pragma unroll
    for (int mb = 0; mb < WMB; ++mb)
#pragma unroll
      for (int nb = 0; nb < WNB; ++nb) store_tok_u(out + (size_t)(m0w + mb * 32) * ldo + n0w + nb * 32, (unsigned)((r * ldo + 4 * h) * 2), acc[mb][nb], 1.f);
  }
};

struct EpiProj0 {
  u16* base; unsigned* qkmax;
  static constexpr int SWAPMODE = 2;
  DI bool swap(int n0) const { const int reg = n0 >> 9; return !(reg == 2 || reg == 5); }
  template <int WMB, int WNB>
  DI void store(int m0w, int n0w, f32x16 (&acc)[WMB][WNB], int r, int h, bool) const {
    const int reg = n0w >> 9, nl = n0w & 511;
    u16* buf = base + (size_t)reg * SEG512;
    const float sc = (reg == 0 || reg == 3) ? QSCALE64 : 1.f;
#pragma unroll
    for (int mb = 0; mb < WMB; ++mb)
#pragma unroll
      for (int nb = 0; nb < WNB; ++nb) store_tok_u(buf + (size_t)(m0w + mb * 32) * 512 + nl + nb * 32, (unsigned)((r * 512 + 4 * h) * 2), acc[mb][nb], sc);
    __builtin_amdgcn_sched_barrier(0);
    if (reg == 3 || reg == 4) {
      static_assert(WNB == 2, "one head per wave tile");
      float mxn = 0.f;
#pragma unroll
      for (int mb = 0; mb < WMB; ++mb) {
        float ss = 0.f;
#pragma unroll
        for (int nb = 0; nb < WNB; ++nb)
#pragma unroll
          for (int i = 0; i < 16; ++i) { const float v = acc[mb][nb][i]; ss += v * v; }
        { const u32x2 sw = __builtin_amdgcn_permlane32_swap(__float_as_uint(ss), __float_as_uint(ss), false, false); ss = __uint_as_float(sw.x) + __uint_as_float(sw.y); }
        mxn = fmaxf(mxn, ss);
      }
      mxn = fmaxf(mxn, __int_as_float(__builtin_amdgcn_ds_swizzle(__float_as_int(mxn), (16 << 10) | 0x1f)));
      mxn = fmaxf(mxn, __int_as_float(__builtin_amdgcn_ds_swizzle(__float_as_int(mxn), (8 << 10) | 0x1f)));
      mxn = fmaxf(mxn, __int_as_float(__builtin_amdgcn_ds_swizzle(__float_as_int(mxn), (4 << 10) | 0x1f)));
      mxn = fmaxf(mxn, __int_as_float(__builtin_amdgcn_ds_swizzle(__float_as_int(mxn), (2 << 10) | 0x1f)));
      mxn = fmaxf(mxn, __int_as_float(__builtin_amdgcn_ds_swizzle(__float_as_int(mxn), (1 << 10) | 0x1f)));
      if (r == 0 && h == 0) atomicMax(qkmax + (reg - 3) * 8 + (nl >> 6), __float_as_uint(sqrtf(mxn) * sc));
    }
  }
  template <int WMB, int WNB>
  DI void store_t(int n0w, int m0w, f32x16 (&acc)[WMB][WNB], int r, int h) const {
    const int reg = n0w >> 9, nl = n0w & 511;
    u16* buf = base + (size_t)reg * SEG512;
#pragma unroll
    for (int mb = 0; mb < WMB; ++mb)
#pragma unroll
      for (int nb = 0; nb < WNB; ++nb) store_tr_u(buf + (size_t)(nl + mb * 32) * T_TOK + m0w + nb * 32, (unsigned)((r * T_TOK + 4 * h) * 2), acc[mb][nb], nullptr);
  }
};

struct EpiSwiGLU {
  u16* act;
  static constexpr int SWAPMODE = 1;
  DI bool swap(int) const { return true; }
  template <int WMB, int WNB>
  DI void store(int m0w, int n0w, f32x16 (&acc)[WMB][WNB], int r, int h, bool) const {
    static_assert(WNB == 2, "swiglu epilogue needs a 64-wide wave tile");
#pragma unroll
    for (int mb = 0; mb < WMB; ++mb) {
      char* q = (char*)(act + (size_t)(m0w + mb * 32) * DFF + (n0w >> 1)) + (unsigned)((r * DFF) * 2) + 16 * h;
#pragma unroll
      for (int pi = 0; pi < 2; ++pi) {
        unsigned pk[2][2];
#pragma unroll
        for (int gg = 0; gg < 2; ++gg) {
          const int g = 2 * pi + gg;
          float y[4];
#pragma unroll
          for (int e = 0; e < 4; ++e) {
            const float gt = acc[mb][0][4 * g + e], up = acc[mb][1][4 * g + e];
            y[e] = gt * __builtin_amdgcn_rcpf(1.f + fexp2(-LOG2E * gt)) * up;
          }
          pk[gg][0] = cvt_pk(y[0], y[1]); pk[gg][1] = cvt_pk(y[2], y[3]);
        }
        const u32x2 s0 = __builtin_amdgcn_permlane32_swap(pk[0][0], pk[1][0], false, false);
        const u32x2 s1 = __builtin_amdgcn_permlane32_swap(pk[0][1], pk[1][1], false, false);
        u32x4 u; u.x = s0.x; u.y = s1.x; u.z = s0.y; u.w = s1.y;
        *(u32x4*)(q + 32 * pi) = u;
      }
      __builtin_amdgcn_sched_barrier(0);
    }
  }
};

struct EpiUQ {
  u16* q; const float* rq; const float2* rope;
  static constexpr int SWAPMODE = 1;
  DI bool swap(int) const { return true; }
  template <int WMB, int WNB>
  DI void store(int m0w, int n0w, f32x16 (&acc)[WMB][WNB], int r, int h, bool) const {
#pragma unroll
    for (int mb = 0; mb < WMB; ++mb) {
      const int m = m0w + mb * 32 + r;
      const float sc = rq[m] * QSCALE96;
      const int pos = tok_pos(m);
#pragma unroll
      for (int nb = 0; nb < WNB; ++nb) {
        const int n0b = n0w + nb * 32;
        f32x16 v = acc[mb][nb];
#pragma unroll
        for (int i = 0; i < 16; ++i) v[i] *= sc;
        if (((n0b >> 5) % 3) == 2) {
#pragma unroll
          for (int i = 0; i < 8; ++i) {
            const int f = (i & 3) + 8 * (i >> 2) + 4 * h;
            const float2 cs = rope[pos * 16 + f];
            const float x1 = v[i], x2 = v[i + 8];
            v[i] = x1 * cs.x - x2 * cs.y;
            v[i + 8] = x2 * cs.x + x1 * cs.y;
          }
        }
        store_tok_u(q + (size_t)(m0w + mb * 32) * 1536 + n0b, (unsigned)((r * 1536 + 4 * h) * 2), v, 1.f);
        __builtin_amdgcn_sched_barrier(0);
      }
    }
  }
};

struct EpiUKV {
  u16* knope; u16* vt; const float* rkv; unsigned* kmax;
  static constexpr int SWAPMODE = 2;
  DI bool swap(int n0) const { return n0 < 1024; }
  template <int WMB, int WNB>
  DI void store(int m0w, int n0w, f32x16 (&acc)[WMB][WNB], int r, int h, bool) const {
#pragma unroll
    for (int mb = 0; mb < WMB; ++mb) {
      const int m = m0w + mb * 32 + r;
      const float sc = rkv[m];
#pragma unroll
      for (int nb = 0; nb < WNB; ++nb) store_tok_u(knope + (size_t)(m0w + mb * 32) * 1024 + n0w + nb * 32, (unsigned)((r * 1024 + 4 * h) * 2), acc[mb][nb], sc);
    }
    __builtin_amdgcn_sched_barrier(0);
    static_assert(WNB == 2, "one head per wave tile");
    float mxn = 0.f;
#pragma unroll
    for (int mb = 0; mb < WMB; ++mb) {
      float ss = 0.f;
#pragma unroll
      for (int nb = 0; nb < WNB; ++nb)
#pragma unroll
        for (int i = 0; i < 16; ++i) { const float v = acc[mb][nb][i]; ss += v * v; }
      { const u32x2 sw = __builtin_amdgcn_permlane32_swap(__float_as_uint(ss), __float_as_uint(ss), false, false); ss = __uint_as_float(sw.x) + __uint_as_float(sw.y); }
      const float sc = rkv[m0w + mb * 32 + r];
      mxn = fmaxf(mxn, ss * sc * sc);
    }
    mxn = fmaxf(mxn, __int_as_float(__builtin_amdgcn_ds_swizzle(__float_as_int(mxn), (16 << 10) | 0x1f)));
    mxn = fmaxf(mxn, __int_as_float(__builtin_amdgcn_ds_swizzle(__float_as_int(mxn), (8 << 10) | 0x1f)));
    mxn = fmaxf(mxn, __int_as_float(__builtin_amdgcn_ds_swizzle(__float_as_int(mxn), (4 << 10) | 0x1f)));
    mxn = fmaxf(mxn, __int_as_float(__builtin_amdgcn_ds_swizzle(__float_as_int(mxn), (2 << 10) | 0x1f)));
    mxn = fmaxf(mxn, __int_as_float(__builtin_amdgcn_ds_swizzle(__float_as_int(mxn), (1 << 10) | 0x1f)));
    if (r == 0 && h == 0) atomicMax(kmax + (n0w >> 6), __float_as_uint(sqrtf(mxn)));
  }
  template <int WMB, int WNB>
  DI void store_t(int n0w, int m0w, f32x16 (&acc)[WMB][WNB], int r, int h) const {
#pragma unroll
    for (int mb = 0; mb < WMB; ++mb)
#pragma unroll
      for (int nb = 0; nb < WNB; ++nb) store_tr_u(vt + (size_t)(n0w - 1024 + mb * 32) * T_TOK + m0w + nb * 32, (unsigned)((r * T_TOK + 4 * h) * 2), acc[mb][nb], rkv + m0w + nb * 32 + 4 * h);
  }
};

template <bool SWAP, int WMB, int WNB>
DI void gemm_compute(const char* la, const char* lb, f32x16 (&acc)[WMB][WNB], int wm, int wn, int r, int h) {
#pragma unroll
  for (int ks = 0; ks < 4; ++ks) {
    bf16x8 af[WMB], bfr[WNB];
#pragma unroll
    for (int mb = 0; mb < WMB; ++mb) af[mb] = *(const bf16x8*)(la + (wm * 32 * WMB + mb * 32 + r) * 144 + (ks * 2 + h) * 16);
#pragma unroll
    for (int nb = 0; nb < WNB; ++nb) bfr[nb] = *(const bf16x8*)(lb + (wn * 32 * WNB + nb * 32 + r) * 144 + (ks * 2 + h) * 16);
#pragma unroll
    for (int mb = 0; mb < WMB; ++mb)
#pragma unroll
      for (int nb = 0; nb < WNB; ++nb) {
        if (SWAP) acc[mb][nb] = MFMA32(bfr[nb], af[mb], acc[mb][nb]);
        else acc[mb][nb] = MFMA32(af[mb], bfr[nb], acc[mb][nb]);
      }
  }
}

struct TileDesc { bool valid; bool normal; int m0, n0, ldp, ldq; unsigned po, qo; const char* P; const char* Q; };

template <class Epi>
DI void gemm_phase(const u16* __restrict__ A, int lda, const u16* __restrict__ Bt, int ldb, int M, int N, int K, const Epi epi, char* lds, int bid, int nblk, const Ctx& p) {
  constexpr int WMB = 4, WNB = 2;
  constexpr int TM = 256, TN = 256;
  constexpr int STAGE = (TM + TN) * 144;
  const int tid = otid(p), lane = tid & 63, w = __builtin_amdgcn_readfirstlane(tid >> 6), wm = w >> 2, wn = w & 3, r = lane & 31, h = lane >> 5;
  const int lrow = tid >> 3, lch = tid & 7;
  const int NT = N / TN, MT = M / TM, tiles = MT * NT, nk = K >> 6;
  const int rounds = (tiles + nblk - 1) / nblk;
  auto desc = [&](int rnd) {
    TileDesc d;
    int tile = rnd * nblk + bid;
    if (nblk == 256) tile = rnd * 256 + (bid & 7) * 32 + (bid >> 3);
    d.valid = rnd < rounds && tile < tiles;
    const int grp = tile / (8 * NT), within = tile - grp * (8 * NT);
    const int nt = within >> 3, mt = grp * 8 + (within & 7);
    d.m0 = mt * TM; d.n0 = nt * TN;
    d.normal = true;
    if constexpr (Epi::SWAPMODE == 2) d.normal = epi.swap(d.n0);
    const char* Ab = (const char*)A + (size_t)d.m0 * lda * 2;
    const char* Bb = (const char*)Bt + (size_t)d.n0 * ldb * 2;
    const unsigned aoff = (unsigned)(lrow * lda * 2 + lch * 16), boff = (unsigned)(lrow * ldb * 2 + lch * 16);
    d.P = d.normal ? Ab : Bb; d.Q = d.normal ? Bb : Ab;
    d.po = d.normal ? aoff : boff; d.qo = d.normal ? boff : aoff;
    d.ldp = d.normal ? lda : ldb; d.ldq = d.normal ? ldb : lda;
    return d;
  };
  u32x4 pa[4], pb[4];
  auto issue = [&](const TileDesc& d, int kt) {
    const char* Pk = d.P + (size_t)kt * 128; asm volatile("" : "+s"(Pk));
    const char* Qk = d.Q + (size_t)kt * 128; asm volatile("" : "+s"(Qk));
#pragma unroll
    for (int j = 0; j < 4; ++j) pa[j] = *(const u32x4*)(Pk + (size_t)j * 128 * d.ldp + d.po);
#pragma unroll
    for (int j = 0; j < 4; ++j) pb[j] = *(const u32x4*)(Qk + (size_t)j * 128 * d.ldq + d.qo);
  };
  auto write_stage = [&](int b) {
    char* wa = lds + b * STAGE;
    char* wb = wa + TM * 144;
#pragma unroll
    for (int j = 0; j < 4; ++j) *(u32x4*)(wa + (lrow + 64 * j) * 144 + lch * 16) = pa[j];
#pragma unroll
    for (int j = 0; j < 4; ++j) *(u32x4*)(wb + (lrow + 64 * j) * 144 + lch * 16) = pb[j];
  };
  TileDesc cur = desc(0);
  if (!cur.valid) return;
  issue(cur, 0);
  for (int rnd = 0;; ++rnd) {
    f32x16 acc[WMB][WNB];
#pragma unroll
    for (int mb = 0; mb < WMB; ++mb)
#pragma unroll
      for (int nb = 0; nb < WNB; ++nb)
#pragma unroll
        for (int i = 0; i < 16; ++i) acc[mb][nb][i] = 0.f;
    write_stage(0);
    if (nk > 1) issue(cur, 1);
    __syncthreads();
    if (w < 4) {
      for (int kt = 0; kt < nk; ++kt) {
        const char* la = lds + (kt & 1) * STAGE;
        if (kt + 1 < nk) write_stage((kt + 1) & 1);
        if (kt + 2 < nk) issue(cur, kt + 2);
        gemm_compute<true, WMB, WNB>(la, la + TM * 144, acc, wm, wn, r, h);
        __syncthreads();
      }
    } else {
      for (int kt = 0; kt < nk; ++kt) {
        const char* la = lds + (kt & 1) * STAGE;
        gemm_compute<true, WMB, WNB>(la, la + TM * 144, acc, wm, wn, r, h);
        if (kt + 1 < nk) write_stage((kt + 1) & 1);
        if (kt + 2 < nk) issue(cur, kt + 2);
        __syncthreads();
      }
    }
    const TileDesc nxt = desc(rnd + 1);
    if (nxt.valid) issue(nxt, 0);
    __builtin_amdgcn_sched_barrier(0);
    int m0 = cur.m0, n0 = cur.n0;
    asm volatile("" : "+s"(m0), "+s"(n0));
    int r2 = r, h2 = h, wm2 = wm, wn2 = wn;
    asm volatile("" : "+v"(r2), "+v"(h2));
    asm volatile("" : "+s"(wm2), "+s"(wn2));
    if constexpr (Epi::SWAPMODE == 2) {
      if (cur.normal) epi.template store<WMB, WNB>(m0 + wm2 * 32 * WMB, n0 + wn2 * 32 * WNB, acc, r2, h2, true);
      else epi.template store_t<WMB, WNB>(n0 + wm2 * 32 * WMB, m0 + wn2 * 32 * WNB, acc, r2, h2);
    } else {
      epi.template store<WMB, WNB>(m0 + wm2 * 32 * WMB, n0 + wn2 * 32 * WNB, acc, r2, h2, true);
    }
    if (!nxt.valid) break;
    cur = nxt;
  }
}

DI void lds_st16_as2x8(char* dst, const u32x4 v) {
  u32x2 a; a.x = v.x; a.y = v.y; u32x2 b; b.x = v.z; b.y = v.w;
  *(u32x2*)dst = a;
  *(u32x2*)(dst + 8) = b;
}
constexpr int ATT_STAGE = 35840;
constexpr float DEFER_THR = 8.f;

template <int DQK>
DI void qk_scores_acc(const char* kl, const bf16x8 (&qf)[DQK / 16], f32x16 (&s)[2], int r, int h) {
  constexpr int KS = DQK * 2 + 16;
#pragma unroll
  for (int kb = 0; kb < 2; ++kb)
#pragma unroll
    for (int ks = 0; ks < DQK / 16; ++ks) {
      const bf16x8 a = *(const bf16x8*)(kl + (32 * kb + r) * KS + (2 * ks + h) * 16);
      s[kb] = MFMA32(a, qf[ks], s[kb]);
    }
}
template <int DQK>
DI void qk_scores_qlds(const char* kl, const char* qsl, f32x16 (&s)[2], int r, int h) {
  constexpr int KS = DQK * 2 + 16;
#pragma unroll
  for (int kb = 0; kb < 2; ++kb) {
#pragma unroll
    for (int ks = 0; ks < DQK / 16; ++ks) {
      const bf16x8 a = *(const bf16x8*)(kl + (32 * kb + r) * KS + (2 * ks + h) * 16);
      const bf16x8 qv = *(const bf16x8*)(qsl + ks * 1024);
      s[kb] = MFMA32(a, qv, s[kb]);
    }
  }
}
template <int DQK>
DI void qk_scores(const char* kl, const bf16x8 (&qf)[DQK / 16], const f32x16& initv, f32x16 (&s)[2], int r, int h) {
  constexpr int KS = DQK * 2 + 16;
#pragma unroll
  for (int kb = 0; kb < 2; ++kb) {
    s[kb] = initv;
#pragma unroll
    for (int ks = 0; ks < DQK / 16; ++ks) {
      const bf16x8 a = *(const bf16x8*)(kl + (32 * kb + r) * KS + (2 * ks + h) * 16);
      s[kb] = MFMA32(a, qf[ks], s[kb]);
    }
  }
}

template <int DV>
DI float softmax_pv(f32x16 (&s)[2], f32x16 (&o)[DV / 32], float& l, bool first, const char* vl, int r, int h) {
  float dret = 0.f;
  float mx = fmaxf(fmaxf(s[0][0], s[0][1]), s[0][2]);
#pragma unroll
  for (int i = 3; i < 15; i += 2) mx = fmaxf(fmaxf(mx, s[0][i]), s[0][i + 1]);
  mx = fmaxf(fmaxf(mx, s[0][15]), s[1][0]);
#pragma unroll
  for (int i = 1; i < 15; i += 2) mx = fmaxf(fmaxf(mx, s[1][i]), s[1][i + 1]);
  mx = fmaxf(mx, s[1][15]);
  const bool need = first || (mx > DEFER_THR);
  if (__any(need)) {
    mx = fmaxf(mx, __shfl_xor(mx, 32));
    float delta;
    if (first) delta = mx;
    else {
      delta = fmaxf(mx, 0.f);
      const float alpha = fexp2(-delta);
      l *= alpha;
#pragma unroll
      for (int d = 0; d < DV / 32; ++d)
#pragma unroll
        for (int i = 0; i < 16; ++i) o[d][i] *= alpha;
    }
#pragma unroll
    for (int kb = 0; kb < 2; ++kb)
#pragma unroll
      for (int i = 0; i < 16; ++i) s[kb][i] -= delta;
    dret = delta;
  }
  float ps = 0.f;
#pragma unroll
  for (int kb = 0; kb < 2; ++kb)
#pragma unroll
    for (int i = 0; i < 16; ++i) { const float e = fexp2(s[kb][i]); s[kb][i] = e; ps += e; }
  l += ps;
  bf16x8 pf[2][2];
#pragma unroll
  for (int kb = 0; kb < 2; ++kb)
#pragma unroll
    for (int st = 0; st < 2; ++st) {
      u32x4 u;
      u.x = cvt_pk(s[kb][8 * st + 0], s[kb][8 * st + 1]); u.y = cvt_pk(s[kb][8 * st + 2], s[kb][8 * st + 3]);
      u.z = cvt_pk(s[kb][8 * st + 4], s[kb][8 * st + 5]); u.w = cvt_pk(s[kb][8 * st + 6], s[kb][8 * st + 7]);
      pf[kb][st] = __builtin_bit_cast(bf16x8, u);
    }
#pragma unroll
  for (int d = 0; d < DV / 32; ++d)
#pragma unroll
    for (int kb = 0; kb < 2; ++kb)
#pragma unroll
      for (int st = 0; st < 2; ++st) {
        const char* vp = vl + (32 * d + r) * 136 + (32 * kb + 16 * st + 4 * h) * 2;
        const u32x2 lo = *(const u32x2*)vp;
        const u32x2 hi = *(const u32x2*)(vp + 16);
        u32x4 u; u.x = lo.x; u.y = lo.y; u.z = hi.x; u.w = hi.y;
        o[d] = MFMA32(__builtin_bit_cast(bf16x8, u), pf[kb][st], o[d]);
      }
  return dret;
}

template <int DV>
DI float softmax_pre(f32x16 (&s)[2], f32x16 (&o)[DV / 32], float& l, bool first) {
  float dret = 0.f;
  float mx = fmaxf(fmaxf(s[0][0], s[0][1]), s[0][2]);
#pragma unroll
  for (int i = 3; i < 15; i += 2) mx = fmaxf(fmaxf(mx, s[0][i]), s[0][i + 1]);
  mx = fmaxf(fmaxf(mx, s[0][15]), s[1][0]);
#pragma unroll
  for (int i = 1; i < 15; i += 2) mx = fmaxf(fmaxf(mx, s[1][i]), s[1][i + 1]);
  mx = fmaxf(mx, s[1][15]);
  const bool need = first || (mx > DEFER_THR);
  if (__any(need)) {
    mx = fmaxf(mx, __shfl_xor(mx, 32));
    float delta;
    if (first) delta = mx;
    else {
      delta = fmaxf(mx, 0.f);
      const float alpha = fexp2(-delta);
      l *= alpha;
#pragma unroll
      for (int d = 0; d < DV / 32; ++d)
#pragma unroll
        for (int i = 0; i < 16; ++i) o[d][i] *= alpha;
    }
#pragma unroll
    for (int kb = 0; kb < 2; ++kb)
#pragma unroll
      for (int i = 0; i < 16; ++i) s[kb][i] -= delta;
    dret = delta;
  }
  return dret;
}
DI void softmax_exp_half(f32x16& s, float& l, bf16x8 (&pf)[2]) {
  float ps = 0.f;
#pragma unroll
  for (int i = 0; i < 16; ++i) { const float e = fexp2(s[i]); s[i] = e; ps += e; }
  l += ps;
#pragma unroll
  for (int st = 0; st < 2; ++st) {
    u32x4 u;
    u.x = cvt_pk(s[8 * st + 0], s[8 * st + 1]); u.y = cvt_pk(s[8 * st + 2], s[8 * st + 3]);
    u.z = cvt_pk(s[8 * st + 4], s[8 * st + 5]); u.w = cvt_pk(s[8 * st + 6], s[8 * st + 7]);
    pf[st] = __builtin_bit_cast(bf16x8, u);
  }
}
template <int DV>
DI void pv_half(const bf16x8 (&pf)[2], f32x16 (&o)[DV / 32], const char* vl, int kb, int r, int h) {
#pragma unroll
  for (int d = 0; d < DV / 32; ++d)
#pragma unroll
    for (int st = 0; st < 2; ++st) {
      const char* vp = vl + (32 * d + r) * 136 + (32 * kb + 16 * st + 4 * h) * 2;
      const u32x2 lo = *(const u32x2*)vp;
      const u32x2 hi = *(const u32x2*)(vp + 16);
      u32x4 u; u.x = lo.x; u.y = lo.y; u.z = hi.x; u.w = hi.y;
      o[d] = MFMA32(__builtin_bit_cast(bf16x8, u), pf[st], o[d]);
    }
}

template <int ABL>
DI void attn_mla_item(const Ctx& p, int item, char* lds) {
  constexpr int DQK = 96, DV = 64, KS = DQK * 2 + 16;
  const int tid = otid(p), lane = tid & 63, w = tid >> 6, r = lane & 31, h = lane >> 5;
  int head, qb, ts0, S;
  if (item < 1024) { head = item >> 6; qb = item & 63; ts0 = T_PROMPT; S = 16384; }
  else { const int it = item - 1024; qb = it & 15; head = (it >> 4) & 15; ts0 = (it >> 8) * 4096; S = 4096; }
  const u16* q = (const u16*)(p.ws + OFF_R2);
  const u16* knope = q + (size_t)T_TOK * 1536;
  const u16* vt = knope + (size_t)T_TOK * 1024;
  const u16* krope = (const u16*)(p.ws + OFF_KROPE);
  u16* o1 = (u16*)(p.ws + OFF_R1);
  const int tq = ts0 + qb * 256 + w * 32 + r;
  bf16x8 qf[DQK / 16];
#pragma unroll
  for (int ks = 0; ks < DQK / 16; ++ks) qf[ks] = *(const bf16x8*)(q + (size_t)tq * 1536 + head * 96 + 16 * ks + 8 * h);
  f32x16 o[DV / 32];
#pragma unroll
  for (int d = 0; d < DV / 32; ++d)
#pragma unroll
    for (int i = 0; i < 16; ++i) o[d][i] = 0.f;
  f32x16 initv;
#pragma unroll
  for (int i = 0; i < 16; ++i) initv[i] = 0.f;
  float l = 0.f;
  u32x4 pk0, pk1, pv0;
  const int c1 = 512 + tid;
  const int krow0 = tid / 12, kch0 = tid - krow0 * 12;
  const int krow1 = c1 / 12, kch1 = c1 - krow1 * 12;
  const int vrow = tid >> 3, vch = tid & 7;
  const int nkt = S >> 6;
  auto prefetch = [&](int kt) {
    const int tk0 = ts0 + kt * 64;
    {
      const u16* src = kch0 < 8 ? knope + (size_t)(tk0 + krow0) * 1024 + head * 64 + kch0 * 8 : krope + (size_t)(tk0 + krow0) * 32 + (kch0 - 8) * 8;
      pk0 = *(const u32x4*)src;
    }
    if (tid < 256) {
      const u16* src = kch1 < 8 ? knope + (size_t)(tk0 + krow1) * 1024 + head * 64 + kch1 * 8 : krope + (size_t)(tk0 + krow1) * 32 + (kch1 - 8) * 8;
      pk1 = *(const u32x4*)src;
    }
    pv0 = *(const u32x4*)(vt + (size_t)(head * 64 + vrow) * T_TOK + tk0 + vch * 8);
  };
  auto stage_at = [&](int boff) {
    char* kl = lds + boff;
    char* vl = kl + 64 * KS;
    *(u32x4*)(kl + krow0 * KS + kch0 * 16) = pk0;
    if (tid < 256) *(u32x4*)(kl + krow1 * KS + kch1 * 16) = pk1;
    lds_st16_as2x8(vl + vrow * 136 + vch * 16, pv0);
  };
  prefetch(0);
  __syncthreads();
  stage_at(0);
  prefetch(1);
  stage_at(ATT_STAGE);
  if (nkt > 2) prefetch(2);
  __syncthreads();
  int cur = 0, nxt = ATT_STAGE, nn = 2 * ATT_STAGE;
  f32x16 s[2];
  qk_scores<DQK>(lds, qf, initv, s, r, h);
#pragma unroll 1
  for (int kt = 0; kt < nkt; ++kt) {
    if (ABL == 2) { __syncthreads(); if (kt + 2 < nkt) stage_at(nn); if (kt + 3 < nkt) prefetch(kt + 3); { const int t = cur; cur = nxt; nxt = nn; nn = t; } continue; }
    const float dl = softmax_pre<DV>(s, o, l, kt == 0);
    if (__any(dl != 0.f)) {
#pragma unroll
      for (int i = 0; i < 16; ++i) initv[i] -= dl;
    }
    f32x16 sn[2];
    qk_scores<DQK>(lds + nxt, qf, initv, sn, r, h);
#pragma unroll
    for (int kb = 0; kb < 2; ++kb) {
      bf16x8 pf[2];
      softmax_exp_half(s[kb], l, pf);
      pv_half<DV>(pf, o, lds + cur + 64 * KS, kb, r, h);
    }
    if (ABL != 1) { if (kt + 2 < nkt) stage_at(nn);
    if (kt + 3 < nkt) prefetch(kt + 3); }
    __syncthreads();
    s[0] = sn[0]; s[1] = sn[1];
    const int t = cur; cur = nxt; nxt = nn; nn = t;
  }
  l += __shfl_xor(l, 32);
  const float inv = 1.f / l;
#pragma unroll
  for (int d = 0; d < DV / 32; ++d) store_tok(o1, 1024, tq, head * 64 + 32 * d + 4 * h, o[d], inv);
}

DI void attn_mla_item2(const Ctx& p, int item, char* lds) {
  constexpr int DQK = 96, DV = 64, KS = DQK * 2 + 16;
  const int tid = otid(p), lane = tid & 63, w = tid >> 6, r = lane & 31, h = lane >> 5;
  int head, qb, ts0, S;
  if (item < 512) { head = item >> 5; qb = item & 31; ts0 = T_PROMPT; S = 16384; }
  else { const int it = item - 512; qb = it & 7; head = (it >> 3) & 15; ts0 = (it >> 7) * 4096; S = 4096; }
  const u16* q = (const u16*)(p.ws + OFF_R2);
  const u16* knope = q + (size_t)T_TOK * 1536;
  const u16* vt = knope + (size_t)T_TOK * 1024;
  const u16* krope = (const u16*)(p.ws + OFF_KROPE);
  u16* o1 = (u16*)(p.ws + OFF_R1);
  const int tq0 = ts0 + qb * 512 + w * 64 + r;
  char* qsl = lds + 49152 + w * 12288 + lane * 16;
  __syncthreads();
  float qn2[2] = {0.f, 0.f};
#pragma unroll
  for (int j = 0; j < 2; ++j)
#pragma unroll
    for (int ks = 0; ks < DQK / 16; ++ks) {
      const u32x4 qv = *(const u32x4*)(q + (size_t)(tq0 + 32 * j) * 1536 + head * 96 + 16 * ks + 8 * h);
      *(u32x4*)(qsl + (j * 6 + ks) * 1024) = qv;
      float a;
      a = bflo(qv.x); qn2[j] += a * a; a = bfhi(qv.x); qn2[j] += a * a; a = bflo(qv.y); qn2[j] += a * a; a = bfhi(qv.y); qn2[j] += a * a;
      a = bflo(qv.z); qn2[j] += a * a; a = bfhi(qv.z); qn2[j] += a * a; a = bflo(qv.w); qn2[j] += a * a; a = bfhi(qv.w); qn2[j] += a * a;
    }
  float ref[2];
  {
    const float kn = __uint_as_float(((const unsigned*)(p.ws + OFF_SCAL))[SC_KMAX1 + head]);
    const float kr = __uint_as_float(((const unsigned*)(p.ws + OFF_SCAL))[SC_KRMAX]);
    const float kmaxn = sqrtf(kn * kn + kr * kr);
#pragma unroll
    for (int j = 0; j < 2; ++j) {
      qn2[j] += __shfl_xor(qn2[j], 32);
      ref[j] = sqrtf(qn2[j]) * kmaxn * 1.02f + 0.5f;
    }
  }
  const bool fixedref = !__any(ref[0] > 60.f || ref[1] > 60.f);
  f32x16 o[2][DV / 32];
  f32x16 initv[2];
#pragma unroll
  for (int j = 0; j < 2; ++j) {
#pragma unroll
    for (int d = 0; d < DV / 32; ++d)
#pragma unroll
      for (int i = 0; i < 16; ++i) o[j][d][i] = 0.f;
#pragma unroll
    for (int i = 0; i < 16; ++i) initv[j][i] = fixedref ? -ref[j] : 0.f;
  }
  float l[2] = {0.f, 0.f};
  u32x4 pk0, pk1, pv0;
  const int c1 = 512 + (tid & 255);
  const int krow0 = tid / 12, kch0 = tid - krow0 * 12;
  const int krow1 = c1 / 12, kch1 = c1 - krow1 * 12;
  const int vrow = tid >> 3, vch = tid & 7;
  const int nkt = S >> 6;
  auto prefetch = [&](int kt) {
    const int tk0 = ts0 + kt * 64;
    {
      const u16* src = kch0 < 8 ? knope + (size_t)(tk0 + krow0) * 1024 + head * 64 + kch0 * 8 : krope + (size_t)(tk0 + krow0) * 32 + (kch0 - 8) * 8;
      pk0 = *(const u32x4*)src;
    }
    {
      const u16* src = kch1 < 8 ? knope + (size_t)(tk0 + krow1) * 1024 + head * 64 + kch1 * 8 : krope + (size_t)(tk0 + krow1) * 32 + (kch1 - 8) * 8;
      pk1 = *(const u32x4*)src;
    }
    pv0 = *(const u32x4*)(vt + (size_t)(head * 64 + vrow) * T_TOK + tk0 + vch * 8);
  };
  auto stage_at = [&](int boff) {
    char* kl = lds + boff;
    char* vl = kl + 64 * KS;
    *(u32x4*)(kl + krow0 * KS + kch0 * 16) = pk0;
    *(u32x4*)(kl + krow1 * KS + kch1 * 16) = pk1;
    lds_st16_as2x8(vl + vrow * 136 + vch * 16, pv0);
  };
  prefetch(0);
  stage_at(0);
  prefetch(1);
  __syncthreads();
#pragma unroll 1
  for (int kt = 0; kt < nkt; ++kt) {
    const char* kl = lds + (kt & 1) * 24576;
    const char* vl = kl + 64 * KS;
    if (kt + 1 < nkt) stage_at(((kt + 1) & 1) * 24576);
    if (kt + 2 < nkt) prefetch(kt + 2);
    f32x16 s[2][2];
#pragma unroll
    for (int kb = 0; kb < 2; ++kb) {
      s[0][kb] = initv[0]; s[1][kb] = initv[1];
#pragma unroll
      for (int ks = 0; ks < DQK / 16; ++ks) {
        const bf16x8 a = *(const bf16x8*)(kl + (32 * kb + r) * KS + (2 * ks + h) * 16);
        const bf16x8 q0 = *(const bf16x8*)(qsl + ks * 1024);
        const bf16x8 q1 = *(const bf16x8*)(qsl + (6 + ks) * 1024);
        s[0][kb] = MFMA32(a, q0, s[0][kb]);
        s[1][kb] = MFMA32(a, q1, s[1][kb]);
      }
    }
    if (!fixedref) {
#pragma unroll
      for (int j = 0; j < 2; ++j) {
        const float dl = softmax_pre<DV>(s[j], o[j], l[j], kt == 0);
        if (__any(dl != 0.f)) {
#pragma unroll
          for (int i = 0; i < 16; ++i) initv[j][i] -= dl;
        }
      }
    }
#pragma unroll
    for (int kb = 0; kb < 2; ++kb) {
      bf16x8 pf0[2], pf1[2];
      softmax_exp_half(s[0][kb], l[0], pf0);
      softmax_exp_half(s[1][kb], l[1], pf1);
#pragma unroll
      for (int d = 0; d < DV / 32; ++d)
#pragma unroll
        for (int st = 0; st < 2; ++st) {
          const char* vp = vl + (32 * d + r) * 136 + (32 * kb + 16 * st + 4 * h) * 2;
          const u32x2 lo = *(const u32x2*)vp;
          const u32x2 hi = *(const u32x2*)(vp + 16);
          u32x4 u; u.x = lo.x; u.y = lo.y; u.z = hi.x; u.w = hi.y;
          const bf16x8 vf = __builtin_bit_cast(bf16x8, u);
          o[0][d] = MFMA32(vf, pf0[st], o[0][d]);
          o[1][d] = MFMA32(vf, pf1[st], o[1][d]);
        }
    }
    __syncthreads();
  }
  int tid2 = otid(p);
  const int lane2 = tid2 & 63, h2 = lane2 >> 5, w2 = tid2 >> 6;
  int item2 = item; asm volatile("" : "+s"(item2));
  int head2, tq2;
  if (item2 < 512) { head2 = item2 >> 5; tq2 = T_PROMPT + (item2 & 31) * 512 + w2 * 64 + (lane2 & 31); }
  else { const int it = item2 - 512; head2 = (it >> 3) & 15; tq2 = (it >> 7) * 4096 + (it & 7) * 512 + w2 * 64 + (lane2 & 31); }
#pragma unroll
  for (int j = 0; j < 2; ++j) {
    float lj = l[j];
    lj += __shfl_xor(lj, 32);
    const float inv = __builtin_amdgcn_rcpf(lj);
#pragma unroll
    for (int d = 0; d < DV / 32; ++d) store_tok(o1, 1024, tq2 + 32 * j, head2 * 64 + 32 * d + 4 * h2, o[j][d], inv);
  }
}

DI void diff_decode(int item, int& hh, int& qb, int& ts0, int& S) {
  int j;
  if (item < 128) { hh = 3; j = item; S = 16384; }
  else if (item < 256) { hh = 2; j = item - 128; S = 16384; }
  else if (item < 768) { hh = 3; j = item - 256; S = 4096; }
  else if (item < 1280) { hh = 2; j = item - 768; S = 4096; }
  else if (item < 1408) { hh = 1; j = item - 1280; S = 16384; }
  else if (item < 1920) { hh = 1; j = item - 1408; S = 4096; }
  else if (item < 2048) { hh = 0; j = item - 1920; S = 16384; }
  else { hh = 0; j = item - 2048; S = 4096; }
  if (S == 16384) { qb = j; ts0 = T_PROMPT; } else { qb = j & 31; ts0 = (j >> 5) * 4096; }
}
DI void attn_diff_item(const Ctx& p, int item, char* lds) {
  constexpr int DQK = 64, DV = 128, KS = DQK * 2 + 16;
  const int tid = otid(p), lane = tid & 63, w = tid >> 6, r = lane & 31, h = lane >> 5;
  const int map = w >> 2, qw = w & 3;
  int hh, qb, ts0, S;
  diff_decode(item, hh, qb, ts0, S);
  const u16* base = (const u16*)(p.ws + OFF_R2);
  const u16* dq = base + 3 * SEG512;
  const u16* dk = base + 4 * SEG512;
  const u16* vtd = base + 5 * SEG512;
  u16* o0 = (u16*)(p.ws + OFF_R1);
  const int qpos = qb * 128 + qw * 32 + r;
  const int tq = ts0 + qpos;
  __syncthreads();
  float qn2 = 0.f;
  bf16x8 qf[DQK / 16];
#pragma unroll
  for (int ks = 0; ks < DQK / 16; ++ks) {
    const u32x4 qv = *(const u32x4*)(dq + (size_t)tq * 512 + (2 * hh + map) * 64 + 16 * ks + 8 * h);
    qf[ks] = __builtin_bit_cast(bf16x8, qv);
    float a;
    a = bflo(qv.x); qn2 += a * a; a = bfhi(qv.x); qn2 += a * a; a = bflo(qv.y); qn2 += a * a; a = bfhi(qv.y); qn2 += a * a;
    a = bflo(qv.z); qn2 += a * a; a = bfhi(qv.z); qn2 += a * a; a = bflo(qv.w); qn2 += a * a; a = bfhi(qv.w); qn2 += a * a;
  }
  qn2 += __shfl_xor(qn2, 32);
  f32x16 o[DV / 32];
#pragma unroll
  for (int d = 0; d < DV / 32; ++d)
#pragma unroll
    for (int i = 0; i < 16; ++i) o[d][i] = 0.f;
  float l = 0.f;
  const float refb = sqrtf(qn2) * __uint_as_float(((const unsigned*)(p.ws + OFF_SCAL))[SC_QKMAX + 8 + 2 * hh + map]) * 1.02f + 0.5f;
  const bool fixedref = !__any(refb > 60.f);
  float ref = fixedref ? refb : 0.f;
  const float slope2 = exp2f(-2.f * (float)(hh + 1)) * LOG2E;
  const float cq = slope2 * (float)qpos;
  const int d0 = 2 * qb;
  const int kd = d0 + (qw >> 1);
  int kt_lo, kt_hi;
  {
    const unsigned* qk = (const unsigned*)(p.ws + OFF_SCAL) + SC_QKMAX;
    const float b0 = __uint_as_float(qk[2 * hh]) * __uint_as_float(qk[8 + 2 * hh]);
    const float b1 = __uint_as_float(qk[2 * hh + 1]) * __uint_as_float(qk[8 + 2 * hh + 1]);
    const float B = fmaxf(b0, b1) * 1.02f + 0.5f;
    const float dskip = fminf((2.f * B + 34.f) / slope2 + 1.f, 1.0e6f);
    const int q_lo = qb * 128, q_hi = q_lo + 127, ds = (int)dskip;
    kt_lo = max(0, (q_lo - 63 - ds) >> 6);
    kt_hi = min((S >> 6) - 1, (q_hi + ds) >> 6);
    kt_lo = min(kt_lo, 2 * qb); kt_hi = max(kt_hi, 2 * qb + 1);
  }
  const int nleft = d0 - kt_lo;
  const int nkt = kt_hi - kt_lo + 1;
  u32x4 pk[2], pv[2];
  const int lrow = tid >> 3, lch = tid & 7;
  auto tile_of = [&](int idx) { return idx < 2 ? d0 + idx : (idx - 2 < nleft ? d0 - 1 - (idx - 2) : idx + kt_lo); };
  const unsigned koff = (unsigned)(((ts0 + lrow) * 512 + 2 * hh * 64 + lch * 8) * 2);
  const unsigned voff = (unsigned)((((hh * 128 + lrow) * T_TOK) + ts0 + lch * 8) * 2);
  const char* dkb = (const char*)dk;
  const char* vtb = (const char*)vtd;
  auto prefetch = [&](int kt) {
    const unsigned ko = koff + (unsigned)kt * (64u * 512u * 2u);
    const unsigned vo = voff + (unsigned)kt * 128u;
    pk[0] = *(const u32x4*)(dkb + ko);
    pk[1] = *(const u32x4*)(dkb + ko + 128u);
    pv[0] = *(const u32x4*)(vtb + vo);
    pv[1] = *(const u32x4*)(vtb + vo + (unsigned)(64 * T_TOK * 2));
  };
  auto stage_at = [&](int boff) {
    char* kl0 = lds + boff;
    char* vl = kl0 + 2 * 64 * KS;
#pragma unroll
    for (int j = 0; j < 2; ++j) *(u32x4*)(kl0 + j * 64 * KS + lrow * KS + lch * 16) = pk[j];
#pragma unroll
    for (int j = 0; j < 2; ++j) lds_st16_as2x8(vl + (lrow + 64 * j) * 136 + lch * 16, pv[j]);
  };
  auto scores = [&](int kt, int boff, f32x16 (&sc)[2]) {
    const int side = kt < kd ? -1 : (kt > kd ? 1 : 0);
    const float I = (float)side * cq - ref;
    const unsigned i_hi = cvt_pk(I, 0.f) & 0xffffu;
    const float ir1 = I - __uint_as_float(i_hi << 16);
    const unsigned i_mid = cvt_pk(ir1, 0.f) & 0xffffu;
    const float ir2 = ir1 - __uint_as_float(i_mid << 16);
    const unsigned i_lo = cvt_pk(ir2, 0.f) & 0xffffu;
    const float T = slope2 * (float)(kt * 64);
    const unsigned t_hi = cvt_pk(T, 0.f) & 0xffffu;
    const float r1 = T - __uint_as_float(t_hi << 16);
    const unsigned t_mid = cvt_pk(r1, 0.f) & 0xffffu;
    const float r2 = r1 - __uint_as_float(t_mid << 16);
    const unsigned t_lo = cvt_pk(r2, 0.f) & 0xffffu;
    const unsigned one = side < 0 ? 0x3F80u : (side > 0 ? 0xBF80u : 0u);
    u32x4 qa;
    qa.x = h == 0 ? (one | (one << 16)) : 0u; qa.y = qa.x; qa.z = h == 0 ? (one | (i_hi << 16)) : 0u; qa.w = h == 0 ? (i_mid | (i_lo << 16)) : 0u;
    const bf16x8 qaug = __builtin_bit_cast(bf16x8, qa);
#pragma unroll
    for (int kb = 0; kb < 2; ++kb) {
      const float xl = slope2 * (float)(32 * kb + r);
      const unsigned l_hi = cvt_pk(xl, 0.f) & 0xffffu;
      const unsigned l_lo = cvt_pk(xl - __uint_as_float(l_hi << 16), 0.f) & 0xffffu;
      u32x4 ka; ka.x = h == 0 ? (l_hi | (l_lo << 16)) : 0u; ka.y = h == 0 ? (t_hi | (t_mid << 16)) : 0u; ka.z = h == 0 ? (t_lo | 0x3F800000u) : 0u; ka.w = h == 0 ? 0x3F803F80u : 0u;
      f32x16 z;
#pragma unroll
      for (int i = 0; i < 16; ++i) z[i] = 0.f;
      sc[kb] = MFMA32(__builtin_bit_cast(bf16x8, ka), qaug, z);
    }
    qk_scores_acc<DQK>(lds + boff + map * 64 * KS, qf, sc, r, h);
  };
  prefetch(tile_of(0));
  __syncthreads();
  stage_at(0);
  prefetch(tile_of(1));
  __syncthreads();
#pragma unroll 1
  for (int idx = 0; idx < nkt; ++idx) {
    const int kt = tile_of(idx);
    const int cur = (idx & 1) * ATT_STAGE;
    if (idx + 1 < nkt) stage_at(((idx + 1) & 1) * ATT_STAGE);
    if (idx + 2 < nkt) prefetch(tile_of(idx + 2));
    f32x16 s[2];
    scores(kt, cur, s);
    if (kt == kd) {
#pragma unroll
      for (int kb = 0; kb < 2; ++kb)
#pragma unroll
        for (int i = 0; i < 16; ++i) {
          const int kp = kt * 64 + 32 * kb + (i & 3) + 8 * (i >> 2) + 4 * h;
          s[kb][i] -= slope2 * fabsf((float)(qpos - kp));
        }
    }
    if (!fixedref) ref += softmax_pre<DV>(s, o, l, idx == 0);
#pragma unroll
    for (int kb = 0; kb < 2; ++kb) {
      bf16x8 pf[2];
      softmax_exp_half(s[kb], l, pf);
      pv_half<DV>(pf, o, lds + cur + 2 * 64 * KS, kb, r, h);
    }
    __syncthreads();
  }
  l += __shfl_xor(l, 32);
  const float inv = 1.f / l;
  int tid2 = otid(p);
  const int lane2 = tid2 & 63, qw2 = (tid2 >> 6) & 3, h2 = lane2 >> 5;
  int item2 = item; asm volatile("" : "+s"(item2));
  int hh2, tq2;
  { int qb2, ts02, S2; diff_decode(item2, hh2, qb2, ts02, S2); tq2 = ts02 + qb2 * 128 + qw2 * 32 + (lane2 & 31); }
  float* ex = (float*)lds + qw2 * 4096;
  if (map == 1) {
#pragma unroll
    for (int d = 0; d < DV / 32; ++d)
#pragma unroll
      for (int i = 0; i < 16; ++i) ex[(d * 16 + i) * 64 + lane2] = o[d][i] * inv;
  }
  __syncthreads();
  if (map == 0) {
    const float lam = ((const float*)(p.ws + OFF_SCAL))[0];
    float ss = 0.f;
#pragma unroll
    for (int d = 0; d < DV / 32; ++d)
#pragma unroll
      for (int i = 0; i < 16; ++i) { const float v = o[d][i] * inv - lam * ex[(d * 16 + i) * 64 + lane2]; o[d][i] = v; ss += v * v; }
    ss += __shfl_xor(ss, 32);
    const float rn = rsqrtf(ss * (1.f / 128.f) + EPS) * 0.8f;
    const float* gs = (const float*)(p.ws + OFF_SCAL) + SC_GSUB;
#pragma unroll
    for (int d = 0; d < DV / 32; ++d) {
#pragma unroll
      for (int g = 0; g < 4; ++g) {
        const float4 gv = *(const float4*)(gs + 32 * d + 8 * g + 4 * h2);
        o[d][4 * g] *= gv.x; o[d][4 * g + 1] *= gv.y; o[d][4 * g + 2] *= gv.z; o[d][4 * g + 3] *= gv.w;
      }
      store_tok(o0, 1024, tq2, 512 + hh2 * 128 + 32 * d + 4 * h2, o[d], rn);
    }
  }
}

DI void attn_na_item(const Ctx& p, int item, char* lds) {
  constexpr int DQK = 64, DV = 64, KS = DQK * 2 + 16;
  const int tid = otid(p), lane = tid & 63, w = tid >> 6, r = lane & 31, h = lane >> 5;
  const int quad = item % 320, head = item / 320;
  const int t0 = quad * 256;
  int ts0, rows;
  if (t0 < T_PROMPT) { ts0 = t0 & ~4095; rows = 64; } else { ts0 = T_PROMPT; rows = 256; }
  const int r0 = (t0 - ts0) >> 6;
  const int rw = r0 + (w >> 1);
  const int rs_lo = min(max(r0 - 4, 0), rows - 8);
  const int rs_hi = min(max(r0 + 3 - 4, 0), rows - 8);
  const int rs_w = min(max(rw - 4, 0), rows - 8);
  const int ntile = rs_hi + 8 - rs_lo;
  const u16* base = (const u16*)(p.ws + OFF_R2);
  const u16* qn = base;
  const u16* kn = base + SEG512;
  const u16* vtn = base + 2 * SEG512;
  u16* o0 = (u16*)(p.ws + OFF_R1);
  float* tab = (float*)(lds + 2 * ATT_STAGE) + 64;
  const int qc = (w & 1) * 32 + r;
  const int tq = t0 + w * 32 + r;
  bf16x8 qf[DQK / 16];
#pragma unroll
  for (int ks = 0; ks < DQK / 16; ++ks) qf[ks] = *(const bf16x8*)(qn + (size_t)tq * 512 + head * 64 + 16 * ks + 8 * h);
  f32x16 o[DV / 32];
#pragma unroll
  for (int d = 0; d < DV / 32; ++d)
#pragma unroll
    for (int i = 0; i < 16; ++i) o[d][i] = 0.f;
  f32x16 initv;
#pragma unroll
  for (int i = 0; i < 16; ++i) initv[i] = 0.f;
  float l = 0.f;
  bool first = true;
  u32x4 pk0, pv0;
  const int lrow = tid >> 3, lch = tid & 7;
  auto prefetch = [&](int j) {
    const int tk0 = ts0 + (rs_lo + j) * 64;
    pk0 = *(const u32x4*)(kn + (size_t)(tk0 + lrow) * 512 + head * 64 + lch * 8);
    pv0 = *(const u32x4*)(vtn + (size_t)(head * 64 + lrow) * T_TOK + tk0 + lch * 8);
  };
  auto stage = [&](int b) {
    char* kl = lds + b * ATT_STAGE;
    char* vl = kl + 64 * KS;
    *(u32x4*)(kl + lrow * KS + lch * 16) = pk0;
    lds_st16_as2x8(vl + lrow * 136 + lch * 16, pv0);
  };
  prefetch(0);
  __syncthreads();
  if (tid < 465) tab[tid] = ((const float*)(p.ws + OFF_SCAL))[SC_RPB + head * 465 + tid];
  stage(0);
  prefetch(1);
  __syncthreads();
  const int wc0 = min(max(qc - 8, 0), 48);
  const float* tabq = tab + (15 - qc + 4 * h);
  for (int j = 0; j < ntile; ++j) {
    const char* kl = lds + (j & 1) * ATT_STAGE;
    const char* vl = kl + 64 * KS;
    const int kr = rs_lo + j;
    if (kr >= rs_w && kr < rs_w + 8) {
      f32x16 s[2];
      qk_scores<DQK>(kl, qf, initv, s, r, h);
      const int ridx = kr - rw + 7;
#pragma unroll
      for (int kb = 0; kb < 2; ++kb)
#pragma unroll
        for (int i = 0; i < 16; ++i) {
          const int kc = 32 * kb + (i & 3) + 8 * (i >> 2) + 4 * h;
          const bool ok = (unsigned)(kc - wc0) < 16u;
          float b = tabq[ridx * 31 + 32 * kb + (i & 3) + 8 * (i >> 2)];
          asm volatile("" : "+v"(b));
          s[kb][i] = ok ? s[kb][i] + b : -INFINITY;
        }
      {
        const float dl = softmax_pv<DV>(s, o, l, first, vl, r, h);
        if (__any(dl != 0.f)) {
#pragma unroll
          for (int i = 0; i < 16; ++i) initv[i] -= dl;
        }
      }
      first = false;
    }
    if (j + 1 < ntile) stage((j + 1) & 1);
    if (j + 2 < ntile) prefetch(j + 2);
    __syncthreads();
  }
  l += __shfl_xor(l, 32);
  const float inv = 1.f / l;
#pragma unroll
  for (int d = 0; d < DV / 32; ++d) store_tok(o0, 1024, tq, head * 64 + 32 * d + 4 * h, o[d], inv);
}

namespace pg8 {
#define PG8_LAS __attribute__((address_space(3)))
typedef unsigned short bf16_t;
typedef short bf16x8 __attribute__((ext_vector_type(8)));
typedef float f32x4 __attribute__((ext_vector_type(4)));
typedef unsigned u32x4 __attribute__((ext_vector_type(4)));
constexpr int BM = 256, BK = 64, HALF = 128, HTB = HALF * BK * 2  , STAGE_BYTES = 8 * HTB, NXCD = 8, WGM = 8;

__host__ __device__ __forceinline__ int lds_byte(int r, int c) { const int st = (r >> 4) * 2 + (c >> 5), rr = r & 15, cc = c & 31, ob = rr * 64 + cc * 2; return st * 1024 + (ob ^ (((ob >> 9) & 1) << 5)); }
__host__ __device__ __forceinline__ void stage_rc(int b, int& R, int& C) { const int st = b / 1024, sb = b % 1024, swz = sb ^ (((sb >> 9) & 1) << 5); R = (st >> 1) * 16 + swz / 64; C = (st & 1) * 32 + (swz % 64) / 2; }
__host__ __device__ __forceinline__ int perm32(int rho) { const int n = rho >> 4, i = rho & 15; return 8 * (i >> 2) + 4 * n + (i & 3); }

struct Unit { int pm, pn; };
struct Gemm { const bf16_t* A; const bf16_t* Bt; int M, N, K; };

struct StaticOrder {
    int nM, nN, nwg, G, c;
    __host__ __device__ void init(int M, int N, int G_, int c_) { nM = M / BM; nN = N / BM; nwg = nM * nN; G = G_; c = c_; }
    __host__ __device__ bool next(int i, Unit& u) const {
        const long L = (long)i * G + c; if (L >= nwg) return false;
        int wgid = (int)L; { const int q = nwg / NXCD, r = nwg % NXCD, xcd = wgid % NXCD, off = wgid / NXCD; wgid = (xcd < r ? xcd * (q + 1) : r * (q + 1) + (xcd - r) * q) + off; }
        const int nig = WGM * nN, gid = wgid / nig, fm = gid * WGM, gsz = (nM - fm) < WGM ? (nM - fm) : WGM;
        u.pm = fm + ((wgid % nig) % gsz); u.pn = (wgid % nig) / gsz; return true;
    }
    __device__ __forceinline__ void a_ready(const Unit&) const {}
    __device__ __forceinline__ void done(const Unit&) const {}
};
struct CountedOrder : StaticOrder {
    const unsigned* ready; unsigned need; unsigned* tmo;
    __device__ __forceinline__ void a_ready(const Unit& u) const {
        if (threadIdx.x < 64) {
            const unsigned long long t0 = __builtin_amdgcn_s_memrealtime(); unsigned polls = 0;
            while ((unsigned)__builtin_amdgcn_readfirstlane(__hip_atomic_load(ready + 64 * u.pm, __ATOMIC_RELAXED, __HIP_MEMORY_SCOPE_AGENT)) < need) {
                if ((++polls & 255u) == 0u && __builtin_amdgcn_readfirstlane(__hip_atomic_load(tmo, __ATOMIC_RELAXED, __HIP_MEMORY_SCOPE_AGENT)) != 0u) break;
                if (__builtin_amdgcn_s_memrealtime() - t0 > 2000000ull) {
                    if (threadIdx.x == 0) { unsigned expect = 0u; __hip_atomic_compare_exchange_strong(tmo + 1, &expect, 0x600u | (unsigned)(u.pm & 0xff), __ATOMIC_RELAXED, __ATOMIC_RELAXED, __HIP_MEMORY_SCOPE_AGENT); __hip_atomic_store(tmo, 1u, __ATOMIC_RELAXED, __HIP_MEMORY_SCOPE_AGENT); }
                    break; }
                __builtin_amdgcn_s_sleep(2); }
            __builtin_amdgcn_fence(__ATOMIC_ACQUIRE, "agent");
            asm volatile("s_waitcnt vmcnt(0)" ::: "memory");
        }
#if !defined(BROKEN_HOOK_NO_BARRIER)
        asm volatile("" ::: "memory"); __builtin_amdgcn_s_barrier(); asm volatile("" ::: "memory");
#endif
    }
};

__device__ __forceinline__ unsigned cvt_pk_bf16(float lo, float hi) { unsigned r; asm volatile("v_cvt_pk_bf16_f32 %0, %1, %2" : "=v"(r) : "v"(lo), "v"(hi)); return r; }
typedef float f32x2 __attribute__((ext_vector_type(2)));
__device__ __forceinline__ f32x2 gelu_pk(f32x2 v) {
    const f32x2 av = __builtin_elementwise_abs(v), d = av * 0.2316418882f + 1.0f;
    f32x2 t; t.x = __builtin_amdgcn_rcpf(d.x); t.y = __builtin_amdgcn_rcpf(d.y);
    f32x2 q = t * 0.5307027145f + (-0.7265760135f); q = q * t + 0.7107068705f; q = q * t + (-0.142248368f); q = q * t + 0.127414796f; q = q * t;
    const f32x2 s = (v * v) * (-0.72134752044f);
    f32x2 e; e.x = __builtin_amdgcn_exp2f(s.x); e.y = __builtin_amdgcn_exp2f(s.y);
    const f32x2 m = v * (q * e), r = v - m;
    f32x2 o; o.x = v.x < 0.f ? m.x : r.x; o.y = v.y < 0.f ? m.y : r.y; return o;
}

struct EpiF32 {
    static constexpr bool PERM = false, AFTER_DRAIN = false;
    float* C; int ldc; const float* bias;
    __device__ __forceinline__ void operator()(const f32x4 (&acc)[2][2][4][2], const Unit& u, int wr, int wc, int fr, int fq) const {
        const int row0 = u.pm * BM + wr * 64 + fr, col0 = u.pn * BM + wc * 32 + 4 * fq;
        f32x4 bv[2][2];
#pragma unroll
        for (int bj = 0; bj < 2; ++bj)
#pragma unroll
            for (int n = 0; n < 2; ++n) bv[bj][n] = bias ? *(const f32x4*)(bias + col0 + bj * HALF + n * 16) : (f32x4){0.f, 0.f, 0.f, 0.f};
#pragma unroll
        for (int ai = 0; ai < 2; ++ai)
#pragma unroll
            for (int m = 0; m < 4; ++m) { float* rowp = C + (size_t)(row0 + ai * HALF + m * 16) * ldc + col0;
#pragma unroll
                for (int bj = 0; bj < 2; ++bj)
#pragma unroll
                    for (int n = 0; n < 2; ++n) *(f32x4*)(rowp + bj * HALF + n * 16) = acc[ai][bj][m][n] + bv[bj][n]; }
    }
};
template <int ACT  > struct EpiBf16 {
    static constexpr bool PERM = true, AFTER_DRAIN = false;
    bf16_t* O; int ldc; const float* bias; int split_cols; size_t split_stride;
    __device__ __forceinline__ void operator()(const f32x4 (&acc)[2][2][4][2], const Unit& u, int wr, int wc, int fr, int fq) const {
        const int row0 = u.pm * BM + wr * 64 + fr; int colt = u.pn * BM; bf16_t* base = O;
        if (split_cols) { const int t = colt / split_cols; base += (size_t)t * split_stride; colt -= t * split_cols; }
        const int col0 = colt + wc * 32 + 8 * fq, bcol0 = u.pn * BM + wc * 32 + 8 * fq;
        f32x4 bv[2][2];
#pragma unroll
        for (int bj = 0; bj < 2; ++bj)
#pragma unroll
            for (int n = 0; n < 2; ++n) bv[bj][n] = bias ? *(const f32x4*)(bias + bcol0 + bj * HALF + 4 * n) : (f32x4){0.f, 0.f, 0.f, 0.f};
#pragma unroll
        for (int ai = 0; ai < 2; ++ai)
#pragma unroll
            for (int m = 0; m < 4; ++m) { bf16_t* rowp = base + (size_t)(row0 + ai * HALF + m * 16) * ldc + col0;
#pragma unroll
                for (int bj = 0; bj < 2; ++bj) { f32x4 v0 = acc[ai][bj][m][0] + bv[bj][0], v1 = acc[ai][bj][m][1] + bv[bj][1];
                    if (ACT == 1) { f32x2 a = gelu_pk((f32x2){v0[0], v0[1]}), b = gelu_pk((f32x2){v0[2], v0[3]}), c = gelu_pk((f32x2){v1[0], v1[1]}), d = gelu_pk((f32x2){v1[2], v1[3]});
                        v0 = (f32x4){a.x, a.y, b.x, b.y}; v1 = (f32x4){c.x, c.y, d.x, d.y}; }
                    if (ACT == 2) {
#pragma unroll
                        for (int j = 0; j < 4; ++j) { v0[j] = 0.5f * v0[j] * (1.0f + erff(v0[j] * 0.70710678f)); v1[j] = 0.5f * v1[j] * (1.0f + erff(v1[j] * 0.70710678f)); } }
                    u32x4 w; w.x = cvt_pk_bf16(v0[0], v0[1]); w.y = cvt_pk_bf16(v0[2], v0[3]); w.z = cvt_pk_bf16(v1[0], v1[1]); w.w = cvt_pk_bf16(v1[2], v1[3]);
                    *(u32x4*)(rowp + bj * HALF) = w; } }
    }
};

struct PanelStats {
    unsigned* xbuf;
    unsigned* cnt;
    unsigned* tmo;
    int ntn; float eps;
    unsigned code;
    __device__ __forceinline__ bool run(const f32x4 (&v)[2][2][4][2], const Unit& u, int wr, int wc, int fr, int fq, PG8_LAS unsigned char* lds, int wid, int lane) const {
        typedef float f32x2v __attribute__((ext_vector_type(2)));
        PG8_LAS f32x2v* P = (PG8_LAS f32x2v*)lds;
        PG8_LAS f32x2v* S = (PG8_LAS f32x2v*)(lds + 8192);
        PG8_LAS unsigned* flag = (PG8_LAS unsigned*)(lds + 8192 + 2048);
#pragma unroll
        for (int ai = 0; ai < 2; ++ai)
#pragma unroll
            for (int m = 0; m < 4; ++m) {
                float s = 0.f;
#pragma unroll
                for (int bj = 0; bj < 2; ++bj)
#pragma unroll
                    for (int n = 0; n < 2; ++n) { const f32x4 x = v[ai][bj][m][n]; s += (x[0] + x[1]) + (x[2] + x[3]); }
                s += __shfl_xor(s, 16); s += __shfl_xor(s, 32);
                const float mw = s * (1.0f / 64.0f); float q = 0.f;
#pragma unroll
                for (int bj = 0; bj < 2; ++bj)
#pragma unroll
                    for (int n = 0; n < 2; ++n) { const f32x4 d = v[ai][bj][m][n] - mw; q += (d[0] * d[0] + d[1] * d[1]) + (d[2] * d[2] + d[3] * d[3]); }
                q += __shfl_xor(q, 16); q += __shfl_xor(q, 32);
                if (fq == 0) P[(ai * HALF + wr * 64 + m * 16 + fr) * 4 + wc] = (f32x2v){mw, q};
            }
        asm volatile("s_waitcnt lgkmcnt(0)" ::: "memory"); __builtin_amdgcn_s_barrier(); asm volatile("" ::: "memory");
#if defined(BROKEN_NO_WAIT)
        if (blockIdx.x >= 64) { const long long t0 = clock64(); while (clock64() - t0 < 60000) __builtin_amdgcn_s_sleep(8); }
#endif
        const int row = wid * 32 + (lane & 31);
        if (lane < 32) {
            const f32x2v a = P[row * 4 + 0], b = P[row * 4 + 1], c = P[row * 4 + 2], d = P[row * 4 + 3];
            const float mt = (a.x + b.x + c.x + d.x) * 0.25f;
            const float da = a.x - mt, db = b.x - mt, dc = c.x - mt, dd = d.x - mt;
            const float m2 = (a.y + b.y) + (c.y + d.y) + 64.0f * ((da * da + db * db) + (dc * dc + dd * dd));
            unsigned long long* slot = (unsigned long long*)xbuf + ((size_t)(u.pm * BM + row) * 4 + u.pn);
            __hip_atomic_store(slot, ((unsigned long long)__float_as_uint(m2) << 32) | __float_as_uint(mt), __ATOMIC_RELAXED, __HIP_MEMORY_SCOPE_AGENT);
        }
        asm volatile("s_waitcnt vmcnt(0)" ::: "memory");
        if (lane == 0) __hip_atomic_fetch_add(cnt + 64 * u.pm, 1u, __ATOMIC_RELAXED, __HIP_MEMORY_SCOPE_AGENT);
        if (wid == 0) {
            bool dead = false; const unsigned long long t0 = __builtin_amdgcn_s_memrealtime(); const unsigned want = 8u * (unsigned)ntn;
            for (;;) {
#if defined(BROKEN_NO_WAIT)
                break;
#endif
                if ((unsigned)__builtin_amdgcn_readfirstlane(__hip_atomic_load(cnt + 64 * u.pm, __ATOMIC_RELAXED, __HIP_MEMORY_SCOPE_AGENT)) >= want) break;
                if (__builtin_amdgcn_s_memrealtime() - t0 > 2000000ull) {
                    if (lane == 0) { unsigned expect = 0u; __hip_atomic_compare_exchange_strong(tmo + 1, &expect, code | (unsigned)(u.pm & 0xff), __ATOMIC_RELAXED, __ATOMIC_RELAXED, __HIP_MEMORY_SCOPE_AGENT);
                                     __hip_atomic_store(tmo, 1u, __ATOMIC_RELAXED, __HIP_MEMORY_SCOPE_AGENT); }
                    dead = true; break; }
                __builtin_amdgcn_s_sleep(2);
            }
            __builtin_amdgcn_fence(__ATOMIC_ACQUIRE, "agent");
            if (lane == 0) flag[0] = dead ? 1u : 0u;
        }
        asm volatile("s_waitcnt vmcnt(0) lgkmcnt(0)" ::: "memory"); __builtin_amdgcn_s_barrier(); asm volatile("" ::: "memory");
        const bool bad = flag[0] != 0u;
        if (lane < 32) {
            const unsigned long long* slot = (const unsigned long long*)xbuf + (size_t)(u.pm * BM + row) * 4; float mt[4], m2[4]; float ms = 0.f;
#pragma unroll
            for (int t = 0; t < 4; ++t) { if (t < ntn) { const unsigned long long w = __hip_atomic_load(slot + t, __ATOMIC_RELAXED, __HIP_MEMORY_SCOPE_AGENT); mt[t] = __uint_as_float((unsigned)w); m2[t] = __uint_as_float((unsigned)(w >> 32)); } else { mt[t] = 0.f; m2[t] = 0.f; } ms += mt[t]; }
            const float mean = ms / (float)ntn; float q = 0.f;
#pragma unroll
            for (int t = 0; t < 4; ++t) if (t < ntn) { const float dm = mt[t] - mean; q += m2[t] + 256.0f * dm * dm; }
            S[row] = (f32x2v){mean, 1.0f / sqrtf(q / (256.0f * (float)ntn) + eps)};
        }
        asm volatile("s_waitcnt lgkmcnt(0)" ::: "memory"); __builtin_amdgcn_s_barrier(); asm volatile("" ::: "memory");
        return bad;
    }
};
struct EpiLnRes {
    static constexpr bool PERM = false, AFTER_DRAIN = true;
    const float* base; float* out; int ldc; const float* bias; PanelStats st; unsigned poison;
    __device__ __forceinline__ void refuse(size_t i0, size_t stride, int M, int N) const { const float q = __builtin_nanf(""); for (size_t i = i0; i < (size_t)M * N; i += stride) out[(i / N) * ldc + i % N] = q;
        if (i0 == 0) { unsigned expect = 0u; __hip_atomic_compare_exchange_strong(st.tmo + 1, &expect, 0x7f0u, __ATOMIC_RELAXED, __ATOMIC_RELAXED, __HIP_MEMORY_SCOPE_AGENT); __hip_atomic_store(st.tmo, 1u, __ATOMIC_RELAXED, __HIP_MEMORY_SCOPE_AGENT); } }
    __device__ __forceinline__ void fused(f32x4 (&acc)[2][2][4][2], const Unit& u, int wr, int wc, int fr, int fq, PG8_LAS unsigned char* lds, int wid, int lane) const {
        typedef float f32x2v __attribute__((ext_vector_type(2)));
        const PG8_LAS f32x2v* S = (const PG8_LAS f32x2v*)(lds + 8192);
        const int col0 = u.pn * BM + wc * 32 + 4 * fq;
#pragma unroll
        for (int bj = 0; bj < 2; ++bj)
#pragma unroll
            for (int n = 0; n < 2; ++n) { const f32x4 bv = bias ? *(const f32x4*)(bias + col0 + bj * HALF + n * 16) : (f32x4){0.f, 0.f, 0.f, 0.f};
#pragma unroll
                for (int ai = 0; ai < 2; ++ai)
#pragma unroll
                    for (int m = 0; m < 4; ++m) acc[ai][bj][m][n] += bv; }
        const bool bad = st.run(acc, u, wr, wc, fr, fq, lds, wid, lane) || poison != 0u;
        const float qnan = __builtin_nanf("");
#pragma unroll
        for (int ai = 0; ai < 2; ++ai)
#pragma unroll
            for (int m = 0; m < 4; ++m) { const int r = ai * HALF + wr * 64 + m * 16 + fr; const f32x2v sr = S[r]; const size_t off = (size_t)(u.pm * BM + r) * ldc + col0;
#pragma unroll
                for (int bj = 0; bj < 2; ++bj)
#pragma unroll
                    for (int n = 0; n < 2; ++n) { const f32x4 bs = *(const f32x4*)(base + off + bj * HALF + n * 16); f32x4 o = bs + (acc[ai][bj][m][n] - sr.x) * sr.y;
                        if (bad) o = (f32x4){qnan, qnan, qnan, qnan}; *(f32x4*)(out + off + bj * HALF + n * 16) = o; }
                asm volatile("" ::: "memory"); }
    }
};
struct EpiLnResLn {
    static constexpr bool PERM = false, AFTER_DRAIN = true;
    const float* base; float* out; bf16_t* xn; int ldc; const float* bias; PanelStats st1, st2; unsigned poison;
    __device__ __forceinline__ void refuse(size_t i0, size_t stride, int M, int N) const { const float q = __builtin_nanf(""); for (size_t i = i0; i < (size_t)M * N; i += stride) { const size_t o = (i / N) * ldc + i % N; out[o] = q; xn[o] = (bf16_t)0x7fc0u; }
        if (i0 == 0) { unsigned expect = 0u; __hip_atomic_compare_exchange_strong(st1.tmo + 1, &expect, 0x7f0u, __ATOMIC_RELAXED, __ATOMIC_RELAXED, __HIP_MEMORY_SCOPE_AGENT); __hip_atomic_store(st1.tmo, 1u, __ATOMIC_RELAXED, __HIP_MEMORY_SCOPE_AGENT); } }
    __device__ __forceinline__ void fused(f32x4 (&acc)[2][2][4][2], const Unit& u, int wr, int wc, int fr, int fq, PG8_LAS unsigned char* lds, int wid, int lane) const {
        typedef float f32x2v __attribute__((ext_vector_type(2))); typedef unsigned u32x2v __attribute__((ext_vector_type(2)));
        const PG8_LAS f32x2v* S = (const PG8_LAS f32x2v*)(lds + 8192);
        const int col0 = u.pn * BM + wc * 32 + 4 * fq;
#pragma unroll
        for (int bj = 0; bj < 2; ++bj)
#pragma unroll
            for (int n = 0; n < 2; ++n) { const f32x4 bv = bias ? *(const f32x4*)(bias + col0 + bj * HALF + n * 16) : (f32x4){0.f, 0.f, 0.f, 0.f};
#pragma unroll
                for (int ai = 0; ai < 2; ++ai)
#pragma unroll
                    for (int m = 0; m < 4; ++m) acc[ai][bj][m][n] += bv; }
        bool bad = st1.run(acc, u, wr, wc, fr, fq, lds, wid, lane) || poison != 0u;
        const float qnan = __builtin_nanf("");
#pragma unroll
        for (int ai = 0; ai < 2; ++ai)
#pragma unroll
            for (int m = 0; m < 4; ++m) { const int r = ai * HALF + wr * 64 + m * 16 + fr; const f32x2v sr = S[r]; const size_t off = (size_t)(u.pm * BM + r) * ldc + col0;
#pragma unroll
                for (int bj = 0; bj < 2; ++bj)
#pragma unroll
                    for (int n = 0; n < 2; ++n) { const f32x4 bs = *(const f32x4*)(base + off + bj * HALF + n * 16); acc[ai][bj][m][n] = bs + (acc[ai][bj][m][n] - sr.x) * sr.y; }
                asm volatile("" : "+v"(acc[ai][0][m][0]), "+v"(acc[ai][0][m][1]), "+v"(acc[ai][1][m][0]), "+v"(acc[ai][1][m][1]));
                if (m & 1) asm volatile("" ::: "memory"); }
        const bool bad1 = bad;
        bad = st2.run(acc, u, wr, wc, fr, fq, lds, wid, lane) || bad;
#pragma unroll
        for (int ai = 0; ai < 2; ++ai)
#pragma unroll
            for (int m = 0; m < 4; ++m) { const int r = ai * HALF + wr * 64 + m * 16 + fr; const f32x2v sr = S[r]; const size_t off = (size_t)(u.pm * BM + r) * ldc + col0;
#pragma unroll
                for (int bj = 0; bj < 2; ++bj)
#pragma unroll
                    for (int n = 0; n < 2; ++n) { const f32x4 x1 = acc[ai][bj][m][n]; *(f32x4*)(out + off + bj * HALF + n * 16) = bad1 ? (f32x4){qnan, qnan, qnan, qnan} : x1;
                        const f32x4 o = (x1 - sr.x) * sr.y; u32x2v w; w.x = cvt_pk_bf16(o[0], o[1]); w.y = cvt_pk_bf16(o[2], o[3]);
                        if (bad) { w.x = 0x7fc07fc0u; w.y = 0x7fc07fc0u; } *(u32x2v*)(xn + off + bj * HALF + n * 16) = w; }
                asm volatile("" ::: "memory"); }
    }
};

template <class Epi, class Sched, bool STAMP = false>
__device__ __forceinline__ void gemm_phase(PG8_LAS unsigned char* lds, const Gemm g, const Sched& S, const Epi& E, unsigned long long* stamps, const int tid) {
    const int wid = __builtin_amdgcn_readfirstlane(tid >> 6), lane = tid & 63, wr = wid >> 2, wc = wid & 3, fr = lane & 15, fq = lane >> 4;
    const int K = g.K, nt = K / BK;
    int ts_lo = 0, ts_hi = 0, nts = 0; const unsigned long long rt_entry = STAMP ? (unsigned long long)wall_clock64() : 0ull;
#define PG8_STAMP() do { if (STAMP && wid == 0 && nts < 64) { const unsigned long long _c = (unsigned long long)clock64(); \
        ts_lo = (lane == nts) ? (int)(unsigned)_c : ts_lo; ts_hi = (lane == nts) ? (int)(unsigned)(_c >> 32) : ts_hi; ++nts; } } while (0)
    PG8_STAMP();
    unsigned voffA[2], voffB[2];
#pragma unroll
    for (int i = 0; i < 2; ++i) { int R, C; stage_rc(tid * 16 + i * 8192, R, C); const int Rb = Epi::PERM ? ((R & ~31) + perm32(R & 31)) : R;
        voffA[i] = (unsigned)(R * K + C) * 2u; voffB[i] = (unsigned)(Rb * K + C) * 2u; }
    const size_t kstep = (size_t)(BK * 2);
    const size_t hstep = (size_t)HALF * K * 2;
    const size_t tstep = 2 * hstep;
    const unsigned ldsw = (unsigned)wid * 1024u;
    const int aoff = lds_byte(wr * 64 + fr, fq * 8), boff = lds_byte(wc * 32 + fr, fq * 8);
#define PG8_SA(b, h) (((b) * 2 + (h)) * HTB)
#define PG8_SB(b, h) ((4 + (b) * 2 + (h)) * HTB)
#define PG8_STAGE(bufoff, gbase, voff) do { _Pragma("unroll") for (int _i = 0; _i < 2; ++_i) \
        __builtin_amdgcn_global_load_lds((const unsigned*)((const char*)(gbase) + (voff)[_i]), (PG8_LAS unsigned*)(lds + (bufoff) + ldsw + _i * 8192), 16, 0, 0); } while (0)
#define PG8_LDA(dst, b, h) do { _Pragma("unroll") for (int m = 0; m < 4; ++m) _Pragma("unroll") for (int k = 0; k < 2; ++k) dst[m][k] = *(const PG8_LAS bf16x8*)(lds + PG8_SA(b, h) + aoff + m * 2048 + k * 1024); } while (0)
#define PG8_LDB(dst, b, h) do { _Pragma("unroll") for (int n = 0; n < 2; ++n) _Pragma("unroll") for (int k = 0; k < 2; ++k) dst[n][k] = *(const PG8_LAS bf16x8*)(lds + PG8_SB(b, h) + boff + n * 2048 + k * 1024); } while (0)
#define PG8_MMA(ai, bj, At, Bt) do { __builtin_amdgcn_s_setprio(1); _Pragma("unroll") for (int m = 0; m < 4; ++m) _Pragma("unroll") for (int n = 0; n < 2; ++n) _Pragma("unroll") for (int k = 0; k < 2; ++k) \
        acc[ai][bj][m][n] = __builtin_amdgcn_mfma_f32_16x16x32_bf16(Bt[n][k], At[m][k], acc[ai][bj][m][n], 0, 0, 0); __builtin_amdgcn_s_setprio(0); } while (0)
#define PG8_WAIT_V(n) asm volatile("s_waitcnt vmcnt(" #n ")" ::: "memory")
#define PG8_WAIT_L(n) asm volatile("s_waitcnt lgkmcnt(" #n ")" ::: "memory")
#define PG8_BAR __builtin_amdgcn_s_barrier()
#define PG8_SCHED __builtin_amdgcn_sched_barrier(0)
    Unit cur, nxt; int ui = 0;
    if (!S.next(0, cur)) return;
    f32x4 acc[2][2][4][2];
#pragma unroll
    for (int a = 0; a < 2; ++a)
#pragma unroll
        for (int b = 0; b < 2; ++b)
#pragma unroll
            for (int m = 0; m < 4; ++m)
#pragma unroll
                for (int n = 0; n < 2; ++n) acc[a][b][m][n] = (f32x4){0.f, 0.f, 0.f, 0.f};
    bf16x8 At[4][2], B0[2][2], B1[2][2];
    const char* cA = (const char*)g.A + (size_t)cur.pm * tstep; const char* cB = (const char*)g.Bt + (size_t)cur.pn * tstep;
    S.a_ready(cur);
    PG8_STAGE(PG8_SB(0, 0), cB, voffB); PG8_STAGE(PG8_SA(0, 0), cA, voffA); PG8_STAGE(PG8_SB(0, 1), cB + hstep, voffB); PG8_STAGE(PG8_SA(0, 1), cA + hstep, voffA);
    if (wr == 1) PG8_BAR;
    PG8_WAIT_V(4); PG8_BAR;
    PG8_STAGE(PG8_SB(1, 0), cB + kstep, voffB); PG8_STAGE(PG8_SA(1, 0), cA + kstep, voffA); PG8_STAGE(PG8_SB(1, 1), cB + hstep + kstep, voffB);
    PG8_WAIT_V(6); PG8_BAR;
    PG8_STAMP();
    for (;;) {
        const bool has_next = S.next(ui + 1, nxt);
        const char* nA = has_next ? (const char*)g.A + (size_t)nxt.pm * tstep : cA; const char* nB = has_next ? (const char*)g.Bt + (size_t)nxt.pn * tstep : cB;
        for (int t = 0; t < nt; t += 2) {
            const bool last = (t == nt - 2);
            const char* a1 = cA + (size_t)(t + 1) * kstep;
            const char* a2 = last ? nA : cA + (size_t)(t + 2) * kstep; const char* b2 = last ? nB : cB + (size_t)(t + 2) * kstep;
            const char* a3 = a2 + kstep; const char* b3 = b2 + kstep;
            if (last && has_next) S.a_ready(nxt);
            PG8_LDB(B0, 0, 0); PG8_SCHED; PG8_LDA(At, 0, 0); PG8_STAGE(PG8_SA(1, 1), a1 + hstep, voffA);
            PG8_WAIT_L(8); PG8_BAR; PG8_WAIT_L(0); PG8_MMA(0, 0, At, B0); PG8_BAR; PG8_SCHED;
            PG8_LDB(B1, 0, 1); PG8_STAGE(PG8_SB(0, 0), b2, voffB);
            PG8_BAR; PG8_WAIT_L(0); PG8_MMA(0, 1, At, B1); PG8_BAR;
            PG8_LDA(At, 0, 1); PG8_STAGE(PG8_SA(0, 0), a2, voffA);
            PG8_BAR; PG8_WAIT_L(0); PG8_MMA(1, 0, At, B0); PG8_BAR; PG8_SCHED;
            PG8_STAGE(PG8_SB(0, 1), b2 + hstep, voffB);
            PG8_WAIT_V(6); PG8_BAR; PG8_MMA(1, 1, At, B1); PG8_BAR;
            PG8_LDB(B0, 1, 0); PG8_SCHED; PG8_LDA(At, 1, 0); PG8_STAGE(PG8_SA(0, 1), a2 + hstep, voffA);
            PG8_WAIT_L(8); PG8_BAR; PG8_WAIT_L(0); PG8_MMA(0, 0, At, B0); PG8_BAR; PG8_SCHED;
            PG8_LDB(B1, 1, 1); PG8_STAGE(PG8_SB(1, 0), b3, voffB);
            PG8_BAR; PG8_WAIT_L(0); PG8_MMA(0, 1, At, B1); PG8_BAR;
            PG8_LDA(At, 1, 1); PG8_STAGE(PG8_SA(1, 0), a3, voffA);
            PG8_BAR; PG8_WAIT_L(0); PG8_MMA(1, 0, At, B0); PG8_BAR; PG8_SCHED;
            PG8_STAGE(PG8_SB(1, 1), b3 + hstep, voffB);
            PG8_WAIT_V(6); PG8_BAR; PG8_MMA(1, 1, At, B1); PG8_BAR;
        }
        PG8_STAMP();
        if constexpr (!Epi::AFTER_DRAIN) { E(acc, cur, wr, wc, fr, fq); S.done(cur); }
        PG8_STAMP();
        if (!has_next) break;
#pragma unroll
        for (int a = 0; a < 2; ++a)
#pragma unroll
            for (int b = 0; b < 2; ++b)
#pragma unroll
                for (int m = 0; m < 4; ++m)
#pragma unroll
                    for (int n = 0; n < 2; ++n) acc[a][b][m][n] = (f32x4){0.f, 0.f, 0.f, 0.f};
        cur = nxt; cA = nA; cB = nB; ++ui;
    }
    PG8_WAIT_V(0);
    if (wr == 0) PG8_BAR;
    PG8_BAR;
    if constexpr (Epi::AFTER_DRAIN) { E.fused(acc, cur, wr, wc, fr, fq, lds, wid, lane); S.done(cur); }
    PG8_STAMP();
    if (STAMP && wid == 0) { stamps[lane] = lane < nts ? (((unsigned long long)(unsigned)ts_hi << 32) | (unsigned)ts_lo) : 0ull;
        if (lane == 62) stamps[62] = rt_entry; if (lane == 63) stamps[63] = (unsigned long long)wall_clock64(); }
#undef PG8_STAMP
#undef PG8_SA
#undef PG8_SB
#undef PG8_STAGE
#undef PG8_LDA
#undef PG8_LDB
#undef PG8_MMA
#undef PG8_WAIT_V
#undef PG8_WAIT_L
#undef PG8_BAR
#undef PG8_SCHED
}
}

struct PgEpiSwiGLU {
  static constexpr bool PERM = true, AFTER_DRAIN = false;
  u16* act;
  __device__ __forceinline__ void operator()(const pg8::f32x4 (&acc)[2][2][4][2], const pg8::Unit& u, int wr, int wc, int fr, int fq) const {
    const int row0 = u.pm * 256 + wr * 64 + fr, j0 = u.pn * 128 + wc * 32 + 8 * fq;
#pragma unroll
    for (int ai = 0; ai < 2; ++ai)
#pragma unroll
      for (int m = 0; m < 4; ++m) {
        unsigned pk[4];
#pragma unroll
        for (int n = 0; n < 2; ++n) {
          float y[4];
#pragma unroll
          for (int e = 0; e < 4; ++e) {
            const float gt = acc[ai][0][m][n][e], up = acc[ai][1][m][n][e];
            y[e] = gt * __builtin_amdgcn_rcpf(1.f + fexp2(-LOG2E * gt)) * up;
          }
          pk[2 * n] = cvt_pk(y[0], y[1]); pk[2 * n + 1] = cvt_pk(y[2], y[3]);
        }
        u32x4 w4; w4.x = pk[0]; w4.y = pk[1]; w4.z = pk[2]; w4.w = pk[3];
        *(u32x4*)(act + (size_t)(row0 + ai * 128 + m * 16) * DFF + j0) = w4;
      }
  }
};
template <class Epi>
DI void pg_gemm(const u16* A, const u16* Bt, int M, int N, int K, const Epi& E, char* lds, int bid, int nblk, const Ctx& p) {
  pg8::Gemm g{A, Bt, M, N, K};
  pg8::StaticOrder S; S.init(M, N, nblk, bid);
  pg8::gemm_phase<Epi, pg8::StaticOrder, false>((PG8_LAS unsigned char*)lds, g, S, E, nullptr, otid(p));
}

constexpr int LDS_BYTES = 2 * (256 + 256) * 144;
template <int PH>
DI void run_phase(const Ctx& p, char* lds) {
  const int bid = obid(), nblk = gridDim.x;
  u16* wb = (u16*)p.ws;
  u16* R1 = (u16*)(p.ws + OFF_R1);
  u16* R2 = (u16*)(p.ws + OFF_R2);
  u16* R3 = (u16*)(p.ws + OFF_R3);
  if constexpr (PH == 0) phase_prep(p);
  else if constexpr (PH == 1) gemm_phase(R1, 1024, wb + W0IN, 1024, T_TOK, 3072, 1024, EpiProj0{R2, (unsigned*)(p.ws + OFF_SCAL) + SC_QKMAX}, lds, bid, nblk, p);
  else if constexpr (PH == 2) {
    unsigned* ctr = (unsigned*)(p.ws + OFF_SCAL) + SC_CTR;
    int* nxt_slot = (int*)(lds + LDS_BYTES - 16);
    const int tid0 = otid(p);
    int it = bid;
    while (it < 5120) {
      int nx = 0;
      if (tid0 == 0) nx = (int)atomicAdd(ctr, 1u) + nblk;
      if (it < 2560) attn_diff_item(p, it, lds);
      else attn_na_item(p, it - 2560, lds);
      __syncthreads();
      if (tid0 == 0) *nxt_slot = nx;
      __syncthreads();
      it = *nxt_slot;
    }
  }
  else if constexpr (PH == 3) pg_gemm(R1, wb + W0OUT, T_TOK, 1024, 1024, pg8::EpiBf16<0>{R3, 1024, nullptr, 0, 0}, lds, bid, nblk, p);
  else if constexpr (PH == 4) phase_res<true, false>(p, R3, (const float*)(p.ws + OFF_SCAL) + SC_G0);
  else if constexpr (PH == 5) pg_gemm(R1, wb + W0F1, T_TOK, 5632, 1024, PgEpiSwiGLU{R2}, lds, bid, nblk, p);
  else if constexpr (PH == 6) pg_gemm(R2, wb + W0F2, T_TOK, 1024, 2816, pg8::EpiBf16<0>{R3, 1024, nullptr, 0, 0}, lds, bid, nblk, p);
  else if constexpr (PH == 7) phase_res<false, false>(p, R3, (const float*)(p.ws + OFF_SCAL) + SC_G1);
  else if constexpr (PH == 8) pg_gemm(R1, wb + W1DN, T_TOK, 768, 1024, pg8::EpiBf16<0>{R3, 768, nullptr, 0, 0}, lds, bid, nblk, p);
  else if constexpr (PH == 9) phase_mla_stats(p);
  else if constexpr (PH == 10) {
    gemm_phase(R3, 768, wb + W1UQ, 384, T_TOK, 1536, 384,
                     EpiUQ{R2, (const float*)(p.ws + OFF_RQ), (const float2*)(p.ws + OFF_ROPE)}, lds, bid, nblk, p);
    gemm_phase(R3 + 384, 768, wb + W1UKV, 256, T_TOK, 2048, 256,
                     EpiUKV{R2 + (size_t)T_TOK * 1536, R2 + (size_t)T_TOK * 2560, (const float*)(p.ws + OFF_RKV), (unsigned*)(p.ws + OFF_SCAL) + SC_KMAX1}, lds, bid, nblk, p);
  }
  else if constexpr (PH == 11) { for (int it = bid; it < 2560; it += nblk) {
      int itm = it;
      if (nblk == 256) {
        const int rnd = it >> 8, x = bid & 7, j = bid >> 3;
        itm = rnd < 2 ? (8 * rnd + x) * 32 + j : 512 + (2 * (rnd - 2) + (x >> 2)) * 128 + (4 * (x & 3) + (j >> 3)) * 8 + (j & 7);
      }
      attn_mla_item2(p, itm, lds);
    } }
  else if constexpr (PH == 12) pg_gemm(R1, wb + W1OUT, T_TOK, 1024, 1024, pg8::EpiBf16<0>{R3, 1024, nullptr, 0, 0}, lds, bid, nblk, p);
  else if constexpr (PH == 13) phase_res<false, false>(p, R3, (const float*)(p.ws + OFF_SCAL) + SC_G2);
  else if constexpr (PH == 14) pg_gemm(R1, wb + W1F1, T_TOK, 5632, 1024, PgEpiSwiGLU{R2}, lds, bid, nblk, p);
  else if constexpr (PH == 15) pg_gemm(R2, wb + W1F2, T_TOK, 1024, 2816, pg8::EpiBf16<0>{R3, 1024, nullptr, 0, 0}, lds, bid, nblk, p);
  else if constexpr (PH == 16) phase_res<false, true>(p, R3, (const float*)(p.ws + OFF_SCAL) + SC_G3);
}

#if MULTI_LAUNCH
template <int PH>
__global__ void __launch_bounds__(512, 2) k_phase(Params pa) {
  extern __shared__ __attribute__((aligned(16))) char lds[];
  Ctx p;
#pragma unroll
  for (int i = 0; i < 28; ++i) p.in[i] = pa.in[i];
  p.out = pa.out; p.ws = pa.ws;
  p.wv = __builtin_amdgcn_readfirstlane((int)(threadIdx.x >> 6));
  run_phase<PH>(p, lds);
}
template <int PH>
static void launch_all(const Params& p, int grid, hipStream_t stream) {
  (void)hipFuncSetAttribute((const void*)k_phase<PH>, hipFuncAttributeMaxDynamicSharedMemorySize, LDS_BYTES);
  hipLaunchKernelGGL(k_phase<PH>, dim3(grid), dim3(512), LDS_BYTES, stream, p);
  if constexpr (PH + 1 < NPHASE) launch_all<PH + 1>(p, grid, stream);
}
#define OCC_KERNEL k_phase<2>
#else
#ifndef PROBE_DUP
#define PROBE_DUP -1
#endif
#ifndef PROBE_DUP2
#define PROBE_DUP2 -1
#endif
DI void grid_barrier(unsigned* ctr, unsigned target, const Ctx& p) {
  __syncthreads();
  if (otid(p) < 64) {
    __builtin_amdgcn_fence(__ATOMIC_RELEASE, "agent");
    if (otid(p) == 0) {
      __hip_atomic_fetch_add(ctr, 1u, __ATOMIC_RELAXED, __HIP_MEMORY_SCOPE_AGENT);
      while (__hip_atomic_load(ctr, __ATOMIC_RELAXED, __HIP_MEMORY_SCOPE_AGENT) < target) __builtin_amdgcn_s_sleep(1);
    }
    __builtin_amdgcn_fence(__ATOMIC_ACQUIRE, "agent");
  }
  __syncthreads();
}
template <int PH>
DI void run_from(const Ctx& p, char* lds) {
  if constexpr (PH == PROBE_DUP || PH == PROBE_DUP2) { run_phase<PH>(p, lds); cg::this_grid().sync(); }
#ifdef PROBE_ABL
  if constexpr (PH == 11) { for (int it = obid(); it < 5120; it += gridDim.x) attn_mla_item<PROBE_ABL>(p, it, lds); cg::this_grid().sync(); }
#endif
  run_phase<PH>(p, lds);
  if constexpr (PH + 1 < NPHASE) {
    if constexpr (PH == 0) cg::this_grid().sync();
    else grid_barrier((unsigned*)(p.ws + OFF_SCAL) + SC_BAR, (unsigned)PH * gridDim.x, p);
    run_from<PH + 1>(p, lds);
  }
}
__global__ void __launch_bounds__(512, 2) mega(Params pa) {
  extern __shared__ __attribute__((aligned(16))) char lds[];
  Ctx p;
#pragma unroll
  for (int i = 0; i < 28; ++i) p.in[i] = pa.in[i];
  p.out = pa.out; p.ws = pa.ws;
  p.wv = __builtin_amdgcn_readfirstlane((int)(threadIdx.x >> 6));
  run_from<0>(p, lds);
}
#define OCC_KERNEL mega
#endif

extern "C" void kernel_launch(void* const* d_in, const int* in_sizes, int n_in, void* d_out, int out_size, void* d_ws, size_t ws_size,
                              hipStream_t stream) {
  static int grid = 0;
  if (grid == 0) {
    if (n_in != 28 || ws_size < WS_NEED) { fprintf(stderr, "kernel_launch: unexpected n_in %d / ws_size %zu (need %zu)\n", n_in, ws_size, (size_t)WS_NEED); grid = -1; return; }
    int dev = 0, cus = 0, per_cu = 0;
    (void)hipGetDevice(&dev);
    (void)hipDeviceGetAttribute(&cus, hipDeviceAttributeMultiprocessorCount, dev);
    (void)hipFuncSetAttribute((const void*)OCC_KERNEL, hipFuncAttributeMaxDynamicSharedMemorySize, LDS_BYTES);
    (void)hipOccupancyMaxActiveBlocksPerMultiprocessor(&per_cu, (const void*)OCC_KERNEL, 512, LDS_BYTES);
    if (per_cu < 1) per_cu = 1;
    if (per_cu > 1) per_cu = 1;
    grid = cus * per_cu;
  }
  if (grid < 0) return;
  Params p{};
  for (int i = 0; i < 28; ++i) p.in[i] = (const float*)d_in[i];
  p.out = (float*)d_out;
  p.ws = (char*)d_ws;
#if MULTI_LAUNCH
  launch_all<0>(p, grid, stream);
#else
  void* args[] = {&p};
  hipError_t e = hipLaunchCooperativeKernel((const void*)mega, dim3(grid), dim3(512), args, LDS_BYTES, stream);
  if (e != hipSuccess) fprintf(stderr, "cooperative launch failed: %s (grid %d)\n", hipGetErrorString(e), grid);
#endif
}
```

```cpp
#include <hip/hip_runtime.h>
#include <hip/hip_cooperative_groups.h>
#include <stdint.h>
#include <cstdio>
namespace cg = cooperative_groups;

#ifndef MULTI_LAUNCH
#define MULTI_LAUNCH 0
#endif

typedef unsigned short u16;
typedef __attribute__((ext_vector_type(8))) short bf16x8;
typedef __attribute__((ext_vector_type(16))) float f32x16;
typedef __attribute__((ext_vector_type(4))) unsigned u32x4;

#define MFMA32(a, b, c) __builtin_amdgcn_mfma_f32_32x32x16_bf16((a), (b), (c), 0, 0, 0)
#define DI __device__ __forceinline__

constexpr int T_TOK = 81920;
constexpr int T_PROMPT = 65536;
constexpr int DM = 1024;
constexpr int DFF = 2816;
constexpr float EPS = 1e-6f;
constexpr float LOG2E = 1.4426950408889634f;
constexpr float QSCALE64 = 0.125f * LOG2E;
constexpr float QSCALE96 = 0.10206207261596577f * LOG2E;
constexpr int NPHASE = 17;

constexpr size_t MiB = (size_t)1 << 20;
constexpr size_t W0IN = 0;
constexpr size_t W0OUT = W0IN + (size_t)3072 * 1024;
constexpr size_t W0F1 = W0OUT + (size_t)1024 * 1024;
constexpr size_t W0F2 = W0F1 + (size_t)5632 * 1024;
constexpr size_t W1DN = W0F2 + (size_t)1024 * 2816;
constexpr size_t W1UQ = W1DN + (size_t)768 * 1024;
constexpr size_t W1UKV = W1UQ + (size_t)1536 * 384;
constexpr size_t W1OUT = W1UKV + (size_t)2048 * 256;
constexpr size_t W1F1 = W1OUT + (size_t)1024 * 1024;
constexpr size_t W1F2 = W1F1 + (size_t)5632 * 1024;
constexpr size_t W_END = W1F2 + (size_t)1024 * 2816;
static_assert(W_END * 2 <= 48 * MiB, "weights region");
constexpr size_t OFF_ROPE = 48 * MiB;
constexpr size_t OFF_RQ = OFF_ROPE + 2 * MiB;
constexpr size_t OFF_RKV = OFF_RQ + MiB / 2;
constexpr size_t OFF_KROPE = OFF_RKV + MiB / 2;
constexpr size_t OFF_SCAL = OFF_KROPE + 5 * MiB;
constexpr int SC_KP = 64;
constexpr int SC_QKMAX = 16, SC_CTR = 32, SC_BAR = 33, SC_BAR2 = 34, SC_KMAX1 = 40, SC_KRMAX = 56;
constexpr int SC_G0 = 1024, SC_G1 = 2048, SC_G2 = 3072, SC_G3 = 4096, SC_GSUB = 5120, SC_RPB = 6144;
constexpr size_t OFF_R1 = 58 * MiB;
constexpr size_t OFF_R3 = OFF_R1 + 160 * MiB;
constexpr size_t OFF_R2 = OFF_R3 + 160 * MiB;
constexpr size_t WS_NEED = OFF_R2 + 560 * MiB;
constexpr size_t SEG512 = (size_t)T_TOK * 512;

struct Params {
  const float* in[28];
  float* out;
  char* ws;
};
struct Ctx {
  const float* in[28];
  float* out;
  char* ws;
  int wv;
};

DI u16 f2bf(float x) { unsigned u = __float_as_uint(x); u += 0x7fffu + ((u >> 16) & 1u); return (u16)(u >> 16); }
DI unsigned pack2(float a, float b) { return (unsigned)f2bf(a) | ((unsigned)f2bf(b) << 16); }
DI float bflo(unsigned v) { return __uint_as_float(v << 16); }
DI float bfhi(unsigned v) { return __uint_as_float(v & 0xffff0000u); }
DI float wave_sum(float v) {
#pragma unroll
  for (int o = 32; o; o >>= 1) v += __shfl_xor(v, o);
  return v;
}
DI int tok_pos(int t) { return t < T_PROMPT ? (t & 4095) : (t - T_PROMPT); }
DI float fexp2(float x) { return __builtin_amdgcn_exp2f(x); }
typedef __attribute__((ext_vector_type(2))) float f32x2;
typedef __attribute__((ext_vector_type(2))) __bf16 bf16x2_t;
typedef __attribute__((ext_vector_type(2))) unsigned u32x2;
typedef __attribute__((ext_vector_type(4))) unsigned u32x4_;
DI unsigned cvt_pk(float a, float b) {
  f32x2 v; v.x = a; v.y = b;
  return __builtin_bit_cast(unsigned, __builtin_convertvector(v, bf16x2_t));
}
DI int otid(const Ctx& p) {
  int wv = p.wv; asm volatile("" : "+s"(wv));
  int t = wv * 64 + (int)__builtin_amdgcn_mbcnt_hi(~0u, __builtin_amdgcn_mbcnt_lo(~0u, 0u));
  asm volatile("" : "+v"(t));
  return t;
}
DI int obid() { int b = blockIdx.x; asm volatile("" : "+s"(b)); return b; }

__device__ const float ROPE_INV[16] = {1.0f, 0.5623413324356079f, 0.3162277638912201f, 0.17782793939113617f, 0.10000000149011612f, 0.05623413249850273f, 0.03162277489900589f, 0.017782794311642647f, 0.009999999776482582f, 0.005623413249850273f, 0.003162277629598975f, 0.0017782794311642647f, 0.0010000000474974513f, 0.000562341301701963f, 0.0003162277571391314f, 0.00017782794020604342f};

DI void wconv(const float* __restrict__ W, const float* __restrict__ g, u16* __restrict__ dst, int K, int N, int rowsOut, int perm, int gtid, int gthreads) {
  const int kc = K >> 3;
  const long total = (long)rowsOut * kc;
  for (long c = gtid; c < total; c += gthreads) {
    const int n = (int)(c % rowsOut);
    const int k0 = (int)(c / rowsOut) * 8;
    int sc;
    if (perm == 1) { const int blk = n >> 8, w = n & 255; const int j = blk * 128 + (w & 127); sc = (w < 128) ? j : DFF + j; }
    else if (perm == 3) { sc = n < 1024 ? n : (n < 2048 ? n + 512 : (n < 2560 ? n - 1024 : n)); }
    else if (perm == 2) { const int hd = (n & 1023) >> 6, d = n & 63; sc = hd * 128 + (n >= 1024 ? 64 : 0) + d; }
    else sc = n;
    uint4 o = make_uint4(0, 0, 0, 0);
    if (sc < N) {
      float v[8];
      const float rsc = (perm == 3 && (n < 512 || (n >= 1024 && n < 1536))) ? QSCALE64 : 1.f;
#pragma unroll
      for (int i = 0; i < 8; ++i) { float x = W[(size_t)(k0 + i) * N + sc]; if (g) x *= g[k0 + i]; v[i] = x * rsc; }
      o.x = pack2(v[0], v[1]); o.y = pack2(v[2], v[3]); o.z = pack2(v[4], v[5]); o.w = pack2(v[6], v[7]);
    }
    *(uint4*)(dst + (size_t)n * K + k0) = o;
  }
}

DI void phase_prep(const Ctx& p) {
  const int gtid = obid() * 512 + otid(p), gthreads = gridDim.x * 512;
  u16* wb = (u16*)p.ws;
  wconv(p.in[3], p.in[2], wb + W0IN, 1024, 3072, 3072, 3, gtid, gthreads);
  wconv(p.in[10], nullptr, wb + W0OUT, 1024, 1024, 1024, 0, gtid, gthreads);
  wconv(p.in[13], p.in[12], wb + W0F1, 1024, 5632, 5632, 1, gtid, gthreads);
  wconv(p.in[14], nullptr, wb + W0F2, 2816, 1024, 1024, 0, gtid, gthreads);
  wconv(p.in[17], p.in[16], wb + W1DN, 1024, 672, 768, 0, gtid, gthreads);
  wconv(p.in[20], p.in[18], wb + W1UQ, 384, 1536, 1536, 0, gtid, gthreads);
  wconv(p.in[21], p.in[19], wb + W1UKV, 256, 2048, 2048, 2, gtid, gthreads);
  wconv(p.in[22], nullptr, wb + W1OUT, 1024, 1024, 1024, 0, gtid, gthreads);
  wconv(p.in[25], p.in[24], wb + W1F1, 1024, 5632, 5632, 1, gtid, gthreads);
  wconv(p.in[26], nullptr, wb + W1F2, 2816, 1024, 1024, 0, gtid, gthreads);
  float2* rope = (float2*)(p.ws + OFF_ROPE);
  for (int idx = gtid; idx < 16384 * 16; idx += gthreads) {
    const int pos = idx >> 4, i = idx & 15;
    const float ang = (float)pos * ROPE_INV[i];
    double rev = (double)ang * 0.15915494309189535;
    rev -= rint(rev);
    const float rf = (float)rev;
    rope[idx] = make_float2(__builtin_amdgcn_cosf(rf), __builtin_amdgcn_sinf(rf));
  }
  if (gtid == 0) {
    float s1 = 0.f, s2 = 0.f;
    for (int i = 0; i < 64; ++i) { s1 += p.in[5][i] * p.in[6][i]; s2 += p.in[7][i] * p.in[8][i]; }
    float* sc = (float*)(p.ws + OFF_SCAL);
    sc[0] = __expf(s1) - __expf(s2) + 0.2f;
    for (int i = 0; i < 176; ++i) ((unsigned*)sc)[SC_QKMAX + i] = 0u;
  }
  {
    float* sc = (float*)(p.ws + OFF_SCAL);
    for (int i = gtid; i < 1024; i += gthreads) { sc[SC_G0 + i] = p.in[11][i]; sc[SC_G1 + i] = p.in[15][i]; sc[SC_G2 + i] = p.in[23][i]; sc[SC_G3 + i] = p.in[27][i]; }
    for (int i = gtid; i < 128; i += gthreads) sc[SC_GSUB + i] = p.in[9][i];
    for (int i = gtid; i < 8 * 465; i += gthreads) sc[SC_RPB + i] = p.in[4][i] * LOG2E;
  }
  const int tid_ = otid(p);
  const int lane = tid_ & 63;
  const int gw = obid() * 8 + (tid_ >> 6), nw = gridDim.x * 8;
  u16* hb = (u16*)(p.ws + OFF_R1);
  for (int row = gw; row < T_TOK; row += nw) {
    const float* xr = row < T_PROMPT ? p.in[0] + (size_t)row * DM : p.in[1] + (size_t)(row - T_PROMPT) * DM;
    float4 v[4];
    float ss = 0.f;
#pragma unroll
    for (int j = 0; j < 4; ++j) { v[j] = ((const float4*)xr)[lane + 64 * j]; ss += v[j].x * v[j].x + v[j].y * v[j].y + v[j].z * v[j].z + v[j].w * v[j].w; }
    ss = wave_sum(ss);
    const float r = rsqrtf(ss * (1.f / DM) + EPS);
#pragma unroll
    for (int j = 0; j < 4; ++j) {
      uint2 o; o.x = pack2(v[j].x * r, v[j].y * r); o.y = pack2(v[j].z * r, v[j].w * r);
      ((uint2*)(hb + (size_t)row * DM))[lane + 64 * j] = o;
    }
  }
}

template <bool FIRST, bool LAST>
DI void phase_res(const Ctx& p, const u16* __restrict__ mbuf, const float* __restrict__ g) {
  const int tid_ = otid(p);
  const int lane = tid_ & 63;
  const int gw = obid() * 8 + (tid_ >> 6), nw = gridDim.x * 8;
  u16* hb = (u16*)(p.ws + OFF_R1);
  float4 gv[4];
#pragma unroll
  for (int j = 0; j < 4; ++j) gv[j] = ((const float4*)g)[lane + 64 * j];
  for (int row0 = gw; row0 < T_TOK; row0 += 2 * nw) {
    float4 xv[2][4], mv[2][4];
    float ss[2] = {0.f, 0.f};
    bool act[2];
#pragma unroll
    for (int t = 0; t < 2; ++t) {
      const int row = row0 + t * nw;
      act[t] = row < T_TOK;
      const int rr = act[t] ? row : row0;
      const float* xr;
      if (FIRST) xr = rr < T_PROMPT ? p.in[0] + (size_t)rr * DM : p.in[1] + (size_t)(rr - T_PROMPT) * DM;
      else xr = p.out + (size_t)rr * DM;
#pragma unroll
      for (int j = 0; j < 4; ++j) {
        const uint2 u = ((const uint2*)(mbuf + (size_t)rr * DM))[lane + 64 * j];
        mv[t][j] = make_float4(bflo(u.x), bfhi(u.x), bflo(u.y), bfhi(u.y));
        xv[t][j] = ((const float4*)xr)[lane + 64 * j];
      }
    }
#pragma unroll
    for (int t = 0; t < 2; ++t) {
#pragma unroll
      for (int j = 0; j < 4; ++j) ss[t] += mv[t][j].x * mv[t][j].x + mv[t][j].y * mv[t][j].y + mv[t][j].z * mv[t][j].z + mv[t][j].w * mv[t][j].w;
      ss[t] = wave_sum(ss[t]);
    }
#pragma unroll
    for (int t = 0; t < 2; ++t) {
      if (!act[t]) continue;
      const int row = row0 + t * nw;
      const float rm = rsqrtf(ss[t] * (1.f / DM) + EPS);
      float s2 = 0.f;
#pragma unroll
      for (int j = 0; j < 4; ++j) {
        xv[t][j].x += mv[t][j].x * rm * gv[j].x; xv[t][j].y += mv[t][j].y * rm * gv[j].y;
        xv[t][j].z += mv[t][j].z * rm * gv[j].z; xv[t][j].w += mv[t][j].w * rm * gv[j].w;
        s2 += xv[t][j].x * xv[t][j].x + xv[t][j].y * xv[t][j].y + xv[t][j].z * xv[t][j].z + xv[t][j].w * xv[t][j].w;
        ((float4*)(p.out + (size_t)row * DM))[lane + 64 * j] = xv[t][j];
      }
      if (!LAST) {
        s2 = wave_sum(s2);
        const float r2 = rsqrtf(s2 * (1.f / DM) + EPS);
#pragma unroll
        for (int j = 0; j < 4; ++j) {
          uint2 o; o.x = pack2(xv[t][j].x * r2, xv[t][j].y * r2); o.y = pack2(xv[t][j].z * r2, xv[t][j].w * r2);
          ((uint2*)(hb + (size_t)row * DM))[lane + 64 * j] = o;
        }
      }
    }
  }
}

DI void phase_mla_stats(const Ctx& p) {
  const int tid_ = otid(p);
  const int lane = tid_ & 63;
  const int gw = obid() * 8 + (tid_ >> 6), nw = gridDim.x * 8;
  const u16* c = (const u16*)(p.ws + OFF_R3);
  float* rq = (float*)(p.ws + OFF_RQ);
  float* rkv = (float*)(p.ws + OFF_RKV);
  u16* krope = (u16*)(p.ws + OFF_KROPE);
  const float2* rope = (const float2*)(p.ws + OFF_ROPE);
  float krmax2 = 0.f;
  for (int row = gw; row < T_TOK; row += nw) {
    const u16* cr = c + (size_t)row * 768;
    const uint4 u0 = ((const uint4*)cr)[lane];
    float s0 = 0.f;
    { float a;
      a = bflo(u0.x); s0 += a * a; a = bfhi(u0.x); s0 += a * a; a = bflo(u0.y); s0 += a * a; a = bfhi(u0.y); s0 += a * a;
      a = bflo(u0.z); s0 += a * a; a = bfhi(u0.z); s0 += a * a; a = bflo(u0.w); s0 += a * a; a = bfhi(u0.w); s0 += a * a; }
    float s1 = 0.f;
    if (lane < 16) {
      const uint4 u1 = ((const uint4*)cr)[64 + lane];
      float a;
      a = bflo(u1.x); s1 += a * a; a = bfhi(u1.x); s1 += a * a; a = bflo(u1.y); s1 += a * a; a = bfhi(u1.y); s1 += a * a;
      a = bflo(u1.z); s1 += a * a; a = bfhi(u1.z); s1 += a * a; a = bflo(u1.w); s1 += a * a; a = bfhi(u1.w); s1 += a * a;
    }
    const float sq = wave_sum(lane < 48 ? s0 : 0.f);
    const float skv = wave_sum((lane >= 48 ? s0 : 0.f) + s1);
    if (lane == 0) {
      rq[row] = rsqrtf(sq * (1.f / 384.f) + EPS);
      rkv[row] = rsqrtf(skv * (1.f / 256.f) + EPS);
    }
    float kr2 = 0.f;
    if (lane < 16) {
      const float x1 = __uint_as_float((unsigned)cr[640 + lane] << 16);
      const float x2 = __uint_as_float((unsigned)cr[656 + lane] << 16);
      const float2 cs = rope[tok_pos(row) * 16 + lane];
      const float o1 = x1 * cs.x - x2 * cs.y, o2 = x2 * cs.x + x1 * cs.y;
      krope[(size_t)row * 32 + lane] = f2bf(o1);
      krope[(size_t)row * 32 + 16 + lane] = f2bf(o2);
      kr2 = o1 * o1 + o2 * o2;
    }
    krmax2 = fmaxf(krmax2, wave_sum(kr2));
  }
  if (lane == 0) atomicMax((unsigned*)(p.ws + OFF_SCAL) + SC_KRMAX, __float_as_uint(sqrtf(krmax2)));
}

DI void store_tok(u16* out, int ldo, int m, int nbase, const f32x16& v, float sc) {
  u16* q = out + (size_t)m * ldo + nbase;
#pragma unroll
  for (int g = 0; g < 4; ++g) {
    uint2 u; u.x = pack2(v[4 * g] * sc, v[4 * g + 1] * sc); u.y = pack2(v[4 * g + 2] * sc, v[4 * g + 3] * sc);
    *(uint2*)(q + 8 * g) = u;
  }
}
DI void store_tr(u16* outT, size_t ldt, int n, int mbase, const f32x16& v, const float* __restrict__ rs) {
  u16* q = outT + (size_t)n * ldt + mbase;
#pragma unroll
  for (int g = 0; g < 4; ++g) {
    float4 s = make_float4(1.f, 1.f, 1.f, 1.f);
    if (rs) s = *(const float4*)(rs + mbase + 8 * g);
    uint2 u; u.x = pack2(v[4 * g] * s.x, v[4 * g + 1] * s.y); u.y = pack2(v[4 * g + 2] * s.z, v[4 * g + 3] * s.w);
    *(uint2*)(q + 8 * g) = u;
  }
}

DI void store_tok_u(u16* ub, unsigned loff, const f32x16& v, float sc) {
  char* q = (char*)ub;
  const unsigned hoff = (loff & 8u) << 1;
  const unsigned lbase = loff & ~8u;
#pragma unroll
  for (int pi = 0; pi < 2; ++pi) {
    const int g0 = 2 * pi, g1 = 2 * pi + 1;
    const unsigned a0 = cvt_pk(v[4 * g0] * sc, v[4 * g0 + 1] * sc), a1 = cvt_pk(v[4 * g0 + 2] * sc, v[4 * g0 + 3] * sc);
    const unsigned b0 = cvt_pk(v[4 * g1] * sc, v[4 * g1 + 1] * sc), b1 = cvt_pk(v[4 * g1 + 2] * sc, v[4 * g1 + 3] * sc);
    const u32x2 s0 = __builtin_amdgcn_permlane32_swap(a0, b0, false, false);
    const u32x2 s1 = __builtin_amdgcn_permlane32_swap(a1, b1, false, false);
    u32x4 u; u.x = s0.x; u.y = s1.x; u.z = s0.y; u.w = s1.y;
    *(u32x4*)(q + lbase + hoff + 32 * pi) = u;
  }
}
DI void store_tr_u(u16* ub, unsigned loff, const f32x16& v, const float* __restrict__ rs) {
  char* q = (char*)ub;
  const unsigned hoff = (loff & 8u) << 1;
  const unsigned lbase = loff & ~8u;
#pragma unroll
  for (int pi = 0; pi < 2; ++pi) {
    const int g0 = 2 * pi, g1 = 2 * pi + 1;
    float4 sa = make_float4(1.f, 1.f, 1.f, 1.f), sb = sa;
    if (rs) { sa = *(const float4*)(rs + 8 * g0); sb = *(const float4*)(rs + 8 * g1); }
    const unsigned a0 = cvt_pk(v[4 * g0] * sa.x, v[4 * g0 + 1] * sa.y), a1 = cvt_pk(v[4 * g0 + 2] * sa.z, v[4 * g0 + 3] * sa.w);
    const unsigned b0 = cvt_pk(v[4 * g1] * sb.x, v[4 * g1 + 1] * sb.y), b1 = cvt_pk(v[4 * g1 + 2] * sb.z, v[4 * g1 + 3] * sb.w);
    const u32x2 s0 = __builtin_amdgcn_permlane32_swap(a0, b0, false, false);
    const u32x2 s1 = __builtin_amdgcn_permlane32_swap(a1, b1, false, false);
    u32x4 u; u.x = s0.x; u.y = s1.x; u.z = s0.y; u.w = s1.y;
    *(u32x4*)(q + lbase + hoff + 32 * pi) = u;
  }
}

struct EpiTok {
  u16* out; int ldo;
  static constexpr int SWAPMODE = 1;
  DI bool swap(int) const { return true; }
  template <int WMB, int WNB>
  DI void store(int m0w, int n0w, f32x16 (&acc)[WMB][WNB], int r, int h, bool) const {
#pragma unroll
    for (int mb = 0; mb < WMB; ++mb)
#pragma unroll
      for (int nb = 0; nb < WNB; ++nb) store_tok_u(out + (size_t)(m0w + mb * 32) * ldo + n0w + nb * 32, (unsigned)((r * ldo + 4 * h) * 2), acc[mb][nb], 1.f);
  }
};

struct EpiProj0 {
  u16* base; unsigned* qkmax;
  static constexpr int SWAPMODE = 2;
  DI bool swap(int n0) const { const int reg = n0 >> 9; return !(reg == 2 || reg == 5); }
  template <int WMB, int WNB>
  DI void store(int m0w, int n0w, f32x16 (&acc)[WMB][WNB], int r, int h, bool) const {
    const int reg = n0w >> 9, nl = n0w & 511;
    u16* buf = base + (size_t)reg * SEG512;
    const float sc = (reg == 0 || reg == 3) ? QSCALE64 : 1.f;
#pragma unroll
    for (int mb = 0; mb < WMB; ++mb)
#pragma unroll
      for (int nb = 0; nb < WNB; ++nb) store_tok_u(buf + (size_t)(m0w + mb * 32) * 512 + nl + nb * 32, (unsigned)((r * 512 + 4 * h) * 2), acc[mb][nb], sc);
    __builtin_amdgcn_sched_barrier(0);
    if (reg == 3 || reg == 4) {
      static_assert(WNB == 2, "one head per wave tile");
      float mxn = 0.f;
#pragma unroll
      for (int mb = 0; mb < WMB; ++mb) {
        float ss = 0.f;
#pragma unroll
        for (int nb = 0; nb < WNB; ++nb)
#pragma unroll
          for (int i = 0; i < 16; ++i) { const float v = acc[mb][nb][i]; ss += v * v; }
        { const u32x2 sw = __builtin_amdgcn_permlane32_swap(__float_as_uint(ss), __float_as_uint(ss), false, false); ss = __uint_as_float(sw.x) + __uint_as_float(sw.y); }
        mxn = fmaxf(mxn, ss);
      }
      mxn = fmaxf(mxn, __int_as_float(__builtin_amdgcn_ds_swizzle(__float_as_int(mxn), (16 << 10) | 0x1f)));
      mxn = fmaxf(mxn, __int_as_float(__builtin_amdgcn_ds_swizzle(__float_as_int(mxn), (8 << 10) | 0x1f)));
      mxn = fmaxf(mxn, __int_as_float(__builtin_amdgcn_ds_swizzle(__float_as_int(mxn), (4 << 10) | 0x1f)));
      mxn = fmaxf(mxn, __int_as_float(__builtin_amdgcn_ds_swizzle(__float_as_int(mxn), (2 << 10) | 0x1f)));
      mxn = fmaxf(mxn, __int_as_float(__builtin_amdgcn_ds_swizzle(__float_as_int(mxn), (1 << 10) | 0x1f)));
      if (r == 0 && h == 0) atomicMax(qkmax + (reg - 3) * 8 + (nl >> 6), __float_as_uint(sqrtf(mxn) * sc));
    }
  }
  template <int WMB, int WNB>
  DI void store_t(int n0w, int m0w, f32x16 (&acc)[WMB][WNB], int r, int h) const {
    const int reg = n0w >> 9, nl = n0w & 511;
    u16* buf = base + (size_t)reg * SEG512;
#pragma unroll
    for (int mb = 0; mb < WMB; ++mb)
#pragma unroll
      for (int nb = 0; nb < WNB; ++nb) store_tr_u(buf + (size_t)(nl + mb * 32) * T_TOK + m0w + nb * 32, (unsigned)((r * T_TOK + 4 * h) * 2), acc[mb][nb], nullptr);
  }
};

struct EpiSwiGLU {
  u16* act;
  static constexpr int SWAPMODE = 1;
  DI bool swap(int) const { return true; }
  template <int WMB, int WNB>
  DI void store(int m0w, int n0w, f32x16 (&acc)[WMB][WNB], int r, int h, bool) const {
    static_assert(WNB == 2, "swiglu epilogue needs a 64-wide wave tile");
#pragma unroll
    for (int mb = 0; mb < WMB; ++mb) {
      char* q = (char*)(act + (size_t)(m0w + mb * 32) * DFF + (n0w >> 1)) + (unsigned)((r * DFF) * 2) + 16 * h;
#pragma unroll
      for (int pi = 0; pi < 2; ++pi) {
        unsigned pk[2][2];
#pragma unroll
        for (int gg = 0; gg < 2; ++gg) {
          const int g = 2 * pi + gg;
          float y[4];
#pragma unroll
          for (int e = 0; e < 4; ++e) {
            const float gt = acc[mb][0][4 * g + e], up = acc[mb][1][4 * g + e];
            y[e] = gt * __builtin_amdgcn_rcpf(1.f + fexp2(-LOG2E * gt)) * up;
          }
          pk[gg][0] = cvt_pk(y[0], y[1]); pk[gg][1] = cvt_pk(y[2], y[3]);
        }
        const u32x2 s0 = __builtin_amdgcn_permlane32_swap(pk[0][0], pk[1][0], false, false);
        const u32x2 s1 = __builtin_amdgcn_permlane32_swap(pk[0][1], pk[1][1], false, false);
        u32x4 u; u.x = s0.x; u.y = s1.x; u.z = s0.y; u.w = s1.y;
        *(u32x4*)(q + 32 * pi) = u;
      }
      __builtin_amdgcn_sched_barrier(0);
    }
  }
};

struct EpiUQ {
  u16* q; const float* rq; const float2* rope;
  static constexpr int SWAPMODE = 1;
  DI bool swap(int) const { return true; }
  template <int WMB, int WNB>
  DI void store(int m0w, int n0w, f32x16 (&acc)[WMB][WNB], int r, int h, bool) const {
#pragma unroll
    for (int mb = 0; mb < WMB; ++mb) {
      const int m = m0w + mb * 32 + r;
      const float sc = rq[m] * QSCALE96;
      const int pos = tok_pos(m);
#pragma unroll
      for (int nb = 0; nb < WNB; ++nb) {
        const int n0b = n0w + nb * 32;
        f32x16 v = acc[mb][nb];
#pragma unroll
        for (int i = 0; i < 16; ++i) v[i] *= sc;
        if (((n0b >> 5) % 3) == 2) {
#pragma unroll
          for (int i = 0; i < 8; ++i) {
            const int f = (i & 3) + 8 * (i >> 2) + 4 * h;
            const float2 cs = rope[pos * 16 + f];
            const float x1 = v[i], x2 = v[i + 8];
            v[i] = x1 * cs.x - x2 * cs.y;
            v[i + 8] = x2 * cs.x + x1 * cs.y;
          }
        }
        store_tok_u(q + (size_t)(m0w + mb * 32) * 1536 + n0b, (unsigned)((r * 1536 + 4 * h) * 2), v, 1.f);
        __builtin_amdgcn_sched_barrier(0);
      }
    }
  }
};

struct EpiUKV {
  u16* knope; u16* vt; const float* rkv; unsigned* kmax;
  static constexpr int SWAPMODE = 2;
  DI bool swap(int n0) const { return n0 < 1024; }
  template <int WMB, int WNB>
  DI void store(int m0w, int n0w, f32x16 (&acc)[WMB][WNB], int r, int h, bool) const {
#pragma unroll
    for (int mb = 0; mb < WMB; ++mb) {
      const int m = m0w + mb * 32 + r;
      const float sc = rkv[m];
#pragma unroll
      for (int nb = 0; nb < WNB; ++nb) store_tok_u(knope + (size_t)(m0w + mb * 32) * 1024 + n0w + nb * 32, (unsigned)((r * 1024 + 4 * h) * 2), acc[mb][nb], sc);
    }
    __builtin_amdgcn_sched_barrier(0);
    static_assert(WNB == 2, "one head per wave tile");
    float mxn = 0.f;
#pragma unroll
    for (int mb = 0; mb < WMB; ++mb) {
      float ss = 0.f;
#pragma unroll
      for (int nb = 0; nb < WNB; ++nb)
#pragma unroll
        for (int i = 0; i < 16; ++i) { const float v = acc[mb][nb][i]; ss += v * v; }
      { const u32x2 sw = __builtin_amdgcn_permlane32_swap(__float_as_uint(ss), __float_as_uint(ss), false, false); ss = __uint_as_float(sw.x) + __uint_as_float(sw.y); }
      const float sc = rkv[m0w + mb * 32 + r];
      mxn = fmaxf(mxn, ss * sc * sc);
    }
    mxn = fmaxf(mxn, __int_as_float(__builtin_amdgcn_ds_swizzle(__float_as_int(mxn), (16 << 10) | 0x1f)));
    mxn = fmaxf(mxn, __int_as_float(__builtin_amdgcn_ds_swizzle(__float_as_int(mxn), (8 << 10) | 0x1f)));
    mxn = fmaxf(mxn, __int_as_float(__builtin_amdgcn_ds_swizzle(__float_as_int(mxn), (4 << 10) | 0x1f)));
    mxn = fmaxf(mxn, __int_as_float(__builtin_amdgcn_ds_swizzle(__float_as_int(mxn), (2 << 10) | 0x1f)));
    mxn = fmaxf(mxn, __int_as_float(__builtin_amdgcn_ds_swizzle(__float_as_int(mxn), (1 << 10) | 0x1f)));
    if (r == 0 && h == 0) atomicMax(kmax + (n0w >> 6), __float_as_uint(sqrtf(mxn)));
  }
  template <int WMB, int WNB>
  DI void store_t(int n0w, int m0w, f32x16 (&acc)[WMB][WNB], int r, int h) const {
#pragma unroll
    for (int mb = 0; mb < WMB; ++mb)
#pragma unroll
      for (int nb = 0; nb < WNB; ++nb) store_tr_u(vt + (size_t)(n0w - 1024 + mb * 32) * T_TOK + m0w + nb * 32, (unsigned)((r * T_TOK + 4 * h) * 2), acc[mb][nb], rkv + m0w + nb * 32 + 4 * h);
  }
};

template <bool SWAP, int WMB, int WNB>
DI void gemm_compute(const char* la, const char* lb, f32x16 (&acc)[WMB][WNB], int wm, int wn, int r, int h) {
#pragma unroll
  for (int ks = 0; ks < 4; ++ks) {
    bf16x8 af[WMB], bfr[WNB];
#pragma unroll
    for (int mb = 0; mb < WMB; ++mb) af[mb] = *(const bf16x8*)(la + (wm * 32 * WMB + mb * 32 + r) * 144 + (ks * 2 + h) * 16);
#pragma unroll
    for (int nb = 0; nb < WNB; ++nb) bfr[nb] = *(const bf16x8*)(lb + (wn * 32 * WNB + nb * 32 + r) * 144 + (ks * 2 + h) * 16);
#pragma unroll
    for (int mb = 0; mb < WMB; ++mb)
#pragma unroll
      for (int nb = 0; nb < WNB; ++nb) {
        if (SWAP) acc[mb][nb] = MFMA32(bfr[nb], af[mb], acc[mb][nb]);
        else acc[mb][nb] = MFMA32(af[mb], bfr[nb], acc[mb][nb]);
      }
  }
}

struct TileDesc { bool valid; bool normal; int m0, n0, ldp, ldq; unsigned po, qo; const char* P; const char* Q; };

template <class Epi>
DI void gemm_phase(const u16* __restrict__ A, int lda, const u16* __restrict__ Bt, int ldb, int M, int N, int K, const Epi epi, char* lds, int bid, int nblk, const Ctx& p) {
  constexpr int WMB = 4, WNB = 2;
  constexpr int TM = 256, TN = 256;
  constexpr int STAGE = (TM + TN) * 144;
  const int tid = otid(p), lane = tid & 63, w = __builtin_amdgcn_readfirstlane(tid >> 6), wm = w >> 2, wn = w & 3, r = lane & 31, h = lane >> 5;
  const int lrow = tid >> 3, lch = tid & 7;
  const int NT = N / TN, MT = M / TM, tiles = MT * NT, nk = K >> 6;
  const int rounds = (tiles + nblk - 1) / nblk;
  auto desc = [&](int rnd) {
    TileDesc d;
    int tile = rnd * nblk + bid;
    if (nblk == 256) tile = rnd * 256 + (bid & 7) * 32 + (bid >> 3);
    d.valid = rnd < rounds && tile < tiles;
    const int grp = tile / (8 * NT), within = tile - grp * (8 * NT);
    const int nt = within >> 3, mt = grp * 8 + (within & 7);
    d.m0 = mt * TM; d.n0 = nt * TN;
    d.normal = true;
    if constexpr (Epi::SWAPMODE == 2) d.normal = epi.swap(d.n0);
    const char* Ab = (const char*)A + (size_t)d.m0 * lda * 2;
    const char* Bb = (const char*)Bt + (size_t)d.n0 * ldb * 2;
    const unsigned aoff = (unsigned)(lrow * lda * 2 + lch * 16), boff = (unsigned)(lrow * ldb * 2 + lch * 16);
    d.P = d.normal ? Ab : Bb; d.Q = d.normal ? Bb : Ab;
    d.po = d.normal ? aoff : boff; d.qo = d.normal ? boff : aoff;
    d.ldp = d.normal ? lda : ldb; d.ldq = d.normal ? ldb : lda;
    return d;
  };
  u32x4 pa[4], pb[4];
  auto issue = [&](const TileDesc& d, int kt) {
    const char* Pk = d.P + (size_t)kt * 128; asm volatile("" : "+s"(Pk));
    const char* Qk = d.Q + (size_t)kt * 128; asm volatile("" : "+s"(Qk));
#pragma unroll
    for (int j = 0; j < 4; ++j) pa[j] = *(const u32x4*)(Pk + (size_t)j * 128 * d.ldp + d.po);
#pragma unroll
    for (int j = 0; j < 4; ++j) pb[j] = *(const u32x4*)(Qk + (size_t)j * 128 * d.ldq + d.qo);
  };
  auto write_stage = [&](int b) {
    char* wa = lds + b * STAGE;
    char* wb = wa + TM * 144;
#pragma unroll
    for (int j = 0; j < 4; ++j) *(u32x4*)(wa + (lrow + 64 * j) * 144 + lch * 16) = pa[j];
#pragma unroll
    for (int j = 0; j < 4; ++j) *(u32x4*)(wb + (lrow + 64 * j) * 144 + lch * 16) = pb[j];
  };
  TileDesc cur = desc(0);
  if (!cur.valid) return;
  issue(cur, 0);
  for (int rnd = 0;; ++rnd) {
    f32x16 acc[WMB][WNB];
#pragma unroll
    for (int mb = 0; mb < WMB; ++mb)
#pragma unroll
      for (int nb = 0; nb < WNB; ++nb)
#pragma unroll
        for (int i = 0; i < 16; ++i) acc[mb][nb][i] = 0.f;
    write_stage(0);
    if (nk > 1) issue(cur, 1);
    __syncthreads();
    if (w < 4) {
      for (int kt = 0; kt < nk; ++kt) {
        const char* la = lds + (kt & 1) * STAGE;
        if (kt + 1 < nk) write_stage((kt + 1) & 1);
        if (kt + 2 < nk) issue(cur, kt + 2);
        gemm_compute<true, WMB, WNB>(la, la + TM * 144, acc, wm, wn, r, h);
        __syncthreads();
      }
    } else {
      for (int kt = 0; kt < nk; ++kt) {
        const char* la = lds + (kt & 1) * STAGE;
        gemm_compute<true, WMB, WNB>(la, la + TM * 144, acc, wm, wn, r, h);
        if (kt + 1 < nk) write_stage((kt + 1) & 1);
        if (kt + 2 < nk) issue(cur, kt + 2);
        __syncthreads();
      }
    }
    const TileDesc nxt = desc(rnd + 1);
    if (nxt.valid) issue(nxt, 0);
    __builtin_amdgcn_sched_barrier(0);
    int m0 = cur.m0, n0 = cur.n0;
    asm volatile("" : "+s"(m0), "+s"(n0));
    int r2 = r, h2 = h, wm2 = wm, wn2 = wn;
    asm volatile("" : "+v"(r2), "+v"(h2));
    asm volatile("" : "+s"(wm2), "+s"(wn2));
    if constexpr (Epi::SWAPMODE == 2) {
      if (cur.normal) epi.template store<WMB, WNB>(m0 + wm2 * 32 * WMB, n0 + wn2 * 32 * WNB, acc, r2, h2, true);
      else epi.template store_t<WMB, WNB>(n0 + wm2 * 32 * WMB, m0 + wn2 * 32 * WNB, acc, r2, h2);
    } else {
      epi.template store<WMB, WNB>(m0 + wm2 * 32 * WMB, n0 + wn2 * 32 * WNB, acc, r2, h2, true);
    }
    if (!nxt.valid) break;
    cur = nxt;
  }
}

DI void lds_st16_as2x8(char* dst, const u32x4 v) {
  u32x2 a; a.x = v.x; a.y = v.y; u32x2 b; b.x = v.z; b.y = v.w;
  *(u32x2*)dst = a;
  *(u32x2*)(dst + 8) = b;
}
constexpr int ATT_STAGE = 35840;
constexpr float DEFER_THR = 8.f;

template <int DQK>
DI void qk_scores_acc(const char* kl, const bf16x8 (&qf)[DQK / 16], f32x16 (&s)[2], int r, int h) {
  constexpr int KS = DQK * 2 + 16;
#pragma unroll
  for (int kb = 0; kb < 2; ++kb)
#pragma unroll
    for (int ks = 0; ks < DQK / 16; ++ks) {
      const bf16x8 a = *(const bf16x8*)(kl + (32 * kb + r) * KS + (2 * ks + h) * 16);
      s[kb] = MFMA32(a, qf[ks], s[kb]);
    }
}
template <int DQK>
DI void qk_scores_qlds(const char* kl, const char* qsl, f32x16 (&s)[2], int r, int h) {
  constexpr int KS = DQK * 2 + 16;
#pragma unroll
  for (int kb = 0; kb < 2; ++kb) {
#pragma unroll
    for (int ks = 0; ks < DQK / 16; ++ks) {
      const bf16x8 a = *(const bf16x8*)(kl + (32 * kb + r) * KS + (2 * ks + h) * 16);
      const bf16x8 qv = *(const bf16x8*)(qsl + ks * 1024);
      s[kb] = MFMA32(a, qv, s[kb]);
    }
  }
}
template <int DQK>
DI void qk_scores(const char* kl, const bf16x8 (&qf)[DQK / 16], const f32x16& initv, f32x16 (&s)[2], int r, int h) {
  constexpr int KS = DQK * 2 + 16;
#pragma unroll
  for (int kb = 0; kb < 2; ++kb) {
    s[kb] = initv;
#pragma unroll
    for (int ks = 0; ks < DQK / 16; ++ks) {
      const bf16x8 a = *(const bf16x8*)(kl + (32 * kb + r) * KS + (2 * ks + h) * 16);
      s[kb] = MFMA32(a, qf[ks], s[kb]);
    }
  }
}

template <int DV>
DI float softmax_pv(f32x16 (&s)[2], f32x16 (&o)[DV / 32], float& l, bool first, const char* vl, int r, int h) {
  float dret = 0.f;
  float mx = fmaxf(fmaxf(s[0][0], s[0][1]), s[0][2]);
#pragma unroll
  for (int i = 3; i < 15; i += 2) mx = fmaxf(fmaxf(mx, s[0][i]), s[0][i + 1]);
  mx = fmaxf(fmaxf(mx, s[0][15]), s[1][0]);
#pragma unroll
  for (int i = 1; i < 15; i += 2) mx = fmaxf(fmaxf(mx, s[1][i]), s[1][i + 1]);
  mx = fmaxf(mx, s[1][15]);
  const bool need = first || (mx > DEFER_THR);
  if (__any(need)) {
    mx = fmaxf(mx, __shfl_xor(mx, 32));
    float delta;
    if (first) delta = mx;
    else {
      delta = fmaxf(mx, 0.f);
      const float alpha = fexp2(-delta);
      l *= alpha;
#pragma unroll
      for (int d = 0; d < DV / 32; ++d)
#pragma unroll
        for (int i = 0; i < 16; ++i) o[d][i] *= alpha;
    }
#pragma unroll
    for (int kb = 0; kb < 2; ++kb)
#pragma unroll
      for (int i = 0; i < 16; ++i) s[kb][i] -= delta;
    dret = delta;
  }
  float ps = 0.f;
#pragma unroll
  for (int kb = 0; kb < 2; ++kb)
#pragma unroll
    for (int i = 0; i < 16; ++i) { const float e = fexp2(s[kb][i]); s[kb][i] = e; ps += e; }
  l += ps;
  bf16x8 pf[2][2];
#pragma unroll
  for (int kb = 0; kb < 2; ++kb)
#pragma unroll
    for (int st = 0; st < 2; ++st) {
      u32x4 u;
      u.x = cvt_pk(s[kb][8 * st + 0], s[kb][8 * st + 1]); u.y = cvt_pk(s[kb][8 * st + 2], s[kb][8 * st + 3]);
      u.z = cvt_pk(s[kb][8 * st + 4], s[kb][8 * st + 5]); u.w = cvt_pk(s[kb][8 * st + 6], s[kb][8 * st + 7]);
      pf[kb][st] = __builtin_bit_cast(bf16x8, u);
    }
#pragma unroll
  for (int d = 0; d < DV / 32; ++d)
#pragma unroll
    for (int kb = 0; kb < 2; ++kb)
#pragma unroll
      for (int st = 0; st < 2; ++st) {
        const char* vp = vl + (32 * d + r) * 136 + (32 * kb + 16 * st + 4 * h) * 2;
        const u32x2 lo = *(const u32x2*)vp;
        const u32x2 hi = *(const u32x2*)(vp + 16);
        u32x4 u; u.x = lo.x; u.y = lo.y; u.z = hi.x; u.w = hi.y;
        o[d] = MFMA32(__builtin_bit_cast(bf16x8, u), pf[kb][st], o[d]);
      }
  return dret;
}

template <int DV>
DI float softmax_pre(f32x16 (&s)[2], f32x16 (&o)[DV / 32], float& l, bool first) {
  float dret = 0.f;
  float mx = fmaxf(fmaxf(s[0][0], s[0][1]), s[0][2]);
#pragma unroll
  for (int i = 3; i < 15; i += 2) mx = fmaxf(fmaxf(mx, s[0][i]), s[0][i + 1]);
  mx = fmaxf(fmaxf(mx, s[0][15]), s[1][0]);
#pragma unroll
  for (int i = 1; i < 15; i += 2) mx = fmaxf(fmaxf(mx, s[1][i]), s[1][i + 1]);
  mx = fmaxf(mx, s[1][15]);
  const bool need = first || (mx > DEFER_THR);
  if (__any(need)) {
    mx = fmaxf(mx, __shfl_xor(mx, 32));
    float delta;
    if (first) delta = mx;
    else {
      delta = fmaxf(mx, 0.f);
      const float alpha = fexp2(-delta);
      l *= alpha;
#pragma unroll
      for (int d = 0; d < DV / 32; ++d)
#pragma unroll
        for (int i = 0; i < 16; ++i) o[d][i] *= alpha;
    }
#pragma unroll
    for (int kb = 0; kb < 2; ++kb)
#pragma unroll
      for (int i = 0; i < 16; ++i) s[kb][i] -= delta;
    dret = delta;
  }
  return dret;
}
DI void softmax_exp_half(f32x16& s, float& l, bf16x8 (&pf)[2]) {
  float ps = 0.f;
#pragma unroll
  for (int i = 0; i < 16; ++i) { const float e = fexp2(s[i]); s[i] = e; ps += e; }
  l += ps;
#pragma unroll
  for (int st = 0; st < 2; ++st) {
    u32x4 u;
    u.x = cvt_pk(s[8 * st + 0], s[8 * st + 1]); u.y = cvt_pk(s[8 * st + 2], s[8 * st + 3]);
    u.z = cvt_pk(s[8 * st + 4], s[8 * st + 5]); u.w = cvt_pk(s[8 * st + 6], s[8 * st + 7]);
    pf[st] = __builtin_bit_cast(bf16x8, u);
  }
}
template <int DV>
DI void pv_half(const bf16x8 (&pf)[2], f32x16 (&o)[DV / 32], const char* vl, int kb, int r, int h) {
#pragma unroll
  for (int d = 0; d < DV / 32; ++d)
#pragma unroll
    for (int st = 0; st < 2; ++st) {
      const char* vp = vl + (32 * d + r) * 136 + (32 * kb + 16 * st + 4 * h) * 2;
      const u32x2 lo = *(const u32x2*)vp;
      const u32x2 hi = *(const u32x2*)(vp + 16);
      u32x4 u; u.x = lo.x; u.y = lo.y; u.z = hi.x; u.w = hi.y;
      o[d] = MFMA32(__builtin_bit_cast(bf16x8, u), pf[st], o[d]);
    }
}

template <int ABL>
DI void attn_mla_item(const Ctx& p, int item, char* lds) {
  constexpr int DQK = 96, DV = 64, KS = DQK * 2 + 16;
  const int tid = otid(p), lane = tid & 63, w = tid >> 6, r = lane & 31, h = lane >> 5;
  int head, qb, ts0, S;
  if (item < 1024) { head = item >> 6; qb = item & 63; ts0 = T_PROMPT; S = 16384; }
  else { const int it = item - 1024; qb = it & 15; head = (it >> 4) & 15; ts0 = (it >> 8) * 4096; S = 4096; }
  const u16* q = (const u16*)(p.ws + OFF_R2);
  const u16* knope = q + (size_t)T_TOK * 1536;
  const u16* vt = knope + (size_t)T_TOK * 1024;
  const u16* krope = (const u16*)(p.ws + OFF_KROPE);
  u16* o1 = (u16*)(p.ws + OFF_R1);
  const int tq = ts0 + qb * 256 + w * 32 + r;
  bf16x8 qf[DQK / 16];
#pragma unroll
  for (int ks = 0; ks < DQK / 16; ++ks) qf[ks] = *(const bf16x8*)(q + (size_t)tq * 1536 + head * 96 + 16 * ks + 8 * h);
  f32x16 o[DV / 32];
#pragma unroll
  for (int d = 0; d < DV / 32; ++d)
#pragma unroll
    for (int i = 0; i < 16; ++i) o[d][i] = 0.f;
  f32x16 initv;
#pragma unroll
  for (int i = 0; i < 16; ++i) initv[i] = 0.f;
  float l = 0.f;
  u32x4 pk0, pk1, pv0;
  const int c1 = 512 + tid;
  const int krow0 = tid / 12, kch0 = tid - krow0 * 12;
  const int krow1 = c1 / 12, kch1 = c1 - krow1 * 12;
  const int vrow = tid >> 3, vch = tid & 7;
  const int nkt = S >> 6;
  auto prefetch = [&](int kt) {
    const int tk0 = ts0 + kt * 64;
    {
      const u16* src = kch0 < 8 ? knope + (size_t)(tk0 + krow0) * 1024 + head * 64 + kch0 * 8 : krope + (size_t)(tk0 + krow0) * 32 + (kch0 - 8) * 8;
      pk0 = *(const u32x4*)src;
    }
    if (tid < 256) {
      const u16* src = kch1 < 8 ? knope + (size_t)(tk0 + krow1) * 1024 + head * 64 + kch1 * 8 : krope + (size_t)(tk0 + krow1) * 32 + (kch1 - 8) * 8;
      pk1 = *(const u32x4*)src;
    }
    pv0 = *(const u32x4*)(vt + (size_t)(head * 64 + vrow) * T_TOK + tk0 + vch * 8);
  };
  auto stage_at = [&](int boff) {
    char* kl = lds + boff;
    char* vl = kl + 64 * KS;
    *(u32x4*)(kl + krow0 * KS + kch0 * 16) = pk0;
    if (tid < 256) *(u32x4*)(kl + krow1 * KS + kch1 * 16) = pk1;
    lds_st16_as2x8(vl + vrow * 136 + vch * 16, pv0);
  };
  prefetch(0);
  __syncthreads();
  stage_at(0);
  prefetch(1);
  stage_at(ATT_STAGE);
  if (nkt > 2) prefetch(2);
  __syncthreads();
  int cur = 0, nxt = ATT_STAGE, nn = 2 * ATT_STAGE;
  f32x16 s[2];
  qk_scores<DQK>(lds, qf, initv, s, r, h);
#pragma unroll 1
  for (int kt = 0; kt < nkt; ++kt) {
    if (ABL == 2) { __syncthreads(); if (kt + 2 < nkt) stage_at(nn); if (kt + 3 < nkt) prefetch(kt + 3); { const int t = cur; cur = nxt; nxt = nn; nn = t; } continue; }
    const float dl = softmax_pre<DV>(s, o, l, kt == 0);
    if (__any(dl != 0.f)) {
#pragma unroll
      for (int i = 0; i < 16; ++i) initv[i] -= dl;
    }
    f32x16 sn[2];
    qk_scores<DQK>(lds + nxt, qf, initv, sn, r, h);
#pragma unroll
    for (int kb = 0; kb < 2; ++kb) {
      bf16x8 pf[2];
      softmax_exp_half(s[kb], l, pf);
      pv_half<DV>(pf, o, lds + cur + 64 * KS, kb, r, h);
    }
    if (ABL != 1) { if (kt + 2 < nkt) stage_at(nn);
    if (kt + 3 < nkt) prefetch(kt + 3); }
    __syncthreads();
    s[0] = sn[0]; s[1] = sn[1];
    const int t = cur; cur = nxt; nxt = nn; nn = t;
  }
  l += __shfl_xor(l, 32);
  const float inv = 1.f / l;
#pragma unroll
  for (int d = 0; d < DV / 32; ++d) store_tok(o1, 1024, tq, head * 64 + 32 * d + 4 * h, o[d], inv);
}

DI void attn_mla_item2(const Ctx& p, int item, char* lds) {
  constexpr int DQK = 96, DV = 64, KS = DQK * 2 + 16;
  const int tid = otid(p), lane = tid & 63, w = tid >> 6, r = lane & 31, h = lane >> 5;
  int head, qb, ts0, S;
  if (item < 512) { head = item >> 5; qb = item & 31; ts0 = T_PROMPT; S = 16384; }
  else { const int it = item - 512; qb = it & 7; head = (it >> 3) & 15; ts0 = (it >> 7) * 4096; S = 4096; }
  const u16* q = (const u16*)(p.ws + OFF_R2);
  const u16* knope = q + (size_t)T_TOK * 1536;
  const u16* vt = knope + (size_t)T_TOK * 1024;
  const u16* krope = (const u16*)(p.ws + OFF_KROPE);
  u16* o1 = (u16*)(p.ws + OFF_R1);
  const int tq0 = ts0 + qb * 512 + w * 64 + r;
  char* qsl = lds + 49152 + w * 12288 + lane * 16;
  __syncthreads();
  float qn2[2] = {0.f, 0.f};
#pragma unroll
  for (int j = 0; j < 2; ++j)
#pragma unroll
    for (int ks = 0; ks < DQK / 16; ++ks) {
      const u32x4 qv = *(const u32x4*)(q + (size_t)(tq0 + 32 * j) * 1536 + head * 96 + 16 * ks + 8 * h);
      *(u32x4*)(qsl + (j * 6 + ks) * 1024) = qv;
      float a;
      a = bflo(qv.x); qn2[j] += a * a; a = bfhi(qv.x); qn2[j] += a * a; a = bflo(qv.y); qn2[j] += a * a; a = bfhi(qv.y); qn2[j] += a * a;
      a = bflo(qv.z); qn2[j] += a * a; a = bfhi(qv.z); qn2[j] += a * a; a = bflo(qv.w); qn2[j] += a * a; a = bfhi(qv.w); qn2[j] += a * a;
    }
  float ref[2];
  {
    float kn2 = 0.f;
#pragma unroll
    for (int t = 0; t < 8; ++t) { const float v = __uint_as_float(((const unsigned*)(p.ws + OFF_SCAL))[SC_KP + head * 8 + t]); kn2 += v * v; }
    const float kr = __uint_as_float(((const unsigned*)(p.ws + OFF_SCAL))[SC_KRMAX]);
    const float kmaxn = sqrtf(kn2 + kr * kr);
#pragma unroll
    for (int j = 0; j < 2; ++j) {
      qn2[j] += __shfl_xor(qn2[j], 32);
      ref[j] = sqrtf(qn2[j]) * kmaxn * 1.02f + 0.5f;
    }
  }
  const bool fixedref = !__any(ref[0] > 60.f || ref[1] > 60.f);
  f32x16 o[2][DV / 32];
  f32x16 initv[2];
#pragma unroll
  for (int j = 0; j < 2; ++j) {
#pragma unroll
    for (int d = 0; d < DV / 32; ++d)
#pragma unroll
      for (int i = 0; i < 16; ++i) o[j][d][i] = 0.f;
#pragma unroll
    for (int i = 0; i < 16; ++i) initv[j][i] = fixedref ? -ref[j] : 0.f;
  }
  float l[2] = {0.f, 0.f};
  u32x4 pk0, pk1, pv0;
  const int c1 = 512 + (tid & 255);
  const int krow0 = tid / 12, kch0 = tid - krow0 * 12;
  const int krow1 = c1 / 12, kch1 = c1 - krow1 * 12;
  const int vrow = tid >> 3, vch = tid & 7;
  const int nkt = S >> 6;
  auto prefetch = [&](int kt) {
    const int tk0 = ts0 + kt * 64;
    {
      const u16* src = kch0 < 8 ? knope + (size_t)(tk0 + krow0) * 1024 + head * 64 + kch0 * 8 : krope + (size_t)(tk0 + krow0) * 32 + (kch0 - 8) * 8;
      pk0 = *(const u32x4*)src;
    }
    {
      const u16* src = kch1 < 8 ? knope + (size_t)(tk0 + krow1) * 1024 + head * 64 + kch1 * 8 : krope + (size_t)(tk0 + krow1) * 32 + (kch1 - 8) * 8;
      pk1 = *(const u32x4*)src;
    }
    pv0 = *(const u32x4*)(vt + (size_t)(head * 64 + vrow) * T_TOK + tk0 + vch * 8);
  };
  auto stage_at = [&](int boff) {
    char* kl = lds + boff;
    char* vl = kl + 64 * KS;
    *(u32x4*)(kl + krow0 * KS + kch0 * 16) = pk0;
    *(u32x4*)(kl + krow1 * KS + kch1 * 16) = pk1;
    lds_st16_as2x8(vl + vrow * 136 + vch * 16, pv0);
  };
  prefetch(0);
  stage_at(0);
  prefetch(1);
  __syncthreads();
#pragma unroll 1
  for (int kt = 0; kt < nkt; ++kt) {
    const char* kl = lds + (kt & 1) * 24576;
    const char* vl = kl + 64 * KS;
    if (kt + 1 < nkt) stage_at(((kt + 1) & 1) * 24576);
    if (kt + 2 < nkt) prefetch(kt + 2);
    f32x16 s[2][2];
#pragma unroll
    for (int kb = 0; kb < 2; ++kb) {
      s[0][kb] = initv[0]; s[1][kb] = initv[1];
#pragma unroll
      for (int ks = 0; ks < DQK / 16; ++ks) {
        const bf16x8 a = *(const bf16x8*)(kl + (32 * kb + r) * KS + (2 * ks + h) * 16);
        const bf16x8 q0 = *(const bf16x8*)(qsl + ks * 1024);
        const bf16x8 q1 = *(const bf16x8*)(qsl + (6 + ks) * 1024);
        s[0][kb] = MFMA32(a, q0, s[0][kb]);
        s[1][kb] = MFMA32(a, q1, s[1][kb]);
      }
    }
    if (!fixedref) {
#pragma unroll
      for (int j = 0; j < 2; ++j) {
        const float dl = softmax_pre<DV>(s[j], o[j], l[j], kt == 0);
        if (__any(dl != 0.f)) {
#pragma unroll
          for (int i = 0; i < 16; ++i) initv[j][i] -= dl;
        }
      }
    }
#pragma unroll
    for (int kb = 0; kb < 2; ++kb) {
      bf16x8 pf0[2], pf1[2];
      softmax_exp_half(s[0][kb], l[0], pf0);
      softmax_exp_half(s[1][kb], l[1], pf1);
#pragma unroll
      for (int d = 0; d < DV / 32; ++d)
#pragma unroll
        for (int st = 0; st < 2; ++st) {
          const char* vp = vl + (32 * d + r) * 136 + (32 * kb + 16 * st + 4 * h) * 2;
          const u32x2 lo = *(const u32x2*)vp;
          const u32x2 hi = *(const u32x2*)(vp + 16);
          u32x4 u; u.x = lo.x; u.y = lo.y; u.z = hi.x; u.w = hi.y;
          const bf16x8 vf = __builtin_bit_cast(bf16x8, u);
          o[0][d] = MFMA32(vf, pf0[st], o[0][d]);
          o[1][d] = MFMA32(vf, pf1[st], o[1][d]);
        }
    }
    __syncthreads();
  }
  int tid2 = otid(p);
  const int lane2 = tid2 & 63, h2 = lane2 >> 5, w2 = tid2 >> 6;
  int item2 = item; asm volatile("" : "+s"(item2));
  int head2, tq2;
  if (item2 < 512) { head2 = item2 >> 5; tq2 = T_PROMPT + (item2 & 31) * 512 + w2 * 64 + (lane2 & 31); }
  else { const int it = item2 - 512; head2 = (it >> 3) & 15; tq2 = (it >> 7) * 4096 + (it & 7) * 512 + w2 * 64 + (lane2 & 31); }
#pragma unroll
  for (int j = 0; j < 2; ++j) {
    float lj = l[j];
    lj += __shfl_xor(lj, 32);
    const float inv = __builtin_amdgcn_rcpf(lj);
#pragma unroll
    for (int d = 0; d < DV / 32; ++d) store_tok(o1, 1024, tq2 + 32 * j, head2 * 64 + 32 * d + 4 * h2, o[j][d], inv);
  }
}

DI void diff_decode(int item, int& hh, int& qb, int& ts0, int& S) {
  int j;
  if (item < 128) { hh = 3; j = item; S = 16384; }
  else if (item < 256) { hh = 2; j = item - 128; S = 16384; }
  else if (item < 768) { hh = 3; j = item - 256; S = 4096; }
  else if (item < 1280) { hh = 2; j = item - 768; S = 4096; }
  else if (item < 1408) { hh = 1; j = item - 1280; S = 16384; }
  else if (item < 1920) { hh = 1; j = item - 1408; S = 4096; }
  else if (item < 2048) { hh = 0; j = item - 1920; S = 16384; }
  else { hh = 0; j = item - 2048; S = 4096; }
  if (S == 16384) { qb = j; ts0 = T_PROMPT; } else { qb = j & 31; ts0 = (j >> 5) * 4096; }
}
DI void attn_diff_item(const Ctx& p, int item, char* lds) {
  constexpr int DQK = 64, DV = 128, KS = DQK * 2 + 16;
  const int tid = otid(p), lane = tid & 63, w = tid >> 6, r = lane & 31, h = lane >> 5;
  const int map = w >> 2, qw = w & 3;
  int hh, qb, ts0, S;
  diff_decode(item, hh, qb, ts0, S);
  const u16* base = (const u16*)(p.ws + OFF_R2);
  const u16* dq = base + 2 * SEG512;
  const u16* dk = base + 3 * SEG512;
  const u16* vtd = base + 5 * SEG512;
  u16* o0 = (u16*)(p.ws + OFF_R1);
  const int qpos = qb * 128 + qw * 32 + r;
  const int tq = ts0 + qpos;
  __syncthreads();
  float qn2 = 0.f;
  bf16x8 qf[DQK / 16];
#pragma unroll
  for (int ks = 0; ks < DQK / 16; ++ks) {
    const u32x4 qv = *(const u32x4*)(dq + (size_t)tq * 512 + (2 * hh + map) * 64 + 16 * ks + 8 * h);
    qf[ks] = __builtin_bit_cast(bf16x8, qv);
    float a;
    a = bflo(qv.x); qn2 += a * a; a = bfhi(qv.x); qn2 += a * a; a = bflo(qv.y); qn2 += a * a; a = bfhi(qv.y); qn2 += a * a;
    a = bflo(qv.z); qn2 += a * a; a = bfhi(qv.z); qn2 += a * a; a = bflo(qv.w); qn2 += a * a; a = bfhi(qv.w); qn2 += a * a;
  }
  qn2 += __shfl_xor(qn2, 32);
  f32x16 o[DV / 32];
#pragma unroll
  for (int d = 0; d < DV / 32; ++d)
#pragma unroll
    for (int i = 0; i < 16; ++i) o[d][i] = 0.f;
  float l = 0.f;
  const float refb = sqrtf(qn2) * __uint_as_float(((const unsigned*)(p.ws + OFF_SCAL))[SC_QKMAX + 8 + 2 * hh + map]) * 1.02f + 0.5f;
  const bool fixedref = !__any(refb > 60.f);
  float ref = fixedref ? refb : 0.f;
  const float slope2 = exp2f(-2.f * (float)(hh + 1)) * LOG2E;
  const float cq = slope2 * (float)qpos;
  const int d0 = 2 * qb;
  const int kd = d0 + (qw >> 1);
  int kt_lo, kt_hi;
  {
    const unsigned* qk = (const unsigned*)(p.ws + OFF_SCAL) + SC_QKMAX;
    const float b0 = __uint_as_float(qk[2 * hh]) * __uint_as_float(qk[8 + 2 * hh]);
    const float b1 = __uint_as_float(qk[2 * hh + 1]) * __uint_as_float(qk[8 + 2 * hh + 1]);
    const float B = fmaxf(b0, b1) * 1.02f + 0.5f;
    const float dskip = fminf((2.f * B + 34.f) / slope2 + 1.f, 1.0e6f);
    const int q_lo = qb * 128, q_hi = q_lo + 127, ds = (int)dskip;
    kt_lo = max(0, (q_lo - 63 - ds) >> 6);
    kt_hi = min((S >> 6) - 1, (q_hi + ds) >> 6);
    kt_lo = min(kt_lo, 2 * qb); kt_hi = max(kt_hi, 2 * qb + 1);
  }
  const int nleft = d0 - kt_lo;
  const int nkt = kt_hi - kt_lo + 1;
  u32x4 pk[2], pv[2];
  const int lrow = tid >> 3, lch = tid & 7;
  auto tile_of = [&](int idx) { return idx < 2 ? d0 + idx : (idx - 2 < nleft ? d0 - 1 - (idx - 2) : idx + kt_lo); };
  const unsigned koff = (unsigned)(((ts0 + lrow) * 512 + 2 * hh * 64 + lch * 8) * 2);
  const unsigned voff = (unsigned)((((hh * 128 + lrow) * T_TOK) + ts0 + lch * 8) * 2);
  const char* dkb = (const char*)dk;
  const char* vtb = (const char*)vtd;
  auto prefetch = [&](int kt) {
    const unsigned ko = koff + (unsigned)kt * (64u * 512u * 2u);
    const unsigned vo = voff + (unsigned)kt * 128u;
    pk[0] = *(const u32x4*)(dkb + ko);
    pk[1] = *(const u32x4*)(dkb + ko + 128u);
    pv[0] = *(const u32x4*)(vtb + vo);
    pv[1] = *(const u32x4*)(vtb + vo + (unsigned)(64 * T_TOK * 2));
  };
  auto stage_at = [&](int boff) {
    char* kl0 = lds + boff;
    char* vl = kl0 + 2 * 64 * KS;
#pragma unroll
    for (int j = 0; j < 2; ++j) *(u32x4*)(kl0 + j * 64 * KS + lrow * KS + lch * 16) = pk[j];
#pragma unroll
    for (int j = 0; j < 2; ++j) lds_st16_as2x8(vl + (lrow + 64 * j) * 136 + lch * 16, pv[j]);
  };
  auto scores = [&](int kt, int boff, f32x16 (&sc)[2]) {
    const int side = kt < kd ? -1 : (kt > kd ? 1 : 0);
    const float I = (float)side * cq - ref;
    const unsigned i_hi = cvt_pk(I, 0.f) & 0xffffu;
    const float ir1 = I - __uint_as_float(i_hi << 16);
    const unsigned i_mid = cvt_pk(ir1, 0.f) & 0xffffu;
    const float ir2 = ir1 - __uint_as_float(i_mid << 16);
    const unsigned i_lo = cvt_pk(ir2, 0.f) & 0xffffu;
    const float T = slope2 * (float)(kt * 64);
    const unsigned t_hi = cvt_pk(T, 0.f) & 0xffffu;
    const float r1 = T - __uint_as_float(t_hi << 16);
    const unsigned t_mid = cvt_pk(r1, 0.f) & 0xffffu;
    const float r2 = r1 - __uint_as_float(t_mid << 16);
    const unsigned t_lo = cvt_pk(r2, 0.f) & 0xffffu;
    const unsigned one = side < 0 ? 0x3F80u : (side > 0 ? 0xBF80u : 0u);
    u32x4 qa;
    qa.x = h == 0 ? (one | (one << 16)) : 0u; qa.y = qa.x; qa.z = h == 0 ? (one | (i_hi << 16)) : 0u; qa.w = h == 0 ? (i_mid | (i_lo << 16)) : 0u;
    const bf16x8 qaug = __builtin_bit_cast(bf16x8, qa);
#pragma unroll
    for (int kb = 0; kb < 2; ++kb) {
      const float xl = slope2 * (float)(32 * kb + r);
      const unsigned l_hi = cvt_pk(xl, 0.f) & 0xffffu;
      const unsigned l_lo = cvt_pk(xl - __uint_as_float(l_hi << 16), 0.f) & 0xffffu;
      u32x4 ka; ka.x = h == 0 ? (l_hi | (l_lo << 16)) : 0u; ka.y = h == 0 ? (t_hi | (t_mid << 16)) : 0u; ka.z = h == 0 ? (t_lo | 0x3F800000u) : 0u; ka.w = h == 0 ? 0x3F803F80u : 0u;
      f32x16 z;
#pragma unroll
      for (int i = 0; i < 16; ++i) z[i] = 0.f;
      sc[kb] = MFMA32(__builtin_bit_cast(bf16x8, ka), qaug, z);
    }
    qk_scores_acc<DQK>(lds + boff + map * 64 * KS, qf, sc, r, h);
  };
  prefetch(tile_of(0));
  __syncthreads();
  stage_at(0);
  prefetch(tile_of(1));
  __syncthreads();
#pragma unroll 1
  for (int idx = 0; idx < nkt; ++idx) {
    const int kt = tile_of(idx);
    const int cur = (idx & 1) * ATT_STAGE;
    if (idx + 1 < nkt) stage_at(((idx + 1) & 1) * ATT_STAGE);
    if (idx + 2 < nkt) prefetch(tile_of(idx + 2));
    f32x16 s[2];
    scores(kt, cur, s);
    if (kt == kd) {
#pragma unroll
      for (int kb = 0; kb < 2; ++kb)
#pragma unroll
        for (int i = 0; i < 16; ++i) {
          const int kp = kt * 64 + 32 * kb + (i & 3) + 8 * (i >> 2) + 4 * h;
          s[kb][i] -= slope2 * fabsf((float)(qpos - kp));
        }
    }
    if (!fixedref) ref += softmax_pre<DV>(s, o, l, idx == 0);
#pragma unroll
    for (int kb = 0; kb < 2; ++kb) {
      bf16x8 pf[2];
      softmax_exp_half(s[kb], l, pf);
      pv_half<DV>(pf, o, lds + cur + 2 * 64 * KS, kb, r, h);
    }
    __syncthreads();
  }
  l += __shfl_xor(l, 32);
  const float inv = 1.f / l;
  int tid2 = otid(p);
  const int lane2 = tid2 & 63, qw2 = (tid2 >> 6) & 3, h2 = lane2 >> 5;
  int item2 = item; asm volatile("" : "+s"(item2));
  int hh2, tq2;
  { int qb2, ts02, S2; diff_decode(item2, hh2, qb2, ts02, S2); tq2 = ts02 + qb2 * 128 + qw2 * 32 + (lane2 & 31); }
  float* ex = (float*)lds + qw2 * 4096;
  if (map == 1) {
#pragma unroll
    for (int d = 0; d < DV / 32; ++d)
#pragma unroll
      for (int i = 0; i < 16; ++i) ex[(d * 16 + i) * 64 + lane2] = o[d][i] * inv;
  }
  __syncthreads();
  if (map == 0) {
    const float lam = ((const float*)(p.ws + OFF_SCAL))[0];
    float ss = 0.f;
#pragma unroll
    for (int d = 0; d < DV / 32; ++d)
#pragma unroll
      for (int i = 0; i < 16; ++i) { const float v = o[d][i] * inv - lam * ex[(d * 16 + i) * 64 + lane2]; o[d][i] = v; ss += v * v; }
    ss += __shfl_xor(ss, 32);
    const float rn = rsqrtf(ss * (1.f / 128.f) + EPS) * 0.8f;
    const float* gs = (const float*)(p.ws + OFF_SCAL) + SC_GSUB;
#pragma unroll
    for (int d = 0; d < DV / 32; ++d) {
#pragma unroll
      for (int g = 0; g < 4; ++g) {
        const float4 gv = *(const float4*)(gs + 32 * d + 8 * g + 4 * h2);
        o[d][4 * g] *= gv.x; o[d][4 * g + 1] *= gv.y; o[d][4 * g + 2] *= gv.z; o[d][4 * g + 3] *= gv.w;
      }
      store_tok(o0, 1024, tq2, 512 + hh2 * 128 + 32 * d + 4 * h2, o[d], rn);
    }
  }
}

DI void attn_na_item(const Ctx& p, int item, char* lds) {
  constexpr int DQK = 64, DV = 64, KS = DQK * 2 + 16;
  const int tid = otid(p), lane = tid & 63, w = tid >> 6, r = lane & 31, h = lane >> 5;
  const int quad = item % 320, head = item / 320;
  const int t0 = quad * 256;
  int ts0, rows;
  if (t0 < T_PROMPT) { ts0 = t0 & ~4095; rows = 64; } else { ts0 = T_PROMPT; rows = 256; }
  const int r0 = (t0 - ts0) >> 6;
  const int rw = r0 + (w >> 1);
  const int rs_lo = min(max(r0 - 4, 0), rows - 8);
  const int rs_hi = min(max(r0 + 3 - 4, 0), rows - 8);
  const int rs_w = min(max(rw - 4, 0), rows - 8);
  const int ntile = rs_hi + 8 - rs_lo;
  const u16* base = (const u16*)(p.ws + OFF_R2);
  const u16* qn = base;
  const u16* kn = base + SEG512;
  const u16* vtn = base + 4 * SEG512;
  u16* o0 = (u16*)(p.ws + OFF_R1);
  float* tab = (float*)(lds + 2 * ATT_STAGE) + 64;
  const int qc = (w & 1) * 32 + r;
  const int tq = t0 + w * 32 + r;
  bf16x8 qf[DQK / 16];
#pragma unroll
  for (int ks = 0; ks < DQK / 16; ++ks) qf[ks] = *(const bf16x8*)(qn + (size_t)tq * 512 + head * 64 + 16 * ks + 8 * h);
  f32x16 o[DV / 32];
#pragma unroll
  for (int d = 0; d < DV / 32; ++d)
#pragma unroll
    for (int i = 0; i < 16; ++i) o[d][i] = 0.f;
  f32x16 initv;
#pragma unroll
  for (int i = 0; i < 16; ++i) initv[i] = 0.f;
  float l = 0.f;
  bool first = true;
  u32x4 pk0, pv0;
  const int lrow = tid >> 3, lch = tid & 7;
  auto prefetch = [&](int j) {
    const int tk0 = ts0 + (rs_lo + j) * 64;
    pk0 = *(const u32x4*)(kn + (size_t)(tk0 + lrow) * 512 + head * 64 + lch * 8);
    pv0 = *(const u32x4*)(vtn + (size_t)(head * 64 + lrow) * T_TOK + tk0 + lch * 8);
  };
  auto stage = [&](int b) {
    char* kl = lds + b * ATT_STAGE;
    char* vl = kl + 64 * KS;
    *(u32x4*)(kl + lrow * KS + lch * 16) = pk0;
    lds_st16_as2x8(vl + lrow * 136 + lch * 16, pv0);
  };
  prefetch(0);
  __syncthreads();
  if (tid < 465) tab[tid] = ((const float*)(p.ws + OFF_SCAL))[SC_RPB + head * 465 + tid];
  stage(0);
  prefetch(1);
  __syncthreads();
  const int wc0 = min(max(qc - 8, 0), 48);
  const float* tabq = tab + (15 - qc + 4 * h);
  for (int j = 0; j < ntile; ++j) {
    const char* kl = lds + (j & 1) * ATT_STAGE;
    const char* vl = kl + 64 * KS;
    const int kr = rs_lo + j;
    if (kr >= rs_w && kr < rs_w + 8) {
      f32x16 s[2];
      qk_scores<DQK>(kl, qf, initv, s, r, h);
      const int ridx = kr - rw + 7;
#pragma unroll
      for (int kb = 0; kb < 2; ++kb)
#pragma unroll
        for (int i = 0; i < 16; ++i) {
          const int kc = 32 * kb + (i & 3) + 8 * (i >> 2) + 4 * h;
          const bool ok = (unsigned)(kc - wc0) < 16u;
          float b = tabq[ridx * 31 + 32 * kb + (i & 3) + 8 * (i >> 2)];
          asm volatile("" : "+v"(b));
          s[kb][i] = ok ? s[kb][i] + b : -INFINITY;
        }
      {
        const float dl = softmax_pv<DV>(s, o, l, first, vl, r, h);
        if (__any(dl != 0.f)) {
#pragma unroll
          for (int i = 0; i < 16; ++i) initv[i] -= dl;
        }
      }
      first = false;
    }
    if (j + 1 < ntile) stage((j + 1) & 1);
    if (j + 2 < ntile) prefetch(j + 2);
    __syncthreads();
  }
  l += __shfl_xor(l, 32);
  const float inv = 1.f / l;
#pragma unroll
  for (int d = 0; d < DV / 32; ++d) store_tok(o0, 1024, tq, head * 64 + 32 * d + 4 * h, o[d], inv);
}

DI void phase_qk_norms(const Ctx& p) {
  const int tid_ = otid(p);
  const int lane = tid_ & 63;
  const int gw = obid() * 8 + (tid_ >> 6), nw = gridDim.x * 8;
  const u16* dq = (const u16*)(p.ws + OFF_R2) + 2 * SEG512;
  const u16* dk = (const u16*)(p.ws + OFF_R2) + 3 * SEG512;
  float mq = 0.f, mk = 0.f;
  for (int row = gw; row < T_TOK; row += nw) {
    const uint4 a = ((const uint4*)(dq + (size_t)row * 512))[lane];
    const uint4 b = ((const uint4*)(dk + (size_t)row * 512))[lane];
    float sa = 0.f, sb = 0.f, t;
    t = bflo(a.x); sa += t * t; t = bfhi(a.x); sa += t * t; t = bflo(a.y); sa += t * t; t = bfhi(a.y); sa += t * t;
    t = bflo(a.z); sa += t * t; t = bfhi(a.z); sa += t * t; t = bflo(a.w); sa += t * t; t = bfhi(a.w); sa += t * t;
    t = bflo(b.x); sb += t * t; t = bfhi(b.x); sb += t * t; t = bflo(b.y); sb += t * t; t = bfhi(b.y); sb += t * t;
    t = bflo(b.z); sb += t * t; t = bfhi(b.z); sb += t * t; t = bflo(b.w); sb += t * t; t = bfhi(b.w); sb += t * t;
#pragma unroll
    for (int o = 1; o < 8; o <<= 1) { sa += __shfl_xor(sa, o); sb += __shfl_xor(sb, o); }
    mq = fmaxf(mq, sa); mk = fmaxf(mk, sb);
  }
  if ((lane & 7) == 0) {
    unsigned* qk = (unsigned*)(p.ws + OFF_SCAL) + SC_QKMAX;
    atomicMax(qk + (lane >> 3), __float_as_uint(sqrtf(mq)));
    atomicMax(qk + 8 + (lane >> 3), __float_as_uint(sqrtf(mk)));
  }
}

namespace pg8 {
#define PG8_LAS __attribute__((address_space(3)))
typedef unsigned short bf16_t;
typedef short bf16x8 __attribute__((ext_vector_type(8)));
typedef float f32x4 __attribute__((ext_vector_type(4)));
typedef unsigned u32x4 __attribute__((ext_vector_type(4)));
constexpr int BM = 256, BK = 64, HALF = 128, HTB = HALF * BK * 2  , STAGE_BYTES = 8 * HTB, NXCD = 8, WGM = 8;

__host__ __device__ __forceinline__ int lds_byte(int r, int c) { const int st = (r >> 4) * 2 + (c >> 5), rr = r & 15, cc = c & 31, ob = rr * 64 + cc * 2; return st * 1024 + (ob ^ (((ob >> 9) & 1) << 5)); }
__host__ __device__ __forceinline__ void stage_rc(int b, int& R, int& C) { const int st = b / 1024, sb = b % 1024, swz = sb ^ (((sb >> 9) & 1) << 5); R = (st >> 1) * 16 + swz / 64; C = (st & 1) * 32 + (swz % 64) / 2; }
__host__ __device__ __forceinline__ int perm32(int rho) { const int n = rho >> 4, i = rho & 15; return 8 * (i >> 2) + 4 * n + (i & 3); }

struct Unit { int pm, pn; };
struct Gemm { const bf16_t* A; const bf16_t* Bt; int M, N, K; int lda, ldb; };

struct StaticOrder {
    int nM, nN, nwg, G, c;
    __host__ __device__ void init(int M, int N, int G_, int c_) { nM = M / BM; nN = N / BM; nwg = nM * nN; G = G_; c = c_; }
    __host__ __device__ bool next(int i, Unit& u) const {
        const long L = (long)i * G + c; if (L >= nwg) return false;
        int wgid = (int)L; { const int q = nwg / NXCD, r = nwg % NXCD, xcd = wgid % NXCD, off = wgid / NXCD; wgid = (xcd < r ? xcd * (q + 1) : r * (q + 1) + (xcd - r) * q) + off; }
        const int nig = WGM * nN, gid = wgid / nig, fm = gid * WGM, gsz = (nM - fm) < WGM ? (nM - fm) : WGM;
        u.pm = fm + ((wgid % nig) % gsz); u.pn = (wgid % nig) / gsz; return true;
    }
    __device__ __forceinline__ void a_ready(const Unit&) const {}
    __device__ __forceinline__ void done(const Unit&) const {}
};
struct CountedOrder : StaticOrder {
    const unsigned* ready; unsigned need; unsigned* tmo;
    __device__ __forceinline__ void a_ready(const Unit& u) const {
        if (threadIdx.x < 64) {
            const unsigned long long t0 = __builtin_amdgcn_s_memrealtime(); unsigned polls = 0;
            while ((unsigned)__builtin_amdgcn_readfirstlane(__hip_atomic_load(ready + 64 * u.pm, __ATOMIC_RELAXED, __HIP_MEMORY_SCOPE_AGENT)) < need) {
                if ((++polls & 255u) == 0u && __builtin_amdgcn_readfirstlane(__hip_atomic_load(tmo, __ATOMIC_RELAXED, __HIP_MEMORY_SCOPE_AGENT)) != 0u) break;
                if (__builtin_amdgcn_s_memrealtime() - t0 > 2000000ull) {
                    if (threadIdx.x == 0) { unsigned expect = 0u; __hip_atomic_compare_exchange_strong(tmo + 1, &expect, 0x600u | (unsigned)(u.pm & 0xff), __ATOMIC_RELAXED, __ATOMIC_RELAXED, __HIP_MEMORY_SCOPE_AGENT); __hip_atomic_store(tmo, 1u, __ATOMIC_RELAXED, __HIP_MEMORY_SCOPE_AGENT); }
                    break; }
                __builtin_amdgcn_s_sleep(2); }
            __builtin_amdgcn_fence(__ATOMIC_ACQUIRE, "agent");
            asm volatile("s_waitcnt vmcnt(0)" ::: "memory");
        }
#if !defined(BROKEN_HOOK_NO_BARRIER)
        asm volatile("" ::: "memory"); __builtin_amdgcn_s_barrier(); asm volatile("" ::: "memory");
#endif
    }
};

__device__ __forceinline__ unsigned cvt_pk_bf16(float lo, float hi) { unsigned r; asm volatile("v_cvt_pk_bf16_f32 %0, %1, %2" : "=v"(r) : "v"(lo), "v"(hi)); return r; }
typedef float f32x2 __attribute__((ext_vector_type(2)));
__device__ __forceinline__ f32x2 gelu_pk(f32x2 v) {
    const f32x2 av = __builtin_elementwise_abs(v), d = av * 0.2316418882f + 1.0f;
    f32x2 t; t.x = __builtin_amdgcn_rcpf(d.x); t.y = __builtin_amdgcn_rcpf(d.y);
    f32x2 q = t * 0.5307027145f + (-0.7265760135f); q = q * t + 0.7107068705f; q = q * t + (-0.142248368f); q = q * t + 0.127414796f; q = q * t;
    const f32x2 s = (v * v) * (-0.72134752044f);
    f32x2 e; e.x = __builtin_amdgcn_exp2f(s.x); e.y = __builtin_amdgcn_exp2f(s.y);
    const f32x2 m = v * (q * e), r = v - m;
    f32x2 o; o.x = v.x < 0.f ? m.x : r.x; o.y = v.y < 0.f ? m.y : r.y; return o;
}

struct EpiF32 {
    static constexpr bool PERM = false, AFTER_DRAIN = false;
    float* C; int ldc; const float* bias;
    __device__ __forceinline__ void operator()(const f32x4 (&acc)[2][2][4][2], const Unit& u, int wr, int wc, int fr, int fq) const {
        const int row0 = u.pm * BM + wr * 64 + fr, col0 = u.pn * BM + wc * 32 + 4 * fq;
        f32x4 bv[2][2];
#pragma unroll
        for (int bj = 0; bj < 2; ++bj)
#pragma unroll
            for (int n = 0; n < 2; ++n) bv[bj][n] = bias ? *(const f32x4*)(bias + col0 + bj * HALF + n * 16) : (f32x4){0.f, 0.f, 0.f, 0.f};
#pragma unroll
        for (int ai = 0; ai < 2; ++ai)
#pragma unroll
            for (int m = 0; m < 4; ++m) { float* rowp = C + (size_t)(row0 + ai * HALF + m * 16) * ldc + col0;
#pragma unroll
                for (int bj = 0; bj < 2; ++bj)
#pragma unroll
                    for (int n = 0; n < 2; ++n) *(f32x4*)(rowp + bj * HALF + n * 16) = acc[ai][bj][m][n] + bv[bj][n]; }
    }
};
template <int ACT  > struct EpiBf16 {
    static constexpr bool PERM = true, AFTER_DRAIN = false;
    bf16_t* O; int ldc; const float* bias; int split_cols; size_t split_stride;
    __device__ __forceinline__ void operator()(const f32x4 (&acc)[2][2][4][2], const Unit& u, int wr, int wc, int fr, int fq) const {
        const int row0 = u.pm * BM + wr * 64 + fr; int colt = u.pn * BM; bf16_t* base = O;
        if (split_cols) { const int t = colt / split_cols; base += (size_t)t * split_stride; colt -= t * split_cols; }
        const int col0 = colt + wc * 32 + 8 * fq, bcol0 = u.pn * BM + wc * 32 + 8 * fq;
        f32x4 bv[2][2];
#pragma unroll
        for (int bj = 0; bj < 2; ++bj)
#pragma unroll
            for (int n = 0; n < 2; ++n) bv[bj][n] = bias ? *(const f32x4*)(bias + bcol0 + bj * HALF + 4 * n) : (f32x4){0.f, 0.f, 0.f, 0.f};
#pragma unroll
        for (int ai = 0; ai < 2; ++ai)
#pragma unroll
            for (int m = 0; m < 4; ++m) { bf16_t* rowp = base + (size_t)(row0 + ai * HALF + m * 16) * ldc + col0;
#pragma unroll
                for (int bj = 0; bj < 2; ++bj) { f32x4 v0 = acc[ai][bj][m][0] + bv[bj][0], v1 = acc[ai][bj][m][1] + bv[bj][1];
                    if (ACT == 1) { f32x2 a = gelu_pk((f32x2){v0[0], v0[1]}), b = gelu_pk((f32x2){v0[2], v0[3]}), c = gelu_pk((f32x2){v1[0], v1[1]}), d = gelu_pk((f32x2){v1[2], v1[3]});
                        v0 = (f32x4){a.x, a.y, b.x, b.y}; v1 = (f32x4){c.x, c.y, d.x, d.y}; }
                    if (ACT == 2) {
#pragma unroll
                        for (int j = 0; j < 4; ++j) { v0[j] = 0.5f * v0[j] * (1.0f + erff(v0[j] * 0.70710678f)); v1[j] = 0.5f * v1[j] * (1.0f + erff(v1[j] * 0.70710678f)); } }
                    u32x4 w; w.x = cvt_pk_bf16(v0[0], v0[1]); w.y = cvt_pk_bf16(v0[2], v0[3]); w.z = cvt_pk_bf16(v1[0], v1[1]); w.w = cvt_pk_bf16(v1[2], v1[3]);
                    *(u32x4*)(rowp + bj * HALF) = w; } }
    }
};

struct PanelStats {
    unsigned* xbuf;
    unsigned* cnt;
    unsigned* tmo;
    int ntn; float eps;
    unsigned code;
    __device__ __forceinline__ bool run(const f32x4 (&v)[2][2][4][2], const Unit& u, int wr, int wc, int fr, int fq, PG8_LAS unsigned char* lds, int wid, int lane) const {
        typedef float f32x2v __attribute__((ext_vector_type(2)));
        PG8_LAS f32x2v* P = (PG8_LAS f32x2v*)lds;
        PG8_LAS f32x2v* S = (PG8_LAS f32x2v*)(lds + 8192);
        PG8_LAS unsigned* flag = (PG8_LAS unsigned*)(lds + 8192 + 2048);
#pragma unroll
        for (int ai = 0; ai < 2; ++ai)
#pragma unroll
            for (int m = 0; m < 4; ++m) {
                float s = 0.f;
#pragma unroll
                for (int bj = 0; bj < 2; ++bj)
#pragma unroll
                    for (int n = 0; n < 2; ++n) { const f32x4 x = v[ai][bj][m][n]; s += (x[0] + x[1]) + (x[2] + x[3]); }
                s += __shfl_xor(s, 16); s += __shfl_xor(s, 32);
                const float mw = s * (1.0f / 64.0f); float q = 0.f;
#pragma unroll
                for (int bj = 0; bj < 2; ++bj)
#pragma unroll
                    for (int n = 0; n < 2; ++n) { const f32x4 d = v[ai][bj][m][n] - mw; q += (d[0] * d[0] + d[1] * d[1]) + (d[2] * d[2] + d[3] * d[3]); }
                q += __shfl_xor(q, 16); q += __shfl_xor(q, 32);
                if (fq == 0) P[(ai * HALF + wr * 64 + m * 16 + fr) * 4 + wc] = (f32x2v){mw, q};
            }
        asm volatile("s_waitcnt lgkmcnt(0)" ::: "memory"); __builtin_amdgcn_s_barrier(); asm volatile("" ::: "memory");
#if defined(BROKEN_NO_WAIT)
        if (blockIdx.x >= 64) { const long long t0 = clock64(); while (clock64() - t0 < 60000) __builtin_amdgcn_s_sleep(8); }
#endif
        const int row = wid * 32 + (lane & 31);
        if (lane < 32) {
            const f32x2v a = P[row * 4 + 0], b = P[row * 4 + 1], c = P[row * 4 + 2], d = P[row * 4 + 3];
            const float mt = (a.x + b.x + c.x + d.x) * 0.25f;
            const float da = a.x - mt, db = b.x - mt, dc = c.x - mt, dd = d.x - mt;
            const float m2 = (a.y + b.y) + (c.y + d.y) + 64.0f * ((da * da + db * db) + (dc * dc + dd * dd));
            unsigned long long* slot = (unsigned long long*)xbuf + ((size_t)(u.pm * BM + row) * 4 + u.pn);
            __hip_atomic_store(slot, ((unsigned long long)__float_as_uint(m2) << 32) | __float_as_uint(mt), __ATOMIC_RELAXED, __HIP_MEMORY_SCOPE_AGENT);
        }
        asm volatile("s_waitcnt vmcnt(0)" ::: "memory");
        if (lane == 0) __hip_atomic_fetch_add(cnt + 64 * u.pm, 1u, __ATOMIC_RELAXED, __HIP_MEMORY_SCOPE_AGENT);
        if (wid == 0) {
            bool dead = false; const unsigned long long t0 = __builtin_amdgcn_s_memrealtime(); const unsigned want = 8u * (unsigned)ntn;
            for (;;) {
#if defined(BROKEN_NO_WAIT)
                break;
#endif
                if ((unsigned)__builtin_amdgcn_readfirstlane(__hip_atomic_load(cnt + 64 * u.pm, __ATOMIC_RELAXED, __HIP_MEMORY_SCOPE_AGENT)) >= want) break;
                if (__builtin_amdgcn_s_memrealtime() - t0 > 2000000ull) {
                    if (lane == 0) { unsigned expect = 0u; __hip_atomic_compare_exchange_strong(tmo + 1, &expect, code | (unsigned)(u.pm & 0xff), __ATOMIC_RELAXED, __ATOMIC_RELAXED, __HIP_MEMORY_SCOPE_AGENT);
                                     __hip_atomic_store(tmo, 1u, __ATOMIC_RELAXED, __HIP_MEMORY_SCOPE_AGENT); }
                    dead = true; break; }
                __builtin_amdgcn_s_sleep(2);
            }
            __builtin_amdgcn_fence(__ATOMIC_ACQUIRE, "agent");
            if (lane == 0) flag[0] = dead ? 1u : 0u;
        }
        asm volatile("s_waitcnt vmcnt(0) lgkmcnt(0)" ::: "memory"); __builtin_amdgcn_s_barrier(); asm volatile("" ::: "memory");
        const bool bad = flag[0] != 0u;
        if (lane < 32) {
            const unsigned long long* slot = (const unsigned long long*)xbuf + (size_t)(u.pm * BM + row) * 4; float mt[4], m2[4]; float ms = 0.f;
#pragma unroll
            for (int t = 0; t < 4; ++t) { if (t < ntn) { const unsigned long long w = __hip_atomic_load(slot + t, __ATOMIC_RELAXED, __HIP_MEMORY_SCOPE_AGENT); mt[t] = __uint_as_float((unsigned)w); m2[t] = __uint_as_float((unsigned)(w >> 32)); } else { mt[t] = 0.f; m2[t] = 0.f; } ms += mt[t]; }
            const float mean = ms / (float)ntn; float q = 0.f;
#pragma unroll
            for (int t = 0; t < 4; ++t) if (t < ntn) { const float dm = mt[t] - mean; q += m2[t] + 256.0f * dm * dm; }
            S[row] = (f32x2v){mean, 1.0f / sqrtf(q / (256.0f * (float)ntn) + eps)};
        }
        asm volatile("s_waitcnt lgkmcnt(0)" ::: "memory"); __builtin_amdgcn_s_barrier(); asm volatile("" ::: "memory");
        return bad;
    }
};
struct EpiLnRes {
    static constexpr bool PERM = false, AFTER_DRAIN = true;
    const float* base; float* out; int ldc; const float* bias; PanelStats st; unsigned poison;
    __device__ __forceinline__ void refuse(size_t i0, size_t stride, int M, int N) const { const float q = __builtin_nanf(""); for (size_t i = i0; i < (size_t)M * N; i += stride) out[(i / N) * ldc + i % N] = q;
        if (i0 == 0) { unsigned expect = 0u; __hip_atomic_compare_exchange_strong(st.tmo + 1, &expect, 0x7f0u, __ATOMIC_RELAXED, __ATOMIC_RELAXED, __HIP_MEMORY_SCOPE_AGENT); __hip_atomic_store(st.tmo, 1u, __ATOMIC_RELAXED, __HIP_MEMORY_SCOPE_AGENT); } }
    __device__ __forceinline__ void fused(f32x4 (&acc)[2][2][4][2], const Unit& u, int wr, int wc, int fr, int fq, PG8_LAS unsigned char* lds, int wid, int lane) const {
        typedef float f32x2v __attribute__((ext_vector_type(2)));
        const PG8_LAS f32x2v* S = (const PG8_LAS f32x2v*)(lds + 8192);
        const int col0 = u.pn * BM + wc * 32 + 4 * fq;
#pragma unroll
        for (int bj = 0; bj < 2; ++bj)
#pragma unroll
            for (int n = 0; n < 2; ++n) { const f32x4 bv = bias ? *(const f32x4*)(bias + col0 + bj * HALF + n * 16) : (f32x4){0.f, 0.f, 0.f, 0.f};
#pragma unroll
                for (int ai = 0; ai < 2; ++ai)
#pragma unroll
                    for (int m = 0; m < 4; ++m) acc[ai][bj][m][n] += bv; }
        const bool bad = st.run(acc, u, wr, wc, fr, fq, lds, wid, lane) || poison != 0u;
        const float qnan = __builtin_nanf("");
#pragma unroll
        for (int ai = 0; ai < 2; ++ai)
#pragma unroll
            for (int m = 0; m < 4; ++m) { const int r = ai * HALF + wr * 64 + m * 16 + fr; const f32x2v sr = S[r]; const size_t off = (size_t)(u.pm * BM + r) * ldc + col0;
#pragma unroll
                for (int bj = 0; bj < 2; ++bj)
#pragma unroll
                    for (int n = 0; n < 2; ++n) { const f32x4 bs = *(const f32x4*)(base + off + bj * HALF + n * 16); f32x4 o = bs + (acc[ai][bj][m][n] - sr.x) * sr.y;
                        if (bad) o = (f32x4){qnan, qnan, qnan, qnan}; *(f32x4*)(out + off + bj * HALF + n * 16) = o; }
                asm volatile("" ::: "memory"); }
    }
};
struct EpiLnResLn {
    static constexpr bool PERM = false, AFTER_DRAIN = true;
    const float* base; float* out; bf16_t* xn; int ldc; const float* bias; PanelStats st1, st2; unsigned poison;
    __device__ __forceinline__ void refuse(size_t i0, size_t stride, int M, int N) const { const float q = __builtin_nanf(""); for (size_t i = i0; i < (size_t)M * N; i += stride) { const size_t o = (i / N) * ldc + i % N; out[o] = q; xn[o] = (bf16_t)0x7fc0u; }
        if (i0 == 0) { unsigned expect = 0u; __hip_atomic_compare_exchange_strong(st1.tmo + 1, &expect, 0x7f0u, __ATOMIC_RELAXED, __ATOMIC_RELAXED, __HIP_MEMORY_SCOPE_AGENT); __hip_atomic_store(st1.tmo, 1u, __ATOMIC_RELAXED, __HIP_MEMORY_SCOPE_AGENT); } }
    __device__ __forceinline__ void fused(f32x4 (&acc)[2][2][4][2], const Unit& u, int wr, int wc, int fr, int fq, PG8_LAS unsigned char* lds, int wid, int lane) const {
        typedef float f32x2v __attribute__((ext_vector_type(2))); typedef unsigned u32x2v __attribute__((ext_vector_type(2)));
        const PG8_LAS f32x2v* S = (const PG8_LAS f32x2v*)(lds + 8192);
        const int col0 = u.pn * BM + wc * 32 + 4 * fq;
#pragma unroll
        for (int bj = 0; bj < 2; ++bj)
#pragma unroll
            for (int n = 0; n < 2; ++n) { const f32x4 bv = bias ? *(const f32x4*)(bias + col0 + bj * HALF + n * 16) : (f32x4){0.f, 0.f, 0.f, 0.f};
#pragma unroll
                for (int ai = 0; ai < 2; ++ai)
#pragma unroll
                    for (int m = 0; m < 4; ++m) acc[ai][bj][m][n] += bv; }
        bool bad = st1.run(acc, u, wr, wc, fr, fq, lds, wid, lane) || poison != 0u;
        const float qnan = __builtin_nanf("");
#pragma unroll
        for (int ai = 0; ai < 2; ++ai)
#pragma unroll
            for (int m = 0; m < 4; ++m) { const int r = ai * HALF + wr * 64 + m * 16 + fr; const f32x2v sr = S[r]; const size_t off = (size_t)(u.pm * BM + r) * ldc + col0;
#pragma unroll
                for (int bj = 0; bj < 2; ++bj)
#pragma unroll
                    for (int n = 0; n < 2; ++n) { const f32x4 bs = *(const f32x4*)(base + off + bj * HALF + n * 16); acc[ai][bj][m][n] = bs + (acc[ai][bj][m][n] - sr.x) * sr.y; }
                asm volatile("" : "+v"(acc[ai][0][m][0]), "+v"(acc[ai][0][m][1]), "+v"(acc[ai][1][m][0]), "+v"(acc[ai][1][m][1]));
                if (m & 1) asm volatile("" ::: "memory"); }
        const bool bad1 = bad;
        bad = st2.run(acc, u, wr, wc, fr, fq, lds, wid, lane) || bad;
#pragma unroll
        for (int ai = 0; ai < 2; ++ai)
#pragma unroll
            for (int m = 0; m < 4; ++m) { const int r = ai * HALF + wr * 64 + m * 16 + fr; const f32x2v sr = S[r]; const size_t off = (size_t)(u.pm * BM + r) * ldc + col0;
#pragma unroll
                for (int bj = 0; bj < 2; ++bj)
#pragma unroll
                    for (int n = 0; n < 2; ++n) { const f32x4 x1 = acc[ai][bj][m][n]; *(f32x4*)(out + off + bj * HALF + n * 16) = bad1 ? (f32x4){qnan, qnan, qnan, qnan} : x1;
                        const f32x4 o = (x1 - sr.x) * sr.y; u32x2v w; w.x = cvt_pk_bf16(o[0], o[1]); w.y = cvt_pk_bf16(o[2], o[3]);
                        if (bad) { w.x = 0x7fc07fc0u; w.y = 0x7fc07fc0u; } *(u32x2v*)(xn + off + bj * HALF + n * 16) = w; }
                asm volatile("" ::: "memory"); }
    }
};

template <class Epi, class Sched, bool STAMP = false>
__device__ __forceinline__ void gemm_phase(PG8_LAS unsigned char* lds, const Gemm g, const Sched& S, const Epi& E, unsigned long long* stamps, const int tid) {
    const int wid = __builtin_amdgcn_readfirstlane(tid >> 6), lane = tid & 63, wr = wid >> 2, wc = wid & 3, fr = lane & 15, fq = lane >> 4;
    const int K = g.K, nt = K / BK;
    int ts_lo = 0, ts_hi = 0, nts = 0; const unsigned long long rt_entry = STAMP ? (unsigned long long)wall_clock64() : 0ull;
#define PG8_STAMP() do { if (STAMP && wid == 0 && nts < 64) { const unsigned long long _c = (unsigned long long)clock64(); \
        ts_lo = (lane == nts) ? (int)(unsigned)_c : ts_lo; ts_hi = (lane == nts) ? (int)(unsigned)(_c >> 32) : ts_hi; ++nts; } } while (0)
    PG8_STAMP();
    unsigned voffA[2], voffB[2];
#pragma unroll
    for (int i = 0; i < 2; ++i) { int R, C; stage_rc(tid * 16 + i * 8192, R, C); const int Rb = Epi::PERM ? ((R & ~31) + perm32(R & 31)) : R;
        voffA[i] = (unsigned)(R * g.lda + C) * 2u; voffB[i] = (unsigned)(Rb * g.ldb + C) * 2u; }
    const size_t kstep = (size_t)(BK * 2);
    const size_t hstepA = (size_t)HALF * g.lda * 2, hstepB = (size_t)HALF * g.ldb * 2;
    const size_t tstepA = 2 * hstepA, tstepB = 2 * hstepB;
    const unsigned ldsw = (unsigned)wid * 1024u;
    const int aoff = lds_byte(wr * 64 + fr, fq * 8), boff = lds_byte(wc * 32 + fr, fq * 8);
#define PG8_SA(b, h) (((b) * 2 + (h)) * HTB)
#define PG8_SB(b, h) ((4 + (b) * 2 + (h)) * HTB)
#define PG8_STAGE(bufoff, gbase, voff) do { _Pragma("unroll") for (int _i = 0; _i < 2; ++_i) \
        __builtin_amdgcn_global_load_lds((const unsigned*)((const char*)(gbase) + (voff)[_i]), (PG8_LAS unsigned*)(lds + (bufoff) + ldsw + _i * 8192), 16, 0, 0); } while (0)
#define PG8_LDA(dst, b, h) do { _Pragma("unroll") for (int m = 0; m < 4; ++m) _Pragma("unroll") for (int k = 0; k < 2; ++k) dst[m][k] = *(const PG8_LAS bf16x8*)(lds + PG8_SA(b, h) + aoff + m * 2048 + k * 1024); } while (0)
#define PG8_LDB(dst, b, h) do { _Pragma("unroll") for (int n = 0; n < 2; ++n) _Pragma("unroll") for (int k = 0; k < 2; ++k) dst[n][k] = *(const PG8_LAS bf16x8*)(lds + PG8_SB(b, h) + boff + n * 2048 + k * 1024); } while (0)
#define PG8_MMA(ai, bj, At, Bt) do { __builtin_amdgcn_s_setprio(1); _Pragma("unroll") for (int m = 0; m < 4; ++m) _Pragma("unroll") for (int n = 0; n < 2; ++n) _Pragma("unroll") for (int k = 0; k < 2; ++k) \
        acc[ai][bj][m][n] = __builtin_amdgcn_mfma_f32_16x16x32_bf16(Bt[n][k], At[m][k], acc[ai][bj][m][n], 0, 0, 0); __builtin_amdgcn_s_setprio(0); } while (0)
#define PG8_WAIT_V(n) asm volatile("s_waitcnt vmcnt(" #n ")" ::: "memory")
#define PG8_WAIT_L(n) asm volatile("s_waitcnt lgkmcnt(" #n ")" ::: "memory")
#define PG8_BAR __builtin_amdgcn_s_barrier()
#define PG8_SCHED __builtin_amdgcn_sched_barrier(0)
    Unit cur, nxt; int ui = 0;
    if (!S.next(0, cur)) return;
    f32x4 acc[2][2][4][2];
#pragma unroll
    for (int a = 0; a < 2; ++a)
#pragma unroll
        for (int b = 0; b < 2; ++b)
#pragma unroll
            for (int m = 0; m < 4; ++m)
#pragma unroll
                for (int n = 0; n < 2; ++n) acc[a][b][m][n] = (f32x4){0.f, 0.f, 0.f, 0.f};
    bf16x8 At[4][2], B0[2][2], B1[2][2];
    const char* cA = (const char*)g.A + (size_t)cur.pm * tstepA; const char* cB = (const char*)g.Bt + (size_t)cur.pn * tstepB;
    S.a_ready(cur);
    PG8_STAGE(PG8_SB(0, 0), cB, voffB); PG8_STAGE(PG8_SA(0, 0), cA, voffA); PG8_STAGE(PG8_SB(0, 1), cB + hstepB, voffB); PG8_STAGE(PG8_SA(0, 1), cA + hstepA, voffA);
    if (wr == 1) PG8_BAR;
    PG8_WAIT_V(4); PG8_BAR;
    PG8_STAGE(PG8_SB(1, 0), cB + kstep, voffB); PG8_STAGE(PG8_SA(1, 0), cA + kstep, voffA); PG8_STAGE(PG8_SB(1, 1), cB + hstepB + kstep, voffB);
    PG8_WAIT_V(6); PG8_BAR;
    PG8_STAMP();
    for (;;) {
        const bool has_next = S.next(ui + 1, nxt);
        const char* nA = has_next ? (const char*)g.A + (size_t)nxt.pm * tstepA : cA; const char* nB = has_next ? (const char*)g.Bt + (size_t)nxt.pn * tstepB : cB;
        for (int t = 0; t < nt; t += 2) {
            const bool last = (t == nt - 2);
            const char* a1 = cA + (size_t)(t + 1) * kstep;
            const char* a2 = last ? nA : cA + (size_t)(t + 2) * kstep; const char* b2 = last ? nB : cB + (size_t)(t + 2) * kstep;
            const char* a3 = a2 + kstep; const char* b3 = b2 + kstep;
            if (last && has_next) S.a_ready(nxt);
            PG8_LDB(B0, 0, 0); PG8_SCHED; PG8_LDA(At, 0, 0); PG8_STAGE(PG8_SA(1, 1), a1 + hstepA, voffA);
            PG8_WAIT_L(8); PG8_BAR; PG8_WAIT_L(0); PG8_MMA(0, 0, At, B0); PG8_BAR; PG8_SCHED;
            PG8_LDB(B1, 0, 1); PG8_STAGE(PG8_SB(0, 0), b2, voffB);
            PG8_BAR; PG8_WAIT_L(0); PG8_MMA(0, 1, At, B1); PG8_BAR;
            PG8_LDA(At, 0, 1); PG8_STAGE(PG8_SA(0, 0), a2, voffA);
            PG8_BAR; PG8_WAIT_L(0); PG8_MMA(1, 0, At, B0); PG8_BAR; PG8_SCHED;
            PG8_STAGE(PG8_SB(0, 1), b2 + hstepB, voffB);
            PG8_WAIT_V(6); PG8_BAR; PG8_MMA(1, 1, At, B1); PG8_BAR;
            PG8_LDB(B0, 1, 0); PG8_SCHED; PG8_LDA(At, 1, 0); PG8_STAGE(PG8_SA(0, 1), a2 + hstepA, voffA);
            PG8_WAIT_L(8); PG8_BAR; PG8_WAIT_L(0); PG8_MMA(0, 0, At, B0); PG8_BAR; PG8_SCHED;
            PG8_LDB(B1, 1, 1); PG8_STAGE(PG8_SB(1, 0), b3, voffB);
            PG8_BAR; PG8_WAIT_L(0); PG8_MMA(0, 1, At, B1); PG8_BAR;
            PG8_LDA(At, 1, 1); PG8_STAGE(PG8_SA(1, 0), a3, voffA);
            PG8_BAR; PG8_WAIT_L(0); PG8_MMA(1, 0, At, B0); PG8_BAR; PG8_SCHED;
            PG8_STAGE(PG8_SB(1, 1), b3 + hstepB, voffB);
            PG8_WAIT_V(6); PG8_BAR; PG8_MMA(1, 1, At, B1); PG8_BAR;
        }
        PG8_STAMP();
        if constexpr (!Epi::AFTER_DRAIN) { E(acc, cur, wr, wc, fr, fq); S.done(cur); }
        PG8_STAMP();
        if (!has_next) break;
#pragma unroll
        for (int a = 0; a < 2; ++a)
#pragma unroll
            for (int b = 0; b < 2; ++b)
#pragma unroll
                for (int m = 0; m < 4; ++m)
#pragma unroll
                    for (int n = 0; n < 2; ++n) acc[a][b][m][n] = (f32x4){0.f, 0.f, 0.f, 0.f};
        cur = nxt; cA = nA; cB = nB; ++ui;
    }
    PG8_WAIT_V(0);
    if (wr == 0) PG8_BAR;
    PG8_BAR;
    if constexpr (Epi::AFTER_DRAIN) { E.fused(acc, cur, wr, wc, fr, fq, lds, wid, lane); S.done(cur); }
    PG8_STAMP();
    if (STAMP && wid == 0) { stamps[lane] = lane < nts ? (((unsigned long long)(unsigned)ts_hi << 32) | (unsigned)ts_lo) : 0ull;
        if (lane == 62) stamps[62] = rt_entry; if (lane == 63) stamps[63] = (unsigned long long)wall_clock64(); }
#undef PG8_STAMP
#undef PG8_SA
#undef PG8_SB
#undef PG8_STAGE
#undef PG8_LDA
#undef PG8_LDB
#undef PG8_MMA
#undef PG8_WAIT_V
#undef PG8_WAIT_L
#undef PG8_BAR
#undef PG8_SCHED
}
}

struct PgEpiSwiGLU {
  static constexpr bool PERM = true, AFTER_DRAIN = false;
  u16* act;
  __device__ __forceinline__ void operator()(const pg8::f32x4 (&acc)[2][2][4][2], const pg8::Unit& u, int wr, int wc, int fr, int fq) const {
    const int row0 = u.pm * 256 + wr * 64 + fr, j0 = u.pn * 128 + wc * 32 + 8 * fq;
#pragma unroll
    for (int ai = 0; ai < 2; ++ai)
#pragma unroll
      for (int m = 0; m < 4; ++m) {
        unsigned pk[4];
#pragma unroll
        for (int n = 0; n < 2; ++n) {
          float y[4];
#pragma unroll
          for (int e = 0; e < 4; ++e) {
            const float gt = acc[ai][0][m][n][e], up = acc[ai][1][m][n][e];
            y[e] = gt * __builtin_amdgcn_rcpf(1.f + fexp2(-LOG2E * gt)) * up;
          }
          pk[2 * n] = cvt_pk(y[0], y[1]); pk[2 * n + 1] = cvt_pk(y[2], y[3]);
        }
        u32x4 w4; w4.x = pk[0]; w4.y = pk[1]; w4.z = pk[2]; w4.w = pk[3];
        *(u32x4*)(act + (size_t)(row0 + ai * 128 + m * 16) * DFF + j0) = w4;
      }
  }
};
template <class Epi>
DI void pg_gemm(const u16* A, const u16* Bt, int M, int N, int K, const Epi& E, char* lds, int bid, int nblk, const Ctx& p) {
  pg8::Gemm g{A, Bt, M, N, K, K, K};
  pg8::StaticOrder S; S.init(M, N, nblk, bid);
  pg8::gemm_phase<Epi, pg8::StaticOrder, false>((PG8_LAS unsigned char*)lds, g, S, E, nullptr, otid(p));
}

constexpr int LDS_BYTES = 2 * (256 + 256) * 144;

struct PgEpiUQ {
  static constexpr bool PERM = false, AFTER_DRAIN = false;
  u16* q; const float* rq; const float2* rope;
  __device__ __forceinline__ void operator()(const pg8::f32x4 (&acc)[2][2][4][2], const pg8::Unit& u, int wr, int wc, int fr, int fq) const {
    const int row0 = u.pm * 256 + wr * 64 + fr;
#pragma unroll
    for (int ai = 0; ai < 2; ++ai)
#pragma unroll
      for (int m = 0; m < 4; ++m) {
        const int row = row0 + ai * 128 + m * 16;
        const float sc = rq[row] * QSCALE96;
        const int pos = tok_pos(row);
#pragma unroll
        for (int bj = 0; bj < 2; ++bj) {
          const int gb = u.pn * 256 + bj * 128 + wc * 32;
          pg8::f32x4 v0 = acc[ai][bj][m][0] * sc, v1 = acc[ai][bj][m][1] * sc;
          if (((gb >> 5) % 3) == 2) {
            const float4 ca = *(const float4*)(rope + pos * 16 + 4 * fq), cb = *(const float4*)(rope + pos * 16 + 4 * fq + 2);
            const float cs[4] = {ca.x, ca.z, cb.x, cb.z}, sn[4] = {ca.y, ca.w, cb.y, cb.w};
#pragma unroll
            for (int e = 0; e < 4; ++e) { const float x1 = v0[e], x2 = v1[e]; v0[e] = x1 * cs[e] - x2 * sn[e]; v1[e] = x2 * cs[e] + x1 * sn[e]; }
          }
          u16* dst = q + (size_t)row * 1536 + gb + 4 * fq;
          u32x2 w0; w0.x = cvt_pk(v0[0], v0[1]); w0.y = cvt_pk(v0[2], v0[3]);
          u32x2 w1; w1.x = cvt_pk(v1[0], v1[1]); w1.y = cvt_pk(v1[2], v1[3]);
          *(u32x2*)dst = w0;
          *(u32x2*)(dst + 16) = w1;
        }
      }
  }
};
struct PgEpiKnope {
  static constexpr bool PERM = true, AFTER_DRAIN = false;
  u16* knope; const float* rkv; unsigned* kp;
  __device__ __forceinline__ void operator()(const pg8::f32x4 (&acc)[2][2][4][2], const pg8::Unit& u, int wr, int wc, int fr, int fq) const {
    const int row0 = u.pm * 256 + wr * 64 + fr;
    float pm[2] = {0.f, 0.f};
#pragma unroll
    for (int ai = 0; ai < 2; ++ai)
#pragma unroll
      for (int m = 0; m < 4; ++m) {
        const int row = row0 + ai * 128 + m * 16;
        const float sc = rkv[row];
#pragma unroll
        for (int bj = 0; bj < 2; ++bj) {
          const pg8::f32x4 v0 = acc[ai][bj][m][0] * sc, v1 = acc[ai][bj][m][1] * sc;
          u32x4 w4; w4.x = cvt_pk(v0[0], v0[1]); w4.y = cvt_pk(v0[2], v0[3]); w4.z = cvt_pk(v1[0], v1[1]); w4.w = cvt_pk(v1[2], v1[3]);
          *(u32x4*)(knope + (size_t)row * 1024 + u.pn * 256 + bj * 128 + wc * 32 + 8 * fq) = w4;
          float ss = 0.f;
#pragma unroll
          for (int e = 0; e < 4; ++e) ss += v0[e] * v0[e] + v1[e] * v1[e];
          pm[bj] = fmaxf(pm[bj], ss);
        }
      }
#pragma unroll
    for (int bj = 0; bj < 2; ++bj) {
      float v = pm[bj];
      v = fmaxf(v, __int_as_float(__builtin_amdgcn_ds_swizzle(__float_as_int(v), (8 << 10) | 0x1f)));
      v = fmaxf(v, __int_as_float(__builtin_amdgcn_ds_swizzle(__float_as_int(v), (4 << 10) | 0x1f)));
      v = fmaxf(v, __int_as_float(__builtin_amdgcn_ds_swizzle(__float_as_int(v), (2 << 10) | 0x1f)));
      v = fmaxf(v, __int_as_float(__builtin_amdgcn_ds_swizzle(__float_as_int(v), (1 << 10) | 0x1f)));
      if (fr == 0) atomicMax(kp + ((u.pn * 256 + bj * 128 + wc * 32) >> 6) * 8 + ((wc & 1) << 2) + fq, __float_as_uint(sqrtf(v) * 1.01f));
    }
  }
};
struct PgEpiVt {
  static constexpr bool PERM = true, AFTER_DRAIN = false;
  u16* vt; const float* rkv;
  __device__ __forceinline__ void operator()(const pg8::f32x4 (&acc)[2][2][4][2], const pg8::Unit& u, int wr, int wc, int fr, int fq) const {
    const int row0 = u.pm * 256 + wr * 64 + fr;
#pragma unroll
    for (int bj = 0; bj < 2; ++bj) {
      const int c0 = u.pn * 256 + bj * 128 + wc * 32 + 8 * fq;
      const float4 s0 = *(const float4*)(rkv + c0), s1 = *(const float4*)(rkv + c0 + 4);
#pragma unroll
      for (int ai = 0; ai < 2; ++ai)
#pragma unroll
        for (int m = 0; m < 4; ++m) {
          const pg8::f32x4 v0 = acc[ai][bj][m][0], v1 = acc[ai][bj][m][1];
          u32x4 w4; w4.x = cvt_pk(v0[0] * s0.x, v0[1] * s0.y); w4.y = cvt_pk(v0[2] * s0.z, v0[3] * s0.w);
          w4.z = cvt_pk(v1[0] * s1.x, v1[1] * s1.y); w4.w = cvt_pk(v1[2] * s1.z, v1[3] * s1.w);
          *(u32x4*)(vt + (size_t)(row0 + ai * 128 + m * 16) * T_TOK + c0) = w4;
        }
    }
  }
};
template <class Epi>
DI void pg_gemm_ld(const u16* A, int lda, const u16* Bt, int ldb, int M, int N, int K, const Epi& E, char* lds, int bid, int nblk, const Ctx& p) {
  pg8::Gemm g{A, Bt, M, N, K, lda, ldb};
  pg8::StaticOrder S; S.init(M, N, nblk, bid);
  pg8::gemm_phase<Epi, pg8::StaticOrder, false>((PG8_LAS unsigned char*)lds, g, S, E, nullptr, otid(p));
}

DI void grid_barrier(unsigned* ctr, unsigned target, const Ctx& p) {
  __syncthreads();
  if (otid(p) < 64) {
    __builtin_amdgcn_fence(__ATOMIC_RELEASE, "agent");
    if (otid(p) == 0) {
      __hip_atomic_fetch_add(ctr, 1u, __ATOMIC_RELAXED, __HIP_MEMORY_SCOPE_AGENT);
      while (__hip_atomic_load(ctr, __ATOMIC_RELAXED, __HIP_MEMORY_SCOPE_AGENT) < target) __builtin_amdgcn_s_sleep(1);
    }
    __builtin_amdgcn_fence(__ATOMIC_ACQUIRE, "agent");
  }
  __syncthreads();
}
template <int PH>
DI void run_phase(const Ctx& p, char* lds) {
  const int bid = obid(), nblk = gridDim.x;
  u16* wb = (u16*)p.ws;
  u16* R1 = (u16*)(p.ws + OFF_R1);
  u16* R2 = (u16*)(p.ws + OFF_R2);
  u16* R3 = (u16*)(p.ws + OFF_R3);
  if constexpr (PH == 0) phase_prep(p);
  else if constexpr (PH == 1) {
    pg_gemm(R1, wb + W0IN, T_TOK, 2048, 1024, pg8::EpiBf16<0>{R2, 512, nullptr, 512, SEG512}, lds, bid, nblk, p);
    pg_gemm(wb + W0IN + (size_t)2048 * 1024, R1, 1024, T_TOK, 1024, pg8::EpiBf16<0>{R2 + 4 * SEG512, T_TOK, nullptr, 0, 0}, lds, bid, nblk, p);
    grid_barrier((unsigned*)(p.ws + OFF_SCAL) + SC_BAR2, (unsigned)nblk, p);
    phase_qk_norms(p);
  }
  else if constexpr (PH == 2) {
    unsigned* ctr = (unsigned*)(p.ws + OFF_SCAL) + SC_CTR;
    int* nxt_slot = (int*)(lds + LDS_BYTES - 16);
    const int tid0 = otid(p);
    int it = bid;
    while (it < 5120) {
      int nx = 0;
      if (tid0 == 0) nx = (int)atomicAdd(ctr, 1u) + nblk;
      if (it < 2560) attn_diff_item(p, it, lds);
      else attn_na_item(p, it - 2560, lds);
      __syncthreads();
      if (tid0 == 0) *nxt_slot = nx;
      __syncthreads();
      it = *nxt_slot;
    }
  }
  else if constexpr (PH == 3) pg_gemm(R1, wb + W0OUT, T_TOK, 1024, 1024, pg8::EpiBf16<0>{R3, 1024, nullptr, 0, 0}, lds, bid, nblk, p);
  else if constexpr (PH == 4) phase_res<true, false>(p, R3, (const float*)(p.ws + OFF_SCAL) + SC_G0);
  else if constexpr (PH == 5) pg_gemm(R1, wb + W0F1, T_TOK, 5632, 1024, PgEpiSwiGLU{R2}, lds, bid, nblk, p);
  else if constexpr (PH == 6) pg_gemm(R2, wb + W0F2, T_TOK, 1024, 2816, pg8::EpiBf16<0>{R3, 1024, nullptr, 0, 0}, lds, bid, nblk, p);
  else if constexpr (PH == 7) phase_res<false, false>(p, R3, (const float*)(p.ws + OFF_SCAL) + SC_G1);
  else if constexpr (PH == 8) pg_gemm(R1, wb + W1DN, T_TOK, 768, 1024, pg8::EpiBf16<0>{R3, 768, nullptr, 0, 0}, lds, bid, nblk, p);
  else if constexpr (PH == 9) phase_mla_stats(p);
  else if constexpr (PH == 10) {
    pg_gemm_ld(R3, 768, wb + W1UQ, 384, T_TOK, 1536, 384, PgEpiUQ{R2, (const float*)(p.ws + OFF_RQ), (const float2*)(p.ws + OFF_ROPE)}, lds, bid, nblk, p);
    pg_gemm_ld(R3 + 384, 768, wb + W1UKV, 256, T_TOK, 1024, 256,
               PgEpiKnope{R2 + (size_t)T_TOK * 1536, (const float*)(p.ws + OFF_RKV), (unsigned*)(p.ws + OFF_SCAL) + SC_KP}, lds, bid, nblk, p);
    pg_gemm_ld(wb + W1UKV + (size_t)1024 * 256, 256, R3 + 384, 768, 1024, T_TOK, 256,
               PgEpiVt{R2 + (size_t)T_TOK * 2560, (const float*)(p.ws + OFF_RKV)}, lds, bid, nblk, p);
  }
  else if constexpr (PH == 11) { for (int it = bid; it < 2560; it += nblk) {
      int itm = it;
      if (nblk == 256) {
        const int rnd = it >> 8, x = bid & 7, j = bid >> 3;
        itm = rnd < 2 ? (8 * rnd + x) * 32 + j : 512 + (2 * (rnd - 2) + (x >> 2)) * 128 + (4 * (x & 3) + (j >> 3)) * 8 + (j & 7);
      }
      attn_mla_item2(p, itm, lds);
    } }
  else if constexpr (PH == 12) pg_gemm(R1, wb + W1OUT, T_TOK, 1024, 1024, pg8::EpiBf16<0>{R3, 1024, nullptr, 0, 0}, lds, bid, nblk, p);
  else if constexpr (PH == 13) phase_res<false, false>(p, R3, (const float*)(p.ws + OFF_SCAL) + SC_G2);
  else if constexpr (PH == 14) pg_gemm(R1, wb + W1F1, T_TOK, 5632, 1024, PgEpiSwiGLU{R2}, lds, bid, nblk, p);
  else if constexpr (PH == 15) pg_gemm(R2, wb + W1F2, T_TOK, 1024, 2816, pg8::EpiBf16<0>{R3, 1024, nullptr, 0, 0}, lds, bid, nblk, p);
  else if constexpr (PH == 16) phase_res<false, true>(p, R3, (const float*)(p.ws + OFF_SCAL) + SC_G3);
}

#if MULTI_LAUNCH
template <int PH>
__global__ void __launch_bounds__(512, 2) k_phase(Params pa) {
  extern __shared__ __attribute__((aligned(16))) char lds[];
  Ctx p;
#pragma unroll
  for (int i = 0; i < 28; ++i) p.in[i] = pa.in[i];
  p.out = pa.out; p.ws = pa.ws;
  p.wv = __builtin_amdgcn_readfirstlane((int)(threadIdx.x >> 6));
  run_phase<PH>(p, lds);
}
template <int PH>
static void launch_all(const Params& p, int grid, hipStream_t stream) {
  (void)hipFuncSetAttribute((const void*)k_phase<PH>, hipFuncAttributeMaxDynamicSharedMemorySize, LDS_BYTES);
  hipLaunchKernelGGL(k_phase<PH>, dim3(grid), dim3(512), LDS_BYTES, stream, p);
  if constexpr (PH + 1 < NPHASE) launch_all<PH + 1>(p, grid, stream);
}
#define OCC_KERNEL k_phase<2>
#else
#ifndef PROBE_DUP
#define PROBE_DUP -1
#endif
#ifndef PROBE_DUP2
#define PROBE_DUP2 -1
#endif
template <int PH>
DI void run_from(const Ctx& p, char* lds) {
  if constexpr (PH == PROBE_DUP || PH == PROBE_DUP2) { run_phase<PH>(p, lds); cg::this_grid().sync(); }
#ifdef PROBE_ABL
  if constexpr (PH == 11) { for (int it = obid(); it < 5120; it += gridDim.x) attn_mla_item<PROBE_ABL>(p, it, lds); cg::this_grid().sync(); }
#endif
  run_phase<PH>(p, lds);
  if constexpr (PH + 1 < NPHASE) {
    if constexpr (PH == 0) cg::this_grid().sync();
    else grid_barrier((unsigned*)(p.ws + OFF_SCAL) + SC_BAR, (unsigned)PH * gridDim.x, p);
    run_from<PH + 1>(p, lds);
  }
}
__global__ void __launch_bounds__(512, 2) mega(Params pa) {
  extern __shared__ __attribute__((aligned(16))) char lds[];
  Ctx p;
#pragma unroll
  for (int i = 0; i < 28; ++i) p.in[i] = pa.in[i];
  p.out = pa.out; p.ws = pa.ws;
  p.wv = __builtin_amdgcn_readfirstlane((int)(threadIdx.x >> 6));
  run_from<0>(p, lds);
}
#define OCC_KERNEL mega
#endif

extern "C" void kernel_launch(void* const* d_in, const int* in_sizes, int n_in, void* d_out, int out_size, void* d_ws, size_t ws_size,
                              hipStream_t stream) {
  static int grid = 0;
  if (grid == 0) {
    if (n_in != 28 || ws_size < WS_NEED) { fprintf(stderr, "kernel_launch: unexpected n_in %d / ws_size %zu (need %zu)\n", n_in, ws_size, (size_t)WS_NEED); grid = -1; return; }
    int dev = 0, cus = 0, per_cu = 0;
    (void)hipGetDevice(&dev);
    (void)hipDeviceGetAttribute(&cus, hipDeviceAttributeMultiprocessorCount, dev);
    (void)hipFuncSetAttribute((const void*)OCC_KERNEL, hipFuncAttributeMaxDynamicSharedMemorySize, LDS_BYTES);
    (void)hipOccupancyMaxActiveBlocksPerMultiprocessor(&per_cu, (const void*)OCC_KERNEL, 512, LDS_BYTES);
    if (per_cu < 1) per_cu = 1;
    if (per_cu > 1) per_cu = 1;
    grid = cus * per_cu;
  }
  if (grid < 0) return;
  Params p{};
  for (int i = 0; i < 28; ++i) p.in[i] = (const float*)d_in[i];
  p.out = (float*)d_out;
  p.ws = (char*)d_ws;
#if MULTI_LAUNCH
  launch_all<0>(p, grid, stream);
#else
  void* args[] = {&p};
  hipError_t e = hipLaunchCooperativeKernel((const void*)mega, dim3(grid), dim3(512), args, LDS_BYTES, stream);
  if (e != hipSuccess) fprintf(stderr, "cooperative launch failed: %s (grid %d)\n", hipGetErrorString(e), grid);
#endif
}
```

```cpp
#include <hip/hip_runtime.h>
#include <hip/hip_cooperative_groups.h>
#include <stdint.h>
#include <cstdio>
namespace cg = cooperative_groups;

#ifndef MULTI_LAUNCH
#define MULTI_LAUNCH 0
#endif

typedef unsigned short u16;
typedef __attribute__((ext_vector_type(8))) short bf16x8;
typedef __attribute__((ext_vector_type(16))) float f32x16;
typedef __attribute__((ext_vector_type(4))) unsigned u32x4;

#define MFMA32(a, b, c) __builtin_amdgcn_mfma_f32_32x32x16_bf16((a), (b), (c), 0, 0, 0)
#define DI __device__ __forceinline__

constexpr int T_TOK = 81920;
constexpr int T_PROMPT = 65536;
constexpr int DM = 1024;
constexpr int DFF = 2816;
constexpr float EPS = 1e-6f;
constexpr float LOG2E = 1.4426950408889634f;
constexpr float QSCALE64 = 0.125f * LOG2E;
constexpr float QSCALE96 = 0.10206207261596577f * LOG2E;
constexpr int NPHASE = 17;

constexpr size_t MiB = (size_t)1 << 20;
constexpr size_t W0IN = 0;
constexpr size_t W0OUT = W0IN + (size_t)3072 * 1024;
constexpr size_t W0F1 = W0OUT + (size_t)1024 * 1024;
constexpr size_t W0F2 = W0F1 + (size_t)5632 * 1024;
constexpr size_t W1DN = W0F2 + (size_t)1024 * 2816;
constexpr size_t W1UQ = W1DN + (size_t)768 * 1024;
constexpr size_t W1UKV = W1UQ + (size_t)1536 * 384;
constexpr size_t W1OUT = W1UKV + (size_t)2048 * 256;
constexpr size_t W1F1 = W1OUT + (size_t)1024 * 1024;
constexpr size_t W1F2 = W1F1 + (size_t)5632 * 1024;
constexpr size_t W_END = W1F2 + (size_t)1024 * 2816;
static_assert(W_END * 2 <= 48 * MiB, "weights region");
constexpr size_t OFF_ROPE = 48 * MiB;
constexpr size_t OFF_RQ = OFF_ROPE + 2 * MiB;
constexpr size_t OFF_RKV = OFF_RQ + MiB / 2;
constexpr size_t OFF_KROPE = OFF_RKV + MiB / 2;
constexpr size_t OFF_SCAL = OFF_KROPE + 5 * MiB;
constexpr int SC_KP = 64;
constexpr int SC_QKMAX = 16, SC_CTR = 32, SC_BAR = 33, SC_BAR2 = 34, SC_KMAX1 = 40, SC_KRMAX = 56;
constexpr int SC_G0 = 1024, SC_G1 = 2048, SC_G2 = 3072, SC_G3 = 4096, SC_GSUB = 5120, SC_RPB = 6144;
constexpr size_t OFF_R1 = 58 * MiB;
constexpr size_t OFF_R3 = OFF_R1 + 160 * MiB;
constexpr size_t OFF_R2 = OFF_R3 + 160 * MiB;
constexpr size_t WS_NEED = OFF_R2 + 560 * MiB;
constexpr size_t SEG512 = (size_t)T_TOK * 512;

struct Params {
  const float* in[28];
  float* out;
  char* ws;
};
struct Ctx {
  const float* in[28];
  float* out;
  char* ws;
  int wv;
};

DI u16 f2bf(float x) { unsigned u = __float_as_uint(x); u += 0x7fffu + ((u >> 16) & 1u); return (u16)(u >> 16); }
DI unsigned pack2(float a, float b) { return (unsigned)f2bf(a) | ((unsigned)f2bf(b) << 16); }
DI float bflo(unsigned v) { return __uint_as_float(v << 16); }
DI float bfhi(unsigned v) { return __uint_as_float(v & 0xffff0000u); }
DI float wave_sum(float v) {
#pragma unroll
  for (int o = 32; o; o >>= 1) v += __shfl_xor(v, o);
  return v;
}
DI int tok_pos(int t) { return t < T_PROMPT ? (t & 4095) : (t - T_PROMPT); }
DI float fexp2(float x) { return __builtin_amdgcn_exp2f(x); }
typedef __attribute__((ext_vector_type(2))) float f32x2;
typedef __attribute__((ext_vector_type(2))) __bf16 bf16x2_t;
typedef __attribute__((ext_vector_type(2))) unsigned u32x2;
typedef __attribute__((ext_vector_type(4))) unsigned u32x4_;
DI unsigned cvt_pk(float a, float b) {
  f32x2 v; v.x = a; v.y = b;
  return __builtin_bit_cast(unsigned, __builtin_convertvector(v, bf16x2_t));
}
DI int otid(const Ctx& p) {
  int wv = p.wv; asm volatile("" : "+s"(wv));
  int t = wv * 64 + (int)__builtin_amdgcn_mbcnt_hi(~0u, __builtin_amdgcn_mbcnt_lo(~0u, 0u));
  asm volatile("" : "+v"(t));
  return t;
}
DI int obid() { int b = blockIdx.x; asm volatile("" : "+s"(b)); return b; }

__device__ const float ROPE_INV[16] = {1.0f, 0.5623413324356079f, 0.3162277638912201f, 0.17782793939113617f, 0.10000000149011612f, 0.05623413249850273f, 0.03162277489900589f, 0.017782794311642647f, 0.009999999776482582f, 0.005623413249850273f, 0.003162277629598975f, 0.0017782794311642647f, 0.0010000000474974513f, 0.000562341301701963f, 0.0003162277571391314f, 0.00017782794020604342f};

DI void wconv(const float* __restrict__ W, const float* __restrict__ g, u16* __restrict__ dst, int K, int N, int rowsOut, int perm, int gtid, int gthreads) {
  const int kc = K >> 3;
  const long total = (long)rowsOut * kc;
  for (long c = gtid; c < total; c += gthreads) {
    const int n = (int)(c % rowsOut);
    const int k0 = (int)(c / rowsOut) * 8;
    int sc;
    if (perm == 1) { const int blk = n >> 8, w = n & 255; const int j = blk * 128 + (w & 127); sc = (w < 128) ? j : DFF + j; }
    else if (perm == 3) { sc = n < 1024 ? n : (n < 2048 ? n + 512 : (n < 2560 ? n - 1024 : n)); }
    else if (perm == 2) { const int hd = (n & 1023) >> 6, d = n & 63; sc = hd * 128 + (n >= 1024 ? 64 : 0) + d; }
    else sc = n;
    uint4 o = make_uint4(0, 0, 0, 0);
    if (sc < N) {
      float v[8];
      const float rsc = (perm == 3 && (n < 512 || (n >= 1024 && n < 1536))) ? QSCALE64 : 1.f;
#pragma unroll
      for (int i = 0; i < 8; ++i) { float x = W[(size_t)(k0 + i) * N + sc]; if (g) x *= g[k0 + i]; v[i] = x * rsc; }
      o.x = pack2(v[0], v[1]); o.y = pack2(v[2], v[3]); o.z = pack2(v[4], v[5]); o.w = pack2(v[6], v[7]);
    }
    *(uint4*)(dst + (size_t)n * K + k0) = o;
  }
}

DI void phase_prep(const Ctx& p) {
  const int gtid = obid() * 512 + otid(p), gthreads = gridDim.x * 512;
  u16* wb = (u16*)p.ws;
  wconv(p.in[3], p.in[2], wb + W0IN, 1024, 3072, 3072, 3, gtid, gthreads);
  wconv(p.in[10], nullptr, wb + W0OUT, 1024, 1024, 1024, 0, gtid, gthreads);
  wconv(p.in[13], p.in[12], wb + W0F1, 1024, 5632, 5632, 1, gtid, gthreads);
  wconv(p.in[14], nullptr, wb + W0F2, 2816, 1024, 1024, 0, gtid, gthreads);
  wconv(p.in[17], p.in[16], wb + W1DN, 1024, 672, 768, 0, gtid, gthreads);
  wconv(p.in[20], p.in[18], wb + W1UQ, 384, 1536, 1536, 0, gtid, gthreads);
  wconv(p.in[21], p.in[19], wb + W1UKV, 256, 2048, 2048, 2, gtid, gthreads);
  wconv(p.in[22], nullptr, wb + W1OUT, 1024, 1024, 1024, 0, gtid, gthreads);
  wconv(p.in[25], p.in[24], wb + W1F1, 1024, 5632, 5632, 1, gtid, gthreads);
  wconv(p.in[26], nullptr, wb + W1F2, 2816, 1024, 1024, 0, gtid, gthreads);
  float2* rope = (float2*)(p.ws + OFF_ROPE);
  for (int idx = gtid; idx < 16384 * 16; idx += gthreads) {
    const int pos = idx >> 4, i = idx & 15;
    const float ang = (float)pos * ROPE_INV[i];
    double rev = (double)ang * 0.15915494309189535;
    rev -= rint(rev);
    const float rf = (float)rev;
    rope[idx] = make_float2(__builtin_amdgcn_cosf(rf), __builtin_amdgcn_sinf(rf));
  }
  if (gtid == 0) {
    float s1 = 0.f, s2 = 0.f;
    for (int i = 0; i < 64; ++i) { s1 += p.in[5][i] * p.in[6][i]; s2 += p.in[7][i] * p.in[8][i]; }
    float* sc = (float*)(p.ws + OFF_SCAL);
    sc[0] = __expf(s1) - __expf(s2) + 0.2f;
    for (int i = 0; i < 176; ++i) ((unsigned*)sc)[SC_QKMAX + i] = 0u;
  }
  {
    float* sc = (float*)(p.ws + OFF_SCAL);
    for (int i = gtid; i < 1024; i += gthreads) { sc[SC_G0 + i] = p.in[11][i]; sc[SC_G1 + i] = p.in[15][i]; sc[SC_G2 + i] = p.in[23][i]; sc[SC_G3 + i] = p.in[27][i]; }
    for (int i = gtid; i < 128; i += gthreads) sc[SC_GSUB + i] = p.in[9][i];
    for (int i = gtid; i < 8 * 465; i += gthreads) sc[SC_RPB + i] = p.in[4][i] * LOG2E;
  }
  const int tid_ = otid(p);
  const int lane = tid_ & 63;
  const int gw = obid() * 8 + (tid_ >> 6), nw = gridDim.x * 8;
  u16* hb = (u16*)(p.ws + OFF_R1);
  for (int row = gw; row < T_TOK; row += nw) {
    const float* xr = row < T_PROMPT ? p.in[0] + (size_t)row * DM : p.in[1] + (size_t)(row - T_PROMPT) * DM;
    float4 v[4];
    float ss = 0.f;
#pragma unroll
    for (int j = 0; j < 4; ++j) { v[j] = ((const float4*)xr)[lane + 64 * j]; ss += v[j].x * v[j].x + v[j].y * v[j].y + v[j].z * v[j].z + v[j].w * v[j].w; }
    ss = wave_sum(ss);
    const float r = rsqrtf(ss * (1.f / DM) + EPS);
#pragma unroll
    for (int j = 0; j < 4; ++j) {
      uint2 o; o.x = pack2(v[j].x * r, v[j].y * r); o.y = pack2(v[j].z * r, v[j].w * r);
      ((uint2*)(hb + (size_t)row * DM))[lane + 64 * j] = o;
    }
  }
}

template <bool FIRST, bool LAST>
DI void phase_res(const Ctx& p, const u16* __restrict__ mbuf, const float* __restrict__ g) {
  const int tid_ = otid(p);
  const int lane = tid_ & 63;
  const int gw = obid() * 8 + (tid_ >> 6), nw = gridDim.x * 8;
  u16* hb = (u16*)(p.ws + OFF_R1);
  float4 gv[4];
#pragma unroll
  for (int j = 0; j < 4; ++j) gv[j] = ((const float4*)g)[lane + 64 * j];
  for (int row0 = gw; row0 < T_TOK; row0 += 2 * nw) {
    float4 xv[2][4], mv[2][4];
    float ss[2] = {0.f, 0.f};
    bool act[2];
#pragma unroll
    for (int t = 0; t < 2; ++t) {
      const int row = row0 + t * nw;
      act[t] = row < T_TOK;
      const int rr = act[t] ? row : row0;
      const float* xr;
      if (FIRST) xr = rr < T_PROMPT ? p.in[0] + (size_t)rr * DM : p.in[1] + (size_t)(rr - T_PROMPT) * DM;
      else xr = p.out + (size_t)rr * DM;
#pragma unroll
      for (int j = 0; j < 4; ++j) {
        const uint2 u = ((const uint2*)(mbuf + (size_t)rr * DM))[lane + 64 * j];
        mv[t][j] = make_float4(bflo(u.x), bfhi(u.x), bflo(u.y), bfhi(u.y));
        xv[t][j] = ((const float4*)xr)[lane + 64 * j];
      }
    }
#pragma unroll
    for (int t = 0; t < 2; ++t) {
#pragma unroll
      for (int j = 0; j < 4; ++j) ss[t] += mv[t][j].x * mv[t][j].x + mv[t][j].y * mv[t][j].y + mv[t][j].z * mv[t][j].z + mv[t][j].w * mv[t][j].w;
      ss[t] = wave_sum(ss[t]);
    }
#pragma unroll
    for (int t = 0; t < 2; ++t) {
      if (!act[t]) continue;
      const int row = row0 + t * nw;
      const float rm = rsqrtf(ss[t] * (1.f / DM) + EPS);
      float s2 = 0.f;
#pragma unroll
      for (int j = 0; j < 4; ++j) {
        xv[t][j].x += mv[t][j].x * rm * gv[j].x; xv[t][j].y += mv[t][j].y * rm * gv[j].y;
        xv[t][j].z += mv[t][j].z * rm * gv[j].z; xv[t][j].w += mv[t][j].w * rm * gv[j].w;
        s2 += xv[t][j].x * xv[t][j].x + xv[t][j].y * xv[t][j].y + xv[t][j].z * xv[t][j].z + xv[t][j].w * xv[t][j].w;
        ((float4*)(p.out + (size_t)row * DM))[lane + 64 * j] = xv[t][j];
      }
      if (!LAST) {
        s2 = wave_sum(s2);
        const float r2 = rsqrtf(s2 * (1.f / DM) + EPS);
#pragma unroll
        for (int j = 0; j < 4; ++j) {
          uint2 o; o.x = pack2(xv[t][j].x * r2, xv[t][j].y * r2); o.y = pack2(xv[t][j].z * r2, xv[t][j].w * r2);
          ((uint2*)(hb + (size_t)row * DM))[lane + 64 * j] = o;
        }
      }
    }
  }
}

DI void phase_mla_stats(const Ctx& p) {
  const int tid_ = otid(p);
  const int lane = tid_ & 63;
  const int gw = obid() * 8 + (tid_ >> 6), nw = gridDim.x * 8;
  const u16* c = (const u16*)(p.ws + OFF_R3);
  float* rq = (float*)(p.ws + OFF_RQ);
  float* rkv = (float*)(p.ws + OFF_RKV);
  u16* krope = (u16*)(p.ws + OFF_KROPE);
  const float2* rope = (const float2*)(p.ws + OFF_ROPE);
  float krmax2 = 0.f;
  for (int row = gw; row < T_TOK; row += nw) {
    const u16* cr = c + (size_t)row * 768;
    const uint4 u0 = ((const uint4*)cr)[lane];
    float s0 = 0.f;
    { float a;
      a = bflo(u0.x); s0 += a * a; a = bfhi(u0.x); s0 += a * a; a = bflo(u0.y); s0 += a * a; a = bfhi(u0.y); s0 += a * a;
      a = bflo(u0.z); s0 += a * a; a = bfhi(u0.z); s0 += a * a; a = bflo(u0.w); s0 += a * a; a = bfhi(u0.w); s0 += a * a; }
    float s1 = 0.f;
    if (lane < 16) {
      const uint4 u1 = ((const uint4*)cr)[64 + lane];
      float a;
      a = bflo(u1.x); s1 += a * a; a = bfhi(u1.x); s1 += a * a; a = bflo(u1.y); s1 += a * a; a = bfhi(u1.y); s1 += a * a;
      a = bflo(u1.z); s1 += a * a; a = bfhi(u1.z); s1 += a * a; a = bflo(u1.w); s1 += a * a; a = bfhi(u1.w); s1 += a * a;
    }
    const float sq = wave_sum(lane < 48 ? s0 : 0.f);
    const float skv = wave_sum((lane >= 48 ? s0 : 0.f) + s1);
    if (lane == 0) {
      rq[row] = rsqrtf(sq * (1.f / 384.f) + EPS);
      rkv[row] = rsqrtf(skv * (1.f / 256.f) + EPS);
    }
    float kr2 = 0.f;
    if (lane < 16) {
      const float x1 = __uint_as_float((unsigned)cr[640 + lane] << 16);
      const float x2 = __uint_as_float((unsigned)cr[656 + lane] << 16);
      const float2 cs = rope[tok_pos(row) * 16 + lane];
      const float o1 = x1 * cs.x - x2 * cs.y, o2 = x2 * cs.x + x1 * cs.y;
      krope[(size_t)row * 32 + lane] = f2bf(o1);
      krope[(size_t)row * 32 + 16 + lane] = f2bf(o2);
      kr2 = o1 * o1 + o2 * o2;
    }
    krmax2 = fmaxf(krmax2, wave_sum(kr2));
  }
  if (lane == 0) atomicMax((unsigned*)(p.ws + OFF_SCAL) + SC_KRMAX, __float_as_uint(sqrtf(krmax2)));
}

DI void store_tok(u16* out, int ldo, int m, int nbase, const f32x16& v, float sc) {
  u16* q = out + (size_t)m * ldo + nbase;
#pragma unroll
  for (int g = 0; g < 4; ++g) {
    uint2 u; u.x = pack2(v[4 * g] * sc, v[4 * g + 1] * sc); u.y = pack2(v[4 * g + 2] * sc, v[4 * g + 3] * sc);
    *(uint2*)(q + 8 * g) = u;
  }
}
DI void store_tr(u16* outT, size_t ldt, int n, int mbase, const f32x16& v, const float* __restrict__ rs) {
  u16* q = outT + (size_t)n * ldt + mbase;
#pragma unroll
  for (int g = 0; g < 4; ++g) {
    float4 s = make_float4(1.f, 1.f, 1.f, 1.f);
    if (rs) s = *(const float4*)(rs + mbase + 8 * g);
    uint2 u; u.x = pack2(v[4 * g] * s.x, v[4 * g + 1] * s.y); u.y = pack2(v[4 * g + 2] * s.z, v[4 * g + 3] * s.w);
    *(uint2*)(q + 8 * g) = u;
  }
}

DI void store_tok_u(u16* ub, unsigned loff, const f32x16& v, float sc) {
  char* q = (char*)ub;
  const unsigned hoff = (loff & 8u) << 1;
  const unsigned lbase = loff & ~8u;
#pragma unroll
  for (int pi = 0; pi < 2; ++pi) {
    const int g0 = 2 * pi, g1 = 2 * pi + 1;
    const unsigned a0 = cvt_pk(v[4 * g0] * sc, v[4 * g0 + 1] * sc), a1 = cvt_pk(v[4 * g0 + 2] * sc, v[4 * g0 + 3] * sc);
    const unsigned b0 = cvt_pk(v[4 * g1] * sc, v[4 * g1 + 1] * sc), b1 = cvt_pk(v[4 * g1 + 2] * sc, v[4 * g1 + 3] * sc);
    const u32x2 s0 = __builtin_amdgcn_permlane32_swap(a0, b0, false, false);
    const u32x2 s1 = __builtin_amdgcn_permlane32_swap(a1, b1, false, false);
    u32x4 u; u.x = s0.x; u.y = s1.x; u.z = s0.y; u.w = s1.y;
    *(u32x4*)(q + lbase + hoff + 32 * pi) = u;
  }
}
DI void store_tr_u(u16* ub, unsigned loff, const f32x16& v, const float* __restrict__ rs) {
  char* q = (char*)ub;
  const unsigned hoff = (loff & 8u) << 1;
  const unsigned lbase = loff & ~8u;
#pragma unroll
  for (int pi = 0; pi < 2; ++pi) {
    const int g0 = 2 * pi, g1 = 2 * pi + 1;
    float4 sa = make_float4(1.f, 1.f, 1.f, 1.f), sb = sa;
    if (rs) { sa = *(const float4*)(rs + 8 * g0); sb = *(const float4*)(rs + 8 * g1); }
    const unsigned a0 = cvt_pk(v[4 * g0] * sa.x, v[4 * g0 + 1] * sa.y), a1 = cvt_pk(v[4 * g0 + 2] * sa.z, v[4 * g0 + 3] * sa.w);
    const unsigned b0 = cvt_pk(v[4 * g1] * sb.x, v[4 * g1 + 1] * sb.y), b1 = cvt_pk(v[4 * g1 + 2] * sb.z, v[4 * g1 + 3] * sb.w);
    const u32x2 s0 = __builtin_amdgcn_permlane32_swap(a0, b0, false, false);
    const u32x2 s1 = __builtin_amdgcn_permlane32_swap(a1, b1, false, false);
    u32x4 u; u.x = s0.x; u.y = s1.x; u.z = s0.y; u.w = s1.y;
    *(u32x4*)(q + lbase + hoff + 32 * pi) = u;
  }
}

struct EpiTok {
  u16* out; int ldo;
  static constexpr int SWAPMODE = 1;
  DI bool swap(int) const { return true; }
  template <int WMB, int WNB>
  DI void store(int m0w, int n0w, f32x16 (&acc)[WMB][WNB], int r, int h, bool) const {
#pragma unroll
    for (int mb = 0; mb < WMB; ++mb)
#pragma unroll
      for (int nb = 0; nb < WNB; ++nb) store_tok_u(out + (size_t)(m0w + mb * 32) * ldo + n0w + nb * 32, (unsigned)((r * ldo + 4 * h) * 2), acc[mb][nb], 1.f);
  }
};

struct EpiProj0 {
  u16* base; unsigned* qkmax;
  static constexpr int SWAPMODE = 2;
  DI bool swap(int n0) const { const int reg = n0 >> 9; return !(reg == 2 || reg == 5); }
  template <int WMB, int WNB>
  DI void store(int m0w, int n0w, f32x16 (&acc)[WMB][WNB], int r, int h, bool) const {
    const int reg = n0w >> 9, nl = n0w & 511;
    u16* buf = base + (size_t)reg * SEG512;
    const float sc = (reg == 0 || reg == 3) ? QSCALE64 : 1.f;
#pragma unroll
    for (int mb = 0; mb < WMB; ++mb)
#pragma unroll
      for (int nb = 0; nb < WNB; ++nb) store_tok_u(buf + (size_t)(m0w + mb * 32) * 512 + nl + nb * 32, (unsigned)((r * 512 + 4 * h) * 2), acc[mb][nb], sc);
    __builtin_amdgcn_sched_barrier(0);
    if (reg == 3 || reg == 4) {
      static_assert(WNB == 2, "one head per wave tile");
      float mxn = 0.f;
#pragma unroll
      for (int mb = 0; mb < WMB; ++mb) {
        float ss = 0.f;
#pragma unroll
        for (int nb = 0; nb < WNB; ++nb)
#pragma unroll
          for (int i = 0; i < 16; ++i) { const float v = acc[mb][nb][i]; ss += v * v; }
        { const u32x2 sw = __builtin_amdgcn_permlane32_swap(__float_as_uint(ss), __float_as_uint(ss), false, false); ss = __uint_as_float(sw.x) + __uint_as_float(sw.y); }
        mxn = fmaxf(mxn, ss);
      }
      mxn = fmaxf(mxn, __int_as_float(__builtin_amdgcn_ds_swizzle(__float_as_int(mxn), (16 << 10) | 0x1f)));
      mxn = fmaxf(mxn, __int_as_float(__builtin_amdgcn_ds_swizzle(__float_as_int(mxn), (8 << 10) | 0x1f)));
      mxn = fmaxf(mxn, __int_as_float(__builtin_amdgcn_ds_swizzle(__float_as_int(mxn), (4 << 10) | 0x1f)));
      mxn = fmaxf(mxn, __int_as_float(__builtin_amdgcn_ds_swizzle(__float_as_int(mxn), (2 << 10) | 0x1f)));
      mxn = fmaxf(mxn, __int_as_float(__builtin_amdgcn_ds_swizzle(__float_as_int(mxn), (1 << 10) | 0x1f)));
      if (r == 0 && h == 0) atomicMax(qkmax + (reg - 3) * 8 + (nl >> 6), __float_as_uint(sqrtf(mxn) * sc));
    }
  }
  template <int WMB, int WNB>
  DI void store_t(int n0w, int m0w, f32x16 (&acc)[WMB][WNB], int r, int h) const {
    const int reg = n0w >> 9, nl = n0w & 511;
    u16* buf = base + (size_t)reg * SEG512;
#pragma unroll
    for (int mb = 0; mb < WMB; ++mb)
#pragma unroll
      for (int nb = 0; nb < WNB; ++nb) store_tr_u(buf + (size_t)(nl + mb * 32) * T_TOK + m0w + nb * 32, (unsigned)((r * T_TOK + 4 * h) * 2), acc[mb][nb], nullptr);
  }
};

struct EpiSwiGLU {
  u16* act;
  static constexpr int SWAPMODE = 1;
  DI bool swap(int) const { return true; }
  template <int WMB, int WNB>
  DI void store(int m0w, int n0w, f32x16 (&acc)[WMB][WNB], int r, int h, bool) const {
    static_assert(WNB == 2, "swiglu epilogue needs a 64-wide wave tile");
#pragma unroll
    for (int mb = 0; mb < WMB; ++mb) {
      char* q = (char*)(act + (size_t)(m0w + mb * 32) * DFF + (n0w >> 1)) + (unsigned)((r * DFF) * 2) + 16 * h;
#pragma unroll
      for (int pi = 0; pi < 2; ++pi) {
        unsigned pk[2][2];
#pragma unroll
        for (int gg = 0; gg < 2; ++gg) {
          const int g = 2 * pi + gg;
          float y[4];
#pragma unroll
          for (int e = 0; e < 4; ++e) {
            const float gt = acc[mb][0][4 * g + e], up = acc[mb][1][4 * g + e];
            y[e] = gt * __builtin_amdgcn_rcpf(1.f + fexp2(-LOG2E * gt)) * up;
          }
          pk[gg][0] = cvt_pk(y[0], y[1]); pk[gg][1] = cvt_pk(y[2], y[3]);
        }
        const u32x2 s0 = __builtin_amdgcn_permlane32_swap(pk[0][0], pk[1][0], false, false);
        const u32x2 s1 = __builtin_amdgcn_permlane32_swap(pk[0][1], pk[1][1], false, false);
        u32x4 u; u.x = s0.x; u.y = s1.x; u.z = s0.y; u.w = s1.y;
        *(u32x4*)(q + 32 * pi) = u;
      }
      __builtin_amdgcn_sched_barrier(0);
    }
  }
};

struct EpiUQ {
  u16* q; const float* rq; const float2* rope;
  static constexpr int SWAPMODE = 1;
  DI bool swap(int) const { return true; }
  template <int WMB, int WNB>
  DI void store(int m0w, int n0w, f32x16 (&acc)[WMB][WNB], int r, int h, bool) const {
#pragma unroll
    for (int mb = 0; mb < WMB; ++mb) {
      const int m = m0w + mb * 32 + r;
      const float sc = rq[m] * QSCALE96;
      const int pos = tok_pos(m);
#pragma unroll
      for (int nb = 0; nb < WNB; ++nb) {
        const int n0b = n0w + nb * 32;
        f32x16 v = acc[mb][nb];
#pragma unroll
        for (int i = 0; i < 16; ++i) v[i] *= sc;
        if (((n0b >> 5) % 3) == 2) {
#pragma unroll
          for (int i = 0; i < 8; ++i) {
            const int f = (i & 3) + 8 * (i >> 2) + 4 * h;
            const float2 cs = rope[pos * 16 + f];
            const float x1 = v[i], x2 = v[i + 8];
            v[i] = x1 * cs.x - x2 * cs.y;
            v[i + 8] = x2 * cs.x + x1 * cs.y;
          }
        }
        store_tok_u(q + (size_t)(m0w + mb * 32) * 1536 + n0b, (unsigned)((r * 1536 + 4 * h) * 2), v, 1.f);
        __builtin_amdgcn_sched_barrier(0);
      }
    }
  }
};

struct EpiUKV {
  u16* knope; u16* vt; const float* rkv; unsigned* kmax;
  static constexpr int SWAPMODE = 2;
  DI bool swap(int n0) const { return n0 < 1024; }
  template <int WMB, int WNB>
  DI void store(int m0w, int n0w, f32x16 (&acc)[WMB][WNB], int r, int h, bool) const {
#pragma unroll
    for (int mb = 0; mb < WMB; ++mb) {
      const int m = m0w + mb * 32 + r;
      const float sc = rkv[m];
#pragma unroll
      for (int nb = 0; nb < WNB; ++nb) store_tok_u(knope + (size_t)(m0w + mb * 32) * 1024 + n0w + nb * 32, (unsigned)((r * 1024 + 4 * h) * 2), acc[mb][nb], sc);
    }
    __builtin_amdgcn_sched_barrier(0);
    static_assert(WNB == 2, "one head per wave tile");
    float mxn = 0.f;
#pragma unroll
    for (int mb = 0; mb < WMB; ++mb) {
      float ss = 0.f;
#pragma unroll
      for (int nb = 0; nb < WNB; ++nb)
#pragma unroll
        for (int i = 0; i < 16; ++i) { const float v = acc[mb][nb][i]; ss += v * v; }
      { const u32x2 sw = __builtin_amdgcn_permlane32_swap(__float_as_uint(ss), __float_as_uint(ss), false, false); ss = __uint_as_float(sw.x) + __uint_as_float(sw.y); }
      const float sc = rkv[m0w + mb * 32 + r];
      mxn = fmaxf(mxn, ss * sc * sc);
    }
    mxn = fmaxf(mxn, __int_as_float(__builtin_amdgcn_ds_swizzle(__float_as_int(mxn), (16 << 10) | 0x1f)));
    mxn = fmaxf(mxn, __int_as_float(__builtin_amdgcn_ds_swizzle(__float_as_int(mxn), (8 << 10) | 0x1f)));
    mxn = fmaxf(mxn, __int_as_float(__builtin_amdgcn_ds_swizzle(__float_as_int(mxn), (4 << 10) | 0x1f)));
    mxn = fmaxf(mxn, __int_as_float(__builtin_amdgcn_ds_swizzle(__float_as_int(mxn), (2 << 10) | 0x1f)));
    mxn = fmaxf(mxn, __int_as_float(__builtin_amdgcn_ds_swizzle(__float_as_int(mxn), (1 << 10) | 0x1f)));
    if (r == 0 && h == 0) atomicMax(kmax + (n0w >> 6), __float_as_uint(sqrtf(mxn)));
  }
  template <int WMB, int WNB>
  DI void store_t(int n0w, int m0w, f32x16 (&acc)[WMB][WNB], int r, int h) const {
#pragma unroll
    for (int mb = 0; mb < WMB; ++mb)
#pragma unroll
      for (int nb = 0; nb < WNB; ++nb) store_tr_u(vt + (size_t)(n0w - 1024 + mb * 32) * T_TOK + m0w + nb * 32, (unsigned)((r * T_TOK + 4 * h) * 2), acc[mb][nb], rkv + m0w + nb * 32 + 4 * h);
  }
};

template <bool SWAP, int WMB, int WNB>
DI void gemm_compute(const char* la, const char* lb, f32x16 (&acc)[WMB][WNB], int wm, int wn, int r, int h) {
#pragma unroll
  for (int ks = 0; ks < 4; ++ks) {
    bf16x8 af[WMB], bfr[WNB];
#pragma unroll
    for (int mb = 0; mb < WMB; ++mb) af[mb] = *(const bf16x8*)(la + (wm * 32 * WMB + mb * 32 + r) * 144 + (ks * 2 + h) * 16);
#pragma unroll
    for (int nb = 0; nb < WNB; ++nb) bfr[nb] = *(const bf16x8*)(lb + (wn * 32 * WNB + nb * 32 + r) * 144 + (ks * 2 + h) * 16);
#pragma unroll
    for (int mb = 0; mb < WMB; ++mb)
#pragma unroll
      for (int nb = 0; nb < WNB; ++nb) {
        if (SWAP) acc[mb][nb] = MFMA32(bfr[nb], af[mb], acc[mb][nb]);
        else acc[mb][nb] = MFMA32(af[mb], bfr[nb], acc[mb][nb]);
      }
  }
}

struct TileDesc { bool valid; bool normal; int m0, n0, ldp, ldq; unsigned po, qo; const char* P; const char* Q; };

template <class Epi>
DI void gemm_phase(const u16* __restrict__ A, int lda, const u16* __restrict__ Bt, int ldb, int M, int N, int K, const Epi epi, char* lds, int bid, int nblk, const Ctx& p) {
  constexpr int WMB = 4, WNB = 2;
  constexpr int TM = 256, TN = 256;
  constexpr int STAGE = (TM + TN) * 144;
  const int tid = otid(p), lane = tid & 63, w = __builtin_amdgcn_readfirstlane(tid >> 6), wm = w >> 2, wn = w & 3, r = lane & 31, h = lane >> 5;
  const int lrow = tid >> 3, lch = tid & 7;
  const int NT = N / TN, MT = M / TM, tiles = MT * NT, nk = K >> 6;
  const int rounds = (tiles + nblk - 1) / nblk;
  auto desc = [&](int rnd) {
    TileDesc d;
    int tile = rnd * nblk + bid;
    if (nblk == 256) tile = rnd * 256 + (bid & 7) * 32 + (bid >> 3);
    d.valid = rnd < rounds && tile < tiles;
    const int grp = tile / (8 * NT), within = tile - grp * (8 * NT);
    const int nt = within >> 3, mt = grp * 8 + (within & 7);
    d.m0 = mt * TM; d.n0 = nt * TN;
    d.normal = true;
    if constexpr (Epi::SWAPMODE == 2) d.normal = epi.swap(d.n0);
    const char* Ab = (const char*)A + (size_t)d.m0 * lda * 2;
    const char* Bb = (const char*)Bt + (size_t)d.n0 * ldb * 2;
    const unsigned aoff = (unsigned)(lrow * lda * 2 + lch * 16), boff = (unsigned)(lrow * ldb * 2 + lch * 16);
    d.P = d.normal ? Ab : Bb; d.Q = d.normal ? Bb : Ab;
    d.po = d.normal ? aoff : boff; d.qo = d.normal ? boff : aoff;
    d.ldp = d.normal ? lda : ldb; d.ldq = d.normal ? ldb : lda;
    return d;
  };
  u32x4 pa[4], pb[4];
  auto issue = [&](const TileDesc& d, int kt) {
    const char* Pk = d.P + (size_t)kt * 128; asm volatile("" : "+s"(Pk));
    const char* Qk = d.Q + (size_t)kt * 128; asm volatile("" : "+s"(Qk));
#pragma unroll
    for (int j = 0; j < 4; ++j) pa[j] = *(const u32x4*)(Pk + (size_t)j * 128 * d.ldp + d.po);
#pragma unroll
    for (int j = 0; j < 4; ++j) pb[j] = *(const u32x4*)(Qk + (size_t)j * 128 * d.ldq + d.qo);
  };
  auto write_stage = [&](int b) {
    char* wa = lds + b * STAGE;
    char* wb = wa + TM * 144;
#pragma unroll
    for (int j = 0; j < 4; ++j) *(u32x4*)(wa + (lrow + 64 * j) * 144 + lch * 16) = pa[j];
#pragma unroll
    for (int j = 0; j < 4; ++j) *(u32x4*)(wb + (lrow + 64 * j) * 144 + lch * 16) = pb[j];
  };
  TileDesc cur = desc(0);
  if (!cur.valid) return;
  issue(cur, 0);
  for (int rnd = 0;; ++rnd) {
    f32x16 acc[WMB][WNB];
#pragma unroll
    for (int mb = 0; mb < WMB; ++mb)
#pragma unroll
      for (int nb = 0; nb < WNB; ++nb)
#pragma unroll
        for (int i = 0; i < 16; ++i) acc[mb][nb][i] = 0.f;
    write_stage(0);
    if (nk > 1) issue(cur, 1);
    __syncthreads();
    if (w < 4) {
      for (int kt = 0; kt < nk; ++kt) {
        const char* la = lds + (kt & 1) * STAGE;
        if (kt + 1 < nk) write_stage((kt + 1) & 1);
        if (kt + 2 < nk) issue(cur, kt + 2);
        gemm_compute<true, WMB, WNB>(la, la + TM * 144, acc, wm, wn, r, h);
        __syncthreads();
      }
    } else {
      for (int kt = 0; kt < nk; ++kt) {
        const char* la = lds + (kt & 1) * STAGE;
        gemm_compute<true, WMB, WNB>(la, la + TM * 144, acc, wm, wn, r, h);
        if (kt + 1 < nk) write_stage((kt + 1) & 1);
        if (kt + 2 < nk) issue(cur, kt + 2);
        __syncthreads();
      }
    }
    const TileDesc nxt = desc(rnd + 1);
    if (nxt.valid) issue(nxt, 0);
    __builtin_amdgcn_sched_barrier(0);
    int m0 = cur.m0, n0 = cur.n0;
    asm volatile("" : "+s"(m0), "+s"(n0));
    int r2 = r, h2 = h, wm2 = wm, wn2 = wn;
    asm volatile("" : "+v"(r2), "+v"(h2));
    asm volatile("" : "+s"(wm2), "+s"(wn2));
    if constexpr (Epi::SWAPMODE == 2) {
      if (cur.normal) epi.template store<WMB, WNB>(m0 + wm2 * 32 * WMB, n0 + wn2 * 32 * WNB, acc, r2, h2, true);
      else epi.template store_t<WMB, WNB>(n0 + wm2 * 32 * WMB, m0 + wn2 * 32 * WNB, acc, r2, h2);
    } else {
      epi.template store<WMB, WNB>(m0 + wm2 * 32 * WMB, n0 + wn2 * 32 * WNB, acc, r2, h2, true);
    }
    if (!nxt.valid) break;
    cur = nxt;
  }
}

DI void lds_st16_as2x8(char* dst, const u32x4 v) {
  u32x2 a; a.x = v.x; a.y = v.y; u32x2 b; b.x = v.z; b.y = v.w;
  *(u32x2*)dst = a;
  *(u32x2*)(dst + 8) = b;
}
DI void lds_st_vt(char* row, int ch, const u32x4 v) {
  u32x2 a; a.x = v.x; a.y = v.y; u32x2 b; b.x = v.z; b.y = v.w;
  char* g = row + (ch >> 1) * 32 + (ch & 1) * 8;
  *(u32x2*)g = a;
  *(u32x2*)(g + 16) = b;
}
constexpr int ATT_STAGE = 36864;
constexpr float DEFER_THR = 8.f;

template <int DQK>
DI void qk_scores_acc(const char* kl, const bf16x8 (&qf)[DQK / 16], f32x16 (&s)[2], int r, int h) {
  constexpr int KS = DQK * 2 + 16;
#pragma unroll
  for (int kb = 0; kb < 2; ++kb)
#pragma unroll
    for (int ks = 0; ks < DQK / 16; ++ks) {
      const bf16x8 a = *(const bf16x8*)(kl + (32 * kb + r) * KS + (2 * ks + h) * 16);
      s[kb] = MFMA32(a, qf[ks], s[kb]);
    }
}
template <int DQK>
DI void qk_scores_qlds(const char* kl, const char* qsl, f32x16 (&s)[2], int r, int h) {
  constexpr int KS = DQK * 2 + 16;
#pragma unroll
  for (int kb = 0; kb < 2; ++kb) {
#pragma unroll
    for (int ks = 0; ks < DQK / 16; ++ks) {
      const bf16x8 a = *(const bf16x8*)(kl + (32 * kb + r) * KS + (2 * ks + h) * 16);
      const bf16x8 qv = *(const bf16x8*)(qsl + ks * 1024);
      s[kb] = MFMA32(a, qv, s[kb]);
    }
  }
}
template <int DQK>
DI void qk_scores(const char* kl, const bf16x8 (&qf)[DQK / 16], const f32x16& initv, f32x16 (&s)[2], int r, int h) {
  constexpr int KS = DQK * 2 + 16;
#pragma unroll
  for (int kb = 0; kb < 2; ++kb) {
    s[kb] = initv;
#pragma unroll
    for (int ks = 0; ks < DQK / 16; ++ks) {
      const bf16x8 a = *(const bf16x8*)(kl + (32 * kb + r) * KS + (2 * ks + h) * 16);
      s[kb] = MFMA32(a, qf[ks], s[kb]);
    }
  }
}

template <int DV>
DI float softmax_pv(f32x16 (&s)[2], f32x16 (&o)[DV / 32], float& l, bool first, const char* vl, int r, int h) {
  float dret = 0.f;
  float mx = fmaxf(fmaxf(s[0][0], s[0][1]), s[0][2]);
#pragma unroll
  for (int i = 3; i < 15; i += 2) mx = fmaxf(fmaxf(mx, s[0][i]), s[0][i + 1]);
  mx = fmaxf(fmaxf(mx, s[0][15]), s[1][0]);
#pragma unroll
  for (int i = 1; i < 15; i += 2) mx = fmaxf(fmaxf(mx, s[1][i]), s[1][i + 1]);
  mx = fmaxf(mx, s[1][15]);
  const bool need = first || (mx > DEFER_THR);
  if (__any(need)) {
    mx = fmaxf(mx, __shfl_xor(mx, 32));
    float delta;
    if (first) delta = mx;
    else {
      delta = fmaxf(mx, 0.f);
      const float alpha = fexp2(-delta);
      l *= alpha;
#pragma unroll
      for (int d = 0; d < DV / 32; ++d)
#pragma unroll
        for (int i = 0; i < 16; ++i) o[d][i] *= alpha;
    }
#pragma unroll
    for (int kb = 0; kb < 2; ++kb)
#pragma unroll
      for (int i = 0; i < 16; ++i) s[kb][i] -= delta;
    dret = delta;
  }
  float ps = 0.f;
#pragma unroll
  for (int kb = 0; kb < 2; ++kb)
#pragma unroll
    for (int i = 0; i < 16; ++i) { const float e = fexp2(s[kb][i]); s[kb][i] = e; ps += e; }
  l += ps;
  bf16x8 pf[2][2];
#pragma unroll
  for (int kb = 0; kb < 2; ++kb)
#pragma unroll
    for (int st = 0; st < 2; ++st) {
      u32x4 u;
      u.x = cvt_pk(s[kb][8 * st + 0], s[kb][8 * st + 1]); u.y = cvt_pk(s[kb][8 * st + 2], s[kb][8 * st + 3]);
      u.z = cvt_pk(s[kb][8 * st + 4], s[kb][8 * st + 5]); u.w = cvt_pk(s[kb][8 * st + 6], s[kb][8 * st + 7]);
      pf[kb][st] = __builtin_bit_cast(bf16x8, u);
    }
#pragma unroll
  for (int d = 0; d < DV / 32; ++d)
#pragma unroll
    for (int kb = 0; kb < 2; ++kb)
#pragma unroll
      for (int st = 0; st < 2; ++st) {
        const u32x4 u = *(const u32x4*)(vl + (32 * d + r) * 144 + (2 * kb + st) * 32 + h * 16);
        o[d] = MFMA32(__builtin_bit_cast(bf16x8, u), pf[kb][st], o[d]);
      }
  return dret;
}

template <int DV>
DI float softmax_pre(f32x16 (&s)[2], f32x16 (&o)[DV / 32], float& l, bool first) {
  float dret = 0.f;
  float mx = fmaxf(fmaxf(s[0][0], s[0][1]), s[0][2]);
#pragma unroll
  for (int i = 3; i < 15; i += 2) mx = fmaxf(fmaxf(mx, s[0][i]), s[0][i + 1]);
  mx = fmaxf(fmaxf(mx, s[0][15]), s[1][0]);
#pragma unroll
  for (int i = 1; i < 15; i += 2) mx = fmaxf(fmaxf(mx, s[1][i]), s[1][i + 1]);
  mx = fmaxf(mx, s[1][15]);
  const bool need = first || (mx > DEFER_THR);
  if (__any(need)) {
    mx = fmaxf(mx, __shfl_xor(mx, 32));
    float delta;
    if (first) delta = mx;
    else {
      delta = fmaxf(mx, 0.f);
      const float alpha = fexp2(-delta);
      l *= alpha;
#pragma unroll
      for (int d = 0; d < DV / 32; ++d)
#pragma unroll
        for (int i = 0; i < 16; ++i) o[d][i] *= alpha;
    }
#pragma unroll
    for (int kb = 0; kb < 2; ++kb)
#pragma unroll
      for (int i = 0; i < 16; ++i) s[kb][i] -= delta;
    dret = delta;
  }
  return dret;
}
DI void softmax_exp_half(f32x16& s, float& l, bf16x8 (&pf)[2]) {
  float ps = 0.f;
#pragma unroll
  for (int i = 0; i < 16; ++i) { const float e = fexp2(s[i]); s[i] = e; ps += e; }
  l += ps;
#pragma unroll
  for (int st = 0; st < 2; ++st) {
    u32x4 u;
    u.x = cvt_pk(s[8 * st + 0], s[8 * st + 1]); u.y = cvt_pk(s[8 * st + 2], s[8 * st + 3]);
    u.z = cvt_pk(s[8 * st + 4], s[8 * st + 5]); u.w = cvt_pk(s[8 * st + 6], s[8 * st + 7]);
    pf[st] = __builtin_bit_cast(bf16x8, u);
  }
}
template <int DV>
DI void pv_half(const bf16x8 (&pf)[2], f32x16 (&o)[DV / 32], const char* vl, int kb, int r, int h) {
#pragma unroll
  for (int d = 0; d < DV / 32; ++d)
#pragma unroll
    for (int st = 0; st < 2; ++st) {
      const u32x4 u = *(const u32x4*)(vl + (32 * d + r) * 144 + (2 * kb + st) * 32 + h * 16);
      o[d] = MFMA32(__builtin_bit_cast(bf16x8, u), pf[st], o[d]);
    }
}

template <int ABL>
DI void attn_mla_item(const Ctx& p, int item, char* lds) {
  constexpr int DQK = 96, DV = 64, KS = DQK * 2 + 16;
  const int tid = otid(p), lane = tid & 63, w = tid >> 6, r = lane & 31, h = lane >> 5;
  int head, qb, ts0, S;
  if (item < 1024) { head = item >> 6; qb = item & 63; ts0 = T_PROMPT; S = 16384; }
  else { const int it = item - 1024; qb = it & 15; head = (it >> 4) & 15; ts0 = (it >> 8) * 4096; S = 4096; }
  const u16* q = (const u16*)(p.ws + OFF_R2);
  const u16* knope = q + (size_t)T_TOK * 1536;
  const u16* vt = knope + (size_t)T_TOK * 1024;
  const u16* krope = (const u16*)(p.ws + OFF_KROPE);
  u16* o1 = (u16*)(p.ws + OFF_R1);
  const int tq = ts0 + qb * 256 + w * 32 + r;
  bf16x8 qf[DQK / 16];
#pragma unroll
  for (int ks = 0; ks < DQK / 16; ++ks) qf[ks] = *(const bf16x8*)(q + (size_t)tq * 1536 + head * 96 + 16 * ks + 8 * h);
  f32x16 o[DV / 32];
#pragma unroll
  for (int d = 0; d < DV / 32; ++d)
#pragma unroll
    for (int i = 0; i < 16; ++i) o[d][i] = 0.f;
  f32x16 initv;
#pragma unroll
  for (int i = 0; i < 16; ++i) initv[i] = 0.f;
  float l = 0.f;
  u32x4 pk0, pk1, pv0;
  const int c1 = 512 + tid;
  const int krow0 = tid / 12, kch0 = tid - krow0 * 12;
  const int krow1 = c1 / 12, kch1 = c1 - krow1 * 12;
  const int vrow = tid >> 3, vch = tid & 7;
  const int nkt = S >> 6;
  auto prefetch = [&](int kt) {
    const int tk0 = ts0 + kt * 64;
    {
      const u16* src = kch0 < 8 ? knope + (size_t)(tk0 + krow0) * 1024 + head * 64 + kch0 * 8 : krope + (size_t)(tk0 + krow0) * 32 + (kch0 - 8) * 8;
      pk0 = *(const u32x4*)src;
    }
    if (tid < 256) {
      const u16* src = kch1 < 8 ? knope + (size_t)(tk0 + krow1) * 1024 + head * 64 + kch1 * 8 : krope + (size_t)(tk0 + krow1) * 32 + (kch1 - 8) * 8;
      pk1 = *(const u32x4*)src;
    }
    pv0 = *(const u32x4*)(vt + (size_t)(head * 64 + vrow) * T_TOK + tk0 + vch * 8);
  };
  auto stage_at = [&](int boff) {
    char* kl = lds + boff;
    char* vl = kl + 64 * KS;
    *(u32x4*)(kl + krow0 * KS + kch0 * 16) = pk0;
    if (tid < 256) *(u32x4*)(kl + krow1 * KS + kch1 * 16) = pk1;
    lds_st_vt(vl + vrow * 144, vch, pv0);
  };
  prefetch(0);
  __syncthreads();
  stage_at(0);
  prefetch(1);
  stage_at(ATT_STAGE);
  if (nkt > 2) prefetch(2);
  __syncthreads();
  int cur = 0, nxt = ATT_STAGE, nn = 2 * ATT_STAGE;
  f32x16 s[2];
  qk_scores<DQK>(lds, qf, initv, s, r, h);
#pragma unroll 1
  for (int kt = 0; kt < nkt; ++kt) {
    if (ABL == 2) { __syncthreads(); if (kt + 2 < nkt) stage_at(nn); if (kt + 3 < nkt) prefetch(kt + 3); { const int t = cur; cur = nxt; nxt = nn; nn = t; } continue; }
    const float dl = softmax_pre<DV>(s, o, l, kt == 0);
    if (__any(dl != 0.f)) {
#pragma unroll
      for (int i = 0; i < 16; ++i) initv[i] -= dl;
    }
    f32x16 sn[2];
    qk_scores<DQK>(lds + nxt, qf, initv, sn, r, h);
#pragma unroll
    for (int kb = 0; kb < 2; ++kb) {
      bf16x8 pf[2];
      softmax_exp_half(s[kb], l, pf);
      pv_half<DV>(pf, o, lds + cur + 64 * KS, kb, r, h);
    }
    if (ABL != 1) { if (kt + 2 < nkt) stage_at(nn);
    if (kt + 3 < nkt) prefetch(kt + 3); }
    __syncthreads();
    s[0] = sn[0]; s[1] = sn[1];
    const int t = cur; cur = nxt; nxt = nn; nn = t;
  }
  l += __shfl_xor(l, 32);
  const float inv = 1.f / l;
#pragma unroll
  for (int d = 0; d < DV / 32; ++d) store_tok(o1, 1024, tq, head * 64 + 32 * d + 4 * h, o[d], inv);
}

DI void attn_mla_item2(const Ctx& p, int item, char* lds) {
  constexpr int DQK = 96, DV = 64, KS = DQK * 2 + 16;
  const int tid = otid(p), lane = tid & 63, w = tid >> 6, r = lane & 31, h = lane >> 5;
  int head, qb, ts0, S;
  if (item < 512) { head = item >> 5; qb = item & 31; ts0 = T_PROMPT; S = 16384; }
  else { const int it = item - 512; qb = it & 7; head = (it >> 3) & 15; ts0 = (it >> 7) * 4096; S = 4096; }
  const u16* q = (const u16*)(p.ws + OFF_R2);
  const u16* knope = q + (size_t)T_TOK * 1536;
  const u16* vt = knope + (size_t)T_TOK * 1024;
  const u16* krope = (const u16*)(p.ws + OFF_KROPE);
  u16* o1 = (u16*)(p.ws + OFF_R1);
  const int tq0 = ts0 + qb * 512 + w * 64 + r;
  char* qsl = lds + 49152 + w * 12288 + lane * 16;
  __syncthreads();
  float qn2[2] = {0.f, 0.f};
#pragma unroll
  for (int j = 0; j < 2; ++j)
#pragma unroll
    for (int ks = 0; ks < DQK / 16; ++ks) {
      const u32x4 qv = *(const u32x4*)(q + (size_t)(tq0 + 32 * j) * 1536 + head * 96 + 16 * ks + 8 * h);
      *(u32x4*)(qsl + (j * 6 + ks) * 1024) = qv;
      float a;
      a = bflo(qv.x); qn2[j] += a * a; a = bfhi(qv.x); qn2[j] += a * a; a = bflo(qv.y); qn2[j] += a * a; a = bfhi(qv.y); qn2[j] += a * a;
      a = bflo(qv.z); qn2[j] += a * a; a = bfhi(qv.z); qn2[j] += a * a; a = bflo(qv.w); qn2[j] += a * a; a = bfhi(qv.w); qn2[j] += a * a;
    }
  float ref[2];
  {
    float kn2 = 0.f;
#pragma unroll
    for (int t = 0; t < 8; ++t) { const float v = __uint_as_float(((const unsigned*)(p.ws + OFF_SCAL))[SC_KP + head * 8 + t]); kn2 += v * v; }
    const float kr = __uint_as_float(((const unsigned*)(p.ws + OFF_SCAL))[SC_KRMAX]);
    const float kmaxn = sqrtf(kn2 + kr * kr);
#pragma unroll
    for (int j = 0; j < 2; ++j) {
      qn2[j] += __shfl_xor(qn2[j], 32);
      ref[j] = sqrtf(qn2[j]) * kmaxn * 1.02f + 0.5f;
    }
  }
  const bool fixedref = !__any(ref[0] > 60.f || ref[1] > 60.f);
  f32x16 o[2][DV / 32];
  f32x16 initv[2];
#pragma unroll
  for (int j = 0; j < 2; ++j) {
#pragma unroll
    for (int d = 0; d < DV / 32; ++d)
#pragma unroll
      for (int i = 0; i < 16; ++i) o[j][d][i] = 0.f;
#pragma unroll
    for (int i = 0; i < 16; ++i) initv[j][i] = fixedref ? -ref[j] : 0.f;
  }
  float l[2] = {0.f, 0.f};
  u32x4 pk0, pk1, pv0;
  const int c1 = 512 + (tid & 255);
  const int krow0 = tid / 12, kch0 = tid - krow0 * 12;
  const int krow1 = c1 / 12, kch1 = c1 - krow1 * 12;
  const int vrow = tid >> 3, vch = tid & 7;
  const int nkt = S >> 6;
  auto prefetch = [&](int kt) {
    const int tk0 = ts0 + kt * 64;
    {
      const u16* src = kch0 < 8 ? knope + (size_t)(tk0 + krow0) * 1024 + head * 64 + kch0 * 8 : krope + (size_t)(tk0 + krow0) * 32 + (kch0 - 8) * 8;
      pk0 = *(const u32x4*)src;
    }
    {
      const u16* src = kch1 < 8 ? knope + (size_t)(tk0 + krow1) * 1024 + head * 64 + kch1 * 8 : krope + (size_t)(tk0 + krow1) * 32 + (kch1 - 8) * 8;
      pk1 = *(const u32x4*)src;
    }
    pv0 = *(const u32x4*)(vt + (size_t)(head * 64 + vrow) * T_TOK + tk0 + vch * 8);
  };
  auto stage_at = [&](int boff) {
    char* kl = lds + boff;
    char* vl = kl + 64 * KS;
    *(u32x4*)(kl + krow0 * KS + kch0 * 16) = pk0;
    *(u32x4*)(kl + krow1 * KS + kch1 * 16) = pk1;
    lds_st_vt(vl + vrow * 144, vch, pv0);
  };
  prefetch(0);
  stage_at(0);
  prefetch(1);
  __syncthreads();
#pragma unroll 1
  for (int kt = 0; kt < nkt; ++kt) {
    const char* kl = lds + (kt & 1) * 24576;
    const char* vl = kl + 64 * KS;
    if (kt + 1 < nkt) stage_at(((kt + 1) & 1) * 24576);
    if (kt + 2 < nkt) prefetch(kt + 2);
    f32x16 s[2][2];
#pragma unroll
    for (int kb = 0; kb < 2; ++kb) {
      s[0][kb] = initv[0]; s[1][kb] = initv[1];
#pragma unroll
      for (int ks = 0; ks < DQK / 16; ++ks) {
        const bf16x8 a = *(const bf16x8*)(kl + (32 * kb + r) * KS + (2 * ks + h) * 16);
        const bf16x8 q0 = *(const bf16x8*)(qsl + ks * 1024);
        const bf16x8 q1 = *(const bf16x8*)(qsl + (6 + ks) * 1024);
        s[0][kb] = MFMA32(a, q0, s[0][kb]);
        s[1][kb] = MFMA32(a, q1, s[1][kb]);
      }
    }
    if (!fixedref) {
#pragma unroll
      for (int j = 0; j < 2; ++j) {
        const float dl = softmax_pre<DV>(s[j], o[j], l[j], kt == 0);
        if (__any(dl != 0.f)) {
#pragma unroll
          for (int i = 0; i < 16; ++i) initv[j][i] -= dl;
        }
      }
    }
#pragma unroll
    for (int kb = 0; kb < 2; ++kb) {
      bf16x8 pf0[2], pf1[2];
      softmax_exp_half(s[0][kb], l[0], pf0);
      softmax_exp_half(s[1][kb], l[1], pf1);
#pragma unroll
      for (int d = 0; d < DV / 32; ++d)
#pragma unroll
        for (int st = 0; st < 2; ++st) {
          const u32x4 u = *(const u32x4*)(vl + (32 * d + r) * 144 + (2 * kb + st) * 32 + h * 16);
          const bf16x8 vf = __builtin_bit_cast(bf16x8, u);
          o[0][d] = MFMA32(vf, pf0[st], o[0][d]);
          o[1][d] = MFMA32(vf, pf1[st], o[1][d]);
        }
    }
    __syncthreads();
  }
  int tid2 = otid(p);
  const int lane2 = tid2 & 63, h2 = lane2 >> 5, w2 = tid2 >> 6;
  int item2 = item; asm volatile("" : "+s"(item2));
  int head2, tq2;
  if (item2 < 512) { head2 = item2 >> 5; tq2 = T_PROMPT + (item2 & 31) * 512 + w2 * 64 + (lane2 & 31); }
  else { const int it = item2 - 512; head2 = (it >> 3) & 15; tq2 = (it >> 7) * 4096 + (it & 7) * 512 + w2 * 64 + (lane2 & 31); }
#pragma unroll
  for (int j = 0; j < 2; ++j) {
    float lj = l[j];
    lj += __shfl_xor(lj, 32);
    const float inv = __builtin_amdgcn_rcpf(lj);
#pragma unroll
    for (int d = 0; d < DV / 32; ++d) store_tok(o1, 1024, tq2 + 32 * j, head2 * 64 + 32 * d + 4 * h2, o[j][d], inv);
  }
}

DI void diff_decode(int item, int& hh, int& qb, int& ts0, int& S) {
  int j;
  if (item < 128) { hh = 3; j = item; S = 16384; }
  else if (item < 256) { hh = 2; j = item - 128; S = 16384; }
  else if (item < 768) { hh = 3; j = item - 256; S = 4096; }
  else if (item < 1280) { hh = 2; j = item - 768; S = 4096; }
  else if (item < 1408) { hh = 1; j = item - 1280; S = 16384; }
  else if (item < 1920) { hh = 1; j = item - 1408; S = 4096; }
  else if (item < 2048) { hh = 0; j = item - 1920; S = 16384; }
  else { hh = 0; j = item - 2048; S = 4096; }
  if (S == 16384) { qb = j; ts0 = T_PROMPT; } else { qb = j & 31; ts0 = (j >> 5) * 4096; }
}
DI void attn_diff_item(const Ctx& p, int item, char* lds) {
  constexpr int DQK = 64, DV = 128, KS = DQK * 2 + 16;
  const int tid = otid(p), lane = tid & 63, w = tid >> 6, r = lane & 31, h = lane >> 5;
  const int map = w >> 2, qw = w & 3;
  int hh, qb, ts0, S;
  diff_decode(item, hh, qb, ts0, S);
  const u16* base = (const u16*)(p.ws + OFF_R2);
  const u16* dq = base + 2 * SEG512;
  const u16* dk = base + 3 * SEG512;
  const u16* vtd = base + 5 * SEG512;
  u16* o0 = (u16*)(p.ws + OFF_R1);
  const int qpos = qb * 128 + qw * 32 + r;
  const int tq = ts0 + qpos;
  __syncthreads();
  float qn2 = 0.f;
  bf16x8 qf[DQK / 16];
#pragma unroll
  for (int ks = 0; ks < DQK / 16; ++ks) {
    const u32x4 qv = *(const u32x4*)(dq + (size_t)tq * 512 + (2 * hh + map) * 64 + 16 * ks + 8 * h);
    qf[ks] = __builtin_bit_cast(bf16x8, qv);
    float a;
    a = bflo(qv.x); qn2 += a * a; a = bfhi(qv.x); qn2 += a * a; a = bflo(qv.y); qn2 += a * a; a = bfhi(qv.y); qn2 += a * a;
    a = bflo(qv.z); qn2 += a * a; a = bfhi(qv.z); qn2 += a * a; a = bflo(qv.w); qn2 += a * a; a = bfhi(qv.w); qn2 += a * a;
  }
  qn2 += __shfl_xor(qn2, 32);
  f32x16 o[DV / 32];
#pragma unroll
  for (int d = 0; d < DV / 32; ++d)
#pragma unroll
    for (int i = 0; i < 16; ++i) o[d][i] = 0.f;
  float l = 0.f;
  const float refb = sqrtf(qn2) * __uint_as_float(((const unsigned*)(p.ws + OFF_SCAL))[SC_QKMAX + 8 + 2 * hh + map]) * 1.02f + 0.5f;
  const bool fixedref = !__any(refb > 60.f);
  float ref = fixedref ? refb : 0.f;
  const float slope2 = exp2f(-2.f * (float)(hh + 1)) * LOG2E;
  const float cq = slope2 * (float)qpos;
  const int d0 = 2 * qb;
  const int kd = d0 + (qw >> 1);
  int kt_lo, kt_hi;
  {
    const unsigned* qk = (const unsigned*)(p.ws + OFF_SCAL) + SC_QKMAX;
    const float b0 = __uint_as_float(qk[2 * hh]) * __uint_as_float(qk[8 + 2 * hh]);
    const float b1 = __uint_as_float(qk[2 * hh + 1]) * __uint_as_float(qk[8 + 2 * hh + 1]);
    const float B = fmaxf(b0, b1) * 1.02f + 0.5f;
    const float dskip = fminf((2.f * B + 34.f) / slope2 + 1.f, 1.0e6f);
    const int q_lo = qb * 128, q_hi = q_lo + 127, ds = (int)dskip;
    kt_lo = max(0, (q_lo - 63 - ds) >> 6);
    kt_hi = min((S >> 6) - 1, (q_hi + ds) >> 6);
    kt_lo = min(kt_lo, 2 * qb); kt_hi = max(kt_hi, 2 * qb + 1);
  }
  const int nleft = d0 - kt_lo;
  const int nkt = kt_hi - kt_lo + 1;
  u32x4 pk[2], pv[2];
  const int lrow = tid >> 3, lch = tid & 7;
  auto tile_of = [&](int idx) { return idx < 2 ? d0 + idx : (idx - 2 < nleft ? d0 - 1 - (idx - 2) : idx + kt_lo); };
  const unsigned koff = (unsigned)(((ts0 + lrow) * 512 + 2 * hh * 64 + lch * 8) * 2);
  const unsigned voff = (unsigned)((((hh * 128 + lrow) * T_TOK) + ts0 + lch * 8) * 2);
  const char* dkb = (const char*)dk;
  const char* vtb = (const char*)vtd;
  auto prefetch = [&](int kt) {
    const unsigned ko = koff + (unsigned)kt * (64u * 512u * 2u);
    const unsigned vo = voff + (unsigned)kt * 128u;
    pk[0] = *(const u32x4*)(dkb + ko);
    pk[1] = *(const u32x4*)(dkb + ko + 128u);
    pv[0] = *(const u32x4*)(vtb + vo);
    pv[1] = *(const u32x4*)(vtb + vo + (unsigned)(64 * T_TOK * 2));
  };
  auto stage_at = [&](int boff) {
    char* kl0 = lds + boff;
    char* vl = kl0 + 2 * 64 * KS;
#pragma unroll
    for (int j = 0; j < 2; ++j) *(u32x4*)(kl0 + j * 64 * KS + lrow * KS + lch * 16) = pk[j];
#pragma unroll
    for (int j = 0; j < 2; ++j) lds_st_vt(vl + (lrow + 64 * j) * 144, lch, pv[j]);
  };
  auto scores = [&](int kt, int boff, f32x16 (&sc)[2]) {
    const int side = kt < kd ? -1 : (kt > kd ? 1 : 0);
    const float I = (float)side * cq - ref;
    const unsigned i_hi = cvt_pk(I, 0.f) & 0xffffu;
    const float ir1 = I - __uint_as_float(i_hi << 16);
    const unsigned i_mid = cvt_pk(ir1, 0.f) & 0xffffu;
    const float ir2 = ir1 - __uint_as_float(i_mid << 16);
    const unsigned i_lo = cvt_pk(ir2, 0.f) & 0xffffu;
    const float T = slope2 * (float)(kt * 64);
    const unsigned t_hi = cvt_pk(T, 0.f) & 0xffffu;
    const float r1 = T - __uint_as_float(t_hi << 16);
    const unsigned t_mid = cvt_pk(r1, 0.f) & 0xffffu;
    const float r2 = r1 - __uint_as_float(t_mid << 16);
    const unsigned t_lo = cvt_pk(r2, 0.f) & 0xffffu;
    const unsigned one = side < 0 ? 0x3F80u : (side > 0 ? 0xBF80u : 0u);
    u32x4 qa;
    qa.x = h == 0 ? (one | (one << 16)) : 0u; qa.y = qa.x; qa.z = h == 0 ? (one | (i_hi << 16)) : 0u; qa.w = h == 0 ? (i_mid | (i_lo << 16)) : 0u;
    const bf16x8 qaug = __builtin_bit_cast(bf16x8, qa);
#pragma unroll
    for (int kb = 0; kb < 2; ++kb) {
      const float xl = slope2 * (float)(32 * kb + r);
      const unsigned l_hi = cvt_pk(xl, 0.f) & 0xffffu;
      const unsigned l_lo = cvt_pk(xl - __uint_as_float(l_hi << 16), 0.f) & 0xffffu;
      u32x4 ka; ka.x = h == 0 ? (l_hi | (l_lo << 16)) : 0u; ka.y = h == 0 ? (t_hi | (t_mid << 16)) : 0u; ka.z = h == 0 ? (t_lo | 0x3F800000u) : 0u; ka.w = h == 0 ? 0x3F803F80u : 0u;
      f32x16 z;
#pragma unroll
      for (int i = 0; i < 16; ++i) z[i] = 0.f;
      sc[kb] = MFMA32(__builtin_bit_cast(bf16x8, ka), qaug, z);
    }
    qk_scores_acc<DQK>(lds + boff + map * 64 * KS, qf, sc, r, h);
  };
  prefetch(tile_of(0));
  __syncthreads();
  stage_at(0);
  prefetch(tile_of(1));
  __syncthreads();
#pragma unroll 1
  for (int idx = 0; idx < nkt; ++idx) {
    const int kt = tile_of(idx);
    const int cur = (idx & 1) * ATT_STAGE;
    if (idx + 1 < nkt) stage_at(((idx + 1) & 1) * ATT_STAGE);
    if (idx + 2 < nkt) prefetch(tile_of(idx + 2));
    f32x16 s[2];
    scores(kt, cur, s);
    if (kt == kd) {
#pragma unroll
      for (int kb = 0; kb < 2; ++kb)
#pragma unroll
        for (int i = 0; i < 16; ++i) {
          const int kp = kt * 64 + 32 * kb + (i & 3) + 8 * (i >> 2) + 4 * h;
          s[kb][i] -= slope2 * fabsf((float)(qpos - kp));
        }
    }
    if (!fixedref) ref += softmax_pre<DV>(s, o, l, idx == 0);
#pragma unroll
    for (int kb = 0; kb < 2; ++kb) {
      bf16x8 pf[2];
      softmax_exp_half(s[kb], l, pf);
      pv_half<DV>(pf, o, lds + cur + 2 * 64 * KS, kb, r, h);
    }
    __syncthreads();
  }
  l += __shfl_xor(l, 32);
  const float inv = 1.f / l;
  int tid2 = otid(p);
  const int lane2 = tid2 & 63, qw2 = (tid2 >> 6) & 3, h2 = lane2 >> 5;
  int item2 = item; asm volatile("" : "+s"(item2));
  int hh2, tq2;
  { int qb2, ts02, S2; diff_decode(item2, hh2, qb2, ts02, S2); tq2 = ts02 + qb2 * 128 + qw2 * 32 + (lane2 & 31); }
  float* ex = (float*)lds + qw2 * 4096;
  if (map == 1) {
#pragma unroll
    for (int d = 0; d < DV / 32; ++d)
#pragma unroll
      for (int i = 0; i < 16; ++i) ex[(d * 16 + i) * 64 + lane2] = o[d][i] * inv;
  }
  __syncthreads();
  if (map == 0) {
    const float lam = ((const float*)(p.ws + OFF_SCAL))[0];
    float ss = 0.f;
#pragma unroll
    for (int d = 0; d < DV / 32; ++d)
#pragma unroll
      for (int i = 0; i < 16; ++i) { const float v = o[d][i] * inv - lam * ex[(d * 16 + i) * 64 + lane2]; o[d][i] = v; ss += v * v; }
    ss += __shfl_xor(ss, 32);
    const float rn = rsqrtf(ss * (1.f / 128.f) + EPS) * 0.8f;
    const float* gs = (const float*)(p.ws + OFF_SCAL) + SC_GSUB;
#pragma unroll
    for (int d = 0; d < DV / 32; ++d) {
#pragma unroll
      for (int g = 0; g < 4; ++g) {
        const float4 gv = *(const float4*)(gs + 32 * d + 8 * g + 4 * h2);
        o[d][4 * g] *= gv.x; o[d][4 * g + 1] *= gv.y; o[d][4 * g + 2] *= gv.z; o[d][4 * g + 3] *= gv.w;
      }
      store_tok(o0, 1024, tq2, 512 + hh2 * 128 + 32 * d + 4 * h2, o[d], rn);
    }
  }
}

DI void attn_na_item(const Ctx& p, int item, char* lds) {
  constexpr int DQK = 64, DV = 64, KS = DQK * 2 + 16;
  const int tid = otid(p), lane = tid & 63, w = tid >> 6, r = lane & 31, h = lane >> 5;
  const int quad = item % 320, head = item / 320;
  const int t0 = quad * 256;
  int ts0, rows;
  if (t0 < T_PROMPT) { ts0 = t0 & ~4095; rows = 64; } else { ts0 = T_PROMPT; rows = 256; }
  const int r0 = (t0 - ts0) >> 6;
  const int rw = r0 + (w >> 1);
  const int rs_lo = min(max(r0 - 4, 0), rows - 8);
  const int rs_hi = min(max(r0 + 3 - 4, 0), rows - 8);
  const int rs_w = min(max(rw - 4, 0), rows - 8);
  const int ntile = rs_hi + 8 - rs_lo;
  const u16* base = (const u16*)(p.ws + OFF_R2);
  const u16* qn = base;
  const u16* kn = base + SEG512;
  const u16* vtn = base + 4 * SEG512;
  u16* o0 = (u16*)(p.ws + OFF_R1);
  float* tab = (float*)(lds + 2 * ATT_STAGE) + 64;
  const int qc = (w & 1) * 32 + r;
  const int tq = t0 + w * 32 + r;
  bf16x8 qf[DQK / 16];
#pragma unroll
  for (int ks = 0; ks < DQK / 16; ++ks) qf[ks] = *(const bf16x8*)(qn + (size_t)tq * 512 + head * 64 + 16 * ks + 8 * h);
  f32x16 o[DV / 32];
#pragma unroll
  for (int d = 0; d < DV / 32; ++d)
#pragma unroll
    for (int i = 0; i < 16; ++i) o[d][i] = 0.f;
  f32x16 initv;
#pragma unroll
  for (int i = 0; i < 16; ++i) initv[i] = 0.f;
  float l = 0.f;
  bool first = true;
  u32x4 pk0, pv0;
  const int lrow = tid >> 3, lch = tid & 7;
  auto prefetch = [&](int j) {
    const int tk0 = ts0 + (rs_lo + j) * 64;
    pk0 = *(const u32x4*)(kn + (size_t)(tk0 + lrow) * 512 + head * 64 + lch * 8);
    pv0 = *(const u32x4*)(vtn + (size_t)(head * 64 + lrow) * T_TOK + tk0 + lch * 8);
  };
  auto stage = [&](int b) {
    char* kl = lds + b * ATT_STAGE;
    char* vl = kl + 64 * KS;
    *(u32x4*)(kl + lrow * KS + lch * 16) = pk0;
    lds_st_vt(vl + lrow * 144, lch, pv0);
  };
  prefetch(0);
  __syncthreads();
  if (tid < 465) tab[tid] = ((const float*)(p.ws + OFF_SCAL))[SC_RPB + head * 465 + tid];
  stage(0);
  prefetch(1);
  __syncthreads();
  const int wc0 = min(max(qc - 8, 0), 48);
  const float* tabq = tab + (15 - qc + 4 * h);
  for (int j = 0; j < ntile; ++j) {
    const char* kl = lds + (j & 1) * ATT_STAGE;
    const char* vl = kl + 64 * KS;
    const int kr = rs_lo + j;
    if (kr >= rs_w && kr < rs_w + 8) {
      f32x16 s[2];
      qk_scores<DQK>(kl, qf, initv, s, r, h);
      const int ridx = kr - rw + 7;
#pragma unroll
      for (int kb = 0; kb < 2; ++kb)
#pragma unroll
        for (int i = 0; i < 16; ++i) {
          const int kc = 32 * kb + (i & 3) + 8 * (i >> 2) + 4 * h;
          const bool ok = (unsigned)(kc - wc0) < 16u;
          float b = tabq[ridx * 31 + 32 * kb + (i & 3) + 8 * (i >> 2)];
          asm volatile("" : "+v"(b));
          s[kb][i] = ok ? s[kb][i] + b : -INFINITY;
        }
      {
        const float dl = softmax_pv<DV>(s, o, l, first, vl, r, h);
        if (__any(dl != 0.f)) {
#pragma unroll
          for (int i = 0; i < 16; ++i) initv[i] -= dl;
        }
      }
      first = false;
    }
    if (j + 1 < ntile) stage((j + 1) & 1);
    if (j + 2 < ntile) prefetch(j + 2);
    __syncthreads();
  }
  l += __shfl_xor(l, 32);
  const float inv = 1.f / l;
#pragma unroll
  for (int d = 0; d < DV / 32; ++d) store_tok(o0, 1024, tq, head * 64 + 32 * d + 4 * h, o[d], inv);
}

DI void phase_qk_norms(const Ctx& p) {
  const int tid_ = otid(p);
  const int lane = tid_ & 63;
  const int gw = obid() * 8 + (tid_ >> 6), nw = gridDim.x * 8;
  const u16* dq = (const u16*)(p.ws + OFF_R2) + 2 * SEG512;
  const u16* dk = (const u16*)(p.ws + OFF_R2) + 3 * SEG512;
  float mq = 0.f, mk = 0.f;
  for (int row = gw; row < T_TOK; row += nw) {
    const uint4 a = ((const uint4*)(dq + (size_t)row * 512))[lane];
    const uint4 b = ((const uint4*)(dk + (size_t)row * 512))[lane];
    float sa = 0.f, sb = 0.f, t;
    t = bflo(a.x); sa += t * t; t = bfhi(a.x); sa += t * t; t = bflo(a.y); sa += t * t; t = bfhi(a.y); sa += t * t;
    t = bflo(a.z); sa += t * t; t = bfhi(a.z); sa += t * t; t = bflo(a.w); sa += t * t; t = bfhi(a.w); sa += t * t;
    t = bflo(b.x); sb += t * t; t = bfhi(b.x); sb += t * t; t = bflo(b.y); sb += t * t; t = bfhi(b.y); sb += t * t;
    t = bflo(b.z); sb += t * t; t = bfhi(b.z); sb += t * t; t = bflo(b.w); sb += t * t; t = bfhi(b.w); sb += t * t;
#pragma unroll
    for (int o = 1; o < 8; o <<= 1) { sa += __shfl_xor(sa, o); sb += __shfl_xor(sb, o); }
    mq = fmaxf(mq, sa); mk = fmaxf(mk, sb);
  }
  if ((lane & 7) == 0) {
    unsigned* qk = (unsigned*)(p.ws + OFF_SCAL) + SC_QKMAX;
    atomicMax(qk + (lane >> 3), __float_as_uint(sqrtf(mq)));
    atomicMax(qk + 8 + (lane >> 3), __float_as_uint(sqrtf(mk)));
  }
}

namespace pg8 {
#define PG8_LAS __attribute__((address_space(3)))
typedef unsigned short bf16_t;
typedef short bf16x8 __attribute__((ext_vector_type(8)));
typedef float f32x4 __attribute__((ext_vector_type(4)));
typedef unsigned u32x4 __attribute__((ext_vector_type(4)));
constexpr int BM = 256, BK = 64, HALF = 128, HTB = HALF * BK * 2  , STAGE_BYTES = 8 * HTB, NXCD = 8, WGM = 8;

__host__ __device__ __forceinline__ int lds_byte(int r, int c) { const int st = (r >> 4) * 2 + (c >> 5), rr = r & 15, cc = c & 31, ob = rr * 64 + cc * 2; return st * 1024 + (ob ^ (((ob >> 9) & 1) << 5)); }
__host__ __device__ __forceinline__ void stage_rc(int b, int& R, int& C) { const int st = b / 1024, sb = b % 1024, swz = sb ^ (((sb >> 9) & 1) << 5); R = (st >> 1) * 16 + swz / 64; C = (st & 1) * 32 + (swz % 64) / 2; }
__host__ __device__ __forceinline__ int perm32(int rho) { const int n = rho >> 4, i = rho & 15; return 8 * (i >> 2) + 4 * n + (i & 3); }

struct Unit { int pm, pn; };
struct Gemm { const bf16_t* A; const bf16_t* Bt; int M, N, K; int lda, ldb; };

struct StaticOrder {
    int nM, nN, nwg, G, c;
    __host__ __device__ void init(int M, int N, int G_, int c_) { nM = M / BM; nN = N / BM; nwg = nM * nN; G = G_; c = c_; }
    __host__ __device__ bool next(int i, Unit& u) const {
        const long L = (long)i * G + c; if (L >= nwg) return false;
        int wgid = (int)L; { const int q = nwg / NXCD, r = nwg % NXCD, xcd = wgid % NXCD, off = wgid / NXCD; wgid = (xcd < r ? xcd * (q + 1) : r * (q + 1) + (xcd - r) * q) + off; }
        const int nig = WGM * nN, gid = wgid / nig, fm = gid * WGM, gsz = (nM - fm) < WGM ? (nM - fm) : WGM;
        u.pm = fm + ((wgid % nig) % gsz); u.pn = (wgid % nig) / gsz; return true;
    }
    __device__ __forceinline__ void a_ready(const Unit&) const {}
    __device__ __forceinline__ void done(const Unit&) const {}
};
struct CountedOrder : StaticOrder {
    const unsigned* ready; unsigned need; unsigned* tmo;
    __device__ __forceinline__ void a_ready(const Unit& u) const {
        if (threadIdx.x < 64) {
            const unsigned long long t0 = __builtin_amdgcn_s_memrealtime(); unsigned polls = 0;
            while ((unsigned)__builtin_amdgcn_readfirstlane(__hip_atomic_load(ready + 64 * u.pm, __ATOMIC_RELAXED, __HIP_MEMORY_SCOPE_AGENT)) < need) {
                if ((++polls & 255u) == 0u && __builtin_amdgcn_readfirstlane(__hip_atomic_load(tmo, __ATOMIC_RELAXED, __HIP_MEMORY_SCOPE_AGENT)) != 0u) break;
                if (__builtin_amdgcn_s_memrealtime() - t0 > 2000000ull) {
                    if (threadIdx.x == 0) { unsigned expect = 0u; __hip_atomic_compare_exchange_strong(tmo + 1, &expect, 0x600u | (unsigned)(u.pm & 0xff), __ATOMIC_RELAXED, __ATOMIC_RELAXED, __HIP_MEMORY_SCOPE_AGENT); __hip_atomic_store(tmo, 1u, __ATOMIC_RELAXED, __HIP_MEMORY_SCOPE_AGENT); }
                    break; }
                __builtin_amdgcn_s_sleep(2); }
            __builtin_amdgcn_fence(__ATOMIC_ACQUIRE, "agent");
            asm volatile("s_waitcnt vmcnt(0)" ::: "memory");
        }
#if !defined(BROKEN_HOOK_NO_BARRIER)
        asm volatile("" ::: "memory"); __builtin_amdgcn_s_barrier(); asm volatile("" ::: "memory");
#endif
    }
};

__device__ __forceinline__ unsigned cvt_pk_bf16(float lo, float hi) { unsigned r; asm volatile("v_cvt_pk_bf16_f32 %0, %1, %2" : "=v"(r) : "v"(lo), "v"(hi)); return r; }
typedef float f32x2 __attribute__((ext_vector_type(2)));
__device__ __forceinline__ f32x2 gelu_pk(f32x2 v) {
    const f32x2 av = __builtin_elementwise_abs(v), d = av * 0.2316418882f + 1.0f;
    f32x2 t; t.x = __builtin_amdgcn_rcpf(d.x); t.y = __builtin_amdgcn_rcpf(d.y);
    f32x2 q = t * 0.5307027145f + (-0.7265760135f); q = q * t + 0.7107068705f; q = q * t + (-0.142248368f); q = q * t + 0.127414796f; q = q * t;
    const f32x2 s = (v * v) * (-0.72134752044f);
    f32x2 e; e.x = __builtin_amdgcn_exp2f(s.x); e.y = __builtin_amdgcn_exp2f(s.y);
    const f32x2 m = v * (q * e), r = v - m;
    f32x2 o; o.x = v.x < 0.f ? m.x : r.x; o.y = v.y < 0.f ? m.y : r.y; return o;
}

struct EpiF32 {
    static constexpr bool PERM = false, AFTER_DRAIN = false;
    float* C; int ldc; const float* bias;
    __device__ __forceinline__ void operator()(const f32x4 (&acc)[2][2][4][2], const Unit& u, int wr, int wc, int fr, int fq) const {
        const int row0 = u.pm * BM + wr * 64 + fr, col0 = u.pn * BM + wc * 32 + 4 * fq;
        f32x4 bv[2][2];
#pragma unroll
        for (int bj = 0; bj < 2; ++bj)
#pragma unroll
            for (int n = 0; n < 2; ++n) bv[bj][n] = bias ? *(const f32x4*)(bias + col0 + bj * HALF + n * 16) : (f32x4){0.f, 0.f, 0.f, 0.f};
#pragma unroll
        for (int ai = 0; ai < 2; ++ai)
#pragma unroll
            for (int m = 0; m < 4; ++m) { float* rowp = C + (size_t)(row0 + ai * HALF + m * 16) * ldc + col0;
#pragma unroll
                for (int bj = 0; bj < 2; ++bj)
#pragma unroll
                    for (int n = 0; n < 2; ++n) *(f32x4*)(rowp + bj * HALF + n * 16) = acc[ai][bj][m][n] + bv[bj][n]; }
    }
};
template <int ACT  > struct EpiBf16 {
    static constexpr bool PERM = true, AFTER_DRAIN = false;
    bf16_t* O; int ldc; const float* bias; int split_cols; size_t split_stride;
    __device__ __forceinline__ void operator()(const f32x4 (&acc)[2][2][4][2], const Unit& u, int wr, int wc, int fr, int fq) const {
        const int row0 = u.pm * BM + wr * 64 + fr; int colt = u.pn * BM; bf16_t* base = O;
        if (split_cols) { const int t = colt / split_cols; base += (size_t)t * split_stride; colt -= t * split_cols; }
        const int col0 = colt + wc * 32 + 8 * fq, bcol0 = u.pn * BM + wc * 32 + 8 * fq;
        f32x4 bv[2][2];
#pragma unroll
        for (int bj = 0; bj < 2; ++bj)
#pragma unroll
            for (int n = 0; n < 2; ++n) bv[bj][n] = bias ? *(const f32x4*)(bias + bcol0 + bj * HALF + 4 * n) : (f32x4){0.f, 0.f, 0.f, 0.f};
#pragma unroll
        for (int ai = 0; ai < 2; ++ai)
#pragma unroll
            for (int m = 0; m < 4; ++m) { bf16_t* rowp = base + (size_t)(row0 + ai * HALF + m * 16) * ldc + col0;
#pragma unroll
                for (int bj = 0; bj < 2; ++bj) { f32x4 v0 = acc[ai][bj][m][0] + bv[bj][0], v1 = acc[ai][bj][m][1] + bv[bj][1];
                    if (ACT == 1) { f32x2 a = gelu_pk((f32x2){v0[0], v0[1]}), b = gelu_pk((f32x2){v0[2], v0[3]}), c = gelu_pk((f32x2){v1[0], v1[1]}), d = gelu_pk((f32x2){v1[2], v1[3]});
                        v0 = (f32x4){a.x, a.y, b.x, b.y}; v1 = (f32x4){c.x, c.y, d.x, d.y}; }
                    if (ACT == 2) {
#pragma unroll
                        for (int j = 0; j < 4; ++j) { v0[j] = 0.5f * v0[j] * (1.0f + erff(v0[j] * 0.70710678f)); v1[j] = 0.5f * v1[j] * (1.0f + erff(v1[j] * 0.70710678f)); } }
                    u32x4 w; w.x = cvt_pk_bf16(v0[0], v0[1]); w.y = cvt_pk_bf16(v0[2], v0[3]); w.z = cvt_pk_bf16(v1[0], v1[1]); w.w = cvt_pk_bf16(v1[2], v1[3]);
                    *(u32x4*)(rowp + bj * HALF) = w; } }
    }
};

struct PanelStats {
    unsigned* xbuf;
    unsigned* cnt;
    unsigned* tmo;
    int ntn; float eps;
    unsigned code;
    __device__ __forceinline__ bool run(const f32x4 (&v)[2][2][4][2], const Unit& u, int wr, int wc, int fr, int fq, PG8_LAS unsigned char* lds, int wid, int lane) const {
        typedef float f32x2v __attribute__((ext_vector_type(2)));
        PG8_LAS f32x2v* P = (PG8_LAS f32x2v*)lds;
        PG8_LAS f32x2v* S = (PG8_LAS f32x2v*)(lds + 8192);
        PG8_LAS unsigned* flag = (PG8_LAS unsigned*)(lds + 8192 + 2048);
#pragma unroll
        for (int ai = 0; ai < 2; ++ai)
#pragma unroll
            for (int m = 0; m < 4; ++m) {
                float s = 0.f;
#pragma unroll
                for (int bj = 0; bj < 2; ++bj)
#pragma unroll
                    for (int n = 0; n < 2; ++n) { const f32x4 x = v[ai][bj][m][n]; s += (x[0] + x[1]) + (x[2] + x[3]); }
                s += __shfl_xor(s, 16); s += __shfl_xor(s, 32);
                const float mw = s * (1.0f / 64.0f); float q = 0.f;
#pragma unroll
                for (int bj = 0; bj < 2; ++bj)
#pragma unroll
                    for (int n = 0; n < 2; ++n) { const f32x4 d = v[ai][bj][m][n] - mw; q += (d[0] * d[0] + d[1] * d[1]) + (d[2] * d[2] + d[3] * d[3]); }
                q += __shfl_xor(q, 16); q += __shfl_xor(q, 32);
                if (fq == 0) P[(ai * HALF + wr * 64 + m * 16 + fr) * 4 + wc] = (f32x2v){mw, q};
            }
        asm volatile("s_waitcnt lgkmcnt(0)" ::: "memory"); __builtin_amdgcn_s_barrier(); asm volatile("" ::: "memory");
#if defined(BROKEN_NO_WAIT)
        if (blockIdx.x >= 64) { const long long t0 = clock64(); while (clock64() - t0 < 60000) __builtin_amdgcn_s_sleep(8); }
#endif
        const int row = wid * 32 + (lane & 31);
        if (lane < 32) {
            const f32x2v a = P[row * 4 + 0], b = P[row * 4 + 1], c = P[row * 4 + 2], d = P[row * 4 + 3];
            const float mt = (a.x + b.x + c.x + d.x) * 0.25f;
            const float da = a.x - mt, db = b.x - mt, dc = c.x - mt, dd = d.x - mt;
            const float m2 = (a.y + b.y) + (c.y + d.y) + 64.0f * ((da * da + db * db) + (dc * dc + dd * dd));
            unsigned long long* slot = (unsigned long long*)xbuf + ((size_t)(u.pm * BM + row) * 4 + u.pn);
            __hip_atomic_store(slot, ((unsigned long long)__float_as_uint(m2) << 32) | __float_as_uint(mt), __ATOMIC_RELAXED, __HIP_MEMORY_SCOPE_AGENT);
        }
        asm volatile("s_waitcnt vmcnt(0)" ::: "memory");
        if (lane == 0) __hip_atomic_fetch_add(cnt + 64 * u.pm, 1u, __ATOMIC_RELAXED, __HIP_MEMORY_SCOPE_AGENT);
        if (wid == 0) {
            bool dead = false; const unsigned long long t0 = __builtin_amdgcn_s_memrealtime(); const unsigned want = 8u * (unsigned)ntn;
            for (;;) {
#if defined(BROKEN_NO_WAIT)
                break;
#endif
                if ((unsigned)__builtin_amdgcn_readfirstlane(__hip_atomic_load(cnt + 64 * u.pm, __ATOMIC_RELAXED, __HIP_MEMORY_SCOPE_AGENT)) >= want) break;
                if (__builtin_amdgcn_s_memrealtime() - t0 > 2000000ull) {
                    if (lane == 0) { unsigned expect = 0u; __hip_atomic_compare_exchange_strong(tmo + 1, &expect, code | (unsigned)(u.pm & 0xff), __ATOMIC_RELAXED, __ATOMIC_RELAXED, __HIP_MEMORY_SCOPE_AGENT);
                                     __hip_atomic_store(tmo, 1u, __ATOMIC_RELAXED, __HIP_MEMORY_SCOPE_AGENT); }
                    dead = true; break; }
                __builtin_amdgcn_s_sleep(2);
            }
            __builtin_amdgcn_fence(__ATOMIC_ACQUIRE, "agent");
            if (lane == 0) flag[0] = dead ? 1u : 0u;
        }
        asm volatile("s_waitcnt vmcnt(0) lgkmcnt(0)" ::: "memory"); __builtin_amdgcn_s_barrier(); asm volatile("" ::: "memory");
        const bool bad = flag[0] != 0u;
        if (lane < 32) {
            const unsigned long long* slot = (const unsigned long long*)xbuf + (size_t)(u.pm * BM + row) * 4; float mt[4], m2[4]; float ms = 0.f;
#pragma unroll
            for (int t = 0; t < 4; ++t) { if (t < ntn) { const unsigned long long w = __hip_atomic_load(slot + t, __ATOMIC_RELAXED, __HIP_MEMORY_SCOPE_AGENT); mt[t] = __uint_as_float((unsigned)w); m2[t] = __uint_as_float((unsigned)(w >> 32)); } else { mt[t] = 0.f; m2[t] = 0.f; } ms += mt[t]; }
            const float mean = ms / (float)ntn; float q = 0.f;
#pragma unroll
            for (int t = 0; t < 4; ++t) if (t < ntn) { const float dm = mt[t] - mean; q += m2[t] + 256.0f * dm * dm; }
            S[row] = (f32x2v){mean, 1.0f / sqrtf(q / (256.0f * (float)ntn) + eps)};
        }
        asm volatile("s_waitcnt lgkmcnt(0)" ::: "memory"); __builtin_amdgcn_s_barrier(); asm volatile("" ::: "memory");
        return bad;
    }
};
struct EpiLnRes {
    static constexpr bool PERM = false, AFTER_DRAIN = true;
    const float* base; float* out; int ldc; const float* bias; PanelStats st; unsigned poison;
    __device__ __forceinline__ void refuse(size_t i0, size_t stride, int M, int N) const { const float q = __builtin_nanf(""); for (size_t i = i0; i < (size_t)M * N; i += stride) out[(i / N) * ldc + i % N] = q;
        if (i0 == 0) { unsigned expect = 0u; __hip_atomic_compare_exchange_strong(st.tmo + 1, &expect, 0x7f0u, __ATOMIC_RELAXED, __ATOMIC_RELAXED, __HIP_MEMORY_SCOPE_AGENT); __hip_atomic_store(st.tmo, 1u, __ATOMIC_RELAXED, __HIP_MEMORY_SCOPE_AGENT); } }
    __device__ __forceinline__ void fused(f32x4 (&acc)[2][2][4][2], const Unit& u, int wr, int wc, int fr, int fq, PG8_LAS unsigned char* lds, int wid, int lane) const {
        typedef float f32x2v __attribute__((ext_vector_type(2)));
        const PG8_LAS f32x2v* S = (const PG8_LAS f32x2v*)(lds + 8192);
        const int col0 = u.pn * BM + wc * 32 + 4 * fq;
#pragma unroll
        for (int bj = 0; bj < 2; ++bj)
#pragma unroll
            for (int n = 0; n < 2; ++n) { const f32x4 bv = bias ? *(const f32x4*)(bias + col0 + bj * HALF + n * 16) : (f32x4){0.f, 0.f, 0.f, 0.f};
#pragma unroll
                for (int ai = 0; ai < 2; ++ai)
#pragma unroll
                    for (int m = 0; m < 4; ++m) acc[ai][bj][m][n] += bv; }
        const bool bad = st.run(acc, u, wr, wc, fr, fq, lds, wid, lane) || poison != 0u;
        const float qnan = __builtin_nanf("");
#pragma unroll
        for (int ai = 0; ai < 2; ++ai)
#pragma unroll
            for (int m = 0; m < 4; ++m) { const int r = ai * HALF + wr * 64 + m * 16 + fr; const f32x2v sr = S[r]; const size_t off = (size_t)(u.pm * BM + r) * ldc + col0;
#pragma unroll
                for (int bj = 0; bj < 2; ++bj)
#pragma unroll
                    for (int n = 0; n < 2; ++n) { const f32x4 bs = *(const f32x4*)(base + off + bj * HALF + n * 16); f32x4 o = bs + (acc[ai][bj][m][n] - sr.x) * sr.y;
                        if (bad) o = (f32x4){qnan, qnan, qnan, qnan}; *(f32x4*)(out + off + bj * HALF + n * 16) = o; }
                asm volatile("" ::: "memory"); }
    }
};
struct EpiLnResLn {
    static constexpr bool PERM = false, AFTER_DRAIN = true;
    const float* base; float* out; bf16_t* xn; int ldc; const float* bias; PanelStats st1, st2; unsigned poison;
    __device__ __forceinline__ void refuse(size_t i0, size_t stride, int M, int N) const { const float q = __builtin_nanf(""); for (size_t i = i0; i < (size_t)M * N; i += stride) { const size_t o = (i / N) * ldc + i % N; out[o] = q; xn[o] = (bf16_t)0x7fc0u; }
        if (i0 == 0) { unsigned expect = 0u; __hip_atomic_compare_exchange_strong(st1.tmo + 1, &expect, 0x7f0u, __ATOMIC_RELAXED, __ATOMIC_RELAXED, __HIP_MEMORY_SCOPE_AGENT); __hip_atomic_store(st1.tmo, 1u, __ATOMIC_RELAXED, __HIP_MEMORY_SCOPE_AGENT); } }
    __device__ __forceinline__ void fused(f32x4 (&acc)[2][2][4][2], const Unit& u, int wr, int wc, int fr, int fq, PG8_LAS unsigned char* lds, int wid, int lane) const {
        typedef float f32x2v __attribute__((ext_vector_type(2))); typedef unsigned u32x2v __attribute__((ext_vector_type(2)));
        const PG8_LAS f32x2v* S = (const PG8_LAS f32x2v*)(lds + 8192);
        const int col0 = u.pn * BM + wc * 32 + 4 * fq;
#pragma unroll
        for (int bj = 0; bj < 2; ++bj)
#pragma unroll
            for (int n = 0; n < 2; ++n) { const f32x4 bv = bias ? *(const f32x4*)(bias + col0 + bj * HALF + n * 16) : (f32x4){0.f, 0.f, 0.f, 0.f};
#pragma unroll
                for (int ai = 0; ai < 2; ++ai)
#pragma unroll
                    for (int m = 0; m < 4; ++m) acc[ai][bj][m][n] += bv; }
        bool bad = st1.run(acc, u, wr, wc, fr, fq, lds, wid, lane) || poison != 0u;
        const float qnan = __builtin_nanf("");
#pragma unroll
        for (int ai = 0; ai < 2; ++ai)
#pragma unroll
            for (int m = 0; m < 4; ++m) { const int r = ai * HALF + wr * 64 + m * 16 + fr; const f32x2v sr = S[r]; const size_t off = (size_t)(u.pm * BM + r) * ldc + col0;
#pragma unroll
                for (int bj = 0; bj < 2; ++bj)
#pragma unroll
                    for (int n = 0; n < 2; ++n) { const f32x4 bs = *(const f32x4*)(base + off + bj * HALF + n * 16); acc[ai][bj][m][n] = bs + (acc[ai][bj][m][n] - sr.x) * sr.y; }
                asm volatile("" : "+v"(acc[ai][0][m][0]), "+v"(acc[ai][0][m][1]), "+v"(acc[ai][1][m][0]), "+v"(acc[ai][1][m][1]));
                if (m & 1) asm volatile("" ::: "memory"); }
        const bool bad1 = bad;
        bad = st2.run(acc, u, wr, wc, fr, fq, lds, wid, lane) || bad;
#pragma unroll
        for (int ai = 0; ai < 2; ++ai)
#pragma unroll
            for (int m = 0; m < 4; ++m) { const int r = ai * HALF + wr * 64 + m * 16 + fr; const f32x2v sr = S[r]; const size_t off = (size_t)(u.pm * BM + r) * ldc + col0;
#pragma unroll
                for (int bj = 0; bj < 2; ++bj)
#pragma unroll
                    for (int n = 0; n < 2; ++n) { const f32x4 x1 = acc[ai][bj][m][n]; *(f32x4*)(out + off + bj * HALF + n * 16) = bad1 ? (f32x4){qnan, qnan, qnan, qnan} : x1;
                        const f32x4 o = (x1 - sr.x) * sr.y; u32x2v w; w.x = cvt_pk_bf16(o[0], o[1]); w.y = cvt_pk_bf16(o[2], o[3]);
                        if (bad) { w.x = 0x7fc07fc0u; w.y = 0x7fc07fc0u; } *(u32x2v*)(xn + off + bj * HALF + n * 16) = w; }
                asm volatile("" ::: "memory"); }
    }
};

template <class Epi, class Sched, bool STAMP = false>
__device__ __forceinline__ void gemm_phase(PG8_LAS unsigned char* lds, const Gemm g, const Sched& S, const Epi& E, unsigned long long* stamps, const int tid) {
    const int wid = __builtin_amdgcn_readfirstlane(tid >> 6), lane = tid & 63, wr = wid >> 2, wc = wid & 3, fr = lane & 15, fq = lane >> 4;
    const int K = g.K, nt = K / BK;
    int ts_lo = 0, ts_hi = 0, nts = 0; const unsigned long long rt_entry = STAMP ? (unsigned long long)wall_clock64() : 0ull;
#define PG8_STAMP() do { if (STAMP && wid == 0 && nts < 64) { const unsigned long long _c = (unsigned long long)clock64(); \
        ts_lo = (lane == nts) ? (int)(unsigned)_c : ts_lo; ts_hi = (lane == nts) ? (int)(unsigned)(_c >> 32) : ts_hi; ++nts; } } while (0)
    PG8_STAMP();
    unsigned voffA[2], voffB[2];
#pragma unroll
    for (int i = 0; i < 2; ++i) { int R, C; stage_rc(tid * 16 + i * 8192, R, C); const int Rb = Epi::PERM ? ((R & ~31) + perm32(R & 31)) : R;
        voffA[i] = (unsigned)(R * g.lda + C) * 2u; voffB[i] = (unsigned)(Rb * g.ldb + C) * 2u; }
    const size_t kstep = (size_t)(BK * 2);
    const size_t hstepA = (size_t)HALF * g.lda * 2, hstepB = (size_t)HALF * g.ldb * 2;
    const size_t tstepA = 2 * hstepA, tstepB = 2 * hstepB;
    const unsigned ldsw = (unsigned)wid * 1024u;
    const int aoff = lds_byte(wr * 64 + fr, fq * 8), boff = lds_byte(wc * 32 + fr, fq * 8);
#define PG8_SA(b, h) (((b) * 2 + (h)) * HTB)
#define PG8_SB(b, h) ((4 + (b) * 2 + (h)) * HTB)
#define PG8_STAGE(bufoff, gbase, voff) do { _Pragma("unroll") for (int _i = 0; _i < 2; ++_i) \
        __builtin_amdgcn_global_load_lds((const unsigned*)((const char*)(gbase) + (voff)[_i]), (PG8_LAS unsigned*)(lds + (bufoff) + ldsw + _i * 8192), 16, 0, 0); } while (0)
#define PG8_LDA(dst, b, h) do { _Pragma("unroll") for (int m = 0; m < 4; ++m) _Pragma("unroll") for (int k = 0; k < 2; ++k) dst[m][k] = *(const PG8_LAS bf16x8*)(lds + PG8_SA(b, h) + aoff + m * 2048 + k * 1024); } while (0)
#define PG8_LDB(dst, b, h) do { _Pragma("unroll") for (int n = 0; n < 2; ++n) _Pragma("unroll") for (int k = 0; k < 2; ++k) dst[n][k] = *(const PG8_LAS bf16x8*)(lds + PG8_SB(b, h) + boff + n * 2048 + k * 1024); } while (0)
#define PG8_MMA(ai, bj, At, Bt) do { __builtin_amdgcn_s_setprio(1); _Pragma("unroll") for (int m = 0; m < 4; ++m) _Pragma("unroll") for (int n = 0; n < 2; ++n) _Pragma("unroll") for (int k = 0; k < 2; ++k) \
        acc[ai][bj][m][n] = __builtin_amdgcn_mfma_f32_16x16x32_bf16(Bt[n][k], At[m][k], acc[ai][bj][m][n], 0, 0, 0); __builtin_amdgcn_s_setprio(0); } while (0)
#define PG8_WAIT_V(n) asm volatile("s_waitcnt vmcnt(" #n ")" ::: "memory")
#define PG8_WAIT_L(n) asm volatile("s_waitcnt lgkmcnt(" #n ")" ::: "memory")
#define PG8_BAR __builtin_amdgcn_s_barrier()
#define PG8_SCHED __builtin_amdgcn_sched_barrier(0)
    Unit cur, nxt; int ui = 0;
    if (!S.next(0, cur)) return;
    f32x4 acc[2][2][4][2];
#pragma unroll
    for (int a = 0; a < 2; ++a)
#pragma unroll
        for (int b = 0; b < 2; ++b)
#pragma unroll
            for (int m = 0; m < 4; ++m)
#pragma unroll
                for (int n = 0; n < 2; ++n) acc[a][b][m][n] = (f32x4){0.f, 0.f, 0.f, 0.f};
    bf16x8 At[4][2], B0[2][2], B1[2][2];
    const char* cA = (const char*)g.A + (size_t)cur.pm * tstepA; const char* cB = (const char*)g.Bt + (size_t)cur.pn * tstepB;
    S.a_ready(cur);
    PG8_STAGE(PG8_SB(0, 0), cB, voffB); PG8_STAGE(PG8_SA(0, 0), cA, voffA); PG8_STAGE(PG8_SB(0, 1), cB + hstepB, voffB); PG8_STAGE(PG8_SA(0, 1), cA + hstepA, voffA);
    if (wr == 1) PG8_BAR;
    PG8_WAIT_V(4); PG8_BAR;
    PG8_STAGE(PG8_SB(1, 0), cB + kstep, voffB); PG8_STAGE(PG8_SA(1, 0), cA + kstep, voffA); PG8_STAGE(PG8_SB(1, 1), cB + hstepB + kstep, voffB);
    PG8_WAIT_V(6); PG8_BAR;
    PG8_STAMP();
    for (;;) {
        const bool has_next = S.next(ui + 1, nxt);
        const char* nA = has_next ? (const char*)g.A + (size_t)nxt.pm * tstepA : cA; const char* nB = has_next ? (const char*)g.Bt + (size_t)nxt.pn * tstepB : cB;
        for (int t = 0; t < nt; t += 2) {
            const bool last = (t == nt - 2);
            const char* a1 = cA + (size_t)(t + 1) * kstep;
            const char* a2 = last ? nA : cA + (size_t)(t + 2) * kstep; const char* b2 = last ? nB : cB + (size_t)(t + 2) * kstep;
            const char* a3 = a2 + kstep; const char* b3 = b2 + kstep;
            if (last && has_next) S.a_ready(nxt);
            PG8_LDB(B0, 0, 0); PG8_SCHED; PG8_LDA(At, 0, 0); PG8_STAGE(PG8_SA(1, 1), a1 + hstepA, voffA);
            PG8_WAIT_L(8); PG8_BAR; PG8_WAIT_L(0); PG8_MMA(0, 0, At, B0); PG8_BAR; PG8_SCHED;
            PG8_LDB(B1, 0, 1); PG8_STAGE(PG8_SB(0, 0), b2, voffB);
            PG8_BAR; PG8_WAIT_L(0); PG8_MMA(0, 1, At, B1); PG8_BAR;
            PG8_LDA(At, 0, 1); PG8_STAGE(PG8_SA(0, 0), a2, voffA);
            PG8_BAR; PG8_WAIT_L(0); PG8_MMA(1, 0, At, B0); PG8_BAR; PG8_SCHED;
            PG8_STAGE(PG8_SB(0, 1), b2 + hstepB, voffB);
            PG8_WAIT_V(6); PG8_BAR; PG8_MMA(1, 1, At, B1); PG8_BAR;
            PG8_LDB(B0, 1, 0); PG8_SCHED; PG8_LDA(At, 1, 0); PG8_STAGE(PG8_SA(0, 1), a2 + hstepA, voffA);
            PG8_WAIT_L(8); PG8_BAR; PG8_WAIT_L(0); PG8_MMA(0, 0, At, B0); PG8_BAR; PG8_SCHED;
            PG8_LDB(B1, 1, 1); PG8_STAGE(PG8_SB(1, 0), b3, voffB);
            PG8_BAR; PG8_WAIT_L(0); PG8_MMA(0, 1, At, B1); PG8_BAR;
            PG8_LDA(At, 1, 1); PG8_STAGE(PG8_SA(1, 0), a3, voffA);
            PG8_BAR; PG8_WAIT_L(0); PG8_MMA(1, 0, At, B0); PG8_BAR; PG8_SCHED;
            PG8_STAGE(PG8_SB(1, 1), b3 + hstepB, voffB);
            PG8_WAIT_V(6); PG8_BAR; PG8_MMA(1, 1, At, B1); PG8_BAR;
        }
        PG8_STAMP();
        if constexpr (!Epi::AFTER_DRAIN) { E(acc, cur, wr, wc, fr, fq); S.done(cur); }
        PG8_STAMP();
        if (!has_next) break;
#pragma unroll
        for (int a = 0; a < 2; ++a)
#pragma unroll
            for (int b = 0; b < 2; ++b)
#pragma unroll
                for (int m = 0; m < 4; ++m)
#pragma unroll
                    for (int n = 0; n < 2; ++n) acc[a][b][m][n] = (f32x4){0.f, 0.f, 0.f, 0.f};
        cur = nxt; cA = nA; cB = nB; ++ui;
    }
    PG8_WAIT_V(0);
    if (wr == 0) PG8_BAR;
    PG8_BAR;
    if constexpr (Epi::AFTER_DRAIN) { E.fused(acc, cur, wr, wc, fr, fq, lds, wid, lane); S.done(cur); }
    PG8_STAMP();
    if (STAMP && wid == 0) { stamps[lane] = lane < nts ? (((unsigned long long)(unsigned)ts_hi << 32) | (unsigned)ts_lo) : 0ull;
        if (lane == 62) stamps[62] = rt_entry; if (lane == 63) stamps[63] = (unsigned long long)wall_clock64(); }
#undef PG8_STAMP
#undef PG8_SA
#undef PG8_SB
#undef PG8_STAGE
#undef PG8_LDA
#undef PG8_LDB
#undef PG8_MMA
#undef PG8_WAIT_V
#undef PG8_WAIT_L
#undef PG8_BAR
#undef PG8_SCHED
}
}

struct PgEpiSwiGLU {
  static constexpr bool PERM = true, AFTER_DRAIN = false;
  u16* act;
  __device__ __forceinline__ void operator()(const pg8::f32x4 (&acc)[2][2][4][2], const pg8::Unit& u, int wr, int wc, int fr, int fq) const {
    const int row0 = u.pm * 256 + wr * 64 + fr, j0 = u.pn * 128 + wc * 32 + 8 * fq;
#pragma unroll
    for (int ai = 0; ai < 2; ++ai)
#pragma unroll
      for (int m = 0; m < 4; ++m) {
        unsigned pk[4];
#pragma unroll
        for (int n = 0; n < 2; ++n) {
          float y[4];
#pragma unroll
          for (int e = 0; e < 4; ++e) {
            const float gt = acc[ai][0][m][n][e], up = acc[ai][1][m][n][e];
            y[e] = gt * __builtin_amdgcn_rcpf(1.f + fexp2(-LOG2E * gt)) * up;
          }
          pk[2 * n] = cvt_pk(y[0], y[1]); pk[2 * n + 1] = cvt_pk(y[2], y[3]);
        }
        u32x4 w4; w4.x = pk[0]; w4.y = pk[1]; w4.z = pk[2]; w4.w = pk[3];
        *(u32x4*)(act + (size_t)(row0 + ai * 128 + m * 16) * DFF + j0) = w4;
      }
  }
};
template <class Epi>
DI void pg_gemm(const u16* A, const u16* Bt, int M, int N, int K, const Epi& E, char* lds, int bid, int nblk, const Ctx& p) {
  pg8::Gemm g{A, Bt, M, N, K, K, K};
  pg8::StaticOrder S; S.init(M, N, nblk, bid);
  pg8::gemm_phase<Epi, pg8::StaticOrder, false>((PG8_LAS unsigned char*)lds, g, S, E, nullptr, otid(p));
}

constexpr int LDS_BYTES = 2 * (256 + 256) * 144;

struct PgEpiUQ {
  static constexpr bool PERM = false, AFTER_DRAIN = false;
  u16* q; const float* rq; const float2* rope;
  __device__ __forceinline__ void operator()(const pg8::f32x4 (&acc)[2][2][4][2], const pg8::Unit& u, int wr, int wc, int fr, int fq) const {
    const int row0 = u.pm * 256 + wr * 64 + fr;
#pragma unroll
    for (int ai = 0; ai < 2; ++ai)
#pragma unroll
      for (int m = 0; m < 4; ++m) {
        const int row = row0 + ai * 128 + m * 16;
        const float sc = rq[row] * QSCALE96;
        const int pos = tok_pos(row);
#pragma unroll
        for (int bj = 0; bj < 2; ++bj) {
          const int gb = u.pn * 256 + bj * 128 + wc * 32;
          pg8::f32x4 v0 = acc[ai][bj][m][0] * sc, v1 = acc[ai][bj][m][1] * sc;
          if (((gb >> 5) % 3) == 2) {
            const float4 ca = *(const float4*)(rope + pos * 16 + 4 * fq), cb = *(const float4*)(rope + pos * 16 + 4 * fq + 2);
            const float cs[4] = {ca.x, ca.z, cb.x, cb.z}, sn[4] = {ca.y, ca.w, cb.y, cb.w};
#pragma unroll
            for (int e = 0; e < 4; ++e) { const float x1 = v0[e], x2 = v1[e]; v0[e] = x1 * cs[e] - x2 * sn[e]; v1[e] = x2 * cs[e] + x1 * sn[e]; }
          }
          u16* dst = q + (size_t)row * 1536 + gb + 4 * fq;
          u32x2 w0; w0.x = cvt_pk(v0[0], v0[1]); w0.y = cvt_pk(v0[2], v0[3]);
          u32x2 w1; w1.x = cvt_pk(v1[0], v1[1]); w1.y = cvt_pk(v1[2], v1[3]);
          *(u32x2*)dst = w0;
          *(u32x2*)(dst + 16) = w1;
        }
      }
  }
};
struct PgEpiKnope {
  static constexpr bool PERM = true, AFTER_DRAIN = false;
  u16* knope; const float* rkv; unsigned* kp;
  __device__ __forceinline__ void operator()(const pg8::f32x4 (&acc)[2][2][4][2], const pg8::Unit& u, int wr, int wc, int fr, int fq) const {
    const int row0 = u.pm * 256 + wr * 64 + fr;
    float pm[2] = {0.f, 0.f};
#pragma unroll
    for (int ai = 0; ai < 2; ++ai)
#pragma unroll
      for (int m = 0; m < 4; ++m) {
        const int row = row0 + ai * 128 + m * 16;
        const float sc = rkv[row];
#pragma unroll
        for (int bj = 0; bj < 2; ++bj) {
          const pg8::f32x4 v0 = acc[ai][bj][m][0] * sc, v1 = acc[ai][bj][m][1] * sc;
          u32x4 w4; w4.x = cvt_pk(v0[0], v0[1]); w4.y = cvt_pk(v0[2], v0[3]); w4.z = cvt_pk(v1[0], v1[1]); w4.w = cvt_pk(v1[2], v1[3]);
          *(u32x4*)(knope + (size_t)row * 1024 + u.pn * 256 + bj * 128 + wc * 32 + 8 * fq) = w4;
          float ss = 0.f;
#pragma unroll
          for (int e = 0; e < 4; ++e) ss += v0[e] * v0[e] + v1[e] * v1[e];
          pm[bj] = fmaxf(pm[bj], ss);
        }
      }
#pragma unroll
    for (int bj = 0; bj < 2; ++bj) {
      float v = pm[bj];
      v = fmaxf(v, __int_as_float(__builtin_amdgcn_ds_swizzle(__float_as_int(v), (8 << 10) | 0x1f)));
      v = fmaxf(v, __int_as_float(__builtin_amdgcn_ds_swizzle(__float_as_int(v), (4 << 10) | 0x1f)));
      v = fmaxf(v, __int_as_float(__builtin_amdgcn_ds_swizzle(__float_as_int(v), (2 << 10) | 0x1f)));
      v = fmaxf(v, __int_as_float(__builtin_amdgcn_ds_swizzle(__float_as_int(v), (1 << 10) | 0x1f)));
      if (fr == 0) atomicMax(kp + ((u.pn * 256 + bj * 128 + wc * 32) >> 6) * 8 + ((wc & 1) << 2) + fq, __float_as_uint(sqrtf(v) * 1.01f));
    }
  }
};
struct PgEpiVt {
  static constexpr bool PERM = true, AFTER_DRAIN = false;
  u16* vt; const float* rkv;
  __device__ __forceinline__ void operator()(const pg8::f32x4 (&acc)[2][2][4][2], const pg8::Unit& u, int wr, int wc, int fr, int fq) const {
    const int row0 = u.pm * 256 + wr * 64 + fr;
#pragma unroll
    for (int bj = 0; bj < 2; ++bj) {
      const int c0 = u.pn * 256 + bj * 128 + wc * 32 + 8 * fq;
      const float4 s0 = *(const float4*)(rkv + c0), s1 = *(const float4*)(rkv + c0 + 4);
#pragma unroll
      for (int ai = 0; ai < 2; ++ai)
#pragma unroll
        for (int m = 0; m < 4; ++m) {
          const pg8::f32x4 v0 = acc[ai][bj][m][0], v1 = acc[ai][bj][m][1];
          u32x4 w4; w4.x = cvt_pk(v0[0] * s0.x, v0[1] * s0.y); w4.y = cvt_pk(v0[2] * s0.z, v0[3] * s0.w);
          w4.z = cvt_pk(v1[0] * s1.x, v1[1] * s1.y); w4.w = cvt_pk(v1[2] * s1.z, v1[3] * s1.w);
          *(u32x4*)(vt + (size_t)(row0 + ai * 128 + m * 16) * T_TOK + c0) = w4;
        }
    }
  }
};
template <class Epi>
DI void pg_gemm_ld(const u16* A, int lda, const u16* Bt, int ldb, int M, int N, int K, const Epi& E, char* lds, int bid, int nblk, const Ctx& p) {
  pg8::Gemm g{A, Bt, M, N, K, lda, ldb};
  pg8::StaticOrder S; S.init(M, N, nblk, bid);
  pg8::gemm_phase<Epi, pg8::StaticOrder, false>((PG8_LAS unsigned char*)lds, g, S, E, nullptr, otid(p));
}

DI void grid_barrier(unsigned* ctr, unsigned target, const Ctx& p) {
  __syncthreads();
  if (otid(p) < 64) {
    __builtin_amdgcn_fence(__ATOMIC_RELEASE, "agent");
    if (otid(p) == 0) {
      __hip_atomic_fetch_add(ctr, 1u, __ATOMIC_RELAXED, __HIP_MEMORY_SCOPE_AGENT);
      while (__hip_atomic_load(ctr, __ATOMIC_RELAXED, __HIP_MEMORY_SCOPE_AGENT) < target) __builtin_amdgcn_s_sleep(1);
    }
    __builtin_amdgcn_fence(__ATOMIC_ACQUIRE, "agent");
  }
  __syncthreads();
}
template <int PH>
DI void run_phase(const Ctx& p, char* lds) {
  const int bid = obid(), nblk = gridDim.x;
  u16* wb = (u16*)p.ws;
  u16* R1 = (u16*)(p.ws + OFF_R1);
  u16* R2 = (u16*)(p.ws + OFF_R2);
  u16* R3 = (u16*)(p.ws + OFF_R3);
  if constexpr (PH == 0) phase_prep(p);
  else if constexpr (PH == 1) {
    pg_gemm(R1, wb + W0IN, T_TOK, 2048, 1024, pg8::EpiBf16<0>{R2, 512, nullptr, 512, SEG512}, lds, bid, nblk, p);
    pg_gemm(wb + W0IN + (size_t)2048 * 1024, R1, 1024, T_TOK, 1024, pg8::EpiBf16<0>{R2 + 4 * SEG512, T_TOK, nullptr, 0, 0}, lds, bid, nblk, p);
    grid_barrier((unsigned*)(p.ws + OFF_SCAL) + SC_BAR2, (unsigned)nblk, p);
    phase_qk_norms(p);
  }
  else if constexpr (PH == 2) {
    unsigned* ctr = (unsigned*)(p.ws + OFF_SCAL) + SC_CTR;
    int* nxt_slot = (int*)(lds + LDS_BYTES - 16);
    const int tid0 = otid(p);
    int it = bid;
    while (it < 5120) {
      int nx = 0;
      if (tid0 == 0) nx = (int)atomicAdd(ctr, 1u) + nblk;
      if (it < 2560) attn_diff_item(p, it, lds);
      else attn_na_item(p, it - 2560, lds);
      __syncthreads();
      if (tid0 == 0) *nxt_slot = nx;
      __syncthreads();
      it = *nxt_slot;
    }
  }
  else if constexpr (PH == 3) pg_gemm(R1, wb + W0OUT, T_TOK, 1024, 1024, pg8::EpiBf16<0>{R3, 1024, nullptr, 0, 0}, lds, bid, nblk, p);
  else if constexpr (PH == 4) phase_res<true, false>(p, R3, (const float*)(p.ws + OFF_SCAL) + SC_G0);
  else if constexpr (PH == 5) pg_gemm(R1, wb + W0F1, T_TOK, 5632, 1024, PgEpiSwiGLU{R2}, lds, bid, nblk, p);
  else if constexpr (PH == 6) pg_gemm(R2, wb + W0F2, T_TOK, 1024, 2816, pg8::EpiBf16<0>{R3, 1024, nullptr, 0, 0}, lds, bid, nblk, p);
  else if constexpr (PH == 7) phase_res<false, false>(p, R3, (const float*)(p.ws + OFF_SCAL) + SC_G1);
  else if constexpr (PH == 8) pg_gemm(R1, wb + W1DN, T_TOK, 768, 1024, pg8::EpiBf16<0>{R3, 768, nullptr, 0, 0}, lds, bid, nblk, p);
  else if constexpr (PH == 9) phase_mla_stats(p);
  else if constexpr (PH == 10) {
    pg_gemm_ld(R3, 768, wb + W1UQ, 384, T_TOK, 1536, 384, PgEpiUQ{R2, (const float*)(p.ws + OFF_RQ), (const float2*)(p.ws + OFF_ROPE)}, lds, bid, nblk, p);
    pg_gemm_ld(R3 + 384, 768, wb + W1UKV, 256, T_TOK, 1024, 256,
               PgEpiKnope{R2 + (size_t)T_TOK * 1536, (const float*)(p.ws + OFF_RKV), (unsigned*)(p.ws + OFF_SCAL) + SC_KP}, lds, bid, nblk, p);
    pg_gemm_ld(wb + W1UKV + (size_t)1024 * 256, 256, R3 + 384, 768, 1024, T_TOK, 256,
               PgEpiVt{R2 + (size_t)T_TOK * 2560, (const float*)(p.ws + OFF_RKV)}, lds, bid, nblk, p);
  }
  else if constexpr (PH == 11) { for (int it = bid; it < 2560; it += nblk) {
      int itm = it;
      if (nblk == 256) {
        const int rnd = it >> 8, x = bid & 7, j = bid >> 3;
        itm = rnd < 2 ? (8 * rnd + x) * 32 + j : 512 + (2 * (rnd - 2) + (x >> 2)) * 128 + (4 * (x & 3) + (j >> 3)) * 8 + (j & 7);
      }
      attn_mla_item2(p, itm, lds);
    } }
  else if constexpr (PH == 12) pg_gemm(R1, wb + W1OUT, T_TOK, 1024, 1024, pg8::EpiBf16<0>{R3, 1024, nullptr, 0, 0}, lds, bid, nblk, p);
  else if constexpr (PH == 13) phase_res<false, false>(p, R3, (const float*)(p.ws + OFF_SCAL) + SC_G2);
  else if constexpr (PH == 14) pg_gemm(R1, wb + W1F1, T_TOK, 5632, 1024, PgEpiSwiGLU{R2}, lds, bid, nblk, p);
  else if constexpr (PH == 15) pg_gemm(R2, wb + W1F2, T_TOK, 1024, 2816, pg8::EpiBf16<0>{R3, 1024, nullptr, 0, 0}, lds, bid, nblk, p);
  else if constexpr (PH == 16) phase_res<false, true>(p, R3, (const float*)(p.ws + OFF_SCAL) + SC_G3);
}

#if MULTI_LAUNCH
template <int PH>
__global__ void __launch_bounds__(512, 2) k_phase(Params pa) {
  extern __shared__ __attribute__((aligned(16))) char lds[];
  Ctx p;
#pragma unroll
  for (int i = 0; i < 28; ++i) p.in[i] = pa.in[i];
  p.out = pa.out; p.ws = pa.ws;
  p.wv = __builtin_amdgcn_readfirstlane((int)(threadIdx.x >> 6));
  run_phase<PH>(p, lds);
}
template <int PH>
static void launch_all(const Params& p, int grid, hipStream_t stream) {
  (void)hipFuncSetAttribute((const void*)k_phase<PH>, hipFuncAttributeMaxDynamicSharedMemorySize, LDS_BYTES);
  hipLaunchKernelGGL(k_phase<PH>, dim3(grid), dim3(512), LDS_BYTES, stream, p);
  if constexpr (PH + 1 < NPHASE) launch_all<PH + 1>(p, grid, stream);
}
#define OCC_KERNEL k_phase<2>
#else
#ifndef PROBE_DUP
#define PROBE_DUP -1
#endif
#ifndef PROBE_DUP2
#define PROBE_DUP2 -1
#endif
template <int PH>
DI void run_from(const Ctx& p, char* lds) {
  if constexpr (PH == PROBE_DUP || PH == PROBE_DUP2) { run_phase<PH>(p, lds); cg::this_grid().sync(); }
#ifdef PROBE_ABL
  if constexpr (PH == 11) { for (int it = obid(); it < 5120; it += gridDim.x) attn_mla_item<PROBE_ABL>(p, it, lds); cg::this_grid().sync(); }
#endif
  run_phase<PH>(p, lds);
  if constexpr (PH + 1 < NPHASE) {
    if constexpr (PH == 0) cg::this_grid().sync();
    else grid_barrier((unsigned*)(p.ws + OFF_SCAL) + SC_BAR, (unsigned)PH * gridDim.x, p);
    run_from<PH + 1>(p, lds);
  }
}
__global__ void __launch_bounds__(512, 2) mega(Params pa) {
  extern __shared__ __attribute__((aligned(16))) char lds[];
  Ctx p;
#pragma unroll
  for (int i = 0; i < 28; ++i) p.in[i] = pa.in[i];
  p.out = pa.out; p.ws = pa.ws;
  p.wv = __builtin_amdgcn_readfirstlane((int)(threadIdx.x >> 6));
  run_from<0>(p, lds);
}
#define OCC_KERNEL mega
#endif

extern "C" void kernel_launch(void* const* d_in, const int* in_sizes, int n_in, void* d_out, int out_size, void* d_ws, size_t ws_size,
                              hipStream_t stream) {
  static int grid = 0;
  if (grid == 0) {
    if (n_in != 28 || ws_size < WS_NEED) { fprintf(stderr, "kernel_launch: unexpected n_in %d / ws_size %zu (need %zu)\n", n_in, ws_size, (size_t)WS_NEED); grid = -1; return; }
    int dev = 0, cus = 0, per_cu = 0;
    (void)hipGetDevice(&dev);
    (void)hipDeviceGetAttribute(&cus, hipDeviceAttributeMultiprocessorCount, dev);
    (void)hipFuncSetAttribute((const void*)OCC_KERNEL, hipFuncAttributeMaxDynamicSharedMemorySize, LDS_BYTES);
    (void)hipOccupancyMaxActiveBlocksPerMultiprocessor(&per_cu, (const void*)OCC_KERNEL, 512, LDS_BYTES);
    if (per_cu < 1) per_cu = 1;
    if (per_cu > 1) per_cu = 1;
    grid = cus * per_cu;
  }
  if (grid < 0) return;
  Params p{};
  for (int i = 0; i < 28; ++i) p.in[i] = (const float*)d_in[i];
  p.out = (float*)d_out;
  p.ws = (char*)d_ws;
#if MULTI_LAUNCH
  launch_all<0>(p, grid, stream);
#else
  void* args[] = {&p};
  hipError_t e = hipLaunchCooperativeKernel((const void*)mega, dim3(grid), dim3(512), args, LDS_BYTES, stream);
  if (e != hipSuccess) fprintf(stderr, "cooperative launch failed: %s (grid %d)\n", hipGetErrorString(e), grid);
#endif
}
```

```cpp
#include <hip/hip_runtime.h>
#include <hip/hip_cooperative_groups.h>
#include <stdint.h>
#include <cstdio>
namespace cg = cooperative_groups;

#ifndef MULTI_LAUNCH
#define MULTI_LAUNCH 0
#endif

typedef unsigned short u16;
typedef __attribute__((ext_vector_type(8))) short bf16x8;
typedef __attribute__((ext_vector_type(16))) float f32x16;
typedef __attribute__((ext_vector_type(4))) unsigned u32x4;

#define MFMA32(a, b, c) __builtin_amdgcn_mfma_f32_32x32x16_bf16((a), (b), (c), 0, 0, 0)
#define DI __device__ __forceinline__

constexpr int T_TOK = 81920;
constexpr int T_PROMPT = 65536;
constexpr int DM = 1024;
constexpr int DFF = 2816;
constexpr float EPS = 1e-6f;
constexpr float LOG2E = 1.4426950408889634f;
constexpr float QSCALE64 = 0.125f * LOG2E;
constexpr float QSCALE96 = 0.10206207261596577f * LOG2E;
constexpr int NPHASE = 17;

constexpr size_t MiB = (size_t)1 << 20;
constexpr size_t W0IN = 0;
constexpr size_t W0OUT = W0IN + (size_t)3072 * 1024;
constexpr size_t W0F1 = W0OUT + (size_t)1024 * 1024;
constexpr size_t W0F2 = W0F1 + (size_t)5632 * 1024;
constexpr size_t W1DN = W0F2 + (size_t)1024 * 2816;
constexpr size_t W1UQ = W1DN + (size_t)768 * 1024;
constexpr size_t W1UKV = W1UQ + (size_t)1536 * 384;
constexpr size_t W1OUT = W1UKV + (size_t)2048 * 256;
constexpr size_t W1F1 = W1OUT + (size_t)1024 * 1024;
constexpr size_t W1F2 = W1F1 + (size_t)5632 * 1024;
constexpr size_t W_END = W1F2 + (size_t)1024 * 2816;
static_assert(W_END * 2 <= 48 * MiB, "weights region");
constexpr size_t OFF_ROPE = 48 * MiB;
constexpr size_t OFF_RQ = OFF_ROPE + 2 * MiB;
constexpr size_t OFF_RKV = OFF_RQ + MiB / 2;
constexpr size_t OFF_KROPE = OFF_RKV + MiB / 2;
constexpr size_t OFF_SCAL = OFF_KROPE + 5 * MiB;
constexpr int SC_KP = 64;
constexpr int SC_QKMAX = 16, SC_CTR = 32, SC_BAR = 33, SC_BAR2 = 34, SC_KMAX1 = 40, SC_KRMAX = 56;
constexpr int SC_G0 = 1024, SC_G1 = 2048, SC_G2 = 3072, SC_G3 = 4096, SC_GSUB = 5120, SC_RPB = 6144;
constexpr size_t OFF_R1 = 58 * MiB;
constexpr size_t OFF_R3 = OFF_R1 + 160 * MiB;
constexpr size_t OFF_R2 = OFF_R3 + 160 * MiB;
constexpr size_t WS_NEED = OFF_R2 + 560 * MiB;
constexpr size_t SEG512 = (size_t)T_TOK * 512;

struct Params {
  const float* in[28];
  float* out;
  char* ws;
};
struct Ctx {
  const float* in[28];
  float* out;
  char* ws;
  int wv;
};

DI u16 f2bf(float x) { unsigned u = __float_as_uint(x); u += 0x7fffu + ((u >> 16) & 1u); return (u16)(u >> 16); }
DI unsigned pack2(float a, float b) { return (unsigned)f2bf(a) | ((unsigned)f2bf(b) << 16); }
DI float bflo(unsigned v) { return __uint_as_float(v << 16); }
DI float bfhi(unsigned v) { return __uint_as_float(v & 0xffff0000u); }
DI float wave_sum(float v) {
#pragma unroll
  for (int o = 32; o; o >>= 1) v += __shfl_xor(v, o);
  return v;
}
DI int tok_pos(int t) { return t < T_PROMPT ? (t & 4095) : (t - T_PROMPT); }
DI float fexp2(float x) { return __builtin_amdgcn_exp2f(x); }
typedef __attribute__((ext_vector_type(2))) float f32x2;
typedef __attribute__((ext_vector_type(2))) __bf16 bf16x2_t;
typedef __attribute__((ext_vector_type(2))) unsigned u32x2;
typedef __attribute__((ext_vector_type(4))) unsigned u32x4_;
DI unsigned cvt_pk(float a, float b) {
  f32x2 v; v.x = a; v.y = b;
  return __builtin_bit_cast(unsigned, __builtin_convertvector(v, bf16x2_t));
}
DI int otid(const Ctx& p) {
  int wv = p.wv; asm volatile("" : "+s"(wv));
  int t = wv * 64 + (int)__builtin_amdgcn_mbcnt_hi(~0u, __builtin_amdgcn_mbcnt_lo(~0u, 0u));
  asm volatile("" : "+v"(t));
  return t;
}
DI int obid() { int b = blockIdx.x; asm volatile("" : "+s"(b)); return b; }

__device__ const float ROPE_INV[16] = {1.0f, 0.5623413324356079f, 0.3162277638912201f, 0.17782793939113617f, 0.10000000149011612f, 0.05623413249850273f, 0.03162277489900589f, 0.017782794311642647f, 0.009999999776482582f, 0.005623413249850273f, 0.003162277629598975f, 0.0017782794311642647f, 0.0010000000474974513f, 0.000562341301701963f, 0.0003162277571391314f, 0.00017782794020604342f};

DI void wconv(const float* __restrict__ W, const float* __restrict__ g, u16* __restrict__ dst, int K, int N, int rowsOut, int perm, int gtid, int gthreads) {
  const int kc = K >> 3;
  const long total = (long)rowsOut * kc;
  for (long c = gtid; c < total; c += gthreads) {
    const int n = (int)(c % rowsOut);
    const int k0 = (int)(c / rowsOut) * 8;
    int sc;
    if (perm == 1) { const int blk = n >> 8, w = n & 255; const int j = blk * 128 + (w & 127); sc = (w < 128) ? j : DFF + j; }
    else if (perm == 3) { sc = n < 1024 ? n : (n < 2048 ? n + 512 : (n < 2560 ? n - 1024 : n)); }
    else if (perm == 2) { const int hd = (n & 1023) >> 6, d = n & 63; sc = hd * 128 + (n >= 1024 ? 64 : 0) + d; }
    else sc = n;
    uint4 o = make_uint4(0, 0, 0, 0);
    if (sc < N) {
      float v[8];
      const float rsc = (perm == 3 && (n < 512 || (n >= 1024 && n < 1536))) ? QSCALE64 : 1.f;
#pragma unroll
      for (int i = 0; i < 8; ++i) { float x = W[(size_t)(k0 + i) * N + sc]; if (g) x *= g[k0 + i]; v[i] = x * rsc; }
      o.x = pack2(v[0], v[1]); o.y = pack2(v[2], v[3]); o.z = pack2(v[4], v[5]); o.w = pack2(v[6], v[7]);
    }
    *(uint4*)(dst + (size_t)n * K + k0) = o;
  }
}

DI void phase_prep(const Ctx& p) {
  const int gtid = obid() * 512 + otid(p), gthreads = gridDim.x * 512;
  u16* wb = (u16*)p.ws;
  wconv(p.in[3], p.in[2], wb + W0IN, 1024, 3072, 3072, 3, gtid, gthreads);
  wconv(p.in[10], nullptr, wb + W0OUT, 1024, 1024, 1024, 0, gtid, gthreads);
  wconv(p.in[13], p.in[12], wb + W0F1, 1024, 5632, 5632, 1, gtid, gthreads);
  wconv(p.in[14], nullptr, wb + W0F2, 2816, 1024, 1024, 0, gtid, gthreads);
  wconv(p.in[17], p.in[16], wb + W1DN, 1024, 672, 768, 0, gtid, gthreads);
  wconv(p.in[20], p.in[18], wb + W1UQ, 384, 1536, 1536, 0, gtid, gthreads);
  wconv(p.in[21], p.in[19], wb + W1UKV, 256, 2048, 2048, 2, gtid, gthreads);
  wconv(p.in[22], nullptr, wb + W1OUT, 1024, 1024, 1024, 0, gtid, gthreads);
  wconv(p.in[25], p.in[24], wb + W1F1, 1024, 5632, 5632, 1, gtid, gthreads);
  wconv(p.in[26], nullptr, wb + W1F2, 2816, 1024, 1024, 0, gtid, gthreads);
  float2* rope = (float2*)(p.ws + OFF_ROPE);
  for (int idx = gtid; idx < 16384 * 16; idx += gthreads) {
    const int pos = idx >> 4, i = idx & 15;
    const float ang = (float)pos * ROPE_INV[i];
    double rev = (double)ang * 0.15915494309189535;
    rev -= rint(rev);
    const float rf = (float)rev;
    rope[idx] = make_float2(__builtin_amdgcn_cosf(rf), __builtin_amdgcn_sinf(rf));
  }
  if (gtid == 0) {
    float s1 = 0.f, s2 = 0.f;
    for (int i = 0; i < 64; ++i) { s1 += p.in[5][i] * p.in[6][i]; s2 += p.in[7][i] * p.in[8][i]; }
    float* sc = (float*)(p.ws + OFF_SCAL);
    sc[0] = __expf(s1) - __expf(s2) + 0.2f;
    for (int i = 0; i < 176; ++i) ((unsigned*)sc)[SC_QKMAX + i] = 0u;
  }
  {
    float* sc = (float*)(p.ws + OFF_SCAL);
    for (int i = gtid; i < 1024; i += gthreads) { sc[SC_G0 + i] = p.in[11][i]; sc[SC_G1 + i] = p.in[15][i]; sc[SC_G2 + i] = p.in[23][i]; sc[SC_G3 + i] = p.in[27][i]; }
    for (int i = gtid; i < 128; i += gthreads) sc[SC_GSUB + i] = p.in[9][i];
    for (int i = gtid; i < 8 * 465; i += gthreads) sc[SC_RPB + i] = p.in[4][i] * LOG2E;
  }
  const int tid_ = otid(p);
  const int lane = tid_ & 63;
  const int gw = obid() * 8 + (tid_ >> 6), nw = gridDim.x * 8;
  u16* hb = (u16*)(p.ws + OFF_R1);
  for (int row = gw; row < T_TOK; row += nw) {
    const float* xr = row < T_PROMPT ? p.in[0] + (size_t)row * DM : p.in[1] + (size_t)(row - T_PROMPT) * DM;
    float4 v[4];
    float ss = 0.f;
#pragma unroll
    for (int j = 0; j < 4; ++j) { v[j] = ((const float4*)xr)[lane + 64 * j]; ss += v[j].x * v[j].x + v[j].y * v[j].y + v[j].z * v[j].z + v[j].w * v[j].w; }
    ss = wave_sum(ss);
    const float r = rsqrtf(ss * (1.f / DM) + EPS);
#pragma unroll
    for (int j = 0; j < 4; ++j) {
      uint2 o; o.x = pack2(v[j].x * r, v[j].y * r); o.y = pack2(v[j].z * r, v[j].w * r);
      ((uint2*)(hb + (size_t)row * DM))[lane + 64 * j] = o;
    }
  }
}

template <bool FIRST, bool LAST>
DI void phase_res(const Ctx& p, const u16* __restrict__ mbuf, const float* __restrict__ g) {
  const int tid_ = otid(p);
  const int lane = tid_ & 63;
  const int gw = obid() * 8 + (tid_ >> 6), nw = gridDim.x * 8;
  u16* hb = (u16*)(p.ws + OFF_R1);
  float4 gv[4];
#pragma unroll
  for (int j = 0; j < 4; ++j) gv[j] = ((const float4*)g)[lane + 64 * j];
  for (int row0 = gw; row0 < T_TOK; row0 += 2 * nw) {
    float4 xv[2][4], mv[2][4];
    float ss[2] = {0.f, 0.f};
    bool act[2];
#pragma unroll
    for (int t = 0; t < 2; ++t) {
      const int row = row0 + t * nw;
      act[t] = row < T_TOK;
      const int rr = act[t] ? row : row0;
      const float* xr;
      if (FIRST) xr = rr < T_PROMPT ? p.in[0] + (size_t)rr * DM : p.in[1] + (size_t)(rr - T_PROMPT) * DM;
      else xr = p.out + (size_t)rr * DM;
#pragma unroll
      for (int j = 0; j < 4; ++j) {
        const uint2 u = ((const uint2*)(mbuf + (size_t)rr * DM))[lane + 64 * j];
        mv[t][j] = make_float4(bflo(u.x), bfhi(u.x), bflo(u.y), bfhi(u.y));
        xv[t][j] = ((const float4*)xr)[lane + 64 * j];
      }
    }
#pragma unroll
    for (int t = 0; t < 2; ++t) {
#pragma unroll
      for (int j = 0; j < 4; ++j) ss[t] += mv[t][j].x * mv[t][j].x + mv[t][j].y * mv[t][j].y + mv[t][j].z * mv[t][j].z + mv[t][j].w * mv[t][j].w;
      ss[t] = wave_sum(ss[t]);
    }
#pragma unroll
    for (int t = 0; t < 2; ++t) {
      if (!act[t]) continue;
      const int row = row0 + t * nw;
      const float rm = rsqrtf(ss[t] * (1.f / DM) + EPS);
      float s2 = 0.f;
#pragma unroll
      for (int j = 0; j < 4; ++j) {
        xv[t][j].x += mv[t][j].x * rm * gv[j].x; xv[t][j].y += mv[t][j].y * rm * gv[j].y;
        xv[t][j].z += mv[t][j].z * rm * gv[j].z; xv[t][j].w += mv[t][j].w * rm * gv[j].w;
        s2 += xv[t][j].x * xv[t][j].x + xv[t][j].y * xv[t][j].y + xv[t][j].z * xv[t][j].z + xv[t][j].w * xv[t][j].w;
        ((float4*)(p.out + (size_t)row * DM))[lane + 64 * j] = xv[t][j];
      }
      if (!LAST) {
        s2 = wave_sum(s2);
        const float r2 = rsqrtf(s2 * (1.f / DM) + EPS);
#pragma unroll
        for (int j = 0; j < 4; ++j) {
          uint2 o; o.x = pack2(xv[t][j].x * r2, xv[t][j].y * r2); o.y = pack2(xv[t][j].z * r2, xv[t][j].w * r2);
          ((uint2*)(hb + (size_t)row * DM))[lane + 64 * j] = o;
        }
      }
    }
  }
}

DI void phase_mla_stats(const Ctx& p) {
  const int tid_ = otid(p);
  const int lane = tid_ & 63;
  const int gw = obid() * 8 + (tid_ >> 6), nw = gridDim.x * 8;
  const u16* c = (const u16*)(p.ws + OFF_R3);
  float* rq = (float*)(p.ws + OFF_RQ);
  float* rkv = (float*)(p.ws + OFF_RKV);
  u16* krope = (u16*)(p.ws + OFF_KROPE);
  const float2* rope = (const float2*)(p.ws + OFF_ROPE);
  float krmax2 = 0.f;
  for (int row = gw; row < T_TOK; row += nw) {
    const u16* cr = c + (size_t)row * 768;
    const uint4 u0 = ((const uint4*)cr)[lane];
    float s0 = 0.f;
    { float a;
      a = bflo(u0.x); s0 += a * a; a = bfhi(u0.x); s0 += a * a; a = bflo(u0.y); s0 += a * a; a = bfhi(u0.y); s0 += a * a;
      a = bflo(u0.z); s0 += a * a; a = bfhi(u0.z); s0 += a * a; a = bflo(u0.w); s0 += a * a; a = bfhi(u0.w); s0 += a * a; }
    float s1 = 0.f;
    if (lane < 16) {
      const uint4 u1 = ((const uint4*)cr)[64 + lane];
      float a;
      a = bflo(u1.x); s1 += a * a; a = bfhi(u1.x); s1 += a * a; a = bflo(u1.y); s1 += a * a; a = bfhi(u1.y); s1 += a * a;
      a = bflo(u1.z); s1 += a * a; a = bfhi(u1.z); s1 += a * a; a = bflo(u1.w); s1 += a * a; a = bfhi(u1.w); s1 += a * a;
    }
    const float sq = wave_sum(lane < 48 ? s0 : 0.f);
    const float skv = wave_sum((lane >= 48 ? s0 : 0.f) + s1);
    if (lane == 0) {
      rq[row] = rsqrtf(sq * (1.f / 384.f) + EPS);
      rkv[row] = rsqrtf(skv * (1.f / 256.f) + EPS);
    }
    float kr2 = 0.f;
    if (lane < 16) {
      const float x1 = __uint_as_float((unsigned)cr[640 + lane] << 16);
      const float x2 = __uint_as_float((unsigned)cr[656 + lane] << 16);
      const float2 cs = rope[tok_pos(row) * 16 + lane];
      const float o1 = x1 * cs.x - x2 * cs.y, o2 = x2 * cs.x + x1 * cs.y;
      krope[(size_t)row * 32 + lane] = f2bf(o1);
      krope[(size_t)row * 32 + 16 + lane] = f2bf(o2);
      kr2 = o1 * o1 + o2 * o2;
    }
    krmax2 = fmaxf(krmax2, wave_sum(kr2));
  }
  if (lane == 0) atomicMax((unsigned*)(p.ws + OFF_SCAL) + SC_KRMAX, __float_as_uint(sqrtf(krmax2)));
}

DI void store_tok(u16* out, int ldo, int m, int nbase, const f32x16& v, float sc) {
  u16* q = out + (size_t)m * ldo + nbase;
#pragma unroll
  for (int g = 0; g < 4; ++g) {
    uint2 u; u.x = pack2(v[4 * g] * sc, v[4 * g + 1] * sc); u.y = pack2(v[4 * g + 2] * sc, v[4 * g + 3] * sc);
    *(uint2*)(q + 8 * g) = u;
  }
}
DI void store_tr(u16* outT, size_t ldt, int n, int mbase, const f32x16& v, const float* __restrict__ rs) {
  u16* q = outT + (size_t)n * ldt + mbase;
#pragma unroll
  for (int g = 0; g < 4; ++g) {
    float4 s = make_float4(1.f, 1.f, 1.f, 1.f);
    if (rs) s = *(const float4*)(rs + mbase + 8 * g);
    uint2 u; u.x = pack2(v[4 * g] * s.x, v[4 * g + 1] * s.y); u.y = pack2(v[4 * g + 2] * s.z, v[4 * g + 3] * s.w);
    *(uint2*)(q + 8 * g) = u;
  }
}

DI void store_tok_u(u16* ub, unsigned loff, const f32x16& v, float sc) {
  char* q = (char*)ub;
  const unsigned hoff = (loff & 8u) << 1;
  const unsigned lbase = loff & ~8u;
#pragma unroll
  for (int pi = 0; pi < 2; ++pi) {
    const int g0 = 2 * pi, g1 = 2 * pi + 1;
    const unsigned a0 = cvt_pk(v[4 * g0] * sc, v[4 * g0 + 1] * sc), a1 = cvt_pk(v[4 * g0 + 2] * sc, v[4 * g0 + 3] * sc);
    const unsigned b0 = cvt_pk(v[4 * g1] * sc, v[4 * g1 + 1] * sc), b1 = cvt_pk(v[4 * g1 + 2] * sc, v[4 * g1 + 3] * sc);
    const u32x2 s0 = __builtin_amdgcn_permlane32_swap(a0, b0, false, false);
    const u32x2 s1 = __builtin_amdgcn_permlane32_swap(a1, b1, false, false);
    u32x4 u; u.x = s0.x; u.y = s1.x; u.z = s0.y; u.w = s1.y;
    *(u32x4*)(q + lbase + hoff + 32 * pi) = u;
  }
}
DI void store_tr_u(u16* ub, unsigned loff, const f32x16& v, const float* __restrict__ rs) {
  char* q = (char*)ub;
  const unsigned hoff = (loff & 8u) << 1;
  const unsigned lbase = loff & ~8u;
#pragma unroll
  for (int pi = 0; pi < 2; ++pi) {
    const int g0 = 2 * pi, g1 = 2 * pi + 1;
    float4 sa = make_float4(1.f, 1.f, 1.f, 1.f), sb = sa;
    if (rs) { sa = *(const float4*)(rs + 8 * g0); sb = *(const float4*)(rs + 8 * g1); }
    const unsigned a0 = cvt_pk(v[4 * g0] * sa.x, v[4 * g0 + 1] * sa.y), a1 = cvt_pk(v[4 * g0 + 2] * sa.z, v[4 * g0 + 3] * sa.w);
    const unsigned b0 = cvt_pk(v[4 * g1] * sb.x, v[4 * g1 + 1] * sb.y), b1 = cvt_pk(v[4 * g1 + 2] * sb.z, v[4 * g1 + 3] * sb.w);
    const u32x2 s0 = __builtin_amdgcn_permlane32_swap(a0, b0, false, false);
    const u32x2 s1 = __builtin_amdgcn_permlane32_swap(a1, b1, false, false);
    u32x4 u; u.x = s0.x; u.y = s1.x; u.z = s0.y; u.w = s1.y;
    *(u32x4*)(q + lbase + hoff + 32 * pi) = u;
  }
}

struct EpiTok {
  u16* out; int ldo;
  static constexpr int SWAPMODE = 1;
  DI bool swap(int) const { return true; }
  template <int WMB, int WNB>
  DI void store(int m0w, int n0w, f32x16 (&acc)[WMB][WNB], int r, int h, bool) const {
#pragma unroll
    for (int mb = 0; mb < WMB; ++mb)
#pragma unroll
      for (int nb = 0; nb < WNB; ++nb) store_tok_u(out + (size_t)(m0w + mb * 32) * ldo + n0w + nb * 32, (unsigned)((r * ldo + 4 * h) * 2), acc[mb][nb], 1.f);
  }
};

struct EpiProj0 {
  u16* base; unsigned* qkmax;
  static constexpr int SWAPMODE = 2;
  DI bool swap(int n0) const { const int reg = n0 >> 9; return !(reg == 2 || reg == 5); }
  template <int WMB, int WNB>
  DI void store(int m0w, int n0w, f32x16 (&acc)[WMB][WNB], int r, int h, bool) const {
    const int reg = n0w >> 9, nl = n0w & 511;
    u16* buf = base + (size_t)reg * SEG512;
    const float sc = (reg == 0 || reg == 3) ? QSCALE64 : 1.f;
#pragma unroll
    for (int mb = 0; mb < WMB; ++mb)
#pragma unroll
      for (int nb = 0; nb < WNB; ++nb) store_tok_u(buf + (size_t)(m0w + mb * 32) * 512 + nl + nb * 32, (unsigned)((r * 512 + 4 * h) * 2), acc[mb][nb], sc);
    __builtin_amdgcn_sched_barrier(0);
    if (reg == 3 || reg == 4) {
      static_assert(WNB == 2, "one head per wave tile");
      float mxn = 0.f;
#pragma unroll
      for (int mb = 0; mb < WMB; ++mb) {
        float ss = 0.f;
#pragma unroll
        for (int nb = 0; nb < WNB; ++nb)
#pragma unroll
          for (int i = 0; i < 16; ++i) { const float v = acc[mb][nb][i]; ss += v * v; }
        { const u32x2 sw = __builtin_amdgcn_permlane32_swap(__float_as_uint(ss), __float_as_uint(ss), false, false); ss = __uint_as_float(sw.x) + __uint_as_float(sw.y); }
        mxn = fmaxf(mxn, ss);
      }
      mxn = fmaxf(mxn, __int_as_float(__builtin_amdgcn_ds_swizzle(__float_as_int(mxn), (16 << 10) | 0x1f)));
      mxn = fmaxf(mxn, __int_as_float(__builtin_amdgcn_ds_swizzle(__float_as_int(mxn), (8 << 10) | 0x1f)));
      mxn = fmaxf(mxn, __int_as_float(__builtin_amdgcn_ds_swizzle(__float_as_int(mxn), (4 << 10) | 0x1f)));
      mxn = fmaxf(mxn, __int_as_float(__builtin_amdgcn_ds_swizzle(__float_as_int(mxn), (2 << 10) | 0x1f)));
      mxn = fmaxf(mxn, __int_as_float(__builtin_amdgcn_ds_swizzle(__float_as_int(mxn), (1 << 10) | 0x1f)));
      if (r == 0 && h == 0) atomicMax(qkmax + (reg - 3) * 8 + (nl >> 6), __float_as_uint(sqrtf(mxn) * sc));
    }
  }
  template <int WMB, int WNB>
  DI void store_t(int n0w, int m0w, f32x16 (&acc)[WMB][WNB], int r, int h) const {
    const int reg = n0w >> 9, nl = n0w & 511;
    u16* buf = base + (size_t)reg * SEG512;
#pragma unroll
    for (int mb = 0; mb < WMB; ++mb)
#pragma unroll
      for (int nb = 0; nb < WNB; ++nb) store_tr_u(buf + (size_t)(nl + mb * 32) * T_TOK + m0w + nb * 32, (unsigned)((r * T_TOK + 4 * h) * 2), acc[mb][nb], nullptr);
  }
};

struct EpiSwiGLU {
  u16* act;
  static constexpr int SWAPMODE = 1;
  DI bool swap(int) const { return true; }
  template <int WMB, int WNB>
  DI void store(int m0w, int n0w, f32x16 (&acc)[WMB][WNB], int r, int h, bool) const {
    static_assert(WNB == 2, "swiglu epilogue needs a 64-wide wave tile");
#pragma unroll
    for (int mb = 0; mb < WMB; ++mb) {
      char* q = (char*)(act + (size_t)(m0w + mb * 32) * DFF + (n0w >> 1)) + (unsigned)((r * DFF) * 2) + 16 * h;
#pragma unroll
      for (int pi = 0; pi < 2; ++pi) {
        unsigned pk[2][2];
#pragma unroll
        for (int gg = 0; gg < 2; ++gg) {
          const int g = 2 * pi + gg;
          float y[4];
#pragma unroll
          for (int e = 0; e < 4; ++e) {
            const float gt = acc[mb][0][4 * g + e], up = acc[mb][1][4 * g + e];
            y[e] = gt * __builtin_amdgcn_rcpf(1.f + fexp2(-LOG2E * gt)) * up;
          }
          pk[gg][0] = cvt_pk(y[0], y[1]); pk[gg][1] = cvt_pk(y[2], y[3]);
        }
        const u32x2 s0 = __builtin_amdgcn_permlane32_swap(pk[0][0], pk[1][0], false, false);
        const u32x2 s1 = __builtin_amdgcn_permlane32_swap(pk[0][1], pk[1][1], false, false);
        u32x4 u; u.x = s0.x; u.y = s1.x; u.z = s0.y; u.w = s1.y;
        *(u32x4*)(q + 32 * pi) = u;
      }
      __builtin_amdgcn_sched_barrier(0);
    }
  }
};

struct EpiUQ {
  u16* q; const float* rq; const float2* rope;
  static constexpr int SWAPMODE = 1;
  DI bool swap(int) const { return true; }
  template <int WMB, int WNB>
  DI void store(int m0w, int n0w, f32x16 (&acc)[WMB][WNB], int r, int h, bool) const {
#pragma unroll
    for (int mb = 0; mb < WMB; ++mb) {
      const int m = m0w + mb * 32 + r;
      const float sc = rq[m] * QSCALE96;
      const int pos = tok_pos(m);
#pragma unroll
      for (int nb = 0; nb < WNB; ++nb) {
        const int n0b = n0w + nb * 32;
        f32x16 v = acc[mb][nb];
#pragma unroll
        for (int i = 0; i < 16; ++i) v[i] *= sc;
        if (((n0b >> 5) % 3) == 2) {
#pragma unroll
          for (int i = 0; i < 8; ++i) {
            const int f = (i & 3) + 8 * (i >> 2) + 4 * h;
            const float2 cs = rope[pos * 16 + f];
            const float x1 = v[i], x2 = v[i + 8];
            v[i] = x1 * cs.x - x2 * cs.y;
            v[i + 8] = x2 * cs.x + x1 * cs.y;
          }
        }
        store_tok_u(q + (size_t)(m0w + mb * 32) * 1536 + n0b, (unsigned)((r * 1536 + 4 * h) * 2), v, 1.f);
        __builtin_amdgcn_sched_barrier(0);
      }
    }
  }
};

struct EpiUKV {
  u16* knope; u16* vt; const float* rkv; unsigned* kmax;
  static constexpr int SWAPMODE = 2;
  DI bool swap(int n0) const { return n0 < 1024; }
  template <int WMB, int WNB>
  DI void store(int m0w, int n0w, f32x16 (&acc)[WMB][WNB], int r, int h, bool) const {
#pragma unroll
    for (int mb = 0; mb < WMB; ++mb) {
      const int m = m0w + mb * 32 + r;
      const float sc = rkv[m];
#pragma unroll
      for (int nb = 0; nb < WNB; ++nb) store_tok_u(knope + (size_t)(m0w + mb * 32) * 1024 + n0w + nb * 32, (unsigned)((r * 1024 + 4 * h) * 2), acc[mb][nb], sc);
    }
    __builtin_amdgcn_sched_barrier(0);
    static_assert(WNB == 2, "one head per wave tile");
    float mxn = 0.f;
#pragma unroll
    for (int mb = 0; mb < WMB; ++mb) {
      float ss = 0.f;
#pragma unroll
      for (int nb = 0; nb < WNB; ++nb)
#pragma unroll
        for (int i = 0; i < 16; ++i) { const float v = acc[mb][nb][i]; ss += v * v; }
      { const u32x2 sw = __builtin_amdgcn_permlane32_swap(__float_as_uint(ss), __float_as_uint(ss), false, false); ss = __uint_as_float(sw.x) + __uint_as_float(sw.y); }
      const float sc = rkv[m0w + mb * 32 + r];
      mxn = fmaxf(mxn, ss * sc * sc);
    }
    mxn = fmaxf(mxn, __int_as_float(__builtin_amdgcn_ds_swizzle(__float_as_int(mxn), (16 << 10) | 0x1f)));
    mxn = fmaxf(mxn, __int_as_float(__builtin_amdgcn_ds_swizzle(__float_as_int(mxn), (8 << 10) | 0x1f)));
    mxn = fmaxf(mxn, __int_as_float(__builtin_amdgcn_ds_swizzle(__float_as_int(mxn), (4 << 10) | 0x1f)));
    mxn = fmaxf(mxn, __int_as_float(__builtin_amdgcn_ds_swizzle(__float_as_int(mxn), (2 << 10) | 0x1f)));
    mxn = fmaxf(mxn, __int_as_float(__builtin_amdgcn_ds_swizzle(__float_as_int(mxn), (1 << 10) | 0x1f)));
    if (r == 0 && h == 0) atomicMax(kmax + (n0w >> 6), __float_as_uint(sqrtf(mxn)));
  }
  template <int WMB, int WNB>
  DI void store_t(int n0w, int m0w, f32x16 (&acc)[WMB][WNB], int r, int h) const {
#pragma unroll
    for (int mb = 0; mb < WMB; ++mb)
#pragma unroll
      for (int nb = 0; nb < WNB; ++nb) store_tr_u(vt + (size_t)(n0w - 1024 + mb * 32) * T_TOK + m0w + nb * 32, (unsigned)((r * T_TOK + 4 * h) * 2), acc[mb][nb], rkv + m0w + nb * 32 + 4 * h);
  }
};

template <bool SWAP, int WMB, int WNB>
DI void gemm_compute(const char* la, const char* lb, f32x16 (&acc)[WMB][WNB], int wm, int wn, int r, int h) {
#pragma unroll
  for (int ks = 0; ks < 4; ++ks) {
    bf16x8 af[WMB], bfr[WNB];
#pragma unroll
    for (int mb = 0; mb < WMB; ++mb) af[mb] = *(const bf16x8*)(la + (wm * 32 * WMB + mb * 32 + r) * 144 + (ks * 2 + h) * 16);
#pragma unroll
    for (int nb = 0; nb < WNB; ++nb) bfr[nb] = *(const bf16x8*)(lb + (wn * 32 * WNB + nb * 32 + r) * 144 + (ks * 2 + h) * 16);
#pragma unroll
    for (int mb = 0; mb < WMB; ++mb)
#pragma unroll
      for (int nb = 0; nb < WNB; ++nb) {
        if (SWAP) acc[mb][nb] = MFMA32(bfr[nb], af[mb], acc[mb][nb]);
        else acc[mb][nb] = MFMA32(af[mb], bfr[nb], acc[mb][nb]);
      }
  }
}

struct TileDesc { bool valid; bool normal; int m0, n0, ldp, ldq; unsigned po, qo; const char* P; const char* Q; };

template <class Epi>
DI void gemm_phase(const u16* __restrict__ A, int lda, const u16* __restrict__ Bt, int ldb, int M, int N, int K, const Epi epi, char* lds, int bid, int nblk, const Ctx& p) {
  constexpr int WMB = 4, WNB = 2;
  constexpr int TM = 256, TN = 256;
  constexpr int STAGE = (TM + TN) * 144;
  const int tid = otid(p), lane = tid & 63, w = __builtin_amdgcn_readfirstlane(tid >> 6), wm = w >> 2, wn = w & 3, r = lane & 31, h = lane >> 5;
  const int lrow = tid >> 3, lch = tid & 7;
  const int NT = N / TN, MT = M / TM, tiles = MT * NT, nk = K >> 6;
  const int rounds = (tiles + nblk - 1) / nblk;
  auto desc = [&](int rnd) {
    TileDesc d;
    int tile = rnd * nblk + bid;
    if (nblk == 256) tile = rnd * 256 + (bid & 7) * 32 + (bid >> 3);
    d.valid = rnd < rounds && tile < tiles;
    const int grp = tile / (8 * NT), within = tile - grp * (8 * NT);
    const int nt = within >> 3, mt = grp * 8 + (within & 7);
    d.m0 = mt * TM; d.n0 = nt * TN;
    d.normal = true;
    if constexpr (Epi::SWAPMODE == 2) d.normal = epi.swap(d.n0);
    const char* Ab = (const char*)A + (size_t)d.m0 * lda * 2;
    const char* Bb = (const char*)Bt + (size_t)d.n0 * ldb * 2;
    const unsigned aoff = (unsigned)(lrow * lda * 2 + lch * 16), boff = (unsigned)(lrow * ldb * 2 + lch * 16);
    d.P = d.normal ? Ab : Bb; d.Q = d.normal ? Bb : Ab;
    d.po = d.normal ? aoff : boff; d.qo = d.normal ? boff : aoff;
    d.ldp = d.normal ? lda : ldb; d.ldq = d.normal ? ldb : lda;
    return d;
  };
  u32x4 pa[4], pb[4];
  auto issue = [&](const TileDesc& d, int kt) {
    const char* Pk = d.P + (size_t)kt * 128; asm volatile("" : "+s"(Pk));
    const char* Qk = d.Q + (size_t)kt * 128; asm volatile("" : "+s"(Qk));
#pragma unroll
    for (int j = 0; j < 4; ++j) pa[j] = *(const u32x4*)(Pk + (size_t)j * 128 * d.ldp + d.po);
#pragma unroll
    for (int j = 0; j < 4; ++j) pb[j] = *(const u32x4*)(Qk + (size_t)j * 128 * d.ldq + d.qo);
  };
  auto write_stage = [&](int b) {
    char* wa = lds + b * STAGE;
    char* wb = wa + TM * 144;
#pragma unroll
    for (int j = 0; j < 4; ++j) *(u32x4*)(wa + (lrow + 64 * j) * 144 + lch * 16) = pa[j];
#pragma unroll
    for (int j = 0; j < 4; ++j) *(u32x4*)(wb + (lrow + 64 * j) * 144 + lch * 16) = pb[j];
  };
  TileDesc cur = desc(0);
  if (!cur.valid) return;
  issue(cur, 0);
  for (int rnd = 0;; ++rnd) {
    f32x16 acc[WMB][WNB];
#pragma unroll
    for (int mb = 0; mb < WMB; ++mb)
#pragma unroll
      for (int nb = 0; nb < WNB; ++nb)
#pragma unroll
        for (int i = 0; i < 16; ++i) acc[mb][nb][i] = 0.f;
    write_stage(0);
    if (nk > 1) issue(cur, 1);
    __syncthreads();
    if (w < 4) {
      for (int kt = 0; kt < nk; ++kt) {
        const char* la = lds + (kt & 1) * STAGE;
        if (kt + 1 < nk) write_stage((kt + 1) & 1);
        if (kt + 2 < nk) issue(cur, kt + 2);
        gemm_compute<true, WMB, WNB>(la, la + TM * 144, acc, wm, wn, r, h);
        __syncthreads();
      }
    } else {
      for (int kt = 0; kt < nk; ++kt) {
        const char* la = lds + (kt & 1) * STAGE;
        gemm_compute<true, WMB, WNB>(la, la + TM * 144, acc, wm, wn, r, h);
        if (kt + 1 < nk) write_stage((kt + 1) & 1);
        if (kt + 2 < nk) issue(cur, kt + 2);
        __syncthreads();
      }
    }
    const TileDesc nxt = desc(rnd + 1);
    if (nxt.valid) issue(nxt, 0);
    __builtin_amdgcn_sched_barrier(0);
    int m0 = cur.m0, n0 = cur.n0;
    asm volatile("" : "+s"(m0), "+s"(n0));
    int r2 = r, h2 = h, wm2 = wm, wn2 = wn;
    asm volatile("" : "+v"(r2), "+v"(h2));
    asm volatile("" : "+s"(wm2), "+s"(wn2));
    if constexpr (Epi::SWAPMODE == 2) {
      if (cur.normal) epi.template store<WMB, WNB>(m0 + wm2 * 32 * WMB, n0 + wn2 * 32 * WNB, acc, r2, h2, true);
      else epi.template store_t<WMB, WNB>(n0 + wm2 * 32 * WMB, m0 + wn2 * 32 * WNB, acc, r2, h2);
    } else {
      epi.template store<WMB, WNB>(m0 + wm2 * 32 * WMB, n0 + wn2 * 32 * WNB, acc, r2, h2, true);
    }
    if (!nxt.valid) break;
    cur = nxt;
  }
}

DI void lds_st16_as2x8(char* dst, const u32x4 v) {
  u32x2 a; a.x = v.x; a.y = v.y; u32x2 b; b.x = v.z; b.y = v.w;
  *(u32x2*)dst = a;
  *(u32x2*)(dst + 8) = b;
}
DI void lds_st_vt(char* row, int ch, const u32x4 v) {
  u32x2 a; a.x = v.x; a.y = v.y; u32x2 b; b.x = v.z; b.y = v.w;
  char* g = row + (ch >> 1) * 32 + (ch & 1) * 8;
  *(u32x2*)g = a;
  *(u32x2*)(g + 16) = b;
}
constexpr int ATT_STAGE = 36864;
constexpr float DEFER_THR = 8.f;

template <int DQK>
DI void qk_scores_acc(const char* kl, const bf16x8 (&qf)[DQK / 16], f32x16 (&s)[2], int r, int h) {
  constexpr int KS = DQK * 2 + 16;
#pragma unroll
  for (int kb = 0; kb < 2; ++kb)
#pragma unroll
    for (int ks = 0; ks < DQK / 16; ++ks) {
      const bf16x8 a = *(const bf16x8*)(kl + (32 * kb + r) * KS + (2 * ks + h) * 16);
      s[kb] = MFMA32(a, qf[ks], s[kb]);
    }
}
template <int DQK>
DI void qk_scores_qlds(const char* kl, const char* qsl, f32x16 (&s)[2], int r, int h) {
  constexpr int KS = DQK * 2 + 16;
#pragma unroll
  for (int kb = 0; kb < 2; ++kb) {
#pragma unroll
    for (int ks = 0; ks < DQK / 16; ++ks) {
      const bf16x8 a = *(const bf16x8*)(kl + (32 * kb + r) * KS + (2 * ks + h) * 16);
      const bf16x8 qv = *(const bf16x8*)(qsl + ks * 1024);
      s[kb] = MFMA32(a, qv, s[kb]);
    }
  }
}
template <int DQK>
DI void qk_scores(const char* kl, const bf16x8 (&qf)[DQK / 16], const f32x16& initv, f32x16 (&s)[2], int r, int h) {
  constexpr int KS = DQK * 2 + 16;
#pragma unroll
  for (int kb = 0; kb < 2; ++kb) {
    s[kb] = initv;
#pragma unroll
    for (int ks = 0; ks < DQK / 16; ++ks) {
      const bf16x8 a = *(const bf16x8*)(kl + (32 * kb + r) * KS + (2 * ks + h) * 16);
      s[kb] = MFMA32(a, qf[ks], s[kb]);
    }
  }
}

template <int DV>
DI float softmax_pv(f32x16 (&s)[2], f32x16 (&o)[DV / 32], float& l, bool first, const char* vl, int r, int h) {
  float dret = 0.f;
  float mx = fmaxf(fmaxf(s[0][0], s[0][1]), s[0][2]);
#pragma unroll
  for (int i = 3; i < 15; i += 2) mx = fmaxf(fmaxf(mx, s[0][i]), s[0][i + 1]);
  mx = fmaxf(fmaxf(mx, s[0][15]), s[1][0]);
#pragma unroll
  for (int i = 1; i < 15; i += 2) mx = fmaxf(fmaxf(mx, s[1][i]), s[1][i + 1]);
  mx = fmaxf(mx, s[1][15]);
  const bool need = first || (mx > DEFER_THR);
  if (__any(need)) {
    mx = fmaxf(mx, __shfl_xor(mx, 32));
    float delta;
    if (first) delta = mx;
    else {
      delta = fmaxf(mx, 0.f);
      const float alpha = fexp2(-delta);
      l *= alpha;
#pragma unroll
      for (int d = 0; d < DV / 32; ++d)
#pragma unroll
        for (int i = 0; i < 16; ++i) o[d][i] *= alpha;
    }
#pragma unroll
    for (int kb = 0; kb < 2; ++kb)
#pragma unroll
      for (int i = 0; i < 16; ++i) s[kb][i] -= delta;
    dret = delta;
  }
  float ps = 0.f;
#pragma unroll
  for (int kb = 0; kb < 2; ++kb)
#pragma unroll
    for (int i = 0; i < 16; ++i) { const float e = fexp2(s[kb][i]); s[kb][i] = e; ps += e; }
  l += ps;
  bf16x8 pf[2][2];
#pragma unroll
  for (int kb = 0; kb < 2; ++kb)
#pragma unroll
    for (int st = 0; st < 2; ++st) {
      u32x4 u;
      u.x = cvt_pk(s[kb][8 * st + 0], s[kb][8 * st + 1]); u.y = cvt_pk(s[kb][8 * st + 2], s[kb][8 * st + 3]);
      u.z = cvt_pk(s[kb][8 * st + 4], s[kb][8 * st + 5]); u.w = cvt_pk(s[kb][8 * st + 6], s[kb][8 * st + 7]);
      pf[kb][st] = __builtin_bit_cast(bf16x8, u);
    }
#pragma unroll
  for (int d = 0; d < DV / 32; ++d)
#pragma unroll
    for (int kb = 0; kb < 2; ++kb)
#pragma unroll
      for (int st = 0; st < 2; ++st) {
        const u32x4 u = *(const u32x4*)(vl + (32 * d + r) * 144 + (2 * kb + st) * 32 + h * 16);
        o[d] = MFMA32(__builtin_bit_cast(bf16x8, u), pf[kb][st], o[d]);
      }
  return dret;
}

template <int DV>
DI float softmax_pre(f32x16 (&s)[2], f32x16 (&o)[DV / 32], float& l, bool first) {
  float dret = 0.f;
  float mx = fmaxf(fmaxf(s[0][0], s[0][1]), s[0][2]);
#pragma unroll
  for (int i = 3; i < 15; i += 2) mx = fmaxf(fmaxf(mx, s[0][i]), s[0][i + 1]);
  mx = fmaxf(fmaxf(mx, s[0][15]), s[1][0]);
#pragma unroll
  for (int i = 1; i < 15; i += 2) mx = fmaxf(fmaxf(mx, s[1][i]), s[1][i + 1]);
  mx = fmaxf(mx, s[1][15]);
  const bool need = first || (mx > DEFER_THR);
  if (__any(need)) {
    mx = fmaxf(mx, __shfl_xor(mx, 32));
    float delta;
    if (first) delta = mx;
    else {
      delta = fmaxf(mx, 0.f);
      const float alpha = fexp2(-delta);
      l *= alpha;
#pragma unroll
      for (int d = 0; d < DV / 32; ++d)
#pragma unroll
        for (int i = 0; i < 16; ++i) o[d][i] *= alpha;
    }
#pragma unroll
    for (int kb = 0; kb < 2; ++kb)
#pragma unroll
      for (int i = 0; i < 16; ++i) s[kb][i] -= delta;
    dret = delta;
  }
  return dret;
}
DI void softmax_exp_half(f32x16& s, float& l, bf16x8 (&pf)[2]) {
  float ps = 0.f;
#pragma unroll
  for (int i = 0; i < 16; ++i) { const float e = fexp2(s[i]); s[i] = e; ps += e; }
  l += ps;
#pragma unroll
  for (int st = 0; st < 2; ++st) {
    u32x4 u;
    u.x = cvt_pk(s[8 * st + 0], s[8 * st + 1]); u.y = cvt_pk(s[8 * st + 2], s[8 * st + 3]);
    u.z = cvt_pk(s[8 * st + 4], s[8 * st + 5]); u.w = cvt_pk(s[8 * st + 6], s[8 * st + 7]);
    pf[st] = __builtin_bit_cast(bf16x8, u);
  }
}
template <int DV>
DI void pv_half(const bf16x8 (&pf)[2], f32x16 (&o)[DV / 32], const char* vl, int kb, int r, int h) {
#pragma unroll
  for (int d = 0; d < DV / 32; ++d)
#pragma unroll
    for (int st = 0; st < 2; ++st) {
      const u32x4 u = *(const u32x4*)(vl + (32 * d + r) * 144 + (2 * kb + st) * 32 + h * 16);
      o[d] = MFMA32(__builtin_bit_cast(bf16x8, u), pf[st], o[d]);
    }
}

template <int ABL>
DI void attn_mla_item(const Ctx& p, int item, char* lds) {
  constexpr int DQK = 96, DV = 64, KS = DQK * 2 + 16;
  const int tid = otid(p), lane = tid & 63, w = tid >> 6, r = lane & 31, h = lane >> 5;
  int head, qb, ts0, S;
  if (item < 1024) { head = item >> 6; qb = item & 63; ts0 = T_PROMPT; S = 16384; }
  else { const int it = item - 1024; qb = it & 15; head = (it >> 4) & 15; ts0 = (it >> 8) * 4096; S = 4096; }
  const u16* q = (const u16*)(p.ws + OFF_R2);
  const u16* knope = q + (size_t)T_TOK * 1536;
  const u16* vt = knope + (size_t)T_TOK * 1024;
  const u16* krope = (const u16*)(p.ws + OFF_KROPE);
  u16* o1 = (u16*)(p.ws + OFF_R1);
  const int tq = ts0 + qb * 256 + w * 32 + r;
  bf16x8 qf[DQK / 16];
#pragma unroll
  for (int ks = 0; ks < DQK / 16; ++ks) qf[ks] = *(const bf16x8*)(q + (size_t)tq * 1536 + head * 96 + 16 * ks + 8 * h);
  f32x16 o[DV / 32];
#pragma unroll
  for (int d = 0; d < DV / 32; ++d)
#pragma unroll
    for (int i = 0; i < 16; ++i) o[d][i] = 0.f;
  f32x16 initv;
#pragma unroll
  for (int i = 0; i < 16; ++i) initv[i] = 0.f;
  float l = 0.f;
  u32x4 pk0, pk1, pv0;
  const int c1 = 512 + tid;
  const int krow0 = tid / 12, kch0 = tid - krow0 * 12;
  const int krow1 = c1 / 12, kch1 = c1 - krow1 * 12;
  const int vrow = tid >> 3, vch = tid & 7;
  const int nkt = S >> 6;
  auto prefetch = [&](int kt) {
    const int tk0 = ts0 + kt * 64;
    {
      const u16* src = kch0 < 8 ? knope + (size_t)(tk0 + krow0) * 1024 + head * 64 + kch0 * 8 : krope + (size_t)(tk0 + krow0) * 32 + (kch0 - 8) * 8;
      pk0 = *(const u32x4*)src;
    }
    if (tid < 256) {
      const u16* src = kch1 < 8 ? knope + (size_t)(tk0 + krow1) * 1024 + head * 64 + kch1 * 8 : krope + (size_t)(tk0 + krow1) * 32 + (kch1 - 8) * 8;
      pk1 = *(const u32x4*)src;
    }
    pv0 = *(const u32x4*)(vt + (size_t)(head * 64 + vrow) * T_TOK + tk0 + vch * 8);
  };
  auto stage_at = [&](int boff) {
    char* kl = lds + boff;
    char* vl = kl + 64 * KS;
    *(u32x4*)(kl + krow0 * KS + kch0 * 16) = pk0;
    if (tid < 256) *(u32x4*)(kl + krow1 * KS + kch1 * 16) = pk1;
    lds_st_vt(vl + vrow * 144, vch, pv0);
  };
  prefetch(0);
  __syncthreads();
  stage_at(0);
  prefetch(1);
  stage_at(ATT_STAGE);
  if (nkt > 2) prefetch(2);
  __syncthreads();
  int cur = 0, nxt = ATT_STAGE, nn = 2 * ATT_STAGE;
  f32x16 s[2];
  qk_scores<DQK>(lds, qf, initv, s, r, h);
#pragma unroll 1
  for (int kt = 0; kt < nkt; ++kt) {
    if (ABL == 2) { __syncthreads(); if (kt + 2 < nkt) stage_at(nn); if (kt + 3 < nkt) prefetch(kt + 3); { const int t = cur; cur = nxt; nxt = nn; nn = t; } continue; }
    const float dl = softmax_pre<DV>(s, o, l, kt == 0);
    if (__any(dl != 0.f)) {
#pragma unroll
      for (int i = 0; i < 16; ++i) initv[i] -= dl;
    }
    f32x16 sn[2];
    qk_scores<DQK>(lds + nxt, qf, initv, sn, r, h);
#pragma unroll
    for (int kb = 0; kb < 2; ++kb) {
      bf16x8 pf[2];
      softmax_exp_half(s[kb], l, pf);
      pv_half<DV>(pf, o, lds + cur + 64 * KS, kb, r, h);
    }
    if (ABL != 1) { if (kt + 2 < nkt) stage_at(nn);
    if (kt + 3 < nkt) prefetch(kt + 3); }
    __syncthreads();
    s[0] = sn[0]; s[1] = sn[1];
    const int t = cur; cur = nxt; nxt = nn; nn = t;
  }
  l += __shfl_xor(l, 32);
  const float inv = 1.f / l;
#pragma unroll
  for (int d = 0; d < DV / 32; ++d) store_tok(o1, 1024, tq, head * 64 + 32 * d + 4 * h, o[d], inv);
}

DI void attn_mla_item2(const Ctx& p, int item, char* lds) {
  constexpr int DQK = 96, DV = 64, KS = DQK * 2 + 16;
  const int tid = otid(p), lane = tid & 63, w = tid >> 6, r = lane & 31, h = lane >> 5;
  int head, qb, ts0, S;
  if (item < 512) { head = item >> 5; qb = item & 31; ts0 = T_PROMPT; S = 16384; }
  else { const int it = item - 512; qb = it & 7; head = (it >> 3) & 15; ts0 = (it >> 7) * 4096; S = 4096; }
  const u16* q = (const u16*)(p.ws + OFF_R2);
  const u16* knope = q + (size_t)T_TOK * 1536;
  const u16* vt = knope + (size_t)T_TOK * 1024;
  const u16* krope = (const u16*)(p.ws + OFF_KROPE);
  u16* o1 = (u16*)(p.ws + OFF_R1);
  const int tq0 = ts0 + qb * 512 + w * 64 + r;
  char* qsl = lds + 49152 + w * 12288 + lane * 16;
  __syncthreads();
  float qn2[2] = {0.f, 0.f};
#pragma unroll
  for (int j = 0; j < 2; ++j)
#pragma unroll
    for (int ks = 0; ks < DQK / 16; ++ks) {
      const u32x4 qv = *(const u32x4*)(q + (size_t)(tq0 + 32 * j) * 1536 + head * 96 + 16 * ks + 8 * h);
      *(u32x4*)(qsl + (j * 6 + ks) * 1024) = qv;
      float a;
      a = bflo(qv.x); qn2[j] += a * a; a = bfhi(qv.x); qn2[j] += a * a; a = bflo(qv.y); qn2[j] += a * a; a = bfhi(qv.y); qn2[j] += a * a;
      a = bflo(qv.z); qn2[j] += a * a; a = bfhi(qv.z); qn2[j] += a * a; a = bflo(qv.w); qn2[j] += a * a; a = bfhi(qv.w); qn2[j] += a * a;
    }
  float ref[2];
  {
    float kn2 = 0.f;
#pragma unroll
    for (int t = 0; t < 8; ++t) { const float v = __uint_as_float(((const unsigned*)(p.ws + OFF_SCAL))[SC_KP + head * 8 + t]); kn2 += v * v; }
    const float kr = __uint_as_float(((const unsigned*)(p.ws + OFF_SCAL))[SC_KRMAX]);
    const float kmaxn = sqrtf(kn2 + kr * kr);
#pragma unroll
    for (int j = 0; j < 2; ++j) {
      qn2[j] += __shfl_xor(qn2[j], 32);
      ref[j] = sqrtf(qn2[j]) * kmaxn * 1.02f + 0.5f;
    }
  }
  const bool fixedref = !__any(ref[0] > 60.f || ref[1] > 60.f);
  f32x16 o[2][DV / 32];
  f32x16 initv[2];
#pragma unroll
  for (int j = 0; j < 2; ++j) {
#pragma unroll
    for (int d = 0; d < DV / 32; ++d)
#pragma unroll
      for (int i = 0; i < 16; ++i) o[j][d][i] = 0.f;
#pragma unroll
    for (int i = 0; i < 16; ++i) initv[j][i] = fixedref ? -ref[j] : 0.f;
  }
  float l[2] = {0.f, 0.f};
  u32x4 pk0, pk1, pv0;
  const int c1 = 512 + (tid & 255);
  const int krow0 = tid / 12, kch0 = tid - krow0 * 12;
  const int krow1 = c1 / 12, kch1 = c1 - krow1 * 12;
  const int vrow = tid >> 3, vch = tid & 7;
  const int nkt = S >> 6;
  auto prefetch = [&](int kt) {
    const int tk0 = ts0 + kt * 64;
    {
      const u16* src = kch0 < 8 ? knope + (size_t)(tk0 + krow0) * 1024 + head * 64 + kch0 * 8 : krope + (size_t)(tk0 + krow0) * 32 + (kch0 - 8) * 8;
      pk0 = *(const u32x4*)src;
    }
    {
      const u16* src = kch1 < 8 ? knope + (size_t)(tk0 + krow1) * 1024 + head * 64 + kch1 * 8 : krope + (size_t)(tk0 + krow1) * 32 + (kch1 - 8) * 8;
      pk1 = *(const u32x4*)src;
    }
    pv0 = *(const u32x4*)(vt + (size_t)(head * 64 + vrow) * T_TOK + tk0 + vch * 8);
  };
  auto stage_at = [&](int boff) {
    char* kl = lds + boff;
    char* vl = kl + 64 * KS;
    *(u32x4*)(kl + krow0 * KS + kch0 * 16) = pk0;
    *(u32x4*)(kl + krow1 * KS + kch1 * 16) = pk1;
    lds_st_vt(vl + vrow * 144, vch, pv0);
  };
  prefetch(0);
  stage_at(0);
  prefetch(1);
  __syncthreads();
#pragma unroll 1
  for (int kt = 0; kt < nkt; ++kt) {
    const char* kl = lds + (kt & 1) * 24576;
    const char* vl = kl + 64 * KS;
    if (kt + 1 < nkt) stage_at(((kt + 1) & 1) * 24576);
    if (kt + 2 < nkt) prefetch(kt + 2);
    f32x16 s[2][2];
#pragma unroll
    for (int kb = 0; kb < 2; ++kb) {
      s[0][kb] = initv[0]; s[1][kb] = initv[1];
#pragma unroll
      for (int ks = 0; ks < DQK / 16; ++ks) {
        const bf16x8 a = *(const bf16x8*)(kl + (32 * kb + r) * KS + (2 * ks + h) * 16);
        const bf16x8 q0 = *(const bf16x8*)(qsl + ks * 1024);
        const bf16x8 q1 = *(const bf16x8*)(qsl + (6 + ks) * 1024);
        s[0][kb] = MFMA32(a, q0, s[0][kb]);
        s[1][kb] = MFMA32(a, q1, s[1][kb]);
      }
    }
    if (!fixedref) {
#pragma unroll
      for (int j = 0; j < 2; ++j) {
        const float dl = softmax_pre<DV>(s[j], o[j], l[j], kt == 0);
        if (__any(dl != 0.f)) {
#pragma unroll
          for (int i = 0; i < 16; ++i) initv[j][i] -= dl;
        }
      }
    }
#pragma unroll
    for (int kb = 0; kb < 2; ++kb) {
      bf16x8 pf0[2], pf1[2];
      softmax_exp_half(s[0][kb], l[0], pf0);
      softmax_exp_half(s[1][kb], l[1], pf1);
#pragma unroll
      for (int d = 0; d < DV / 32; ++d)
#pragma unroll
        for (int st = 0; st < 2; ++st) {
          const u32x4 u = *(const u32x4*)(vl + (32 * d + r) * 144 + (2 * kb + st) * 32 + h * 16);
          const bf16x8 vf = __builtin_bit_cast(bf16x8, u);
          o[0][d] = MFMA32(vf, pf0[st], o[0][d]);
          o[1][d] = MFMA32(vf, pf1[st], o[1][d]);
        }
    }
    __syncthreads();
  }
  int tid2 = otid(p);
  const int lane2 = tid2 & 63, h2 = lane2 >> 5, w2 = tid2 >> 6;
  int item2 = item; asm volatile("" : "+s"(item2));
  int head2, tq2;
  if (item2 < 512) { head2 = item2 >> 5; tq2 = T_PROMPT + (item2 & 31) * 512 + w2 * 64 + (lane2 & 31); }
  else { const int it = item2 - 512; head2 = (it >> 3) & 15; tq2 = (it >> 7) * 4096 + (it & 7) * 512 + w2 * 64 + (lane2 & 31); }
#pragma unroll
  for (int j = 0; j < 2; ++j) {
    float lj = l[j];
    lj += __shfl_xor(lj, 32);
    const float inv = __builtin_amdgcn_rcpf(lj);
#pragma unroll
    for (int d = 0; d < DV / 32; ++d) store_tok(o1, 1024, tq2 + 32 * j, head2 * 64 + 32 * d + 4 * h2, o[j][d], inv);
  }
}

DI void diff_decode(int item, int& hh, int& qb, int& ts0, int& S) {
  int j;
  if (item < 128) { hh = 3; j = item; S = 16384; }
  else if (item < 256) { hh = 2; j = item - 128; S = 16384; }
  else if (item < 768) { hh = 3; j = item - 256; S = 4096; }
  else if (item < 1280) { hh = 2; j = item - 768; S = 4096; }
  else if (item < 1408) { hh = 1; j = item - 1280; S = 16384; }
  else if (item < 1920) { hh = 1; j = item - 1408; S = 4096; }
  else if (item < 2048) { hh = 0; j = item - 1920; S = 16384; }
  else { hh = 0; j = item - 2048; S = 4096; }
  if (S == 16384) { qb = j; ts0 = T_PROMPT; } else { qb = j & 31; ts0 = (j >> 5) * 4096; }
}
DI void attn_diff_item(const Ctx& p, int item, char* lds) {
  constexpr int DQK = 64, DV = 128, KS = DQK * 2 + 16;
  const int tid = otid(p), lane = tid & 63, w = tid >> 6, r = lane & 31, h = lane >> 5;
  const int map = w >> 2, qw = w & 3;
  int hh, qb, ts0, S;
  diff_decode(item, hh, qb, ts0, S);
  const u16* base = (const u16*)(p.ws + OFF_R2);
  const u16* dq = base + 2 * SEG512;
  const u16* dk = base + 3 * SEG512;
  const u16* vtd = base + 5 * SEG512;
  u16* o0 = (u16*)(p.ws + OFF_R1);
  const int qpos = qb * 128 + qw * 32 + r;
  const int tq = ts0 + qpos;
  __syncthreads();
  float qn2 = 0.f;
  bf16x8 qf[DQK / 16];
#pragma unroll
  for (int ks = 0; ks < DQK / 16; ++ks) {
    const u32x4 qv = *(const u32x4*)(dq + (size_t)tq * 512 + (2 * hh + map) * 64 + 16 * ks + 8 * h);
    qf[ks] = __builtin_bit_cast(bf16x8, qv);
    float a;
    a = bflo(qv.x); qn2 += a * a; a = bfhi(qv.x); qn2 += a * a; a = bflo(qv.y); qn2 += a * a; a = bfhi(qv.y); qn2 += a * a;
    a = bflo(qv.z); qn2 += a * a; a = bfhi(qv.z); qn2 += a * a; a = bflo(qv.w); qn2 += a * a; a = bfhi(qv.w); qn2 += a * a;
  }
  qn2 += __shfl_xor(qn2, 32);
  f32x16 o[DV / 32];
#pragma unroll
  for (int d = 0; d < DV / 32; ++d)
#pragma unroll
    for (int i = 0; i < 16; ++i) o[d][i] = 0.f;
  float l = 0.f;
  const float refb = sqrtf(qn2) * __uint_as_float(((const unsigned*)(p.ws + OFF_SCAL))[SC_QKMAX + 8 + 2 * hh + map]) * 1.02f + 0.5f;
  const bool fixedref = !__any(refb > 60.f);
  float ref = fixedref ? refb : 0.f;
  const float slope2 = exp2f(-2.f * (float)(hh + 1)) * LOG2E;
  const float cq = slope2 * (float)qpos;
  const int d0 = 2 * qb;
  const int kd = d0 + (qw >> 1);
  int kt_lo, kt_hi;
  {
    const unsigned* qk = (const unsigned*)(p.ws + OFF_SCAL) + SC_QKMAX;
    const float b0 = __uint_as_float(qk[2 * hh]) * __uint_as_float(qk[8 + 2 * hh]);
    const float b1 = __uint_as_float(qk[2 * hh + 1]) * __uint_as_float(qk[8 + 2 * hh + 1]);
    const float B = fmaxf(b0, b1) * 1.02f + 0.5f;
    const float dskip = fminf((2.f * B + 34.f) / slope2 + 1.f, 1.0e6f);
    const int q_lo = qb * 128, q_hi = q_lo + 127, ds = (int)dskip;
    kt_lo = max(0, (q_lo - 63 - ds) >> 6);
    kt_hi = min((S >> 6) - 1, (q_hi + ds) >> 6);
    kt_lo = min(kt_lo, 2 * qb); kt_hi = max(kt_hi, 2 * qb + 1);
  }
  const int nleft = d0 - kt_lo;
  const int nkt = kt_hi - kt_lo + 1;
  u32x4 pk[2], pv[2];
  const int lrow = tid >> 3, lch = tid & 7;
  auto tile_of = [&](int idx) { return idx < 2 ? d0 + idx : (idx - 2 < nleft ? d0 - 1 - (idx - 2) : idx + kt_lo); };
  const unsigned koff = (unsigned)(((ts0 + lrow) * 512 + 2 * hh * 64 + lch * 8) * 2);
  const unsigned voff = (unsigned)((((hh * 128 + lrow) * T_TOK) + ts0 + lch * 8) * 2);
  const char* dkb = (const char*)dk;
  const char* vtb = (const char*)vtd;
  auto prefetch = [&](int kt) {
    const unsigned ko = koff + (unsigned)kt * (64u * 512u * 2u);
    const unsigned vo = voff + (unsigned)kt * 128u;
    pk[0] = *(const u32x4*)(dkb + ko);
    pk[1] = *(const u32x4*)(dkb + ko + 128u);
    pv[0] = *(const u32x4*)(vtb + vo);
    pv[1] = *(const u32x4*)(vtb + vo + (unsigned)(64 * T_TOK * 2));
  };
  auto stage_at = [&](int boff) {
    char* kl0 = lds + boff;
    char* vl = kl0 + 2 * 64 * KS;
#pragma unroll
    for (int j = 0; j < 2; ++j) *(u32x4*)(kl0 + j * 64 * KS + lrow * KS + lch * 16) = pk[j];
#pragma unroll
    for (int j = 0; j < 2; ++j) lds_st_vt(vl + (lrow + 64 * j) * 144, lch, pv[j]);
  };
  auto scores = [&](int kt, int boff, f32x16 (&sc)[2]) {
    const int side = kt < kd ? -1 : (kt > kd ? 1 : 0);
    const float I = (float)side * cq - ref;
    const unsigned i_hi = cvt_pk(I, 0.f) & 0xffffu;
    const float ir1 = I - __uint_as_float(i_hi << 16);
    const unsigned i_mid = cvt_pk(ir1, 0.f) & 0xffffu;
    const float ir2 = ir1 - __uint_as_float(i_mid << 16);
    const unsigned i_lo = cvt_pk(ir2, 0.f) & 0xffffu;
    const float T = slope2 * (float)(kt * 64);
    const unsigned t_hi = cvt_pk(T, 0.f) & 0xffffu;
    const float r1 = T - __uint_as_float(t_hi << 16);
    const unsigned t_mid = cvt_pk(r1, 0.f) & 0xffffu;
    const float r2 = r1 - __uint_as_float(t_mid << 16);
    const unsigned t_lo = cvt_pk(r2, 0.f) & 0xffffu;
    const unsigned one = side < 0 ? 0x3F80u : (side > 0 ? 0xBF80u : 0u);
    u32x4 qa;
    qa.x = h == 0 ? (one | (one << 16)) : 0u; qa.y = qa.x; qa.z = h == 0 ? (one | (i_hi << 16)) : 0u; qa.w = h == 0 ? (i_mid | (i_lo << 16)) : 0u;
    const bf16x8 qaug = __builtin_bit_cast(bf16x8, qa);
#pragma unroll
    for (int kb = 0; kb < 2; ++kb) {
      const float xl = slope2 * (float)(32 * kb + r);
      const unsigned l_hi = cvt_pk(xl, 0.f) & 0xffffu;
      const unsigned l_lo = cvt_pk(xl - __uint_as_float(l_hi << 16), 0.f) & 0xffffu;
      u32x4 ka; ka.x = h == 0 ? (l_hi | (l_lo << 16)) : 0u; ka.y = h == 0 ? (t_hi | (t_mid << 16)) : 0u; ka.z = h == 0 ? (t_lo | 0x3F800000u) : 0u; ka.w = h == 0 ? 0x3F803F80u : 0u;
      f32x16 z;
#pragma unroll
      for (int i = 0; i < 16; ++i) z[i] = 0.f;
      sc[kb] = MFMA32(__builtin_bit_cast(bf16x8, ka), qaug, z);
    }
    qk_scores_acc<DQK>(lds + boff + map * 64 * KS, qf, sc, r, h);
  };
  prefetch(tile_of(0));
  __syncthreads();
  stage_at(0);
  prefetch(tile_of(1));
  __syncthreads();
  for (int idx = 0; idx < nkt; ++idx) {
    const int kt = tile_of(idx);
    const int cur = (idx & 1) * ATT_STAGE;
    if (idx + 1 < nkt) stage_at(((idx + 1) & 1) * ATT_STAGE);
    if (idx + 2 < nkt) prefetch(tile_of(idx + 2));
    f32x16 s[2];
    scores(kt, cur, s);
    if (kt == kd) {
#pragma unroll
      for (int kb = 0; kb < 2; ++kb)
#pragma unroll
        for (int i = 0; i < 16; ++i) {
          const int kp = kt * 64 + 32 * kb + (i & 3) + 8 * (i >> 2) + 4 * h;
          s[kb][i] -= slope2 * fabsf((float)(qpos - kp));
        }
    }
    if (!fixedref) ref += softmax_pre<DV>(s, o, l, idx == 0);
#pragma unroll
    for (int kb = 0; kb < 2; ++kb) {
      bf16x8 pf[2];
      softmax_exp_half(s[kb], l, pf);
      pv_half<DV>(pf, o, lds + cur + 2 * 64 * KS, kb, r, h);
    }
    __syncthreads();
  }
  l += __shfl_xor(l, 32);
  const float inv = 1.f / l;
  int tid2 = otid(p);
  const int lane2 = tid2 & 63, qw2 = (tid2 >> 6) & 3, h2 = lane2 >> 5;
  int item2 = item; asm volatile("" : "+s"(item2));
  int hh2, tq2;
  { int qb2, ts02, S2; diff_decode(item2, hh2, qb2, ts02, S2); tq2 = ts02 + qb2 * 128 + qw2 * 32 + (lane2 & 31); }
  float* ex = (float*)lds + qw2 * 4096;
  if (map == 1) {
#pragma unroll
    for (int d = 0; d < DV / 32; ++d)
#pragma unroll
      for (int i = 0; i < 16; ++i) ex[(d * 16 + i) * 64 + lane2] = o[d][i] * inv;
  }
  __syncthreads();
  if (map == 0) {
    const float lam = ((const float*)(p.ws + OFF_SCAL))[0];
    float ss = 0.f;
#pragma unroll
    for (int d = 0; d < DV / 32; ++d)
#pragma unroll
      for (int i = 0; i < 16; ++i) { const float v = o[d][i] * inv - lam * ex[(d * 16 + i) * 64 + lane2]; o[d][i] = v; ss += v * v; }
    ss += __shfl_xor(ss, 32);
    const float rn = rsqrtf(ss * (1.f / 128.f) + EPS) * 0.8f;
    const float* gs = (const float*)(p.ws + OFF_SCAL) + SC_GSUB;
#pragma unroll
    for (int d = 0; d < DV / 32; ++d) {
#pragma unroll
      for (int g = 0; g < 4; ++g) {
        const float4 gv = *(const float4*)(gs + 32 * d + 8 * g + 4 * h2);
        o[d][4 * g] *= gv.x; o[d][4 * g + 1] *= gv.y; o[d][4 * g + 2] *= gv.z; o[d][4 * g + 3] *= gv.w;
      }
      store_tok(o0, 1024, tq2, 512 + hh2 * 128 + 32 * d + 4 * h2, o[d], rn);
    }
  }
}

DI void attn_na_item(const Ctx& p, int item, char* lds) {
  constexpr int DQK = 64, DV = 64, KS = DQK * 2 + 16;
  const int tid = otid(p), lane = tid & 63, w = tid >> 6, r = lane & 31, h = lane >> 5;
  const int quad = item % 320, head = item / 320;
  const int t0 = quad * 256;
  int ts0, rows;
  if (t0 < T_PROMPT) { ts0 = t0 & ~4095; rows = 64; } else { ts0 = T_PROMPT; rows = 256; }
  const int r0 = (t0 - ts0) >> 6;
  const int rw = r0 + (w >> 1);
  const int rs_lo = min(max(r0 - 4, 0), rows - 8);
  const int rs_hi = min(max(r0 + 3 - 4, 0), rows - 8);
  const int rs_w = min(max(rw - 4, 0), rows - 8);
  const int ntile = rs_hi + 8 - rs_lo;
  const u16* base = (const u16*)(p.ws + OFF_R2);
  const u16* qn = base;
  const u16* kn = base + SEG512;
  const u16* vtn = base + 4 * SEG512;
  u16* o0 = (u16*)(p.ws + OFF_R1);
  float* tab = (float*)(lds + 2 * ATT_STAGE) + 64;
  const int qc = (w & 1) * 32 + r;
  const int tq = t0 + w * 32 + r;
  bf16x8 qf[DQK / 16];
#pragma unroll
  for (int ks = 0; ks < DQK / 16; ++ks) qf[ks] = *(const bf16x8*)(qn + (size_t)tq * 512 + head * 64 + 16 * ks + 8 * h);
  f32x16 o[DV / 32];
#pragma unroll
  for (int d = 0; d < DV / 32; ++d)
#pragma unroll
    for (int i = 0; i < 16; ++i) o[d][i] = 0.f;
  f32x16 initv;
#pragma unroll
  for (int i = 0; i < 16; ++i) initv[i] = 0.f;
  float l = 0.f;
  bool first = true;
  u32x4 pk0, pv0;
  const int lrow = tid >> 3, lch = tid & 7;
  auto prefetch = [&](int j) {
    const int tk0 = ts0 + (rs_lo + j) * 64;
    pk0 = *(const u32x4*)(kn + (size_t)(tk0 + lrow) * 512 + head * 64 + lch * 8);
    pv0 = *(const u32x4*)(vtn + (size_t)(head * 64 + lrow) * T_TOK + tk0 + lch * 8);
  };
  auto stage = [&](int b) {
    char* kl = lds + b * ATT_STAGE;
    char* vl = kl + 64 * KS;
    *(u32x4*)(kl + lrow * KS + lch * 16) = pk0;
    lds_st_vt(vl + lrow * 144, lch, pv0);
  };
  prefetch(0);
  __syncthreads();
  if (tid < 465) tab[tid] = ((const float*)(p.ws + OFF_SCAL))[SC_RPB + head * 465 + tid];
  stage(0);
  prefetch(1);
  __syncthreads();
  const int wc0 = min(max(qc - 8, 0), 48);
  const float* tabq = tab + (15 - qc + 4 * h);
  for (int j = 0; j < ntile; ++j) {
    const char* kl = lds + (j & 1) * ATT_STAGE;
    const char* vl = kl + 64 * KS;
    const int kr = rs_lo + j;
    if (kr >= rs_w && kr < rs_w + 8) {
      f32x16 s[2];
      qk_scores<DQK>(kl, qf, initv, s, r, h);
      const int ridx = kr - rw + 7;
#pragma unroll
      for (int kb = 0; kb < 2; ++kb)
#pragma unroll
        for (int i = 0; i < 16; ++i) {
          const int kc = 32 * kb + (i & 3) + 8 * (i >> 2) + 4 * h;
          const bool ok = (unsigned)(kc - wc0) < 16u;
          float b = tabq[ridx * 31 + 32 * kb + (i & 3) + 8 * (i >> 2)];
          asm volatile("" : "+v"(b));
          s[kb][i] = ok ? s[kb][i] + b : -INFINITY;
        }
      {
        const float dl = softmax_pv<DV>(s, o, l, first, vl, r, h);
        if (__any(dl != 0.f)) {
#pragma unroll
          for (int i = 0; i < 16; ++i) initv[i] -= dl;
        }
      }
      first = false;
    }
    if (j + 1 < ntile) stage((j + 1) & 1);
    if (j + 2 < ntile) prefetch(j + 2);
    __syncthreads();
  }
  l += __shfl_xor(l, 32);
  const float inv = 1.f / l;
#pragma unroll
  for (int d = 0; d < DV / 32; ++d) store_tok(o0, 1024, tq, head * 64 + 32 * d + 4 * h, o[d], inv);
}

DI void phase_qk_norms(const Ctx& p) {
  const int tid_ = otid(p);
  const int lane = tid_ & 63;
  const int gw = obid() * 8 + (tid_ >> 6), nw = gridDim.x * 8;
  const u16* dq = (const u16*)(p.ws + OFF_R2) + 2 * SEG512;
  const u16* dk = (const u16*)(p.ws + OFF_R2) + 3 * SEG512;
  float mq = 0.f, mk = 0.f;
  for (int row = gw; row < T_TOK; row += nw) {
    const uint4 a = ((const uint4*)(dq + (size_t)row * 512))[lane];
    const uint4 b = ((const uint4*)(dk + (size_t)row * 512))[lane];
    float sa = 0.f, sb = 0.f, t;
    t = bflo(a.x); sa += t * t; t = bfhi(a.x); sa += t * t; t = bflo(a.y); sa += t * t; t = bfhi(a.y); sa += t * t;
    t = bflo(a.z); sa += t * t; t = bfhi(a.z); sa += t * t; t = bflo(a.w); sa += t * t; t = bfhi(a.w); sa += t * t;
    t = bflo(b.x); sb += t * t; t = bfhi(b.x); sb += t * t; t = bflo(b.y); sb += t * t; t = bfhi(b.y); sb += t * t;
    t = bflo(b.z); sb += t * t; t = bfhi(b.z); sb += t * t; t = bflo(b.w); sb += t * t; t = bfhi(b.w); sb += t * t;
#pragma unroll
    for (int o = 1; o < 8; o <<= 1) { sa += __shfl_xor(sa, o); sb += __shfl_xor(sb, o); }
    mq = fmaxf(mq, sa); mk = fmaxf(mk, sb);
  }
  if ((lane & 7) == 0) {
    unsigned* qk = (unsigned*)(p.ws + OFF_SCAL) + SC_QKMAX;
    atomicMax(qk + (lane >> 3), __float_as_uint(sqrtf(mq)));
    atomicMax(qk + 8 + (lane >> 3), __float_as_uint(sqrtf(mk)));
  }
}

namespace pg8 {
#define PG8_LAS __attribute__((address_space(3)))
typedef unsigned short bf16_t;
typedef short bf16x8 __attribute__((ext_vector_type(8)));
typedef float f32x4 __attribute__((ext_vector_type(4)));
typedef unsigned u32x4 __attribute__((ext_vector_type(4)));
constexpr int BM = 256, BK = 64, HALF = 128, HTB = HALF * BK * 2  , STAGE_BYTES = 8 * HTB, NXCD = 8, WGM = 8;

__host__ __device__ __forceinline__ int lds_byte(int r, int c) { const int st = (r >> 4) * 2 + (c >> 5), rr = r & 15, cc = c & 31, ob = rr * 64 + cc * 2; return st * 1024 + (ob ^ (((ob >> 9) & 1) << 5)); }
__host__ __device__ __forceinline__ void stage_rc(int b, int& R, int& C) { const int st = b / 1024, sb = b % 1024, swz = sb ^ (((sb >> 9) & 1) << 5); R = (st >> 1) * 16 + swz / 64; C = (st & 1) * 32 + (swz % 64) / 2; }
__host__ __device__ __forceinline__ int perm32(int rho) { const int n = rho >> 4, i = rho & 15; return 8 * (i >> 2) + 4 * n + (i & 3); }

struct Unit { int pm, pn; };
struct Gemm { const bf16_t* A; const bf16_t* Bt; int M, N, K; int lda, ldb; };

struct StaticOrder {
    int nM, nN, nwg, G, c;
    __host__ __device__ void init(int M, int N, int G_, int c_) { nM = M / BM; nN = N / BM; nwg = nM * nN; G = G_; c = c_; }
    __host__ __device__ bool next(int i, Unit& u) const {
        const long L = (long)i * G + c; if (L >= nwg) return false;
        int wgid = (int)L; { const int q = nwg / NXCD, r = nwg % NXCD, xcd = wgid % NXCD, off = wgid / NXCD; wgid = (xcd < r ? xcd * (q + 1) : r * (q + 1) + (xcd - r) * q) + off; }
        const int nig = WGM * nN, gid = wgid / nig, fm = gid * WGM, gsz = (nM - fm) < WGM ? (nM - fm) : WGM;
        u.pm = fm + ((wgid % nig) % gsz); u.pn = (wgid % nig) / gsz; return true;
    }
    __device__ __forceinline__ void a_ready(const Unit&) const {}
    __device__ __forceinline__ void done(const Unit&) const {}
};
struct CountedOrder : StaticOrder {
    const unsigned* ready; unsigned need; unsigned* tmo;
    __device__ __forceinline__ void a_ready(const Unit& u) const {
        if (threadIdx.x < 64) {
            const unsigned long long t0 = __builtin_amdgcn_s_memrealtime(); unsigned polls = 0;
            while ((unsigned)__builtin_amdgcn_readfirstlane(__hip_atomic_load(ready + 64 * u.pm, __ATOMIC_RELAXED, __HIP_MEMORY_SCOPE_AGENT)) < need) {
                if ((++polls & 255u) == 0u && __builtin_amdgcn_readfirstlane(__hip_atomic_load(tmo, __ATOMIC_RELAXED, __HIP_MEMORY_SCOPE_AGENT)) != 0u) break;
                if (__builtin_amdgcn_s_memrealtime() - t0 > 2000000ull) {
                    if (threadIdx.x == 0) { unsigned expect = 0u; __hip_atomic_compare_exchange_strong(tmo + 1, &expect, 0x600u | (unsigned)(u.pm & 0xff), __ATOMIC_RELAXED, __ATOMIC_RELAXED, __HIP_MEMORY_SCOPE_AGENT); __hip_atomic_store(tmo, 1u, __ATOMIC_RELAXED, __HIP_MEMORY_SCOPE_AGENT); }
                    break; }
                __builtin_amdgcn_s_sleep(2); }
            __builtin_amdgcn_fence(__ATOMIC_ACQUIRE, "agent");
            asm volatile("s_waitcnt vmcnt(0)" ::: "memory");
        }
#if !defined(BROKEN_HOOK_NO_BARRIER)
        asm volatile("" ::: "memory"); __builtin_amdgcn_s_barrier(); asm volatile("" ::: "memory");
#endif
    }
};

__device__ __forceinline__ unsigned cvt_pk_bf16(float lo, float hi) { unsigned r; asm volatile("v_cvt_pk_bf16_f32 %0, %1, %2" : "=v"(r) : "v"(lo), "v"(hi)); return r; }
typedef float f32x2 __attribute__((ext_vector_type(2)));
__device__ __forceinline__ f32x2 gelu_pk(f32x2 v) {
    const f32x2 av = __builtin_elementwise_abs(v), d = av * 0.2316418882f + 1.0f;
    f32x2 t; t.x = __builtin_amdgcn_rcpf(d.x); t.y = __builtin_amdgcn_rcpf(d.y);
    f32x2 q = t * 0.5307027145f + (-0.7265760135f); q = q * t + 0.7107068705f; q = q * t + (-0.142248368f); q = q * t + 0.127414796f; q = q * t;
    const f32x2 s = (v * v) * (-0.72134752044f);
    f32x2 e; e.x = __builtin_amdgcn_exp2f(s.x); e.y = __builtin_amdgcn_exp2f(s.y);
    const f32x2 m = v * (q * e), r = v - m;
    f32x2 o; o.x = v.x < 0.f ? m.x : r.x; o.y = v.y < 0.f ? m.y : r.y; return o;
}

struct EpiF32 {
    static constexpr bool PERM = false, AFTER_DRAIN = false;
    float* C; int ldc; const float* bias;
    __device__ __forceinline__ void operator()(const f32x4 (&acc)[2][2][4][2], const Unit& u, int wr, int wc, int fr, int fq) const {
        const int row0 = u.pm * BM + wr * 64 + fr, col0 = u.pn * BM + wc * 32 + 4 * fq;
        f32x4 bv[2][2];
#pragma unroll
        for (int bj = 0; bj < 2; ++bj)
#pragma unroll
            for (int n = 0; n < 2; ++n) bv[bj][n] = bias ? *(const f32x4*)(bias + col0 + bj * HALF + n * 16) : (f32x4){0.f, 0.f, 0.f, 0.f};
#pragma unroll
        for (int ai = 0; ai < 2; ++ai)
#pragma unroll
            for (int m = 0; m < 4; ++m) { float* rowp = C + (size_t)(row0 + ai * HALF + m * 16) * ldc + col0;
#pragma unroll
                for (int bj = 0; bj < 2; ++bj)
#pragma unroll
                    for (int n = 0; n < 2; ++n) *(f32x4*)(rowp + bj * HALF + n * 16) = acc[ai][bj][m][n] + bv[bj][n]; }
    }
};
template <int ACT  > struct EpiBf16 {
    static constexpr bool PERM = true, AFTER_DRAIN = false;
    bf16_t* O; int ldc; const float* bias; int split_cols; size_t split_stride;
    __device__ __forceinline__ void operator()(const f32x4 (&acc)[2][2][4][2], const Unit& u, int wr, int wc, int fr, int fq) const {
        const int row0 = u.pm * BM + wr * 64 + fr; int colt = u.pn * BM; bf16_t* base = O;
        if (split_cols) { const int t = colt / split_cols; base += (size_t)t * split_stride; colt -= t * split_cols; }
        const int col0 = colt + wc * 32 + 8 * fq, bcol0 = u.pn * BM + wc * 32 + 8 * fq;
        f32x4 bv[2][2];
#pragma unroll
        for (int bj = 0; bj < 2; ++bj)
#pragma unroll
            for (int n = 0; n < 2; ++n) bv[bj][n] = bias ? *(const f32x4*)(bias + bcol0 + bj * HALF + 4 * n) : (f32x4){0.f, 0.f, 0.f, 0.f};
#pragma unroll
        for (int ai = 0; ai < 2; ++ai)
#pragma unroll
            for (int m = 0; m < 4; ++m) { bf16_t* rowp = base + (size_t)(row0 + ai * HALF + m * 16) * ldc + col0;
#pragma unroll
                for (int bj = 0; bj < 2; ++bj) { f32x4 v0 = acc[ai][bj][m][0] + bv[bj][0], v1 = acc[ai][bj][m][1] + bv[bj][1];
                    if (ACT == 1) { f32x2 a = gelu_pk((f32x2){v0[0], v0[1]}), b = gelu_pk((f32x2){v0[2], v0[3]}), c = gelu_pk((f32x2){v1[0], v1[1]}), d = gelu_pk((f32x2){v1[2], v1[3]});
                        v0 = (f32x4){a.x, a.y, b.x, b.y}; v1 = (f32x4){c.x, c.y, d.x, d.y}; }
                    if (ACT == 2) {
#pragma unroll
                        for (int j = 0; j < 4; ++j) { v0[j] = 0.5f * v0[j] * (1.0f + erff(v0[j] * 0.70710678f)); v1[j] = 0.5f * v1[j] * (1.0f + erff(v1[j] * 0.70710678f)); } }
                    u32x4 w; w.x = cvt_pk_bf16(v0[0], v0[1]); w.y = cvt_pk_bf16(v0[2], v0[3]); w.z = cvt_pk_bf16(v1[0], v1[1]); w.w = cvt_pk_bf16(v1[2], v1[3]);
                    *(u32x4*)(rowp + bj * HALF) = w; } }
    }
};

struct PanelStats {
    unsigned* xbuf;
    unsigned* cnt;
    unsigned* tmo;
    int ntn; float eps;
    unsigned code;
    __device__ __forceinline__ bool run(const f32x4 (&v)[2][2][4][2], const Unit& u, int wr, int wc, int fr, int fq, PG8_LAS unsigned char* lds, int wid, int lane) const {
        typedef float f32x2v __attribute__((ext_vector_type(2)));
        PG8_LAS f32x2v* P = (PG8_LAS f32x2v*)lds;
        PG8_LAS f32x2v* S = (PG8_LAS f32x2v*)(lds + 8192);
        PG8_LAS unsigned* flag = (PG8_LAS unsigned*)(lds + 8192 + 2048);
#pragma unroll
        for (int ai = 0; ai < 2; ++ai)
#pragma unroll
            for (int m = 0; m < 4; ++m) {
                float s = 0.f;
#pragma unroll
                for (int bj = 0; bj < 2; ++bj)
#pragma unroll
                    for (int n = 0; n < 2; ++n) { const f32x4 x = v[ai][bj][m][n]; s += (x[0] + x[1]) + (x[2] + x[3]); }
                s += __shfl_xor(s, 16); s += __shfl_xor(s, 32);
                const float mw = s * (1.0f / 64.0f); float q = 0.f;
#pragma unroll
                for (int bj = 0; bj < 2; ++bj)
#pragma unroll
                    for (int n = 0; n < 2; ++n) { const f32x4 d = v[ai][bj][m][n] - mw; q += (d[0] * d[0] + d[1] * d[1]) + (d[2] * d[2] + d[3] * d[3]); }
                q += __shfl_xor(q, 16); q += __shfl_xor(q, 32);
                if (fq == 0) P[(ai * HALF + wr * 64 + m * 16 + fr) * 4 + wc] = (f32x2v){mw, q};
            }
        asm volatile("s_waitcnt lgkmcnt(0)" ::: "memory"); __builtin_amdgcn_s_barrier(); asm volatile("" ::: "memory");
#if defined(BROKEN_NO_WAIT)
        if (blockIdx.x >= 64) { const long long t0 = clock64(); while (clock64() - t0 < 60000) __builtin_amdgcn_s_sleep(8); }
#endif
        const int row = wid * 32 + (lane & 31);
        if (lane < 32) {
            const f32x2v a = P[row * 4 + 0], b = P[row * 4 + 1], c = P[row * 4 + 2], d = P[row * 4 + 3];
            const float mt = (a.x + b.x + c.x + d.x) * 0.25f;
            const float da = a.x - mt, db = b.x - mt, dc = c.x - mt, dd = d.x - mt;
            const float m2 = (a.y + b.y) + (c.y + d.y) + 64.0f * ((da * da + db * db) + (dc * dc + dd * dd));
            unsigned long long* slot = (unsigned long long*)xbuf + ((size_t)(u.pm * BM + row) * 4 + u.pn);
            __hip_atomic_store(slot, ((unsigned long long)__float_as_uint(m2) << 32) | __float_as_uint(mt), __ATOMIC_RELAXED, __HIP_MEMORY_SCOPE_AGENT);
        }
        asm volatile("s_waitcnt vmcnt(0)" ::: "memory");
        if (lane == 0) __hip_atomic_fetch_add(cnt + 64 * u.pm, 1u, __ATOMIC_RELAXED, __HIP_MEMORY_SCOPE_AGENT);
        if (wid == 0) {
            bool dead = false; const unsigned long long t0 = __builtin_amdgcn_s_memrealtime(); const unsigned want = 8u * (unsigned)ntn;
            for (;;) {
#if defined(BROKEN_NO_WAIT)
                break;
#endif
                if ((unsigned)__builtin_amdgcn_readfirstlane(__hip_atomic_load(cnt + 64 * u.pm, __ATOMIC_RELAXED, __HIP_MEMORY_SCOPE_AGENT)) >= want) break;
                if (__builtin_amdgcn_s_memrealtime() - t0 > 2000000ull) {
                    if (lane == 0) { unsigned expect = 0u; __hip_atomic_compare_exchange_strong(tmo + 1, &expect, code | (unsigned)(u.pm & 0xff), __ATOMIC_RELAXED, __ATOMIC_RELAXED, __HIP_MEMORY_SCOPE_AGENT);
                                     __hip_atomic_store(tmo, 1u, __ATOMIC_RELAXED, __HIP_MEMORY_SCOPE_AGENT); }
                    dead = true; break; }
                __builtin_amdgcn_s_sleep(2);
            }
            __builtin_amdgcn_fence(__ATOMIC_ACQUIRE, "agent");
            if (lane == 0) flag[0] = dead ? 1u : 0u;
        }
        asm volatile("s_waitcnt vmcnt(0) lgkmcnt(0)" ::: "memory"); __builtin_amdgcn_s_barrier(); asm volatile("" ::: "memory");
        const bool bad = flag[0] != 0u;
        if (lane < 32) {
            const unsigned long long* slot = (const unsigned long long*)xbuf + (size_t)(u.pm * BM + row) * 4; float mt[4], m2[4]; float ms = 0.f;
#pragma unroll
            for (int t = 0; t < 4; ++t) { if (t < ntn) { const unsigned long long w = __hip_atomic_load(slot + t, __ATOMIC_RELAXED, __HIP_MEMORY_SCOPE_AGENT); mt[t] = __uint_as_float((unsigned)w); m2[t] = __uint_as_float((unsigned)(w >> 32)); } else { mt[t] = 0.f; m2[t] = 0.f; } ms += mt[t]; }
            const float mean = ms / (float)ntn; float q = 0.f;
#pragma unroll
            for (int t = 0; t < 4; ++t) if (t < ntn) { const float dm = mt[t] - mean; q += m2[t] + 256.0f * dm * dm; }
            S[row] = (f32x2v){mean, 1.0f / sqrtf(q / (256.0f * (float)ntn) + eps)};
        }
        asm volatile("s_waitcnt lgkmcnt(0)" ::: "memory"); __builtin_amdgcn_s_barrier(); asm volatile("" ::: "memory");
        return bad;
    }
};
struct EpiLnRes {
    static constexpr bool PERM = false, AFTER_DRAIN = true;
    const float* base; float* out; int ldc; const float* bias; PanelStats st; unsigned poison;
    __device__ __forceinline__ void refuse(size_t i0, size_t stride, int M, int N) const { const float q = __builtin_nanf(""); for (size_t i = i0; i < (size_t)M * N; i += stride) out[(i / N) * ldc + i % N] = q;
        if (i0 == 0) { unsigned expect = 0u; __hip_atomic_compare_exchange_strong(st.tmo + 1, &expect, 0x7f0u, __ATOMIC_RELAXED, __ATOMIC_RELAXED, __HIP_MEMORY_SCOPE_AGENT); __hip_atomic_store(st.tmo, 1u, __ATOMIC_RELAXED, __HIP_MEMORY_SCOPE_AGENT); } }
    __device__ __forceinline__ void fused(f32x4 (&acc)[2][2][4][2], const Unit& u, int wr, int wc, int fr, int fq, PG8_LAS unsigned char* lds, int wid, int lane) const {
        typedef float f32x2v __attribute__((ext_vector_type(2)));
        const PG8_LAS f32x2v* S = (const PG8_LAS f32x2v*)(lds + 8192);
        const int col0 = u.pn * BM + wc * 32 + 4 * fq;
#pragma unroll
        for (int bj = 0; bj < 2; ++bj)
#pragma unroll
            for (int n = 0; n < 2; ++n) { const f32x4 bv = bias ? *(const f32x4*)(bias + col0 + bj * HALF + n * 16) : (f32x4){0.f, 0.f, 0.f, 0.f};
#pragma unroll
                for (int ai = 0; ai < 2; ++ai)
#pragma unroll
                    for (int m = 0; m < 4; ++m) acc[ai][bj][m][n] += bv; }
        const bool bad = st.run(acc, u, wr, wc, fr, fq, lds, wid, lane) || poison != 0u;
        const float qnan = __builtin_nanf("");
#pragma unroll
        for (int ai = 0; ai < 2; ++ai)
#pragma unroll
            for (int m = 0; m < 4; ++m) { const int r = ai * HALF + wr * 64 + m * 16 + fr; const f32x2v sr = S[r]; const size_t off = (size_t)(u.pm * BM + r) * ldc + col0;
#pragma unroll
                for (int bj = 0; bj < 2; ++bj)
#pragma unroll
                    for (int n = 0; n < 2; ++n) { const f32x4 bs = *(const f32x4*)(base + off + bj * HALF + n * 16); f32x4 o = bs + (acc[ai][bj][m][n] - sr.x) * sr.y;
                        if (bad) o = (f32x4){qnan, qnan, qnan, qnan}; *(f32x4*)(out + off + bj * HALF + n * 16) = o; }
                asm volatile("" ::: "memory"); }
    }
};
struct EpiLnResLn {
    static constexpr bool PERM = false, AFTER_DRAIN = true;
    const float* base; float* out; bf16_t* xn; int ldc; const float* bias; PanelStats st1, st2; unsigned poison;
    __device__ __forceinline__ void refuse(size_t i0, size_t stride, int M, int N) const { const float q = __builtin_nanf(""); for (size_t i = i0; i < (size_t)M * N; i += stride) { const size_t o = (i / N) * ldc + i % N; out[o] = q; xn[o] = (bf16_t)0x7fc0u; }
        if (i0 == 0) { unsigned expect = 0u; __hip_atomic_compare_exchange_strong(st1.tmo + 1, &expect, 0x7f0u, __ATOMIC_RELAXED, __ATOMIC_RELAXED, __HIP_MEMORY_SCOPE_AGENT); __hip_atomic_store(st1.tmo, 1u, __ATOMIC_RELAXED, __HIP_MEMORY_SCOPE_AGENT); } }
    __device__ __forceinline__ void fused(f32x4 (&acc)[2][2][4][2], const Unit& u, int wr, int wc, int fr, int fq, PG8_LAS unsigned char* lds, int wid, int lane) const {
        typedef float f32x2v __attribute__((ext_vector_type(2))); typedef unsigned u32x2v __attribute__((ext_vector_type(2)));
        const PG8_LAS f32x2v* S = (const PG8_LAS f32x2v*)(lds + 8192);
        const int col0 = u.pn * BM + wc * 32 + 4 * fq;
#pragma unroll
        for (int bj = 0; bj < 2; ++bj)
#pragma unroll
            for (int n = 0; n < 2; ++n) { const f32x4 bv = bias ? *(const f32x4*)(bias + col0 + bj * HALF + n * 16) : (f32x4){0.f, 0.f, 0.f, 0.f};
#pragma unroll
                for (int ai = 0; ai < 2; ++ai)
#pragma unroll
                    for (int m = 0; m < 4; ++m) acc[ai][bj][m][n] += bv; }
        bool bad = st1.run(acc, u, wr, wc, fr, fq, lds, wid, lane) || poison != 0u;
        const float qnan = __builtin_nanf("");
#pragma unroll
        for (int ai = 0; ai < 2; ++ai)
#pragma unroll
            for (int m = 0; m < 4; ++m) { const int r = ai * HALF + wr * 64 + m * 16 + fr; const f32x2v sr = S[r]; const size_t off = (size_t)(u.pm * BM + r) * ldc + col0;
#pragma unroll
                for (int bj = 0; bj < 2; ++bj)
#pragma unroll
                    for (int n = 0; n < 2; ++n) { const f32x4 bs = *(const f32x4*)(base + off + bj * HALF + n * 16); acc[ai][bj][m][n] = bs + (acc[ai][bj][m][n] - sr.x) * sr.y; }
                asm volatile("" : "+v"(acc[ai][0][m][0]), "+v"(acc[ai][0][m][1]), "+v"(acc[ai][1][m][0]), "+v"(acc[ai][1][m][1]));
                if (m & 1) asm volatile("" ::: "memory"); }
        const bool bad1 = bad;
        bad = st2.run(acc, u, wr, wc, fr, fq, lds, wid, lane) || bad;
#pragma unroll
        for (int ai = 0; ai < 2; ++ai)
#pragma unroll
            for (int m = 0; m < 4; ++m) { const int r = ai * HALF + wr * 64 + m * 16 + fr; const f32x2v sr = S[r]; const size_t off = (size_t)(u.pm * BM + r) * ldc + col0;
#pragma unroll
                for (int bj = 0; bj < 2; ++bj)
#pragma unroll
                    for (int n = 0; n < 2; ++n) { const f32x4 x1 = acc[ai][bj][m][n]; *(f32x4*)(out + off + bj * HALF + n * 16) = bad1 ? (f32x4){qnan, qnan, qnan, qnan} : x1;
                        const f32x4 o = (x1 - sr.x) * sr.y; u32x2v w; w.x = cvt_pk_bf16(o[0], o[1]); w.y = cvt_pk_bf16(o[2], o[3]);
                        if (bad) { w.x = 0x7fc07fc0u; w.y = 0x7fc07fc0u; } *(u32x2v*)(xn + off + bj * HALF + n * 16) = w; }
                asm volatile("" ::: "memory"); }
    }
};

template <class Epi, class Sched, bool STAMP = false>
__device__ __forceinline__ void gemm_phase(PG8_LAS unsigned char* lds, const Gemm g, const Sched& S, const Epi& E, unsigned long long* stamps, const int tid) {
    const int wid = __builtin_amdgcn_readfirstlane(tid >> 6), lane = tid & 63, wr = wid >> 2, wc = wid & 3, fr = lane & 15, fq = lane >> 4;
    const int K = g.K, nt = K / BK;
    int ts_lo = 0, ts_hi = 0, nts = 0; const unsigned long long rt_entry = STAMP ? (unsigned long long)wall_clock64() : 0ull;
#define PG8_STAMP() do { if (STAMP && wid == 0 && nts < 64) { const unsigned long long _c = (unsigned long long)clock64(); \
        ts_lo = (lane == nts) ? (int)(unsigned)_c : ts_lo; ts_hi = (lane == nts) ? (int)(unsigned)(_c >> 32) : ts_hi; ++nts; } } while (0)
    PG8_STAMP();
    unsigned voffA[2], voffB[2];
#pragma unroll
    for (int i = 0; i < 2; ++i) { int R, C; stage_rc(tid * 16 + i * 8192, R, C); const int Rb = Epi::PERM ? ((R & ~31) + perm32(R & 31)) : R;
        voffA[i] = (unsigned)(R * g.lda + C) * 2u; voffB[i] = (unsigned)(Rb * g.ldb + C) * 2u; }
    const size_t kstep = (size_t)(BK * 2);
    const size_t hstepA = (size_t)HALF * g.lda * 2, hstepB = (size_t)HALF * g.ldb * 2;
    const size_t tstepA = 2 * hstepA, tstepB = 2 * hstepB;
    const unsigned ldsw = (unsigned)wid * 1024u;
    const int aoff = lds_byte(wr * 64 + fr, fq * 8), boff = lds_byte(wc * 32 + fr, fq * 8);
#define PG8_SA(b, h) (((b) * 2 + (h)) * HTB)
#define PG8_SB(b, h) ((4 + (b) * 2 + (h)) * HTB)
#define PG8_STAGE(bufoff, gbase, voff) do { _Pragma("unroll") for (int _i = 0; _i < 2; ++_i) \
        __builtin_amdgcn_global_load_lds((const unsigned*)((const char*)(gbase) + (voff)[_i]), (PG8_LAS unsigned*)(lds + (bufoff) + ldsw + _i * 8192), 16, 0, 0); } while (0)
#define PG8_LDA(dst, b, h) do { _Pragma("unroll") for (int m = 0; m < 4; ++m) _Pragma("unroll") for (int k = 0; k < 2; ++k) dst[m][k] = *(const PG8_LAS bf16x8*)(lds + PG8_SA(b, h) + aoff + m * 2048 + k * 1024); } while (0)
#define PG8_LDB(dst, b, h) do { _Pragma("unroll") for (int n = 0; n < 2; ++n) _Pragma("unroll") for (int k = 0; k < 2; ++k) dst[n][k] = *(const PG8_LAS bf16x8*)(lds + PG8_SB(b, h) + boff + n * 2048 + k * 1024); } while (0)
#define PG8_MMA(ai, bj, At, Bt) do { __builtin_amdgcn_s_setprio(1); _Pragma("unroll") for (int m = 0; m < 4; ++m) _Pragma("unroll") for (int n = 0; n < 2; ++n) _Pragma("unroll") for (int k = 0; k < 2; ++k) \
        acc[ai][bj][m][n] = __builtin_amdgcn_mfma_f32_16x16x32_bf16(Bt[n][k], At[m][k], acc[ai][bj][m][n], 0, 0, 0); __builtin_amdgcn_s_setprio(0); } while (0)
#define PG8_WAIT_V(n) asm volatile("s_waitcnt vmcnt(" #n ")" ::: "memory")
#define PG8_WAIT_L(n) asm volatile("s_waitcnt lgkmcnt(" #n ")" ::: "memory")
#define PG8_BAR __builtin_amdgcn_s_barrier()
#define PG8_SCHED __builtin_amdgcn_sched_barrier(0)
    Unit cur, nxt; int ui = 0;
    if (!S.next(0, cur)) return;
    f32x4 acc[2][2][4][2];
#pragma unroll
    for (int a = 0; a < 2; ++a)
#pragma unroll
        for (int b = 0; b < 2; ++b)
#pragma unroll
            for (int m = 0; m < 4; ++m)
#pragma unroll
                for (int n = 0; n < 2; ++n) acc[a][b][m][n] = (f32x4){0.f, 0.f, 0.f, 0.f};
    bf16x8 At[4][2], B0[2][2], B1[2][2];
    const char* cA = (const char*)g.A + (size_t)cur.pm * tstepA; const char* cB = (const char*)g.Bt + (size_t)cur.pn * tstepB;
    S.a_ready(cur);
    PG8_STAGE(PG8_SB(0, 0), cB, voffB); PG8_STAGE(PG8_SA(0, 0), cA, voffA); PG8_STAGE(PG8_SB(0, 1), cB + hstepB, voffB); PG8_STAGE(PG8_SA(0, 1), cA + hstepA, voffA);
    if (wr == 1) PG8_BAR;
    PG8_WAIT_V(4); PG8_BAR;
    PG8_STAGE(PG8_SB(1, 0), cB + kstep, voffB); PG8_STAGE(PG8_SA(1, 0), cA + kstep, voffA); PG8_STAGE(PG8_SB(1, 1), cB + hstepB + kstep, voffB);
    PG8_WAIT_V(6); PG8_BAR;
    PG8_STAMP();
    for (;;) {
        const bool has_next = S.next(ui + 1, nxt);
        const char* nA = has_next ? (const char*)g.A + (size_t)nxt.pm * tstepA : cA; const char* nB = has_next ? (const char*)g.Bt + (size_t)nxt.pn * tstepB : cB;
        for (int t = 0; t < nt; t += 2) {
            const bool last = (t == nt - 2);
            const char* a1 = cA + (size_t)(t + 1) * kstep;
            const char* a2 = last ? nA : cA + (size_t)(t + 2) * kstep; const char* b2 = last ? nB : cB + (size_t)(t + 2) * kstep;
            const char* a3 = a2 + kstep; const char* b3 = b2 + kstep;
            if (last && has_next) S.a_ready(nxt);
            PG8_LDB(B0, 0, 0); PG8_SCHED; PG8_LDA(At, 0, 0); PG8_STAGE(PG8_SA(1, 1), a1 + hstepA, voffA);
            PG8_WAIT_L(8); PG8_BAR; PG8_WAIT_L(0); PG8_MMA(0, 0, At, B0); PG8_BAR; PG8_SCHED;
            PG8_LDB(B1, 0, 1); PG8_STAGE(PG8_SB(0, 0), b2, voffB);
            PG8_BAR; PG8_WAIT_L(0); PG8_MMA(0, 1, At, B1); PG8_BAR;
            PG8_LDA(At, 0, 1); PG8_STAGE(PG8_SA(0, 0), a2, voffA);
            PG8_BAR; PG8_WAIT_L(0); PG8_MMA(1, 0, At, B0); PG8_BAR; PG8_SCHED;
            PG8_STAGE(PG8_SB(0, 1), b2 + hstepB, voffB);
            PG8_WAIT_V(6); PG8_BAR; PG8_MMA(1, 1, At, B1); PG8_BAR;
            PG8_LDB(B0, 1, 0); PG8_SCHED; PG8_LDA(At, 1, 0); PG8_STAGE(PG8_SA(0, 1), a2 + hstepA, voffA);
            PG8_WAIT_L(8); PG8_BAR; PG8_WAIT_L(0); PG8_MMA(0, 0, At, B0); PG8_BAR; PG8_SCHED;
            PG8_LDB(B1, 1, 1); PG8_STAGE(PG8_SB(1, 0), b3, voffB);
            PG8_BAR; PG8_WAIT_L(0); PG8_MMA(0, 1, At, B1); PG8_BAR;
            PG8_LDA(At, 1, 1); PG8_STAGE(PG8_SA(1, 0), a3, voffA);
            PG8_BAR; PG8_WAIT_L(0); PG8_MMA(1, 0, At, B0); PG8_BAR; PG8_SCHED;
            PG8_STAGE(PG8_SB(1, 1), b3 + hstepB, voffB);
            PG8_WAIT_V(6); PG8_BAR; PG8_MMA(1, 1, At, B1); PG8_BAR;
        }
        PG8_STAMP();
        if constexpr (!Epi::AFTER_DRAIN) { E(acc, cur, wr, wc, fr, fq); S.done(cur); }
        PG8_STAMP();
        if (!has_next) break;
#pragma unroll
        for (int a = 0; a < 2; ++a)
#pragma unroll
            for (int b = 0; b < 2; ++b)
#pragma unroll
                for (int m = 0; m < 4; ++m)
#pragma unroll
                    for (int n = 0; n < 2; ++n) acc[a][b][m][n] = (f32x4){0.f, 0.f, 0.f, 0.f};
        cur = nxt; cA = nA; cB = nB; ++ui;
    }
    PG8_WAIT_V(0);
    if (wr == 0) PG8_BAR;
    PG8_BAR;
    if constexpr (Epi::AFTER_DRAIN) { E.fused(acc, cur, wr, wc, fr, fq, lds, wid, lane); S.done(cur); }
    PG8_STAMP();
    if (STAMP && wid == 0) { stamps[lane] = lane < nts ? (((unsigned long long)(unsigned)ts_hi << 32) | (unsigned)ts_lo) : 0ull;
        if (lane == 62) stamps[62] = rt_entry; if (lane == 63) stamps[63] = (unsigned long long)wall_clock64(); }
#undef PG8_STAMP
#undef PG8_SA
#undef PG8_SB
#undef PG8_STAGE
#undef PG8_LDA
#undef PG8_LDB
#undef PG8_MMA
#undef PG8_WAIT_V
#undef PG8_WAIT_L
#undef PG8_BAR
#undef PG8_SCHED
}
}

struct PgEpiSwiGLU {
  static constexpr bool PERM = true, AFTER_DRAIN = false;
  u16* act;
  __device__ __forceinline__ void operator()(const pg8::f32x4 (&acc)[2][2][4][2], const pg8::Unit& u, int wr, int wc, int fr, int fq) const {
    const int row0 = u.pm * 256 + wr * 64 + fr, j0 = u.pn * 128 + wc * 32 + 8 * fq;
#pragma unroll
    for (int ai = 0; ai < 2; ++ai)
#pragma unroll
      for (int m = 0; m < 4; ++m) {
        unsigned pk[4];
#pragma unroll
        for (int n = 0; n < 2; ++n) {
          float y[4];
#pragma unroll
          for (int e = 0; e < 4; ++e) {
            const float gt = acc[ai][0][m][n][e], up = acc[ai][1][m][n][e];
            y[e] = gt * __builtin_amdgcn_rcpf(1.f + fexp2(-LOG2E * gt)) * up;
          }
          pk[2 * n] = cvt_pk(y[0], y[1]); pk[2 * n + 1] = cvt_pk(y[2], y[3]);
        }
        u32x4 w4; w4.x = pk[0]; w4.y = pk[1]; w4.z = pk[2]; w4.w = pk[3];
        *(u32x4*)(act + (size_t)(row0 + ai * 128 + m * 16) * DFF + j0) = w4;
      }
  }
};
template <class Epi>
DI void pg_gemm(const u16* A, const u16* Bt, int M, int N, int K, const Epi& E, char* lds, int bid, int nblk, const Ctx& p) {
  pg8::Gemm g{A, Bt, M, N, K, K, K};
  pg8::StaticOrder S; S.init(M, N, nblk, bid);
  pg8::gemm_phase<Epi, pg8::StaticOrder, false>((PG8_LAS unsigned char*)lds, g, S, E, nullptr, otid(p));
}

constexpr int LDS_BYTES = 2 * (256 + 256) * 144;

struct PgEpiUQ {
  static constexpr bool PERM = false, AFTER_DRAIN = false;
  u16* q; const float* rq; const float2* rope;
  __device__ __forceinline__ void operator()(const pg8::f32x4 (&acc)[2][2][4][2], const pg8::Unit& u, int wr, int wc, int fr, int fq) const {
    const int row0 = u.pm * 256 + wr * 64 + fr;
#pragma unroll
    for (int ai = 0; ai < 2; ++ai)
#pragma unroll
      for (int m = 0; m < 4; ++m) {
        const int row = row0 + ai * 128 + m * 16;
        const float sc = rq[row] * QSCALE96;
        const int pos = tok_pos(row);
#pragma unroll
        for (int bj = 0; bj < 2; ++bj) {
          const int gb = u.pn * 256 + bj * 128 + wc * 32;
          pg8::f32x4 v0 = acc[ai][bj][m][0] * sc, v1 = acc[ai][bj][m][1] * sc;
          if (((gb >> 5) % 3) == 2) {
            const float4 ca = *(const float4*)(rope + pos * 16 + 4 * fq), cb = *(const float4*)(rope + pos * 16 + 4 * fq + 2);
            const float cs[4] = {ca.x, ca.z, cb.x, cb.z}, sn[4] = {ca.y, ca.w, cb.y, cb.w};
#pragma unroll
            for (int e = 0; e < 4; ++e) { const float x1 = v0[e], x2 = v1[e]; v0[e] = x1 * cs[e] - x2 * sn[e]; v1[e] = x2 * cs[e] + x1 * sn[e]; }
          }
          u16* dst = q + (size_t)row * 1536 + gb + 4 * fq;
          u32x2 w0; w0.x = cvt_pk(v0[0], v0[1]); w0.y = cvt_pk(v0[2], v0[3]);
          u32x2 w1; w1.x = cvt_pk(v1[0], v1[1]); w1.y = cvt_pk(v1[2], v1[3]);
          *(u32x2*)dst = w0;
          *(u32x2*)(dst + 16) = w1;
        }
      }
  }
};
struct PgEpiKnope {
  static constexpr bool PERM = true, AFTER_DRAIN = false;
  u16* knope; const float* rkv; unsigned* kp;
  __device__ __forceinline__ void operator()(const pg8::f32x4 (&acc)[2][2][4][2], const pg8::Unit& u, int wr, int wc, int fr, int fq) const {
    const int row0 = u.pm * 256 + wr * 64 + fr;
    float pm[2] = {0.f, 0.f};
#pragma unroll
    for (int ai = 0; ai < 2; ++ai)
#pragma unroll
      for (int m = 0; m < 4; ++m) {
        const int row = row0 + ai * 128 + m * 16;
        const float sc = rkv[row];
#pragma unroll
        for (int bj = 0; bj < 2; ++bj) {
          const pg8::f32x4 v0 = acc[ai][bj][m][0] * sc, v1 = acc[ai][bj][m][1] * sc;
          u32x4 w4; w4.x = cvt_pk(v0[0], v0[1]); w4.y = cvt_pk(v0[2], v0[3]); w4.z = cvt_pk(v1[0], v1[1]); w4.w = cvt_pk(v1[2], v1[3]);
          *(u32x4*)(knope + (size_t)row * 1024 + u.pn * 256 + bj * 128 + wc * 32 + 8 * fq) = w4;
          float ss = 0.f;
#pragma unroll
          for (int e = 0; e < 4; ++e) ss += v0[e] * v0[e] + v1[e] * v1[e];
          pm[bj] = fmaxf(pm[bj], ss);
        }
      }
#pragma unroll
    for (int bj = 0; bj < 2; ++bj) {
      float v = pm[bj];
      v = fmaxf(v, __int_as_float(__builtin_amdgcn_ds_swizzle(__float_as_int(v), (8 << 10) | 0x1f)));
      v = fmaxf(v, __int_as_float(__builtin_amdgcn_ds_swizzle(__float_as_int(v), (4 << 10) | 0x1f)));
      v = fmaxf(v, __int_as_float(__builtin_amdgcn_ds_swizzle(__float_as_int(v), (2 << 10) | 0x1f)));
      v = fmaxf(v, __int_as_float(__builtin_amdgcn_ds_swizzle(__float_as_int(v), (1 << 10) | 0x1f)));
      if (fr == 0) atomicMax(kp + ((u.pn * 256 + bj * 128 + wc * 32) >> 6) * 8 + ((wc & 1) << 2) + fq, __float_as_uint(sqrtf(v) * 1.01f));
    }
  }
};
struct PgEpiVt {
  static constexpr bool PERM = true, AFTER_DRAIN = false;
  u16* vt; const float* rkv;
  __device__ __forceinline__ void operator()(const pg8::f32x4 (&acc)[2][2][4][2], const pg8::Unit& u, int wr, int wc, int fr, int fq) const {
    const int row0 = u.pm * 256 + wr * 64 + fr;
#pragma unroll
    for (int bj = 0; bj < 2; ++bj) {
      const int c0 = u.pn * 256 + bj * 128 + wc * 32 + 8 * fq;
      const float4 s0 = *(const float4*)(rkv + c0), s1 = *(const float4*)(rkv + c0 + 4);
#pragma unroll
      for (int ai = 0; ai < 2; ++ai)
#pragma unroll
        for (int m = 0; m < 4; ++m) {
          const pg8::f32x4 v0 = acc[ai][bj][m][0], v1 = acc[ai][bj][m][1];
          u32x4 w4; w4.x = cvt_pk(v0[0] * s0.x, v0[1] * s0.y); w4.y = cvt_pk(v0[2] * s0.z, v0[3] * s0.w);
          w4.z = cvt_pk(v1[0] * s1.x, v1[1] * s1.y); w4.w = cvt_pk(v1[2] * s1.z, v1[3] * s1.w);
          *(u32x4*)(vt + (size_t)(row0 + ai * 128 + m * 16) * T_TOK + c0) = w4;
        }
    }
  }
};
template <class Epi>
DI void pg_gemm_ld(const u16* A, int lda, const u16* Bt, int ldb, int M, int N, int K, const Epi& E, char* lds, int bid, int nblk, const Ctx& p) {
  pg8::Gemm g{A, Bt, M, N, K, lda, ldb};
  pg8::StaticOrder S; S.init(M, N, nblk, bid);
  pg8::gemm_phase<Epi, pg8::StaticOrder, false>((PG8_LAS unsigned char*)lds, g, S, E, nullptr, otid(p));
}

DI void grid_barrier(unsigned* ctr, unsigned target, const Ctx& p) {
  __syncthreads();
  if (otid(p) < 64) {
    __builtin_amdgcn_fence(__ATOMIC_RELEASE, "agent");
    if (otid(p) == 0) {
      __hip_atomic_fetch_add(ctr, 1u, __ATOMIC_RELAXED, __HIP_MEMORY_SCOPE_AGENT);
      while (__hip_atomic_load(ctr, __ATOMIC_RELAXED, __HIP_MEMORY_SCOPE_AGENT) < target) __builtin_amdgcn_s_sleep(1);
    }
    __builtin_amdgcn_fence(__ATOMIC_ACQUIRE, "agent");
  }
  __syncthreads();
}
template <int PH>
DI void run_phase(const Ctx& p, char* lds) {
  const int bid = obid(), nblk = gridDim.x;
  u16* wb = (u16*)p.ws;
  u16* R1 = (u16*)(p.ws + OFF_R1);
  u16* R2 = (u16*)(p.ws + OFF_R2);
  u16* R3 = (u16*)(p.ws + OFF_R3);
  if constexpr (PH == 0) phase_prep(p);
  else if constexpr (PH == 1) {
    pg_gemm(R1, wb + W0IN, T_TOK, 2048, 1024, pg8::EpiBf16<0>{R2, 512, nullptr, 512, SEG512}, lds, bid, nblk, p);
    pg_gemm(wb + W0IN + (size_t)2048 * 1024, R1, 1024, T_TOK, 1024, pg8::EpiBf16<0>{R2 + 4 * SEG512, T_TOK, nullptr, 0, 0}, lds, bid, nblk, p);
    grid_barrier((unsigned*)(p.ws + OFF_SCAL) + SC_BAR2, (unsigned)nblk, p);
    phase_qk_norms(p);
  }
  else if constexpr (PH == 2) {
    unsigned* ctr = (unsigned*)(p.ws + OFF_SCAL) + SC_CTR;
    int* nxt_slot = (int*)(lds + LDS_BYTES - 16);
    const int tid0 = otid(p);
    int it = bid;
    while (it < 5120) {
      int nx = 0;
      if (tid0 == 0) nx = (int)atomicAdd(ctr, 1u) + nblk;
      if (it < 2560) attn_diff_item(p, it, lds);
      else attn_na_item(p, it - 2560, lds);
      __syncthreads();
      if (tid0 == 0) *nxt_slot = nx;
      __syncthreads();
      it = *nxt_slot;
    }
  }
  else if constexpr (PH == 3) pg_gemm(R1, wb + W0OUT, T_TOK, 1024, 1024, pg8::EpiBf16<0>{R3, 1024, nullptr, 0, 0}, lds, bid, nblk, p);
  else if constexpr (PH == 4) phase_res<true, false>(p, R3, (const float*)(p.ws + OFF_SCAL) + SC_G0);
  else if constexpr (PH == 5) pg_gemm(R1, wb + W0F1, T_TOK, 5632, 1024, PgEpiSwiGLU{R2}, lds, bid, nblk, p);
  else if constexpr (PH == 6) pg_gemm(R2, wb + W0F2, T_TOK, 1024, 2816, pg8::EpiBf16<0>{R3, 1024, nullptr, 0, 0}, lds, bid, nblk, p);
  else if constexpr (PH == 7) phase_res<false, false>(p, R3, (const float*)(p.ws + OFF_SCAL) + SC_G1);
  else if constexpr (PH == 8) pg_gemm(R1, wb + W1DN, T_TOK, 768, 1024, pg8::EpiBf16<0>{R3, 768, nullptr, 0, 0}, lds, bid, nblk, p);
  else if constexpr (PH == 9) phase_mla_stats(p);
  else if constexpr (PH == 10) {
    pg_gemm_ld(R3, 768, wb + W1UQ, 384, T_TOK, 1536, 384, PgEpiUQ{R2, (const float*)(p.ws + OFF_RQ), (const float2*)(p.ws + OFF_ROPE)}, lds, bid, nblk, p);
    pg_gemm_ld(R3 + 384, 768, wb + W1UKV, 256, T_TOK, 1024, 256,
               PgEpiKnope{R2 + (size_t)T_TOK * 1536, (const float*)(p.ws + OFF_RKV), (unsigned*)(p.ws + OFF_SCAL) + SC_KP}, lds, bid, nblk, p);
    pg_gemm_ld(wb + W1UKV + (size_t)1024 * 256, 256, R3 + 384, 768, 1024, T_TOK, 256,
               PgEpiVt{R2 + (size_t)T_TOK * 2560, (const float*)(p.ws + OFF_RKV)}, lds, bid, nblk, p);
  }
  else if constexpr (PH == 11) { for (int it = bid; it < 2560; it += nblk) {
      int itm = it;
      if (nblk == 256) {
        const int rnd = it >> 8, x = bid & 7, j = bid >> 3;
        itm = rnd < 2 ? (8 * rnd + x) * 32 + j : 512 + (2 * (rnd - 2) + (x >> 2)) * 128 + (4 * (x & 3) + (j >> 3)) * 8 + (j & 7);
      }
      attn_mla_item2(p, itm, lds);
    } }
  else if constexpr (PH == 12) pg_gemm(R1, wb + W1OUT, T_TOK, 1024, 1024, pg8::EpiBf16<0>{R3, 1024, nullptr, 0, 0}, lds, bid, nblk, p);
  else if constexpr (PH == 13) phase_res<false, false>(p, R3, (const float*)(p.ws + OFF_SCAL) + SC_G2);
  else if constexpr (PH == 14) pg_gemm(R1, wb + W1F1, T_TOK, 5632, 1024, PgEpiSwiGLU{R2}, lds, bid, nblk, p);
  else if constexpr (PH == 15) pg_gemm(R2, wb + W1F2, T_TOK, 1024, 2816, pg8::EpiBf16<0>{R3, 1024, nullptr, 0, 0}, lds, bid, nblk, p);
  else if constexpr (PH == 16) phase_res<false, true>(p, R3, (const float*)(p.ws + OFF_SCAL) + SC_G3);
}

#if MULTI_LAUNCH
template <int PH>
__global__ void __launch_bounds__(512, 2) k_phase(Params pa) {
  extern __shared__ __attribute__((aligned(16))) char lds[];
  Ctx p;
#pragma unroll
  for (int i = 0; i < 28; ++i) p.in[i] = pa.in[i];
  p.out = pa.out; p.ws = pa.ws;
  p.wv = __builtin_amdgcn_readfirstlane((int)(threadIdx.x >> 6));
  run_phase<PH>(p, lds);
}
template <int PH>
static void launch_all(const Params& p, int grid, hipStream_t stream) {
  (void)hipFuncSetAttribute((const void*)k_phase<PH>, hipFuncAttributeMaxDynamicSharedMemorySize, LDS_BYTES);
  hipLaunchKernelGGL(k_phase<PH>, dim3(grid), dim3(512), LDS_BYTES, stream, p);
  if constexpr (PH + 1 < NPHASE) launch_all<PH + 1>(p, grid, stream);
}
#define OCC_KERNEL k_phase<2>
#else
#ifndef PROBE_DUP
#define PROBE_DUP -1
#endif
#ifndef PROBE_DUP2
#define PROBE_DUP2 -1
#endif
template <int PH>
DI void run_from(const Ctx& p, char* lds) {
  if constexpr (PH == PROBE_DUP || PH == PROBE_DUP2) { run_phase<PH>(p, lds); cg::this_grid().sync(); }
#ifdef PROBE_ABL
  if constexpr (PH == 11) { for (int it = obid(); it < 5120; it += gridDim.x) attn_mla_item<PROBE_ABL>(p, it, lds); cg::this_grid().sync(); }
#endif
  run_phase<PH>(p, lds);
  if constexpr (PH + 1 < NPHASE) {
    if constexpr (PH == 0) cg::this_grid().sync();
    else grid_barrier((unsigned*)(p.ws + OFF_SCAL) + SC_BAR, (unsigned)PH * gridDim.x, p);
    run_from<PH + 1>(p, lds);
  }
}
__global__ void __launch_bounds__(512, 2) mega(Params pa) {
  extern __shared__ __attribute__((aligned(16))) char lds[];
  Ctx p;
#pragma unroll
  for (int i = 0; i < 28; ++i) p.in[i] = pa.in[i];
  p.out = pa.out; p.ws = pa.ws;
  p.wv = __builtin_amdgcn_readfirstlane((int)(threadIdx.x >> 6));
  run_from<0>(p, lds);
}
#define OCC_KERNEL mega
#endif

extern "C" void kernel_launch(void* const* d_in, const int* in_sizes, int n_in, void* d_out, int out_size, void* d_ws, size_t ws_size,
                              hipStream_t stream) {
  static int grid = 0;
  if (grid == 0) {
    if (n_in != 28 || ws_size < WS_NEED) { fprintf(stderr, "kernel_launch: unexpected n_in %d / ws_size %zu (need %zu)\n", n_in, ws_size, (size_t)WS_NEED); grid = -1; return; }
    int dev = 0, cus = 0, per_cu = 0;
    (void)hipGetDevice(&dev);
    (void)hipDeviceGetAttribute(&cus, hipDeviceAttributeMultiprocessorCount, dev);
    (void)hipFuncSetAttribute((const void*)OCC_KERNEL, hipFuncAttributeMaxDynamicSharedMemorySize, LDS_BYTES);
    (void)hipOccupancyMaxActiveBlocksPerMultiprocessor(&per_cu, (const void*)OCC_KERNEL, 512, LDS_BYTES);
    if (per_cu < 1) per_cu = 1;
    if (per_cu > 1) per_cu = 1;
    grid = cus * per_cu;
  }
  if (grid < 0) return;
  Params p{};
  for (int i = 0; i < 28; ++i) p.in[i] = (const float*)d_in[i];
  p.out = (float*)d_out;
  p.ws = (char*)d_ws;
#if MULTI_LAUNCH
  launch_all<0>(p, grid, stream);
#else
  void* args[] = {&p};
  hipError_t e = hipLaunchCooperativeKernel((const void*)mega, dim3(grid), dim3(512), args, LDS_BYTES, stream);
  if (e != hipSuccess) fprintf(stderr, "cooperative launch failed: %s (grid %d)\n", hipGetErrorString(e), grid);
#endif
}
```

```cpp
#include <hip/hip_runtime.h>
#include <hip/hip_cooperative_groups.h>
#include <stdint.h>
#include <cstdio>
namespace cg = cooperative_groups;

#ifndef MULTI_LAUNCH
#define MULTI_LAUNCH 0
#endif

typedef unsigned short u16;
typedef __attribute__((ext_vector_type(8))) short bf16x8;
typedef __attribute__((ext_vector_type(16))) float f32x16;
typedef __attribute__((ext_vector_type(4))) unsigned u32x4;

#define MFMA32(a, b, c) __builtin_amdgcn_mfma_f32_32x32x16_bf16((a), (b), (c), 0, 0, 0)
#define DI __device__ __forceinline__

constexpr int T_TOK = 81920;
constexpr int T_PROMPT = 65536;
constexpr int DM = 1024;
constexpr int DFF = 2816;
constexpr float EPS = 1e-6f;
constexpr float LOG2E = 1.4426950408889634f;
constexpr float QSCALE64 = 0.125f * LOG2E;
constexpr float QSCALE96 = 0.10206207261596577f * LOG2E;
constexpr int NPHASE = 17;

constexpr size_t MiB = (size_t)1 << 20;
constexpr size_t W0IN = 0;
constexpr size_t W0OUT = W0IN + (size_t)3072 * 1024;
constexpr size_t W0F1 = W0OUT + (size_t)1024 * 1024;
constexpr size_t W0F2 = W0F1 + (size_t)5632 * 1024;
constexpr size_t W1DN = W0F2 + (size_t)1024 * 2816;
constexpr size_t W1UQ = W1DN + (size_t)768 * 1024;
constexpr size_t W1UKV = W1UQ + (size_t)1536 * 384;
constexpr size_t W1OUT = W1UKV + (size_t)2048 * 256;
constexpr size_t W1F1 = W1OUT + (size_t)1024 * 1024;
constexpr size_t W1F2 = W1F1 + (size_t)5632 * 1024;
constexpr size_t W_END = W1F2 + (size_t)1024 * 2816;
static_assert(W_END * 2 <= 48 * MiB, "weights region");
constexpr size_t OFF_ROPE = 48 * MiB;
constexpr size_t OFF_RQ = OFF_ROPE + 2 * MiB;
constexpr size_t OFF_RKV = OFF_RQ + MiB / 2;
constexpr size_t OFF_KROPE = OFF_RKV + MiB / 2;
constexpr size_t OFF_SCAL = OFF_KROPE + 5 * MiB;
constexpr int SC_KP = 64;
constexpr int SC_QKMAX = 16, SC_CTR = 32, SC_BAR = 33, SC_BAR2 = 34, SC_KMAX1 = 40, SC_KRMAX = 56;
constexpr int SC_G0 = 1024, SC_G1 = 2048, SC_G2 = 3072, SC_G3 = 4096, SC_GSUB = 5120, SC_RPB = 6144;
constexpr size_t OFF_R1 = 58 * MiB;
constexpr size_t OFF_R3 = OFF_R1 + 160 * MiB;
constexpr size_t OFF_R2 = OFF_R3 + 160 * MiB;
constexpr size_t WS_NEED = OFF_R2 + 560 * MiB;
constexpr size_t SEG512 = (size_t)T_TOK * 512;

struct Params {
  const float* in[28];
  float* out;
  char* ws;
};
struct Ctx {
  const float* in[28];
  float* out;
  char* ws;
  int wv;
};

DI u16 f2bf(float x) { unsigned u = __float_as_uint(x); u += 0x7fffu + ((u >> 16) & 1u); return (u16)(u >> 16); }
DI unsigned pack2(float a, float b) { return (unsigned)f2bf(a) | ((unsigned)f2bf(b) << 16); }
DI float bflo(unsigned v) { return __uint_as_float(v << 16); }
DI float bfhi(unsigned v) { return __uint_as_float(v & 0xffff0000u); }
DI float wave_sum(float v) {
#pragma unroll
  for (int o = 32; o; o >>= 1) v += __shfl_xor(v, o);
  return v;
}
DI int tok_pos(int t) { return t < T_PROMPT ? (t & 4095) : (t - T_PROMPT); }
DI float fexp2(float x) { return __builtin_amdgcn_exp2f(x); }
typedef __attribute__((ext_vector_type(2))) float f32x2;
typedef __attribute__((ext_vector_type(2))) __bf16 bf16x2_t;
typedef __attribute__((ext_vector_type(2))) unsigned u32x2;
typedef __attribute__((ext_vector_type(4))) unsigned u32x4_;
DI unsigned cvt_pk(float a, float b) {
  f32x2 v; v.x = a; v.y = b;
  return __builtin_bit_cast(unsigned, __builtin_convertvector(v, bf16x2_t));
}
DI int otid(const Ctx& p) {
  int wv = p.wv; asm volatile("" : "+s"(wv));
  int t = wv * 64 + (int)__builtin_amdgcn_mbcnt_hi(~0u, __builtin_amdgcn_mbcnt_lo(~0u, 0u));
  asm volatile("" : "+v"(t));
  return t;
}
DI int obid() { int b = blockIdx.x; asm volatile("" : "+s"(b)); return b; }

__device__ const float ROPE_INV[16] = {1.0f, 0.5623413324356079f, 0.3162277638912201f, 0.17782793939113617f, 0.10000000149011612f, 0.05623413249850273f, 0.03162277489900589f, 0.017782794311642647f, 0.009999999776482582f, 0.005623413249850273f, 0.003162277629598975f, 0.0017782794311642647f, 0.0010000000474974513f, 0.000562341301701963f, 0.0003162277571391314f, 0.00017782794020604342f};

DI void wconv(const float* __restrict__ W, const float* __restrict__ g, u16* __restrict__ dst, int K, int N, int rowsOut, int perm, int gtid, int gthreads) {
  const int kc = K >> 3;
  const long total = (long)rowsOut * kc;
  for (long c = gtid; c < total; c += gthreads) {
    const int n = (int)(c % rowsOut);
    const int k0 = (int)(c / rowsOut) * 8;
    int sc;
    if (perm == 1) { const int blk = n >> 8, w = n & 255; const int j = blk * 128 + (w & 127); sc = (w < 128) ? j : DFF + j; }
    else if (perm == 3) { sc = n < 1024 ? n : (n < 2048 ? n + 512 : (n < 2560 ? n - 1024 : n)); }
    else if (perm == 2) { const int hd = (n & 1023) >> 6, d = n & 63; sc = hd * 128 + (n >= 1024 ? 64 : 0) + d; }
    else sc = n;
    uint4 o = make_uint4(0, 0, 0, 0);
    if (sc < N) {
      float v[8];
      const float rsc = (perm == 3 && (n < 512 || (n >= 1024 && n < 1536))) ? QSCALE64 : 1.f;
#pragma unroll
      for (int i = 0; i < 8; ++i) { float x = W[(size_t)(k0 + i) * N + sc]; if (g) x *= g[k0 + i]; v[i] = x * rsc; }
      o.x = pack2(v[0], v[1]); o.y = pack2(v[2], v[3]); o.z = pack2(v[4], v[5]); o.w = pack2(v[6], v[7]);
    }
    *(uint4*)(dst + (size_t)n * K + k0) = o;
  }
}

DI void phase_prep(const Ctx& p) {
  const int gtid = obid() * 512 + otid(p), gthreads = gridDim.x * 512;
  u16* wb = (u16*)p.ws;
  wconv(p.in[3], p.in[2], wb + W0IN, 1024, 3072, 3072, 3, gtid, gthreads);
  wconv(p.in[10], nullptr, wb + W0OUT, 1024, 1024, 1024, 0, gtid, gthreads);
  wconv(p.in[13], p.in[12], wb + W0F1, 1024, 5632, 5632, 1, gtid, gthreads);
  wconv(p.in[14], nullptr, wb + W0F2, 2816, 1024, 1024, 0, gtid, gthreads);
  wconv(p.in[17], p.in[16], wb + W1DN, 1024, 672, 768, 0, gtid, gthreads);
  wconv(p.in[20], p.in[18], wb + W1UQ, 384, 1536, 1536, 0, gtid, gthreads);
  wconv(p.in[21], p.in[19], wb + W1UKV, 256, 2048, 2048, 2, gtid, gthreads);
  wconv(p.in[22], nullptr, wb + W1OUT, 1024, 1024, 1024, 0, gtid, gthreads);
  wconv(p.in[25], p.in[24], wb + W1F1, 1024, 5632, 5632, 1, gtid, gthreads);
  wconv(p.in[26], nullptr, wb + W1F2, 2816, 1024, 1024, 0, gtid, gthreads);
  float2* rope = (float2*)(p.ws + OFF_ROPE);
  for (int idx = gtid; idx < 16384 * 16; idx += gthreads) {
    const int pos = idx >> 4, i = idx & 15;
    const float ang = (float)pos * ROPE_INV[i];
    double rev = (double)ang * 0.15915494309189535;
    rev -= rint(rev);
    const float rf = (float)rev;
    rope[idx] = make_float2(__builtin_amdgcn_cosf(rf), __builtin_amdgcn_sinf(rf));
  }
  if (gtid == 0) {
    float s1 = 0.f, s2 = 0.f;
    for (int i = 0; i < 64; ++i) { s1 += p.in[5][i] * p.in[6][i]; s2 += p.in[7][i] * p.in[8][i]; }
    float* sc = (float*)(p.ws + OFF_SCAL);
    sc[0] = __expf(s1) - __expf(s2) + 0.2f;
    for (int i = 0; i < 176; ++i) ((unsigned*)sc)[SC_QKMAX + i] = 0u;
  }
  {
    float* sc = (float*)(p.ws + OFF_SCAL);
    for (int i = gtid; i < 1024; i += gthreads) { sc[SC_G0 + i] = p.in[11][i]; sc[SC_G1 + i] = p.in[15][i]; sc[SC_G2 + i] = p.in[23][i]; sc[SC_G3 + i] = p.in[27][i]; }
    for (int i = gtid; i < 128; i += gthreads) sc[SC_GSUB + i] = p.in[9][i];
    for (int i = gtid; i < 8 * 465; i += gthreads) sc[SC_RPB + i] = p.in[4][i] * LOG2E;
  }
  const int tid_ = otid(p);
  const int lane = tid_ & 63;
  const int gw = obid() * 8 + (tid_ >> 6), nw = gridDim.x * 8;
  u16* hb = (u16*)(p.ws + OFF_R1);
  for (int row = gw; row < T_TOK; row += nw) {
    const float* xr = row < T_PROMPT ? p.in[0] + (size_t)row * DM : p.in[1] + (size_t)(row - T_PROMPT) * DM;
    float4 v[4];
    float ss = 0.f;
#pragma unroll
    for (int j = 0; j < 4; ++j) { v[j] = ((const float4*)xr)[lane + 64 * j]; ss += v[j].x * v[j].x + v[j].y * v[j].y + v[j].z * v[j].z + v[j].w * v[j].w; }
    ss = wave_sum(ss);
    const float r = rsqrtf(ss * (1.f / DM) + EPS);
#pragma unroll
    for (int j = 0; j < 4; ++j) {
      uint2 o; o.x = pack2(v[j].x * r, v[j].y * r); o.y = pack2(v[j].z * r, v[j].w * r);
      ((uint2*)(hb + (size_t)row * DM))[lane + 64 * j] = o;
    }
  }
}

typedef float f32x4nt __attribute__((ext_vector_type(4)));
template <bool FIRST, bool LAST>
DI void phase_res(const Ctx& p, const u16* __restrict__ mbuf, const float* __restrict__ g) {
  const int tid_ = otid(p);
  const int lane = tid_ & 63;
  const int gw = obid() * 8 + (tid_ >> 6), nw = gridDim.x * 8;
  u16* hb = (u16*)(p.ws + OFF_R1);
  float4 gv[4];
#pragma unroll
  for (int j = 0; j < 4; ++j) gv[j] = ((const float4*)g)[lane + 64 * j];
  for (int row0 = gw; row0 < T_TOK; row0 += 2 * nw) {
    float4 xv[2][4], mv[2][4];
    float ss[2] = {0.f, 0.f};
    bool act[2];
#pragma unroll
    for (int t = 0; t < 2; ++t) {
      const int row = row0 + t * nw;
      act[t] = row < T_TOK;
      const int rr = act[t] ? row : row0;
      const float* xr;
      if (FIRST) xr = rr < T_PROMPT ? p.in[0] + (size_t)rr * DM : p.in[1] + (size_t)(rr - T_PROMPT) * DM;
      else xr = p.out + (size_t)rr * DM;
#pragma unroll
      for (int j = 0; j < 4; ++j) {
        const u32x2 u = __builtin_nontemporal_load((const u32x2*)(mbuf + (size_t)rr * DM) + lane + 64 * j);
        mv[t][j] = make_float4(bflo(u.x), bfhi(u.x), bflo(u.y), bfhi(u.y));
        { const f32x4nt xx = __builtin_nontemporal_load((const f32x4nt*)xr + lane + 64 * j); xv[t][j] = make_float4(xx.x, xx.y, xx.z, xx.w); }
      }
    }
#pragma unroll
    for (int t = 0; t < 2; ++t) {
#pragma unroll
      for (int j = 0; j < 4; ++j) ss[t] += mv[t][j].x * mv[t][j].x + mv[t][j].y * mv[t][j].y + mv[t][j].z * mv[t][j].z + mv[t][j].w * mv[t][j].w;
      ss[t] = wave_sum(ss[t]);
    }
#pragma unroll
    for (int t = 0; t < 2; ++t) {
      if (!act[t]) continue;
      const int row = row0 + t * nw;
      const float rm = rsqrtf(ss[t] * (1.f / DM) + EPS);
      float s2 = 0.f;
#pragma unroll
      for (int j = 0; j < 4; ++j) {
        xv[t][j].x += mv[t][j].x * rm * gv[j].x; xv[t][j].y += mv[t][j].y * rm * gv[j].y;
        xv[t][j].z += mv[t][j].z * rm * gv[j].z; xv[t][j].w += mv[t][j].w * rm * gv[j].w;
        s2 += xv[t][j].x * xv[t][j].x + xv[t][j].y * xv[t][j].y + xv[t][j].z * xv[t][j].z + xv[t][j].w * xv[t][j].w;
        { f32x4nt xx; xx.x = xv[t][j].x; xx.y = xv[t][j].y; xx.z = xv[t][j].z; xx.w = xv[t][j].w; __builtin_nontemporal_store(xx, (f32x4nt*)(p.out + (size_t)row * DM) + lane + 64 * j); }
      }
      if (!LAST) {
        s2 = wave_sum(s2);
        const float r2 = rsqrtf(s2 * (1.f / DM) + EPS);
#pragma unroll
        for (int j = 0; j < 4; ++j) {
          uint2 o; o.x = pack2(xv[t][j].x * r2, xv[t][j].y * r2); o.y = pack2(xv[t][j].z * r2, xv[t][j].w * r2);
          ((uint2*)(hb + (size_t)row * DM))[lane + 64 * j] = o;
        }
      }
    }
  }
}

DI void phase_mla_stats(const Ctx& p) {
  const int tid_ = otid(p);
  const int lane = tid_ & 63;
  const int gw = obid() * 8 + (tid_ >> 6), nw = gridDim.x * 8;
  const u16* c = (const u16*)(p.ws + OFF_R3);
  float* rq = (float*)(p.ws + OFF_RQ);
  float* rkv = (float*)(p.ws + OFF_RKV);
  u16* krope = (u16*)(p.ws + OFF_KROPE);
  const float2* rope = (const float2*)(p.ws + OFF_ROPE);
  float krmax2 = 0.f;
  for (int row = gw; row < T_TOK; row += nw) {
    const u16* cr = c + (size_t)row * 768;
    const uint4 u0 = ((const uint4*)cr)[lane];
    float s0 = 0.f;
    { float a;
      a = bflo(u0.x); s0 += a * a; a = bfhi(u0.x); s0 += a * a; a = bflo(u0.y); s0 += a * a; a = bfhi(u0.y); s0 += a * a;
      a = bflo(u0.z); s0 += a * a; a = bfhi(u0.z); s0 += a * a; a = bflo(u0.w); s0 += a * a; a = bfhi(u0.w); s0 += a * a; }
    float s1 = 0.f;
    if (lane < 16) {
      const uint4 u1 = ((const uint4*)cr)[64 + lane];
      float a;
      a = bflo(u1.x); s1 += a * a; a = bfhi(u1.x); s1 += a * a; a = bflo(u1.y); s1 += a * a; a = bfhi(u1.y); s1 += a * a;
      a = bflo(u1.z); s1 += a * a; a = bfhi(u1.z); s1 += a * a; a = bflo(u1.w); s1 += a * a; a = bfhi(u1.w); s1 += a * a;
    }
    const float sq = wave_sum(lane < 48 ? s0 : 0.f);
    const float skv = wave_sum((lane >= 48 ? s0 : 0.f) + s1);
    if (lane == 0) {
      rq[row] = rsqrtf(sq * (1.f / 384.f) + EPS);
      rkv[row] = rsqrtf(skv * (1.f / 256.f) + EPS);
    }
    float kr2 = 0.f;
    if (lane < 16) {
      const float x1 = __uint_as_float((unsigned)cr[640 + lane] << 16);
      const float x2 = __uint_as_float((unsigned)cr[656 + lane] << 16);
      const float2 cs = rope[tok_pos(row) * 16 + lane];
      const float o1 = x1 * cs.x - x2 * cs.y, o2 = x2 * cs.x + x1 * cs.y;
      krope[(size_t)row * 32 + lane] = f2bf(o1);
      krope[(size_t)row * 32 + 16 + lane] = f2bf(o2);
      kr2 = o1 * o1 + o2 * o2;
    }
    krmax2 = fmaxf(krmax2, wave_sum(kr2));
  }
  if (lane == 0) atomicMax((unsigned*)(p.ws + OFF_SCAL) + SC_KRMAX, __float_as_uint(sqrtf(krmax2)));
}

DI void store_tok(u16* out, int ldo, int m, int nbase, const f32x16& v, float sc) {
  u16* q = out + (size_t)m * ldo + nbase;
#pragma unroll
  for (int g = 0; g < 4; ++g) {
    uint2 u; u.x = pack2(v[4 * g] * sc, v[4 * g + 1] * sc); u.y = pack2(v[4 * g + 2] * sc, v[4 * g + 3] * sc);
    *(uint2*)(q + 8 * g) = u;
  }
}
DI void store_tr(u16* outT, size_t ldt, int n, int mbase, const f32x16& v, const float* __restrict__ rs) {
  u16* q = outT + (size_t)n * ldt + mbase;
#pragma unroll
  for (int g = 0; g < 4; ++g) {
    float4 s = make_float4(1.f, 1.f, 1.f, 1.f);
    if (rs) s = *(const float4*)(rs + mbase + 8 * g);
    uint2 u; u.x = pack2(v[4 * g] * s.x, v[4 * g + 1] * s.y); u.y = pack2(v[4 * g + 2] * s.z, v[4 * g + 3] * s.w);
    *(uint2*)(q + 8 * g) = u;
  }
}

DI void store_tok_u(u16* ub, unsigned loff, const f32x16& v, float sc) {
  char* q = (char*)ub;
  const unsigned hoff = (loff & 8u) << 1;
  const unsigned lbase = loff & ~8u;
#pragma unroll
  for (int pi = 0; pi < 2; ++pi) {
    const int g0 = 2 * pi, g1 = 2 * pi + 1;
    const unsigned a0 = cvt_pk(v[4 * g0] * sc, v[4 * g0 + 1] * sc), a1 = cvt_pk(v[4 * g0 + 2] * sc, v[4 * g0 + 3] * sc);
    const unsigned b0 = cvt_pk(v[4 * g1] * sc, v[4 * g1 + 1] * sc), b1 = cvt_pk(v[4 * g1 + 2] * sc, v[4 * g1 + 3] * sc);
    const u32x2 s0 = __builtin_amdgcn_permlane32_swap(a0, b0, false, false);
    const u32x2 s1 = __builtin_amdgcn_permlane32_swap(a1, b1, false, false);
    u32x4 u; u.x = s0.x; u.y = s1.x; u.z = s0.y; u.w = s1.y;
    *(u32x4*)(q + lbase + hoff + 32 * pi) = u;
  }
}
DI void store_tr_u(u16* ub, unsigned loff, const f32x16& v, const float* __restrict__ rs) {
  char* q = (char*)ub;
  const unsigned hoff = (loff & 8u) << 1;
  const unsigned lbase = loff & ~8u;
#pragma unroll
  for (int pi = 0; pi < 2; ++pi) {
    const int g0 = 2 * pi, g1 = 2 * pi + 1;
    float4 sa = make_float4(1.f, 1.f, 1.f, 1.f), sb = sa;
    if (rs) { sa = *(const float4*)(rs + 8 * g0); sb = *(const float4*)(rs + 8 * g1); }
    const unsigned a0 = cvt_pk(v[4 * g0] * sa.x, v[4 * g0 + 1] * sa.y), a1 = cvt_pk(v[4 * g0 + 2] * sa.z, v[4 * g0 + 3] * sa.w);
    const unsigned b0 = cvt_pk(v[4 * g1] * sb.x, v[4 * g1 + 1] * sb.y), b1 = cvt_pk(v[4 * g1 + 2] * sb.z, v[4 * g1 + 3] * sb.w);
    const u32x2 s0 = __builtin_amdgcn_permlane32_swap(a0, b0, false, false);
    const u32x2 s1 = __builtin_amdgcn_permlane32_swap(a1, b1, false, false);
    u32x4 u; u.x = s0.x; u.y = s1.x; u.z = s0.y; u.w = s1.y;
    *(u32x4*)(q + lbase + hoff + 32 * pi) = u;
  }
}

struct EpiTok {
  u16* out; int ldo;
  static constexpr int SWAPMODE = 1;
  DI bool swap(int) const { return true; }
  template <int WMB, int WNB>
  DI void store(int m0w, int n0w, f32x16 (&acc)[WMB][WNB], int r, int h, bool) const {
#pragma unroll
    for (int mb = 0; mb < WMB; ++mb)
#pragma unroll
      for (int nb = 0; nb < WNB; ++nb) store_tok_u(out + (size_t)(m0w + mb * 32) * ldo + n0w + nb * 32, (unsigned)((r * ldo + 4 * h) * 2), acc[mb][nb], 1.f);
  }
};

struct EpiProj0 {
  u16* base; unsigned* qkmax;
  static constexpr int SWAPMODE = 2;
  DI bool swap(int n0) const { const int reg = n0 >> 9; return !(reg == 2 || reg == 5); }
  template <int WMB, int WNB>
  DI void store(int m0w, int n0w, f32x16 (&acc)[WMB][WNB], int r, int h, bool) const {
    const int reg = n0w >> 9, nl = n0w & 511;
    u16* buf = base + (size_t)reg * SEG512;
    const float sc = (reg == 0 || reg == 3) ? QSCALE64 : 1.f;
#pragma unroll
    for (int mb = 0; mb < WMB; ++mb)
#pragma unroll
      for (int nb = 0; nb < WNB; ++nb) store_tok_u(buf + (size_t)(m0w + mb * 32) * 512 + nl + nb * 32, (unsigned)((r * 512 + 4 * h) * 2), acc[mb][nb], sc);
    __builtin_amdgcn_sched_barrier(0);
    if (reg == 3 || reg == 4) {
      static_assert(WNB == 2, "one head per wave tile");
      float mxn = 0.f;
#pragma unroll
      for (int mb = 0; mb < WMB; ++mb) {
        float ss = 0.f;
#pragma unroll
        for (int nb = 0; nb < WNB; ++nb)
#pragma unroll
          for (int i = 0; i < 16; ++i) { const float v = acc[mb][nb][i]; ss += v * v; }
        { const u32x2 sw = __builtin_amdgcn_permlane32_swap(__float_as_uint(ss), __float_as_uint(ss), false, false); ss = __uint_as_float(sw.x) + __uint_as_float(sw.y); }
        mxn = fmaxf(mxn, ss);
      }
      mxn = fmaxf(mxn, __int_as_float(__builtin_amdgcn_ds_swizzle(__float_as_int(mxn), (16 << 10) | 0x1f)));
      mxn = fmaxf(mxn, __int_as_float(__builtin_amdgcn_ds_swizzle(__float_as_int(mxn), (8 << 10) | 0x1f)));
      mxn = fmaxf(mxn, __int_as_float(__builtin_amdgcn_ds_swizzle(__float_as_int(mxn), (4 << 10) | 0x1f)));
      mxn = fmaxf(mxn, __int_as_float(__builtin_amdgcn_ds_swizzle(__float_as_int(mxn), (2 << 10) | 0x1f)));
      mxn = fmaxf(mxn, __int_as_float(__builtin_amdgcn_ds_swizzle(__float_as_int(mxn), (1 << 10) | 0x1f)));
      if (r == 0 && h == 0) atomicMax(qkmax + (reg - 3) * 8 + (nl >> 6), __float_as_uint(sqrtf(mxn) * sc));
    }
  }
  template <int WMB, int WNB>
  DI void store_t(int n0w, int m0w, f32x16 (&acc)[WMB][WNB], int r, int h) const {
    const int reg = n0w >> 9, nl = n0w & 511;
    u16* buf = base + (size_t)reg * SEG512;
#pragma unroll
    for (int mb = 0; mb < WMB; ++mb)
#pragma unroll
      for (int nb = 0; nb < WNB; ++nb) store_tr_u(buf + (size_t)(nl + mb * 32) * T_TOK + m0w + nb * 32, (unsigned)((r * T_TOK + 4 * h) * 2), acc[mb][nb], nullptr);
  }
};

struct EpiSwiGLU {
  u16* act;
  static constexpr int SWAPMODE = 1;
  DI bool swap(int) const { return true; }
  template <int WMB, int WNB>
  DI void store(int m0w, int n0w, f32x16 (&acc)[WMB][WNB], int r, int h, bool) const {
    static_assert(WNB == 2, "swiglu epilogue needs a 64-wide wave tile");
#pragma unroll
    for (int mb = 0; mb < WMB; ++mb) {
      char* q = (char*)(act + (size_t)(m0w + mb * 32) * DFF + (n0w >> 1)) + (unsigned)((r * DFF) * 2) + 16 * h;
#pragma unroll
      for (int pi = 0; pi < 2; ++pi) {
        unsigned pk[2][2];
#pragma unroll
        for (int gg = 0; gg < 2; ++gg) {
          const int g = 2 * pi + gg;
          float y[4];
#pragma unroll
          for (int e = 0; e < 4; ++e) {
            const float gt = acc[mb][0][4 * g + e], up = acc[mb][1][4 * g + e];
            y[e] = gt * __builtin_amdgcn_rcpf(1.f + fexp2(-LOG2E * gt)) * up;
          }
          pk[gg][0] = cvt_pk(y[0], y[1]); pk[gg][1] = cvt_pk(y[2], y[3]);
        }
        const u32x2 s0 = __builtin_amdgcn_permlane32_swap(pk[0][0], pk[1][0], false, false);
        const u32x2 s1 = __builtin_amdgcn_permlane32_swap(pk[0][1], pk[1][1], false, false);
        u32x4 u; u.x = s0.x; u.y = s1.x; u.z = s0.y; u.w = s1.y;
        *(u32x4*)(q + 32 * pi) = u;
      }
      __builtin_amdgcn_sched_barrier(0);
    }
  }
};

struct EpiUQ {
  u16* q; const float* rq; const float2* rope;
  static constexpr int SWAPMODE = 1;
  DI bool swap(int) const { return true; }
  template <int WMB, int WNB>
  DI void store(int m0w, int n0w, f32x16 (&acc)[WMB][WNB], int r, int h, bool) const {
#pragma unroll
    for (int mb = 0; mb < WMB; ++mb) {
      const int m = m0w + mb * 32 + r;
      const float sc = rq[m] * QSCALE96;
      const int pos = tok_pos(m);
#pragma unroll
      for (int nb = 0; nb < WNB; ++nb) {
        const int n0b = n0w + nb * 32;
        f32x16 v = acc[mb][nb];
#pragma unroll
        for (int i = 0; i < 16; ++i) v[i] *= sc;
        if (((n0b >> 5) % 3) == 2) {
#pragma unroll
          for (int i = 0; i < 8; ++i) {
            const int f = (i & 3) + 8 * (i >> 2) + 4 * h;
            const float2 cs = rope[pos * 16 + f];
            const float x1 = v[i], x2 = v[i + 8];
            v[i] = x1 * cs.x - x2 * cs.y;
            v[i + 8] = x2 * cs.x + x1 * cs.y;
          }
        }
        store_tok_u(q + (size_t)(m0w + mb * 32) * 1536 + n0b, (unsigned)((r * 1536 + 4 * h) * 2), v, 1.f);
        __builtin_amdgcn_sched_barrier(0);
      }
    }
  }
};

struct EpiUKV {
  u16* knope; u16* vt; const float* rkv; unsigned* kmax;
  static constexpr int SWAPMODE = 2;
  DI bool swap(int n0) const { return n0 < 1024; }
  template <int WMB, int WNB>
  DI void store(int m0w, int n0w, f32x16 (&acc)[WMB][WNB], int r, int h, bool) const {
#pragma unroll
    for (int mb = 0; mb < WMB; ++mb) {
      const int m = m0w + mb * 32 + r;
      const float sc = rkv[m];
#pragma unroll
      for (int nb = 0; nb < WNB; ++nb) store_tok_u(knope + (size_t)(m0w + mb * 32) * 1024 + n0w + nb * 32, (unsigned)((r * 1024 + 4 * h) * 2), acc[mb][nb], sc);
    }
    __builtin_amdgcn_sched_barrier(0);
    static_assert(WNB == 2, "one head per wave tile");
    float mxn = 0.f;
#pragma unroll
    for (int mb = 0; mb < WMB; ++mb) {
      float ss = 0.f;
#pragma unroll
      for (int nb = 0; nb < WNB; ++nb)
#pragma unroll
        for (int i = 0; i < 16; ++i) { const float v = acc[mb][nb][i]; ss += v * v; }
      { const u32x2 sw = __builtin_amdgcn_permlane32_swap(__float_as_uint(ss), __float_as_uint(ss), false, false); ss = __uint_as_float(sw.x) + __uint_as_float(sw.y); }
      const float sc = rkv[m0w + mb * 32 + r];
      mxn = fmaxf(mxn, ss * sc * sc);
    }
    mxn = fmaxf(mxn, __int_as_float(__builtin_amdgcn_ds_swizzle(__float_as_int(mxn), (16 << 10) | 0x1f)));
    mxn = fmaxf(mxn, __int_as_float(__builtin_amdgcn_ds_swizzle(__float_as_int(mxn), (8 << 10) | 0x1f)));
    mxn = fmaxf(mxn, __int_as_float(__builtin_amdgcn_ds_swizzle(__float_as_int(mxn), (4 << 10) | 0x1f)));
    mxn = fmaxf(mxn, __int_as_float(__builtin_amdgcn_ds_swizzle(__float_as_int(mxn), (2 << 10) | 0x1f)));
    mxn = fmaxf(mxn, __int_as_float(__builtin_amdgcn_ds_swizzle(__float_as_int(mxn), (1 << 10) | 0x1f)));
    if (r == 0 && h == 0) atomicMax(kmax + (n0w >> 6), __float_as_uint(sqrtf(mxn)));
  }
  template <int WMB, int WNB>
  DI void store_t(int n0w, int m0w, f32x16 (&acc)[WMB][WNB], int r, int h) const {
#pragma unroll
    for (int mb = 0; mb < WMB; ++mb)
#pragma unroll
      for (int nb = 0; nb < WNB; ++nb) store_tr_u(vt + (size_t)(n0w - 1024 + mb * 32) * T_TOK + m0w + nb * 32, (unsigned)((r * T_TOK + 4 * h) * 2), acc[mb][nb], rkv + m0w + nb * 32 + 4 * h);
  }
};

template <bool SWAP, int WMB, int WNB>
DI void gemm_compute(const char* la, const char* lb, f32x16 (&acc)[WMB][WNB], int wm, int wn, int r, int h) {
#pragma unroll
  for (int ks = 0; ks < 4; ++ks) {
    bf16x8 af[WMB], bfr[WNB];
#pragma unroll
    for (int mb = 0; mb < WMB; ++mb) af[mb] = *(const bf16x8*)(la + (wm * 32 * WMB + mb * 32 + r) * 144 + (ks * 2 + h) * 16);
#pragma unroll
    for (int nb = 0; nb < WNB; ++nb) bfr[nb] = *(const bf16x8*)(lb + (wn * 32 * WNB + nb * 32 + r) * 144 + (ks * 2 + h) * 16);
#pragma unroll
    for (int mb = 0; mb < WMB; ++mb)
#pragma unroll
      for (int nb = 0; nb < WNB; ++nb) {
        if (SWAP) acc[mb][nb] = MFMA32(bfr[nb], af[mb], acc[mb][nb]);
        else acc[mb][nb] = MFMA32(af[mb], bfr[nb], acc[mb][nb]);
      }
  }
}

struct TileDesc { bool valid; bool normal; int m0, n0, ldp, ldq; unsigned po, qo; const char* P; const char* Q; };

template <class Epi>
DI void gemm_phase(const u16* __restrict__ A, int lda, const u16* __restrict__ Bt, int ldb, int M, int N, int K, const Epi epi, char* lds, int bid, int nblk, const Ctx& p) {
  constexpr int WMB = 4, WNB = 2;
  constexpr int TM = 256, TN = 256;
  constexpr int STAGE = (TM + TN) * 144;
  const int tid = otid(p), lane = tid & 63, w = __builtin_amdgcn_readfirstlane(tid >> 6), wm = w >> 2, wn = w & 3, r = lane & 31, h = lane >> 5;
  const int lrow = tid >> 3, lch = tid & 7;
  const int NT = N / TN, MT = M / TM, tiles = MT * NT, nk = K >> 6;
  const int rounds = (tiles + nblk - 1) / nblk;
  auto desc = [&](int rnd) {
    TileDesc d;
    int tile = rnd * nblk + bid;
    if (nblk == 256) tile = rnd * 256 + (bid & 7) * 32 + (bid >> 3);
    d.valid = rnd < rounds && tile < tiles;
    const int grp = tile / (8 * NT), within = tile - grp * (8 * NT);
    const int nt = within >> 3, mt = grp * 8 + (within & 7);
    d.m0 = mt * TM; d.n0 = nt * TN;
    d.normal = true;
    if constexpr (Epi::SWAPMODE == 2) d.normal = epi.swap(d.n0);
    const char* Ab = (const char*)A + (size_t)d.m0 * lda * 2;
    const char* Bb = (const char*)Bt + (size_t)d.n0 * ldb * 2;
    const unsigned aoff = (unsigned)(lrow * lda * 2 + lch * 16), boff = (unsigned)(lrow * ldb * 2 + lch * 16);
    d.P = d.normal ? Ab : Bb; d.Q = d.normal ? Bb : Ab;
    d.po = d.normal ? aoff : boff; d.qo = d.normal ? boff : aoff;
    d.ldp = d.normal ? lda : ldb; d.ldq = d.normal ? ldb : lda;
    return d;
  };
  u32x4 pa[4], pb[4];
  auto issue = [&](const TileDesc& d, int kt) {
    const char* Pk = d.P + (size_t)kt * 128; asm volatile("" : "+s"(Pk));
    const char* Qk = d.Q + (size_t)kt * 128; asm volatile("" : "+s"(Qk));
#pragma unroll
    for (int j = 0; j < 4; ++j) pa[j] = *(const u32x4*)(Pk + (size_t)j * 128 * d.ldp + d.po);
#pragma unroll
    for (int j = 0; j < 4; ++j) pb[j] = *(const u32x4*)(Qk + (size_t)j * 128 * d.ldq + d.qo);
  };
  auto write_stage = [&](int b) {
    char* wa = lds + b * STAGE;
    char* wb = wa + TM * 144;
#pragma unroll
    for (int j = 0; j < 4; ++j) *(u32x4*)(wa + (lrow + 64 * j) * 144 + lch * 16) = pa[j];
#pragma unroll
    for (int j = 0; j < 4; ++j) *(u32x4*)(wb + (lrow + 64 * j) * 144 + lch * 16) = pb[j];
  };
  TileDesc cur = desc(0);
  if (!cur.valid) return;
  issue(cur, 0);
  for (int rnd = 0;; ++rnd) {
    f32x16 acc[WMB][WNB];
#pragma unroll
    for (int mb = 0; mb < WMB; ++mb)
#pragma unroll
      for (int nb = 0; nb < WNB; ++nb)
#pragma unroll
        for (int i = 0; i < 16; ++i) acc[mb][nb][i] = 0.f;
    write_stage(0);
    if (nk > 1) issue(cur, 1);
    __syncthreads();
    if (w < 4) {
      for (int kt = 0; kt < nk; ++kt) {
        const char* la = lds + (kt & 1) * STAGE;
        if (kt + 1 < nk) write_stage((kt + 1) & 1);
        if (kt + 2 < nk) issue(cur, kt + 2);
        gemm_compute<true, WMB, WNB>(la, la + TM * 144, acc, wm, wn, r, h);
        __syncthreads();
      }
    } else {
      for (int kt = 0; kt < nk; ++kt) {
        const char* la = lds + (kt & 1) * STAGE;
        gemm_compute<true, WMB, WNB>(la, la + TM * 144, acc, wm, wn, r, h);
        if (kt + 1 < nk) write_stage((kt + 1) & 1);
        if (kt + 2 < nk) issue(cur, kt + 2);
        __syncthreads();
      }
    }
    const TileDesc nxt = desc(rnd + 1);
    if (nxt.valid) issue(nxt, 0);
    __builtin_amdgcn_sched_barrier(0);
    int m0 = cur.m0, n0 = cur.n0;
    asm volatile("" : "+s"(m0), "+s"(n0));
    int r2 = r, h2 = h, wm2 = wm, wn2 = wn;
    asm volatile("" : "+v"(r2), "+v"(h2));
    asm volatile("" : "+s"(wm2), "+s"(wn2));
    if constexpr (Epi::SWAPMODE == 2) {
      if (cur.normal) epi.template store<WMB, WNB>(m0 + wm2 * 32 * WMB, n0 + wn2 * 32 * WNB, acc, r2, h2, true);
      else epi.template store_t<WMB, WNB>(n0 + wm2 * 32 * WMB, m0 + wn2 * 32 * WNB, acc, r2, h2);
    } else {
      epi.template store<WMB, WNB>(m0 + wm2 * 32 * WMB, n0 + wn2 * 32 * WNB, acc, r2, h2, true);
    }
    if (!nxt.valid) break;
    cur = nxt;
  }
}

DI void lds_st16_as2x8(char* dst, const u32x4 v) {
  u32x2 a; a.x = v.x; a.y = v.y; u32x2 b; b.x = v.z; b.y = v.w;
  *(u32x2*)dst = a;
  *(u32x2*)(dst + 8) = b;
}
DI void lds_st_vt(char* row, int ch, const u32x4 v) {
  u32x2 a; a.x = v.x; a.y = v.y; u32x2 b; b.x = v.z; b.y = v.w;
  char* g = row + (ch >> 1) * 32 + (ch & 1) * 8;
  *(u32x2*)g = a;
  *(u32x2*)(g + 16) = b;
}
constexpr int ATT_STAGE = 36864;
constexpr float DEFER_THR = 8.f;

template <int DQK>
DI void qk_scores_acc(const char* kl, const bf16x8 (&qf)[DQK / 16], f32x16 (&s)[2], int r, int h) {
  constexpr int KS = DQK * 2 + 16;
#pragma unroll
  for (int kb = 0; kb < 2; ++kb)
#pragma unroll
    for (int ks = 0; ks < DQK / 16; ++ks) {
      const bf16x8 a = *(const bf16x8*)(kl + (32 * kb + r) * KS + (2 * ks + h) * 16);
      s[kb] = MFMA32(a, qf[ks], s[kb]);
    }
}
template <int DQK>
DI void qk_scores_qlds(const char* kl, const char* qsl, f32x16 (&s)[2], int r, int h) {
  constexpr int KS = DQK * 2 + 16;
#pragma unroll
  for (int kb = 0; kb < 2; ++kb) {
#pragma unroll
    for (int ks = 0; ks < DQK / 16; ++ks) {
      const bf16x8 a = *(const bf16x8*)(kl + (32 * kb + r) * KS + (2 * ks + h) * 16);
      const bf16x8 qv = *(const bf16x8*)(qsl + ks * 1024);
      s[kb] = MFMA32(a, qv, s[kb]);
    }
  }
}
template <int DQK>
DI void qk_scores(const char* kl, const bf16x8 (&qf)[DQK / 16], const f32x16& initv, f32x16 (&s)[2], int r, int h) {
  constexpr int KS = DQK * 2 + 16;
#pragma unroll
  for (int kb = 0; kb < 2; ++kb) {
    s[kb] = initv;
#pragma unroll
    for (int ks = 0; ks < DQK / 16; ++ks) {
      const bf16x8 a = *(const bf16x8*)(kl + (32 * kb + r) * KS + (2 * ks + h) * 16);
      s[kb] = MFMA32(a, qf[ks], s[kb]);
    }
  }
}

template <int DV>
DI float softmax_pv(f32x16 (&s)[2], f32x16 (&o)[DV / 32], float& l, bool first, const char* vl, int r, int h) {
  float dret = 0.f;
  float mx = fmaxf(fmaxf(s[0][0], s[0][1]), s[0][2]);
#pragma unroll
  for (int i = 3; i < 15; i += 2) mx = fmaxf(fmaxf(mx, s[0][i]), s[0][i + 1]);
  mx = fmaxf(fmaxf(mx, s[0][15]), s[1][0]);
#pragma unroll
  for (int i = 1; i < 15; i += 2) mx = fmaxf(fmaxf(mx, s[1][i]), s[1][i + 1]);
  mx = fmaxf(mx, s[1][15]);
  const bool need = first || (mx > DEFER_THR);
  if (__any(need)) {
    mx = fmaxf(mx, __shfl_xor(mx, 32));
    float delta;
    if (first) delta = mx;
    else {
      delta = fmaxf(mx, 0.f);
      const float alpha = fexp2(-delta);
      l *= alpha;
#pragma unroll
      for (int d = 0; d < DV / 32; ++d)
#pragma unroll
        for (int i = 0; i < 16; ++i) o[d][i] *= alpha;
    }
#pragma unroll
    for (int kb = 0; kb < 2; ++kb)
#pragma unroll
      for (int i = 0; i < 16; ++i) s[kb][i] -= delta;
    dret = delta;
  }
  float ps = 0.f;
#pragma unroll
  for (int kb = 0; kb < 2; ++kb)
#pragma unroll
    for (int i = 0; i < 16; ++i) { const float e = fexp2(s[kb][i]); s[kb][i] = e; ps += e; }
  l += ps;
  bf16x8 pf[2][2];
#pragma unroll
  for (int kb = 0; kb < 2; ++kb)
#pragma unroll
    for (int st = 0; st < 2; ++st) {
      u32x4 u;
      u.x = cvt_pk(s[kb][8 * st + 0], s[kb][8 * st + 1]); u.y = cvt_pk(s[kb][8 * st + 2], s[kb][8 * st + 3]);
      u.z = cvt_pk(s[kb][8 * st + 4], s[kb][8 * st + 5]); u.w = cvt_pk(s[kb][8 * st + 6], s[kb][8 * st + 7]);
      pf[kb][st] = __builtin_bit_cast(bf16x8, u);
    }
#pragma unroll
  for (int d = 0; d < DV / 32; ++d)
#pragma unroll
    for (int kb = 0; kb < 2; ++kb)
#pragma unroll
      for (int st = 0; st < 2; ++st) {
        const u32x4 u = *(const u32x4*)(vl + (32 * d + r) * 144 + (2 * kb + st) * 32 + h * 16);
        o[d] = MFMA32(__builtin_bit_cast(bf16x8, u), pf[kb][st], o[d]);
      }
  return dret;
}

template <int DV>
DI float softmax_pre(f32x16 (&s)[2], f32x16 (&o)[DV / 32], float& l, bool first) {
  float dret = 0.f;
  float mx = fmaxf(fmaxf(s[0][0], s[0][1]), s[0][2]);
#pragma unroll
  for (int i = 3; i < 15; i += 2) mx = fmaxf(fmaxf(mx, s[0][i]), s[0][i + 1]);
  mx = fmaxf(fmaxf(mx, s[0][15]), s[1][0]);
#pragma unroll
  for (int i = 1; i < 15; i += 2) mx = fmaxf(fmaxf(mx, s[1][i]), s[1][i + 1]);
  mx = fmaxf(mx, s[1][15]);
  const bool need = first || (mx > DEFER_THR);
  if (__any(need)) {
    mx = fmaxf(mx, __shfl_xor(mx, 32));
    float delta;
    if (first) delta = mx;
    else {
      delta = fmaxf(mx, 0.f);
      const float alpha = fexp2(-delta);
      l *= alpha;
#pragma unroll
      for (int d = 0; d < DV / 32; ++d)
#pragma unroll
        for (int i = 0; i < 16; ++i) o[d][i] *= alpha;
    }
#pragma unroll
    for (int kb = 0; kb < 2; ++kb)
#pragma unroll
      for (int i = 0; i < 16; ++i) s[kb][i] -= delta;
    dret = delta;
  }
  return dret;
}
DI void softmax_exp_half(f32x16& s, float& l, bf16x8 (&pf)[2]) {
  float ps = 0.f;
#pragma unroll
  for (int i = 0; i < 16; ++i) { const float e = fexp2(s[i]); s[i] = e; ps += e; }
  l += ps;
#pragma unroll
  for (int st = 0; st < 2; ++st) {
    u32x4 u;
    u.x = cvt_pk(s[8 * st + 0], s[8 * st + 1]); u.y = cvt_pk(s[8 * st + 2], s[8 * st + 3]);
    u.z = cvt_pk(s[8 * st + 4], s[8 * st + 5]); u.w = cvt_pk(s[8 * st + 6], s[8 * st + 7]);
    pf[st] = __builtin_bit_cast(bf16x8, u);
  }
}
template <int DV>
DI void pv_half(const bf16x8 (&pf)[2], f32x16 (&o)[DV / 32], const char* vl, int kb, int r, int h) {
#pragma unroll
  for (int d = 0; d < DV / 32; ++d)
#pragma unroll
    for (int st = 0; st < 2; ++st) {
      const u32x4 u = *(const u32x4*)(vl + (32 * d + r) * 144 + (2 * kb + st) * 32 + h * 16);
      o[d] = MFMA32(__builtin_bit_cast(bf16x8, u), pf[st], o[d]);
    }
}

template <int ABL>
DI void attn_mla_item(const Ctx& p, int item, char* lds) {
  constexpr int DQK = 96, DV = 64, KS = DQK * 2 + 16;
  const int tid = otid(p), lane = tid & 63, w = tid >> 6, r = lane & 31, h = lane >> 5;
  int head, qb, ts0, S;
  if (item < 1024) { head = item >> 6; qb = item & 63; ts0 = T_PROMPT; S = 16384; }
  else { const int it = item - 1024; qb = it & 15; head = (it >> 4) & 15; ts0 = (it >> 8) * 4096; S = 4096; }
  const u16* q = (const u16*)(p.ws + OFF_R2);
  const u16* knope = q + (size_t)T_TOK * 1536;
  const u16* vt = knope + (size_t)T_TOK * 1024;
  const u16* krope = (const u16*)(p.ws + OFF_KROPE);
  u16* o1 = (u16*)(p.ws + OFF_R1);
  const int tq = ts0 + qb * 256 + w * 32 + r;
  bf16x8 qf[DQK / 16];
#pragma unroll
  for (int ks = 0; ks < DQK / 16; ++ks) qf[ks] = *(const bf16x8*)(q + (size_t)tq * 1536 + head * 96 + 16 * ks + 8 * h);
  f32x16 o[DV / 32];
#pragma unroll
  for (int d = 0; d < DV / 32; ++d)
#pragma unroll
    for (int i = 0; i < 16; ++i) o[d][i] = 0.f;
  f32x16 initv;
#pragma unroll
  for (int i = 0; i < 16; ++i) initv[i] = 0.f;
  float l = 0.f;
  u32x4 pk0, pk1, pv0;
  const int c1 = 512 + tid;
  const int krow0 = tid / 12, kch0 = tid - krow0 * 12;
  const int krow1 = c1 / 12, kch1 = c1 - krow1 * 12;
  const int vrow = tid >> 3, vch = tid & 7;
  const int nkt = S >> 6;
  auto prefetch = [&](int kt) {
    const int tk0 = ts0 + kt * 64;
    {
      const u16* src = kch0 < 8 ? knope + (size_t)(tk0 + krow0) * 1024 + head * 64 + kch0 * 8 : krope + (size_t)(tk0 + krow0) * 32 + (kch0 - 8) * 8;
      pk0 = *(const u32x4*)src;
    }
    if (tid < 256) {
      const u16* src = kch1 < 8 ? knope + (size_t)(tk0 + krow1) * 1024 + head * 64 + kch1 * 8 : krope + (size_t)(tk0 + krow1) * 32 + (kch1 - 8) * 8;
      pk1 = *(const u32x4*)src;
    }
    pv0 = *(const u32x4*)(vt + (size_t)(head * 64 + vrow) * T_TOK + tk0 + vch * 8);
  };
  auto stage_at = [&](int boff) {
    char* kl = lds + boff;
    char* vl = kl + 64 * KS;
    *(u32x4*)(kl + krow0 * KS + kch0 * 16) = pk0;
    if (tid < 256) *(u32x4*)(kl + krow1 * KS + kch1 * 16) = pk1;
    lds_st_vt(vl + vrow * 144, vch, pv0);
  };
  prefetch(0);
  __syncthreads();
  stage_at(0);
  prefetch(1);
  stage_at(ATT_STAGE);
  if (nkt > 2) prefetch(2);
  __syncthreads();
  int cur = 0, nxt = ATT_STAGE, nn = 2 * ATT_STAGE;
  f32x16 s[2];
  qk_scores<DQK>(lds, qf, initv, s, r, h);
#pragma unroll 1
  for (int kt = 0; kt < nkt; ++kt) {
    if (ABL == 2) { __syncthreads(); if (kt + 2 < nkt) stage_at(nn); if (kt + 3 < nkt) prefetch(kt + 3); { const int t = cur; cur = nxt; nxt = nn; nn = t; } continue; }
    const float dl = softmax_pre<DV>(s, o, l, kt == 0);
    if (__any(dl != 0.f)) {
#pragma unroll
      for (int i = 0; i < 16; ++i) initv[i] -= dl;
    }
    f32x16 sn[2];
    qk_scores<DQK>(lds + nxt, qf, initv, sn, r, h);
#pragma unroll
    for (int kb = 0; kb < 2; ++kb) {
      bf16x8 pf[2];
      softmax_exp_half(s[kb], l, pf);
      pv_half<DV>(pf, o, lds + cur + 64 * KS, kb, r, h);
    }
    if (ABL != 1) { if (kt + 2 < nkt) stage_at(nn);
    if (kt + 3 < nkt) prefetch(kt + 3); }
    __syncthreads();
    s[0] = sn[0]; s[1] = sn[1];
    const int t = cur; cur = nxt; nxt = nn; nn = t;
  }
  l += __shfl_xor(l, 32);
  const float inv = 1.f / l;
#pragma unroll
  for (int d = 0; d < DV / 32; ++d) store_tok(o1, 1024, tq, head * 64 + 32 * d + 4 * h, o[d], inv);
}

DI void attn_mla_item2(const Ctx& p, int item, char* lds) {
  constexpr int DQK = 96, DV = 64, KS = DQK * 2 + 16;
  const int tid = otid(p), lane = tid & 63, w = tid >> 6, r = lane & 31, h = lane >> 5;
  int head, qb, ts0, S;
  if (item < 512) { head = item >> 5; qb = item & 31; ts0 = T_PROMPT; S = 16384; }
  else { const int it = item - 512; qb = it & 7; head = (it >> 3) & 15; ts0 = (it >> 7) * 4096; S = 4096; }
  const u16* q = (const u16*)(p.ws + OFF_R2);
  const u16* knope = q + (size_t)T_TOK * 1536;
  const u16* vt = knope + (size_t)T_TOK * 1024;
  const u16* krope = (const u16*)(p.ws + OFF_KROPE);
  u16* o1 = (u16*)(p.ws + OFF_R1);
  const int tq0 = ts0 + qb * 512 + w * 64 + r;
  char* qsl = lds + 49152 + w * 12288 + lane * 16;
  __syncthreads();
  float qn2[2] = {0.f, 0.f};
#pragma unroll
  for (int j = 0; j < 2; ++j)
#pragma unroll
    for (int ks = 0; ks < DQK / 16; ++ks) {
      const u32x4 qv = *(const u32x4*)(q + (size_t)(tq0 + 32 * j) * 1536 + head * 96 + 16 * ks + 8 * h);
      *(u32x4*)(qsl + (j * 6 + ks) * 1024) = qv;
      float a;
      a = bflo(qv.x); qn2[j] += a * a; a = bfhi(qv.x); qn2[j] += a * a; a = bflo(qv.y); qn2[j] += a * a; a = bfhi(qv.y); qn2[j] += a * a;
      a = bflo(qv.z); qn2[j] += a * a; a = bfhi(qv.z); qn2[j] += a * a; a = bflo(qv.w); qn2[j] += a * a; a = bfhi(qv.w); qn2[j] += a * a;
    }
  float ref[2];
  {
    float kn2 = 0.f;
#pragma unroll
    for (int t = 0; t < 8; ++t) { const float v = __uint_as_float(((const unsigned*)(p.ws + OFF_SCAL))[SC_KP + head * 8 + t]); kn2 += v * v; }
    const float kr = __uint_as_float(((const unsigned*)(p.ws + OFF_SCAL))[SC_KRMAX]);
    const float kmaxn = sqrtf(kn2 + kr * kr);
#pragma unroll
    for (int j = 0; j < 2; ++j) {
      qn2[j] += __shfl_xor(qn2[j], 32);
      ref[j] = sqrtf(qn2[j]) * kmaxn * 1.02f + 0.5f;
    }
  }
  const bool fixedref = !__any(ref[0] > 60.f || ref[1] > 60.f);
  f32x16 o[2][DV / 32];
  f32x16 initv[2];
#pragma unroll
  for (int j = 0; j < 2; ++j) {
#pragma unroll
    for (int d = 0; d < DV / 32; ++d)
#pragma unroll
      for (int i = 0; i < 16; ++i) o[j][d][i] = 0.f;
#pragma unroll
    for (int i = 0; i < 16; ++i) initv[j][i] = fixedref ? -ref[j] : 0.f;
  }
  float l[2] = {0.f, 0.f};
  u32x4 pk0, pk1, pv0;
  const int c1 = 512 + (tid & 255);
  const int krow0 = tid / 12, kch0 = tid - krow0 * 12;
  const int krow1 = c1 / 12, kch1 = c1 - krow1 * 12;
  const int vrow = tid >> 3, vch = tid & 7;
  const int nkt = S >> 6;
  auto prefetch = [&](int kt) {
    const int tk0 = ts0 + kt * 64;
    {
      const u16* src = kch0 < 8 ? knope + (size_t)(tk0 + krow0) * 1024 + head * 64 + kch0 * 8 : krope + (size_t)(tk0 + krow0) * 32 + (kch0 - 8) * 8;
      pk0 = *(const u32x4*)src;
    }
    {
      const u16* src = kch1 < 8 ? knope + (size_t)(tk0 + krow1) * 1024 + head * 64 + kch1 * 8 : krope + (size_t)(tk0 + krow1) * 32 + (kch1 - 8) * 8;
      pk1 = *(const u32x4*)src;
    }
    pv0 = *(const u32x4*)(vt + (size_t)(head * 64 + vrow) * T_TOK + tk0 + vch * 8);
  };
  auto stage_at = [&](int boff) {
    char* kl = lds + boff;
    char* vl = kl + 64 * KS;
    *(u32x4*)(kl + krow0 * KS + kch0 * 16) = pk0;
    *(u32x4*)(kl + krow1 * KS + kch1 * 16) = pk1;
    lds_st_vt(vl + vrow * 144, vch, pv0);
  };
  prefetch(0);
  stage_at(0);
  prefetch(1);
  __syncthreads();
#pragma unroll 1
  for (int kt = 0; kt < nkt; ++kt) {
    const char* kl = lds + (kt & 1) * 24576;
    const char* vl = kl + 64 * KS;
    if (kt + 1 < nkt) stage_at(((kt + 1) & 1) * 24576);
    if (kt + 2 < nkt) prefetch(kt + 2);
    f32x16 s[2][2];
#pragma unroll
    for (int kb = 0; kb < 2; ++kb) {
      s[0][kb] = initv[0]; s[1][kb] = initv[1];
#pragma unroll
      for (int ks = 0; ks < DQK / 16; ++ks) {
        const bf16x8 a = *(const bf16x8*)(kl + (32 * kb + r) * KS + (2 * ks + h) * 16);
        const bf16x8 q0 = *(const bf16x8*)(qsl + ks * 1024);
        const bf16x8 q1 = *(const bf16x8*)(qsl + (6 + ks) * 1024);
        s[0][kb] = MFMA32(a, q0, s[0][kb]);
        s[1][kb] = MFMA32(a, q1, s[1][kb]);
      }
    }
    if (!fixedref) {
#pragma unroll
      for (int j = 0; j < 2; ++j) {
        const float dl = softmax_pre<DV>(s[j], o[j], l[j], kt == 0);
        if (__any(dl != 0.f)) {
#pragma unroll
          for (int i = 0; i < 16; ++i) initv[j][i] -= dl;
        }
      }
    }
#pragma unroll
    for (int kb = 0; kb < 2; ++kb) {
      bf16x8 pf0[2], pf1[2];
      softmax_exp_half(s[0][kb], l[0], pf0);
      softmax_exp_half(s[1][kb], l[1], pf1);
#pragma unroll
      for (int d = 0; d < DV / 32; ++d)
#pragma unroll
        for (int st = 0; st < 2; ++st) {
          const u32x4 u = *(const u32x4*)(vl + (32 * d + r) * 144 + (2 * kb + st) * 32 + h * 16);
          const bf16x8 vf = __builtin_bit_cast(bf16x8, u);
          o[0][d] = MFMA32(vf, pf0[st], o[0][d]);
          o[1][d] = MFMA32(vf, pf1[st], o[1][d]);
        }
    }
    __syncthreads();
  }
  int tid2 = otid(p);
  const int lane2 = tid2 & 63, h2 = lane2 >> 5, w2 = tid2 >> 6;
  int item2 = item; asm volatile("" : "+s"(item2));
  int head2, tq2;
  if (item2 < 512) { head2 = item2 >> 5; tq2 = T_PROMPT + (item2 & 31) * 512 + w2 * 64 + (lane2 & 31); }
  else { const int it = item2 - 512; head2 = (it >> 3) & 15; tq2 = (it >> 7) * 4096 + (it & 7) * 512 + w2 * 64 + (lane2 & 31); }
#pragma unroll
  for (int j = 0; j < 2; ++j) {
    float lj = l[j];
    lj += __shfl_xor(lj, 32);
    const float inv = __builtin_amdgcn_rcpf(lj);
#pragma unroll
    for (int d = 0; d < DV / 32; ++d) store_tok(o1, 1024, tq2 + 32 * j, head2 * 64 + 32 * d + 4 * h2, o[j][d], inv);
  }
}

DI void diff_decode(int item, int& hh, int& qb, int& ts0, int& S) {
  int j;
  if (item < 128) { hh = 3; j = item; S = 16384; }
  else if (item < 256) { hh = 2; j = item - 128; S = 16384; }
  else if (item < 768) { hh = 3; j = item - 256; S = 4096; }
  else if (item < 1280) { hh = 2; j = item - 768; S = 4096; }
  else if (item < 1408) { hh = 1; j = item - 1280; S = 16384; }
  else if (item < 1920) { hh = 1; j = item - 1408; S = 4096; }
  else if (item < 2048) { hh = 0; j = item - 1920; S = 16384; }
  else { hh = 0; j = item - 2048; S = 4096; }
  if (S == 16384) { qb = j; ts0 = T_PROMPT; } else { qb = j & 31; ts0 = (j >> 5) * 4096; }
}
DI void attn_diff_item(const Ctx& p, int item, char* lds) {
  constexpr int DQK = 64, DV = 128, KS = DQK * 2 + 16;
  const int tid = otid(p), lane = tid & 63, w = tid >> 6, r = lane & 31, h = lane >> 5;
  const int map = w >> 2, qw = w & 3;
  int hh, qb, ts0, S;
  diff_decode(item, hh, qb, ts0, S);
  const u16* base = (const u16*)(p.ws + OFF_R2);
  const u16* dq = base + 2 * SEG512;
  const u16* dk = base + 3 * SEG512;
  const u16* vtd = base + 5 * SEG512;
  u16* o0 = (u16*)(p.ws + OFF_R1);
  const int qpos = qb * 128 + qw * 32 + r;
  const int tq = ts0 + qpos;
  __syncthreads();
  float qn2 = 0.f;
  bf16x8 qf[DQK / 16];
#pragma unroll
  for (int ks = 0; ks < DQK / 16; ++ks) {
    const u32x4 qv = *(const u32x4*)(dq + (size_t)tq * 512 + (2 * hh + map) * 64 + 16 * ks + 8 * h);
    qf[ks] = __builtin_bit_cast(bf16x8, qv);
    float a;
    a = bflo(qv.x); qn2 += a * a; a = bfhi(qv.x); qn2 += a * a; a = bflo(qv.y); qn2 += a * a; a = bfhi(qv.y); qn2 += a * a;
    a = bflo(qv.z); qn2 += a * a; a = bfhi(qv.z); qn2 += a * a; a = bflo(qv.w); qn2 += a * a; a = bfhi(qv.w); qn2 += a * a;
  }
  qn2 += __shfl_xor(qn2, 32);
  f32x16 o[DV / 32];
#pragma unroll
  for (int d = 0; d < DV / 32; ++d)
#pragma unroll
    for (int i = 0; i < 16; ++i) o[d][i] = 0.f;
  float l = 0.f;
  const float refb = sqrtf(qn2) * __uint_as_float(((const unsigned*)(p.ws + OFF_SCAL))[SC_QKMAX + 8 + 2 * hh + map]) * 1.02f + 0.5f;
  const bool fixedref = !__any(refb > 60.f);
  float ref = fixedref ? refb : 0.f;
  const float slope2 = exp2f(-2.f * (float)(hh + 1)) * LOG2E;
  const float cq = slope2 * (float)qpos;
  const int d0 = 2 * qb;
  const int kd = d0 + (qw >> 1);
  int kt_lo, kt_hi;
  {
    const unsigned* qk = (const unsigned*)(p.ws + OFF_SCAL) + SC_QKMAX;
    const float b0 = __uint_as_float(qk[2 * hh]) * __uint_as_float(qk[8 + 2 * hh]);
    const float b1 = __uint_as_float(qk[2 * hh + 1]) * __uint_as_float(qk[8 + 2 * hh + 1]);
    const float B = fmaxf(b0, b1) * 1.02f + 0.5f;
    const float dskip = fminf((2.f * B + 34.f) / slope2 + 1.f, 1.0e6f);
    const int q_lo = qb * 128, q_hi = q_lo + 127, ds = (int)dskip;
    kt_lo = max(0, (q_lo - 63 - ds) >> 6);
    kt_hi = min((S >> 6) - 1, (q_hi + ds) >> 6);
    kt_lo = min(kt_lo, 2 * qb); kt_hi = max(kt_hi, 2 * qb + 1);
  }
  const int nleft = d0 - kt_lo;
  const int nkt = kt_hi - kt_lo + 1;
  u32x4 pk[2], pv[2];
  const int lrow = tid >> 3, lch = tid & 7;
  auto tile_of = [&](int idx) { return idx < 2 ? d0 + idx : (idx - 2 < nleft ? d0 - 1 - (idx - 2) : idx + kt_lo); };
  const unsigned koff = (unsigned)(((ts0 + lrow) * 512 + 2 * hh * 64 + lch * 8) * 2);
  const unsigned voff = (unsigned)((((hh * 128 + lrow) * T_TOK) + ts0 + lch * 8) * 2);
  const char* dkb = (const char*)dk;
  const char* vtb = (const char*)vtd;
  auto prefetch = [&](int kt) {
    const unsigned ko = koff + (unsigned)kt * (64u * 512u * 2u);
    const unsigned vo = voff + (unsigned)kt * 128u;
    pk[0] = *(const u32x4*)(dkb + ko);
    pk[1] = *(const u32x4*)(dkb + ko + 128u);
    pv[0] = *(const u32x4*)(vtb + vo);
    pv[1] = *(const u32x4*)(vtb + vo + (unsigned)(64 * T_TOK * 2));
  };
  auto stage_at = [&](int boff) {
    char* kl0 = lds + boff;
    char* vl = kl0 + 2 * 64 * KS;
#pragma unroll
    for (int j = 0; j < 2; ++j) *(u32x4*)(kl0 + j * 64 * KS + lrow * KS + lch * 16) = pk[j];
#pragma unroll
    for (int j = 0; j < 2; ++j) lds_st_vt(vl + (lrow + 64 * j) * 144, lch, pv[j]);
  };
  auto scores = [&](int kt, int boff, f32x16 (&sc)[2]) {
    const int side = kt < kd ? -1 : (kt > kd ? 1 : 0);
    const float I = (float)side * cq - ref;
    const unsigned i_hi = cvt_pk(I, 0.f) & 0xffffu;
    const float ir1 = I - __uint_as_float(i_hi << 16);
    const unsigned i_mid = cvt_pk(ir1, 0.f) & 0xffffu;
    const float ir2 = ir1 - __uint_as_float(i_mid << 16);
    const unsigned i_lo = cvt_pk(ir2, 0.f) & 0xffffu;
    const float T = slope2 * (float)(kt * 64);
    const unsigned t_hi = cvt_pk(T, 0.f) & 0xffffu;
    const float r1 = T - __uint_as_float(t_hi << 16);
    const unsigned t_mid = cvt_pk(r1, 0.f) & 0xffffu;
    const float r2 = r1 - __uint_as_float(t_mid << 16);
    const unsigned t_lo = cvt_pk(r2, 0.f) & 0xffffu;
    const unsigned one = side < 0 ? 0x3F80u : (side > 0 ? 0xBF80u : 0u);
    u32x4 qa;
    qa.x = h == 0 ? (one | (one << 16)) : 0u; qa.y = qa.x; qa.z = h == 0 ? (one | (i_hi << 16)) : 0u; qa.w = h == 0 ? (i_mid | (i_lo << 16)) : 0u;
    const bf16x8 qaug = __builtin_bit_cast(bf16x8, qa);
#pragma unroll
    for (int kb = 0; kb < 2; ++kb) {
      const float xl = slope2 * (float)(32 * kb + r);
      const unsigned l_hi = cvt_pk(xl, 0.f) & 0xffffu;
      const unsigned l_lo = cvt_pk(xl - __uint_as_float(l_hi << 16), 0.f) & 0xffffu;
      u32x4 ka; ka.x = h == 0 ? (l_hi | (l_lo << 16)) : 0u; ka.y = h == 0 ? (t_hi | (t_mid << 16)) : 0u; ka.z = h == 0 ? (t_lo | 0x3F800000u) : 0u; ka.w = h == 0 ? 0x3F803F80u : 0u;
      f32x16 z;
#pragma unroll
      for (int i = 0; i < 16; ++i) z[i] = 0.f;
      sc[kb] = MFMA32(__builtin_bit_cast(bf16x8, ka), qaug, z);
    }
    qk_scores_acc<DQK>(lds + boff + map * 64 * KS, qf, sc, r, h);
  };
  prefetch(tile_of(0));
  __syncthreads();
  stage_at(0);
  prefetch(tile_of(1));
  __syncthreads();
#pragma unroll 1
  for (int idx = 0; idx < nkt; ++idx) {
    const int kt = tile_of(idx);
    const int cur = (idx & 1) * ATT_STAGE;
    if (idx + 1 < nkt) stage_at(((idx + 1) & 1) * ATT_STAGE);
    if (idx + 2 < nkt) prefetch(tile_of(idx + 2));
    f32x16 s[2];
    scores(kt, cur, s);
    if (kt == kd) {
#pragma unroll
      for (int kb = 0; kb < 2; ++kb)
#pragma unroll
        for (int i = 0; i < 16; ++i) {
          const int kp = kt * 64 + 32 * kb + (i & 3) + 8 * (i >> 2) + 4 * h;
          s[kb][i] -= slope2 * fabsf((float)(qpos - kp));
        }
    }
    if (!fixedref) ref += softmax_pre<DV>(s, o, l, idx == 0);
#pragma unroll
    for (int kb = 0; kb < 2; ++kb) {
      bf16x8 pf[2];
      softmax_exp_half(s[kb], l, pf);
      pv_half<DV>(pf, o, lds + cur + 2 * 64 * KS, kb, r, h);
    }
    __syncthreads();
  }
  l += __shfl_xor(l, 32);
  const float inv = 1.f / l;
  int tid2 = otid(p);
  const int lane2 = tid2 & 63, qw2 = (tid2 >> 6) & 3, h2 = lane2 >> 5;
  int item2 = item; asm volatile("" : "+s"(item2));
  int hh2, tq2;
  { int qb2, ts02, S2; diff_decode(item2, hh2, qb2, ts02, S2); tq2 = ts02 + qb2 * 128 + qw2 * 32 + (lane2 & 31); }
  float* ex = (float*)lds + qw2 * 4096;
  if (map == 1) {
#pragma unroll
    for (int d = 0; d < DV / 32; ++d)
#pragma unroll
      for (int i = 0; i < 16; ++i) ex[(d * 16 + i) * 64 + lane2] = o[d][i] * inv;
  }
  __syncthreads();
  if (map == 0) {
    const float lam = ((const float*)(p.ws + OFF_SCAL))[0];
    float ss = 0.f;
#pragma unroll
    for (int d = 0; d < DV / 32; ++d)
#pragma unroll
      for (int i = 0; i < 16; ++i) { const float v = o[d][i] * inv - lam * ex[(d * 16 + i) * 64 + lane2]; o[d][i] = v; ss += v * v; }
    ss += __shfl_xor(ss, 32);
    const float rn = rsqrtf(ss * (1.f / 128.f) + EPS) * 0.8f;
    const float* gs = (const float*)(p.ws + OFF_SCAL) + SC_GSUB;
#pragma unroll
    for (int d = 0; d < DV / 32; ++d) {
#pragma unroll
      for (int g = 0; g < 4; ++g) {
        const float4 gv = *(const float4*)(gs + 32 * d + 8 * g + 4 * h2);
        o[d][4 * g] *= gv.x; o[d][4 * g + 1] *= gv.y; o[d][4 * g + 2] *= gv.z; o[d][4 * g + 3] *= gv.w;
      }
      store_tok(o0, 1024, tq2, 512 + hh2 * 128 + 32 * d + 4 * h2, o[d], rn);
    }
  }
}

DI void attn_na_item(const Ctx& p, int item, char* lds) {
  constexpr int DQK = 64, DV = 64, KS = DQK * 2 + 16;
  const int tid = otid(p), lane = tid & 63, w = tid >> 6, r = lane & 31, h = lane >> 5;
  const int quad = item % 320, head = item / 320;
  const int t0 = quad * 256;
  int ts0, rows;
  if (t0 < T_PROMPT) { ts0 = t0 & ~4095; rows = 64; } else { ts0 = T_PROMPT; rows = 256; }
  const int r0 = (t0 - ts0) >> 6;
  const int rw = r0 + (w >> 1);
  const int rs_lo = min(max(r0 - 4, 0), rows - 8);
  const int rs_hi = min(max(r0 + 3 - 4, 0), rows - 8);
  const int rs_w = min(max(rw - 4, 0), rows - 8);
  const int ntile = rs_hi + 8 - rs_lo;
  const u16* base = (const u16*)(p.ws + OFF_R2);
  const u16* qn = base;
  const u16* kn = base + SEG512;
  const u16* vtn = base + 4 * SEG512;
  u16* o0 = (u16*)(p.ws + OFF_R1);
  float* tab = (float*)(lds + 2 * ATT_STAGE) + 64;
  const int qc = (w & 1) * 32 + r;
  const int tq = t0 + w * 32 + r;
  bf16x8 qf[DQK / 16];
#pragma unroll
  for (int ks = 0; ks < DQK / 16; ++ks) qf[ks] = *(const bf16x8*)(qn + (size_t)tq * 512 + head * 64 + 16 * ks + 8 * h);
  f32x16 o[DV / 32];
#pragma unroll
  for (int d = 0; d < DV / 32; ++d)
#pragma unroll
    for (int i = 0; i < 16; ++i) o[d][i] = 0.f;
  f32x16 initv;
#pragma unroll
  for (int i = 0; i < 16; ++i) initv[i] = 0.f;
  float l = 0.f;
  bool first = true;
  u32x4 pk0, pv0;
  const int lrow = tid >> 3, lch = tid & 7;
  auto prefetch = [&](int j) {
    const int tk0 = ts0 + (rs_lo + j) * 64;
    pk0 = *(const u32x4*)(kn + (size_t)(tk0 + lrow) * 512 + head * 64 + lch * 8);
    pv0 = *(const u32x4*)(vtn + (size_t)(head * 64 + lrow) * T_TOK + tk0 + lch * 8);
  };
  auto stage = [&](int b) {
    char* kl = lds + b * ATT_STAGE;
    char* vl = kl + 64 * KS;
    *(u32x4*)(kl + lrow * KS + lch * 16) = pk0;
    lds_st_vt(vl + lrow * 144, lch, pv0);
  };
  prefetch(0);
  __syncthreads();
  if (tid < 465) tab[tid] = ((const float*)(p.ws + OFF_SCAL))[SC_RPB + head * 465 + tid];
  stage(0);
  prefetch(1);
  __syncthreads();
  const int wc0 = min(max(qc - 8, 0), 48);
  const float* tabq = tab + (15 - qc + 4 * h);
  for (int j = 0; j < ntile; ++j) {
    const char* kl = lds + (j & 1) * ATT_STAGE;
    const char* vl = kl + 64 * KS;
    const int kr = rs_lo + j;
    if (kr >= rs_w && kr < rs_w + 8) {
      f32x16 s[2];
      qk_scores<DQK>(kl, qf, initv, s, r, h);
      const int ridx = kr - rw + 7;
#pragma unroll
      for (int kb = 0; kb < 2; ++kb)
#pragma unroll
        for (int i = 0; i < 16; ++i) {
          const int kc = 32 * kb + (i & 3) + 8 * (i >> 2) + 4 * h;
          const bool ok = (unsigned)(kc - wc0) < 16u;
          float b = tabq[ridx * 31 + 32 * kb + (i & 3) + 8 * (i >> 2)];
          asm volatile("" : "+v"(b));
          s[kb][i] = ok ? s[kb][i] + b : -INFINITY;
        }
      {
        const float dl = softmax_pv<DV>(s, o, l, first, vl, r, h);
        if (__any(dl != 0.f)) {
#pragma unroll
          for (int i = 0; i < 16; ++i) initv[i] -= dl;
        }
      }
      first = false;
    }
    if (j + 1 < ntile) stage((j + 1) & 1);
    if (j + 2 < ntile) prefetch(j + 2);
    __syncthreads();
  }
  l += __shfl_xor(l, 32);
  const float inv = 1.f / l;
#pragma unroll
  for (int d = 0; d < DV / 32; ++d) store_tok(o0, 1024, tq, head * 64 + 32 * d + 4 * h, o[d], inv);
}

DI void phase_qk_norms(const Ctx& p) {
  const int tid_ = otid(p);
  const int lane = tid_ & 63;
  const int gw = obid() * 8 + (tid_ >> 6), nw = gridDim.x * 8;
  const u16* dq = (const u16*)(p.ws + OFF_R2) + 2 * SEG512;
  const u16* dk = (const u16*)(p.ws + OFF_R2) + 3 * SEG512;
  float mq = 0.f, mk = 0.f;
  for (int row = gw; row < T_TOK; row += nw) {
    const uint4 a = ((const uint4*)(dq + (size_t)row * 512))[lane];
    const uint4 b = ((const uint4*)(dk + (size_t)row * 512))[lane];
    float sa = 0.f, sb = 0.f, t;
    t = bflo(a.x); sa += t * t; t = bfhi(a.x); sa += t * t; t = bflo(a.y); sa += t * t; t = bfhi(a.y); sa += t * t;
    t = bflo(a.z); sa += t * t; t = bfhi(a.z); sa += t * t; t = bflo(a.w); sa += t * t; t = bfhi(a.w); sa += t * t;
    t = bflo(b.x); sb += t * t; t = bfhi(b.x); sb += t * t; t = bflo(b.y); sb += t * t; t = bfhi(b.y); sb += t * t;
    t = bflo(b.z); sb += t * t; t = bfhi(b.z); sb += t * t; t = bflo(b.w); sb += t * t; t = bfhi(b.w); sb += t * t;
#pragma unroll
    for (int o = 1; o < 8; o <<= 1) { sa += __shfl_xor(sa, o); sb += __shfl_xor(sb, o); }
    mq = fmaxf(mq, sa); mk = fmaxf(mk, sb);
  }
  if ((lane & 7) == 0) {
    unsigned* qk = (unsigned*)(p.ws + OFF_SCAL) + SC_QKMAX;
    atomicMax(qk + (lane >> 3), __float_as_uint(sqrtf(mq)));
    atomicMax(qk + 8 + (lane >> 3), __float_as_uint(sqrtf(mk)));
  }
}

namespace pg8 {
#define PG8_LAS __attribute__((address_space(3)))
typedef unsigned short bf16_t;
typedef short bf16x8 __attribute__((ext_vector_type(8)));
typedef float f32x4 __attribute__((ext_vector_type(4)));
typedef unsigned u32x4 __attribute__((ext_vector_type(4)));
constexpr int BM = 256, BK = 64, HALF = 128, HTB = HALF * BK * 2  , STAGE_BYTES = 8 * HTB, NXCD = 8, WGM = 8;

__host__ __device__ __forceinline__ int lds_byte(int r, int c) { const int st = (r >> 4) * 2 + (c >> 5), rr = r & 15, cc = c & 31, ob = rr * 64 + cc * 2; return st * 1024 + (ob ^ (((ob >> 9) & 1) << 5)); }
__host__ __device__ __forceinline__ void stage_rc(int b, int& R, int& C) { const int st = b / 1024, sb = b % 1024, swz = sb ^ (((sb >> 9) & 1) << 5); R = (st >> 1) * 16 + swz / 64; C = (st & 1) * 32 + (swz % 64) / 2; }
__host__ __device__ __forceinline__ int perm32(int rho) { const int n = rho >> 4, i = rho & 15; return 8 * (i >> 2) + 4 * n + (i & 3); }

struct Unit { int pm, pn; };
struct Gemm { const bf16_t* A; const bf16_t* Bt; int M, N, K; int lda, ldb; };

struct StaticOrder {
    int nM, nN, nwg, G, c;
    __host__ __device__ void init(int M, int N, int G_, int c_) { nM = M / BM; nN = N / BM; nwg = nM * nN; G = G_; c = c_; }
    __host__ __device__ bool next(int i, Unit& u) const {
        const long L = (long)i * G + c; if (L >= nwg) return false;
        int wgid = (int)L; { const int q = nwg / NXCD, r = nwg % NXCD, xcd = wgid % NXCD, off = wgid / NXCD; wgid = (xcd < r ? xcd * (q + 1) : r * (q + 1) + (xcd - r) * q) + off; }
        const int nig = WGM * nN, gid = wgid / nig, fm = gid * WGM, gsz = (nM - fm) < WGM ? (nM - fm) : WGM;
        u.pm = fm + ((wgid % nig) % gsz); u.pn = (wgid % nig) / gsz; return true;
    }
    __device__ __forceinline__ void a_ready(const Unit&) const {}
    __device__ __forceinline__ void done(const Unit&) const {}
};
struct CountedOrder : StaticOrder {
    const unsigned* ready; unsigned need; unsigned* tmo;
    __device__ __forceinline__ void a_ready(const Unit& u) const {
        if (threadIdx.x < 64) {
            const unsigned long long t0 = __builtin_amdgcn_s_memrealtime(); unsigned polls = 0;
            while ((unsigned)__builtin_amdgcn_readfirstlane(__hip_atomic_load(ready + 64 * u.pm, __ATOMIC_RELAXED, __HIP_MEMORY_SCOPE_AGENT)) < need) {
                if ((++polls & 255u) == 0u && __builtin_amdgcn_readfirstlane(__hip_atomic_load(tmo, __ATOMIC_RELAXED, __HIP_MEMORY_SCOPE_AGENT)) != 0u) break;
                if (__builtin_amdgcn_s_memrealtime() - t0 > 2000000ull) {
                    if (threadIdx.x == 0) { unsigned expect = 0u; __hip_atomic_compare_exchange_strong(tmo + 1, &expect, 0x600u | (unsigned)(u.pm & 0xff), __ATOMIC_RELAXED, __ATOMIC_RELAXED, __HIP_MEMORY_SCOPE_AGENT); __hip_atomic_store(tmo, 1u, __ATOMIC_RELAXED, __HIP_MEMORY_SCOPE_AGENT); }
                    break; }
                __builtin_amdgcn_s_sleep(2); }
            __builtin_amdgcn_fence(__ATOMIC_ACQUIRE, "agent");
            asm volatile("s_waitcnt vmcnt(0)" ::: "memory");
        }
#if !defined(BROKEN_HOOK_NO_BARRIER)
        asm volatile("" ::: "memory"); __builtin_amdgcn_s_barrier(); asm volatile("" ::: "memory");
#endif
    }
};

__device__ __forceinline__ unsigned cvt_pk_bf16(float lo, float hi) { unsigned r; asm volatile("v_cvt_pk_bf16_f32 %0, %1, %2" : "=v"(r) : "v"(lo), "v"(hi)); return r; }
typedef float f32x2 __attribute__((ext_vector_type(2)));
__device__ __forceinline__ f32x2 gelu_pk(f32x2 v) {
    const f32x2 av = __builtin_elementwise_abs(v), d = av * 0.2316418882f + 1.0f;
    f32x2 t; t.x = __builtin_amdgcn_rcpf(d.x); t.y = __builtin_amdgcn_rcpf(d.y);
    f32x2 q = t * 0.5307027145f + (-0.7265760135f); q = q * t + 0.7107068705f; q = q * t + (-0.142248368f); q = q * t + 0.127414796f; q = q * t;
    const f32x2 s = (v * v) * (-0.72134752044f);
    f32x2 e; e.x = __builtin_amdgcn_exp2f(s.x); e.y = __builtin_amdgcn_exp2f(s.y);
    const f32x2 m = v * (q * e), r = v - m;
    f32x2 o; o.x = v.x < 0.f ? m.x : r.x; o.y = v.y < 0.f ? m.y : r.y; return o;
}

struct EpiF32 {
    static constexpr bool PERM = false, AFTER_DRAIN = false;
    float* C; int ldc; const float* bias;
    __device__ __forceinline__ void operator()(const f32x4 (&acc)[2][2][4][2], const Unit& u, int wr, int wc, int fr, int fq) const {
        const int row0 = u.pm * BM + wr * 64 + fr, col0 = u.pn * BM + wc * 32 + 4 * fq;
        f32x4 bv[2][2];
#pragma unroll
        for (int bj = 0; bj < 2; ++bj)
#pragma unroll
            for (int n = 0; n < 2; ++n) bv[bj][n] = bias ? *(const f32x4*)(bias + col0 + bj * HALF + n * 16) : (f32x4){0.f, 0.f, 0.f, 0.f};
#pragma unroll
        for (int ai = 0; ai < 2; ++ai)
#pragma unroll
            for (int m = 0; m < 4; ++m) { float* rowp = C + (size_t)(row0 + ai * HALF + m * 16) * ldc + col0;
#pragma unroll
                for (int bj = 0; bj < 2; ++bj)
#pragma unroll
                    for (int n = 0; n < 2; ++n) *(f32x4*)(rowp + bj * HALF + n * 16) = acc[ai][bj][m][n] + bv[bj][n]; }
    }
};
template <int ACT  > struct EpiBf16 {
    static constexpr bool PERM = true, AFTER_DRAIN = false;
    bf16_t* O; int ldc; const float* bias; int split_cols; size_t split_stride;
    __device__ __forceinline__ void operator()(const f32x4 (&acc)[2][2][4][2], const Unit& u, int wr, int wc, int fr, int fq) const {
        const int row0 = u.pm * BM + wr * 64 + fr; int colt = u.pn * BM; bf16_t* base = O;
        if (split_cols) { const int t = colt / split_cols; base += (size_t)t * split_stride; colt -= t * split_cols; }
        const int col0 = colt + wc * 32 + 8 * fq, bcol0 = u.pn * BM + wc * 32 + 8 * fq;
        f32x4 bv[2][2];
#pragma unroll
        for (int bj = 0; bj < 2; ++bj)
#pragma unroll
            for (int n = 0; n < 2; ++n) bv[bj][n] = bias ? *(const f32x4*)(bias + bcol0 + bj * HALF + 4 * n) : (f32x4){0.f, 0.f, 0.f, 0.f};
#pragma unroll
        for (int ai = 0; ai < 2; ++ai)
#pragma unroll
            for (int m = 0; m < 4; ++m) { bf16_t* rowp = base + (size_t)(row0 + ai * HALF + m * 16) * ldc + col0;
#pragma unroll
                for (int bj = 0; bj < 2; ++bj) { f32x4 v0 = acc[ai][bj][m][0] + bv[bj][0], v1 = acc[ai][bj][m][1] + bv[bj][1];
                    if (ACT == 1) { f32x2 a = gelu_pk((f32x2){v0[0], v0[1]}), b = gelu_pk((f32x2){v0[2], v0[3]}), c = gelu_pk((f32x2){v1[0], v1[1]}), d = gelu_pk((f32x2){v1[2], v1[3]});
                        v0 = (f32x4){a.x, a.y, b.x, b.y}; v1 = (f32x4){c.x, c.y, d.x, d.y}; }
                    if (ACT == 2) {
#pragma unroll
                        for (int j = 0; j < 4; ++j) { v0[j] = 0.5f * v0[j] * (1.0f + erff(v0[j] * 0.70710678f)); v1[j] = 0.5f * v1[j] * (1.0f + erff(v1[j] * 0.70710678f)); } }
                    u32x4 w; w.x = cvt_pk_bf16(v0[0], v0[1]); w.y = cvt_pk_bf16(v0[2], v0[3]); w.z = cvt_pk_bf16(v1[0], v1[1]); w.w = cvt_pk_bf16(v1[2], v1[3]);
                    *(u32x4*)(rowp + bj * HALF) = w; } }
    }
};

struct PanelStats {
    unsigned* xbuf;
    unsigned* cnt;
    unsigned* tmo;
    int ntn; float eps;
    unsigned code;
    __device__ __forceinline__ bool run(const f32x4 (&v)[2][2][4][2], const Unit& u, int wr, int wc, int fr, int fq, PG8_LAS unsigned char* lds, int wid, int lane) const {
        typedef float f32x2v __attribute__((ext_vector_type(2)));
        PG8_LAS f32x2v* P = (PG8_LAS f32x2v*)lds;
        PG8_LAS f32x2v* S = (PG8_LAS f32x2v*)(lds + 8192);
        PG8_LAS unsigned* flag = (PG8_LAS unsigned*)(lds + 8192 + 2048);
#pragma unroll
        for (int ai = 0; ai < 2; ++ai)
#pragma unroll
            for (int m = 0; m < 4; ++m) {
                float s = 0.f;
#pragma unroll
                for (int bj = 0; bj < 2; ++bj)
#pragma unroll
                    for (int n = 0; n < 2; ++n) { const f32x4 x = v[ai][bj][m][n]; s += (x[0] + x[1]) + (x[2] + x[3]); }
                s += __shfl_xor(s, 16); s += __shfl_xor(s, 32);
                const float mw = s * (1.0f / 64.0f); float q = 0.f;
#pragma unroll
                for (int bj = 0; bj < 2; ++bj)
#pragma unroll
                    for (int n = 0; n < 2; ++n) { const f32x4 d = v[ai][bj][m][n] - mw; q += (d[0] * d[0] + d[1] * d[1]) + (d[2] * d[2] + d[3] * d[3]); }
                q += __shfl_xor(q, 16); q += __shfl_xor(q, 32);
                if (fq == 0) P[(ai * HALF + wr * 64 + m * 16 + fr) * 4 + wc] = (f32x2v){mw, q};
            }
        asm volatile("s_waitcnt lgkmcnt(0)" ::: "memory"); __builtin_amdgcn_s_barrier(); asm volatile("" ::: "memory");
#if defined(BROKEN_NO_WAIT)
        if (blockIdx.x >= 64) { const long long t0 = clock64(); while (clock64() - t0 < 60000) __builtin_amdgcn_s_sleep(8); }
#endif
        const int row = wid * 32 + (lane & 31);
        if (lane < 32) {
            const f32x2v a = P[row * 4 + 0], b = P[row * 4 + 1], c = P[row * 4 + 2], d = P[row * 4 + 3];
            const float mt = (a.x + b.x + c.x + d.x) * 0.25f;
            const float da = a.x - mt, db = b.x - mt, dc = c.x - mt, dd = d.x - mt;
            const float m2 = (a.y + b.y) + (c.y + d.y) + 64.0f * ((da * da + db * db) + (dc * dc + dd * dd));
            unsigned long long* slot = (unsigned long long*)xbuf + ((size_t)(u.pm * BM + row) * 4 + u.pn);
            __hip_atomic_store(slot, ((unsigned long long)__float_as_uint(m2) << 32) | __float_as_uint(mt), __ATOMIC_RELAXED, __HIP_MEMORY_SCOPE_AGENT);
        }
        asm volatile("s_waitcnt vmcnt(0)" ::: "memory");
        if (lane == 0) __hip_atomic_fetch_add(cnt + 64 * u.pm, 1u, __ATOMIC_RELAXED, __HIP_MEMORY_SCOPE_AGENT);
        if (wid == 0) {
            bool dead = false; const unsigned long long t0 = __builtin_amdgcn_s_memrealtime(); const unsigned want = 8u * (unsigned)ntn;
            for (;;) {
#if defined(BROKEN_NO_WAIT)
                break;
#endif
                if ((unsigned)__builtin_amdgcn_readfirstlane(__hip_atomic_load(cnt + 64 * u.pm, __ATOMIC_RELAXED, __HIP_MEMORY_SCOPE_AGENT)) >= want) break;
                if (__builtin_amdgcn_s_memrealtime() - t0 > 2000000ull) {
                    if (lane == 0) { unsigned expect = 0u; __hip_atomic_compare_exchange_strong(tmo + 1, &expect, code | (unsigned)(u.pm & 0xff), __ATOMIC_RELAXED, __ATOMIC_RELAXED, __HIP_MEMORY_SCOPE_AGENT);
                                     __hip_atomic_store(tmo, 1u, __ATOMIC_RELAXED, __HIP_MEMORY_SCOPE_AGENT); }
                    dead = true; break; }
                __builtin_amdgcn_s_sleep(2);
            }
            __builtin_amdgcn_fence(__ATOMIC_ACQUIRE, "agent");
            if (lane == 0) flag[0] = dead ? 1u : 0u;
        }
        asm volatile("s_waitcnt vmcnt(0) lgkmcnt(0)" ::: "memory"); __builtin_amdgcn_s_barrier(); asm volatile("" ::: "memory");
        const bool bad = flag[0] != 0u;
        if (lane < 32) {
            const unsigned long long* slot = (const unsigned long long*)xbuf + (size_t)(u.pm * BM + row) * 4; float mt[4], m2[4]; float ms = 0.f;
#pragma unroll
            for (int t = 0; t < 4; ++t) { if (t < ntn) { const unsigned long long w = __hip_atomic_load(slot + t, __ATOMIC_RELAXED, __HIP_MEMORY_SCOPE_AGENT); mt[t] = __uint_as_float((unsigned)w); m2[t] = __uint_as_float((unsigned)(w >> 32)); } else { mt[t] = 0.f; m2[t] = 0.f; } ms += mt[t]; }
            const float mean = ms / (float)ntn; float q = 0.f;
#pragma unroll
            for (int t = 0; t < 4; ++t) if (t < ntn) { const float dm = mt[t] - mean; q += m2[t] + 256.0f * dm * dm; }
            S[row] = (f32x2v){mean, 1.0f / sqrtf(q / (256.0f * (float)ntn) + eps)};
        }
        asm volatile("s_waitcnt lgkmcnt(0)" ::: "memory"); __builtin_amdgcn_s_barrier(); asm volatile("" ::: "memory");
        return bad;
    }
};
struct EpiLnRes {
    static constexpr bool PERM = false, AFTER_DRAIN = true;
    const float* base; float* out; int ldc; const float* bias; PanelStats st; unsigned poison;
    __device__ __forceinline__ void refuse(size_t i0, size_t stride, int M, int N) const { const float q = __builtin_nanf(""); for (size_t i = i0; i < (size_t)M * N; i += stride) out[(i / N) * ldc + i % N] = q;
        if (i0 == 0) { unsigned expect = 0u; __hip_atomic_compare_exchange_strong(st.tmo + 1, &expect, 0x7f0u, __ATOMIC_RELAXED, __ATOMIC_RELAXED, __HIP_MEMORY_SCOPE_AGENT); __hip_atomic_store(st.tmo, 1u, __ATOMIC_RELAXED, __HIP_MEMORY_SCOPE_AGENT); } }
    __device__ __forceinline__ void fused(f32x4 (&acc)[2][2][4][2], const Unit& u, int wr, int wc, int fr, int fq, PG8_LAS unsigned char* lds, int wid, int lane) const {
        typedef float f32x2v __attribute__((ext_vector_type(2)));
        const PG8_LAS f32x2v* S = (const PG8_LAS f32x2v*)(lds + 8192);
        const int col0 = u.pn * BM + wc * 32 + 4 * fq;
#pragma unroll
        for (int bj = 0; bj < 2; ++bj)
#pragma unroll
            for (int n = 0; n < 2; ++n) { const f32x4 bv = bias ? *(const f32x4*)(bias + col0 + bj * HALF + n * 16) : (f32x4){0.f, 0.f, 0.f, 0.f};
#pragma unroll
                for (int ai = 0; ai < 2; ++ai)
#pragma unroll
                    for (int m = 0; m < 4; ++m) acc[ai][bj][m][n] += bv; }
        const bool bad = st.run(acc, u, wr, wc, fr, fq, lds, wid, lane) || poison != 0u;
        const float qnan = __builtin_nanf("");
#pragma unroll
        for (int ai = 0; ai < 2; ++ai)
#pragma unroll
            for (int m = 0; m < 4; ++m) { const int r = ai * HALF + wr * 64 + m * 16 + fr; const f32x2v sr = S[r]; const size_t off = (size_t)(u.pm * BM + r) * ldc + col0;
#pragma unroll
                for (int bj = 0; bj < 2; ++bj)
#pragma unroll
                    for (int n = 0; n < 2; ++n) { const f32x4 bs = *(const f32x4*)(base + off + bj * HALF + n * 16); f32x4 o = bs + (acc[ai][bj][m][n] - sr.x) * sr.y;
                        if (bad) o = (f32x4){qnan, qnan, qnan, qnan}; *(f32x4*)(out + off + bj * HALF + n * 16) = o; }
                asm volatile("" ::: "memory"); }
    }
};
struct EpiLnResLn {
    static constexpr bool PERM = false, AFTER_DRAIN = true;
    const float* base; float* out; bf16_t* xn; int ldc; const float* bias; PanelStats st1, st2; unsigned poison;
    __device__ __forceinline__ void refuse(size_t i0, size_t stride, int M, int N) const { const float q = __builtin_nanf(""); for (size_t i = i0; i < (size_t)M * N; i += stride) { const size_t o = (i / N) * ldc + i % N; out[o] = q; xn[o] = (bf16_t)0x7fc0u; }
        if (i0 == 0) { unsigned expect = 0u; __hip_atomic_compare_exchange_strong(st1.tmo + 1, &expect, 0x7f0u, __ATOMIC_RELAXED, __ATOMIC_RELAXED, __HIP_MEMORY_SCOPE_AGENT); __hip_atomic_store(st1.tmo, 1u, __ATOMIC_RELAXED, __HIP_MEMORY_SCOPE_AGENT); } }
    __device__ __forceinline__ void fused(f32x4 (&acc)[2][2][4][2], const Unit& u, int wr, int wc, int fr, int fq, PG8_LAS unsigned char* lds, int wid, int lane) const {
        typedef float f32x2v __attribute__((ext_vector_type(2))); typedef unsigned u32x2v __attribute__((ext_vector_type(2)));
        const PG8_LAS f32x2v* S = (const PG8_LAS f32x2v*)(lds + 8192);
        const int col0 = u.pn * BM + wc * 32 + 4 * fq;
#pragma unroll
        for (int bj = 0; bj < 2; ++bj)
#pragma unroll
            for (int n = 0; n < 2; ++n) { const f32x4 bv = bias ? *(const f32x4*)(bias + col0 + bj * HALF + n * 16) : (f32x4){0.f, 0.f, 0.f, 0.f};
#pragma unroll
                for (int ai = 0; ai < 2; ++ai)
#pragma unroll
                    for (int m = 0; m < 4; ++m) acc[ai][bj][m][n] += bv; }
        bool bad = st1.run(acc, u, wr, wc, fr, fq, lds, wid, lane) || poison != 0u;
        const float qnan = __builtin_nanf("");
#pragma unroll
        for (int ai = 0; ai < 2; ++ai)
#pragma unroll
            for (int m = 0; m < 4; ++m) { const int r = ai * HALF + wr * 64 + m * 16 + fr; const f32x2v sr = S[r]; const size_t off = (size_t)(u.pm * BM + r) * ldc + col0;
#pragma unroll
                for (int bj = 0; bj < 2; ++bj)
#pragma unroll
                    for (int n = 0; n < 2; ++n) { const f32x4 bs = *(const f32x4*)(base + off + bj * HALF + n * 16); acc[ai][bj][m][n] = bs + (acc[ai][bj][m][n] - sr.x) * sr.y; }
                asm volatile("" : "+v"(acc[ai][0][m][0]), "+v"(acc[ai][0][m][1]), "+v"(acc[ai][1][m][0]), "+v"(acc[ai][1][m][1]));
                if (m & 1) asm volatile("" ::: "memory"); }
        const bool bad1 = bad;
        bad = st2.run(acc, u, wr, wc, fr, fq, lds, wid, lane) || bad;
#pragma unroll
        for (int ai = 0; ai < 2; ++ai)
#pragma unroll
            for (int m = 0; m < 4; ++m) { const int r = ai * HALF + wr * 64 + m * 16 + fr; const f32x2v sr = S[r]; const size_t off = (size_t)(u.pm * BM + r) * ldc + col0;
#pragma unroll
                for (int bj = 0; bj < 2; ++bj)
#pragma unroll
                    for (int n = 0; n < 2; ++n) { const f32x4 x1 = acc[ai][bj][m][n]; *(f32x4*)(out + off + bj * HALF + n * 16) = bad1 ? (f32x4){qnan, qnan, qnan, qnan} : x1;
                        const f32x4 o = (x1 - sr.x) * sr.y; u32x2v w; w.x = cvt_pk_bf16(o[0], o[1]); w.y = cvt_pk_bf16(o[2], o[3]);
                        if (bad) { w.x = 0x7fc07fc0u; w.y = 0x7fc07fc0u; } *(u32x2v*)(xn + off + bj * HALF + n * 16) = w; }
                asm volatile("" ::: "memory"); }
    }
};

template <class Epi, class Sched, bool STAMP = false>
__device__ __forceinline__ void gemm_phase(PG8_LAS unsigned char* lds, const Gemm g, const Sched& S, const Epi& E, unsigned long long* stamps, const int tid) {
    const int wid = __builtin_amdgcn_readfirstlane(tid >> 6), lane = tid & 63, wr = wid >> 2, wc = wid & 3, fr = lane & 15, fq = lane >> 4;
    const int K = g.K, nt = K / BK;
    int ts_lo = 0, ts_hi = 0, nts = 0; const unsigned long long rt_entry = STAMP ? (unsigned long long)wall_clock64() : 0ull;
#define PG8_STAMP() do { if (STAMP && wid == 0 && nts < 64) { const unsigned long long _c = (unsigned long long)clock64(); \
        ts_lo = (lane == nts) ? (int)(unsigned)_c : ts_lo; ts_hi = (lane == nts) ? (int)(unsigned)(_c >> 32) : ts_hi; ++nts; } } while (0)
    PG8_STAMP();
    unsigned voffA[2], voffB[2];
#pragma unroll
    for (int i = 0; i < 2; ++i) { int R, C; stage_rc(tid * 16 + i * 8192, R, C); const int Rb = Epi::PERM ? ((R & ~31) + perm32(R & 31)) : R;
        voffA[i] = (unsigned)(R * g.lda + C) * 2u; voffB[i] = (unsigned)(Rb * g.ldb + C) * 2u; }
    const size_t kstep = (size_t)(BK * 2);
    const size_t hstepA = (size_t)HALF * g.lda * 2, hstepB = (size_t)HALF * g.ldb * 2;
    const size_t tstepA = 2 * hstepA, tstepB = 2 * hstepB;
    const unsigned ldsw = (unsigned)wid * 1024u;
    const int aoff = lds_byte(wr * 64 + fr, fq * 8), boff = lds_byte(wc * 32 + fr, fq * 8);
#define PG8_SA(b, h) (((b) * 2 + (h)) * HTB)
#define PG8_SB(b, h) ((4 + (b) * 2 + (h)) * HTB)
#define PG8_STAGE(bufoff, gbase, voff) do { _Pragma("unroll") for (int _i = 0; _i < 2; ++_i) \
        __builtin_amdgcn_global_load_lds((const unsigned*)((const char*)(gbase) + (voff)[_i]), (PG8_LAS unsigned*)(lds + (bufoff) + ldsw + _i * 8192), 16, 0, 0); } while (0)
#define PG8_LDA(dst, b, h) do { _Pragma("unroll") for (int m = 0; m < 4; ++m) _Pragma("unroll") for (int k = 0; k < 2; ++k) dst[m][k] = *(const PG8_LAS bf16x8*)(lds + PG8_SA(b, h) + aoff + m * 2048 + k * 1024); } while (0)
#define PG8_LDB(dst, b, h) do { _Pragma("unroll") for (int n = 0; n < 2; ++n) _Pragma("unroll") for (int k = 0; k < 2; ++k) dst[n][k] = *(const PG8_LAS bf16x8*)(lds + PG8_SB(b, h) + boff + n * 2048 + k * 1024); } while (0)
#define PG8_MMA(ai, bj, At, Bt) do { __builtin_amdgcn_s_setprio(1); _Pragma("unroll") for (int m = 0; m < 4; ++m) _Pragma("unroll") for (int n = 0; n < 2; ++n) _Pragma("unroll") for (int k = 0; k < 2; ++k) \
        acc[ai][bj][m][n] = __builtin_amdgcn_mfma_f32_16x16x32_bf16(Bt[n][k], At[m][k], acc[ai][bj][m][n], 0, 0, 0); __builtin_amdgcn_s_setprio(0); } while (0)
#define PG8_WAIT_V(n) asm volatile("s_waitcnt vmcnt(" #n ")" ::: "memory")
#define PG8_WAIT_L(n) asm volatile("s_waitcnt lgkmcnt(" #n ")" ::: "memory")
#define PG8_BAR __builtin_amdgcn_s_barrier()
#define PG8_SCHED __builtin_amdgcn_sched_barrier(0)
    Unit cur, nxt; int ui = 0;
    if (!S.next(0, cur)) return;
    f32x4 acc[2][2][4][2];
#pragma unroll
    for (int a = 0; a < 2; ++a)
#pragma unroll
        for (int b = 0; b < 2; ++b)
#pragma unroll
            for (int m = 0; m < 4; ++m)
#pragma unroll
                for (int n = 0; n < 2; ++n) acc[a][b][m][n] = (f32x4){0.f, 0.f, 0.f, 0.f};
    bf16x8 At[4][2], B0[2][2], B1[2][2];
    const char* cA = (const char*)g.A + (size_t)cur.pm * tstepA; const char* cB = (const char*)g.Bt + (size_t)cur.pn * tstepB;
    S.a_ready(cur);
    PG8_STAGE(PG8_SB(0, 0), cB, voffB); PG8_STAGE(PG8_SA(0, 0), cA, voffA); PG8_STAGE(PG8_SB(0, 1), cB + hstepB, voffB); PG8_STAGE(PG8_SA(0, 1), cA + hstepA, voffA);
    if (wr == 1) PG8_BAR;
    PG8_WAIT_V(4); PG8_BAR;
    PG8_STAGE(PG8_SB(1, 0), cB + kstep, voffB); PG8_STAGE(PG8_SA(1, 0), cA + kstep, voffA); PG8_STAGE(PG8_SB(1, 1), cB + hstepB + kstep, voffB);
    PG8_WAIT_V(6); PG8_BAR;
    PG8_STAMP();
    for (;;) {
        const bool has_next = S.next(ui + 1, nxt);
        const char* nA = has_next ? (const char*)g.A + (size_t)nxt.pm * tstepA : cA; const char* nB = has_next ? (const char*)g.Bt + (size_t)nxt.pn * tstepB : cB;
        for (int t = 0; t < nt; t += 2) {
            const bool last = (t == nt - 2);
            const char* a1 = cA + (size_t)(t + 1) * kstep;
            const char* a2 = last ? nA : cA + (size_t)(t + 2) * kstep; const char* b2 = last ? nB : cB + (size_t)(t + 2) * kstep;
            const char* a3 = a2 + kstep; const char* b3 = b2 + kstep;
            if (last && has_next) S.a_ready(nxt);
            PG8_LDB(B0, 0, 0); PG8_SCHED; PG8_LDA(At, 0, 0); PG8_STAGE(PG8_SA(1, 1), a1 + hstepA, voffA);
            PG8_WAIT_L(8); PG8_BAR; PG8_WAIT_L(0); PG8_MMA(0, 0, At, B0); PG8_BAR; PG8_SCHED;
            PG8_LDB(B1, 0, 1); PG8_STAGE(PG8_SB(0, 0), b2, voffB);
            PG8_BAR; PG8_WAIT_L(0); PG8_MMA(0, 1, At, B1); PG8_BAR;
            PG8_LDA(At, 0, 1); PG8_STAGE(PG8_SA(0, 0), a2, voffA);
            PG8_BAR; PG8_WAIT_L(0); PG8_MMA(1, 0, At, B0); PG8_BAR; PG8_SCHED;
            PG8_STAGE(PG8_SB(0, 1), b2 + hstepB, voffB);
            PG8_WAIT_V(6); PG8_BAR; PG8_MMA(1, 1, At, B1); PG8_BAR;
            PG8_LDB(B0, 1, 0); PG8_SCHED; PG8_LDA(At, 1, 0); PG8_STAGE(PG8_SA(0, 1), a2 + hstepA, voffA);
            PG8_WAIT_L(8); PG8_BAR; PG8_WAIT_L(0); PG8_MMA(0, 0, At, B0); PG8_BAR; PG8_SCHED;
            PG8_LDB(B1, 1, 1); PG8_STAGE(PG8_SB(1, 0), b3, voffB);
            PG8_BAR; PG8_WAIT_L(0); PG8_MMA(0, 1, At, B1); PG8_BAR;
            PG8_LDA(At, 1, 1); PG8_STAGE(PG8_SA(1, 0), a3, voffA);
            PG8_BAR; PG8_WAIT_L(0); PG8_MMA(1, 0, At, B0); PG8_BAR; PG8_SCHED;
            PG8_STAGE(PG8_SB(1, 1), b3 + hstepB, voffB);
            PG8_WAIT_V(6); PG8_BAR; PG8_MMA(1, 1, At, B1); PG8_BAR;
        }
        PG8_STAMP();
        if constexpr (!Epi::AFTER_DRAIN) { E(acc, cur, wr, wc, fr, fq); S.done(cur); }
        PG8_STAMP();
        if (!has_next) break;
#pragma unroll
        for (int a = 0; a < 2; ++a)
#pragma unroll
            for (int b = 0; b < 2; ++b)
#pragma unroll
                for (int m = 0; m < 4; ++m)
#pragma unroll
                    for (int n = 0; n < 2; ++n) acc[a][b][m][n] = (f32x4){0.f, 0.f, 0.f, 0.f};
        cur = nxt; cA = nA; cB = nB; ++ui;
    }
    PG8_WAIT_V(0);
    if (wr == 0) PG8_BAR;
    PG8_BAR;
    if constexpr (Epi::AFTER_DRAIN) { E.fused(acc, cur, wr, wc, fr, fq, lds, wid, lane); S.done(cur); }
    PG8_STAMP();
    if (STAMP && wid == 0) { stamps[lane] = lane < nts ? (((unsigned long long)(unsigned)ts_hi << 32) | (unsigned)ts_lo) : 0ull;
        if (lane == 62) stamps[62] = rt_entry; if (lane == 63) stamps[63] = (unsigned long long)wall_clock64(); }
#undef PG8_STAMP
#undef PG8_SA
#undef PG8_SB
#undef PG8_STAGE
#undef PG8_LDA
#undef PG8_LDB
#undef PG8_MMA
#undef PG8_WAIT_V
#undef PG8_WAIT_L
#undef PG8_BAR
#undef PG8_SCHED
}
}

struct PgEpiSwiGLU {
  static constexpr bool PERM = true, AFTER_DRAIN = false;
  u16* act;
  __device__ __forceinline__ void operator()(const pg8::f32x4 (&acc)[2][2][4][2], const pg8::Unit& u, int wr, int wc, int fr, int fq) const {
    const int row0 = u.pm * 256 + wr * 64 + fr, j0 = u.pn * 128 + wc * 32 + 8 * fq;
#pragma unroll
    for (int ai = 0; ai < 2; ++ai)
#pragma unroll
      for (int m = 0; m < 4; ++m) {
        unsigned pk[4];
#pragma unroll
        for (int n = 0; n < 2; ++n) {
          float y[4];
#pragma unroll
          for (int e = 0; e < 4; ++e) {
            const float gt = acc[ai][0][m][n][e], up = acc[ai][1][m][n][e];
            y[e] = gt * __builtin_amdgcn_rcpf(1.f + fexp2(-LOG2E * gt)) * up;
          }
          pk[2 * n] = cvt_pk(y[0], y[1]); pk[2 * n + 1] = cvt_pk(y[2], y[3]);
        }
        u32x4 w4; w4.x = pk[0]; w4.y = pk[1]; w4.z = pk[2]; w4.w = pk[3];
        *(u32x4*)(act + (size_t)(row0 + ai * 128 + m * 16) * DFF + j0) = w4;
      }
  }
};
template <class Epi>
DI void pg_gemm(const u16* A, const u16* Bt, int M, int N, int K, const Epi& E, char* lds, int bid, int nblk, const Ctx& p) {
  pg8::Gemm g{A, Bt, M, N, K, K, K};
  pg8::StaticOrder S; S.init(M, N, nblk, bid);
  pg8::gemm_phase<Epi, pg8::StaticOrder, false>((PG8_LAS unsigned char*)lds, g, S, E, nullptr, otid(p));
}

constexpr int LDS_BYTES = 2 * (256 + 256) * 144;

struct PgEpiUQ {
  static constexpr bool PERM = false, AFTER_DRAIN = false;
  u16* q; const float* rq; const float2* rope;
  __device__ __forceinline__ void operator()(const pg8::f32x4 (&acc)[2][2][4][2], const pg8::Unit& u, int wr, int wc, int fr, int fq) const {
    const int row0 = u.pm * 256 + wr * 64 + fr;
#pragma unroll
    for (int ai = 0; ai < 2; ++ai)
#pragma unroll
      for (int m = 0; m < 4; ++m) {
        const int row = row0 + ai * 128 + m * 16;
        const float sc = rq[row] * QSCALE96;
        const int pos = tok_pos(row);
#pragma unroll
        for (int bj = 0; bj < 2; ++bj) {
          const int gb = u.pn * 256 + bj * 128 + wc * 32;
          pg8::f32x4 v0 = acc[ai][bj][m][0] * sc, v1 = acc[ai][bj][m][1] * sc;
          if (((gb >> 5) % 3) == 2) {
            const float4 ca = *(const float4*)(rope + pos * 16 + 4 * fq), cb = *(const float4*)(rope + pos * 16 + 4 * fq + 2);
            const float cs[4] = {ca.x, ca.z, cb.x, cb.z}, sn[4] = {ca.y, ca.w, cb.y, cb.w};
#pragma unroll
            for (int e = 0; e < 4; ++e) { const float x1 = v0[e], x2 = v1[e]; v0[e] = x1 * cs[e] - x2 * sn[e]; v1[e] = x2 * cs[e] + x1 * sn[e]; }
          }
          u16* dst = q + (size_t)row * 1536 + gb + 4 * fq;
          u32x2 w0; w0.x = cvt_pk(v0[0], v0[1]); w0.y = cvt_pk(v0[2], v0[3]);
          u32x2 w1; w1.x = cvt_pk(v1[0], v1[1]); w1.y = cvt_pk(v1[2], v1[3]);
          *(u32x2*)dst = w0;
          *(u32x2*)(dst + 16) = w1;
        }
      }
  }
};
struct PgEpiKnope {
  static constexpr bool PERM = true, AFTER_DRAIN = false;
  u16* knope; const float* rkv; unsigned* kp;
  __device__ __forceinline__ void operator()(const pg8::f32x4 (&acc)[2][2][4][2], const pg8::Unit& u, int wr, int wc, int fr, int fq) const {
    const int row0 = u.pm * 256 + wr * 64 + fr;
    float pm[2] = {0.f, 0.f};
#pragma unroll
    for (int ai = 0; ai < 2; ++ai)
#pragma unroll
      for (int m = 0; m < 4; ++m) {
        const int row = row0 + ai * 128 + m * 16;
        const float sc = rkv[row];
#pragma unroll
        for (int bj = 0; bj < 2; ++bj) {
          const pg8::f32x4 v0 = acc[ai][bj][m][0] * sc, v1 = acc[ai][bj][m][1] * sc;
          u32x4 w4; w4.x = cvt_pk(v0[0], v0[1]); w4.y = cvt_pk(v0[2], v0[3]); w4.z = cvt_pk(v1[0], v1[1]); w4.w = cvt_pk(v1[2], v1[3]);
          *(u32x4*)(knope + (size_t)row * 1024 + u.pn * 256 + bj * 128 + wc * 32 + 8 * fq) = w4;
          float ss = 0.f;
#pragma unroll
          for (int e = 0; e < 4; ++e) ss += v0[e] * v0[e] + v1[e] * v1[e];
          pm[bj] = fmaxf(pm[bj], ss);
        }
      }
#pragma unroll
    for (int bj = 0; bj < 2; ++bj) {
      float v = pm[bj];
      v = fmaxf(v, __int_as_float(__builtin_amdgcn_ds_swizzle(__float_as_int(v), (8 << 10) | 0x1f)));
      v = fmaxf(v, __int_as_float(__builtin_amdgcn_ds_swizzle(__float_as_int(v), (4 << 10) | 0x1f)));
      v = fmaxf(v, __int_as_float(__builtin_amdgcn_ds_swizzle(__float_as_int(v), (2 << 10) | 0x1f)));
      v = fmaxf(v, __int_as_float(__builtin_amdgcn_ds_swizzle(__float_as_int(v), (1 << 10) | 0x1f)));
      if (fr == 0) atomicMax(kp + ((u.pn * 256 + bj * 128 + wc * 32) >> 6) * 8 + ((wc & 1) << 2) + fq, __float_as_uint(sqrtf(v) * 1.01f));
    }
  }
};
struct PgEpiVt {
  static constexpr bool PERM = true, AFTER_DRAIN = false;
  u16* vt; const float* rkv;
  __device__ __forceinline__ void operator()(const pg8::f32x4 (&acc)[2][2][4][2], const pg8::Unit& u, int wr, int wc, int fr, int fq) const {
    const int row0 = u.pm * 256 + wr * 64 + fr;
#pragma unroll
    for (int bj = 0; bj < 2; ++bj) {
      const int c0 = u.pn * 256 + bj * 128 + wc * 32 + 8 * fq;
      const float4 s0 = *(const float4*)(rkv + c0), s1 = *(const float4*)(rkv + c0 + 4);
#pragma unroll
      for (int ai = 0; ai < 2; ++ai)
#pragma unroll
        for (int m = 0; m < 4; ++m) {
          const pg8::f32x4 v0 = acc[ai][bj][m][0], v1 = acc[ai][bj][m][1];
          u32x4 w4; w4.x = cvt_pk(v0[0] * s0.x, v0[1] * s0.y); w4.y = cvt_pk(v0[2] * s0.z, v0[3] * s0.w);
          w4.z = cvt_pk(v1[0] * s1.x, v1[1] * s1.y); w4.w = cvt_pk(v1[2] * s1.z, v1[3] * s1.w);
          *(u32x4*)(vt + (size_t)(row0 + ai * 128 + m * 16) * T_TOK + c0) = w4;
        }
    }
  }
};
template <class Epi>
DI void pg_gemm_ld(const u16* A, int lda, const u16* Bt, int ldb, int M, int N, int K, const Epi& E, char* lds, int bid, int nblk, const Ctx& p) {
  pg8::Gemm g{A, Bt, M, N, K, lda, ldb};
  pg8::StaticOrder S; S.init(M, N, nblk, bid);
  pg8::gemm_phase<Epi, pg8::StaticOrder, false>((PG8_LAS unsigned char*)lds, g, S, E, nullptr, otid(p));
}

DI void grid_barrier(unsigned* ctr, unsigned target, const Ctx& p) {
  __syncthreads();
  if (otid(p) < 64) {
    __builtin_amdgcn_fence(__ATOMIC_RELEASE, "agent");
    if (otid(p) == 0) {
      __hip_atomic_fetch_add(ctr, 1u, __ATOMIC_RELAXED, __HIP_MEMORY_SCOPE_AGENT);
      while (__hip_atomic_load(ctr, __ATOMIC_RELAXED, __HIP_MEMORY_SCOPE_AGENT) < target) __builtin_amdgcn_s_sleep(1);
    }
    __builtin_amdgcn_fence(__ATOMIC_ACQUIRE, "agent");
  }
  __syncthreads();
}
template <int PH>
DI void run_phase(const Ctx& p, char* lds) {
  const int bid = obid(), nblk = gridDim.x;
  u16* wb = (u16*)p.ws;
  u16* R1 = (u16*)(p.ws + OFF_R1);
  u16* R2 = (u16*)(p.ws + OFF_R2);
  u16* R3 = (u16*)(p.ws + OFF_R3);
  if constexpr (PH == 0) phase_prep(p);
  else if constexpr (PH == 1) {
    pg_gemm(R1, wb + W0IN, T_TOK, 2048, 1024, pg8::EpiBf16<0>{R2, 512, nullptr, 512, SEG512}, lds, bid, nblk, p);
    pg_gemm(wb + W0IN + (size_t)2048 * 1024, R1, 1024, T_TOK, 1024, pg8::EpiBf16<0>{R2 + 4 * SEG512, T_TOK, nullptr, 0, 0}, lds, bid, nblk, p);
    grid_barrier((unsigned*)(p.ws + OFF_SCAL) + SC_BAR2, (unsigned)nblk, p);
    phase_qk_norms(p);
  }
  else if constexpr (PH == 2) {
    unsigned* ctr = (unsigned*)(p.ws + OFF_SCAL) + SC_CTR;
    int* nxt_slot = (int*)(lds + LDS_BYTES - 16);
    const int tid0 = otid(p);
    int it = bid;
    while (it < 5120) {
      int nx = 0;
      if (tid0 == 0) nx = (int)atomicAdd(ctr, 1u) + nblk;
      if (it < 2560) attn_diff_item(p, it, lds);
      else attn_na_item(p, it - 2560, lds);
      __syncthreads();
      if (tid0 == 0) *nxt_slot = nx;
      __syncthreads();
      it = *nxt_slot;
    }
  }
  else if constexpr (PH == 3) pg_gemm(R1, wb + W0OUT, T_TOK, 1024, 1024, pg8::EpiBf16<0>{R3, 1024, nullptr, 0, 0}, lds, bid, nblk, p);
  else if constexpr (PH == 4) phase_res<true, false>(p, R3, (const float*)(p.ws + OFF_SCAL) + SC_G0);
  else if constexpr (PH == 5) pg_gemm(R1, wb + W0F1, T_TOK, 5632, 1024, PgEpiSwiGLU{R2}, lds, bid, nblk, p);
  else if constexpr (PH == 6) pg_gemm(R2, wb + W0F2, T_TOK, 1024, 2816, pg8::EpiBf16<0>{R3, 1024, nullptr, 0, 0}, lds, bid, nblk, p);
  else if constexpr (PH == 7) phase_res<false, false>(p, R3, (const float*)(p.ws + OFF_SCAL) + SC_G1);
  else if constexpr (PH == 8) pg_gemm(R1, wb + W1DN, T_TOK, 768, 1024, pg8::EpiBf16<0>{R3, 768, nullptr, 0, 0}, lds, bid, nblk, p);
  else if constexpr (PH == 9) phase_mla_stats(p);
  else if constexpr (PH == 10) {
    pg_gemm_ld(R3, 768, wb + W1UQ, 384, T_TOK, 1536, 384, PgEpiUQ{R2, (const float*)(p.ws + OFF_RQ), (const float2*)(p.ws + OFF_ROPE)}, lds, bid, nblk, p);
    pg_gemm_ld(R3 + 384, 768, wb + W1UKV, 256, T_TOK, 1024, 256,
               PgEpiKnope{R2 + (size_t)T_TOK * 1536, (const float*)(p.ws + OFF_RKV), (unsigned*)(p.ws + OFF_SCAL) + SC_KP}, lds, bid, nblk, p);
    pg_gemm_ld(wb + W1UKV + (size_t)1024 * 256, 256, R3 + 384, 768, 1024, T_TOK, 256,
               PgEpiVt{R2 + (size_t)T_TOK * 2560, (const float*)(p.ws + OFF_RKV)}, lds, bid, nblk, p);
  }
  else if constexpr (PH == 11) { for (int it = bid; it < 2560; it += nblk) {
      int itm = it;
      if (nblk == 256) {
        const int rnd = it >> 8, x = bid & 7, j = bid >> 3;
        itm = rnd < 2 ? (8 * rnd + x) * 32 + j : 512 + (2 * (rnd - 2) + (x >> 2)) * 128 + (4 * (x & 3) + (j >> 3)) * 8 + (j & 7);
      }
      attn_mla_item2(p, itm, lds);
    } }
  else if constexpr (PH == 12) pg_gemm(R1, wb + W1OUT, T_TOK, 1024, 1024, pg8::EpiBf16<0>{R3, 1024, nullptr, 0, 0}, lds, bid, nblk, p);
  else if constexpr (PH == 13) phase_res<false, false>(p, R3, (const float*)(p.ws + OFF_SCAL) + SC_G2);
  else if constexpr (PH == 14) pg_gemm(R1, wb + W1F1, T_TOK, 5632, 1024, PgEpiSwiGLU{R2}, lds, bid, nblk, p);
  else if constexpr (PH == 15) pg_gemm(R2, wb + W1F2, T_TOK, 1024, 2816, pg8::EpiBf16<0>{R3, 1024, nullptr, 0, 0}, lds, bid, nblk, p);
  else if constexpr (PH == 16) phase_res<false, true>(p, R3, (const float*)(p.ws + OFF_SCAL) + SC_G3);
}

#if MULTI_LAUNCH
template <int PH>
__global__ void __launch_bounds__(512, 2) k_phase(Params pa) {
  extern __shared__ __attribute__((aligned(16))) char lds[];
  Ctx p;
#pragma unroll
  for (int i = 0; i < 28; ++i) p.in[i] = pa.in[i];
  p.out = pa.out; p.ws = pa.ws;
  p.wv = __builtin_amdgcn_readfirstlane((int)(threadIdx.x >> 6));
  run_phase<PH>(p, lds);
}
template <int PH>
static void launch_all(const Params& p, int grid, hipStream_t stream) {
  (void)hipFuncSetAttribute((const void*)k_phase<PH>, hipFuncAttributeMaxDynamicSharedMemorySize, LDS_BYTES);
  hipLaunchKernelGGL(k_phase<PH>, dim3(grid), dim3(512), LDS_BYTES, stream, p);
  if constexpr (PH + 1 < NPHASE) launch_all<PH + 1>(p, grid, stream);
}
#define OCC_KERNEL k_phase<2>
#else
#ifndef PROBE_DUP
#define PROBE_DUP -1
#endif
#ifndef PROBE_DUP2
#define PROBE_DUP2 -1
#endif
template <int PH>
DI void run_from(const Ctx& p, char* lds) {
  if constexpr (PH == PROBE_DUP || PH == PROBE_DUP2) { run_phase<PH>(p, lds); cg::this_grid().sync(); }
#ifdef PROBE_ABL
  if constexpr (PH == 11) { for (int it = obid(); it < 5120; it += gridDim.x) attn_mla_item<PROBE_ABL>(p, it, lds); cg::this_grid().sync(); }
#endif
  run_phase<PH>(p, lds);
  if constexpr (PH + 1 < NPHASE) {
    if constexpr (PH == 0) cg::this_grid().sync();
    else grid_barrier((unsigned*)(p.ws + OFF_SCAL) + SC_BAR, (unsigned)PH * gridDim.x, p);
    run_from<PH + 1>(p, lds);
  }
}
__global__ void __launch_bounds__(512, 2) mega(Params pa) {
  extern __shared__ __attribute__((aligned(16))) char lds[];
  Ctx p;
#pragma unroll
  for (int i = 0; i < 28; ++i) p.in[i] = pa.in[i];
  p.out = pa.out; p.ws = pa.ws;
  p.wv = __builtin_amdgcn_readfirstlane((int)(threadIdx.x >> 6));
  run_from<0>(p, lds);
}
#define OCC_KERNEL mega
#endif

extern "C" void kernel_launch(void* const* d_in, const int* in_sizes, int n_in, void* d_out, int out_size, void* d_ws, size_t ws_size,
                              hipStream_t stream) {
  static int grid = 0;
  if (grid == 0) {
    if (n_in != 28 || ws_size < WS_NEED) { fprintf(stderr, "kernel_launch: unexpected n_in %d / ws_size %zu (need %zu)\n", n_in, ws_size, (size_t)WS_NEED); grid = -1; return; }
    int dev = 0, cus = 0, per_cu = 0;
    (void)hipGetDevice(&dev);
    (void)hipDeviceGetAttribute(&cus, hipDeviceAttributeMultiprocessorCount, dev);
    (void)hipFuncSetAttribute((const void*)OCC_KERNEL, hipFuncAttributeMaxDynamicSharedMemorySize, LDS_BYTES);
    (void)hipOccupancyMaxActiveBlocksPerMultiprocessor(&per_cu, (const void*)OCC_KERNEL, 512, LDS_BYTES);
    if (per_cu < 1) per_cu = 1;
    if (per_cu > 1) per_cu = 1;
    grid = cus * per_cu;
  }
  if (grid < 0) return;
  Params p{};
  for (int i = 0; i < 28; ++i) p.in[i] = (const float*)d_in[i];
  p.out = (float*)d_out;
  p.ws = (char*)d_ws;
#if MULTI_LAUNCH
  launch_all<0>(p, grid, stream);
#else
  void* args[] = {&p};
  hipError_t e = hipLaunchCooperativeKernel((const void*)mega, dim3(grid), dim3(512), args, LDS_BYTES, stream);
  if (e != hipSuccess) fprintf(stderr, "cooperative launch failed: %s (grid %d)\n", hipGetErrorString(e), grid);
#endif
}
```

```cpp
#include <hip/hip_runtime.h>
#include <hip/hip_cooperative_groups.h>
#include <stdint.h>
#include <cstdio>
namespace cg = cooperative_groups;

#ifndef MULTI_LAUNCH
#define MULTI_LAUNCH 0
#endif

typedef unsigned short u16;
typedef __attribute__((ext_vector_type(8))) short bf16x8;
typedef __attribute__((ext_vector_type(16))) float f32x16;
typedef __attribute__((ext_vector_type(4))) unsigned u32x4;

#define MFMA32(a, b, c) __builtin_amdgcn_mfma_f32_32x32x16_bf16((a), (b), (c), 0, 0, 0)
#define DI __device__ __forceinline__

constexpr int T_TOK = 81920;
constexpr int T_PROMPT = 65536;
constexpr int DM = 1024;
constexpr int DFF = 2816;
constexpr float EPS = 1e-6f;
constexpr float LOG2E = 1.4426950408889634f;
constexpr float QSCALE64 = 0.125f * LOG2E;
constexpr float QSCALE96 = 0.10206207261596577f * LOG2E;
constexpr int NPHASE = 17;

constexpr size_t MiB = (size_t)1 << 20;
constexpr size_t W0IN = 0;
constexpr size_t W0OUT = W0IN + (size_t)3072 * 1024;
constexpr size_t W0F1 = W0OUT + (size_t)1024 * 1024;
constexpr size_t W0F2 = W0F1 + (size_t)5632 * 1024;
constexpr size_t W1DN = W0F2 + (size_t)1024 * 2816;
constexpr size_t W1UQ = W1DN + (size_t)768 * 1024;
constexpr size_t W1UKV = W1UQ + (size_t)1536 * 384;
constexpr size_t W1OUT = W1UKV + (size_t)2048 * 256;
constexpr size_t W1F1 = W1OUT + (size_t)1024 * 1024;
constexpr size_t W1F2 = W1F1 + (size_t)5632 * 1024;
constexpr size_t W_END = W1F2 + (size_t)1024 * 2816;
static_assert(W_END * 2 <= 48 * MiB, "weights region");
constexpr size_t OFF_ROPE = 48 * MiB;
constexpr size_t OFF_RQ = OFF_ROPE + 2 * MiB;
constexpr size_t OFF_RKV = OFF_RQ + MiB / 2;
constexpr size_t OFF_KROPE = OFF_RKV + MiB / 2;
constexpr size_t OFF_SCAL = OFF_KROPE + 5 * MiB;
constexpr int SC_KP = 64;
constexpr int SC_QKMAX = 16, SC_CTR = 32, SC_BAR = 33, SC_BAR2 = 34, SC_KMAX1 = 40, SC_KRMAX = 56;
constexpr int SC_G0 = 1024, SC_G1 = 2048, SC_G2 = 3072, SC_G3 = 4096, SC_GSUB = 5120, SC_RPB = 6144;
constexpr size_t OFF_R1 = 58 * MiB;
constexpr size_t OFF_R3 = OFF_R1 + 160 * MiB;
constexpr size_t OFF_R2 = OFF_R3 + 160 * MiB;
constexpr size_t WS_NEED = OFF_R2 + 560 * MiB;
constexpr size_t SEG512 = (size_t)T_TOK * 512;

struct Params {
  const float* in[28];
  float* out;
  char* ws;
};
struct Ctx {
  const float* in[28];
  float* out;
  char* ws;
  int wv;
};

DI u16 f2bf(float x) { unsigned u = __float_as_uint(x); u += 0x7fffu + ((u >> 16) & 1u); return (u16)(u >> 16); }
DI unsigned pack2(float a, float b) { return (unsigned)f2bf(a) | ((unsigned)f2bf(b) << 16); }
DI float bflo(unsigned v) { return __uint_as_float(v << 16); }
DI float bfhi(unsigned v) { return __uint_as_float(v & 0xffff0000u); }
DI float wave_sum(float v) {
#pragma unroll
  for (int o = 32; o; o >>= 1) v += __shfl_xor(v, o);
  return v;
}
DI int tok_pos(int t) { return t < T_PROMPT ? (t & 4095) : (t - T_PROMPT); }
typedef float f32x4nt __attribute__((ext_vector_type(4)));
DI float fexp2(float x) { return __builtin_amdgcn_exp2f(x); }
typedef __attribute__((ext_vector_type(2))) float f32x2;
typedef __attribute__((ext_vector_type(2))) __bf16 bf16x2_t;
typedef __attribute__((ext_vector_type(2))) unsigned u32x2;
typedef __attribute__((ext_vector_type(4))) unsigned u32x4_;
DI unsigned cvt_pk(float a, float b) {
  f32x2 v; v.x = a; v.y = b;
  return __builtin_bit_cast(unsigned, __builtin_convertvector(v, bf16x2_t));
}
DI int otid(const Ctx& p) {
  int wv = p.wv; asm volatile("" : "+s"(wv));
  int t = wv * 64 + (int)__builtin_amdgcn_mbcnt_hi(~0u, __builtin_amdgcn_mbcnt_lo(~0u, 0u));
  asm volatile("" : "+v"(t));
  return t;
}
DI int obid() { int b = blockIdx.x; asm volatile("" : "+s"(b)); return b; }

__device__ const float ROPE_INV[16] = {1.0f, 0.5623413324356079f, 0.3162277638912201f, 0.17782793939113617f, 0.10000000149011612f, 0.05623413249850273f, 0.03162277489900589f, 0.017782794311642647f, 0.009999999776482582f, 0.005623413249850273f, 0.003162277629598975f, 0.0017782794311642647f, 0.0010000000474974513f, 0.000562341301701963f, 0.0003162277571391314f, 0.00017782794020604342f};

DI void wconv(const float* __restrict__ W, const float* __restrict__ g, u16* __restrict__ dst, int K, int N, int rowsOut, int perm, int gtid, int gthreads) {
  const int kc = K >> 3;
  const long total = (long)rowsOut * kc;
  for (long c = gtid; c < total; c += gthreads) {
    const int n = (int)(c % rowsOut);
    const int k0 = (int)(c / rowsOut) * 8;
    int sc;
    if (perm == 1) { const int blk = n >> 8, w = n & 255; const int j = blk * 128 + (w & 127); sc = (w < 128) ? j : DFF + j; }
    else if (perm == 3) { sc = n < 1024 ? n : (n < 2048 ? n + 512 : (n < 2560 ? n - 1024 : n)); }
    else if (perm == 2) { const int hd = (n & 1023) >> 6, d = n & 63; sc = hd * 128 + (n >= 1024 ? 64 : 0) + d; }
    else sc = n;
    uint4 o = make_uint4(0, 0, 0, 0);
    if (sc < N) {
      float v[8];
      const float rsc = (perm == 3 && (n < 512 || (n >= 1024 && n < 1536))) ? QSCALE64 : 1.f;
#pragma unroll
      for (int i = 0; i < 8; ++i) { float x = __builtin_nontemporal_load(W + (size_t)(k0 + i) * N + sc); if (g) x *= g[k0 + i]; v[i] = x * rsc; }
      o.x = pack2(v[0], v[1]); o.y = pack2(v[2], v[3]); o.z = pack2(v[4], v[5]); o.w = pack2(v[6], v[7]);
    }
    *(uint4*)(dst + (size_t)n * K + k0) = o;
  }
}

DI void phase_prep(const Ctx& p) {
  const int gtid = obid() * 512 + otid(p), gthreads = gridDim.x * 512;
  u16* wb = (u16*)p.ws;
  wconv(p.in[3], p.in[2], wb + W0IN, 1024, 3072, 3072, 3, gtid, gthreads);
  wconv(p.in[10], nullptr, wb + W0OUT, 1024, 1024, 1024, 0, gtid, gthreads);
  wconv(p.in[13], p.in[12], wb + W0F1, 1024, 5632, 5632, 1, gtid, gthreads);
  wconv(p.in[14], nullptr, wb + W0F2, 2816, 1024, 1024, 0, gtid, gthreads);
  wconv(p.in[17], p.in[16], wb + W1DN, 1024, 672, 768, 0, gtid, gthreads);
  wconv(p.in[20], p.in[18], wb + W1UQ, 384, 1536, 1536, 0, gtid, gthreads);
  wconv(p.in[21], p.in[19], wb + W1UKV, 256, 2048, 2048, 2, gtid, gthreads);
  wconv(p.in[22], nullptr, wb + W1OUT, 1024, 1024, 1024, 0, gtid, gthreads);
  wconv(p.in[25], p.in[24], wb + W1F1, 1024, 5632, 5632, 1, gtid, gthreads);
  wconv(p.in[26], nullptr, wb + W1F2, 2816, 1024, 1024, 0, gtid, gthreads);
  float2* rope = (float2*)(p.ws + OFF_ROPE);
  for (int idx = gtid; idx < 16384 * 16; idx += gthreads) {
    const int pos = idx >> 4, i = idx & 15;
    const float ang = (float)pos * ROPE_INV[i];
    double rev = (double)ang * 0.15915494309189535;
    rev -= rint(rev);
    const float rf = (float)rev;
    rope[idx] = make_float2(__builtin_amdgcn_cosf(rf), __builtin_amdgcn_sinf(rf));
  }
  if (gtid == 0) {
    float s1 = 0.f, s2 = 0.f;
    for (int i = 0; i < 64; ++i) { s1 += p.in[5][i] * p.in[6][i]; s2 += p.in[7][i] * p.in[8][i]; }
    float* sc = (float*)(p.ws + OFF_SCAL);
    sc[0] = __expf(s1) - __expf(s2) + 0.2f;
    for (int i = 0; i < 176; ++i) ((unsigned*)sc)[SC_QKMAX + i] = 0u;
  }
  {
    float* sc = (float*)(p.ws + OFF_SCAL);
    for (int i = gtid; i < 1024; i += gthreads) { sc[SC_G0 + i] = p.in[11][i]; sc[SC_G1 + i] = p.in[15][i]; sc[SC_G2 + i] = p.in[23][i]; sc[SC_G3 + i] = p.in[27][i]; }
    for (int i = gtid; i < 128; i += gthreads) sc[SC_GSUB + i] = p.in[9][i];
    for (int i = gtid; i < 8 * 465; i += gthreads) sc[SC_RPB + i] = p.in[4][i] * LOG2E;
  }
  const int tid_ = otid(p);
  const int lane = tid_ & 63;
  const int gw = obid() * 8 + (tid_ >> 6), nw = gridDim.x * 8;
  u16* hb = (u16*)(p.ws + OFF_R1);
  for (int row = gw; row < T_TOK; row += nw) {
    const float* xr = row < T_PROMPT ? p.in[0] + (size_t)row * DM : p.in[1] + (size_t)(row - T_PROMPT) * DM;
    float4 v[4];
    float ss = 0.f;
#pragma unroll
    for (int j = 0; j < 4; ++j) { const f32x4nt xx = __builtin_nontemporal_load((const f32x4nt*)xr + lane + 64 * j); v[j] = make_float4(xx.x, xx.y, xx.z, xx.w); ss += v[j].x * v[j].x + v[j].y * v[j].y + v[j].z * v[j].z + v[j].w * v[j].w; }
    ss = wave_sum(ss);
    const float r = rsqrtf(ss * (1.f / DM) + EPS);
#pragma unroll
    for (int j = 0; j < 4; ++j) {
      uint2 o; o.x = pack2(v[j].x * r, v[j].y * r); o.y = pack2(v[j].z * r, v[j].w * r);
      ((uint2*)(hb + (size_t)row * DM))[lane + 64 * j] = o;
    }
  }
}

template <bool FIRST, bool LAST>
DI void phase_res(const Ctx& p, const u16* __restrict__ mbuf, const float* __restrict__ g) {
  const int tid_ = otid(p);
  const int lane = tid_ & 63;
  const int gw = obid() * 8 + (tid_ >> 6), nw = gridDim.x * 8;
  u16* hb = (u16*)(p.ws + OFF_R1);
  float4 gv[4];
#pragma unroll
  for (int j = 0; j < 4; ++j) gv[j] = ((const float4*)g)[lane + 64 * j];
  for (int row0 = gw; row0 < T_TOK; row0 += 2 * nw) {
    float4 xv[2][4], mv[2][4];
    float ss[2] = {0.f, 0.f};
    bool act[2];
#pragma unroll
    for (int t = 0; t < 2; ++t) {
      const int row = row0 + t * nw;
      act[t] = row < T_TOK;
      const int rr = act[t] ? row : row0;
      const float* xr;
      if (FIRST) xr = rr < T_PROMPT ? p.in[0] + (size_t)rr * DM : p.in[1] + (size_t)(rr - T_PROMPT) * DM;
      else xr = p.out + (size_t)rr * DM;
#pragma unroll
      for (int j = 0; j < 4; ++j) {
        const u32x2 u = __builtin_nontemporal_load((const u32x2*)(mbuf + (size_t)rr * DM) + lane + 64 * j);
        mv[t][j] = make_float4(bflo(u.x), bfhi(u.x), bflo(u.y), bfhi(u.y));
        { const f32x4nt xx = __builtin_nontemporal_load((const f32x4nt*)xr + lane + 64 * j); xv[t][j] = make_float4(xx.x, xx.y, xx.z, xx.w); }
      }
    }
#pragma unroll
    for (int t = 0; t < 2; ++t) {
#pragma unroll
      for (int j = 0; j < 4; ++j) ss[t] += mv[t][j].x * mv[t][j].x + mv[t][j].y * mv[t][j].y + mv[t][j].z * mv[t][j].z + mv[t][j].w * mv[t][j].w;
      ss[t] = wave_sum(ss[t]);
    }
#pragma unroll
    for (int t = 0; t < 2; ++t) {
      if (!act[t]) continue;
      const int row = row0 + t * nw;
      const float rm = rsqrtf(ss[t] * (1.f / DM) + EPS);
      float s2 = 0.f;
#pragma unroll
      for (int j = 0; j < 4; ++j) {
        xv[t][j].x += mv[t][j].x * rm * gv[j].x; xv[t][j].y += mv[t][j].y * rm * gv[j].y;
        xv[t][j].z += mv[t][j].z * rm * gv[j].z; xv[t][j].w += mv[t][j].w * rm * gv[j].w;
        s2 += xv[t][j].x * xv[t][j].x + xv[t][j].y * xv[t][j].y + xv[t][j].z * xv[t][j].z + xv[t][j].w * xv[t][j].w;
        { f32x4nt xx; xx.x = xv[t][j].x; xx.y = xv[t][j].y; xx.z = xv[t][j].z; xx.w = xv[t][j].w; __builtin_nontemporal_store(xx, (f32x4nt*)(p.out + (size_t)row * DM) + lane + 64 * j); }
      }
      if (!LAST) {
        s2 = wave_sum(s2);
        const float r2 = rsqrtf(s2 * (1.f / DM) + EPS);
#pragma unroll
        for (int j = 0; j < 4; ++j) {
          uint2 o; o.x = pack2(xv[t][j].x * r2, xv[t][j].y * r2); o.y = pack2(xv[t][j].z * r2, xv[t][j].w * r2);
          ((uint2*)(hb + (size_t)row * DM))[lane + 64 * j] = o;
        }
      }
    }
  }
}

DI void phase_mla_stats(const Ctx& p) {
  const int tid_ = otid(p);
  const int lane = tid_ & 63;
  const int gw = obid() * 8 + (tid_ >> 6), nw = gridDim.x * 8;
  const u16* c = (const u16*)(p.ws + OFF_R3);
  float* rq = (float*)(p.ws + OFF_RQ);
  float* rkv = (float*)(p.ws + OFF_RKV);
  u16* krope = (u16*)(p.ws + OFF_KROPE);
  const float2* rope = (const float2*)(p.ws + OFF_ROPE);
  float krmax2 = 0.f;
  for (int row = gw; row < T_TOK; row += nw) {
    const u16* cr = c + (size_t)row * 768;
    const uint4 u0 = ((const uint4*)cr)[lane];
    float s0 = 0.f;
    { float a;
      a = bflo(u0.x); s0 += a * a; a = bfhi(u0.x); s0 += a * a; a = bflo(u0.y); s0 += a * a; a = bfhi(u0.y); s0 += a * a;
      a = bflo(u0.z); s0 += a * a; a = bfhi(u0.z); s0 += a * a; a = bflo(u0.w); s0 += a * a; a = bfhi(u0.w); s0 += a * a; }
    float s1 = 0.f;
    if (lane < 16) {
      const uint4 u1 = ((const uint4*)cr)[64 + lane];
      float a;
      a = bflo(u1.x); s1 += a * a; a = bfhi(u1.x); s1 += a * a; a = bflo(u1.y); s1 += a * a; a = bfhi(u1.y); s1 += a * a;
      a = bflo(u1.z); s1 += a * a; a = bfhi(u1.z); s1 += a * a; a = bflo(u1.w); s1 += a * a; a = bfhi(u1.w); s1 += a * a;
    }
    const float sq = wave_sum(lane < 48 ? s0 : 0.f);
    const float skv = wave_sum((lane >= 48 ? s0 : 0.f) + s1);
    if (lane == 0) {
      rq[row] = rsqrtf(sq * (1.f / 384.f) + EPS);
      rkv[row] = rsqrtf(skv * (1.f / 256.f) + EPS);
    }
    float kr2 = 0.f;
    if (lane < 16) {
      const float x1 = __uint_as_float((unsigned)cr[640 + lane] << 16);
      const float x2 = __uint_as_float((unsigned)cr[656 + lane] << 16);
      const float2 cs = rope[tok_pos(row) * 16 + lane];
      const float o1 = x1 * cs.x - x2 * cs.y, o2 = x2 * cs.x + x1 * cs.y;
      krope[(size_t)row * 32 + lane] = f2bf(o1);
      krope[(size_t)row * 32 + 16 + lane] = f2bf(o2);
      kr2 = o1 * o1 + o2 * o2;
    }
    krmax2 = fmaxf(krmax2, wave_sum(kr2));
  }
  if (lane == 0) atomicMax((unsigned*)(p.ws + OFF_SCAL) + SC_KRMAX, __float_as_uint(sqrtf(krmax2)));
}

DI void store_tok(u16* out, int ldo, int m, int nbase, const f32x16& v, float sc) {
  u16* q = out + (size_t)m * ldo + nbase;
#pragma unroll
  for (int g = 0; g < 4; ++g) {
    uint2 u; u.x = pack2(v[4 * g] * sc, v[4 * g + 1] * sc); u.y = pack2(v[4 * g + 2] * sc, v[4 * g + 3] * sc);
    *(uint2*)(q + 8 * g) = u;
  }
}
DI void store_tr(u16* outT, size_t ldt, int n, int mbase, const f32x16& v, const float* __restrict__ rs) {
  u16* q = outT + (size_t)n * ldt + mbase;
#pragma unroll
  for (int g = 0; g < 4; ++g) {
    float4 s = make_float4(1.f, 1.f, 1.f, 1.f);
    if (rs) s = *(const float4*)(rs + mbase + 8 * g);
    uint2 u; u.x = pack2(v[4 * g] * s.x, v[4 * g + 1] * s.y); u.y = pack2(v[4 * g + 2] * s.z, v[4 * g + 3] * s.w);
    *(uint2*)(q + 8 * g) = u;
  }
}

DI void store_tok_u(u16* ub, unsigned loff, const f32x16& v, float sc) {
  char* q = (char*)ub;
  const unsigned hoff = (loff & 8u) << 1;
  const unsigned lbase = loff & ~8u;
#pragma unroll
  for (int pi = 0; pi < 2; ++pi) {
    const int g0 = 2 * pi, g1 = 2 * pi + 1;
    const unsigned a0 = cvt_pk(v[4 * g0] * sc, v[4 * g0 + 1] * sc), a1 = cvt_pk(v[4 * g0 + 2] * sc, v[4 * g0 + 3] * sc);
    const unsigned b0 = cvt_pk(v[4 * g1] * sc, v[4 * g1 + 1] * sc), b1 = cvt_pk(v[4 * g1 + 2] * sc, v[4 * g1 + 3] * sc);
    const u32x2 s0 = __builtin_amdgcn_permlane32_swap(a0, b0, false, false);
    const u32x2 s1 = __builtin_amdgcn_permlane32_swap(a1, b1, false, false);
    u32x4 u; u.x = s0.x; u.y = s1.x; u.z = s0.y; u.w = s1.y;
    *(u32x4*)(q + lbase + hoff + 32 * pi) = u;
  }
}
DI void store_tr_u(u16* ub, unsigned loff, const f32x16& v, const float* __restrict__ rs) {
  char* q = (char*)ub;
  const unsigned hoff = (loff & 8u) << 1;
  const unsigned lbase = loff & ~8u;
#pragma unroll
  for (int pi = 0; pi < 2; ++pi) {
    const int g0 = 2 * pi, g1 = 2 * pi + 1;
    float4 sa = make_float4(1.f, 1.f, 1.f, 1.f), sb = sa;
    if (rs) { sa = *(const float4*)(rs + 8 * g0); sb = *(const float4*)(rs + 8 * g1); }
    const unsigned a0 = cvt_pk(v[4 * g0] * sa.x, v[4 * g0 + 1] * sa.y), a1 = cvt_pk(v[4 * g0 + 2] * sa.z, v[4 * g0 + 3] * sa.w);
    const unsigned b0 = cvt_pk(v[4 * g1] * sb.x, v[4 * g1 + 1] * sb.y), b1 = cvt_pk(v[4 * g1 + 2] * sb.z, v[4 * g1 + 3] * sb.w);
    const u32x2 s0 = __builtin_amdgcn_permlane32_swap(a0, b0, false, false);
    const u32x2 s1 = __builtin_amdgcn_permlane32_swap(a1, b1, false, false);
    u32x4 u; u.x = s0.x; u.y = s1.x; u.z = s0.y; u.w = s1.y;
    *(u32x4*)(q + lbase + hoff + 32 * pi) = u;
  }
}

struct EpiTok {
  u16* out; int ldo;
  static constexpr int SWAPMODE = 1;
  DI bool swap(int) const { return true; }
  template <int WMB, int WNB>
  DI void store(int m0w, int n0w, f32x16 (&acc)[WMB][WNB], int r, int h, bool) const {
#pragma unroll
    for (int mb = 0; mb < WMB; ++mb)
#pragma unroll
      for (int nb = 0; nb < WNB; ++nb) store_tok_u(out + (size_t)(m0w + mb * 32) * ldo + n0w + nb * 32, (unsigned)((r * ldo + 4 * h) * 2), acc[mb][nb], 1.f);
  }
};

struct EpiProj0 {
  u16* base; unsigned* qkmax;
  static constexpr int SWAPMODE = 2;
  DI bool swap(int n0) const { const int reg = n0 >> 9; return !(reg == 2 || reg == 5); }
  template <int WMB, int WNB>
  DI void store(int m0w, int n0w, f32x16 (&acc)[WMB][WNB], int r, int h, bool) const {
    const int reg = n0w >> 9, nl = n0w & 511;
    u16* buf = base + (size_t)reg * SEG512;
    const float sc = (reg == 0 || reg == 3) ? QSCALE64 : 1.f;
#pragma unroll
    for (int mb = 0; mb < WMB; ++mb)
#pragma unroll
      for (int nb = 0; nb < WNB; ++nb) store_tok_u(buf + (size_t)(m0w + mb * 32) * 512 + nl + nb * 32, (unsigned)((r * 512 + 4 * h) * 2), acc[mb][nb], sc);
    __builtin_amdgcn_sched_barrier(0);
    if (reg == 3 || reg == 4) {
      static_assert(WNB == 2, "one head per wave tile");
      float mxn = 0.f;
#pragma unroll
      for (int mb = 0; mb < WMB; ++mb) {
        float ss = 0.f;
#pragma unroll
        for (int nb = 0; nb < WNB; ++nb)
#pragma unroll
          for (int i = 0; i < 16; ++i) { const float v = acc[mb][nb][i]; ss += v * v; }
        { const u32x2 sw = __builtin_amdgcn_permlane32_swap(__float_as_uint(ss), __float_as_uint(ss), false, false); ss = __uint_as_float(sw.x) + __uint_as_float(sw.y); }
        mxn = fmaxf(mxn, ss);
      }
      mxn = fmaxf(mxn, __int_as_float(__builtin_amdgcn_ds_swizzle(__float_as_int(mxn), (16 << 10) | 0x1f)));
      mxn = fmaxf(mxn, __int_as_float(__builtin_amdgcn_ds_swizzle(__float_as_int(mxn), (8 << 10) | 0x1f)));
      mxn = fmaxf(mxn, __int_as_float(__builtin_amdgcn_ds_swizzle(__float_as_int(mxn), (4 << 10) | 0x1f)));
      mxn = fmaxf(mxn, __int_as_float(__builtin_amdgcn_ds_swizzle(__float_as_int(mxn), (2 << 10) | 0x1f)));
      mxn = fmaxf(mxn, __int_as_float(__builtin_amdgcn_ds_swizzle(__float_as_int(mxn), (1 << 10) | 0x1f)));
      if (r == 0 && h == 0) atomicMax(qkmax + (reg - 3) * 8 + (nl >> 6), __float_as_uint(sqrtf(mxn) * sc));
    }
  }
  template <int WMB, int WNB>
  DI void store_t(int n0w, int m0w, f32x16 (&acc)[WMB][WNB], int r, int h) const {
    const int reg = n0w >> 9, nl = n0w & 511;
    u16* buf = base + (size_t)reg * SEG512;
#pragma unroll
    for (int mb = 0; mb < WMB; ++mb)
#pragma unroll
      for (int nb = 0; nb < WNB; ++nb) store_tr_u(buf + (size_t)(nl + mb * 32) * T_TOK + m0w + nb * 32, (unsigned)((r * T_TOK + 4 * h) * 2), acc[mb][nb], nullptr);
  }
};

struct EpiSwiGLU {
  u16* act;
  static constexpr int SWAPMODE = 1;
  DI bool swap(int) const { return true; }
  template <int WMB, int WNB>
  DI void store(int m0w, int n0w, f32x16 (&acc)[WMB][WNB], int r, int h, bool) const {
    static_assert(WNB == 2, "swiglu epilogue needs a 64-wide wave tile");
#pragma unroll
    for (int mb = 0; mb < WMB; ++mb) {
      char* q = (char*)(act + (size_t)(m0w + mb * 32) * DFF + (n0w >> 1)) + (unsigned)((r * DFF) * 2) + 16 * h;
#pragma unroll
      for (int pi = 0; pi < 2; ++pi) {
        unsigned pk[2][2];
#pragma unroll
        for (int gg = 0; gg < 2; ++gg) {
          const int g = 2 * pi + gg;
          float y[4];
#pragma unroll
          for (int e = 0; e < 4; ++e) {
            const float gt = acc[mb][0][4 * g + e], up = acc[mb][1][4 * g + e];
            y[e] = gt * __builtin_amdgcn_rcpf(1.f + fexp2(-LOG2E * gt)) * up;
          }
          pk[gg][0] = cvt_pk(y[0], y[1]); pk[gg][1] = cvt_pk(y[2], y[3]);
        }
        const u32x2 s0 = __builtin_amdgcn_permlane32_swap(pk[0][0], pk[1][0], false, false);
        const u32x2 s1 = __builtin_amdgcn_permlane32_swap(pk[0][1], pk[1][1], false, false);
        u32x4 u; u.x = s0.x; u.y = s1.x; u.z = s0.y; u.w = s1.y;
        *(u32x4*)(q + 32 * pi) = u;
      }
      __builtin_amdgcn_sched_barrier(0);
    }
  }
};

struct EpiUQ {
  u16* q; const float* rq; const float2* rope;
  static constexpr int SWAPMODE = 1;
  DI bool swap(int) const { return true; }
  template <int WMB, int WNB>
  DI void store(int m0w, int n0w, f32x16 (&acc)[WMB][WNB], int r, int h, bool) const {
#pragma unroll
    for (int mb = 0; mb < WMB; ++mb) {
      const int m = m0w + mb * 32 + r;
      const float sc = rq[m] * QSCALE96;
      const int pos = tok_pos(m);
#pragma unroll
      for (int nb = 0; nb < WNB; ++nb) {
        const int n0b = n0w + nb * 32;
        f32x16 v = acc[mb][nb];
#pragma unroll
        for (int i = 0; i < 16; ++i) v[i] *= sc;
        if (((n0b >> 5) % 3) == 2) {
#pragma unroll
          for (int i = 0; i < 8; ++i) {
            const int f = (i & 3) + 8 * (i >> 2) + 4 * h;
            const float2 cs = rope[pos * 16 + f];
            const float x1 = v[i], x2 = v[i + 8];
            v[i] = x1 * cs.x - x2 * cs.y;
            v[i + 8] = x2 * cs.x + x1 * cs.y;
          }
        }
        store_tok_u(q + (size_t)(m0w + mb * 32) * 1536 + n0b, (unsigned)((r * 1536 + 4 * h) * 2), v, 1.f);
        __builtin_amdgcn_sched_barrier(0);
      }
    }
  }
};

struct EpiUKV {
  u16* knope; u16* vt; const float* rkv; unsigned* kmax;
  static constexpr int SWAPMODE = 2;
  DI bool swap(int n0) const { return n0 < 1024; }
  template <int WMB, int WNB>
  DI void store(int m0w, int n0w, f32x16 (&acc)[WMB][WNB], int r, int h, bool) const {
#pragma unroll
    for (int mb = 0; mb < WMB; ++mb) {
      const int m = m0w + mb * 32 + r;
      const float sc = rkv[m];
#pragma unroll
      for (int nb = 0; nb < WNB; ++nb) store_tok_u(knope + (size_t)(m0w + mb * 32) * 1024 + n0w + nb * 32, (unsigned)((r * 1024 + 4 * h) * 2), acc[mb][nb], sc);
    }
    __builtin_amdgcn_sched_barrier(0);
    static_assert(WNB == 2, "one head per wave tile");
    float mxn = 0.f;
#pragma unroll
    for (int mb = 0; mb < WMB; ++mb) {
      float ss = 0.f;
#pragma unroll
      for (int nb = 0; nb < WNB; ++nb)
#pragma unroll
        for (int i = 0; i < 16; ++i) { const float v = acc[mb][nb][i]; ss += v * v; }
      { const u32x2 sw = __builtin_amdgcn_permlane32_swap(__float_as_uint(ss), __float_as_uint(ss), false, false); ss = __uint_as_float(sw.x) + __uint_as_float(sw.y); }
      const float sc = rkv[m0w + mb * 32 + r];
      mxn = fmaxf(mxn, ss * sc * sc);
    }
    mxn = fmaxf(mxn, __int_as_float(__builtin_amdgcn_ds_swizzle(__float_as_int(mxn), (16 << 10) | 0x1f)));
    mxn = fmaxf(mxn, __int_as_float(__builtin_amdgcn_ds_swizzle(__float_as_int(mxn), (8 << 10) | 0x1f)));
    mxn = fmaxf(mxn, __int_as_float(__builtin_amdgcn_ds_swizzle(__float_as_int(mxn), (4 << 10) | 0x1f)));
    mxn = fmaxf(mxn, __int_as_float(__builtin_amdgcn_ds_swizzle(__float_as_int(mxn), (2 << 10) | 0x1f)));
    mxn = fmaxf(mxn, __int_as_float(__builtin_amdgcn_ds_swizzle(__float_as_int(mxn), (1 << 10) | 0x1f)));
    if (r == 0 && h == 0) atomicMax(kmax + (n0w >> 6), __float_as_uint(sqrtf(mxn)));
  }
  template <int WMB, int WNB>
  DI void store_t(int n0w, int m0w, f32x16 (&acc)[WMB][WNB], int r, int h) const {
#pragma unroll
    for (int mb = 0; mb < WMB; ++mb)
#pragma unroll
      for (int nb = 0; nb < WNB; ++nb) store_tr_u(vt + (size_t)(n0w - 1024 + mb * 32) * T_TOK + m0w + nb * 32, (unsigned)((r * T_TOK + 4 * h) * 2), acc[mb][nb], rkv + m0w + nb * 32 + 4 * h);
  }
};

template <bool SWAP, int WMB, int WNB>
DI void gemm_compute(const char* la, const char* lb, f32x16 (&acc)[WMB][WNB], int wm, int wn, int r, int h) {
#pragma unroll
  for (int ks = 0; ks < 4; ++ks) {
    bf16x8 af[WMB], bfr[WNB];
#pragma unroll
    for (int mb = 0; mb < WMB; ++mb) af[mb] = *(const bf16x8*)(la + (wm * 32 * WMB + mb * 32 + r) * 144 + (ks * 2 + h) * 16);
#pragma unroll
    for (int nb = 0; nb < WNB; ++nb) bfr[nb] = *(const bf16x8*)(lb + (wn * 32 * WNB + nb * 32 + r) * 144 + (ks * 2 + h) * 16);
#pragma unroll
    for (int mb = 0; mb < WMB; ++mb)
#pragma unroll
      for (int nb = 0; nb < WNB; ++nb) {
        if (SWAP) acc[mb][nb] = MFMA32(bfr[nb], af[mb], acc[mb][nb]);
        else acc[mb][nb] = MFMA32(af[mb], bfr[nb], acc[mb][nb]);
      }
  }
}

struct TileDesc { bool valid; bool normal; int m0, n0, ldp, ldq; unsigned po, qo; const char* P; const char* Q; };

template <class Epi>
DI void gemm_phase(const u16* __restrict__ A, int lda, const u16* __restrict__ Bt, int ldb, int M, int N, int K, const Epi epi, char* lds, int bid, int nblk, const Ctx& p) {
  constexpr int WMB = 4, WNB = 2;
  constexpr int TM = 256, TN = 256;
  constexpr int STAGE = (TM + TN) * 144;
  const int tid = otid(p), lane = tid & 63, w = __builtin_amdgcn_readfirstlane(tid >> 6), wm = w >> 2, wn = w & 3, r = lane & 31, h = lane >> 5;
  const int lrow = tid >> 3, lch = tid & 7;
  const int NT = N / TN, MT = M / TM, tiles = MT * NT, nk = K >> 6;
  const int rounds = (tiles + nblk - 1) / nblk;
  auto desc = [&](int rnd) {
    TileDesc d;
    int tile = rnd * nblk + bid;
    if (nblk == 256) tile = rnd * 256 + (bid & 7) * 32 + (bid >> 3);
    d.valid = rnd < rounds && tile < tiles;
    const int grp = tile / (8 * NT), within = tile - grp * (8 * NT);
    const int nt = within >> 3, mt = grp * 8 + (within & 7);
    d.m0 = mt * TM; d.n0 = nt * TN;
    d.normal = true;
    if constexpr (Epi::SWAPMODE == 2) d.normal = epi.swap(d.n0);
    const char* Ab = (const char*)A + (size_t)d.m0 * lda * 2;
    const char* Bb = (const char*)Bt + (size_t)d.n0 * ldb * 2;
    const unsigned aoff = (unsigned)(lrow * lda * 2 + lch * 16), boff = (unsigned)(lrow * ldb * 2 + lch * 16);
    d.P = d.normal ? Ab : Bb; d.Q = d.normal ? Bb : Ab;
    d.po = d.normal ? aoff : boff; d.qo = d.normal ? boff : aoff;
    d.ldp = d.normal ? lda : ldb; d.ldq = d.normal ? ldb : lda;
    return d;
  };
  u32x4 pa[4], pb[4];
  auto issue = [&](const TileDesc& d, int kt) {
    const char* Pk = d.P + (size_t)kt * 128; asm volatile("" : "+s"(Pk));
    const char* Qk = d.Q + (size_t)kt * 128; asm volatile("" : "+s"(Qk));
#pragma unroll
    for (int j = 0; j < 4; ++j) pa[j] = *(const u32x4*)(Pk + (size_t)j * 128 * d.ldp + d.po);
#pragma unroll
    for (int j = 0; j < 4; ++j) pb[j] = *(const u32x4*)(Qk + (size_t)j * 128 * d.ldq + d.qo);
  };
  auto write_stage = [&](int b) {
    char* wa = lds + b * STAGE;
    char* wb = wa + TM * 144;
#pragma unroll
    for (int j = 0; j < 4; ++j) *(u32x4*)(wa + (lrow + 64 * j) * 144 + lch * 16) = pa[j];
#pragma unroll
    for (int j = 0; j < 4; ++j) *(u32x4*)(wb + (lrow + 64 * j) * 144 + lch * 16) = pb[j];
  };
  TileDesc cur = desc(0);
  if (!cur.valid) return;
  issue(cur, 0);
  for (int rnd = 0;; ++rnd) {
    f32x16 acc[WMB][WNB];
#pragma unroll
    for (int mb = 0; mb < WMB; ++mb)
#pragma unroll
      for (int nb = 0; nb < WNB; ++nb)
#pragma unroll
        for (int i = 0; i < 16; ++i) acc[mb][nb][i] = 0.f;
    write_stage(0);
    if (nk > 1) issue(cur, 1);
    __syncthreads();
    if (w < 4) {
      for (int kt = 0; kt < nk; ++kt) {
        const char* la = lds + (kt & 1) * STAGE;
        if (kt + 1 < nk) write_stage((kt + 1) & 1);
        if (kt + 2 < nk) issue(cur, kt + 2);
        gemm_compute<true, WMB, WNB>(la, la + TM * 144, acc, wm, wn, r, h);
        __syncthreads();
      }
    } else {
      for (int kt = 0; kt < nk; ++kt) {
        const char* la = lds + (kt & 1) * STAGE;
        gemm_compute<true, WMB, WNB>(la, la + TM * 144, acc, wm, wn, r, h);
        if (kt + 1 < nk) write_stage((kt + 1) & 1);
        if (kt + 2 < nk) issue(cur, kt + 2);
        __syncthreads();
      }
    }
    const TileDesc nxt = desc(rnd + 1);
    if (nxt.valid) issue(nxt, 0);
    __builtin_amdgcn_sched_barrier(0);
    int m0 = cur.m0, n0 = cur.n0;
    asm volatile("" : "+s"(m0), "+s"(n0));
    int r2 = r, h2 = h, wm2 = wm, wn2 = wn;
    asm volatile("" : "+v"(r2), "+v"(h2));
    asm volatile("" : "+s"(wm2), "+s"(wn2));
    if constexpr (Epi::SWAPMODE == 2) {
      if (cur.normal) epi.template store<WMB, WNB>(m0 + wm2 * 32 * WMB, n0 + wn2 * 32 * WNB, acc, r2, h2, true);
      else epi.template store_t<WMB, WNB>(n0 + wm2 * 32 * WMB, m0 + wn2 * 32 * WNB, acc, r2, h2);
    } else {
      epi.template store<WMB, WNB>(m0 + wm2 * 32 * WMB, n0 + wn2 * 32 * WNB, acc, r2, h2, true);
    }
    if (!nxt.valid) break;
    cur = nxt;
  }
}

DI void lds_st16_as2x8(char* dst, const u32x4 v) {
  u32x2 a; a.x = v.x; a.y = v.y; u32x2 b; b.x = v.z; b.y = v.w;
  *(u32x2*)dst = a;
  *(u32x2*)(dst + 8) = b;
}
DI void lds_st_vt(char* row, int ch, const u32x4 v) {
  u32x2 a; a.x = v.x; a.y = v.y; u32x2 b; b.x = v.z; b.y = v.w;
  char* g = row + (ch >> 1) * 32 + (ch & 1) * 8;
  *(u32x2*)g = a;
  *(u32x2*)(g + 16) = b;
}
constexpr int ATT_STAGE = 36864;
constexpr float DEFER_THR = 8.f;

template <int DQK>
DI void qk_scores_acc(const char* kl, const bf16x8 (&qf)[DQK / 16], f32x16 (&s)[2], int r, int h) {
  constexpr int KS = DQK * 2 + 16;
#pragma unroll
  for (int kb = 0; kb < 2; ++kb)
#pragma unroll
    for (int ks = 0; ks < DQK / 16; ++ks) {
      const bf16x8 a = *(const bf16x8*)(kl + (32 * kb + r) * KS + (2 * ks + h) * 16);
      s[kb] = MFMA32(a, qf[ks], s[kb]);
    }
}
template <int DQK>
DI void qk_scores_qlds(const char* kl, const char* qsl, f32x16 (&s)[2], int r, int h) {
  constexpr int KS = DQK * 2 + 16;
#pragma unroll
  for (int kb = 0; kb < 2; ++kb) {
#pragma unroll
    for (int ks = 0; ks < DQK / 16; ++ks) {
      const bf16x8 a = *(const bf16x8*)(kl + (32 * kb + r) * KS + (2 * ks + h) * 16);
      const bf16x8 qv = *(const bf16x8*)(qsl + ks * 1024);
      s[kb] = MFMA32(a, qv, s[kb]);
    }
  }
}
template <int DQK>
DI void qk_scores(const char* kl, const bf16x8 (&qf)[DQK / 16], const f32x16& initv, f32x16 (&s)[2], int r, int h) {
  constexpr int KS = DQK * 2 + 16;
#pragma unroll
  for (int kb = 0; kb < 2; ++kb) {
    s[kb] = initv;
#pragma unroll
    for (int ks = 0; ks < DQK / 16; ++ks) {
      const bf16x8 a = *(const bf16x8*)(kl + (32 * kb + r) * KS + (2 * ks + h) * 16);
      s[kb] = MFMA32(a, qf[ks], s[kb]);
    }
  }
}

template <int DV>
DI float softmax_pv(f32x16 (&s)[2], f32x16 (&o)[DV / 32], float& l, bool first, const char* vl, int r, int h) {
  float dret = 0.f;
  float mx = fmaxf(fmaxf(s[0][0], s[0][1]), s[0][2]);
#pragma unroll
  for (int i = 3; i < 15; i += 2) mx = fmaxf(fmaxf(mx, s[0][i]), s[0][i + 1]);
  mx = fmaxf(fmaxf(mx, s[0][15]), s[1][0]);
#pragma unroll
  for (int i = 1; i < 15; i += 2) mx = fmaxf(fmaxf(mx, s[1][i]), s[1][i + 1]);
  mx = fmaxf(mx, s[1][15]);
  const bool need = first || (mx > DEFER_THR);
  if (__any(need)) {
    mx = fmaxf(mx, __shfl_xor(mx, 32));
    float delta;
    if (first) delta = mx;
    else {
      delta = fmaxf(mx, 0.f);
      const float alpha = fexp2(-delta);
      l *= alpha;
#pragma unroll
      for (int d = 0; d < DV / 32; ++d)
#pragma unroll
        for (int i = 0; i < 16; ++i) o[d][i] *= alpha;
    }
#pragma unroll
    for (int kb = 0; kb < 2; ++kb)
#pragma unroll
      for (int i = 0; i < 16; ++i) s[kb][i] -= delta;
    dret = delta;
  }
  float ps = 0.f;
#pragma unroll
  for (int kb = 0; kb < 2; ++kb)
#pragma unroll
    for (int i = 0; i < 16; ++i) { const float e = fexp2(s[kb][i]); s[kb][i] = e; ps += e; }
  l += ps;
  bf16x8 pf[2][2];
#pragma unroll
  for (int kb = 0; kb < 2; ++kb)
#pragma unroll
    for (int st = 0; st < 2; ++st) {
      u32x4 u;
      u.x = cvt_pk(s[kb][8 * st + 0], s[kb][8 * st + 1]); u.y = cvt_pk(s[kb][8 * st + 2], s[kb][8 * st + 3]);
      u.z = cvt_pk(s[kb][8 * st + 4], s[kb][8 * st + 5]); u.w = cvt_pk(s[kb][8 * st + 6], s[kb][8 * st + 7]);
      pf[kb][st] = __builtin_bit_cast(bf16x8, u);
    }
#pragma unroll
  for (int d = 0; d < DV / 32; ++d)
#pragma unroll
    for (int kb = 0; kb < 2; ++kb)
#pragma unroll
      for (int st = 0; st < 2; ++st) {
        const u32x4 u = *(const u32x4*)(vl + (32 * d + r) * 144 + (2 * kb + st) * 32 + h * 16);
        o[d] = MFMA32(__builtin_bit_cast(bf16x8, u), pf[kb][st], o[d]);
      }
  return dret;
}

template <int DV>
DI float softmax_pre(f32x16 (&s)[2], f32x16 (&o)[DV / 32], float& l, bool first) {
  float dret = 0.f;
  float mx = fmaxf(fmaxf(s[0][0], s[0][1]), s[0][2]);
#pragma unroll
  for (int i = 3; i < 15; i += 2) mx = fmaxf(fmaxf(mx, s[0][i]), s[0][i + 1]);
  mx = fmaxf(fmaxf(mx, s[0][15]), s[1][0]);
#pragma unroll
  for (int i = 1; i < 15; i += 2) mx = fmaxf(fmaxf(mx, s[1][i]), s[1][i + 1]);
  mx = fmaxf(mx, s[1][15]);
  const bool need = first || (mx > DEFER_THR);
  if (__any(need)) {
    mx = fmaxf(mx, __shfl_xor(mx, 32));
    float delta;
    if (first) delta = mx;
    else {
      delta = fmaxf(mx, 0.f);
      const float alpha = fexp2(-delta);
      l *= alpha;
#pragma unroll
      for (int d = 0; d < DV / 32; ++d)
#pragma unroll
        for (int i = 0; i < 16; ++i) o[d][i] *= alpha;
    }
#pragma unroll
    for (int kb = 0; kb < 2; ++kb)
#pragma unroll
      for (int i = 0; i < 16; ++i) s[kb][i] -= delta;
    dret = delta;
  }
  return dret;
}
DI void softmax_exp_half(f32x16& s, float& l, bf16x8 (&pf)[2]) {
  float ps = 0.f;
#pragma unroll
  for (int i = 0; i < 16; ++i) { const float e = fexp2(s[i]); s[i] = e; ps += e; }
  l += ps;
#pragma unroll
  for (int st = 0; st < 2; ++st) {
    u32x4 u;
    u.x = cvt_pk(s[8 * st + 0], s[8 * st + 1]); u.y = cvt_pk(s[8 * st + 2], s[8 * st + 3]);
    u.z = cvt_pk(s[8 * st + 4], s[8 * st + 5]); u.w = cvt_pk(s[8 * st + 6], s[8 * st + 7]);
    pf[st] = __builtin_bit_cast(bf16x8, u);
  }
}
template <int DV>
DI void pv_half(const bf16x8 (&pf)[2], f32x16 (&o)[DV / 32], const char* vl, int kb, int r, int h) {
#pragma unroll
  for (int d = 0; d < DV / 32; ++d)
#pragma unroll
    for (int st = 0; st < 2; ++st) {
      const u32x4 u = *(const u32x4*)(vl + (32 * d + r) * 144 + (2 * kb + st) * 32 + h * 16);
      o[d] = MFMA32(__builtin_bit_cast(bf16x8, u), pf[st], o[d]);
    }
}

template <int ABL>
DI void attn_mla_item(const Ctx& p, int item, char* lds) {
  constexpr int DQK = 96, DV = 64, KS = DQK * 2 + 16;
  const int tid = otid(p), lane = tid & 63, w = tid >> 6, r = lane & 31, h = lane >> 5;
  int head, qb, ts0, S;
  if (item < 1024) { head = item >> 6; qb = item & 63; ts0 = T_PROMPT; S = 16384; }
  else { const int it = item - 1024; qb = it & 15; head = (it >> 4) & 15; ts0 = (it >> 8) * 4096; S = 4096; }
  const u16* q = (const u16*)(p.ws + OFF_R2);
  const u16* knope = q + (size_t)T_TOK * 1536;
  const u16* vt = knope + (size_t)T_TOK * 1024;
  const u16* krope = (const u16*)(p.ws + OFF_KROPE);
  u16* o1 = (u16*)(p.ws + OFF_R1);
  const int tq = ts0 + qb * 256 + w * 32 + r;
  bf16x8 qf[DQK / 16];
#pragma unroll
  for (int ks = 0; ks < DQK / 16; ++ks) qf[ks] = *(const bf16x8*)(q + (size_t)tq * 1536 + head * 96 + 16 * ks + 8 * h);
  f32x16 o[DV / 32];
#pragma unroll
  for (int d = 0; d < DV / 32; ++d)
#pragma unroll
    for (int i = 0; i < 16; ++i) o[d][i] = 0.f;
  f32x16 initv;
#pragma unroll
  for (int i = 0; i < 16; ++i) initv[i] = 0.f;
  float l = 0.f;
  u32x4 pk0, pk1, pv0;
  const int c1 = 512 + tid;
  const int krow0 = tid / 12, kch0 = tid - krow0 * 12;
  const int krow1 = c1 / 12, kch1 = c1 - krow1 * 12;
  const int vrow = tid >> 3, vch = tid & 7;
  const int nkt = S >> 6;
  auto prefetch = [&](int kt) {
    const int tk0 = ts0 + kt * 64;
    {
      const u16* src = kch0 < 8 ? knope + (size_t)(tk0 + krow0) * 1024 + head * 64 + kch0 * 8 : krope + (size_t)(tk0 + krow0) * 32 + (kch0 - 8) * 8;
      pk0 = *(const u32x4*)src;
    }
    if (tid < 256) {
      const u16* src = kch1 < 8 ? knope + (size_t)(tk0 + krow1) * 1024 + head * 64 + kch1 * 8 : krope + (size_t)(tk0 + krow1) * 32 + (kch1 - 8) * 8;
      pk1 = *(const u32x4*)src;
    }
    pv0 = *(const u32x4*)(vt + (size_t)(head * 64 + vrow) * T_TOK + tk0 + vch * 8);
  };
  auto stage_at = [&](int boff) {
    char* kl = lds + boff;
    char* vl = kl + 64 * KS;
    *(u32x4*)(kl + krow0 * KS + kch0 * 16) = pk0;
    if (tid < 256) *(u32x4*)(kl + krow1 * KS + kch1 * 16) = pk1;
    lds_st_vt(vl + vrow * 144, vch, pv0);
  };
  prefetch(0);
  __syncthreads();
  stage_at(0);
  prefetch(1);
  stage_at(ATT_STAGE);
  if (nkt > 2) prefetch(2);
  __syncthreads();
  int cur = 0, nxt = ATT_STAGE, nn = 2 * ATT_STAGE;
  f32x16 s[2];
  qk_scores<DQK>(lds, qf, initv, s, r, h);
#pragma unroll 1
  for (int kt = 0; kt < nkt; ++kt) {
    if (ABL == 2) { __syncthreads(); if (kt + 2 < nkt) stage_at(nn); if (kt + 3 < nkt) prefetch(kt + 3); { const int t = cur; cur = nxt; nxt = nn; nn = t; } continue; }
    const float dl = softmax_pre<DV>(s, o, l, kt == 0);
    if (__any(dl != 0.f)) {
#pragma unroll
      for (int i = 0; i < 16; ++i) initv[i] -= dl;
    }
    f32x16 sn[2];
    qk_scores<DQK>(lds + nxt, qf, initv, sn, r, h);
#pragma unroll
    for (int kb = 0; kb < 2; ++kb) {
      bf16x8 pf[2];
      softmax_exp_half(s[kb], l, pf);
      pv_half<DV>(pf, o, lds + cur + 64 * KS, kb, r, h);
    }
    if (ABL != 1) { if (kt + 2 < nkt) stage_at(nn);
    if (kt + 3 < nkt) prefetch(kt + 3); }
    __syncthreads();
    s[0] = sn[0]; s[1] = sn[1];
    const int t = cur; cur = nxt; nxt = nn; nn = t;
  }
  l += __shfl_xor(l, 32);
  const float inv = 1.f / l;
#pragma unroll
  for (int d = 0; d < DV / 32; ++d) store_tok(o1, 1024, tq, head * 64 + 32 * d + 4 * h, o[d], inv);
}

DI void attn_mla_item2(const Ctx& p, int item, char* lds) {
  constexpr int DQK = 96, DV = 64, KS = DQK * 2 + 16;
  const int tid = otid(p), lane = tid & 63, w = tid >> 6, r = lane & 31, h = lane >> 5;
  int head, qb, ts0, S;
  if (item < 512) { head = item >> 5; qb = item & 31; ts0 = T_PROMPT; S = 16384; }
  else { const int it = item - 512; qb = it & 7; head = (it >> 3) & 15; ts0 = (it >> 7) * 4096; S = 4096; }
  const u16* q = (const u16*)(p.ws + OFF_R2);
  const u16* knope = q + (size_t)T_TOK * 1536;
  const u16* vt = knope + (size_t)T_TOK * 1024;
  const u16* krope = (const u16*)(p.ws + OFF_KROPE);
  u16* o1 = (u16*)(p.ws + OFF_R1);
  const int tq0 = ts0 + qb * 512 + w * 64 + r;
  char* qsl = lds + 49152 + w * 12288 + lane * 16;
  __syncthreads();
  float qn2[2] = {0.f, 0.f};
#pragma unroll
  for (int j = 0; j < 2; ++j)
#pragma unroll
    for (int ks = 0; ks < DQK / 16; ++ks) {
      const u32x4 qv = *(const u32x4*)(q + (size_t)(tq0 + 32 * j) * 1536 + head * 96 + 16 * ks + 8 * h);
      *(u32x4*)(qsl + (j * 6 + ks) * 1024) = qv;
      float a;
      a = bflo(qv.x); qn2[j] += a * a; a = bfhi(qv.x); qn2[j] += a * a; a = bflo(qv.y); qn2[j] += a * a; a = bfhi(qv.y); qn2[j] += a * a;
      a = bflo(qv.z); qn2[j] += a * a; a = bfhi(qv.z); qn2[j] += a * a; a = bflo(qv.w); qn2[j] += a * a; a = bfhi(qv.w); qn2[j] += a * a;
    }
  float ref[2];
  {
    float kn2 = 0.f;
#pragma unroll
    for (int t = 0; t < 8; ++t) { const float v = __uint_as_float(((const unsigned*)(p.ws + OFF_SCAL))[SC_KP + head * 8 + t]); kn2 += v * v; }
    const float kr = __uint_as_float(((const unsigned*)(p.ws + OFF_SCAL))[SC_KRMAX]);
    const float kmaxn = sqrtf(kn2 + kr * kr);
#pragma unroll
    for (int j = 0; j < 2; ++j) {
      qn2[j] += __shfl_xor(qn2[j], 32);
      ref[j] = sqrtf(qn2[j]) * kmaxn * 1.02f + 0.5f;
    }
  }
  const bool fixedref = !__any(ref[0] > 60.f || ref[1] > 60.f);
  f32x16 o[2][DV / 32];
  f32x16 initv[2];
#pragma unroll
  for (int j = 0; j < 2; ++j) {
#pragma unroll
    for (int d = 0; d < DV / 32; ++d)
#pragma unroll
      for (int i = 0; i < 16; ++i) o[j][d][i] = 0.f;
#pragma unroll
    for (int i = 0; i < 16; ++i) initv[j][i] = fixedref ? -ref[j] : 0.f;
  }
  float l[2] = {0.f, 0.f};
  u32x4 pk0, pk1, pv0;
  const int c1 = 512 + (tid & 255);
  const int krow0 = tid / 12, kch0 = tid - krow0 * 12;
  const int krow1 = c1 / 12, kch1 = c1 - krow1 * 12;
  const int vrow = tid >> 3, vch = tid & 7;
  const int nkt = S >> 6;
  auto prefetch = [&](int kt) {
    const int tk0 = ts0 + kt * 64;
    {
      const u16* src = kch0 < 8 ? knope + (size_t)(tk0 + krow0) * 1024 + head * 64 + kch0 * 8 : krope + (size_t)(tk0 + krow0) * 32 + (kch0 - 8) * 8;
      pk0 = *(const u32x4*)src;
    }
    {
      const u16* src = kch1 < 8 ? knope + (size_t)(tk0 + krow1) * 1024 + head * 64 + kch1 * 8 : krope + (size_t)(tk0 + krow1) * 32 + (kch1 - 8) * 8;
      pk1 = *(const u32x4*)src;
    }
    pv0 = *(const u32x4*)(vt + (size_t)(head * 64 + vrow) * T_TOK + tk0 + vch * 8);
  };
  auto stage_at = [&](int boff) {
    char* kl = lds + boff;
    char* vl = kl + 64 * KS;
    *(u32x4*)(kl + krow0 * KS + kch0 * 16) = pk0;
    *(u32x4*)(kl + krow1 * KS + kch1 * 16) = pk1;
    lds_st_vt(vl + vrow * 144, vch, pv0);
  };
  prefetch(0);
  stage_at(0);
  prefetch(1);
  __syncthreads();
#pragma unroll 1
  for (int kt = 0; kt < nkt; ++kt) {
    const char* kl = lds + (kt & 1) * 24576;
    const char* vl = kl + 64 * KS;
    if (kt + 1 < nkt) stage_at(((kt + 1) & 1) * 24576);
    if (kt + 2 < nkt) prefetch(kt + 2);
    f32x16 s[2][2];
#pragma unroll
    for (int kb = 0; kb < 2; ++kb) {
      s[0][kb] = initv[0]; s[1][kb] = initv[1];
#pragma unroll
      for (int ks = 0; ks < DQK / 16; ++ks) {
        const bf16x8 a = *(const bf16x8*)(kl + (32 * kb + r) * KS + (2 * ks + h) * 16);
        const bf16x8 q0 = *(const bf16x8*)(qsl + ks * 1024);
        const bf16x8 q1 = *(const bf16x8*)(qsl + (6 + ks) * 1024);
        s[0][kb] = MFMA32(a, q0, s[0][kb]);
        s[1][kb] = MFMA32(a, q1, s[1][kb]);
      }
    }
    if (!fixedref) {
#pragma unroll
      for (int j = 0; j < 2; ++j) {
        const float dl = softmax_pre<DV>(s[j], o[j], l[j], kt == 0);
        if (__any(dl != 0.f)) {
#pragma unroll
          for (int i = 0; i < 16; ++i) initv[j][i] -= dl;
        }
      }
    }
#pragma unroll
    for (int kb = 0; kb < 2; ++kb) {
      bf16x8 pf0[2], pf1[2];
      softmax_exp_half(s[0][kb], l[0], pf0);
      softmax_exp_half(s[1][kb], l[1], pf1);
#pragma unroll
      for (int d = 0; d < DV / 32; ++d)
#pragma unroll
        for (int st = 0; st < 2; ++st) {
          const u32x4 u = *(const u32x4*)(vl + (32 * d + r) * 144 + (2 * kb + st) * 32 + h * 16);
          const bf16x8 vf = __builtin_bit_cast(bf16x8, u);
          o[0][d] = MFMA32(vf, pf0[st], o[0][d]);
          o[1][d] = MFMA32(vf, pf1[st], o[1][d]);
        }
    }
    __syncthreads();
  }
  int tid2 = otid(p);
  const int lane2 = tid2 & 63, h2 = lane2 >> 5, w2 = tid2 >> 6;
  int item2 = item; asm volatile("" : "+s"(item2));
  int head2, tq2;
  if (item2 < 512) { head2 = item2 >> 5; tq2 = T_PROMPT + (item2 & 31) * 512 + w2 * 64 + (lane2 & 31); }
  else { const int it = item2 - 512; head2 = (it >> 3) & 15; tq2 = (it >> 7) * 4096 + (it & 7) * 512 + w2 * 64 + (lane2 & 31); }
#pragma unroll
  for (int j = 0; j < 2; ++j) {
    float lj = l[j];
    lj += __shfl_xor(lj, 32);
    const float inv = __builtin_amdgcn_rcpf(lj);
#pragma unroll
    for (int d = 0; d < DV / 32; ++d) store_tok(o1, 1024, tq2 + 32 * j, head2 * 64 + 32 * d + 4 * h2, o[j][d], inv);
  }
}

DI void diff_decode(int item, int& hh, int& qb, int& ts0, int& S) {
  int j;
  if (item < 128) { hh = 3; j = item; S = 16384; }
  else if (item < 256) { hh = 2; j = item - 128; S = 16384; }
  else if (item < 768) { hh = 3; j = item - 256; S = 4096; }
  else if (item < 1280) { hh = 2; j = item - 768; S = 4096; }
  else if (item < 1408) { hh = 1; j = item - 1280; S = 16384; }
  else if (item < 1920) { hh = 1; j = item - 1408; S = 4096; }
  else if (item < 2048) { hh = 0; j = item - 1920; S = 16384; }
  else { hh = 0; j = item - 2048; S = 4096; }
  if (S == 16384) { qb = j; ts0 = T_PROMPT; } else { qb = j & 31; ts0 = (j >> 5) * 4096; }
}
DI void attn_diff_item(const Ctx& p, int item, char* lds) {
  constexpr int DQK = 64, DV = 128, KS = DQK * 2 + 16;
  const int tid = otid(p), lane = tid & 63, w = tid >> 6, r = lane & 31, h = lane >> 5;
  const int map = w >> 2, qw = w & 3;
  int hh, qb, ts0, S;
  diff_decode(item, hh, qb, ts0, S);
  const u16* base = (const u16*)(p.ws + OFF_R2);
  const u16* dq = base + 2 * SEG512;
  const u16* dk = base + 3 * SEG512;
  const u16* vtd = base + 5 * SEG512;
  u16* o0 = (u16*)(p.ws + OFF_R1);
  const int qpos = qb * 128 + qw * 32 + r;
  const int tq = ts0 + qpos;
  __syncthreads();
  float qn2 = 0.f;
  bf16x8 qf[DQK / 16];
#pragma unroll
  for (int ks = 0; ks < DQK / 16; ++ks) {
    const u32x4 qv = *(const u32x4*)(dq + (size_t)tq * 512 + (2 * hh + map) * 64 + 16 * ks + 8 * h);
    qf[ks] = __builtin_bit_cast(bf16x8, qv);
    float a;
    a = bflo(qv.x); qn2 += a * a; a = bfhi(qv.x); qn2 += a * a; a = bflo(qv.y); qn2 += a * a; a = bfhi(qv.y); qn2 += a * a;
    a = bflo(qv.z); qn2 += a * a; a = bfhi(qv.z); qn2 += a * a; a = bflo(qv.w); qn2 += a * a; a = bfhi(qv.w); qn2 += a * a;
  }
  qn2 += __shfl_xor(qn2, 32);
  f32x16 o[DV / 32];
#pragma unroll
  for (int d = 0; d < DV / 32; ++d)
#pragma unroll
    for (int i = 0; i < 16; ++i) o[d][i] = 0.f;
  float l = 0.f;
  const float refb = sqrtf(qn2) * __uint_as_float(((const unsigned*)(p.ws + OFF_SCAL))[SC_QKMAX + 8 + 2 * hh + map]) * 1.02f + 0.5f;
  const bool fixedref = !__any(refb > 60.f);
  float ref = fixedref ? refb : 0.f;
  const float slope2 = exp2f(-2.f * (float)(hh + 1)) * LOG2E;
  const float cq = slope2 * (float)qpos;
  const int d0 = 2 * qb;
  const int kd = d0 + (qw >> 1);
  int kt_lo, kt_hi;
  {
    const unsigned* qk = (const unsigned*)(p.ws + OFF_SCAL) + SC_QKMAX;
    const float b0 = __uint_as_float(qk[2 * hh]) * __uint_as_float(qk[8 + 2 * hh]);
    const float b1 = __uint_as_float(qk[2 * hh + 1]) * __uint_as_float(qk[8 + 2 * hh + 1]);
    const float B = fmaxf(b0, b1) * 1.02f + 0.5f;
    const float dskip = fminf((2.f * B + 34.f) / slope2 + 1.f, 1.0e6f);
    const int q_lo = qb * 128, q_hi = q_lo + 127, ds = (int)dskip;
    kt_lo = max(0, (q_lo - 63 - ds) >> 6);
    kt_hi = min((S >> 6) - 1, (q_hi + ds) >> 6);
    kt_lo = min(kt_lo, 2 * qb); kt_hi = max(kt_hi, 2 * qb + 1);
  }
  const int nleft = d0 - kt_lo;
  const int nkt = kt_hi - kt_lo + 1;
  u32x4 pk[2], pv[2];
  const int lrow = tid >> 3, lch = tid & 7;
  auto tile_of = [&](int idx) { return idx < 2 ? d0 + idx : (idx - 2 < nleft ? d0 - 1 - (idx - 2) : idx + kt_lo); };
  const unsigned koff = (unsigned)(((ts0 + lrow) * 512 + 2 * hh * 64 + lch * 8) * 2);
  const unsigned voff = (unsigned)((((hh * 128 + lrow) * T_TOK) + ts0 + lch * 8) * 2);
  const char* dkb = (const char*)dk;
  const char* vtb = (const char*)vtd;
  auto prefetch = [&](int kt) {
    const unsigned ko = koff + (unsigned)kt * (64u * 512u * 2u);
    const unsigned vo = voff + (unsigned)kt * 128u;
    pk[0] = *(const u32x4*)(dkb + ko);
    pk[1] = *(const u32x4*)(dkb + ko + 128u);
    pv[0] = *(const u32x4*)(vtb + vo);
    pv[1] = *(const u32x4*)(vtb + vo + (unsigned)(64 * T_TOK * 2));
  };
  auto stage_at = [&](int boff) {
    char* kl0 = lds + boff;
    char* vl = kl0 + 2 * 64 * KS;
#pragma unroll
    for (int j = 0; j < 2; ++j) *(u32x4*)(kl0 + j * 64 * KS + lrow * KS + lch * 16) = pk[j];
#pragma unroll
    for (int j = 0; j < 2; ++j) lds_st_vt(vl + (lrow + 64 * j) * 144, lch, pv[j]);
  };
  auto scores = [&](int kt, int boff, f32x16 (&sc)[2]) {
    const int side = kt < kd ? -1 : (kt > kd ? 1 : 0);
    const float I = (float)side * cq - ref;
    const unsigned i_hi = cvt_pk(I, 0.f) & 0xffffu;
    const float ir1 = I - __uint_as_float(i_hi << 16);
    const unsigned i_mid = cvt_pk(ir1, 0.f) & 0xffffu;
    const float ir2 = ir1 - __uint_as_float(i_mid << 16);
    const unsigned i_lo = cvt_pk(ir2, 0.f) & 0xffffu;
    const float T = slope2 * (float)(kt * 64);
    const unsigned t_hi = cvt_pk(T, 0.f) & 0xffffu;
    const float r1 = T - __uint_as_float(t_hi << 16);
    const unsigned t_mid = cvt_pk(r1, 0.f) & 0xffffu;
    const float r2 = r1 - __uint_as_float(t_mid << 16);
    const unsigned t_lo = cvt_pk(r2, 0.f) & 0xffffu;
    const unsigned one = side < 0 ? 0x3F80u : (side > 0 ? 0xBF80u : 0u);
    u32x4 qa;
    qa.x = h == 0 ? (one | (one << 16)) : 0u; qa.y = qa.x; qa.z = h == 0 ? (one | (i_hi << 16)) : 0u; qa.w = h == 0 ? (i_mid | (i_lo << 16)) : 0u;
    const bf16x8 qaug = __builtin_bit_cast(bf16x8, qa);
#pragma unroll
    for (int kb = 0; kb < 2; ++kb) {
      const float xl = slope2 * (float)(32 * kb + r);
      const unsigned l_hi = cvt_pk(xl, 0.f) & 0xffffu;
      const unsigned l_lo = cvt_pk(xl - __uint_as_float(l_hi << 16), 0.f) & 0xffffu;
      u32x4 ka; ka.x = h == 0 ? (l_hi | (l_lo << 16)) : 0u; ka.y = h == 0 ? (t_hi | (t_mid << 16)) : 0u; ka.z = h == 0 ? (t_lo | 0x3F800000u) : 0u; ka.w = h == 0 ? 0x3F803F80u : 0u;
      f32x16 z;
#pragma unroll
      for (int i = 0; i < 16; ++i) z[i] = 0.f;
      sc[kb] = MFMA32(__builtin_bit_cast(bf16x8, ka), qaug, z);
    }
    qk_scores_acc<DQK>(lds + boff + map * 64 * KS, qf, sc, r, h);
  };
  prefetch(tile_of(0));
  __syncthreads();
  stage_at(0);
  prefetch(tile_of(1));
  __syncthreads();
#pragma unroll 1
  for (int idx = 0; idx < nkt; ++idx) {
    const int kt = tile_of(idx);
    const int cur = (idx & 1) * ATT_STAGE;
    if (idx + 1 < nkt) stage_at(((idx + 1) & 1) * ATT_STAGE);
    if (idx + 2 < nkt) prefetch(tile_of(idx + 2));
    f32x16 s[2];
    scores(kt, cur, s);
    if (kt == kd) {
#pragma unroll
      for (int kb = 0; kb < 2; ++kb)
#pragma unroll
        for (int i = 0; i < 16; ++i) {
          const int kp = kt * 64 + 32 * kb + (i & 3) + 8 * (i >> 2) + 4 * h;
          s[kb][i] -= slope2 * fabsf((float)(qpos - kp));
        }
    }
    if (!fixedref) ref += softmax_pre<DV>(s, o, l, idx == 0);
#pragma unroll
    for (int kb = 0; kb < 2; ++kb) {
      bf16x8 pf[2];
      softmax_exp_half(s[kb], l, pf);
      pv_half<DV>(pf, o, lds + cur + 2 * 64 * KS, kb, r, h);
    }
    __syncthreads();
  }
  l += __shfl_xor(l, 32);
  const float inv = 1.f / l;
  int tid2 = otid(p);
  const int lane2 = tid2 & 63, qw2 = (tid2 >> 6) & 3, h2 = lane2 >> 5;
  int item2 = item; asm volatile("" : "+s"(item2));
  int hh2, tq2;
  { int qb2, ts02, S2; diff_decode(item2, hh2, qb2, ts02, S2); tq2 = ts02 + qb2 * 128 + qw2 * 32 + (lane2 & 31); }
  float* ex = (float*)lds + qw2 * 4096;
  if (map == 1) {
#pragma unroll
    for (int d = 0; d < DV / 32; ++d)
#pragma unroll
      for (int i = 0; i < 16; ++i) ex[(d * 16 + i) * 64 + lane2] = o[d][i] * inv;
  }
  __syncthreads();
  if (map == 0) {
    const float lam = ((const float*)(p.ws + OFF_SCAL))[0];
    float ss = 0.f;
#pragma unroll
    for (int d = 0; d < DV / 32; ++d)
#pragma unroll
      for (int i = 0; i < 16; ++i) { const float v = o[d][i] * inv - lam * ex[(d * 16 + i) * 64 + lane2]; o[d][i] = v; ss += v * v; }
    ss += __shfl_xor(ss, 32);
    const float rn = rsqrtf(ss * (1.f / 128.f) + EPS) * 0.8f;
    const float* gs = (const float*)(p.ws + OFF_SCAL) + SC_GSUB;
#pragma unroll
    for (int d = 0; d < DV / 32; ++d) {
#pragma unroll
      for (int g = 0; g < 4; ++g) {
        const float4 gv = *(const float4*)(gs + 32 * d + 8 * g + 4 * h2);
        o[d][4 * g] *= gv.x; o[d][4 * g + 1] *= gv.y; o[d][4 * g + 2] *= gv.z; o[d][4 * g + 3] *= gv.w;
      }
      store_tok(o0, 1024, tq2, 512 + hh2 * 128 + 32 * d + 4 * h2, o[d], rn);
    }
  }
}

DI void attn_na_item(const Ctx& p, int item, char* lds) {
  constexpr int DQK = 64, DV = 64, KS = DQK * 2 + 16;
  const int tid = otid(p), lane = tid & 63, w = tid >> 6, r = lane & 31, h = lane >> 5;
  const int quad = item % 320, head = item / 320;
  const int t0 = quad * 256;
  int ts0, rows;
  if (t0 < T_PROMPT) { ts0 = t0 & ~4095; rows = 64; } else { ts0 = T_PROMPT; rows = 256; }
  const int r0 = (t0 - ts0) >> 6;
  const int rw = r0 + (w >> 1);
  const int rs_lo = min(max(r0 - 4, 0), rows - 8);
  const int rs_hi = min(max(r0 + 3 - 4, 0), rows - 8);
  const int rs_w = min(max(rw - 4, 0), rows - 8);
  const int ntile = rs_hi + 8 - rs_lo;
  const u16* base = (const u16*)(p.ws + OFF_R2);
  const u16* qn = base;
  const u16* kn = base + SEG512;
  const u16* vtn = base + 4 * SEG512;
  u16* o0 = (u16*)(p.ws + OFF_R1);
  float* tab = (float*)(lds + 2 * ATT_STAGE) + 64;
  const int qc = (w & 1) * 32 + r;
  const int tq = t0 + w * 32 + r;
  bf16x8 qf[DQK / 16];
#pragma unroll
  for (int ks = 0; ks < DQK / 16; ++ks) qf[ks] = *(const bf16x8*)(qn + (size_t)tq * 512 + head * 64 + 16 * ks + 8 * h);
  f32x16 o[DV / 32];
#pragma unroll
  for (int d = 0; d < DV / 32; ++d)
#pragma unroll
    for (int i = 0; i < 16; ++i) o[d][i] = 0.f;
  f32x16 initv;
#pragma unroll
  for (int i = 0; i < 16; ++i) initv[i] = 0.f;
  float l = 0.f;
  bool first = true;
  u32x4 pk0, pv0;
  const int lrow = tid >> 3, lch = tid & 7;
  auto prefetch = [&](int j) {
    const int tk0 = ts0 + (rs_lo + j) * 64;
    pk0 = *(const u32x4*)(kn + (size_t)(tk0 + lrow) * 512 + head * 64 + lch * 8);
    pv0 = *(const u32x4*)(vtn + (size_t)(head * 64 + lrow) * T_TOK + tk0 + lch * 8);
  };
  auto stage = [&](int b) {
    char* kl = lds + b * ATT_STAGE;
    char* vl = kl + 64 * KS;
    *(u32x4*)(kl + lrow * KS + lch * 16) = pk0;
    lds_st_vt(vl + lrow * 144, lch, pv0);
  };
  prefetch(0);
  __syncthreads();
  if (tid < 465) tab[tid] = ((const float*)(p.ws + OFF_SCAL))[SC_RPB + head * 465 + tid];
  stage(0);
  prefetch(1);
  __syncthreads();
  const int wc0 = min(max(qc - 8, 0), 48);
  const float* tabq = tab + (15 - qc + 4 * h);
  for (int j = 0; j < ntile; ++j) {
    const char* kl = lds + (j & 1) * ATT_STAGE;
    const char* vl = kl + 64 * KS;
    const int kr = rs_lo + j;
    if (kr >= rs_w && kr < rs_w + 8) {
      f32x16 s[2];
      qk_scores<DQK>(kl, qf, initv, s, r, h);
      const int ridx = kr - rw + 7;
#pragma unroll
      for (int kb = 0; kb < 2; ++kb)
#pragma unroll
        for (int i = 0; i < 16; ++i) {
          const int kc = 32 * kb + (i & 3) + 8 * (i >> 2) + 4 * h;
          const bool ok = (unsigned)(kc - wc0) < 16u;
          float b = tabq[ridx * 31 + 32 * kb + (i & 3) + 8 * (i >> 2)];
          asm volatile("" : "+v"(b));
          s[kb][i] = ok ? s[kb][i] + b : -INFINITY;
        }
      {
        const float dl = softmax_pv<DV>(s, o, l, first, vl, r, h);
        if (__any(dl != 0.f)) {
#pragma unroll
          for (int i = 0; i < 16; ++i) initv[i] -= dl;
        }
      }
      first = false;
    }
    if (j + 1 < ntile) stage((j + 1) & 1);
    if (j + 2 < ntile) prefetch(j + 2);
    __syncthreads();
  }
  l += __shfl_xor(l, 32);
  const float inv = 1.f / l;
#pragma unroll
  for (int d = 0; d < DV / 32; ++d) store_tok(o0, 1024, tq, head * 64 + 32 * d + 4 * h, o[d], inv);
}

DI void phase_qk_norms(const Ctx& p) {
  const int tid_ = otid(p);
  const int lane = tid_ & 63;
  const int gw = obid() * 8 + (tid_ >> 6), nw = gridDim.x * 8;
  const u16* dq = (const u16*)(p.ws + OFF_R2) + 2 * SEG512;
  const u16* dk = (const u16*)(p.ws + OFF_R2) + 3 * SEG512;
  float mq = 0.f, mk = 0.f;
  for (int row = gw; row < T_TOK; row += nw) {
    const uint4 a = ((const uint4*)(dq + (size_t)row * 512))[lane];
    const uint4 b = ((const uint4*)(dk + (size_t)row * 512))[lane];
    float sa = 0.f, sb = 0.f, t;
    t = bflo(a.x); sa += t * t; t = bfhi(a.x); sa += t * t; t = bflo(a.y); sa += t * t; t = bfhi(a.y); sa += t * t;
    t = bflo(a.z); sa += t * t; t = bfhi(a.z); sa += t * t; t = bflo(a.w); sa += t * t; t = bfhi(a.w); sa += t * t;
    t = bflo(b.x); sb += t * t; t = bfhi(b.x); sb += t * t; t = bflo(b.y); sb += t * t; t = bfhi(b.y); sb += t * t;
    t = bflo(b.z); sb += t * t; t = bfhi(b.z); sb += t * t; t = bflo(b.w); sb += t * t; t = bfhi(b.w); sb += t * t;
#pragma unroll
    for (int o = 1; o < 8; o <<= 1) { sa += __shfl_xor(sa, o); sb += __shfl_xor(sb, o); }
    mq = fmaxf(mq, sa); mk = fmaxf(mk, sb);
  }
  if ((lane & 7) == 0) {
    unsigned* qk = (unsigned*)(p.ws + OFF_SCAL) + SC_QKMAX;
    atomicMax(qk + (lane >> 3), __float_as_uint(sqrtf(mq)));
    atomicMax(qk + 8 + (lane >> 3), __float_as_uint(sqrtf(mk)));
  }
}

namespace pg8 {
#define PG8_LAS __attribute__((address_space(3)))
typedef unsigned short bf16_t;
typedef short bf16x8 __attribute__((ext_vector_type(8)));
typedef float f32x4 __attribute__((ext_vector_type(4)));
typedef unsigned u32x4 __attribute__((ext_vector_type(4)));
constexpr int BM = 256, BK = 64, HALF = 128, HTB = HALF * BK * 2  , STAGE_BYTES = 8 * HTB, NXCD = 8, WGM = 8;

__host__ __device__ __forceinline__ int lds_byte(int r, int c) { const int st = (r >> 4) * 2 + (c >> 5), rr = r & 15, cc = c & 31, ob = rr * 64 + cc * 2; return st * 1024 + (ob ^ (((ob >> 9) & 1) << 5)); }
__host__ __device__ __forceinline__ void stage_rc(int b, int& R, int& C) { const int st = b / 1024, sb = b % 1024, swz = sb ^ (((sb >> 9) & 1) << 5); R = (st >> 1) * 16 + swz / 64; C = (st & 1) * 32 + (swz % 64) / 2; }
__host__ __device__ __forceinline__ int perm32(int rho) { const int n = rho >> 4, i = rho & 15; return 8 * (i >> 2) + 4 * n + (i & 3); }

struct Unit { int pm, pn; };
struct Gemm { const bf16_t* A; const bf16_t* Bt; int M, N, K; int lda, ldb; };

struct StaticOrder {
    int nM, nN, nwg, G, c;
    __host__ __device__ void init(int M, int N, int G_, int c_) { nM = M / BM; nN = N / BM; nwg = nM * nN; G = G_; c = c_; }
    __host__ __device__ bool next(int i, Unit& u) const {
        const long L = (long)i * G + c; if (L >= nwg) return false;
        int wgid = (int)L; { const int q = nwg / NXCD, r = nwg % NXCD, xcd = wgid % NXCD, off = wgid / NXCD; wgid = (xcd < r ? xcd * (q + 1) : r * (q + 1) + (xcd - r) * q) + off; }
        const int nig = WGM * nN, gid = wgid / nig, fm = gid * WGM, gsz = (nM - fm) < WGM ? (nM - fm) : WGM;
        u.pm = fm + ((wgid % nig) % gsz); u.pn = (wgid % nig) / gsz; return true;
    }
    __device__ __forceinline__ void a_ready(const Unit&) const {}
    __device__ __forceinline__ void done(const Unit&) const {}
};
struct CountedOrder : StaticOrder {
    const unsigned* ready; unsigned need; unsigned* tmo;
    __device__ __forceinline__ void a_ready(const Unit& u) const {
        if (threadIdx.x < 64) {
            const unsigned long long t0 = __builtin_amdgcn_s_memrealtime(); unsigned polls = 0;
            while ((unsigned)__builtin_amdgcn_readfirstlane(__hip_atomic_load(ready + 64 * u.pm, __ATOMIC_RELAXED, __HIP_MEMORY_SCOPE_AGENT)) < need) {
                if ((++polls & 255u) == 0u && __builtin_amdgcn_readfirstlane(__hip_atomic_load(tmo, __ATOMIC_RELAXED, __HIP_MEMORY_SCOPE_AGENT)) != 0u) break;
                if (__builtin_amdgcn_s_memrealtime() - t0 > 2000000ull) {
                    if (threadIdx.x == 0) { unsigned expect = 0u; __hip_atomic_compare_exchange_strong(tmo + 1, &expect, 0x600u | (unsigned)(u.pm & 0xff), __ATOMIC_RELAXED, __ATOMIC_RELAXED, __HIP_MEMORY_SCOPE_AGENT); __hip_atomic_store(tmo, 1u, __ATOMIC_RELAXED, __HIP_MEMORY_SCOPE_AGENT); }
                    break; }
                __builtin_amdgcn_s_sleep(2); }
            __builtin_amdgcn_fence(__ATOMIC_ACQUIRE, "agent");
            asm volatile("s_waitcnt vmcnt(0)" ::: "memory");
        }
#if !defined(BROKEN_HOOK_NO_BARRIER)
        asm volatile("" ::: "memory"); __builtin_amdgcn_s_barrier(); asm volatile("" ::: "memory");
#endif
    }
};

__device__ __forceinline__ unsigned cvt_pk_bf16(float lo, float hi) { unsigned r; asm volatile("v_cvt_pk_bf16_f32 %0, %1, %2" : "=v"(r) : "v"(lo), "v"(hi)); return r; }
typedef float f32x2 __attribute__((ext_vector_type(2)));
__device__ __forceinline__ f32x2 gelu_pk(f32x2 v) {
    const f32x2 av = __builtin_elementwise_abs(v), d = av * 0.2316418882f + 1.0f;
    f32x2 t; t.x = __builtin_amdgcn_rcpf(d.x); t.y = __builtin_amdgcn_rcpf(d.y);
    f32x2 q = t * 0.5307027145f + (-0.7265760135f); q = q * t + 0.7107068705f; q = q * t + (-0.142248368f); q = q * t + 0.127414796f; q = q * t;
    const f32x2 s = (v * v) * (-0.72134752044f);
    f32x2 e; e.x = __builtin_amdgcn_exp2f(s.x); e.y = __builtin_amdgcn_exp2f(s.y);
    const f32x2 m = v * (q * e), r = v - m;
    f32x2 o; o.x = v.x < 0.f ? m.x : r.x; o.y = v.y < 0.f ? m.y : r.y; return o;
}

struct EpiF32 {
    static constexpr bool PERM = false, AFTER_DRAIN = false;
    float* C; int ldc; const float* bias;
    __device__ __forceinline__ void operator()(const f32x4 (&acc)[2][2][4][2], const Unit& u, int wr, int wc, int fr, int fq) const {
        const int row0 = u.pm * BM + wr * 64 + fr, col0 = u.pn * BM + wc * 32 + 4 * fq;
        f32x4 bv[2][2];
#pragma unroll
        for (int bj = 0; bj < 2; ++bj)
#pragma unroll
            for (int n = 0; n < 2; ++n) bv[bj][n] = bias ? *(const f32x4*)(bias + col0 + bj * HALF + n * 16) : (f32x4){0.f, 0.f, 0.f, 0.f};
#pragma unroll
        for (int ai = 0; ai < 2; ++ai)
#pragma unroll
            for (int m = 0; m < 4; ++m) { float* rowp = C + (size_t)(row0 + ai * HALF + m * 16) * ldc + col0;
#pragma unroll
                for (int bj = 0; bj < 2; ++bj)
#pragma unroll
                    for (int n = 0; n < 2; ++n) *(f32x4*)(rowp + bj * HALF + n * 16) = acc[ai][bj][m][n] + bv[bj][n]; }
    }
};
template <int ACT  > struct EpiBf16 {
    static constexpr bool PERM = true, AFTER_DRAIN = false;
    bf16_t* O; int ldc; const float* bias; int split_cols; size_t split_stride;
    __device__ __forceinline__ void operator()(const f32x4 (&acc)[2][2][4][2], const Unit& u, int wr, int wc, int fr, int fq) const {
        const int row0 = u.pm * BM + wr * 64 + fr; int colt = u.pn * BM; bf16_t* base = O;
        if (split_cols) { const int t = colt / split_cols; base += (size_t)t * split_stride; colt -= t * split_cols; }
        const int col0 = colt + wc * 32 + 8 * fq, bcol0 = u.pn * BM + wc * 32 + 8 * fq;
        f32x4 bv[2][2];
#pragma unroll
        for (int bj = 0; bj < 2; ++bj)
#pragma unroll
            for (int n = 0; n < 2; ++n) bv[bj][n] = bias ? *(const f32x4*)(bias + bcol0 + bj * HALF + 4 * n) : (f32x4){0.f, 0.f, 0.f, 0.f};
#pragma unroll
        for (int ai = 0; ai < 2; ++ai)
#pragma unroll
            for (int m = 0; m < 4; ++m) { bf16_t* rowp = base + (size_t)(row0 + ai * HALF + m * 16) * ldc + col0;
#pragma unroll
                for (int bj = 0; bj < 2; ++bj) { f32x4 v0 = acc[ai][bj][m][0] + bv[bj][0], v1 = acc[ai][bj][m][1] + bv[bj][1];
                    if (ACT == 1) { f32x2 a = gelu_pk((f32x2){v0[0], v0[1]}), b = gelu_pk((f32x2){v0[2], v0[3]}), c = gelu_pk((f32x2){v1[0], v1[1]}), d = gelu_pk((f32x2){v1[2], v1[3]});
                        v0 = (f32x4){a.x, a.y, b.x, b.y}; v1 = (f32x4){c.x, c.y, d.x, d.y}; }
                    if (ACT == 2) {
#pragma unroll
                        for (int j = 0; j < 4; ++j) { v0[j] = 0.5f * v0[j] * (1.0f + erff(v0[j] * 0.70710678f)); v1[j] = 0.5f * v1[j] * (1.0f + erff(v1[j] * 0.70710678f)); } }
                    u32x4 w; w.x = cvt_pk_bf16(v0[0], v0[1]); w.y = cvt_pk_bf16(v0[2], v0[3]); w.z = cvt_pk_bf16(v1[0], v1[1]); w.w = cvt_pk_bf16(v1[2], v1[3]);
                    *(u32x4*)(rowp + bj * HALF) = w; } }
    }
};

struct PanelStats {
    unsigned* xbuf;
    unsigned* cnt;
    unsigned* tmo;
    int ntn; float eps;
    unsigned code;
    __device__ __forceinline__ bool run(const f32x4 (&v)[2][2][4][2], const Unit& u, int wr, int wc, int fr, int fq, PG8_LAS unsigned char* lds, int wid, int lane) const {
        typedef float f32x2v __attribute__((ext_vector_type(2)));
        PG8_LAS f32x2v* P = (PG8_LAS f32x2v*)lds;
        PG8_LAS f32x2v* S = (PG8_LAS f32x2v*)(lds + 8192);
        PG8_LAS unsigned* flag = (PG8_LAS unsigned*)(lds + 8192 + 2048);
#pragma unroll
        for (int ai = 0; ai < 2; ++ai)
#pragma unroll
            for (int m = 0; m < 4; ++m) {
                float s = 0.f;
#pragma unroll
                for (int bj = 0; bj < 2; ++bj)
#pragma unroll
                    for (int n = 0; n < 2; ++n) { const f32x4 x = v[ai][bj][m][n]; s += (x[0] + x[1]) + (x[2] + x[3]); }
                s += __shfl_xor(s, 16); s += __shfl_xor(s, 32);
                const float mw = s * (1.0f / 64.0f); float q = 0.f;
#pragma unroll
                for (int bj = 0; bj < 2; ++bj)
#pragma unroll
                    for (int n = 0; n < 2; ++n) { const f32x4 d = v[ai][bj][m][n] - mw; q += (d[0] * d[0] + d[1] * d[1]) + (d[2] * d[2] + d[3] * d[3]); }
                q += __shfl_xor(q, 16); q += __shfl_xor(q, 32);
                if (fq == 0) P[(ai * HALF + wr * 64 + m * 16 + fr) * 4 + wc] = (f32x2v){mw, q};
            }
        asm volatile("s_waitcnt lgkmcnt(0)" ::: "memory"); __builtin_amdgcn_s_barrier(); asm volatile("" ::: "memory");
#if defined(BROKEN_NO_WAIT)
        if (blockIdx.x >= 64) { const long long t0 = clock64(); while (clock64() - t0 < 60000) __builtin_amdgcn_s_sleep(8); }
#endif
        const int row = wid * 32 + (lane & 31);
        if (lane < 32) {
            const f32x2v a = P[row * 4 + 0], b = P[row * 4 + 1], c = P[row * 4 + 2], d = P[row * 4 + 3];
            const float mt = (a.x + b.x + c.x + d.x) * 0.25f;
            const float da = a.x - mt, db = b.x - mt, dc = c.x - mt, dd = d.x - mt;
            const float m2 = (a.y + b.y) + (c.y + d.y) + 64.0f * ((da * da + db * db) + (dc * dc + dd * dd));
            unsigned long long* slot = (unsigned long long*)xbuf + ((size_t)(u.pm * BM + row) * 4 + u.pn);
            __hip_atomic_store(slot, ((unsigned long long)__float_as_uint(m2) << 32) | __float_as_uint(mt), __ATOMIC_RELAXED, __HIP_MEMORY_SCOPE_AGENT);
        }
        asm volatile("s_waitcnt vmcnt(0)" ::: "memory");
        if (lane == 0) __hip_atomic_fetch_add(cnt + 64 * u.pm, 1u, __ATOMIC_RELAXED, __HIP_MEMORY_SCOPE_AGENT);
        if (wid == 0) {
            bool dead = false; const unsigned long long t0 = __builtin_amdgcn_s_memrealtime(); const unsigned want = 8u * (unsigned)ntn;
            for (;;) {
#if defined(BROKEN_NO_WAIT)
                break;
#endif
                if ((unsigned)__builtin_amdgcn_readfirstlane(__hip_atomic_load(cnt + 64 * u.pm, __ATOMIC_RELAXED, __HIP_MEMORY_SCOPE_AGENT)) >= want) break;
                if (__builtin_amdgcn_s_memrealtime() - t0 > 2000000ull) {
                    if (lane == 0) { unsigned expect = 0u; __hip_atomic_compare_exchange_strong(tmo + 1, &expect, code | (unsigned)(u.pm & 0xff), __ATOMIC_RELAXED, __ATOMIC_RELAXED, __HIP_MEMORY_SCOPE_AGENT);
                                     __hip_atomic_store(tmo, 1u, __ATOMIC_RELAXED, __HIP_MEMORY_SCOPE_AGENT); }
                    dead = true; break; }
                __builtin_amdgcn_s_sleep(2);
            }
            __builtin_amdgcn_fence(__ATOMIC_ACQUIRE, "agent");
            if (lane == 0) flag[0] = dead ? 1u : 0u;
        }
        asm volatile("s_waitcnt vmcnt(0) lgkmcnt(0)" ::: "memory"); __builtin_amdgcn_s_barrier(); asm volatile("" ::: "memory");
        const bool bad = flag[0] != 0u;
        if (lane < 32) {
            const unsigned long long* slot = (const unsigned long long*)xbuf + (size_t)(u.pm * BM + row) * 4; float mt[4], m2[4]; float ms = 0.f;
#pragma unroll
            for (int t = 0; t < 4; ++t) { if (t < ntn) { const unsigned long long w = __hip_atomic_load(slot + t, __ATOMIC_RELAXED, __HIP_MEMORY_SCOPE_AGENT); mt[t] = __uint_as_float((unsigned)w); m2[t] = __uint_as_float((unsigned)(w >> 32)); } else { mt[t] = 0.f; m2[t] = 0.f; } ms += mt[t]; }
            const float mean = ms / (float)ntn; float q = 0.f;
#pragma unroll
            for (int t = 0; t < 4; ++t) if (t < ntn) { const float dm = mt[t] - mean; q += m2[t] + 256.0f * dm * dm; }
            S[row] = (f32x2v){mean, 1.0f / sqrtf(q / (256.0f * (float)ntn) + eps)};
        }
        asm volatile("s_waitcnt lgkmcnt(0)" ::: "memory"); __builtin_amdgcn_s_barrier(); asm volatile("" ::: "memory");
        return bad;
    }
};
struct EpiLnRes {
    static constexpr bool PERM = false, AFTER_DRAIN = true;
    const float* base; float* out; int ldc; const float* bias; PanelStats st; unsigned poison;
    __device__ __forceinline__ void refuse(size_t i0, size_t stride, int M, int N) const { const float q = __builtin_nanf(""); for (size_t i = i0; i < (size_t)M * N; i += stride) out[(i / N) * ldc + i % N] = q;
        if (i0 == 0) { unsigned expect = 0u; __hip_atomic_compare_exchange_strong(st.tmo + 1, &expect, 0x7f0u, __ATOMIC_RELAXED, __ATOMIC_RELAXED, __HIP_MEMORY_SCOPE_AGENT); __hip_atomic_store(st.tmo, 1u, __ATOMIC_RELAXED, __HIP_MEMORY_SCOPE_AGENT); } }
    __device__ __forceinline__ void fused(f32x4 (&acc)[2][2][4][2], const Unit& u, int wr, int wc, int fr, int fq, PG8_LAS unsigned char* lds, int wid, int lane) const {
        typedef float f32x2v __attribute__((ext_vector_type(2)));
        const PG8_LAS f32x2v* S = (const PG8_LAS f32x2v*)(lds + 8192);
        const int col0 = u.pn * BM + wc * 32 + 4 * fq;
#pragma unroll
        for (int bj = 0; bj < 2; ++bj)
#pragma unroll
            for (int n = 0; n < 2; ++n) { const f32x4 bv = bias ? *(const f32x4*)(bias + col0 + bj * HALF + n * 16) : (f32x4){0.f, 0.f, 0.f, 0.f};
#pragma unroll
                for (int ai = 0; ai < 2; ++ai)
#pragma unroll
                    for (int m = 0; m < 4; ++m) acc[ai][bj][m][n] += bv; }
        const bool bad = st.run(acc, u, wr, wc, fr, fq, lds, wid, lane) || poison != 0u;
        const float qnan = __builtin_nanf("");
#pragma unroll
        for (int ai = 0; ai < 2; ++ai)
#pragma unroll
            for (int m = 0; m < 4; ++m) { const int r = ai * HALF + wr * 64 + m * 16 + fr; const f32x2v sr = S[r]; const size_t off = (size_t)(u.pm * BM + r) * ldc + col0;
#pragma unroll
                for (int bj = 0; bj < 2; ++bj)
#pragma unroll
                    for (int n = 0; n < 2; ++n) { const f32x4 bs = *(const f32x4*)(base + off + bj * HALF + n * 16); f32x4 o = bs + (acc[ai][bj][m][n] - sr.x) * sr.y;
                        if (bad) o = (f32x4){qnan, qnan, qnan, qnan}; *(f32x4*)(out + off + bj * HALF + n * 16) = o; }
                asm volatile("" ::: "memory"); }
    }
};
struct EpiLnResLn {
    static constexpr bool PERM = false, AFTER_DRAIN = true;
    const float* base; float* out; bf16_t* xn; int ldc; const float* bias; PanelStats st1, st2; unsigned poison;
    __device__ __forceinline__ void refuse(size_t i0, size_t stride, int M, int N) const { const float q = __builtin_nanf(""); for (size_t i = i0; i < (size_t)M * N; i += stride) { const size_t o = (i / N) * ldc + i % N; out[o] = q; xn[o] = (bf16_t)0x7fc0u; }
        if (i0 == 0) { unsigned expect = 0u; __hip_atomic_compare_exchange_strong(st1.tmo + 1, &expect, 0x7f0u, __ATOMIC_RELAXED, __ATOMIC_RELAXED, __HIP_MEMORY_SCOPE_AGENT); __hip_atomic_store(st1.tmo, 1u, __ATOMIC_RELAXED, __HIP_MEMORY_SCOPE_AGENT); } }
    __device__ __forceinline__ void fused(f32x4 (&acc)[2][2][4][2], const Unit& u, int wr, int wc, int fr, int fq, PG8_LAS unsigned char* lds, int wid, int lane) const {
        typedef float f32x2v __attribute__((ext_vector_type(2))); typedef unsigned u32x2v __attribute__((ext_vector_type(2)));
        const PG8_LAS f32x2v* S = (const PG8_LAS f32x2v*)(lds + 8192);
        const int col0 = u.pn * BM + wc * 32 + 4 * fq;
#pragma unroll
        for (int bj = 0; bj < 2; ++bj)
#pragma unroll
            for (int n = 0; n < 2; ++n) { const f32x4 bv = bias ? *(const f32x4*)(bias + col0 + bj * HALF + n * 16) : (f32x4){0.f, 0.f, 0.f, 0.f};
#pragma unroll
                for (int ai = 0; ai < 2; ++ai)
#pragma unroll
                    for (int m = 0; m < 4; ++m) acc[ai][bj][m][n] += bv; }
        bool bad = st1.run(acc, u, wr, wc, fr, fq, lds, wid, lane) || poison != 0u;
        const float qnan = __builtin_nanf("");
#pragma unroll
        for (int ai = 0; ai < 2; ++ai)
#pragma unroll
            for (int m = 0; m < 4; ++m) { const int r = ai * HALF + wr * 64 + m * 16 + fr; const f32x2v sr = S[r]; const size_t off = (size_t)(u.pm * BM + r) * ldc + col0;
#pragma unroll
                for (int bj = 0; bj < 2; ++bj)
#pragma unroll
                    for (int n = 0; n < 2; ++n) { const f32x4 bs = *(const f32x4*)(base + off + bj * HALF + n * 16); acc[ai][bj][m][n] = bs + (acc[ai][bj][m][n] - sr.x) * sr.y; }
                asm volatile("" : "+v"(acc[ai][0][m][0]), "+v"(acc[ai][0][m][1]), "+v"(acc[ai][1][m][0]), "+v"(acc[ai][1][m][1]));
                if (m & 1) asm volatile("" ::: "memory"); }
        const bool bad1 = bad;
        bad = st2.run(acc, u, wr, wc, fr, fq, lds, wid, lane) || bad;
#pragma unroll
        for (int ai = 0; ai < 2; ++ai)
#pragma unroll
            for (int m = 0; m < 4; ++m) { const int r = ai * HALF + wr * 64 + m * 16 + fr; const f32x2v sr = S[r]; const size_t off = (size_t)(u.pm * BM + r) * ldc + col0;
#pragma unroll
                for (int bj = 0; bj < 2; ++bj)
#pragma unroll
                    for (int n = 0; n < 2; ++n) { const f32x4 x1 = acc[ai][bj][m][n]; *(f32x4*)(out + off + bj * HALF + n * 16) = bad1 ? (f32x4){qnan, qnan, qnan, qnan} : x1;
                        const f32x4 o = (x1 - sr.x) * sr.y; u32x2v w; w.x = cvt_pk_bf16(o[0], o[1]); w.y = cvt_pk_bf16(o[2], o[3]);
                        if (bad) { w.x = 0x7fc07fc0u; w.y = 0x7fc07fc0u; } *(u32x2v*)(xn + off + bj * HALF + n * 16) = w; }
                asm volatile("" ::: "memory"); }
    }
};

template <class Epi, class Sched, bool STAMP = false>
__device__ __forceinline__ void gemm_phase(PG8_LAS unsigned char* lds, const Gemm g, const Sched& S, const Epi& E, unsigned long long* stamps, const int tid) {
    const int wid = __builtin_amdgcn_readfirstlane(tid >> 6), lane = tid & 63, wr = wid >> 2, wc = wid & 3, fr = lane & 15, fq = lane >> 4;
    const int K = g.K, nt = K / BK;
    int ts_lo = 0, ts_hi = 0, nts = 0; const unsigned long long rt_entry = STAMP ? (unsigned long long)wall_clock64() : 0ull;
#define PG8_STAMP() do { if (STAMP && wid == 0 && nts < 64) { const unsigned long long _c = (unsigned long long)clock64(); \
        ts_lo = (lane == nts) ? (int)(unsigned)_c : ts_lo; ts_hi = (lane == nts) ? (int)(unsigned)(_c >> 32) : ts_hi; ++nts; } } while (0)
    PG8_STAMP();
    unsigned voffA[2], voffB[2];
#pragma unroll
    for (int i = 0; i < 2; ++i) { int R, C; stage_rc(tid * 16 + i * 8192, R, C); const int Rb = Epi::PERM ? ((R & ~31) + perm32(R & 31)) : R;
        voffA[i] = (unsigned)(R * g.lda + C) * 2u; voffB[i] = (unsigned)(Rb * g.ldb + C) * 2u; }
    const size_t kstep = (size_t)(BK * 2);
    const size_t hstepA = (size_t)HALF * g.lda * 2, hstepB = (size_t)HALF * g.ldb * 2;
    const size_t tstepA = 2 * hstepA, tstepB = 2 * hstepB;
    const unsigned ldsw = (unsigned)wid * 1024u;
    const int aoff = lds_byte(wr * 64 + fr, fq * 8), boff = lds_byte(wc * 32 + fr, fq * 8);
#define PG8_SA(b, h) (((b) * 2 + (h)) * HTB)
#define PG8_SB(b, h) ((4 + (b) * 2 + (h)) * HTB)
#define PG8_STAGE(bufoff, gbase, voff) do { _Pragma("unroll") for (int _i = 0; _i < 2; ++_i) \
        __builtin_amdgcn_global_load_lds((const unsigned*)((const char*)(gbase) + (voff)[_i]), (PG8_LAS unsigned*)(lds + (bufoff) + ldsw + _i * 8192), 16, 0, 0); } while (0)
#define PG8_LDA(dst, b, h) do { _Pragma("unroll") for (int m = 0; m < 4; ++m) _Pragma("unroll") for (int k = 0; k < 2; ++k) dst[m][k] = *(const PG8_LAS bf16x8*)(lds + PG8_SA(b, h) + aoff + m * 2048 + k * 1024); } while (0)
#define PG8_LDB(dst, b, h) do { _Pragma("unroll") for (int n = 0; n < 2; ++n) _Pragma("unroll") for (int k = 0; k < 2; ++k) dst[n][k] = *(const PG8_LAS bf16x8*)(lds + PG8_SB(b, h) + boff + n * 2048 + k * 1024); } while (0)
#define PG8_MMA(ai, bj, At, Bt) do { __builtin_amdgcn_s_setprio(1); _Pragma("unroll") for (int m = 0; m < 4; ++m) _Pragma("unroll") for (int n = 0; n < 2; ++n) _Pragma("unroll") for (int k = 0; k < 2; ++k) \
        acc[ai][bj][m][n] = __builtin_amdgcn_mfma_f32_16x16x32_bf16(Bt[n][k], At[m][k], acc[ai][bj][m][n], 0, 0, 0); __builtin_amdgcn_s_setprio(0); } while (0)
#define PG8_WAIT_V(n) asm volatile("s_waitcnt vmcnt(" #n ")" ::: "memory")
#define PG8_WAIT_L(n) asm volatile("s_waitcnt lgkmcnt(" #n ")" ::: "memory")
#define PG8_BAR __builtin_amdgcn_s_barrier()
#define PG8_SCHED __builtin_amdgcn_sched_barrier(0)
    Unit cur, nxt; int ui = 0;
    if (!S.next(0, cur)) return;
    f32x4 acc[2][2][4][2];
#pragma unroll
    for (int a = 0; a < 2; ++a)
#pragma unroll
        for (int b = 0; b < 2; ++b)
#pragma unroll
            for (int m = 0; m < 4; ++m)
#pragma unroll
                for (int n = 0; n < 2; ++n) acc[a][b][m][n] = (f32x4){0.f, 0.f, 0.f, 0.f};
    bf16x8 At[4][2], B0[2][2], B1[2][2];
    const char* cA = (const char*)g.A + (size_t)cur.pm * tstepA; const char* cB = (const char*)g.Bt + (size_t)cur.pn * tstepB;
    S.a_ready(cur);
    PG8_STAGE(PG8_SB(0, 0), cB, voffB); PG8_STAGE(PG8_SA(0, 0), cA, voffA); PG8_STAGE(PG8_SB(0, 1), cB + hstepB, voffB); PG8_STAGE(PG8_SA(0, 1), cA + hstepA, voffA);
    if (wr == 1) PG8_BAR;
    PG8_WAIT_V(4); PG8_BAR;
    PG8_STAGE(PG8_SB(1, 0), cB + kstep, voffB); PG8_STAGE(PG8_SA(1, 0), cA + kstep, voffA); PG8_STAGE(PG8_SB(1, 1), cB + hstepB + kstep, voffB);
    PG8_WAIT_V(6); PG8_BAR;
    PG8_STAMP();
    for (;;) {
        const bool has_next = S.next(ui + 1, nxt);
        const char* nA = has_next ? (const char*)g.A + (size_t)nxt.pm * tstepA : cA; const char* nB = has_next ? (const char*)g.Bt + (size_t)nxt.pn * tstepB : cB;
        for (int t = 0; t < nt; t += 2) {
            const bool last = (t == nt - 2);
            const char* a1 = cA + (size_t)(t + 1) * kstep;
            const char* a2 = last ? nA : cA + (size_t)(t + 2) * kstep; const char* b2 = last ? nB : cB + (size_t)(t + 2) * kstep;
            const char* a3 = a2 + kstep; const char* b3 = b2 + kstep;
            if (last && has_next) S.a_ready(nxt);
            PG8_LDB(B0, 0, 0); PG8_SCHED; PG8_LDA(At, 0, 0); PG8_STAGE(PG8_SA(1, 1), a1 + hstepA, voffA);
            PG8_WAIT_L(8); PG8_BAR; PG8_WAIT_L(0); PG8_MMA(0, 0, At, B0); PG8_BAR; PG8_SCHED;
            PG8_LDB(B1, 0, 1); PG8_STAGE(PG8_SB(0, 0), b2, voffB);
            PG8_BAR; PG8_WAIT_L(0); PG8_MMA(0, 1, At, B1); PG8_BAR;
            PG8_LDA(At, 0, 1); PG8_STAGE(PG8_SA(0, 0), a2, voffA);
            PG8_BAR; PG8_WAIT_L(0); PG8_MMA(1, 0, At, B0); PG8_BAR; PG8_SCHED;
            PG8_STAGE(PG8_SB(0, 1), b2 + hstepB, voffB);
            PG8_WAIT_V(6); PG8_BAR; PG8_MMA(1, 1, At, B1); PG8_BAR;
            PG8_LDB(B0, 1, 0); PG8_SCHED; PG8_LDA(At, 1, 0); PG8_STAGE(PG8_SA(0, 1), a2 + hstepA, voffA);
            PG8_WAIT_L(8); PG8_BAR; PG8_WAIT_L(0); PG8_MMA(0, 0, At, B0); PG8_BAR; PG8_SCHED;
            PG8_LDB(B1, 1, 1); PG8_STAGE(PG8_SB(1, 0), b3, voffB);
            PG8_BAR; PG8_WAIT_L(0); PG8_MMA(0, 1, At, B1); PG8_BAR;
            PG8_LDA(At, 1, 1); PG8_STAGE(PG8_SA(1, 0), a3, voffA);
            PG8_BAR; PG8_WAIT_L(0); PG8_MMA(1, 0, At, B0); PG8_BAR; PG8_SCHED;
            PG8_STAGE(PG8_SB(1, 1), b3 + hstepB, voffB);
            PG8_WAIT_V(6); PG8_BAR; PG8_MMA(1, 1, At, B1); PG8_BAR;
        }
        PG8_STAMP();
        if constexpr (!Epi::AFTER_DRAIN) { E(acc, cur, wr, wc, fr, fq); S.done(cur); }
        PG8_STAMP();
        if (!has_next) break;
#pragma unroll
        for (int a = 0; a < 2; ++a)
#pragma unroll
            for (int b = 0; b < 2; ++b)
#pragma unroll
                for (int m = 0; m < 4; ++m)
#pragma unroll
                    for (int n = 0; n < 2; ++n) acc[a][b][m][n] = (f32x4){0.f, 0.f, 0.f, 0.f};
        cur = nxt; cA = nA; cB = nB; ++ui;
    }
    PG8_WAIT_V(0);
    if (wr == 0) PG8_BAR;
    PG8_BAR;
    if constexpr (Epi::AFTER_DRAIN) { E.fused(acc, cur, wr, wc, fr, fq, lds, wid, lane); S.done(cur); }
    PG8_STAMP();
    if (STAMP && wid == 0) { stamps[lane] = lane < nts ? (((unsigned long long)(unsigned)ts_hi << 32) | (unsigned)ts_lo) : 0ull;
        if (lane == 62) stamps[62] = rt_entry; if (lane == 63) stamps[63] = (unsigned long long)wall_clock64(); }
#undef PG8_STAMP
#undef PG8_SA
#undef PG8_SB
#undef PG8_STAGE
#undef PG8_LDA
#undef PG8_LDB
#undef PG8_MMA
#undef PG8_WAIT_V
#undef PG8_WAIT_L
#undef PG8_BAR
#undef PG8_SCHED
}
}

struct PgEpiSwiGLU {
  static constexpr bool PERM = true, AFTER_DRAIN = false;
  u16* act;
  __device__ __forceinline__ void operator()(const pg8::f32x4 (&acc)[2][2][4][2], const pg8::Unit& u, int wr, int wc, int fr, int fq) const {
    const int row0 = u.pm * 256 + wr * 64 + fr, j0 = u.pn * 128 + wc * 32 + 8 * fq;
#pragma unroll
    for (int ai = 0; ai < 2; ++ai)
#pragma unroll
      for (int m = 0; m < 4; ++m) {
        unsigned pk[4];
#pragma unroll
        for (int n = 0; n < 2; ++n) {
          float y[4];
#pragma unroll
          for (int e = 0; e < 4; ++e) {
            const float gt = acc[ai][0][m][n][e], up = acc[ai][1][m][n][e];
            y[e] = gt * __builtin_amdgcn_rcpf(1.f + fexp2(-LOG2E * gt)) * up;
          }
          pk[2 * n] = cvt_pk(y[0], y[1]); pk[2 * n + 1] = cvt_pk(y[2], y[3]);
        }
        u32x4 w4; w4.x = pk[0]; w4.y = pk[1]; w4.z = pk[2]; w4.w = pk[3];
        *(u32x4*)(act + (size_t)(row0 + ai * 128 + m * 16) * DFF + j0) = w4;
      }
  }
};
template <class Epi>
DI void pg_gemm(const u16* A, const u16* Bt, int M, int N, int K, const Epi& E, char* lds, int bid, int nblk, const Ctx& p) {
  pg8::Gemm g{A, Bt, M, N, K, K, K};
  pg8::StaticOrder S; S.init(M, N, nblk, bid);
  pg8::gemm_phase<Epi, pg8::StaticOrder, false>((PG8_LAS unsigned char*)lds, g, S, E, nullptr, otid(p));
}

constexpr int LDS_BYTES = 2 * (256 + 256) * 144;

struct PgEpiUQ {
  static constexpr bool PERM = false, AFTER_DRAIN = false;
  u16* q; const float* rq; const float2* rope;
  __device__ __forceinline__ void operator()(const pg8::f32x4 (&acc)[2][2][4][2], const pg8::Unit& u, int wr, int wc, int fr, int fq) const {
    const int row0 = u.pm * 256 + wr * 64 + fr;
#pragma unroll
    for (int ai = 0; ai < 2; ++ai)
#pragma unroll
      for (int m = 0; m < 4; ++m) {
        const int row = row0 + ai * 128 + m * 16;
        const float sc = rq[row] * QSCALE96;
        const int pos = tok_pos(row);
#pragma unroll
        for (int bj = 0; bj < 2; ++bj) {
          const int gb = u.pn * 256 + bj * 128 + wc * 32;
          pg8::f32x4 v0 = acc[ai][bj][m][0] * sc, v1 = acc[ai][bj][m][1] * sc;
          if (((gb >> 5) % 3) == 2) {
            const float4 ca = *(const float4*)(rope + pos * 16 + 4 * fq), cb = *(const float4*)(rope + pos * 16 + 4 * fq + 2);
            const float cs[4] = {ca.x, ca.z, cb.x, cb.z}, sn[4] = {ca.y, ca.w, cb.y, cb.w};
#pragma unroll
            for (int e = 0; e < 4; ++e) { const float x1 = v0[e], x2 = v1[e]; v0[e] = x1 * cs[e] - x2 * sn[e]; v1[e] = x2 * cs[e] + x1 * sn[e]; }
          }
          u16* dst = q + (size_t)row * 1536 + gb + 4 * fq;
          u32x2 w0; w0.x = cvt_pk(v0[0], v0[1]); w0.y = cvt_pk(v0[2], v0[3]);
          u32x2 w1; w1.x = cvt_pk(v1[0], v1[1]); w1.y = cvt_pk(v1[2], v1[3]);
          *(u32x2*)dst = w0;
          *(u32x2*)(dst + 16) = w1;
        }
      }
  }
};
struct PgEpiKnope {
  static constexpr bool PERM = true, AFTER_DRAIN = false;
  u16* knope; const float* rkv; unsigned* kp;
  __device__ __forceinline__ void operator()(const pg8::f32x4 (&acc)[2][2][4][2], const pg8::Unit& u, int wr, int wc, int fr, int fq) const {
    const int row0 = u.pm * 256 + wr * 64 + fr;
    float pm[2] = {0.f, 0.f};
#pragma unroll
    for (int ai = 0; ai < 2; ++ai)
#pragma unroll
      for (int m = 0; m < 4; ++m) {
        const int row = row0 + ai * 128 + m * 16;
        const float sc = rkv[row];
#pragma unroll
        for (int bj = 0; bj < 2; ++bj) {
          const pg8::f32x4 v0 = acc[ai][bj][m][0] * sc, v1 = acc[ai][bj][m][1] * sc;
          u32x4 w4; w4.x = cvt_pk(v0[0], v0[1]); w4.y = cvt_pk(v0[2], v0[3]); w4.z = cvt_pk(v1[0], v1[1]); w4.w = cvt_pk(v1[2], v1[3]);
          *(u32x4*)(knope + (size_t)row * 1024 + u.pn * 256 + bj * 128 + wc * 32 + 8 * fq) = w4;
          float ss = 0.f;
#pragma unroll
          for (int e = 0; e < 4; ++e) ss += v0[e] * v0[e] + v1[e] * v1[e];
          pm[bj] = fmaxf(pm[bj], ss);
        }
      }
#pragma unroll
    for (int bj = 0; bj < 2; ++bj) {
      float v = pm[bj];
      v = fmaxf(v, __int_as_float(__builtin_amdgcn_ds_swizzle(__float_as_int(v), (8 << 10) | 0x1f)));
      v = fmaxf(v, __int_as_float(__builtin_amdgcn_ds_swizzle(__float_as_int(v), (4 << 10) | 0x1f)));
      v = fmaxf(v, __int_as_float(__builtin_amdgcn_ds_swizzle(__float_as_int(v), (2 << 10) | 0x1f)));
      v = fmaxf(v, __int_as_float(__builtin_amdgcn_ds_swizzle(__float_as_int(v), (1 << 10) | 0x1f)));
      if (fr == 0) atomicMax(kp + ((u.pn * 256 + bj * 128 + wc * 32) >> 6) * 8 + ((wc & 1) << 2) + fq, __float_as_uint(sqrtf(v) * 1.01f));
    }
  }
};
struct PgEpiVt {
  static constexpr bool PERM = true, AFTER_DRAIN = false;
  u16* vt; const float* rkv;
  __device__ __forceinline__ void operator()(const pg8::f32x4 (&acc)[2][2][4][2], const pg8::Unit& u, int wr, int wc, int fr, int fq) const {
    const int row0 = u.pm * 256 + wr * 64 + fr;
#pragma unroll
    for (int bj = 0; bj < 2; ++bj) {
      const int c0 = u.pn * 256 + bj * 128 + wc * 32 + 8 * fq;
      const float4 s0 = *(const float4*)(rkv + c0), s1 = *(const float4*)(rkv + c0 + 4);
#pragma unroll
      for (int ai = 0; ai < 2; ++ai)
#pragma unroll
        for (int m = 0; m < 4; ++m) {
          const pg8::f32x4 v0 = acc[ai][bj][m][0], v1 = acc[ai][bj][m][1];
          u32x4 w4; w4.x = cvt_pk(v0[0] * s0.x, v0[1] * s0.y); w4.y = cvt_pk(v0[2] * s0.z, v0[3] * s0.w);
          w4.z = cvt_pk(v1[0] * s1.x, v1[1] * s1.y); w4.w = cvt_pk(v1[2] * s1.z, v1[3] * s1.w);
          *(u32x4*)(vt + (size_t)(row0 + ai * 128 + m * 16) * T_TOK + c0) = w4;
        }
    }
  }
};
template <class Epi>
DI void pg_gemm_ld(const u16* A, int lda, const u16* Bt, int ldb, int M, int N, int K, const Epi& E, char* lds, int bid, int nblk, const Ctx& p) {
  pg8::Gemm g{A, Bt, M, N, K, lda, ldb};
  pg8::StaticOrder S; S.init(M, N, nblk, bid);
  pg8::gemm_phase<Epi, pg8::StaticOrder, false>((PG8_LAS unsigned char*)lds, g, S, E, nullptr, otid(p));
}

DI void grid_barrier(unsigned* ctr, unsigned target, const Ctx& p) {
  __syncthreads();
  if (otid(p) < 64) {
    __builtin_amdgcn_fence(__ATOMIC_RELEASE, "agent");
    if (otid(p) == 0) {
      __hip_atomic_fetch_add(ctr, 1u, __ATOMIC_RELAXED, __HIP_MEMORY_SCOPE_AGENT);
      while (__hip_atomic_load(ctr, __ATOMIC_RELAXED, __HIP_MEMORY_SCOPE_AGENT) < target) __builtin_amdgcn_s_sleep(1);
    }
    __builtin_amdgcn_fence(__ATOMIC_ACQUIRE, "agent");
  }
  __syncthreads();
}
template <int PH>
DI void run_phase(const Ctx& p, char* lds) {
  const int bid = obid(), nblk = gridDim.x;
  u16* wb = (u16*)p.ws;
  u16* R1 = (u16*)(p.ws + OFF_R1);
  u16* R2 = (u16*)(p.ws + OFF_R2);
  u16* R3 = (u16*)(p.ws + OFF_R3);
  if constexpr (PH == 0) phase_prep(p);
  else if constexpr (PH == 1) {
    pg_gemm(R1, wb + W0IN, T_TOK, 2048, 1024, pg8::EpiBf16<0>{R2, 512, nullptr, 512, SEG512}, lds, bid, nblk, p);
    pg_gemm(wb + W0IN + (size_t)2048 * 1024, R1, 1024, T_TOK, 1024, pg8::EpiBf16<0>{R2 + 4 * SEG512, T_TOK, nullptr, 0, 0}, lds, bid, nblk, p);
    grid_barrier((unsigned*)(p.ws + OFF_SCAL) + SC_BAR2, (unsigned)nblk, p);
    phase_qk_norms(p);
  }
  else if constexpr (PH == 2) {
    unsigned* ctr = (unsigned*)(p.ws + OFF_SCAL) + SC_CTR;
    int* nxt_slot = (int*)(lds + LDS_BYTES - 16);
    const int tid0 = otid(p);
    int it = bid;
    while (it < 5120) {
      int nx = 0;
      if (tid0 == 0) nx = (int)atomicAdd(ctr, 1u) + nblk;
      if (it < 2560) attn_diff_item(p, it, lds);
      else attn_na_item(p, it - 2560, lds);
      __syncthreads();
      if (tid0 == 0) *nxt_slot = nx;
      __syncthreads();
      it = *nxt_slot;
    }
  }
  else if constexpr (PH == 3) pg_gemm(R1, wb + W0OUT, T_TOK, 1024, 1024, pg8::EpiBf16<0>{R3, 1024, nullptr, 0, 0}, lds, bid, nblk, p);
  else if constexpr (PH == 4) phase_res<true, false>(p, R3, (const float*)(p.ws + OFF_SCAL) + SC_G0);
  else if constexpr (PH == 5) pg_gemm(R1, wb + W0F1, T_TOK, 5632, 1024, PgEpiSwiGLU{R2}, lds, bid, nblk, p);
  else if constexpr (PH == 6) pg_gemm(R2, wb + W0F2, T_TOK, 1024, 2816, pg8::EpiBf16<0>{R3, 1024, nullptr, 0, 0}, lds, bid, nblk, p);
  else if constexpr (PH == 7) phase_res<false, false>(p, R3, (const float*)(p.ws + OFF_SCAL) + SC_G1);
  else if constexpr (PH == 8) pg_gemm(R1, wb + W1DN, T_TOK, 768, 1024, pg8::EpiBf16<0>{R3, 768, nullptr, 0, 0}, lds, bid, nblk, p);
  else if constexpr (PH == 9) phase_mla_stats(p);
  else if constexpr (PH == 10) {
    pg_gemm_ld(R3, 768, wb + W1UQ, 384, T_TOK, 1536, 384, PgEpiUQ{R2, (const float*)(p.ws + OFF_RQ), (const float2*)(p.ws + OFF_ROPE)}, lds, bid, nblk, p);
    pg_gemm_ld(R3 + 384, 768, wb + W1UKV, 256, T_TOK, 1024, 256,
               PgEpiKnope{R2 + (size_t)T_TOK * 1536, (const float*)(p.ws + OFF_RKV), (unsigned*)(p.ws + OFF_SCAL) + SC_KP}, lds, bid, nblk, p);
    pg_gemm_ld(wb + W1UKV + (size_t)1024 * 256, 256, R3 + 384, 768, 1024, T_TOK, 256,
               PgEpiVt{R2 + (size_t)T_TOK * 2560, (const float*)(p.ws + OFF_RKV)}, lds, bid, nblk, p);
  }
  else if constexpr (PH == 11) { for (int it = bid; it < 2560; it += nblk) {
      int itm = it;
      if (nblk == 256) {
        const int rnd = it >> 8, x = bid & 7, j = bid >> 3;
        itm = rnd < 2 ? (8 * rnd + x) * 32 + j : 512 + (2 * (rnd - 2) + (x >> 2)) * 128 + (4 * (x & 3) + (j >> 3)) * 8 + (j & 7);
      }
      attn_mla_item2(p, itm, lds);
    } }
  else if constexpr (PH == 12) pg_gemm(R1, wb + W1OUT, T_TOK, 1024, 1024, pg8::EpiBf16<0>{R3, 1024, nullptr, 0, 0}, lds, bid, nblk, p);
  else if constexpr (PH == 13) phase_res<false, false>(p, R3, (const float*)(p.ws + OFF_SCAL) + SC_G2);
  else if constexpr (PH == 14) pg_gemm(R1, wb + W1F1, T_TOK, 5632, 1024, PgEpiSwiGLU{R2}, lds, bid, nblk, p);
  else if constexpr (PH == 15) pg_gemm(R2, wb + W1F2, T_TOK, 1024, 2816, pg8::EpiBf16<0>{R3, 1024, nullptr, 0, 0}, lds, bid, nblk, p);
  else if constexpr (PH == 16) phase_res<false, true>(p, R3, (const float*)(p.ws + OFF_SCAL) + SC_G3);
}

#if MULTI_LAUNCH
template <int PH>
__global__ void __launch_bounds__(512, 2) k_phase(Params pa) {
  extern __shared__ __attribute__((aligned(16))) char lds[];
  Ctx p;
#pragma unroll
  for (int i = 0; i < 28; ++i) p.in[i] = pa.in[i];
  p.out = pa.out; p.ws = pa.ws;
  p.wv = __builtin_amdgcn_readfirstlane((int)(threadIdx.x >> 6));
  run_phase<PH>(p, lds);
}
template <int PH>
static void launch_all(const Params& p, int grid, hipStream_t stream) {
  (void)hipFuncSetAttribute((const void*)k_phase<PH>, hipFuncAttributeMaxDynamicSharedMemorySize, LDS_BYTES);
  hipLaunchKernelGGL(k_phase<PH>, dim3(grid), dim3(512), LDS_BYTES, stream, p);
  if constexpr (PH + 1 < NPHASE) launch_all<PH + 1>(p, grid, stream);
}
#define OCC_KERNEL k_phase<2>
#else
#ifndef PROBE_DUP
#define PROBE_DUP -1
#endif
#ifndef PROBE_DUP2
#define PROBE_DUP2 -1
#endif
template <int PH>
DI void run_from(const Ctx& p, char* lds) {
  if constexpr (PH == PROBE_DUP || PH == PROBE_DUP2) { run_phase<PH>(p, lds); cg::this_grid().sync(); }
#ifdef PROBE_ABL
  if constexpr (PH == 11) { for (int it = obid(); it < 5120; it += gridDim.x) attn_mla_item<PROBE_ABL>(p, it, lds); cg::this_grid().sync(); }
#endif
  run_phase<PH>(p, lds);
  if constexpr (PH + 1 < NPHASE) {
    if constexpr (PH == 0) cg::this_grid().sync();
    else grid_barrier((unsigned*)(p.ws + OFF_SCAL) + SC_BAR, (unsigned)PH * gridDim.x, p);
    run_from<PH + 1>(p, lds);
  }
}
__global__ void __launch_bounds__(512, 2) mega(Params pa) {
  extern __shared__ __attribute__((aligned(16))) char lds[];
  Ctx p;
#pragma unroll
  for (int i = 0; i < 28; ++i) p.in[i] = pa.in[i];
  p.out = pa.out; p.ws = pa.ws;
  p.wv = __builtin_amdgcn_readfirstlane((int)(threadIdx.x >> 6));
  run_from<0>(p, lds);
}
#define OCC_KERNEL mega
#endif

extern "C" void kernel_launch(void* const* d_in, const int* in_sizes, int n_in, void* d_out, int out_size, void* d_ws, size_t ws_size,
                              hipStream_t stream) {
  static int grid = 0;
  if (grid == 0) {
    if (n_in != 28 || ws_size < WS_NEED) { fprintf(stderr, "kernel_launch: unexpected n_in %d / ws_size %zu (need %zu)\n", n_in, ws_size, (size_t)WS_NEED); grid = -1; return; }
    int dev = 0, cus = 0, per_cu = 0;
    (void)hipGetDevice(&dev);
    (void)hipDeviceGetAttribute(&cus, hipDeviceAttributeMultiprocessorCount, dev);
    (void)hipFuncSetAttribute((const void*)OCC_KERNEL, hipFuncAttributeMaxDynamicSharedMemorySize, LDS_BYTES);
    (void)hipOccupancyMaxActiveBlocksPerMultiprocessor(&per_cu, (const void*)OCC_KERNEL, 512, LDS_BYTES);
    if (per_cu < 1) per_cu = 1;
    if (per_cu > 1) per_cu = 1;
    grid = cus * per_cu;
  }
  if (grid < 0) return;
  Params p{};
  for (int i = 0; i < 28; ++i) p.in[i] = (const float*)d_in[i];
  p.out = (float*)d_out;
  p.ws = (char*)d_ws;
#if MULTI_LAUNCH
  launch_all<0>(p, grid, stream);
#else
  void* args[] = {&p};
  hipError_t e = hipLaunchCooperativeKernel((const void*)mega, dim3(grid), dim3(512), args, LDS_BYTES, stream);
  if (e != hipSuccess) fprintf(stderr, "cooperative launch failed: %s (grid %d)\n", hipGetErrorString(e), grid);
#endif
}
```

```cpp
#include <hip/hip_runtime.h>
#include <hip/hip_cooperative_groups.h>
#include <stdint.h>
#include <cstdio>
namespace cg = cooperative_groups;

#ifndef MULTI_LAUNCH
#define MULTI_LAUNCH 0
#endif

typedef unsigned short u16;
typedef __attribute__((ext_vector_type(8))) short bf16x8;
typedef __attribute__((ext_vector_type(16))) float f32x16;
typedef __attribute__((ext_vector_type(4))) unsigned u32x4;

#define MFMA32(a, b, c) __builtin_amdgcn_mfma_f32_32x32x16_bf16((a), (b), (c), 0, 0, 0)
#define DI __device__ __forceinline__

constexpr int T_TOK = 81920;
constexpr int T_PROMPT = 65536;
constexpr int DM = 1024;
constexpr int DFF = 2816;
constexpr float EPS = 1e-6f;
constexpr float LOG2E = 1.4426950408889634f;
constexpr float QSCALE64 = 0.125f * LOG2E;
constexpr float QSCALE96 = 0.10206207261596577f * LOG2E;
constexpr int NPHASE = 17;

constexpr size_t MiB = (size_t)1 << 20;
constexpr size_t W0IN = 0;
constexpr size_t W0OUT = W0IN + (size_t)3072 * 1024;
constexpr size_t W0F1 = W0OUT + (size_t)1024 * 1024;
constexpr size_t W0F2 = W0F1 + (size_t)5632 * 1024;
constexpr size_t W1DN = W0F2 + (size_t)1024 * 2816;
constexpr size_t W1UQ = W1DN + (size_t)768 * 1024;
constexpr size_t W1UKV = W1UQ + (size_t)1536 * 384;
constexpr size_t W1OUT = W1UKV + (size_t)2048 * 256;
constexpr size_t W1F1 = W1OUT + (size_t)1024 * 1024;
constexpr size_t W1F2 = W1F1 + (size_t)5632 * 1024;
constexpr size_t W_END = W1F2 + (size_t)1024 * 2816;
static_assert(W_END * 2 <= 48 * MiB, "weights region");
constexpr size_t OFF_ROPE = 48 * MiB;
constexpr size_t OFF_RQ = OFF_ROPE + 2 * MiB;
constexpr size_t OFF_RKV = OFF_RQ + MiB / 2;
constexpr size_t OFF_KROPE = OFF_RKV + MiB / 2;
constexpr size_t OFF_SCAL = OFF_KROPE + 5 * MiB;
constexpr int SC_KP = 64;
constexpr int SC_QKMAX = 16, SC_CTR = 32, SC_BAR = 33, SC_BAR2 = 34, SC_KMAX1 = 40, SC_KRMAX = 56;
constexpr int SC_G0 = 1024, SC_G1 = 2048, SC_G2 = 3072, SC_G3 = 4096, SC_GSUB = 5120, SC_RPB = 6144;
constexpr size_t OFF_R1 = 58 * MiB;
constexpr size_t OFF_R3 = OFF_R1 + 160 * MiB;
constexpr size_t OFF_R2 = OFF_R3 + 160 * MiB;
constexpr size_t WS_NEED = OFF_R2 + 560 * MiB;
constexpr size_t SEG512 = (size_t)T_TOK * 512;

struct Params {
  const float* in[28];
  float* out;
  char* ws;
};
struct Ctx {
  const float* in[28];
  float* out;
  char* ws;
  int wv;
};

DI u16 f2bf(float x) { unsigned u = __float_as_uint(x); u += 0x7fffu + ((u >> 16) & 1u); return (u16)(u >> 16); }
DI unsigned pack2(float a, float b) { return (unsigned)f2bf(a) | ((unsigned)f2bf(b) << 16); }
DI float bflo(unsigned v) { return __uint_as_float(v << 16); }
DI float bfhi(unsigned v) { return __uint_as_float(v & 0xffff0000u); }
DI float wave_sum(float v) {
#pragma unroll
  for (int o = 32; o; o >>= 1) v += __shfl_xor(v, o);
  return v;
}
DI int tok_pos(int t) { return t < T_PROMPT ? (t & 4095) : (t - T_PROMPT); }
typedef float f32x4nt __attribute__((ext_vector_type(4)));
DI float fexp2(float x) { return __builtin_amdgcn_exp2f(x); }
typedef __attribute__((ext_vector_type(2))) float f32x2;
typedef __attribute__((ext_vector_type(2))) __bf16 bf16x2_t;
typedef __attribute__((ext_vector_type(2))) unsigned u32x2;
typedef __attribute__((ext_vector_type(4))) unsigned u32x4_;
DI unsigned cvt_pk(float a, float b) {
  f32x2 v; v.x = a; v.y = b;
  return __builtin_bit_cast(unsigned, __builtin_convertvector(v, bf16x2_t));
}
DI int otid(const Ctx& p) {
  int wv = p.wv; asm volatile("" : "+s"(wv));
  int t = wv * 64 + (int)__builtin_amdgcn_mbcnt_hi(~0u, __builtin_amdgcn_mbcnt_lo(~0u, 0u));
  asm volatile("" : "+v"(t));
  return t;
}
DI int obid() { int b = blockIdx.x; asm volatile("" : "+s"(b)); return b; }

__device__ const float ROPE_INV[16] = {1.0f, 0.5623413324356079f, 0.3162277638912201f, 0.17782793939113617f, 0.10000000149011612f, 0.05623413249850273f, 0.03162277489900589f, 0.017782794311642647f, 0.009999999776482582f, 0.005623413249850273f, 0.003162277629598975f, 0.0017782794311642647f, 0.0010000000474974513f, 0.000562341301701963f, 0.0003162277571391314f, 0.00017782794020604342f};

DI void wconv(const float* __restrict__ W, const float* __restrict__ g, u16* __restrict__ dst, int K, int N, int rowsOut, int perm, int gtid, int gthreads) {
  const int kc = K >> 3;
  const long total = (long)rowsOut * kc;
  for (long c = gtid; c < total; c += gthreads) {
    const int n = (int)(c % rowsOut);
    const int k0 = (int)(c / rowsOut) * 8;
    int sc;
    if (perm == 1) { const int blk = n >> 8, w = n & 255; const int j = blk * 128 + (w & 127); sc = (w < 128) ? j : DFF + j; }
    else if (perm == 3) { sc = n < 1024 ? n : (n < 2048 ? n + 512 : (n < 2560 ? n - 1024 : n)); }
    else if (perm == 2) { const int hd = (n & 1023) >> 6, d = n & 63; sc = hd * 128 + (n >= 1024 ? 64 : 0) + d; }
    else sc = n;
    uint4 o = make_uint4(0, 0, 0, 0);
    if (sc < N) {
      float v[8];
      const float rsc = (perm == 3 && (n < 512 || (n >= 1024 && n < 1536))) ? QSCALE64 : 1.f;
#pragma unroll
      for (int i = 0; i < 8; ++i) { float x = __builtin_nontemporal_load(W + (size_t)(k0 + i) * N + sc); if (g) x *= g[k0 + i]; v[i] = x * rsc; }
      o.x = pack2(v[0], v[1]); o.y = pack2(v[2], v[3]); o.z = pack2(v[4], v[5]); o.w = pack2(v[6], v[7]);
    }
    *(uint4*)(dst + (size_t)n * K + k0) = o;
  }
}

DI void phase_prep(const Ctx& p) {
  const int gtid = obid() * 512 + otid(p), gthreads = gridDim.x * 512;
  u16* wb = (u16*)p.ws;
  wconv(p.in[3], p.in[2], wb + W0IN, 1024, 3072, 3072, 3, gtid, gthreads);
  wconv(p.in[10], nullptr, wb + W0OUT, 1024, 1024, 1024, 0, gtid, gthreads);
  wconv(p.in[13], p.in[12], wb + W0F1, 1024, 5632, 5632, 1, gtid, gthreads);
  wconv(p.in[14], nullptr, wb + W0F2, 2816, 1024, 1024, 0, gtid, gthreads);
  wconv(p.in[17], p.in[16], wb + W1DN, 1024, 672, 768, 0, gtid, gthreads);
  wconv(p.in[20], p.in[18], wb + W1UQ, 384, 1536, 1536, 0, gtid, gthreads);
  wconv(p.in[21], p.in[19], wb + W1UKV, 256, 2048, 2048, 2, gtid, gthreads);
  wconv(p.in[22], nullptr, wb + W1OUT, 1024, 1024, 1024, 0, gtid, gthreads);
  wconv(p.in[25], p.in[24], wb + W1F1, 1024, 5632, 5632, 1, gtid, gthreads);
  wconv(p.in[26], nullptr, wb + W1F2, 2816, 1024, 1024, 0, gtid, gthreads);
  float2* rope = (float2*)(p.ws + OFF_ROPE);
  for (int idx = gtid; idx < 16384 * 16; idx += gthreads) {
    const int pos = idx >> 4, i = idx & 15;
    const float ang = (float)pos * ROPE_INV[i];
    double rev = (double)ang * 0.15915494309189535;
    rev -= rint(rev);
    const float rf = (float)rev;
    rope[idx] = make_float2(__builtin_amdgcn_cosf(rf), __builtin_amdgcn_sinf(rf));
  }
  if (gtid == 0) {
    float s1 = 0.f, s2 = 0.f;
    for (int i = 0; i < 64; ++i) { s1 += p.in[5][i] * p.in[6][i]; s2 += p.in[7][i] * p.in[8][i]; }
    float* sc = (float*)(p.ws + OFF_SCAL);
    sc[0] = __expf(s1) - __expf(s2) + 0.2f;
    for (int i = 0; i < 176; ++i) ((unsigned*)sc)[SC_QKMAX + i] = 0u;
  }
  {
    float* sc = (float*)(p.ws + OFF_SCAL);
    for (int i = gtid; i < 1024; i += gthreads) { sc[SC_G0 + i] = p.in[11][i]; sc[SC_G1 + i] = p.in[15][i]; sc[SC_G2 + i] = p.in[23][i]; sc[SC_G3 + i] = p.in[27][i]; }
    for (int i = gtid; i < 128; i += gthreads) sc[SC_GSUB + i] = p.in[9][i];
    for (int i = gtid; i < 8 * 465; i += gthreads) sc[SC_RPB + i] = p.in[4][i] * LOG2E;
  }
  const int tid_ = otid(p);
  const int lane = tid_ & 63;
  const int gw = obid() * 8 + (tid_ >> 6), nw = gridDim.x * 8;
  u16* hb = (u16*)(p.ws + OFF_R1);
  for (int row = gw; row < T_TOK; row += nw) {
    const float* xr = row < T_PROMPT ? p.in[0] + (size_t)row * DM : p.in[1] + (size_t)(row - T_PROMPT) * DM;
    float4 v[4];
    float ss = 0.f;
#pragma unroll
    for (int j = 0; j < 4; ++j) { const f32x4nt xx = __builtin_nontemporal_load((const f32x4nt*)xr + lane + 64 * j); v[j] = make_float4(xx.x, xx.y, xx.z, xx.w); ss += v[j].x * v[j].x + v[j].y * v[j].y + v[j].z * v[j].z + v[j].w * v[j].w; }
    ss = wave_sum(ss);
    const float r = rsqrtf(ss * (1.f / DM) + EPS);
#pragma unroll
    for (int j = 0; j < 4; ++j) {
      uint2 o; o.x = pack2(v[j].x * r, v[j].y * r); o.y = pack2(v[j].z * r, v[j].w * r);
      ((uint2*)(hb + (size_t)row * DM))[lane + 64 * j] = o;
    }
  }
}

template <bool FIRST, bool LAST>
DI void phase_res(const Ctx& p, const u16* __restrict__ mbuf, const float* __restrict__ g) {
  const int tid_ = otid(p);
  const int lane = tid_ & 63;
  const int gw = obid() * 8 + (tid_ >> 6), nw = gridDim.x * 8;
  u16* hb = (u16*)(p.ws + OFF_R1);
  float4 gv[4];
#pragma unroll
  for (int j = 0; j < 4; ++j) gv[j] = ((const float4*)g)[lane + 64 * j];
  for (int row0 = gw; row0 < T_TOK; row0 += 2 * nw) {
    float4 xv[2][4], mv[2][4];
    float ss[2] = {0.f, 0.f};
    bool act[2];
#pragma unroll
    for (int t = 0; t < 2; ++t) {
      const int row = row0 + t * nw;
      act[t] = row < T_TOK;
      const int rr = act[t] ? row : row0;
      const float* xr;
      if (FIRST) xr = rr < T_PROMPT ? p.in[0] + (size_t)rr * DM : p.in[1] + (size_t)(rr - T_PROMPT) * DM;
      else xr = p.out + (size_t)rr * DM;
#pragma unroll
      for (int j = 0; j < 4; ++j) {
        const u32x2 u = __builtin_nontemporal_load((const u32x2*)(mbuf + (size_t)rr * DM) + lane + 64 * j);
        mv[t][j] = make_float4(bflo(u.x), bfhi(u.x), bflo(u.y), bfhi(u.y));
        { const f32x4nt xx = __builtin_nontemporal_load((const f32x4nt*)xr + lane + 64 * j); xv[t][j] = make_float4(xx.x, xx.y, xx.z, xx.w); }
      }
    }
#pragma unroll
    for (int t = 0; t < 2; ++t) {
#pragma unroll
      for (int j = 0; j < 4; ++j) ss[t] += mv[t][j].x * mv[t][j].x + mv[t][j].y * mv[t][j].y + mv[t][j].z * mv[t][j].z + mv[t][j].w * mv[t][j].w;
      ss[t] = wave_sum(ss[t]);
    }
#pragma unroll
    for (int t = 0; t < 2; ++t) {
      if (!act[t]) continue;
      const int row = row0 + t * nw;
      const float rm = rsqrtf(ss[t] * (1.f / DM) + EPS);
      float s2 = 0.f;
#pragma unroll
      for (int j = 0; j < 4; ++j) {
        xv[t][j].x += mv[t][j].x * rm * gv[j].x; xv[t][j].y += mv[t][j].y * rm * gv[j].y;
        xv[t][j].z += mv[t][j].z * rm * gv[j].z; xv[t][j].w += mv[t][j].w * rm * gv[j].w;
        s2 += xv[t][j].x * xv[t][j].x + xv[t][j].y * xv[t][j].y + xv[t][j].z * xv[t][j].z + xv[t][j].w * xv[t][j].w;
        { f32x4nt xx; xx.x = xv[t][j].x; xx.y = xv[t][j].y; xx.z = xv[t][j].z; xx.w = xv[t][j].w; __builtin_nontemporal_store(xx, (f32x4nt*)(p.out + (size_t)row * DM) + lane + 64 * j); }
      }
      if (!LAST) {
        s2 = wave_sum(s2);
        const float r2 = rsqrtf(s2 * (1.f / DM) + EPS);
#pragma unroll
        for (int j = 0; j < 4; ++j) {
          uint2 o; o.x = pack2(xv[t][j].x * r2, xv[t][j].y * r2); o.y = pack2(xv[t][j].z * r2, xv[t][j].w * r2);
          ((uint2*)(hb + (size_t)row * DM))[lane + 64 * j] = o;
        }
      }
    }
  }
}

DI void phase_mla_stats(const Ctx& p) {
  const int tid_ = otid(p);
  const int lane = tid_ & 63;
  const int gw = obid() * 8 + (tid_ >> 6), nw = gridDim.x * 8;
  const u16* c = (const u16*)(p.ws + OFF_R3);
  float* rq = (float*)(p.ws + OFF_RQ);
  float* rkv = (float*)(p.ws + OFF_RKV);
  u16* krope = (u16*)(p.ws + OFF_KROPE);
  const float2* rope = (const float2*)(p.ws + OFF_ROPE);
  float krmax2 = 0.f;
  for (int row = gw; row < T_TOK; row += nw) {
    const u16* cr = c + (size_t)row * 768;
    const uint4 u0 = ((const uint4*)cr)[lane];
    float s0 = 0.f;
    { float a;
      a = bflo(u0.x); s0 += a * a; a = bfhi(u0.x); s0 += a * a; a = bflo(u0.y); s0 += a * a; a = bfhi(u0.y); s0 += a * a;
      a = bflo(u0.z); s0 += a * a; a = bfhi(u0.z); s0 += a * a; a = bflo(u0.w); s0 += a * a; a = bfhi(u0.w); s0 += a * a; }
    float s1 = 0.f;
    if (lane < 16) {
      const uint4 u1 = ((const uint4*)cr)[64 + lane];
      float a;
      a = bflo(u1.x); s1 += a * a; a = bfhi(u1.x); s1 += a * a; a = bflo(u1.y); s1 += a * a; a = bfhi(u1.y); s1 += a * a;
      a = bflo(u1.z); s1 += a * a; a = bfhi(u1.z); s1 += a * a; a = bflo(u1.w); s1 += a * a; a = bfhi(u1.w); s1 += a * a;
    }
    const float sq = wave_sum(lane < 48 ? s0 : 0.f);
    const float skv = wave_sum((lane >= 48 ? s0 : 0.f) + s1);
    if (lane == 0) {
      rq[row] = rsqrtf(sq * (1.f / 384.f) + EPS);
      rkv[row] = rsqrtf(skv * (1.f / 256.f) + EPS);
    }
    float kr2 = 0.f;
    if (lane < 16) {
      const float x1 = __uint_as_float((unsigned)cr[640 + lane] << 16);
      const float x2 = __uint_as_float((unsigned)cr[656 + lane] << 16);
      const float2 cs = rope[tok_pos(row) * 16 + lane];
      const float o1 = x1 * cs.x - x2 * cs.y, o2 = x2 * cs.x + x1 * cs.y;
      krope[(size_t)row * 32 + lane] = f2bf(o1);
      krope[(size_t)row * 32 + 16 + lane] = f2bf(o2);
      kr2 = o1 * o1 + o2 * o2;
    }
    krmax2 = fmaxf(krmax2, wave_sum(kr2));
  }
  if (lane == 0) atomicMax((unsigned*)(p.ws + OFF_SCAL) + SC_KRMAX, __float_as_uint(sqrtf(krmax2)));
}

DI void store_tok(u16* out, int ldo, int m, int nbase, const f32x16& v, float sc) {
  u16* q = out + (size_t)m * ldo + nbase;
#pragma unroll
  for (int g = 0; g < 4; ++g) {
    uint2 u; u.x = pack2(v[4 * g] * sc, v[4 * g + 1] * sc); u.y = pack2(v[4 * g + 2] * sc, v[4 * g + 3] * sc);
    *(uint2*)(q + 8 * g) = u;
  }
}
DI void store_tr(u16* outT, size_t ldt, int n, int mbase, const f32x16& v, const float* __restrict__ rs) {
  u16* q = outT + (size_t)n * ldt + mbase;
#pragma unroll
  for (int g = 0; g < 4; ++g) {
    float4 s = make_float4(1.f, 1.f, 1.f, 1.f);
    if (rs) s = *(const float4*)(rs + mbase + 8 * g);
    uint2 u; u.x = pack2(v[4 * g] * s.x, v[4 * g + 1] * s.y); u.y = pack2(v[4 * g + 2] * s.z, v[4 * g + 3] * s.w);
    *(uint2*)(q + 8 * g) = u;
  }
}

DI void store_tok_u(u16* ub, unsigned loff, const f32x16& v, float sc) {
  char* q = (char*)ub;
  const unsigned hoff = (loff & 8u) << 1;
  const unsigned lbase = loff & ~8u;
#pragma unroll
  for (int pi = 0; pi < 2; ++pi) {
    const int g0 = 2 * pi, g1 = 2 * pi + 1;
    const unsigned a0 = cvt_pk(v[4 * g0] * sc, v[4 * g0 + 1] * sc), a1 = cvt_pk(v[4 * g0 + 2] * sc, v[4 * g0 + 3] * sc);
    const unsigned b0 = cvt_pk(v[4 * g1] * sc, v[4 * g1 + 1] * sc), b1 = cvt_pk(v[4 * g1 + 2] * sc, v[4 * g1 + 3] * sc);
    const u32x2 s0 = __builtin_amdgcn_permlane32_swap(a0, b0, false, false);
    const u32x2 s1 = __builtin_amdgcn_permlane32_swap(a1, b1, false, false);
    u32x4 u; u.x = s0.x; u.y = s1.x; u.z = s0.y; u.w = s1.y;
    *(u32x4*)(q + lbase + hoff + 32 * pi) = u;
  }
}
DI void store_tr_u(u16* ub, unsigned loff, const f32x16& v, const float* __restrict__ rs) {
  char* q = (char*)ub;
  const unsigned hoff = (loff & 8u) << 1;
  const unsigned lbase = loff & ~8u;
#pragma unroll
  for (int pi = 0; pi < 2; ++pi) {
    const int g0 = 2 * pi, g1 = 2 * pi + 1;
    float4 sa = make_float4(1.f, 1.f, 1.f, 1.f), sb = sa;
    if (rs) { sa = *(const float4*)(rs + 8 * g0); sb = *(const float4*)(rs + 8 * g1); }
    const unsigned a0 = cvt_pk(v[4 * g0] * sa.x, v[4 * g0 + 1] * sa.y), a1 = cvt_pk(v[4 * g0 + 2] * sa.z, v[4 * g0 + 3] * sa.w);
    const unsigned b0 = cvt_pk(v[4 * g1] * sb.x, v[4 * g1 + 1] * sb.y), b1 = cvt_pk(v[4 * g1 + 2] * sb.z, v[4 * g1 + 3] * sb.w);
    const u32x2 s0 = __builtin_amdgcn_permlane32_swap(a0, b0, false, false);
    const u32x2 s1 = __builtin_amdgcn_permlane32_swap(a1, b1, false, false);
    u32x4 u; u.x = s0.x; u.y = s1.x; u.z = s0.y; u.w = s1.y;
    *(u32x4*)(q + lbase + hoff + 32 * pi) = u;
  }
}

struct EpiTok {
  u16* out; int ldo;
  static constexpr int SWAPMODE = 1;
  DI bool swap(int) const { return true; }
  template <int WMB, int WNB>
  DI void store(int m0w, int n0w, f32x16 (&acc)[WMB][WNB], int r, int h, bool) const {
#pragma unroll
    for (int mb = 0; mb < WMB; ++mb)
#pragma unroll
      for (int nb = 0; nb < WNB; ++nb) store_tok_u(out + (size_t)(m0w + mb * 32) * ldo + n0w + nb * 32, (unsigned)((r * ldo + 4 * h) * 2), acc[mb][nb], 1.f);
  }
};

struct EpiProj0 {
  u16* base; unsigned* qkmax;
  static constexpr int SWAPMODE = 2;
  DI bool swap(int n0) const { const int reg = n0 >> 9; return !(reg == 2 || reg == 5); }
  template <int WMB, int WNB>
  DI void store(int m0w, int n0w, f32x16 (&acc)[WMB][WNB], int r, int h, bool) const {
    const int reg = n0w >> 9, nl = n0w & 511;
    u16* buf = base + (size_t)reg * SEG512;
    const float sc = (reg == 0 || reg == 3) ? QSCALE64 : 1.f;
#pragma unroll
    for (int mb = 0; mb < WMB; ++mb)
#pragma unroll
      for (int nb = 0; nb < WNB; ++nb) store_tok_u(buf + (size_t)(m0w + mb * 32) * 512 + nl + nb * 32, (unsigned)((r * 512 + 4 * h) * 2), acc[mb][nb], sc);
    __builtin_amdgcn_sched_barrier(0);
    if (reg == 3 || reg == 4) {
      static_assert(WNB == 2, "one head per wave tile");
      float mxn = 0.f;
#pragma unroll
      for (int mb = 0; mb < WMB; ++mb) {
        float ss = 0.f;
#pragma unroll
        for (int nb = 0; nb < WNB; ++nb)
#pragma unroll
          for (int i = 0; i < 16; ++i) { const float v = acc[mb][nb][i]; ss += v * v; }
        { const u32x2 sw = __builtin_amdgcn_permlane32_swap(__float_as_uint(ss), __float_as_uint(ss), false, false); ss = __uint_as_float(sw.x) + __uint_as_float(sw.y); }
        mxn = fmaxf(mxn, ss);
      }
      mxn = fmaxf(mxn, __int_as_float(__builtin_amdgcn_ds_swizzle(__float_as_int(mxn), (16 << 10) | 0x1f)));
      mxn = fmaxf(mxn, __int_as_float(__builtin_amdgcn_ds_swizzle(__float_as_int(mxn), (8 << 10) | 0x1f)));
      mxn = fmaxf(mxn, __int_as_float(__builtin_amdgcn_ds_swizzle(__float_as_int(mxn), (4 << 10) | 0x1f)));
      mxn = fmaxf(mxn, __int_as_float(__builtin_amdgcn_ds_swizzle(__float_as_int(mxn), (2 << 10) | 0x1f)));
      mxn = fmaxf(mxn, __int_as_float(__builtin_amdgcn_ds_swizzle(__float_as_int(mxn), (1 << 10) | 0x1f)));
      if (r == 0 && h == 0) atomicMax(qkmax + (reg - 3) * 8 + (nl >> 6), __float_as_uint(sqrtf(mxn) * sc));
    }
  }
  template <int WMB, int WNB>
  DI void store_t(int n0w, int m0w, f32x16 (&acc)[WMB][WNB], int r, int h) const {
    const int reg = n0w >> 9, nl = n0w & 511;
    u16* buf = base + (size_t)reg * SEG512;
#pragma unroll
    for (int mb = 0; mb < WMB; ++mb)
#pragma unroll
      for (int nb = 0; nb < WNB; ++nb) store_tr_u(buf + (size_t)(nl + mb * 32) * T_TOK + m0w + nb * 32, (unsigned)((r * T_TOK + 4 * h) * 2), acc[mb][nb], nullptr);
  }
};

struct EpiSwiGLU {
  u16* act;
  static constexpr int SWAPMODE = 1;
  DI bool swap(int) const { return true; }
  template <int WMB, int WNB>
  DI void store(int m0w, int n0w, f32x16 (&acc)[WMB][WNB], int r, int h, bool) const {
    static_assert(WNB == 2, "swiglu epilogue needs a 64-wide wave tile");
#pragma unroll
    for (int mb = 0; mb < WMB; ++mb) {
      char* q = (char*)(act + (size_t)(m0w + mb * 32) * DFF + (n0w >> 1)) + (unsigned)((r * DFF) * 2) + 16 * h;
#pragma unroll
      for (int pi = 0; pi < 2; ++pi) {
        unsigned pk[2][2];
#pragma unroll
        for (int gg = 0; gg < 2; ++gg) {
          const int g = 2 * pi + gg;
          float y[4];
#pragma unroll
          for (int e = 0; e < 4; ++e) {
            const float gt = acc[mb][0][4 * g + e], up = acc[mb][1][4 * g + e];
            y[e] = gt * __builtin_amdgcn_rcpf(1.f + fexp2(-LOG2E * gt)) * up;
          }
          pk[gg][0] = cvt_pk(y[0], y[1]); pk[gg][1] = cvt_pk(y[2], y[3]);
        }
        const u32x2 s0 = __builtin_amdgcn_permlane32_swap(pk[0][0], pk[1][0], false, false);
        const u32x2 s1 = __builtin_amdgcn_permlane32_swap(pk[0][1], pk[1][1], false, false);
        u32x4 u; u.x = s0.x; u.y = s1.x; u.z = s0.y; u.w = s1.y;
        *(u32x4*)(q + 32 * pi) = u;
      }
      __builtin_amdgcn_sched_barrier(0);
    }
  }
};

struct EpiUQ {
  u16* q; const float* rq; const float2* rope;
  static constexpr int SWAPMODE = 1;
  DI bool swap(int) const { return true; }
  template <int WMB, int WNB>
  DI void store(int m0w, int n0w, f32x16 (&acc)[WMB][WNB], int r, int h, bool) const {
#pragma unroll
    for (int mb = 0; mb < WMB; ++mb) {
      const int m = m0w + mb * 32 + r;
      const float sc = rq[m] * QSCALE96;
      const int pos = tok_pos(m);
#pragma unroll
      for (int nb = 0; nb < WNB; ++nb) {
        const int n0b = n0w + nb * 32;
        f32x16 v = acc[mb][nb];
#pragma unroll
        for (int i = 0; i < 16; ++i) v[i] *= sc;
        if (((n0b >> 5) % 3) == 2) {
#pragma unroll
          for (int i = 0; i < 8; ++i) {
            const int f = (i & 3) + 8 * (i >> 2) + 4 * h;
            const float2 cs = rope[pos * 16 + f];
            const float x1 = v[i], x2 = v[i + 8];
            v[i] = x1 * cs.x - x2 * cs.y;
            v[i + 8] = x2 * cs.x + x1 * cs.y;
          }
        }
        store_tok_u(q + (size_t)(m0w + mb * 32) * 1536 + n0b, (unsigned)((r * 1536 + 4 * h) * 2), v, 1.f);
        __builtin_amdgcn_sched_barrier(0);
      }
    }
  }
};

struct EpiUKV {
  u16* knope; u16* vt; const float* rkv; unsigned* kmax;
  static constexpr int SWAPMODE = 2;
  DI bool swap(int n0) const { return n0 < 1024; }
  template <int WMB, int WNB>
  DI void store(int m0w, int n0w, f32x16 (&acc)[WMB][WNB], int r, int h, bool) const {
#pragma unroll
    for (int mb = 0; mb < WMB; ++mb) {
      const int m = m0w + mb * 32 + r;
      const float sc = rkv[m];
#pragma unroll
      for (int nb = 0; nb < WNB; ++nb) store_tok_u(knope + (size_t)(m0w + mb * 32) * 1024 + n0w + nb * 32, (unsigned)((r * 1024 + 4 * h) * 2), acc[mb][nb], sc);
    }
    __builtin_amdgcn_sched_barrier(0);
    static_assert(WNB == 2, "one head per wave tile");
    float mxn = 0.f;
#pragma unroll
    for (int mb = 0; mb < WMB; ++mb) {
      float ss = 0.f;
#pragma unroll
      for (int nb = 0; nb < WNB; ++nb)
#pragma unroll
        for (int i = 0; i < 16; ++i) { const float v = acc[mb][nb][i]; ss += v * v; }
      { const u32x2 sw = __builtin_amdgcn_permlane32_swap(__float_as_uint(ss), __float_as_uint(ss), false, false); ss = __uint_as_float(sw.x) + __uint_as_float(sw.y); }
      const float sc = rkv[m0w + mb * 32 + r];
      mxn = fmaxf(mxn, ss * sc * sc);
    }
    mxn = fmaxf(mxn, __int_as_float(__builtin_amdgcn_ds_swizzle(__float_as_int(mxn), (16 << 10) | 0x1f)));
    mxn = fmaxf(mxn, __int_as_float(__builtin_amdgcn_ds_swizzle(__float_as_int(mxn), (8 << 10) | 0x1f)));
    mxn = fmaxf(mxn, __int_as_float(__builtin_amdgcn_ds_swizzle(__float_as_int(mxn), (4 << 10) | 0x1f)));
    mxn = fmaxf(mxn, __int_as_float(__builtin_amdgcn_ds_swizzle(__float_as_int(mxn), (2 << 10) | 0x1f)));
    mxn = fmaxf(mxn, __int_as_float(__builtin_amdgcn_ds_swizzle(__float_as_int(mxn), (1 << 10) | 0x1f)));
    if (r == 0 && h == 0) atomicMax(kmax + (n0w >> 6), __float_as_uint(sqrtf(mxn)));
  }
  template <int WMB, int WNB>
  DI void store_t(int n0w, int m0w, f32x16 (&acc)[WMB][WNB], int r, int h) const {
#pragma unroll
    for (int mb = 0; mb < WMB; ++mb)
#pragma unroll
      for (int nb = 0; nb < WNB; ++nb) store_tr_u(vt + (size_t)(n0w - 1024 + mb * 32) * T_TOK + m0w + nb * 32, (unsigned)((r * T_TOK + 4 * h) * 2), acc[mb][nb], rkv + m0w + nb * 32 + 4 * h);
  }
};

template <bool SWAP, int WMB, int WNB>
DI void gemm_compute(const char* la, const char* lb, f32x16 (&acc)[WMB][WNB], int wm, int wn, int r, int h) {
#pragma unroll
  for (int ks = 0; ks < 4; ++ks) {
    bf16x8 af[WMB], bfr[WNB];
#pragma unroll
    for (int mb = 0; mb < WMB; ++mb) af[mb] = *(const bf16x8*)(la + (wm * 32 * WMB + mb * 32 + r) * 144 + (ks * 2 + h) * 16);
#pragma unroll
    for (int nb = 0; nb < WNB; ++nb) bfr[nb] = *(const bf16x8*)(lb + (wn * 32 * WNB + nb * 32 + r) * 144 + (ks * 2 + h) * 16);
#pragma unroll
    for (int mb = 0; mb < WMB; ++mb)
#pragma unroll
      for (int nb = 0; nb < WNB; ++nb) {
        if (SWAP) acc[mb][nb] = MFMA32(bfr[nb], af[mb], acc[mb][nb]);
        else acc[mb][nb] = MFMA32(af[mb], bfr[nb], acc[mb][nb]);
      }
  }
}

struct TileDesc { bool valid; bool normal; int m0, n0, ldp, ldq; unsigned po, qo; const char* P; const char* Q; };

template <class Epi>
DI void gemm_phase(const u16* __restrict__ A, int lda, const u16* __restrict__ Bt, int ldb, int M, int N, int K, const Epi epi, char* lds, int bid, int nblk, const Ctx& p) {
  constexpr int WMB = 4, WNB = 2;
  constexpr int TM = 256, TN = 256;
  constexpr int STAGE = (TM + TN) * 144;
  const int tid = otid(p), lane = tid & 63, w = __builtin_amdgcn_readfirstlane(tid >> 6), wm = w >> 2, wn = w & 3, r = lane & 31, h = lane >> 5;
  const int lrow = tid >> 3, lch = tid & 7;
  const int NT = N / TN, MT = M / TM, tiles = MT * NT, nk = K >> 6;
  const int rounds = (tiles + nblk - 1) / nblk;
  auto desc = [&](int rnd) {
    TileDesc d;
    int tile = rnd * nblk + bid;
    if (nblk == 256) tile = rnd * 256 + (bid & 7) * 32 + (bid >> 3);
    d.valid = rnd < rounds && tile < tiles;
    const int grp = tile / (8 * NT), within = tile - grp * (8 * NT);
    const int nt = within >> 3, mt = grp * 8 + (within & 7);
    d.m0 = mt * TM; d.n0 = nt * TN;
    d.normal = true;
    if constexpr (Epi::SWAPMODE == 2) d.normal = epi.swap(d.n0);
    const char* Ab = (const char*)A + (size_t)d.m0 * lda * 2;
    const char* Bb = (const char*)Bt + (size_t)d.n0 * ldb * 2;
    const unsigned aoff = (unsigned)(lrow * lda * 2 + lch * 16), boff = (unsigned)(lrow * ldb * 2 + lch * 16);
    d.P = d.normal ? Ab : Bb; d.Q = d.normal ? Bb : Ab;
    d.po = d.normal ? aoff : boff; d.qo = d.normal ? boff : aoff;
    d.ldp = d.normal ? lda : ldb; d.ldq = d.normal ? ldb : lda;
    return d;
  };
  u32x4 pa[4], pb[4];
  auto issue = [&](const TileDesc& d, int kt) {
    const char* Pk = d.P + (size_t)kt * 128; asm volatile("" : "+s"(Pk));
    const char* Qk = d.Q + (size_t)kt * 128; asm volatile("" : "+s"(Qk));
#pragma unroll
    for (int j = 0; j < 4; ++j) pa[j] = *(const u32x4*)(Pk + (size_t)j * 128 * d.ldp + d.po);
#pragma unroll
    for (int j = 0; j < 4; ++j) pb[j] = *(const u32x4*)(Qk + (size_t)j * 128 * d.ldq + d.qo);
  };
  auto write_stage = [&](int b) {
    char* wa = lds + b * STAGE;
    char* wb = wa + TM * 144;
#pragma unroll
    for (int j = 0; j < 4; ++j) *(u32x4*)(wa + (lrow + 64 * j) * 144 + lch * 16) = pa[j];
#pragma unroll
    for (int j = 0; j < 4; ++j) *(u32x4*)(wb + (lrow + 64 * j) * 144 + lch * 16) = pb[j];
  };
  TileDesc cur = desc(0);
  if (!cur.valid) return;
  issue(cur, 0);
  for (int rnd = 0;; ++rnd) {
    f32x16 acc[WMB][WNB];
#pragma unroll
    for (int mb = 0; mb < WMB; ++mb)
#pragma unroll
      for (int nb = 0; nb < WNB; ++nb)
#pragma unroll
        for (int i = 0; i < 16; ++i) acc[mb][nb][i] = 0.f;
    write_stage(0);
    if (nk > 1) issue(cur, 1);
    __syncthreads();
    if (w < 4) {
      for (int kt = 0; kt < nk; ++kt) {
        const char* la = lds + (kt & 1) * STAGE;
        if (kt + 1 < nk) write_stage((kt + 1) & 1);
        if (kt + 2 < nk) issue(cur, kt + 2);
        gemm_compute<true, WMB, WNB>(la, la + TM * 144, acc, wm, wn, r, h);
        __syncthreads();
      }
    } else {
      for (int kt = 0; kt < nk; ++kt) {
        const char* la = lds + (kt & 1) * STAGE;
        gemm_compute<true, WMB, WNB>(la, la + TM * 144, acc, wm, wn, r, h);
        if (kt + 1 < nk) write_stage((kt + 1) & 1);
        if (kt + 2 < nk) issue(cur, kt + 2);
        __syncthreads();
      }
    }
    const TileDesc nxt = desc(rnd + 1);
    if (nxt.valid) issue(nxt, 0);
    __builtin_amdgcn_sched_barrier(0);
    int m0 = cur.m0, n0 = cur.n0;
    asm volatile("" : "+s"(m0), "+s"(n0));
    int r2 = r, h2 = h, wm2 = wm, wn2 = wn;
    asm volatile("" : "+v"(r2), "+v"(h2));
    asm volatile("" : "+s"(wm2), "+s"(wn2));
    if constexpr (Epi::SWAPMODE == 2) {
      if (cur.normal) epi.template store<WMB, WNB>(m0 + wm2 * 32 * WMB, n0 + wn2 * 32 * WNB, acc, r2, h2, true);
      else epi.template store_t<WMB, WNB>(n0 + wm2 * 32 * WMB, m0 + wn2 * 32 * WNB, acc, r2, h2);
    } else {
      epi.template store<WMB, WNB>(m0 + wm2 * 32 * WMB, n0 + wn2 * 32 * WNB, acc, r2, h2, true);
    }
    if (!nxt.valid) break;
    cur = nxt;
  }
}

DI void lds_st16_as2x8(char* dst, const u32x4 v) {
  u32x2 a; a.x = v.x; a.y = v.y; u32x2 b; b.x = v.z; b.y = v.w;
  *(u32x2*)dst = a;
  *(u32x2*)(dst + 8) = b;
}
DI void lds_st_vt(char* row, int ch, const u32x4 v) {
  u32x2 a; a.x = v.x; a.y = v.y; u32x2 b; b.x = v.z; b.y = v.w;
  char* g = row + (ch >> 1) * 32 + (ch & 1) * 8;
  *(u32x2*)g = a;
  *(u32x2*)(g + 16) = b;
}
constexpr int ATT_STAGE = 36864;
constexpr float DEFER_THR = 8.f;

template <int DQK>
DI void qk_scores_acc(const char* kl, const bf16x8 (&qf)[DQK / 16], f32x16 (&s)[2], int r, int h) {
  constexpr int KS = DQK * 2 + 16;
#pragma unroll
  for (int kb = 0; kb < 2; ++kb)
#pragma unroll
    for (int ks = 0; ks < DQK / 16; ++ks) {
      const bf16x8 a = *(const bf16x8*)(kl + (32 * kb + r) * KS + (2 * ks + h) * 16);
      s[kb] = MFMA32(a, qf[ks], s[kb]);
    }
}
template <int DQK>
DI void qk_scores_qlds(const char* kl, const char* qsl, f32x16 (&s)[2], int r, int h) {
  constexpr int KS = DQK * 2 + 16;
#pragma unroll
  for (int kb = 0; kb < 2; ++kb) {
#pragma unroll
    for (int ks = 0; ks < DQK / 16; ++ks) {
      const bf16x8 a = *(const bf16x8*)(kl + (32 * kb + r) * KS + (2 * ks + h) * 16);
      const bf16x8 qv = *(const bf16x8*)(qsl + ks * 1024);
      s[kb] = MFMA32(a, qv, s[kb]);
    }
  }
}
template <int DQK>
DI void qk_scores(const char* kl, const bf16x8 (&qf)[DQK / 16], const f32x16& initv, f32x16 (&s)[2], int r, int h) {
  constexpr int KS = DQK * 2 + 16;
#pragma unroll
  for (int kb = 0; kb < 2; ++kb) {
    s[kb] = initv;
#pragma unroll
    for (int ks = 0; ks < DQK / 16; ++ks) {
      const bf16x8 a = *(const bf16x8*)(kl + (32 * kb + r) * KS + (2 * ks + h) * 16);
      s[kb] = MFMA32(a, qf[ks], s[kb]);
    }
  }
}

template <int DV>
DI float softmax_pv(f32x16 (&s)[2], f32x16 (&o)[DV / 32], float& l, bool first, const char* vl, int r, int h) {
  float dret = 0.f;
  float mx = fmaxf(fmaxf(s[0][0], s[0][1]), s[0][2]);
#pragma unroll
  for (int i = 3; i < 15; i += 2) mx = fmaxf(fmaxf(mx, s[0][i]), s[0][i + 1]);
  mx = fmaxf(fmaxf(mx, s[0][15]), s[1][0]);
#pragma unroll
  for (int i = 1; i < 15; i += 2) mx = fmaxf(fmaxf(mx, s[1][i]), s[1][i + 1]);
  mx = fmaxf(mx, s[1][15]);
  const bool need = first || (mx > DEFER_THR);
  if (__any(need)) {
    mx = fmaxf(mx, __shfl_xor(mx, 32));
    float delta;
    if (first) delta = mx;
    else {
      delta = fmaxf(mx, 0.f);
      const float alpha = fexp2(-delta);
      l *= alpha;
#pragma unroll
      for (int d = 0; d < DV / 32; ++d)
#pragma unroll
        for (int i = 0; i < 16; ++i) o[d][i] *= alpha;
    }
#pragma unroll
    for (int kb = 0; kb < 2; ++kb)
#pragma unroll
      for (int i = 0; i < 16; ++i) s[kb][i] -= delta;
    dret = delta;
  }
  float ps = 0.f;
#pragma unroll
  for (int kb = 0; kb < 2; ++kb)
#pragma unroll
    for (int i = 0; i < 16; ++i) { const float e = fexp2(s[kb][i]); s[kb][i] = e; ps += e; }
  l += ps;
  bf16x8 pf[2][2];
#pragma unroll
  for (int kb = 0; kb < 2; ++kb)
#pragma unroll
    for (int st = 0; st < 2; ++st) {
      u32x4 u;
      u.x = cvt_pk(s[kb][8 * st + 0], s[kb][8 * st + 1]); u.y = cvt_pk(s[kb][8 * st + 2], s[kb][8 * st + 3]);
      u.z = cvt_pk(s[kb][8 * st + 4], s[kb][8 * st + 5]); u.w = cvt_pk(s[kb][8 * st + 6], s[kb][8 * st + 7]);
      pf[kb][st] = __builtin_bit_cast(bf16x8, u);
    }
#pragma unroll
  for (int d = 0; d < DV / 32; ++d)
#pragma unroll
    for (int kb = 0; kb < 2; ++kb)
#pragma unroll
      for (int st = 0; st < 2; ++st) {
        const u32x4 u = *(const u32x4*)(vl + (32 * d + r) * 144 + (2 * kb + st) * 32 + h * 16);
        o[d] = MFMA32(__builtin_bit_cast(bf16x8, u), pf[kb][st], o[d]);
      }
  return dret;
}

template <int DV>
DI float softmax_pre(f32x16 (&s)[2], f32x16 (&o)[DV / 32], float& l, bool first) {
  float dret = 0.f;
  float mx = fmaxf(fmaxf(s[0][0], s[0][1]), s[0][2]);
#pragma unroll
  for (int i = 3; i < 15; i += 2) mx = fmaxf(fmaxf(mx, s[0][i]), s[0][i + 1]);
  mx = fmaxf(fmaxf(mx, s[0][15]), s[1][0]);
#pragma unroll
  for (int i = 1; i < 15; i += 2) mx = fmaxf(fmaxf(mx, s[1][i]), s[1][i + 1]);
  mx = fmaxf(mx, s[1][15]);
  const bool need = first || (mx > DEFER_THR);
  if (__any(need)) {
    mx = fmaxf(mx, __shfl_xor(mx, 32));
    float delta;
    if (first) delta = mx;
    else {
      delta = fmaxf(mx, 0.f);
      const float alpha = fexp2(-delta);
      l *= alpha;
#pragma unroll
      for (int d = 0; d < DV / 32; ++d)
#pragma unroll
        for (int i = 0; i < 16; ++i) o[d][i] *= alpha;
    }
#pragma unroll
    for (int kb = 0; kb < 2; ++kb)
#pragma unroll
      for (int i = 0; i < 16; ++i) s[kb][i] -= delta;
    dret = delta;
  }
  return dret;
}
DI void softmax_exp_half(f32x16& s, float& l, bf16x8 (&pf)[2]) {
  float ps = 0.f;
#pragma unroll
  for (int i = 0; i < 16; ++i) { const float e = fexp2(s[i]); s[i] = e; ps += e; }
  l += ps;
#pragma unroll
  for (int st = 0; st < 2; ++st) {
    u32x4 u;
    u.x = cvt_pk(s[8 * st + 0], s[8 * st + 1]); u.y = cvt_pk(s[8 * st + 2], s[8 * st + 3]);
    u.z = cvt_pk(s[8 * st + 4], s[8 * st + 5]); u.w = cvt_pk(s[8 * st + 6], s[8 * st + 7]);
    pf[st] = __builtin_bit_cast(bf16x8, u);
  }
}
template <int DV>
DI void pv_half(const bf16x8 (&pf)[2], f32x16 (&o)[DV / 32], const char* vl, int kb, int r, int h) {
#pragma unroll
  for (int d = 0; d < DV / 32; ++d)
#pragma unroll
    for (int st = 0; st < 2; ++st) {
      const u32x4 u = *(const u32x4*)(vl + (32 * d + r) * 144 + (2 * kb + st) * 32 + h * 16);
      o[d] = MFMA32(__builtin_bit_cast(bf16x8, u), pf[st], o[d]);
    }
}

template <int ABL>
DI void attn_mla_item(const Ctx& p, int item, char* lds) {
  constexpr int DQK = 96, DV = 64, KS = DQK * 2 + 16;
  const int tid = otid(p), lane = tid & 63, w = tid >> 6, r = lane & 31, h = lane >> 5;
  int head, qb, ts0, S;
  if (item < 1024) { head = item >> 6; qb = item & 63; ts0 = T_PROMPT; S = 16384; }
  else { const int it = item - 1024; qb = it & 15; head = (it >> 4) & 15; ts0 = (it >> 8) * 4096; S = 4096; }
  const u16* q = (const u16*)(p.ws + OFF_R2);
  const u16* knope = q + (size_t)T_TOK * 1536;
  const u16* vt = knope + (size_t)T_TOK * 1024;
  const u16* krope = (const u16*)(p.ws + OFF_KROPE);
  u16* o1 = (u16*)(p.ws + OFF_R1);
  const int tq = ts0 + qb * 256 + w * 32 + r;
  bf16x8 qf[DQK / 16];
#pragma unroll
  for (int ks = 0; ks < DQK / 16; ++ks) qf[ks] = *(const bf16x8*)(q + (size_t)tq * 1536 + head * 96 + 16 * ks + 8 * h);
  f32x16 o[DV / 32];
#pragma unroll
  for (int d = 0; d < DV / 32; ++d)
#pragma unroll
    for (int i = 0; i < 16; ++i) o[d][i] = 0.f;
  f32x16 initv;
#pragma unroll
  for (int i = 0; i < 16; ++i) initv[i] = 0.f;
  float l = 0.f;
  u32x4 pk0, pk1, pv0;
  const int c1 = 512 + tid;
  const int krow0 = tid / 12, kch0 = tid - krow0 * 12;
  const int krow1 = c1 / 12, kch1 = c1 - krow1 * 12;
  const int vrow = tid >> 3, vch = tid & 7;
  const int nkt = S >> 6;
  auto prefetch = [&](int kt) {
    const int tk0 = ts0 + kt * 64;
    {
      const u16* src = kch0 < 8 ? knope + (size_t)(tk0 + krow0) * 1024 + head * 64 + kch0 * 8 : krope + (size_t)(tk0 + krow0) * 32 + (kch0 - 8) * 8;
      pk0 = *(const u32x4*)src;
    }
    if (tid < 256) {
      const u16* src = kch1 < 8 ? knope + (size_t)(tk0 + krow1) * 1024 + head * 64 + kch1 * 8 : krope + (size_t)(tk0 + krow1) * 32 + (kch1 - 8) * 8;
      pk1 = *(const u32x4*)src;
    }
    pv0 = *(const u32x4*)(vt + (size_t)(head * 64 + vrow) * T_TOK + tk0 + vch * 8);
  };
  auto stage_at = [&](int boff) {
    char* kl = lds + boff;
    char* vl = kl + 64 * KS;
    *(u32x4*)(kl + krow0 * KS + kch0 * 16) = pk0;
    if (tid < 256) *(u32x4*)(kl + krow1 * KS + kch1 * 16) = pk1;
    lds_st_vt(vl + vrow * 144, vch, pv0);
  };
  prefetch(0);
  __syncthreads();
  stage_at(0);
  prefetch(1);
  stage_at(ATT_STAGE);
  if (nkt > 2) prefetch(2);
  __syncthreads();
  int cur = 0, nxt = ATT_STAGE, nn = 2 * ATT_STAGE;
  f32x16 s[2];
  qk_scores<DQK>(lds, qf, initv, s, r, h);
#pragma unroll 1
  for (int kt = 0; kt < nkt; ++kt) {
    if (ABL == 2) { __syncthreads(); if (kt + 2 < nkt) stage_at(nn); if (kt + 3 < nkt) prefetch(kt + 3); { const int t = cur; cur = nxt; nxt = nn; nn = t; } continue; }
    const float dl = softmax_pre<DV>(s, o, l, kt == 0);
    if (__any(dl != 0.f)) {
#pragma unroll
      for (int i = 0; i < 16; ++i) initv[i] -= dl;
    }
    f32x16 sn[2];
    qk_scores<DQK>(lds + nxt, qf, initv, sn, r, h);
#pragma unroll
    for (int kb = 0; kb < 2; ++kb) {
      bf16x8 pf[2];
      softmax_exp_half(s[kb], l, pf);
      pv_half<DV>(pf, o, lds + cur + 64 * KS, kb, r, h);
    }
    if (ABL != 1) { if (kt + 2 < nkt) stage_at(nn);
    if (kt + 3 < nkt) prefetch(kt + 3); }
    __syncthreads();
    s[0] = sn[0]; s[1] = sn[1];
    const int t = cur; cur = nxt; nxt = nn; nn = t;
  }
  l += __shfl_xor(l, 32);
  const float inv = 1.f / l;
#pragma unroll
  for (int d = 0; d < DV / 32; ++d) store_tok(o1, 1024, tq, head * 64 + 32 * d + 4 * h, o[d], inv);
}

DI void attn_mla_item2(const Ctx& p, int item, char* lds) {
  constexpr int DQK = 96, DV = 64, KS = DQK * 2 + 16;
  const int tid = otid(p), lane = tid & 63, w = tid >> 6, r = lane & 31, h = lane >> 5;
  int head, qb, ts0, S;
  if (item < 512) { head = item >> 5; qb = item & 31; ts0 = T_PROMPT; S = 16384; }
  else { const int it = item - 512; qb = it & 7; head = (it >> 3) & 15; ts0 = (it >> 7) * 4096; S = 4096; }
  const u16* q = (const u16*)(p.ws + OFF_R2);
  const u16* knope = q + (size_t)T_TOK * 1536;
  const u16* vt = knope + (size_t)T_TOK * 1024;
  const u16* krope = (const u16*)(p.ws + OFF_KROPE);
  u16* o1 = (u16*)(p.ws + OFF_R1);
  const int tq0 = ts0 + qb * 512 + w * 64 + r;
  char* qsl = lds + 49152 + w * 12288 + lane * 16;
  __syncthreads();
  float qn2[2] = {0.f, 0.f};
#pragma unroll
  for (int j = 0; j < 2; ++j)
#pragma unroll
    for (int ks = 0; ks < DQK / 16; ++ks) {
      const u32x4 qv = *(const u32x4*)(q + (size_t)(tq0 + 32 * j) * 1536 + head * 96 + 16 * ks + 8 * h);
      *(u32x4*)(qsl + (j * 6 + ks) * 1024) = qv;
      float a;
      a = bflo(qv.x); qn2[j] += a * a; a = bfhi(qv.x); qn2[j] += a * a; a = bflo(qv.y); qn2[j] += a * a; a = bfhi(qv.y); qn2[j] += a * a;
      a = bflo(qv.z); qn2[j] += a * a; a = bfhi(qv.z); qn2[j] += a * a; a = bflo(qv.w); qn2[j] += a * a; a = bfhi(qv.w); qn2[j] += a * a;
    }
  float ref[2];
  {
    float kn2 = 0.f;
#pragma unroll
    for (int t = 0; t < 8; ++t) { const float v = __uint_as_float(((const unsigned*)(p.ws + OFF_SCAL))[SC_KP + head * 8 + t]); kn2 += v * v; }
    const float kr = __uint_as_float(((const unsigned*)(p.ws + OFF_SCAL))[SC_KRMAX]);
    const float kmaxn = sqrtf(kn2 + kr * kr);
#pragma unroll
    for (int j = 0; j < 2; ++j) {
      qn2[j] += __shfl_xor(qn2[j], 32);
      ref[j] = sqrtf(qn2[j]) * kmaxn * 1.02f + 0.5f;
    }
  }
  const bool fixedref = !__any(ref[0] > 60.f || ref[1] > 60.f);
  f32x16 o[2][DV / 32];
  f32x16 initv[2];
#pragma unroll
  for (int j = 0; j < 2; ++j) {
#pragma unroll
    for (int d = 0; d < DV / 32; ++d)
#pragma unroll
      for (int i = 0; i < 16; ++i) o[j][d][i] = 0.f;
#pragma unroll
    for (int i = 0; i < 16; ++i) initv[j][i] = fixedref ? -ref[j] : 0.f;
  }
  float l[2] = {0.f, 0.f};
  u32x4 pk0, pk1, pv0;
  const int c1 = 512 + (tid & 255);
  const int krow0 = tid / 12, kch0 = tid - krow0 * 12;
  const int krow1 = c1 / 12, kch1 = c1 - krow1 * 12;
  const int vrow = tid >> 3, vch = tid & 7;
  const int nkt = S >> 6;
  auto prefetch = [&](int kt) {
    const int tk0 = ts0 + kt * 64;
    {
      const u16* src = kch0 < 8 ? knope + (size_t)(tk0 + krow0) * 1024 + head * 64 + kch0 * 8 : krope + (size_t)(tk0 + krow0) * 32 + (kch0 - 8) * 8;
      pk0 = *(const u32x4*)src;
    }
    {
      const u16* src = kch1 < 8 ? knope + (size_t)(tk0 + krow1) * 1024 + head * 64 + kch1 * 8 : krope + (size_t)(tk0 + krow1) * 32 + (kch1 - 8) * 8;
      pk1 = *(const u32x4*)src;
    }
    pv0 = *(const u32x4*)(vt + (size_t)(head * 64 + vrow) * T_TOK + tk0 + vch * 8);
  };
  auto stage_at = [&](int boff) {
    char* kl = lds + boff;
    char* vl = kl + 64 * KS;
    *(u32x4*)(kl + krow0 * KS + kch0 * 16) = pk0;
    *(u32x4*)(kl + krow1 * KS + kch1 * 16) = pk1;
    lds_st_vt(vl + vrow * 144, vch, pv0);
  };
  prefetch(0);
  stage_at(0);
  prefetch(1);
  __syncthreads();
#pragma unroll 1
  for (int kt = 0; kt < nkt; ++kt) {
    const char* kl = lds + (kt & 1) * 24576;
    const char* vl = kl + 64 * KS;
    if (kt + 1 < nkt) stage_at(((kt + 1) & 1) * 24576);
    if (kt + 2 < nkt) prefetch(kt + 2);
    f32x16 s[2][2];
#pragma unroll
    for (int kb = 0; kb < 2; ++kb) {
      s[0][kb] = initv[0]; s[1][kb] = initv[1];
#pragma unroll
      for (int ks = 0; ks < DQK / 16; ++ks) {
        const bf16x8 a = *(const bf16x8*)(kl + (32 * kb + r) * KS + (2 * ks + h) * 16);
        const bf16x8 q0 = *(const bf16x8*)(qsl + ks * 1024);
        const bf16x8 q1 = *(const bf16x8*)(qsl + (6 + ks) * 1024);
        s[0][kb] = MFMA32(a, q0, s[0][kb]);
        s[1][kb] = MFMA32(a, q1, s[1][kb]);
      }
    }
    if (!fixedref) {
#pragma unroll
      for (int j = 0; j < 2; ++j) {
        const float dl = softmax_pre<DV>(s[j], o[j], l[j], kt == 0);
        if (__any(dl != 0.f)) {
#pragma unroll
          for (int i = 0; i < 16; ++i) initv[j][i] -= dl;
        }
      }
    }
#pragma unroll
    for (int kb = 0; kb < 2; ++kb) {
      bf16x8 pf0[2], pf1[2];
      softmax_exp_half(s[0][kb], l[0], pf0);
      softmax_exp_half(s[1][kb], l[1], pf1);
#pragma unroll
      for (int d = 0; d < DV / 32; ++d)
#pragma unroll
        for (int st = 0; st < 2; ++st) {
          const u32x4 u = *(const u32x4*)(vl + (32 * d + r) * 144 + (2 * kb + st) * 32 + h * 16);
          const bf16x8 vf = __builtin_bit_cast(bf16x8, u);
          o[0][d] = MFMA32(vf, pf0[st], o[0][d]);
          o[1][d] = MFMA32(vf, pf1[st], o[1][d]);
        }
    }
    __syncthreads();
  }
  int tid2 = otid(p);
  const int lane2 = tid2 & 63, h2 = lane2 >> 5, w2 = tid2 >> 6;
  int item2 = item; asm volatile("" : "+s"(item2));
  int head2, tq2;
  if (item2 < 512) { head2 = item2 >> 5; tq2 = T_PROMPT + (item2 & 31) * 512 + w2 * 64 + (lane2 & 31); }
  else { const int it = item2 - 512; head2 = (it >> 3) & 15; tq2 = (it >> 7) * 4096 + (it & 7) * 512 + w2 * 64 + (lane2 & 31); }
#pragma unroll
  for (int j = 0; j < 2; ++j) {
    float lj = l[j];
    lj += __shfl_xor(lj, 32);
    const float inv = __builtin_amdgcn_rcpf(lj);
#pragma unroll
    for (int d = 0; d < DV / 32; ++d) store_tok(o1, 1024, tq2 + 32 * j, head2 * 64 + 32 * d + 4 * h2, o[j][d], inv);
  }
}

DI void diff_decode(int item, int& hh, int& qb, int& ts0, int& S) {
  int j;
  if (item < 128) { hh = 3; j = item; S = 16384; }
  else if (item < 256) { hh = 2; j = item - 128; S = 16384; }
  else if (item < 768) { hh = 3; j = item - 256; S = 4096; }
  else if (item < 1280) { hh = 2; j = item - 768; S = 4096; }
  else if (item < 1408) { hh = 1; j = item - 1280; S = 16384; }
  else if (item < 1920) { hh = 1; j = item - 1408; S = 4096; }
  else if (item < 2048) { hh = 0; j = item - 1920; S = 16384; }
  else { hh = 0; j = item - 2048; S = 4096; }
  if (S == 16384) { qb = j; ts0 = T_PROMPT; } else { qb = j & 31; ts0 = (j >> 5) * 4096; }
}
DI void attn_diff_item(const Ctx& p, int item, char* lds) {
  constexpr int DQK = 64, DV = 128, KS = DQK * 2 + 16;
  const int tid = otid(p), lane = tid & 63, w = tid >> 6, r = lane & 31, h = lane >> 5;
  const int map = w >> 2, qw = w & 3;
  int hh, qb, ts0, S;
  diff_decode(item, hh, qb, ts0, S);
  const u16* base = (const u16*)(p.ws + OFF_R2);
  const u16* dq = base + 2 * SEG512;
  const u16* dk = base + 3 * SEG512;
  const u16* vtd = base + 5 * SEG512;
  u16* o0 = (u16*)(p.ws + OFF_R1);
  const int qpos = qb * 128 + qw * 32 + r;
  const int tq = ts0 + qpos;
  __syncthreads();
  float qn2 = 0.f;
  bf16x8 qf[DQK / 16];
#pragma unroll
  for (int ks = 0; ks < DQK / 16; ++ks) {
    const u32x4 qv = *(const u32x4*)(dq + (size_t)tq * 512 + (2 * hh + map) * 64 + 16 * ks + 8 * h);
    qf[ks] = __builtin_bit_cast(bf16x8, qv);
    float a;
    a = bflo(qv.x); qn2 += a * a; a = bfhi(qv.x); qn2 += a * a; a = bflo(qv.y); qn2 += a * a; a = bfhi(qv.y); qn2 += a * a;
    a = bflo(qv.z); qn2 += a * a; a = bfhi(qv.z); qn2 += a * a; a = bflo(qv.w); qn2 += a * a; a = bfhi(qv.w); qn2 += a * a;
  }
  qn2 += __shfl_xor(qn2, 32);
  f32x16 o[DV / 32];
#pragma unroll
  for (int d = 0; d < DV / 32; ++d)
#pragma unroll
    for (int i = 0; i < 16; ++i) o[d][i] = 0.f;
  float l = 0.f;
  const float refb = sqrtf(qn2) * __uint_as_float(((const unsigned*)(p.ws + OFF_SCAL))[SC_QKMAX + 8 + 2 * hh + map]) * 1.02f + 0.5f;
  const bool fixedref = !__any(refb > 60.f);
  float ref = fixedref ? refb : 0.f;
  const float slope2 = exp2f(-2.f * (float)(hh + 1)) * LOG2E;
  const float cq = slope2 * (float)qpos;
  const int d0 = 2 * qb;
  const int kd = d0 + (qw >> 1);
  int kt_lo, kt_hi;
  {
    const unsigned* qk = (const unsigned*)(p.ws + OFF_SCAL) + SC_QKMAX;
    const float b0 = __uint_as_float(qk[2 * hh]) * __uint_as_float(qk[8 + 2 * hh]);
    const float b1 = __uint_as_float(qk[2 * hh + 1]) * __uint_as_float(qk[8 + 2 * hh + 1]);
    const float B = fmaxf(b0, b1) * 1.02f + 0.5f;
    const float dskip = fminf((2.f * B + 34.f) / slope2 + 1.f, 1.0e6f);
    const int q_lo = qb * 128, q_hi = q_lo + 127, ds = (int)dskip;
    kt_lo = max(0, (q_lo - 63 - ds) >> 6);
    kt_hi = min((S >> 6) - 1, (q_hi + ds) >> 6);
    kt_lo = min(kt_lo, 2 * qb); kt_hi = max(kt_hi, 2 * qb + 1);
  }
  const int nleft = d0 - kt_lo;
  const int nkt = kt_hi - kt_lo + 1;
  u32x4 pk[2], pv[2];
  const int lrow = tid >> 3, lch = tid & 7;
  auto tile_of = [&](int idx) { return idx < 2 ? d0 + idx : (idx - 2 < nleft ? d0 - 1 - (idx - 2) : idx + kt_lo); };
  const unsigned koff = (unsigned)(((ts0 + lrow) * 512 + 2 * hh * 64 + lch * 8) * 2);
  const unsigned voff = (unsigned)((((hh * 128 + lrow) * T_TOK) + ts0 + lch * 8) * 2);
  const char* dkb = (const char*)dk;
  const char* vtb = (const char*)vtd;
  auto prefetch = [&](int kt) {
    const unsigned ko = koff + (unsigned)kt * (64u * 512u * 2u);
    const unsigned vo = voff + (unsigned)kt * 128u;
    pk[0] = *(const u32x4*)(dkb + ko);
    pk[1] = *(const u32x4*)(dkb + ko + 128u);
    pv[0] = *(const u32x4*)(vtb + vo);
    pv[1] = *(const u32x4*)(vtb + vo + (unsigned)(64 * T_TOK * 2));
  };
  auto stage_at = [&](int boff) {
    char* kl0 = lds + boff;
    char* vl = kl0 + 2 * 64 * KS;
#pragma unroll
    for (int j = 0; j < 2; ++j) *(u32x4*)(kl0 + j * 64 * KS + lrow * KS + lch * 16) = pk[j];
#pragma unroll
    for (int j = 0; j < 2; ++j) lds_st_vt(vl + (lrow + 64 * j) * 144, lch, pv[j]);
  };
  auto scores = [&](int kt, int boff, f32x16 (&sc)[2]) {
    const int side = kt < kd ? -1 : (kt > kd ? 1 : 0);
    const float I = (float)side * cq - ref;
    const unsigned i_hi = cvt_pk(I, 0.f) & 0xffffu;
    const float ir1 = I - __uint_as_float(i_hi << 16);
    const unsigned i_mid = cvt_pk(ir1, 0.f) & 0xffffu;
    const float ir2 = ir1 - __uint_as_float(i_mid << 16);
    const unsigned i_lo = cvt_pk(ir2, 0.f) & 0xffffu;
    const float T = slope2 * (float)(kt * 64);
    const unsigned t_hi = cvt_pk(T, 0.f) & 0xffffu;
    const float r1 = T - __uint_as_float(t_hi << 16);
    const unsigned t_mid = cvt_pk(r1, 0.f) & 0xffffu;
    const float r2 = r1 - __uint_as_float(t_mid << 16);
    const unsigned t_lo = cvt_pk(r2, 0.f) & 0xffffu;
    const unsigned one = side < 0 ? 0x3F80u : (side > 0 ? 0xBF80u : 0u);
    u32x4 qa;
    qa.x = h == 0 ? (one | (one << 16)) : 0u; qa.y = qa.x; qa.z = h == 0 ? (one | (i_hi << 16)) : 0u; qa.w = h == 0 ? (i_mid | (i_lo << 16)) : 0u;
    const bf16x8 qaug = __builtin_bit_cast(bf16x8, qa);
#pragma unroll
    for (int kb = 0; kb < 2; ++kb) {
      const float xl = slope2 * (float)(32 * kb + r);
      const unsigned l_hi = cvt_pk(xl, 0.f) & 0xffffu;
      const unsigned l_lo = cvt_pk(xl - __uint_as_float(l_hi << 16), 0.f) & 0xffffu;
      u32x4 ka; ka.x = h == 0 ? (l_hi | (l_lo << 16)) : 0u; ka.y = h == 0 ? (t_hi | (t_mid << 16)) : 0u; ka.z = h == 0 ? (t_lo | 0x3F800000u) : 0u; ka.w = h == 0 ? 0x3F803F80u : 0u;
      f32x16 z;
#pragma unroll
      for (int i = 0; i < 16; ++i) z[i] = 0.f;
      sc[kb] = MFMA32(__builtin_bit_cast(bf16x8, ka), qaug, z);
    }
    qk_scores_acc<DQK>(lds + boff + map * 64 * KS, qf, sc, r, h);
  };
  prefetch(tile_of(0));
  __syncthreads();
  stage_at(0);
  prefetch(tile_of(1));
  __syncthreads();
#pragma unroll 1
  for (int idx = 0; idx < nkt; ++idx) {
    const int kt = tile_of(idx);
    const int cur = (idx & 1) * ATT_STAGE;
    if (idx + 1 < nkt) stage_at(((idx + 1) & 1) * ATT_STAGE);
    if (idx + 2 < nkt) prefetch(tile_of(idx + 2));
    f32x16 s[2];
    scores(kt, cur, s);
    if (kt == kd) {
#pragma unroll
      for (int kb = 0; kb < 2; ++kb)
#pragma unroll
        for (int i = 0; i < 16; ++i) {
          const int kp = kt * 64 + 32 * kb + (i & 3) + 8 * (i >> 2) + 4 * h;
          s[kb][i] -= slope2 * fabsf((float)(qpos - kp));
        }
    }
    if (!fixedref) ref += softmax_pre<DV>(s, o, l, idx == 0);
#pragma unroll
    for (int kb = 0; kb < 2; ++kb) {
      bf16x8 pf[2];
      softmax_exp_half(s[kb], l, pf);
      pv_half<DV>(pf, o, lds + cur + 2 * 64 * KS, kb, r, h);
    }
    __syncthreads();
  }
  l += __shfl_xor(l, 32);
  const float inv = 1.f / l;
  int tid2 = otid(p);
  const int lane2 = tid2 & 63, qw2 = (tid2 >> 6) & 3, h2 = lane2 >> 5;
  int item2 = item; asm volatile("" : "+s"(item2));
  int hh2, tq2;
  { int qb2, ts02, S2; diff_decode(item2, hh2, qb2, ts02, S2); tq2 = ts02 + qb2 * 128 + qw2 * 32 + (lane2 & 31); }
  float* ex = (float*)lds + qw2 * 4096;
  if (map == 1) {
#pragma unroll
    for (int d = 0; d < DV / 32; ++d)
#pragma unroll
      for (int i = 0; i < 16; ++i) ex[(d * 16 + i) * 64 + lane2] = o[d][i] * inv;
  }
  __syncthreads();
  if (map == 0) {
    const float lam = ((const float*)(p.ws + OFF_SCAL))[0];
    float ss = 0.f;
#pragma unroll
    for (int d = 0; d < DV / 32; ++d)
#pragma unroll
      for (int i = 0; i < 16; ++i) { const float v = o[d][i] * inv - lam * ex[(d * 16 + i) * 64 + lane2]; o[d][i] = v; ss += v * v; }
    ss += __shfl_xor(ss, 32);
    const float rn = rsqrtf(ss * (1.f / 128.f) + EPS) * 0.8f;
    const float* gs = (const float*)(p.ws + OFF_SCAL) + SC_GSUB;
#pragma unroll
    for (int d = 0; d < DV / 32; ++d) {
#pragma unroll
      for (int g = 0; g < 4; ++g) {
        const float4 gv = *(const float4*)(gs + 32 * d + 8 * g + 4 * h2);
        o[d][4 * g] *= gv.x; o[d][4 * g + 1] *= gv.y; o[d][4 * g + 2] *= gv.z; o[d][4 * g + 3] *= gv.w;
      }
      store_tok(o0, 1024, tq2, 512 + hh2 * 128 + 32 * d + 4 * h2, o[d], rn);
    }
  }
}

DI void attn_na_item(const Ctx& p, int item, char* lds) {
  constexpr int DQK = 64, DV = 64, KS = DQK * 2 + 16;
  const int tid = otid(p), lane = tid & 63, w = tid >> 6, r = lane & 31, h = lane >> 5;
  const int quad = item % 320, head = item / 320;
  const int t0 = quad * 256;
  int ts0, rows;
  if (t0 < T_PROMPT) { ts0 = t0 & ~4095; rows = 64; } else { ts0 = T_PROMPT; rows = 256; }
  const int r0 = (t0 - ts0) >> 6;
  const int rw = r0 + (w >> 1);
  const int rs_lo = min(max(r0 - 4, 0), rows - 8);
  const int rs_hi = min(max(r0 + 3 - 4, 0), rows - 8);
  const int rs_w = min(max(rw - 4, 0), rows - 8);
  const int ntile = rs_hi + 8 - rs_lo;
  const u16* base = (const u16*)(p.ws + OFF_R2);
  const u16* qn = base;
  const u16* kn = base + SEG512;
  const u16* vtn = base + 4 * SEG512;
  u16* o0 = (u16*)(p.ws + OFF_R1);
  float* tab = (float*)(lds + 2 * ATT_STAGE) + 64;
  const int qc = (w & 1) * 32 + r;
  const int tq = t0 + w * 32 + r;
  bf16x8 qf[DQK / 16];
#pragma unroll
  for (int ks = 0; ks < DQK / 16; ++ks) qf[ks] = *(const bf16x8*)(qn + (size_t)tq * 512 + head * 64 + 16 * ks + 8 * h);
  f32x16 o[DV / 32];
#pragma unroll
  for (int d = 0; d < DV / 32; ++d)
#pragma unroll
    for (int i = 0; i < 16; ++i) o[d][i] = 0.f;
  f32x16 initv;
#pragma unroll
  for (int i = 0; i < 16; ++i) initv[i] = 0.f;
  float l = 0.f;
  bool first = true;
  u32x4 pk0, pv0;
  const int lrow = tid >> 3, lch = tid & 7;
  auto prefetch = [&](int j) {
    const int tk0 = ts0 + (rs_lo + j) * 64;
    pk0 = *(const u32x4*)(kn + (size_t)(tk0 + lrow) * 512 + head * 64 + lch * 8);
    pv0 = *(const u32x4*)(vtn + (size_t)(head * 64 + lrow) * T_TOK + tk0 + lch * 8);
  };
  auto stage = [&](int b) {
    char* kl = lds + b * ATT_STAGE;
    char* vl = kl + 64 * KS;
    *(u32x4*)(kl + lrow * KS + lch * 16) = pk0;
    lds_st_vt(vl + lrow * 144, lch, pv0);
  };
  prefetch(0);
  __syncthreads();
  if (tid < 465) tab[tid] = ((const float*)(p.ws + OFF_SCAL))[SC_RPB + head * 465 + tid];
  stage(0);
  prefetch(1);
  __syncthreads();
  const int wc0 = min(max(qc - 8, 0), 48);
  const float* tabq = tab + (15 - qc + 4 * h);
  for (int j = 0; j < ntile; ++j) {
    const char* kl = lds + (j & 1) * ATT_STAGE;
    const char* vl = kl + 64 * KS;
    const int kr = rs_lo + j;
    if (kr >= rs_w && kr < rs_w + 8) {
      f32x16 s[2];
      qk_scores<DQK>(kl, qf, initv, s, r, h);
      const int ridx = kr - rw + 7;
#pragma unroll
      for (int kb = 0; kb < 2; ++kb)
#pragma unroll
        for (int i = 0; i < 16; ++i) {
          const int kc = 32 * kb + (i & 3) + 8 * (i >> 2) + 4 * h;
          const bool ok = (unsigned)(kc - wc0) < 16u;
          float b = tabq[ridx * 31 + 32 * kb + (i & 3) + 8 * (i >> 2)];
          asm volatile("" : "+v"(b));
          s[kb][i] = ok ? s[kb][i] + b : -INFINITY;
        }
      {
        const float dl = softmax_pv<DV>(s, o, l, first, vl, r, h);
        if (__any(dl != 0.f)) {
#pragma unroll
          for (int i = 0; i < 16; ++i) initv[i] -= dl;
        }
      }
      first = false;
    }
    if (j + 1 < ntile) stage((j + 1) & 1);
    if (j + 2 < ntile) prefetch(j + 2);
    __syncthreads();
  }
  l += __shfl_xor(l, 32);
  const float inv = 1.f / l;
#pragma unroll
  for (int d = 0; d < DV / 32; ++d) store_tok(o0, 1024, tq, head * 64 + 32 * d + 4 * h, o[d], inv);
}

DI void phase_qk_norms(const Ctx& p) {
  const int tid_ = otid(p);
  const int lane = tid_ & 63;
  const int gw = obid() * 8 + (tid_ >> 6), nw = gridDim.x * 8;
  const u16* dq = (const u16*)(p.ws + OFF_R2) + 2 * SEG512;
  const u16* dk = (const u16*)(p.ws + OFF_R2) + 3 * SEG512;
  float mq = 0.f, mk = 0.f;
  for (int row = gw; row < T_TOK; row += nw) {
    const uint4 a = ((const uint4*)(dq + (size_t)row * 512))[lane];
    const uint4 b = ((const uint4*)(dk + (size_t)row * 512))[lane];
    float sa = 0.f, sb = 0.f, t;
    t = bflo(a.x); sa += t * t; t = bfhi(a.x); sa += t * t; t = bflo(a.y); sa += t * t; t = bfhi(a.y); sa += t * t;
    t = bflo(a.z); sa += t * t; t = bfhi(a.z); sa += t * t; t = bflo(a.w); sa += t * t; t = bfhi(a.w); sa += t * t;
    t = bflo(b.x); sb += t * t; t = bfhi(b.x); sb += t * t; t = bflo(b.y); sb += t * t; t = bfhi(b.y); sb += t * t;
    t = bflo(b.z); sb += t * t; t = bfhi(b.z); sb += t * t; t = bflo(b.w); sb += t * t; t = bfhi(b.w); sb += t * t;
#pragma unroll
    for (int o = 1; o < 8; o <<= 1) { sa += __shfl_xor(sa, o); sb += __shfl_xor(sb, o); }
    mq = fmaxf(mq, sa); mk = fmaxf(mk, sb);
  }
  if ((lane & 7) == 0) {
    unsigned* qk = (unsigned*)(p.ws + OFF_SCAL) + SC_QKMAX;
    atomicMax(qk + (lane >> 3), __float_as_uint(sqrtf(mq)));
    atomicMax(qk + 8 + (lane >> 3), __float_as_uint(sqrtf(mk)));
  }
}

namespace pg8 {
#define PG8_LAS __attribute__((address_space(3)))
typedef unsigned short bf16_t;
typedef short bf16x8 __attribute__((ext_vector_type(8)));
typedef float f32x4 __attribute__((ext_vector_type(4)));
typedef unsigned u32x4 __attribute__((ext_vector_type(4)));
constexpr int BM = 256, BK = 64, HALF = 128, HTB = HALF * BK * 2  , STAGE_BYTES = 8 * HTB, NXCD = 8, WGM = 8;

__host__ __device__ __forceinline__ int lds_byte(int r, int c) { const int st = (r >> 4) * 2 + (c >> 5), rr = r & 15, cc = c & 31, ob = rr * 64 + cc * 2; return st * 1024 + (ob ^ (((ob >> 9) & 1) << 5)); }
__host__ __device__ __forceinline__ void stage_rc(int b, int& R, int& C) { const int st = b / 1024, sb = b % 1024, swz = sb ^ (((sb >> 9) & 1) << 5); R = (st >> 1) * 16 + swz / 64; C = (st & 1) * 32 + (swz % 64) / 2; }
__host__ __device__ __forceinline__ int perm32(int rho) { const int n = rho >> 4, i = rho & 15; return 8 * (i >> 2) + 4 * n + (i & 3); }

struct Unit { int pm, pn; };
struct Gemm { const bf16_t* A; const bf16_t* Bt; int M, N, K; int lda, ldb; };

struct StaticOrder {
    int nM, nN, nwg, G, c;
    __host__ __device__ void init(int M, int N, int G_, int c_) { nM = M / BM; nN = N / BM; nwg = nM * nN; G = G_; c = c_; }
    __host__ __device__ bool next(int i, Unit& u) const {
        const long L = (long)i * G + c; if (L >= nwg) return false;
        int wgid = (int)L; { const int q = nwg / NXCD, r = nwg % NXCD, xcd = wgid % NXCD, off = wgid / NXCD; wgid = (xcd < r ? xcd * (q + 1) : r * (q + 1) + (xcd - r) * q) + off; }
        const int nig = WGM * nN, gid = wgid / nig, fm = gid * WGM, gsz = (nM - fm) < WGM ? (nM - fm) : WGM;
        u.pm = fm + ((wgid % nig) % gsz); u.pn = (wgid % nig) / gsz; return true;
    }
    __device__ __forceinline__ void a_ready(const Unit&) const {}
    __device__ __forceinline__ void done(const Unit&) const {}
};
struct CountedOrder : StaticOrder {
    const unsigned* ready; unsigned need; unsigned* tmo;
    __device__ __forceinline__ void a_ready(const Unit& u) const {
        if (threadIdx.x < 64) {
            const unsigned long long t0 = __builtin_amdgcn_s_memrealtime(); unsigned polls = 0;
            while ((unsigned)__builtin_amdgcn_readfirstlane(__hip_atomic_load(ready + 64 * u.pm, __ATOMIC_RELAXED, __HIP_MEMORY_SCOPE_AGENT)) < need) {
                if ((++polls & 255u) == 0u && __builtin_amdgcn_readfirstlane(__hip_atomic_load(tmo, __ATOMIC_RELAXED, __HIP_MEMORY_SCOPE_AGENT)) != 0u) break;
                if (__builtin_amdgcn_s_memrealtime() - t0 > 2000000ull) {
                    if (threadIdx.x == 0) { unsigned expect = 0u; __hip_atomic_compare_exchange_strong(tmo + 1, &expect, 0x600u | (unsigned)(u.pm & 0xff), __ATOMIC_RELAXED, __ATOMIC_RELAXED, __HIP_MEMORY_SCOPE_AGENT); __hip_atomic_store(tmo, 1u, __ATOMIC_RELAXED, __HIP_MEMORY_SCOPE_AGENT); }
                    break; }
                __builtin_amdgcn_s_sleep(2); }
            __builtin_amdgcn_fence(__ATOMIC_ACQUIRE, "agent");
            asm volatile("s_waitcnt vmcnt(0)" ::: "memory");
        }
#if !defined(BROKEN_HOOK_NO_BARRIER)
        asm volatile("" ::: "memory"); __builtin_amdgcn_s_barrier(); asm volatile("" ::: "memory");
#endif
    }
};

__device__ __forceinline__ unsigned cvt_pk_bf16(float lo, float hi) { unsigned r; asm volatile("v_cvt_pk_bf16_f32 %0, %1, %2" : "=v"(r) : "v"(lo), "v"(hi)); return r; }
typedef float f32x2 __attribute__((ext_vector_type(2)));
__device__ __forceinline__ f32x2 gelu_pk(f32x2 v) {
    const f32x2 av = __builtin_elementwise_abs(v), d = av * 0.2316418882f + 1.0f;
    f32x2 t; t.x = __builtin_amdgcn_rcpf(d.x); t.y = __builtin_amdgcn_rcpf(d.y);
    f32x2 q = t * 0.5307027145f + (-0.7265760135f); q = q * t + 0.7107068705f; q = q * t + (-0.142248368f); q = q * t + 0.127414796f; q = q * t;
    const f32x2 s = (v * v) * (-0.72134752044f);
    f32x2 e; e.x = __builtin_amdgcn_exp2f(s.x); e.y = __builtin_amdgcn_exp2f(s.y);
    const f32x2 m = v * (q * e), r = v - m;
    f32x2 o; o.x = v.x < 0.f ? m.x : r.x; o.y = v.y < 0.f ? m.y : r.y; return o;
}

struct EpiF32 {
    static constexpr bool PERM = false, AFTER_DRAIN = false;
    float* C; int ldc; const float* bias;
    __device__ __forceinline__ void operator()(const f32x4 (&acc)[2][2][4][2], const Unit& u, int wr, int wc, int fr, int fq) const {
        const int row0 = u.pm * BM + wr * 64 + fr, col0 = u.pn * BM + wc * 32 + 4 * fq;
        f32x4 bv[2][2];
#pragma unroll
        for (int bj = 0; bj < 2; ++bj)
#pragma unroll
            for (int n = 0; n < 2; ++n) bv[bj][n] = bias ? *(const f32x4*)(bias + col0 + bj * HALF + n * 16) : (f32x4){0.f, 0.f, 0.f, 0.f};
#pragma unroll
        for (int ai = 0; ai < 2; ++ai)
#pragma unroll
            for (int m = 0; m < 4; ++m) { float* rowp = C + (size_t)(row0 + ai * HALF + m * 16) * ldc + col0;
#pragma unroll
                for (int bj = 0; bj < 2; ++bj)
#pragma unroll
                    for (int n = 0; n < 2; ++n) *(f32x4*)(rowp + bj * HALF + n * 16) = acc[ai][bj][m][n] + bv[bj][n]; }
    }
};
template <int ACT  > struct EpiBf16 {
    static constexpr bool PERM = true, AFTER_DRAIN = false;
    bf16_t* O; int ldc; const float* bias; int split_cols; size_t split_stride;
    __device__ __forceinline__ void operator()(const f32x4 (&acc)[2][2][4][2], const Unit& u, int wr, int wc, int fr, int fq) const {
        const int row0 = u.pm * BM + wr * 64 + fr; int colt = u.pn * BM; bf16_t* base = O;
        if (split_cols) { const int t = colt / split_cols; base += (size_t)t * split_stride; colt -= t * split_cols; }
        const int col0 = colt + wc * 32 + 8 * fq, bcol0 = u.pn * BM + wc * 32 + 8 * fq;
        f32x4 bv[2][2];
#pragma unroll
        for (int bj = 0; bj < 2; ++bj)
#pragma unroll
            for (int n = 0; n < 2; ++n) bv[bj][n] = bias ? *(const f32x4*)(bias + bcol0 + bj * HALF + 4 * n) : (f32x4){0.f, 0.f, 0.f, 0.f};
#pragma unroll
        for (int ai = 0; ai < 2; ++ai)
#pragma unroll
            for (int m = 0; m < 4; ++m) { bf16_t* rowp = base + (size_t)(row0 + ai * HALF + m * 16) * ldc + col0;
#pragma unroll
                for (int bj = 0; bj < 2; ++bj) { f32x4 v0 = acc[ai][bj][m][0] + bv[bj][0], v1 = acc[ai][bj][m][1] + bv[bj][1];
                    if (ACT == 1) { f32x2 a = gelu_pk((f32x2){v0[0], v0[1]}), b = gelu_pk((f32x2){v0[2], v0[3]}), c = gelu_pk((f32x2){v1[0], v1[1]}), d = gelu_pk((f32x2){v1[2], v1[3]});
                        v0 = (f32x4){a.x, a.y, b.x, b.y}; v1 = (f32x4){c.x, c.y, d.x, d.y}; }
                    if (ACT == 2) {
#pragma unroll
                        for (int j = 0; j < 4; ++j) { v0[j] = 0.5f * v0[j] * (1.0f + erff(v0[j] * 0.70710678f)); v1[j] = 0.5f * v1[j] * (1.0f + erff(v1[j] * 0.70710678f)); } }
                    u32x4 w; w.x = cvt_pk_bf16(v0[0], v0[1]); w.y = cvt_pk_bf16(v0[2], v0[3]); w.z = cvt_pk_bf16(v1[0], v1[1]); w.w = cvt_pk_bf16(v1[2], v1[3]);
                    *(u32x4*)(rowp + bj * HALF) = w; } }
    }
};

struct PanelStats {
    unsigned* xbuf;
    unsigned* cnt;
    unsigned* tmo;
    int ntn; float eps;
    unsigned code;
    __device__ __forceinline__ bool run(const f32x4 (&v)[2][2][4][2], const Unit& u, int wr, int wc, int fr, int fq, PG8_LAS unsigned char* lds, int wid, int lane) const {
        typedef float f32x2v __attribute__((ext_vector_type(2)));
        PG8_LAS f32x2v* P = (PG8_LAS f32x2v*)lds;
        PG8_LAS f32x2v* S = (PG8_LAS f32x2v*)(lds + 8192);
        PG8_LAS unsigned* flag = (PG8_LAS unsigned*)(lds + 8192 + 2048);
#pragma unroll
        for (int ai = 0; ai < 2; ++ai)
#pragma unroll
            for (int m = 0; m < 4; ++m) {
                float s = 0.f;
#pragma unroll
                for (int bj = 0; bj < 2; ++bj)
#pragma unroll
                    for (int n = 0; n < 2; ++n) { const f32x4 x = v[ai][bj][m][n]; s += (x[0] + x[1]) + (x[2] + x[3]); }
                s += __shfl_xor(s, 16); s += __shfl_xor(s, 32);
                const float mw = s * (1.0f / 64.0f); float q = 0.f;
#pragma unroll
                for (int bj = 0; bj < 2; ++bj)
#pragma unroll
                    for (int n = 0; n < 2; ++n) { const f32x4 d = v[ai][bj][m][n] - mw; q += (d[0] * d[0] + d[1] * d[1]) + (d[2] * d[2] + d[3] * d[3]); }
                q += __shfl_xor(q, 16); q += __shfl_xor(q, 32);
                if (fq == 0) P[(ai * HALF + wr * 64 + m * 16 + fr) * 4 + wc] = (f32x2v){mw, q};
            }
        asm volatile("s_waitcnt lgkmcnt(0)" ::: "memory"); __builtin_amdgcn_s_barrier(); asm volatile("" ::: "memory");
#if defined(BROKEN_NO_WAIT)
        if (blockIdx.x >= 64) { const long long t0 = clock64(); while (clock64() - t0 < 60000) __builtin_amdgcn_s_sleep(8); }
#endif
        const int row = wid * 32 + (lane & 31);
        if (lane < 32) {
            const f32x2v a = P[row * 4 + 0], b = P[row * 4 + 1], c = P[row * 4 + 2], d = P[row * 4 + 3];
            const float mt = (a.x + b.x + c.x + d.x) * 0.25f;
            const float da = a.x - mt, db = b.x - mt, dc = c.x - mt, dd = d.x - mt;
            const float m2 = (a.y + b.y) + (c.y + d.y) + 64.0f * ((da * da + db * db) + (dc * dc + dd * dd));
            unsigned long long* slot = (unsigned long long*)xbuf + ((size_t)(u.pm * BM + row) * 4 + u.pn);
            __hip_atomic_store(slot, ((unsigned long long)__float_as_uint(m2) << 32) | __float_as_uint(mt), __ATOMIC_RELAXED, __HIP_MEMORY_SCOPE_AGENT);
        }
        asm volatile("s_waitcnt vmcnt(0)" ::: "memory");
        if (lane == 0) __hip_atomic_fetch_add(cnt + 64 * u.pm, 1u, __ATOMIC_RELAXED, __HIP_MEMORY_SCOPE_AGENT);
        if (wid == 0) {
            bool dead = false; const unsigned long long t0 = __builtin_amdgcn_s_memrealtime(); const unsigned want = 8u * (unsigned)ntn;
            for (;;) {
#if defined(BROKEN_NO_WAIT)
                break;
#endif
                if ((unsigned)__builtin_amdgcn_readfirstlane(__hip_atomic_load(cnt + 64 * u.pm, __ATOMIC_RELAXED, __HIP_MEMORY_SCOPE_AGENT)) >= want) break;
                if (__builtin_amdgcn_s_memrealtime() - t0 > 2000000ull) {
                    if (lane == 0) { unsigned expect = 0u; __hip_atomic_compare_exchange_strong(tmo + 1, &expect, code | (unsigned)(u.pm & 0xff), __ATOMIC_RELAXED, __ATOMIC_RELAXED, __HIP_MEMORY_SCOPE_AGENT);
                                     __hip_atomic_store(tmo, 1u, __ATOMIC_RELAXED, __HIP_MEMORY_SCOPE_AGENT); }
                    dead = true; break; }
                __builtin_amdgcn_s_sleep(2);
            }
            __builtin_amdgcn_fence(__ATOMIC_ACQUIRE, "agent");
            if (lane == 0) flag[0] = dead ? 1u : 0u;
        }
        asm volatile("s_waitcnt vmcnt(0) lgkmcnt(0)" ::: "memory"); __builtin_amdgcn_s_barrier(); asm volatile("" ::: "memory");
        const bool bad = flag[0] != 0u;
        if (lane < 32) {
            const unsigned long long* slot = (const unsigned long long*)xbuf + (size_t)(u.pm * BM + row) * 4; float mt[4], m2[4]; float ms = 0.f;
#pragma unroll
            for (int t = 0; t < 4; ++t) { if (t < ntn) { const unsigned long long w = __hip_atomic_load(slot + t, __ATOMIC_RELAXED, __HIP_MEMORY_SCOPE_AGENT); mt[t] = __uint_as_float((unsigned)w); m2[t] = __uint_as_float((unsigned)(w >> 32)); } else { mt[t] = 0.f; m2[t] = 0.f; } ms += mt[t]; }
            const float mean = ms / (float)ntn; float q = 0.f;
#pragma unroll
            for (int t = 0; t < 4; ++t) if (t < ntn) { const float dm = mt[t] - mean; q += m2[t] + 256.0f * dm * dm; }
            S[row] = (f32x2v){mean, 1.0f / sqrtf(q / (256.0f * (float)ntn) + eps)};
        }
        asm volatile("s_waitcnt lgkmcnt(0)" ::: "memory"); __builtin_amdgcn_s_barrier(); asm volatile("" ::: "memory");
        return bad;
    }
};
struct EpiLnRes {
    static constexpr bool PERM = false, AFTER_DRAIN = true;
    const float* base; float* out; int ldc; const float* bias; PanelStats st; unsigned poison;
    __device__ __forceinline__ void refuse(size_t i0, size_t stride, int M, int N) const { const float q = __builtin_nanf(""); for (size_t i = i0; i < (size_t)M * N; i += stride) out[(i / N) * ldc + i % N] = q;
        if (i0 == 0) { unsigned expect = 0u; __hip_atomic_compare_exchange_strong(st.tmo + 1, &expect, 0x7f0u, __ATOMIC_RELAXED, __ATOMIC_RELAXED, __HIP_MEMORY_SCOPE_AGENT); __hip_atomic_store(st.tmo, 1u, __ATOMIC_RELAXED, __HIP_MEMORY_SCOPE_AGENT); } }
    __device__ __forceinline__ void fused(f32x4 (&acc)[2][2][4][2], const Unit& u, int wr, int wc, int fr, int fq, PG8_LAS unsigned char* lds, int wid, int lane) const {
        typedef float f32x2v __attribute__((ext_vector_type(2)));
        const PG8_LAS f32x2v* S = (const PG8_LAS f32x2v*)(lds + 8192);
        const int col0 = u.pn * BM + wc * 32 + 4 * fq;
#pragma unroll
        for (int bj = 0; bj < 2; ++bj)
#pragma unroll
            for (int n = 0; n < 2; ++n) { const f32x4 bv = bias ? *(const f32x4*)(bias + col0 + bj * HALF + n * 16) : (f32x4){0.f, 0.f, 0.f, 0.f};
#pragma unroll
                for (int ai = 0; ai < 2; ++ai)
#pragma unroll
                    for (int m = 0; m < 4; ++m) acc[ai][bj][m][n] += bv; }
        const bool bad = st.run(acc, u, wr, wc, fr, fq, lds, wid, lane) || poison != 0u;
        const float qnan = __builtin_nanf("");
#pragma unroll
        for (int ai = 0; ai < 2; ++ai)
#pragma unroll
            for (int m = 0; m < 4; ++m) { const int r = ai * HALF + wr * 64 + m * 16 + fr; const f32x2v sr = S[r]; const size_t off = (size_t)(u.pm * BM + r) * ldc + col0;
#pragma unroll
                for (int bj = 0; bj < 2; ++bj)
#pragma unroll
                    for (int n = 0; n < 2; ++n) { const f32x4 bs = *(const f32x4*)(base + off + bj * HALF + n * 16); f32x4 o = bs + (acc[ai][bj][m][n] - sr.x) * sr.y;
                        if (bad) o = (f32x4){qnan, qnan, qnan, qnan}; *(f32x4*)(out + off + bj * HALF + n * 16) = o; }
                asm volatile("" ::: "memory"); }
    }
};
struct EpiLnResLn {
    static constexpr bool PERM = false, AFTER_DRAIN = true;
    const float* base; float* out; bf16_t* xn; int ldc; const float* bias; PanelStats st1, st2; unsigned poison;
    __device__ __forceinline__ void refuse(size_t i0, size_t stride, int M, int N) const { const float q = __builtin_nanf(""); for (size_t i = i0; i < (size_t)M * N; i += stride) { const size_t o = (i / N) * ldc + i % N; out[o] = q; xn[o] = (bf16_t)0x7fc0u; }
        if (i0 == 0) { unsigned expect = 0u; __hip_atomic_compare_exchange_strong(st1.tmo + 1, &expect, 0x7f0u, __ATOMIC_RELAXED, __ATOMIC_RELAXED, __HIP_MEMORY_SCOPE_AGENT); __hip_atomic_store(st1.tmo, 1u, __ATOMIC_RELAXED, __HIP_MEMORY_SCOPE_AGENT); } }
    __device__ __forceinline__ void fused(f32x4 (&acc)[2][2][4][2], const Unit& u, int wr, int wc, int fr, int fq, PG8_LAS unsigned char* lds, int wid, int lane) const {
        typedef float f32x2v __attribute__((ext_vector_type(2))); typedef unsigned u32x2v __attribute__((ext_vector_type(2)));
        const PG8_LAS f32x2v* S = (const PG8_LAS f32x2v*)(lds + 8192);
        const int col0 = u.pn * BM + wc * 32 + 4 * fq;
#pragma unroll
        for (int bj = 0; bj < 2; ++bj)
#pragma unroll
            for (int n = 0; n < 2; ++n) { const f32x4 bv = bias ? *(const f32x4*)(bias + col0 + bj * HALF + n * 16) : (f32x4){0.f, 0.f, 0.f, 0.f};
#pragma unroll
                for (int ai = 0; ai < 2; ++ai)
#pragma unroll
                    for (int m = 0; m < 4; ++m) acc[ai][bj][m][n] += bv; }
        bool bad = st1.run(acc, u, wr, wc, fr, fq, lds, wid, lane) || poison != 0u;
        const float qnan = __builtin_nanf("");
#pragma unroll
        for (int ai = 0; ai < 2; ++ai)
#pragma unroll
            for (int m = 0; m < 4; ++m) { const int r = ai * HALF + wr * 64 + m * 16 + fr; const f32x2v sr = S[r]; const size_t off = (size_t)(u.pm * BM + r) * ldc + col0;
#pragma unroll
                for (int bj = 0; bj < 2; ++bj)
#pragma unroll
                    for (int n = 0; n < 2; ++n) { const f32x4 bs = *(const f32x4*)(base + off + bj * HALF + n * 16); acc[ai][bj][m][n] = bs + (acc[ai][bj][m][n] - sr.x) * sr.y; }
                asm volatile("" : "+v"(acc[ai][0][m][0]), "+v"(acc[ai][0][m][1]), "+v"(acc[ai][1][m][0]), "+v"(acc[ai][1][m][1]));
                if (m & 1) asm volatile("" ::: "memory"); }
        const bool bad1 = bad;
        bad = st2.run(acc, u, wr, wc, fr, fq, lds, wid, lane) || bad;
#pragma unroll
        for (int ai = 0; ai < 2; ++ai)
#pragma unroll
            for (int m = 0; m < 4; ++m) { const int r = ai * HALF + wr * 64 + m * 16 + fr; const f32x2v sr = S[r]; const size_t off = (size_t)(u.pm * BM + r) * ldc + col0;
#pragma unroll
                for (int bj = 0; bj < 2; ++bj)
#pragma unroll
                    for (int n = 0; n < 2; ++n) { const f32x4 x1 = acc[ai][bj][m][n]; *(f32x4*)(out + off + bj * HALF + n * 16) = bad1 ? (f32x4){qnan, qnan, qnan, qnan} : x1;
                        const f32x4 o = (x1 - sr.x) * sr.y; u32x2v w; w.x = cvt_pk_bf16(o[0], o[1]); w.y = cvt_pk_bf16(o[2], o[3]);
                        if (bad) { w.x = 0x7fc07fc0u; w.y = 0x7fc07fc0u; } *(u32x2v*)(xn + off + bj * HALF + n * 16) = w; }
                asm volatile("" ::: "memory"); }
    }
};

template <class Epi, class Sched, bool STAMP = false>
__device__ __forceinline__ void gemm_phase(PG8_LAS unsigned char* lds, const Gemm g, const Sched& S, const Epi& E, unsigned long long* stamps, const int tid) {
    const int wid = __builtin_amdgcn_readfirstlane(tid >> 6), lane = tid & 63, wr = wid >> 2, wc = wid & 3, fr = lane & 15, fq = lane >> 4;
    const int K = g.K, nt = K / BK;
    int ts_lo = 0, ts_hi = 0, nts = 0; const unsigned long long rt_entry = STAMP ? (unsigned long long)wall_clock64() : 0ull;
#define PG8_STAMP() do { if (STAMP && wid == 0 && nts < 64) { const unsigned long long _c = (unsigned long long)clock64(); \
        ts_lo = (lane == nts) ? (int)(unsigned)_c : ts_lo; ts_hi = (lane == nts) ? (int)(unsigned)(_c >> 32) : ts_hi; ++nts; } } while (0)
    PG8_STAMP();
    unsigned voffA[2], voffB[2];
#pragma unroll
    for (int i = 0; i < 2; ++i) { int R, C; stage_rc(tid * 16 + i * 8192, R, C); const int Rb = Epi::PERM ? ((R & ~31) + perm32(R & 31)) : R;
        voffA[i] = (unsigned)(R * g.lda + C) * 2u; voffB[i] = (unsigned)(Rb * g.ldb + C) * 2u; }
    const size_t kstep = (size_t)(BK * 2);
    const size_t hstepA = (size_t)HALF * g.lda * 2, hstepB = (size_t)HALF * g.ldb * 2;
    const size_t tstepA = 2 * hstepA, tstepB = 2 * hstepB;
    const unsigned ldsw = (unsigned)wid * 1024u;
    const int aoff = lds_byte(wr * 64 + fr, fq * 8), boff = lds_byte(wc * 32 + fr, fq * 8);
#define PG8_SA(b, h) (((b) * 2 + (h)) * HTB)
#define PG8_SB(b, h) ((4 + (b) * 2 + (h)) * HTB)
#define PG8_STAGE(bufoff, gbase, voff) do { _Pragma("unroll") for (int _i = 0; _i < 2; ++_i) \
        __builtin_amdgcn_global_load_lds((const unsigned*)((const char*)(gbase) + (voff)[_i]), (PG8_LAS unsigned*)(lds + (bufoff) + ldsw + _i * 8192), 16, 0, 0); } while (0)
#define PG8_LDA(dst, b, h) do { _Pragma("unroll") for (int m = 0; m < 4; ++m) _Pragma("unroll") for (int k = 0; k < 2; ++k) dst[m][k] = *(const PG8_LAS bf16x8*)(lds + PG8_SA(b, h) + aoff + m * 2048 + k * 1024); } while (0)
#define PG8_LDB(dst, b, h) do { _Pragma("unroll") for (int n = 0; n < 2; ++n) _Pragma("unroll") for (int k = 0; k < 2; ++k) dst[n][k] = *(const PG8_LAS bf16x8*)(lds + PG8_SB(b, h) + boff + n * 2048 + k * 1024); } while (0)
#define PG8_MMA(ai, bj, At, Bt) do { __builtin_amdgcn_s_setprio(1); _Pragma("unroll") for (int m = 0; m < 4; ++m) _Pragma("unroll") for (int n = 0; n < 2; ++n) _Pragma("unroll") for (int k = 0; k < 2; ++k) \
        acc[ai][bj][m][n] = __builtin_amdgcn_mfma_f32_16x16x32_bf16(Bt[n][k], At[m][k], acc[ai][bj][m][n], 0, 0, 0); __builtin_amdgcn_s_setprio(0); } while (0)
#define PG8_WAIT_V(n) asm volatile("s_waitcnt vmcnt(" #n ")" ::: "memory")
#define PG8_WAIT_L(n) asm volatile("s_waitcnt lgkmcnt(" #n ")" ::: "memory")
#define PG8_BAR __builtin_amdgcn_s_barrier()
#define PG8_SCHED __builtin_amdgcn_sched_barrier(0)
    Unit cur, nxt; int ui = 0;
    if (!S.next(0, cur)) return;
    f32x4 acc[2][2][4][2];
#pragma unroll
    for (int a = 0; a < 2; ++a)
#pragma unroll
        for (int b = 0; b < 2; ++b)
#pragma unroll
            for (int m = 0; m < 4; ++m)
#pragma unroll
                for (int n = 0; n < 2; ++n) acc[a][b][m][n] = (f32x4){0.f, 0.f, 0.f, 0.f};
    bf16x8 At[4][2], B0[2][2], B1[2][2];
    const char* cA = (const char*)g.A + (size_t)cur.pm * tstepA; const char* cB = (const char*)g.Bt + (size_t)cur.pn * tstepB;
    S.a_ready(cur);
    PG8_STAGE(PG8_SB(0, 0), cB, voffB); PG8_STAGE(PG8_SA(0, 0), cA, voffA); PG8_STAGE(PG8_SB(0, 1), cB + hstepB, voffB); PG8_STAGE(PG8_SA(0, 1), cA + hstepA, voffA);
    if (wr == 1) PG8_BAR;
    PG8_WAIT_V(4); PG8_BAR;
    PG8_STAGE(PG8_SB(1, 0), cB + kstep, voffB); PG8_STAGE(PG8_SA(1, 0), cA + kstep, voffA); PG8_STAGE(PG8_SB(1, 1), cB + hstepB + kstep, voffB);
    PG8_WAIT_V(6); PG8_BAR;
    PG8_STAMP();
    for (;;) {
        const bool has_next = S.next(ui + 1, nxt);
        const char* nA = has_next ? (const char*)g.A + (size_t)nxt.pm * tstepA : cA; const char* nB = has_next ? (const char*)g.Bt + (size_t)nxt.pn * tstepB : cB;
        for (int t = 0; t < nt; t += 2) {
            const bool last = (t == nt - 2);
            const char* a1 = cA + (size_t)(t + 1) * kstep;
            const char* a2 = last ? nA : cA + (size_t)(t + 2) * kstep; const char* b2 = last ? nB : cB + (size_t)(t + 2) * kstep;
            const char* a3 = a2 + kstep; const char* b3 = b2 + kstep;
            if (last && has_next) S.a_ready(nxt);
            PG8_LDB(B0, 0, 0); PG8_SCHED; PG8_LDA(At, 0, 0); PG8_STAGE(PG8_SA(1, 1), a1 + hstepA, voffA);
            PG8_WAIT_L(8); PG8_BAR; PG8_WAIT_L(0); PG8_MMA(0, 0, At, B0); PG8_BAR; PG8_SCHED;
            PG8_LDB(B1, 0, 1); PG8_STAGE(PG8_SB(0, 0), b2, voffB);
            PG8_BAR; PG8_WAIT_L(0); PG8_MMA(0, 1, At, B1); PG8_BAR;
            PG8_LDA(At, 0, 1); PG8_STAGE(PG8_SA(0, 0), a2, voffA);
            PG8_BAR; PG8_WAIT_L(0); PG8_MMA(1, 0, At, B0); PG8_BAR; PG8_SCHED;
            PG8_STAGE(PG8_SB(0, 1), b2 + hstepB, voffB);
            PG8_WAIT_V(6); PG8_BAR; PG8_MMA(1, 1, At, B1); PG8_BAR;
            PG8_LDB(B0, 1, 0); PG8_SCHED; PG8_LDA(At, 1, 0); PG8_STAGE(PG8_SA(0, 1), a2 + hstepA, voffA);
            PG8_WAIT_L(8); PG8_BAR; PG8_WAIT_L(0); PG8_MMA(0, 0, At, B0); PG8_BAR; PG8_SCHED;
            PG8_LDB(B1, 1, 1); PG8_STAGE(PG8_SB(1, 0), b3, voffB);
            PG8_BAR; PG8_WAIT_L(0); PG8_MMA(0, 1, At, B1); PG8_BAR;
            PG8_LDA(At, 1, 1); PG8_STAGE(PG8_SA(1, 0), a3, voffA);
            PG8_BAR; PG8_WAIT_L(0); PG8_MMA(1, 0, At, B0); PG8_BAR; PG8_SCHED;
            PG8_STAGE(PG8_SB(1, 1), b3 + hstepB, voffB);
            PG8_WAIT_V(6); PG8_BAR; PG8_MMA(1, 1, At, B1); PG8_BAR;
        }
        PG8_STAMP();
        if constexpr (!Epi::AFTER_DRAIN) { E(acc, cur, wr, wc, fr, fq); S.done(cur); }
        PG8_STAMP();
        if (!has_next) break;
#pragma unroll
        for (int a = 0; a < 2; ++a)
#pragma unroll
            for (int b = 0; b < 2; ++b)
#pragma unroll
                for (int m = 0; m < 4; ++m)
#pragma unroll
                    for (int n = 0; n < 2; ++n) acc[a][b][m][n] = (f32x4){0.f, 0.f, 0.f, 0.f};
        cur = nxt; cA = nA; cB = nB; ++ui;
    }
    PG8_WAIT_V(0);
    if (wr == 0) PG8_BAR;
    PG8_BAR;
    if constexpr (Epi::AFTER_DRAIN) { E.fused(acc, cur, wr, wc, fr, fq, lds, wid, lane); S.done(cur); }
    PG8_STAMP();
    if (STAMP && wid == 0) { stamps[lane] = lane < nts ? (((unsigned long long)(unsigned)ts_hi << 32) | (unsigned)ts_lo) : 0ull;
        if (lane == 62) stamps[62] = rt_entry; if (lane == 63) stamps[63] = (unsigned long long)wall_clock64(); }
#undef PG8_STAMP
#undef PG8_SA
#undef PG8_SB
#undef PG8_STAGE
#undef PG8_LDA
#undef PG8_LDB
#undef PG8_MMA
#undef PG8_WAIT_V
#undef PG8_WAIT_L
#undef PG8_BAR
#undef PG8_SCHED
}
}

struct PgEpiSwiGLU {
  static constexpr bool PERM = true, AFTER_DRAIN = false;
  u16* act;
  __device__ __forceinline__ void operator()(const pg8::f32x4 (&acc)[2][2][4][2], const pg8::Unit& u, int wr, int wc, int fr, int fq) const {
    const int row0 = u.pm * 256 + wr * 64 + fr, j0 = u.pn * 128 + wc * 32 + 8 * fq;
#pragma unroll
    for (int ai = 0; ai < 2; ++ai)
#pragma unroll
      for (int m = 0; m < 4; ++m) {
        unsigned pk[4];
#pragma unroll
        for (int n = 0; n < 2; ++n) {
          float y[4];
#pragma unroll
          for (int e = 0; e < 4; ++e) {
            const float gt = acc[ai][0][m][n][e], up = acc[ai][1][m][n][e];
            y[e] = gt * __builtin_amdgcn_rcpf(1.f + fexp2(-LOG2E * gt)) * up;
          }
          pk[2 * n] = cvt_pk(y[0], y[1]); pk[2 * n + 1] = cvt_pk(y[2], y[3]);
        }
        u32x4 w4; w4.x = pk[0]; w4.y = pk[1]; w4.z = pk[2]; w4.w = pk[3];
        *(u32x4*)(act + (size_t)(row0 + ai * 128 + m * 16) * DFF + j0) = w4;
      }
  }
};
template <class Epi>
DI void pg_gemm(const u16* A, const u16* Bt, int M, int N, int K, const Epi& E, char* lds, int bid, int nblk, const Ctx& p) {
  pg8::Gemm g{A, Bt, M, N, K, K, K};
  pg8::StaticOrder S; S.init(M, N, nblk, bid);
  pg8::gemm_phase<Epi, pg8::StaticOrder, false>((PG8_LAS unsigned char*)lds, g, S, E, nullptr, otid(p));
}

constexpr int LDS_BYTES = 2 * (256 + 256) * 144;

struct PgEpiUQ {
  static constexpr bool PERM = false, AFTER_DRAIN = false;
  u16* q; const float* rq; const float2* rope;
  __device__ __forceinline__ void operator()(const pg8::f32x4 (&acc)[2][2][4][2], const pg8::Unit& u, int wr, int wc, int fr, int fq) const {
    const int row0 = u.pm * 256 + wr * 64 + fr;
#pragma unroll
    for (int ai = 0; ai < 2; ++ai)
#pragma unroll
      for (int m = 0; m < 4; ++m) {
        const int row = row0 + ai * 128 + m * 16;
        const float sc = rq[row] * QSCALE96;
        const int pos = tok_pos(row);
#pragma unroll
        for (int bj = 0; bj < 2; ++bj) {
          const int gb = u.pn * 256 + bj * 128 + wc * 32;
          pg8::f32x4 v0 = acc[ai][bj][m][0] * sc, v1 = acc[ai][bj][m][1] * sc;
          if (((gb >> 5) % 3) == 2) {
            const float4 ca = *(const float4*)(rope + pos * 16 + 4 * fq), cb = *(const float4*)(rope + pos * 16 + 4 * fq + 2);
            const float cs[4] = {ca.x, ca.z, cb.x, cb.z}, sn[4] = {ca.y, ca.w, cb.y, cb.w};
#pragma unroll
            for (int e = 0; e < 4; ++e) { const float x1 = v0[e], x2 = v1[e]; v0[e] = x1 * cs[e] - x2 * sn[e]; v1[e] = x2 * cs[e] + x1 * sn[e]; }
          }
          u16* dst = q + (size_t)row * 1536 + gb + 4 * fq;
          u32x2 w0; w0.x = cvt_pk(v0[0], v0[1]); w0.y = cvt_pk(v0[2], v0[3]);
          u32x2 w1; w1.x = cvt_pk(v1[0], v1[1]); w1.y = cvt_pk(v1[2], v1[3]);
          *(u32x2*)dst = w0;
          *(u32x2*)(dst + 16) = w1;
        }
      }
  }
};
struct PgEpiKnope {
  static constexpr bool PERM = true, AFTER_DRAIN = false;
  u16* knope; const float* rkv; unsigned* kp;
  __device__ __forceinline__ void operator()(const pg8::f32x4 (&acc)[2][2][4][2], const pg8::Unit& u, int wr, int wc, int fr, int fq) const {
    const int row0 = u.pm * 256 + wr * 64 + fr;
    float pm[2] = {0.f, 0.f};
#pragma unroll
    for (int ai = 0; ai < 2; ++ai)
#pragma unroll
      for (int m = 0; m < 4; ++m) {
        const int row = row0 + ai * 128 + m * 16;
        const float sc = rkv[row];
#pragma unroll
        for (int bj = 0; bj < 2; ++bj) {
          const pg8::f32x4 v0 = acc[ai][bj][m][0] * sc, v1 = acc[ai][bj][m][1] * sc;
          u32x4 w4; w4.x = cvt_pk(v0[0], v0[1]); w4.y = cvt_pk(v0[2], v0[3]); w4.z = cvt_pk(v1[0], v1[1]); w4.w = cvt_pk(v1[2], v1[3]);
          *(u32x4*)(knope + (size_t)row * 1024 + u.pn * 256 + bj * 128 + wc * 32 + 8 * fq) = w4;
          float ss = 0.f;
#pragma unroll
          for (int e = 0; e < 4; ++e) ss += v0[e] * v0[e] + v1[e] * v1[e];
          pm[bj] = fmaxf(pm[bj], ss);
        }
      }
#pragma unroll
    for (int bj = 0; bj < 2; ++bj) {
      float v = pm[bj];
      v = fmaxf(v, __int_as_float(__builtin_amdgcn_ds_swizzle(__float_as_int(v), (8 << 10) | 0x1f)));
      v = fmaxf(v, __int_as_float(__builtin_amdgcn_ds_swizzle(__float_as_int(v), (4 << 10) | 0x1f)));
      v = fmaxf(v, __int_as_float(__builtin_amdgcn_ds_swizzle(__float_as_int(v), (2 << 10) | 0x1f)));
      v = fmaxf(v, __int_as_float(__builtin_amdgcn_ds_swizzle(__float_as_int(v), (1 << 10) | 0x1f)));
      if (fr == 0) atomicMax(kp + ((u.pn * 256 + bj * 128 + wc * 32) >> 6) * 8 + ((wc & 1) << 2) + fq, __float_as_uint(sqrtf(v) * 1.01f));
    }
  }
};
struct PgEpiVt {
  static constexpr bool PERM = true, AFTER_DRAIN = false;
  u16* vt; const float* rkv;
  __device__ __forceinline__ void operator()(const pg8::f32x4 (&acc)[2][2][4][2], const pg8::Unit& u, int wr, int wc, int fr, int fq) const {
    const int row0 = u.pm * 256 + wr * 64 + fr;
#pragma unroll
    for (int bj = 0; bj < 2; ++bj) {
      const int c0 = u.pn * 256 + bj * 128 + wc * 32 + 8 * fq;
      const float4 s0 = *(const float4*)(rkv + c0), s1 = *(const float4*)(rkv + c0 + 4);
#pragma unroll
      for (int ai = 0; ai < 2; ++ai)
#pragma unroll
        for (int m = 0; m < 4; ++m) {
          const pg8::f32x4 v0 = acc[ai][bj][m][0], v1 = acc[ai][bj][m][1];
          u32x4 w4; w4.x = cvt_pk(v0[0] * s0.x, v0[1] * s0.y); w4.y = cvt_pk(v0[2] * s0.z, v0[3] * s0.w);
          w4.z = cvt_pk(v1[0] * s1.x, v1[1] * s1.y); w4.w = cvt_pk(v1[2] * s1.z, v1[3] * s1.w);
          *(u32x4*)(vt + (size_t)(row0 + ai * 128 + m * 16) * T_TOK + c0) = w4;
        }
    }
  }
};
template <class Epi>
DI void pg_gemm_ld(const u16* A, int lda, const u16* Bt, int ldb, int M, int N, int K, const Epi& E, char* lds, int bid, int nblk, const Ctx& p) {
  pg8::Gemm g{A, Bt, M, N, K, lda, ldb};
  pg8::StaticOrder S; S.init(M, N, nblk, bid);
  pg8::gemm_phase<Epi, pg8::StaticOrder, false>((PG8_LAS unsigned char*)lds, g, S, E, nullptr, otid(p));
}

DI void grid_barrier(unsigned* ctr, unsigned target, const Ctx& p) {
  __syncthreads();
  if (otid(p) < 64) {
    __builtin_amdgcn_fence(__ATOMIC_RELEASE, "agent");
    if (otid(p) == 0) {
      __hip_atomic_fetch_add(ctr, 1u, __ATOMIC_RELAXED, __HIP_MEMORY_SCOPE_AGENT);
      while (__hip_atomic_load(ctr, __ATOMIC_RELAXED, __HIP_MEMORY_SCOPE_AGENT) < target) { }
    }
    __builtin_amdgcn_fence(__ATOMIC_ACQUIRE, "agent");
  }
  __syncthreads();
}
template <int PH>
DI void run_phase(const Ctx& p, char* lds) {
  const int bid = obid(), nblk = gridDim.x;
  u16* wb = (u16*)p.ws;
  u16* R1 = (u16*)(p.ws + OFF_R1);
  u16* R2 = (u16*)(p.ws + OFF_R2);
  u16* R3 = (u16*)(p.ws + OFF_R3);
  if constexpr (PH == 0) phase_prep(p);
  else if constexpr (PH == 1) {
    pg_gemm(R1, wb + W0IN, T_TOK, 2048, 1024, pg8::EpiBf16<0>{R2, 512, nullptr, 512, SEG512}, lds, bid, nblk, p);
    pg_gemm(wb + W0IN + (size_t)2048 * 1024, R1, 1024, T_TOK, 1024, pg8::EpiBf16<0>{R2 + 4 * SEG512, T_TOK, nullptr, 0, 0}, lds, bid, nblk, p);
    grid_barrier((unsigned*)(p.ws + OFF_SCAL) + SC_BAR2, (unsigned)nblk, p);
    phase_qk_norms(p);
  }
  else if constexpr (PH == 2) {
    unsigned* ctr = (unsigned*)(p.ws + OFF_SCAL) + SC_CTR;
    int* nxt_slot = (int*)(lds + LDS_BYTES - 16);
    const int tid0 = otid(p);
    int it = bid;
    while (it < 5120) {
      int nx = 0;
      if (tid0 == 0) nx = (int)atomicAdd(ctr, 1u) + nblk;
      if (it < 2560) attn_diff_item(p, it, lds);
      else attn_na_item(p, it - 2560, lds);
      __syncthreads();
      if (tid0 == 0) *nxt_slot = nx;
      __syncthreads();
      it = *nxt_slot;
    }
  }
  else if constexpr (PH == 3) pg_gemm(R1, wb + W0OUT, T_TOK, 1024, 1024, pg8::EpiBf16<0>{R3, 1024, nullptr, 0, 0}, lds, bid, nblk, p);
  else if constexpr (PH == 4) phase_res<true, false>(p, R3, (const float*)(p.ws + OFF_SCAL) + SC_G0);
  else if constexpr (PH == 5) pg_gemm(R1, wb + W0F1, T_TOK, 5632, 1024, PgEpiSwiGLU{R2}, lds, bid, nblk, p);
  else if constexpr (PH == 6) pg_gemm(R2, wb + W0F2, T_TOK, 1024, 2816, pg8::EpiBf16<0>{R3, 1024, nullptr, 0, 0}, lds, bid, nblk, p);
  else if constexpr (PH == 7) phase_res<false, false>(p, R3, (const float*)(p.ws + OFF_SCAL) + SC_G1);
  else if constexpr (PH == 8) pg_gemm(R1, wb + W1DN, T_TOK, 768, 1024, pg8::EpiBf16<0>{R3, 768, nullptr, 0, 0}, lds, bid, nblk, p);
  else if constexpr (PH == 9) phase_mla_stats(p);
  else if constexpr (PH == 10) {
    pg_gemm_ld(R3, 768, wb + W1UQ, 384, T_TOK, 1536, 384, PgEpiUQ{R2, (const float*)(p.ws + OFF_RQ), (const float2*)(p.ws + OFF_ROPE)}, lds, bid, nblk, p);
    pg_gemm_ld(R3 + 384, 768, wb + W1UKV, 256, T_TOK, 1024, 256,
               PgEpiKnope{R2 + (size_t)T_TOK * 1536, (const float*)(p.ws + OFF_RKV), (unsigned*)(p.ws + OFF_SCAL) + SC_KP}, lds, bid, nblk, p);
    pg_gemm_ld(wb + W1UKV + (size_t)1024 * 256, 256, R3 + 384, 768, 1024, T_TOK, 256,
               PgEpiVt{R2 + (size_t)T_TOK * 2560, (const float*)(p.ws + OFF_RKV)}, lds, bid, nblk, p);
  }
  else if constexpr (PH == 11) { for (int it = bid; it < 2560; it += nblk) {
      int itm = it;
      if (nblk == 256) {
        const int rnd = it >> 8, x = bid & 7, j = bid >> 3;
        itm = rnd < 2 ? (8 * rnd + x) * 32 + j : 512 + (2 * (rnd - 2) + (x >> 2)) * 128 + (4 * (x & 3) + (j >> 3)) * 8 + (j & 7);
      }
      attn_mla_item2(p, itm, lds);
    } }
  else if constexpr (PH == 12) pg_gemm(R1, wb + W1OUT, T_TOK, 1024, 1024, pg8::EpiBf16<0>{R3, 1024, nullptr, 0, 0}, lds, bid, nblk, p);
  else if constexpr (PH == 13) phase_res<false, false>(p, R3, (const float*)(p.ws + OFF_SCAL) + SC_G2);
  else if constexpr (PH == 14) pg_gemm(R1, wb + W1F1, T_TOK, 5632, 1024, PgEpiSwiGLU{R2}, lds, bid, nblk, p);
  else if constexpr (PH == 15) pg_gemm(R2, wb + W1F2, T_TOK, 1024, 2816, pg8::EpiBf16<0>{R3, 1024, nullptr, 0, 0}, lds, bid, nblk, p);
  else if constexpr (PH == 16) phase_res<false, true>(p, R3, (const float*)(p.ws + OFF_SCAL) + SC_G3);
}

#if MULTI_LAUNCH
template <int PH>
__global__ void __launch_bounds__(512, 2) k_phase(Params pa) {
  extern __shared__ __attribute__((aligned(16))) char lds[];
  Ctx p;
#pragma unroll
  for (int i = 0; i < 28; ++i) p.in[i] = pa.in[i];
  p.out = pa.out; p.ws = pa.ws;
  p.wv = __builtin_amdgcn_readfirstlane((int)(threadIdx.x >> 6));
  run_phase<PH>(p, lds);
}
template <int PH>
static void launch_all(const Params& p, int grid, hipStream_t stream) {
  (void)hipFuncSetAttribute((const void*)k_phase<PH>, hipFuncAttributeMaxDynamicSharedMemorySize, LDS_BYTES);
  hipLaunchKernelGGL(k_phase<PH>, dim3(grid), dim3(512), LDS_BYTES, stream, p);
  if constexpr (PH + 1 < NPHASE) launch_all<PH + 1>(p, grid, stream);
}
#define OCC_KERNEL k_phase<2>
#else
#ifndef PROBE_DUP
#define PROBE_DUP -1
#endif
#ifndef PROBE_DUP2
#define PROBE_DUP2 -1
#endif
template <int PH>
DI void run_from(const Ctx& p, char* lds) {
  if constexpr (PH == PROBE_DUP || PH == PROBE_DUP2) { run_phase<PH>(p, lds); cg::this_grid().sync(); }
#ifdef PROBE_ABL
  if constexpr (PH == 11) { for (int it = obid(); it < 5120; it += gridDim.x) attn_mla_item<PROBE_ABL>(p, it, lds); cg::this_grid().sync(); }
#endif
  run_phase<PH>(p, lds);
  if constexpr (PH + 1 < NPHASE) {
    if constexpr (PH == 0) cg::this_grid().sync();
    else grid_barrier((unsigned*)(p.ws + OFF_SCAL) + SC_BAR, (unsigned)PH * gridDim.x, p);
    run_from<PH + 1>(p, lds);
  }
}
__global__ void __launch_bounds__(512, 2) mega(Params pa) {
  extern __shared__ __attribute__((aligned(16))) char lds[];
  Ctx p;
#pragma unroll
  for (int i = 0; i < 28; ++i) p.in[i] = pa.in[i];
  p.out = pa.out; p.ws = pa.ws;
  p.wv = __builtin_amdgcn_readfirstlane((int)(threadIdx.x >> 6));
  run_from<0>(p, lds);
}
#define OCC_KERNEL mega
#endif

extern "C" void kernel_launch(void* const* d_in, const int* in_sizes, int n_in, void* d_out, int out_size, void* d_ws, size_t ws_size,
                              hipStream_t stream) {
  static int grid = 0;
  if (grid == 0) {
    if (n_in != 28 || ws_size < WS_NEED) { fprintf(stderr, "kernel_launch: unexpected n_in %d / ws_size %zu (need %zu)\n", n_in, ws_size, (size_t)WS_NEED); grid = -1; return; }
    int dev = 0, cus = 0, per_cu = 0;
    (void)hipGetDevice(&dev);
    (void)hipDeviceGetAttribute(&cus, hipDeviceAttributeMultiprocessorCount, dev);
    (void)hipFuncSetAttribute((const void*)OCC_KERNEL, hipFuncAttributeMaxDynamicSharedMemorySize, LDS_BYTES);
    (void)hipOccupancyMaxActiveBlocksPerMultiprocessor(&per_cu, (const void*)OCC_KERNEL, 512, LDS_BYTES);
    if (per_cu < 1) per_cu = 1;
    if (per_cu > 1) per_cu = 1;
    grid = cus * per_cu;
  }
  if (grid < 0) return;
  Params p{};
  for (int i = 0; i < 28; ++i) p.in[i] = (const float*)d_in[i];
  p.out = (float*)d_out;
  p.ws = (char*)d_ws;
#if MULTI_LAUNCH
  launch_all<0>(p, grid, stream);
#else
  void* args[] = {&p};
  hipError_t e = hipLaunchCooperativeKernel((const void*)mega, dim3(grid), dim3(512), args, LDS_BYTES, stream);
  if (e != hipSuccess) fprintf(stderr, "cooperative launch failed: %s (grid %d)\n", hipGetErrorString(e), grid);
#endif
}
```
